# Optimizing an MI355X kernel written in HIP

```python
import math
import jax
import jax.numpy as jnp
from jax import lax
import numpy as np

D_MODEL = 1024
BATCH = 2
SEQ = 8192
DEPTH = 2

N_ATTN_LAYERS = (DEPTH + 1) // 2
N_SSD_LAYERS = DEPTH // 2

HEAD_DIM = 64
DIFF_HEADS = 4
DIFF_V = 2 * HEAD_DIM
SB_HEADS = 8
SB_DIM = HEAD_DIM
DIFF_QK_W = DIFF_HEADS * 2 * HEAD_DIM
SB_W = SB_HEADS * SB_DIM
MIX_WIDTH = DIFF_HEADS * DIFF_V + SB_W
ATTN_IN_WIDTH = 3 * DIFF_QK_W + 3 * SB_W
Q_BLOCK = 128
ROPE_THETA = 10000.0
NORM_EPS = 1e-6
SUBLN_EPS = 1e-5

SSD_EXPAND = 2
D_INNER = SSD_EXPAND * D_MODEL
SSD_HEAD_DIM = 64
SSD_HEADS = D_INNER // SSD_HEAD_DIM
SSD_GROUPS = 8
SSD_STATE = 128
SSD_CONV = 4
SSD_CHUNK = 128
SSD_GN = SSD_GROUPS * SSD_STATE
CONV_DIM = D_INNER + 2 * SSD_GN
SSD_IN_WIDTH = 2 * D_INNER + 2 * SSD_GN + SSD_HEADS

D_FF = (((8 * D_MODEL + 2) // 3 + 255) // 256) * 256

kernel_name = "hybrid_diffattn_stickbreak_ssd_swiglu"


def rmsnorm(x, w, eps=NORM_EPS):
    xf = x.astype(jnp.float32)
    y = xf * lax.rsqrt(jnp.mean(xf * xf, axis=-1, keepdims=True) + eps)
    return (y * w.astype(jnp.float32)).astype(x.dtype)


def rope(t, pos):
    half = HEAD_DIM // 2
    inv_freq = ROPE_THETA ** (-jnp.arange(half, dtype=jnp.float32) / half)
    ang = pos.astype(jnp.float32)[:, None] * inv_freq[None, :]
    shape = (1, pos.shape[0]) + (1,) * (t.ndim - 3) + (half,)
    cos = jnp.cos(ang).reshape(shape)
    sin = jnp.sin(ang).reshape(shape)
    tf = t.astype(jnp.float32)
    t1, t2 = tf[..., :half], tf[..., half:]
    out = jnp.concatenate([t1 * cos - t2 * sin, t2 * cos + t1 * sin], axis=-1)
    return out.astype(t.dtype)


def swiglu(h, w_gate, w_up, w_down):
    return (jax.nn.silu(h @ w_gate) * (h @ w_up)) @ w_down


def attn_mixer(h, w_in, lq1, lk1, lq2, lk2, subln_w, w_out, lambda_init):
    f32 = jnp.float32
    b, s, _ = h.shape
    nb = s // Q_BLOCK
    pos = jnp.arange(s, dtype=jnp.int32)
    proj = h @ w_in
    dq, dk, dv, sq, sk, sv = jnp.split(
        proj,
        [DIFF_QK_W, 2 * DIFF_QK_W, 3 * DIFF_QK_W, 3 * DIFF_QK_W + SB_W, 3 * DIFF_QK_W + 2 * SB_W],
        axis=-1)
    dq = rope(dq.reshape(b, s, DIFF_HEADS, 2, HEAD_DIM), pos).transpose(0, 2, 3, 1, 4)
    dk = rope(dk.reshape(b, s, DIFF_HEADS, 2, HEAD_DIM), pos).transpose(0, 2, 3, 1, 4)
    dv = dv.reshape(b, s, DIFF_HEADS, DIFF_V).transpose(0, 2, 1, 3)
    sq = sq.reshape(b, s, SB_HEADS, SB_DIM).transpose(0, 2, 1, 3)
    sk = sk.reshape(b, s, SB_HEADS, SB_DIM).transpose(0, 2, 1, 3)
    sv = sv.reshape(b, s, SB_HEADS, SB_DIM).transpose(0, 2, 1, 3)
    scale = HEAD_DIM ** -0.5
    lam = (jnp.exp(jnp.sum(lq1.astype(f32) * lk1.astype(f32)))
           - jnp.exp(jnp.sum(lq2.astype(f32) * lk2.astype(f32))) + lambda_init)

    dq_blocks = jnp.moveaxis(dq.reshape(b, DIFF_HEADS, 2, nb, Q_BLOCK, HEAD_DIM), 3, 0)
    sq_blocks = jnp.moveaxis(sq.reshape(b, SB_HEADS, nb, Q_BLOCK, SB_DIM), 2, 0)
    starts = jnp.arange(nb, dtype=jnp.int32) * Q_BLOCK

    def block(args):
        start, dq_b, sq_b = args
        qpos = start + jnp.arange(Q_BLOCK, dtype=jnp.int32)
        causal = pos[None, :] <= qpos[:, None]
        strict = pos[None, :] < qpos[:, None]
        sc = jnp.einsum('bhiqd,bhikd->bhiqk', dq_b, dk).astype(f32) * scale
        p = jax.nn.softmax(jnp.where(causal, sc, -jnp.inf), axis=-1)
        p_diff = p[:, :, 0] - lam * p[:, :, 1]
        o_diff = jnp.einsum('bhqk,bhkv->bhqv', p_diff.astype(dv.dtype), dv)
        z = jnp.einsum('bhqd,bhkd->bhqk', sq_b, sk).astype(f32) * scale
        log_keep = jnp.where(strict, jax.nn.log_sigmoid(-z), 0.0)
        tail = lax.cumsum(log_keep, axis=3, reverse=True) - log_keep
        a_sb = jnp.where(strict, jnp.exp(jax.nn.log_sigmoid(z) + tail), 0.0)
        o_sb = jnp.einsum('bhqk,bhkd->bhqd', a_sb.astype(sv.dtype), sv)
        return o_diff, o_sb

    o_diff, o_sb = lax.map(block, (starts, dq_blocks, sq_blocks))
    o_diff = o_diff.transpose(1, 0, 3, 2, 4).reshape(b, s, DIFF_HEADS, DIFF_V)
    o_diff = rmsnorm(o_diff, subln_w, SUBLN_EPS) * (1.0 - lambda_init)
    o_sb = o_sb.transpose(1, 0, 3, 2, 4).reshape(b, s, SB_W)
    mixed = jnp.concatenate([o_diff.reshape(b, s, DIFF_HEADS * DIFF_V), o_sb], axis=-1)
    return mixed @ w_out


def causal_depthwise_conv(u, w, bias):
    out = lax.conv_general_dilated(
        u, w[:, None, :].astype(u.dtype), window_strides=(1,), padding=[(SSD_CONV - 1, 0)],
        dimension_numbers=('NWC', 'WIO', 'NWC'), feature_group_count=u.shape[-1])
    return out + bias


def ssd_scan(x, dt, a, bmat, cmat):
    f32 = jnp.float32
    b, s, nh, p = x.shape
    nc = s // SSD_CHUNK
    r = nh // SSD_GROUPS
    L = SSD_CHUNK
    xdt = (x.astype(f32) * dt[..., None]).reshape(b, nc, L, SSD_GROUPS, r, p)
    acum = jnp.cumsum((dt * a).reshape(b, nc, L, SSD_GROUPS, r), axis=2)
    acum = acum.transpose(0, 1, 3, 4, 2)
    bm = bmat.astype(f32).reshape(b, nc, L, SSD_GROUPS, SSD_STATE)
    cm = cmat.astype(f32).reshape(b, nc, L, SSD_GROUPS, SSD_STATE)
    idx = jnp.arange(L)
    lower = idx[:, None] >= idx[None, :]
    seg = acum[..., :, None] - acum[..., None, :]
    decay = jnp.exp(jnp.where(lower, seg, -jnp.inf))
    cb = jnp.einsum('bclgn,bcmgn->bcglm', cm, bm)
    y_diag = jnp.einsum('bcgrlm,bcmgrp->bclgrp', cb[:, :, :, None] * decay, xdt)
    state_decay = jnp.exp(acum[..., -1:] - acum)
    states = jnp.einsum('bclgn,bcgrl,bclgrp->bcgrpn', bm, state_decay, xdt)
    chunk_decay = jnp.exp(acum[..., -1])

    def step(carry, inp):
        st, dec = inp
        return carry * dec[..., None, None] + st, carry

    init = jnp.zeros((b, SSD_GROUPS, r, p, SSD_STATE), f32)
    _, prev = lax.scan(step, init, (jnp.moveaxis(states, 1, 0), jnp.moveaxis(chunk_decay, 1, 0)))
    prev = jnp.moveaxis(prev, 0, 1)
    y_off = jnp.einsum('bclgn,bcgrpn,bcgrl->bclgrp', cm, prev, jnp.exp(acum))
    return (y_diag + y_off).reshape(b, s, nh, p)


def ssd_mixer(h, w_in, conv_w, conv_b, dt_bias, a_log, d_skip, gnorm_w, w_out):
    f32 = jnp.float32
    b, s, _ = h.shape
    proj = h @ w_in
    z, xbc, dt = jnp.split(proj, [D_INNER, D_INNER + CONV_DIM], axis=-1)
    xbc = jax.nn.silu(causal_depthwise_conv(xbc, conv_w, conv_b))
    xs, bmat, cmat = jnp.split(xbc, [D_INNER, D_INNER + SSD_GN], axis=-1)
    xs = xs.reshape(b, s, SSD_HEADS, SSD_HEAD_DIM)
    dt = jax.nn.softplus(dt.astype(f32) + dt_bias.astype(f32))
    a = -jnp.exp(a_log.astype(f32))
    y = ssd_scan(xs, dt, a,
                 bmat.reshape(b, s, SSD_GROUPS, SSD_STATE),
                 cmat.reshape(b, s, SSD_GROUPS, SSD_STATE))
    y = y + d_skip.astype(f32)[:, None] * xs.astype(f32)
    gated = y.reshape(b, s, D_INNER) * jax.nn.silu(z.astype(f32))
    gated = gated.reshape(b, s, SSD_GROUPS, D_INNER // SSD_GROUPS)
    gated = gated * lax.rsqrt(jnp.mean(gated * gated, axis=-1, keepdims=True) + SUBLN_EPS)
    y = (gated.reshape(b, s, D_INNER) * gnorm_w.astype(f32)).astype(h.dtype)
    return y @ w_out


def setup_inputs(seed: int = 0) -> dict:
    key = jax.random.key(seed)
    ks = iter(jax.random.split(key, 32))

    def nrm(shape, scale):
        return jax.random.normal(next(ks), shape, jnp.float32) * scale

    def gain(shape):
        return 1.0 + nrm(shape, 0.02)

    na, ns = N_ATTN_LAYERS, N_SSD_LAYERS
    x = nrm((BATCH, SEQ, D_MODEL), 1.0)
    attn_norm = gain((na, D_MODEL))
    attn_w_in = nrm((na, D_MODEL, ATTN_IN_WIDTH), D_MODEL ** -0.5)
    diff_lq1 = nrm((na, HEAD_DIM), 0.1)
    diff_lk1 = nrm((na, HEAD_DIM), 0.1)
    diff_lq2 = nrm((na, HEAD_DIM), 0.1)
    diff_lk2 = nrm((na, HEAD_DIM), 0.1)
    diff_subln = gain((na, DIFF_V))
    attn_w_out = nrm((na, MIX_WIDTH, D_MODEL), MIX_WIDTH ** -0.5)
    ssd_norm = gain((ns, D_MODEL))
    ssd_w_in = nrm((ns, D_MODEL, SSD_IN_WIDTH), D_MODEL ** -0.5)
    ssd_conv_w = nrm((ns, SSD_CONV, CONV_DIM), SSD_CONV ** -0.5)
    ssd_conv_b = nrm((ns, CONV_DIM), 0.02)
    u = jax.random.uniform(next(ks), (ns, SSD_HEADS), jnp.float32)
    dt0 = jnp.exp(u * (math.log(0.1) - math.log(0.001)) + math.log(0.001))
    ssd_dt_bias = dt0 + jnp.log(-jnp.expm1(-dt0))
    ssd_a_log = jnp.log(jax.random.uniform(next(ks), (ns, SSD_HEADS), jnp.float32, 1.0, 16.0))
    ssd_d = gain((ns, SSD_HEADS))
    ssd_gnorm = gain((ns, D_INNER))
    ssd_w_out = nrm((ns, D_INNER, D_MODEL), D_INNER ** -0.5)
    ffn_norm = gain((DEPTH, D_MODEL))
    ffn_w_gate = nrm((DEPTH, D_MODEL, D_FF), D_MODEL ** -0.5)
    ffn_w_up = nrm((DEPTH, D_MODEL, D_FF), D_MODEL ** -0.5)
    ffn_w_down = nrm((DEPTH, D_FF, D_MODEL), D_FF ** -0.5)
    final_norm = gain((D_MODEL,))
    return {
        "x": x,
        "attn_norm": attn_norm, "attn_w_in": attn_w_in,
        "diff_lq1": diff_lq1, "diff_lk1": diff_lk1, "diff_lq2": diff_lq2, "diff_lk2": diff_lk2,
        "diff_subln": diff_subln, "attn_w_out": attn_w_out,
        "ssd_norm": ssd_norm, "ssd_w_in": ssd_w_in, "ssd_conv_w": ssd_conv_w, "ssd_conv_b": ssd_conv_b,
        "ssd_dt_bias": ssd_dt_bias, "ssd_a_log": ssd_a_log, "ssd_d": ssd_d, "ssd_gnorm": ssd_gnorm,
        "ssd_w_out": ssd_w_out,
        "ffn_norm": ffn_norm, "ffn_w_gate": ffn_w_gate, "ffn_w_up": ffn_w_up, "ffn_w_down": ffn_w_down,
        "final_norm": final_norm,
    }


def reference(x, attn_norm, attn_w_in, diff_lq1, diff_lk1, diff_lq2, diff_lk2, diff_subln, attn_w_out,
              ssd_norm, ssd_w_in, ssd_conv_w, ssd_conv_b, ssd_dt_bias, ssd_a_log, ssd_d, ssd_gnorm,
              ssd_w_out, ffn_norm, ffn_w_gate, ffn_w_up, ffn_w_down, final_norm):
    h = x
    for layer in range(DEPTH):
        i = layer // 2
        if layer % 2 == 0:
            lambda_init = 0.8 - 0.6 * math.exp(-0.3 * layer)
            h = h + attn_mixer(rmsnorm(h, attn_norm[i]), attn_w_in[i],
                               diff_lq1[i], diff_lk1[i], diff_lq2[i], diff_lk2[i],
                               diff_subln[i], attn_w_out[i], lambda_init)
        else:
            h = h + ssd_mixer(rmsnorm(h, ssd_norm[i]), ssd_w_in[i], ssd_conv_w[i], ssd_conv_b[i],
                              ssd_dt_bias[i], ssd_a_log[i], ssd_d[i], ssd_gnorm[i], ssd_w_out[i])
        h = h + swiglu(rmsnorm(h, ffn_norm[layer]), ffn_w_gate[layer], ffn_w_up[layer], ffn_w_down[layer])
    return rmsnorm(h, final_norm)
```

```cpp
#include <hip/hip_runtime.h>
#include <hip/hip_cooperative_groups.h>
#include <cstdio>
#include <cstdint>
namespace cg = cooperative_groups;
namespace pg8 {
#define PG8_LAS __attribute__((address_space(3)))
typedef unsigned short bf16_t;
typedef short bf16x8 __attribute__((ext_vector_type(8)));
typedef float f32x4 __attribute__((ext_vector_type(4)));
typedef unsigned u32x4 __attribute__((ext_vector_type(4)));
constexpr int BM = 256, BK = 64, HALF = 128, HTB = HALF * BK * 2  , STAGE_BYTES = 8 * HTB, NXCD = 8, WGM = 8;

__host__ __device__ __forceinline__ int lds_byte(int r, int c) { const int st = (r >> 4) * 2 + (c >> 5), rr = r & 15, cc = c & 31, ob = rr * 64 + cc * 2; return st * 1024 + (ob ^ (((ob >> 9) & 1) << 5)); }
__host__ __device__ __forceinline__ void stage_rc(int b, int& R, int& C) { const int st = b / 1024, sb = b % 1024, swz = sb ^ (((sb >> 9) & 1) << 5); R = (st >> 1) * 16 + swz / 64; C = (st & 1) * 32 + (swz % 64) / 2; }
__host__ __device__ __forceinline__ int perm32(int rho) { const int n = rho >> 4, i = rho & 15; return 8 * (i >> 2) + 4 * n + (i & 3); }

struct Unit { int pm, pn; };
struct Gemm { const bf16_t* A; const bf16_t* Bt; int M, N, K; };

struct StaticOrder {
    int nM, nN, nwg, G, c;
    __host__ __device__ void init(int M, int N, int G_, int c_) { nM = M / BM; nN = N / BM; nwg = nM * nN; G = G_; c = c_; }
    __host__ __device__ bool next(int i, Unit& u) const {
        const long L = (long)i * G + c; if (L >= nwg) return false;
        int wgid = (int)L; { const int q = nwg / NXCD, r = nwg % NXCD, xcd = wgid % NXCD, off = wgid / NXCD; wgid = (xcd < r ? xcd * (q + 1) : r * (q + 1) + (xcd - r) * q) + off; }
        const int nig = WGM * nN, gid = wgid / nig, fm = gid * WGM, gsz = (nM - fm) < WGM ? (nM - fm) : WGM;
        u.pm = fm + ((wgid % nig) % gsz); u.pn = (wgid % nig) / gsz; return true;
    }
    __device__ __forceinline__ void a_ready(const Unit&) const {}
    __device__ __forceinline__ void done(const Unit&) const {}
};

template <class Epi, class Sched, bool STAMP = false>
__device__ __forceinline__ void gemm_phase(PG8_LAS unsigned char* lds, const Gemm g, const Sched& S, const Epi& E, unsigned long long* stamps) {
    const int tid = threadIdx.x, wid = __builtin_amdgcn_readfirstlane(tid >> 6), lane = tid & 63, wr = wid >> 2, wc = wid & 3, fr = lane & 15, fq = lane >> 4;
    const int K = g.K, nt = K / BK;
    int ts_lo = 0, ts_hi = 0, nts = 0; const unsigned long long rt_entry = STAMP ? (unsigned long long)wall_clock64() : 0ull;
#define PG8_STAMP() do { if (STAMP && wid == 0 && nts < 64) { const unsigned long long _c = (unsigned long long)clock64(); \
        ts_lo = (lane == nts) ? (int)(unsigned)_c : ts_lo; ts_hi = (lane == nts) ? (int)(unsigned)(_c >> 32) : ts_hi; ++nts; } } while (0)
    PG8_STAMP();
    unsigned voffA[2], voffB[2];
#pragma unroll
    for (int i = 0; i < 2; ++i) { int R, C; stage_rc(tid * 16 + i * 8192, R, C); const int Rb = Epi::PERM ? ((R & ~31) + perm32(R & 31)) : R;
        voffA[i] = (unsigned)(R * K + C) * 2u; voffB[i] = (unsigned)(Rb * K + C) * 2u; }
    const size_t kstep = (size_t)(BK * 2);
    const size_t hstep = (size_t)HALF * K * 2;
    const size_t tstep = 2 * hstep;
    const unsigned ldsw = (unsigned)wid * 1024u;
    const int aoff = lds_byte(wr * 64 + fr, fq * 8), boff = lds_byte(wc * 32 + fr, fq * 8);
#define PG8_SA(b, h) (((b) * 2 + (h)) * HTB)
#define PG8_SB(b, h) ((4 + (b) * 2 + (h)) * HTB)
#define PG8_STAGE(bufoff, gbase, voff) do { _Pragma("unroll") for (int _i = 0; _i < 2; ++_i) \
        __builtin_amdgcn_global_load_lds((const unsigned*)((const char*)(gbase) + (voff)[_i]), (PG8_LAS unsigned*)(lds + (bufoff) + ldsw + _i * 8192), 16, 0, 0); } while (0)
#define PG8_LDA(dst, b, h) do { _Pragma("unroll") for (int m = 0; m < 4; ++m) _Pragma("unroll") for (int k = 0; k < 2; ++k) dst[m][k] = *(const PG8_LAS bf16x8*)(lds + PG8_SA(b, h) + aoff + m * 2048 + k * 1024); } while (0)
#define PG8_LDB(dst, b, h) do { _Pragma("unroll") for (int n = 0; n < 2; ++n) _Pragma("unroll") for (int k = 0; k < 2; ++k) dst[n][k] = *(const PG8_LAS bf16x8*)(lds + PG8_SB(b, h) + boff + n * 2048 + k * 1024); } while (0)
#define PG8_MMA(ai, bj, At, Bt) do { __builtin_amdgcn_s_setprio(1); _Pragma("unroll") for (int m = 0; m < 4; ++m) _Pragma("unroll") for (int n = 0; n < 2; ++n) _Pragma("unroll") for (int k = 0; k < 2; ++k) \
        acc[ai][bj][m][n] = __builtin_amdgcn_mfma_f32_16x16x32_bf16(Bt[n][k], At[m][k], acc[ai][bj][m][n], 0, 0, 0); __builtin_amdgcn_s_setprio(0); } while (0)
#define PG8_WAIT_V(n) asm volatile("s_waitcnt vmcnt(" #n ")" ::: "memory")
#define PG8_WAIT_L(n) asm volatile("s_waitcnt lgkmcnt(" #n ")" ::: "memory")
#define PG8_BAR __builtin_amdgcn_s_barrier()
#define PG8_SCHED __builtin_amdgcn_sched_barrier(0)
    Unit cur, nxt; int ui = 0;
    if (!S.next(0, cur)) return;
    f32x4 acc[2][2][4][2];
#pragma unroll
    for (int a = 0; a < 2; ++a)
#pragma unroll
        for (int b = 0; b < 2; ++b)
#pragma unroll
            for (int m = 0; m < 4; ++m)
#pragma unroll
                for (int n = 0; n < 2; ++n) acc[a][b][m][n] = (f32x4){0.f, 0.f, 0.f, 0.f};
    bf16x8 At[4][2], B0[2][2], B1[2][2];
    const char* cA = (const char*)g.A + (size_t)cur.pm * tstep; const char* cB = (const char*)g.Bt + (size_t)cur.pn * tstep;
    S.a_ready(cur);
    PG8_STAGE(PG8_SB(0, 0), cB, voffB); PG8_STAGE(PG8_SA(0, 0), cA, voffA); PG8_STAGE(PG8_SB(0, 1), cB + hstep, voffB); PG8_STAGE(PG8_SA(0, 1), cA + hstep, voffA);
    if (wr == 1) PG8_BAR;
    PG8_WAIT_V(4); PG8_BAR;
    PG8_STAGE(PG8_SB(1, 0), cB + kstep, voffB); PG8_STAGE(PG8_SA(1, 0), cA + kstep, voffA); PG8_STAGE(PG8_SB(1, 1), cB + hstep + kstep, voffB);
    PG8_WAIT_V(6); PG8_BAR;
    PG8_STAMP();
    for (;;) {
        const bool has_next = S.next(ui + 1, nxt);
        const char* nA = has_next ? (const char*)g.A + (size_t)nxt.pm * tstep : cA; const char* nB = has_next ? (const char*)g.Bt + (size_t)nxt.pn * tstep : cB;
        for (int t = 0; t < nt; t += 2) {
            const bool last = (t == nt - 2);
            const char* a1 = cA + (size_t)(t + 1) * kstep;
            const char* a2 = last ? nA : cA + (size_t)(t + 2) * kstep; const char* b2 = last ? nB : cB + (size_t)(t + 2) * kstep;
            const char* a3 = a2 + kstep; const char* b3 = b2 + kstep;
            if (last && has_next) S.a_ready(nxt);
            PG8_LDB(B0, 0, 0); PG8_SCHED; PG8_LDA(At, 0, 0); PG8_STAGE(PG8_SA(1, 1), a1 + hstep, voffA);
            PG8_WAIT_L(8); PG8_BAR; PG8_WAIT_L(0); PG8_MMA(0, 0, At, B0); PG8_BAR; PG8_SCHED;
            PG8_LDB(B1, 0, 1); PG8_STAGE(PG8_SB(0, 0), b2, voffB);
            PG8_BAR; PG8_WAIT_L(0); PG8_MMA(0, 1, At, B1); PG8_BAR;
            PG8_LDA(At, 0, 1); PG8_STAGE(PG8_SA(0, 0), a2, voffA);
            PG8_BAR; PG8_WAIT_L(0); PG8_MMA(1, 0, At, B0); PG8_BAR; PG8_SCHED;
            PG8_STAGE(PG8_SB(0, 1), b2 + hstep, voffB);
            PG8_WAIT_V(6); PG8_BAR; PG8_MMA(1, 1, At, B1); PG8_BAR;
            PG8_LDB(B0, 1, 0); PG8_SCHED; PG8_LDA(At, 1, 0); PG8_STAGE(PG8_SA(0, 1), a2 + hstep, voffA);
            PG8_WAIT_L(8); PG8_BAR; PG8_WAIT_L(0); PG8_MMA(0, 0, At, B0); PG8_BAR; PG8_SCHED;
            PG8_LDB(B1, 1, 1); PG8_STAGE(PG8_SB(1, 0), b3, voffB);
            PG8_BAR; PG8_WAIT_L(0); PG8_MMA(0, 1, At, B1); PG8_BAR;
            PG8_LDA(At, 1, 1); PG8_STAGE(PG8_SA(1, 0), a3, voffA);
            PG8_BAR; PG8_WAIT_L(0); PG8_MMA(1, 0, At, B0); PG8_BAR; PG8_SCHED;
            PG8_STAGE(PG8_SB(1, 1), b3 + hstep, voffB);
            PG8_WAIT_V(6); PG8_BAR; PG8_MMA(1, 1, At, B1); PG8_BAR;
        }
        PG8_STAMP();
        if constexpr (!Epi::AFTER_DRAIN) { E(acc, cur, wr, wc, fr, fq); S.done(cur); }
        PG8_STAMP();
        if (!has_next) break;
#pragma unroll
        for (int a = 0; a < 2; ++a)
#pragma unroll
            for (int b = 0; b < 2; ++b)
#pragma unroll
                for (int m = 0; m < 4; ++m)
#pragma unroll
                    for (int n = 0; n < 2; ++n) acc[a][b][m][n] = (f32x4){0.f, 0.f, 0.f, 0.f};
        cur = nxt; cA = nA; cB = nB; ++ui;
    }
    PG8_WAIT_V(0);
    if (wr == 0) PG8_BAR;
    PG8_BAR;
    if constexpr (Epi::AFTER_DRAIN) { E.fused(acc, cur, wr, wc, fr, fq, lds, wid, lane); S.done(cur); }
    PG8_STAMP();
    if (STAMP && wid == 0) { stamps[lane] = lane < nts ? (((unsigned long long)(unsigned)ts_hi << 32) | (unsigned)ts_lo) : 0ull;
        if (lane == 62) stamps[62] = rt_entry; if (lane == 63) stamps[63] = (unsigned long long)wall_clock64(); }
#undef PG8_STAMP
#undef PG8_SA
#undef PG8_SB
#undef PG8_STAGE
#undef PG8_LDA
#undef PG8_LDB
#undef PG8_MMA
#undef PG8_WAIT_V
#undef PG8_WAIT_L
#undef PG8_BAR
#undef PG8_SCHED
}
}
using pg8::bf16_t; using pg8::bf16x8; using pg8::f32x4;
typedef short s16x4 __attribute__((ext_vector_type(4)));
typedef float f32x16 __attribute__((ext_vector_type(16)));
typedef float f32x2 __attribute__((ext_vector_type(2)));
typedef __bf16 bf2_t __attribute__((ext_vector_type(2)));
typedef unsigned u32x2 __attribute__((ext_vector_type(2)));
typedef unsigned u32x4 __attribute__((ext_vector_type(4)));
#define LAS __attribute__((address_space(3)))
#define DI __device__ __forceinline__
#define MFMA32(a, b, c) __builtin_amdgcn_mfma_f32_32x32x16_bf16((a), (b), (c), 0, 0, 0)

DI unsigned pk2(float a, float b) { f32x2 v = {a, b}; bf2_t r = __builtin_convertvector(v, bf2_t); return __builtin_bit_cast(unsigned, r); }
DI float bflo(unsigned u) { return __uint_as_float(u << 16); }
DI float bfhi(unsigned u) { return __uint_as_float(u & 0xffff0000u); }
DI float fexp2(float x) { return __builtin_amdgcn_exp2f(x); }
DI float frcp(float x) { return __builtin_amdgcn_rcpf(x); }
DI float fsilu(float x) { return x * frcp(1.0f + fexp2(-1.44269504089f * x)); }
DI int crow(int i, int h) { return (i & 3) + 8 * (i >> 2) + 4 * h; }
DI s16x4 trr(const LAS unsigned char* p) { return __builtin_amdgcn_ds_read_tr16_b64_v4i16((LAS s16x4*)p); }
DI bf16x8 tr2(const LAS unsigned char* p0, const LAS unsigned char* p1) { s16x4 a = trr(p0), b = trr(p1); return __builtin_shufflevector(a, b, 0, 1, 2, 3, 4, 5, 6, 7); }
DI bf16x8 pack8(const f32x16& x, int s) {
    u32x4 p; p[0] = pk2(x[8 * s], x[8 * s + 1]); p[1] = pk2(x[8 * s + 2], x[8 * s + 3]); p[2] = pk2(x[8 * s + 4], x[8 * s + 5]); p[3] = pk2(x[8 * s + 6], x[8 * s + 7]);
    return __builtin_bit_cast(bf16x8, p);
}
DI f32x16 zero16() { f32x16 z; for (int i = 0; i < 16; ++i) z[i] = 0.f; return z; }

constexpr int MT = 16384, SEQ = 8192, DM = 1024, DFF = 2816, AINW = 3072, SINW = 6176, SINWP = 6400, DIN = 2048, XBCW = 4096;
constexpr float LOG2E = 1.44269504089f;
constexpr int LDS_BYTES = 147456;
constexpr size_t W_AIN = 0, W_AOUT = W_AIN + (size_t)AINW * DM * 2, W_GU0 = W_AOUT + (size_t)DM * DM * 2, W_DN0 = W_GU0 + (size_t)2 * DFF * DM * 2,
                 W_SIN = W_DN0 + (size_t)DM * DFF * 2, W_SOUT = W_SIN + (size_t)SINWP * DM * 2, W_GU1 = W_SOUT + (size_t)DM * DIN * 2, W_DN1 = W_GU1 + (size_t)2 * DFF * DM * 2,
                 O_HB = W_DN1 + (size_t)DM * DFF * 2, O_SS = O_HB + (size_t)MT * DM * 2, O_ROPE = O_SS + (size_t)5 * MT * 4, O_DT = O_ROPE + (size_t)SEQ * 32 * 8,
                 O_CDEC = O_DT + (size_t)MT * 32 * 4, O_LAM = O_CDEC + 16384, O_R = 98566144;
static_assert(O_LAM + 256 <= O_R, "map");
constexpr size_t O_PROJ = O_R, O_MIXED = O_PROJ + (size_t)MT * AINW * 2, O_ACT = O_R, O_XBC = O_R, O_ST1 = O_XBC + (size_t)MT * XBCW * 2, O_ST0 = 0;
constexpr size_t ST_BATCH = (size_t)64 * 32 * 64 * 128;
static_assert(O_ST1 + ST_BATCH * 2 <= 268435456ull, "ws");
static_assert(ST_BATCH * 2 <= W_SOUT, "st0 overlay");
static_assert(O_MIXED + (size_t)MT * DM * 2 <= 268435456ull, "ws2");

struct Params { const float* in[23]; float* out; unsigned char* ws; };
DI void wmap(int mode, int c, int& src, float& scale, int& which) {
    src = c; scale = 1.f; which = 0;
    if (mode == 0) {
        if (c < 1024) { const int base = c & ~63, cc = c & 63, g = cc >> 3, e = cc & 7; src = base + (e < 4 ? 4 * g + e : 32 + 4 * g + (e - 4)); }
        if (c < 512) scale = 0.125f * LOG2E; else if (c >= 1536 && c < 2048) scale = 0.125f;
    } else if (mode == 2) { src = 4 * (c >> 3) + (c & 3); which = (c >> 2) & 1; }
    else if (mode == 3) { if (c >= SINW) src = -1; }
}
DI void wconv_tile(LAS float* tile, int mode, const float* W0, const float* W1, const float* kscale, bf16_t* dst, int K, int ldw, int tix) {
    const int tid = threadIdx.x, nk = K >> 6, c0 = (tix / nk) * 64, k0 = (tix % nk) * 64;
#pragma unroll
    for (int i = 0; i < 8; ++i) {
        const int idx = tid + 512 * i, kk = idx >> 6, cc = idx & 63; int src, which; float sc; wmap(mode, c0 + cc, src, sc, which);
        float v = 0.f;
        if (src >= 0) { const float* W = which ? W1 : W0; v = W[(size_t)(k0 + kk) * ldw + src] * sc; if (kscale) v *= kscale[k0 + kk]; }
        tile[kk * 65 + cc] = v;
    }
    __syncthreads();
#pragma unroll
    for (int i = 0; i < 4; ++i) {
        const int idx = tid + 512 * i, cc = idx >> 5, k2 = (idx & 31) * 2;
        *(unsigned*)(dst + (size_t)(c0 + cc) * K + k0 + k2) = pk2(tile[k2 * 65 + cc], tile[(k2 + 1) * 65 + cc]);
    }
    __syncthreads();
}
DI void phase0(LAS unsigned char* lds, const Params& p) {
    const int tid = threadIdx.x, G = gridDim.x, bx = blockIdx.x;
    unsigned char* ws = p.ws;
    const int cnt[8] = {48 * 16, 16 * 16, 88 * 16, 16 * 44, 100 * 16, 16 * 32, 88 * 16, 16 * 44};
    int total = 0;
#pragma unroll
    for (int j = 0; j < 8; ++j) total += cnt[j];
    for (int t = bx; t < total; t += G) {
        int j = 0, tt = t;
#pragma unroll
        for (int q = 0; q < 7; ++q) if (j == q && tt >= cnt[q]) { tt -= cnt[q]; j = q + 1; }
        LAS float* tile = (LAS float*)lds;
        switch (j) {
        case 0: wconv_tile(tile, 0, p.in[2], nullptr, p.in[1], (bf16_t*)(ws + W_AIN), DM, AINW, tt); break;
        case 1: wconv_tile(tile, 1, p.in[8], nullptr, nullptr, (bf16_t*)(ws + W_AOUT), DM, DM, tt); break;
        case 2: wconv_tile(tile, 2, p.in[19], p.in[20], p.in[18], (bf16_t*)(ws + W_GU0), DM, DFF, tt); break;
        case 3: wconv_tile(tile, 1, p.in[21], nullptr, nullptr, (bf16_t*)(ws + W_DN0), DFF, DM, tt); break;
        case 4: wconv_tile(tile, 3, p.in[10], nullptr, p.in[9], (bf16_t*)(ws + W_SIN), DM, SINW, tt); break;
        case 5: wconv_tile(tile, 1, p.in[17], nullptr, nullptr, (bf16_t*)(ws + W_SOUT), DIN, DM, tt); break;
        case 6: wconv_tile(tile, 2, p.in[19] + (size_t)DM * DFF, p.in[20] + (size_t)DM * DFF, p.in[18] + DM, (bf16_t*)(ws + W_GU1), DM, DFF, tt); break;
        default: wconv_tile(tile, 1, p.in[21] + (size_t)DFF * DM, nullptr, nullptr, (bf16_t*)(ws + W_DN1), DFF, DM, tt); break;
        }
    }
    {
        const int wave = tid >> 6, lane = tid & 63; bf16_t* hb = (bf16_t*)(ws + O_HB); float* ss = (float*)(ws + O_SS);
        for (int row = bx * 8 + wave; row < MT; row += G * 8) {
            const float* xr = p.in[0] + (size_t)row * DM; float sq = 0.f;
#pragma unroll
            for (int i = 0; i < 4; ++i) { const f32x4 v = *(const f32x4*)(xr + lane * 4 + 256 * i); sq += v[0] * v[0] + v[1] * v[1] + v[2] * v[2] + v[3] * v[3];
                u32x2 o; o[0] = pk2(v[0], v[1]); o[1] = pk2(v[2], v[3]); *(u32x2*)(hb + (size_t)row * DM + lane * 4 + 256 * i) = o; }
#pragma unroll
            for (int o = 32; o >= 1; o >>= 1) sq += __shfl_xor(sq, o);
            if (lane == 0) ss[row] = sq;
        }
        for (int i = bx * 512 + tid; i < 4 * MT; i += G * 512) ss[MT + i] = 0.f;
        f32x2* tab = (f32x2*)(ws + O_ROPE);
        for (int i = bx * 512 + tid; i < SEQ * 32; i += G * 512) {
            const int pos = i >> 5, f = i & 31; const float inv = fexp2(-(float)f * 0.41524101186092f); const float ang = (float)pos * inv;
            double t = (double)ang * 0.15915494309189535; t -= floor(t); const float tf = (float)t;
            f32x2 cs; cs[0] = __builtin_amdgcn_cosf(tf); cs[1] = __builtin_amdgcn_sinf(tf); tab[i] = cs;
        }
        if (bx == 0 && tid == 0) { float s1 = 0.f, s2 = 0.f; for (int i = 0; i < 64; ++i) { s1 += p.in[3][i] * p.in[4][i]; s2 += p.in[5][i] * p.in[6][i]; }
            *(float*)(ws + O_LAM) = fexp2(s1 * LOG2E) - fexp2(s2 * LOG2E) + 0.2f; }
    }
}

struct EpiAttnIn {
    static constexpr bool PERM = true, AFTER_DRAIN = false;
    bf16_t* O; const float* ss; const f32x4* tab;
    DI void operator()(const f32x4 (&acc)[2][2][4][2], const pg8::Unit& u, int wr, int wc, int fr, int fq) const {
        const int row0 = u.pm * 256 + wr * 64 + fr, colt = u.pn * 256, col0 = colt + wc * 32 + 8 * fq;
        const int fb = 4 * (4 * (wc & 1) + fq);
#pragma unroll
        for (int ai = 0; ai < 2; ++ai)
#pragma unroll
            for (int m = 0; m < 4; ++m) {
                const int row = row0 + ai * 128 + m * 16; const float rs = __builtin_amdgcn_rsqf(ss[row] * (1.0f / 1024.0f) + 1e-6f);
                f32x4 c01 = {1.f, 0.f, 1.f, 0.f}, c23 = {1.f, 0.f, 1.f, 0.f};
                if (colt < 1024) { const int pos = row & (SEQ - 1); c01 = tab[(pos * 32 + fb) >> 1]; c23 = tab[((pos * 32 + fb) >> 1) + 1]; }
#pragma unroll
                for (int bj = 0; bj < 2; ++bj) {
                    f32x4 v0 = acc[ai][bj][m][0] * rs, v1 = acc[ai][bj][m][1] * rs;
                    if (colt < 1024) {
                        const float cs[4] = {c01[0], c01[2], c23[0], c23[2]}, sn[4] = {c01[1], c01[3], c23[1], c23[3]};
#pragma unroll
                        for (int j = 0; j < 4; ++j) { const float t1 = v0[j], t2 = v1[j]; v0[j] = t1 * cs[j] - t2 * sn[j]; v1[j] = t2 * cs[j] + t1 * sn[j]; }
                    }
                    u32x4 o; o[0] = pk2(v0[0], v0[1]); o[1] = pk2(v0[2], v0[3]); o[2] = pk2(v1[0], v1[1]); o[3] = pk2(v1[2], v1[3]);
                    *(u32x4*)(O + (size_t)row * AINW + col0 + bj * 128) = o;
                }
            }
    }
};
template <bool RES_F32, bool OUT_F32> struct EpiRes {
    static constexpr bool PERM = false, AFTER_DRAIN = false;
    const float* xres; bf16_t* hb; float* outf; float* ssn;
    DI void operator()(const f32x4 (&acc)[2][2][4][2], const pg8::Unit& u, int wr, int wc, int fr, int fq) const {
        const int row0 = u.pm * 256 + wr * 64 + fr, col0 = u.pn * 256 + wc * 32 + 4 * fq;
#pragma unroll
        for (int ai = 0; ai < 2; ++ai)
#pragma unroll
            for (int m = 0; m < 4; ++m) {
                const int row = row0 + ai * 128 + m * 16; float sq = 0.f;
#pragma unroll
                for (int bj = 0; bj < 2; ++bj)
#pragma unroll
                    for (int n = 0; n < 2; ++n) {
                        const size_t off = (size_t)row * DM + col0 + bj * 128 + n * 16; f32x4 r;
                        if (RES_F32) r = *(const f32x4*)(xres + off);
                        else { const u32x2 t = *(const u32x2*)(hb + off); r[0] = bflo(t[0]); r[1] = bfhi(t[0]); r[2] = bflo(t[1]); r[3] = bfhi(t[1]); }
                        const f32x4 v = r + acc[ai][bj][m][n];
                        sq += v[0] * v[0] + v[1] * v[1] + v[2] * v[2] + v[3] * v[3];
                        if (OUT_F32) *(f32x4*)(outf + off) = v;
                        else { u32x2 o; o[0] = pk2(v[0], v[1]); o[1] = pk2(v[2], v[3]); *(u32x2*)(hb + off) = o; }
                    }
                sq += __shfl_xor(sq, 16); sq += __shfl_xor(sq, 32);
                if (fq == 0) atomicAdd(ssn + row, sq);
            }
    }
};
struct EpiGU {
    static constexpr bool PERM = true, AFTER_DRAIN = false;
    bf16_t* act; const float* ss;
    DI void operator()(const f32x4 (&acc)[2][2][4][2], const pg8::Unit& u, int wr, int wc, int fr, int fq) const {
        const int row0 = u.pm * 256 + wr * 64 + fr, col0 = u.pn * 256 + wc * 32 + 8 * fq;
#pragma unroll
        for (int ai = 0; ai < 2; ++ai)
#pragma unroll
            for (int m = 0; m < 4; ++m) {
                const int row = row0 + ai * 128 + m * 16; const float rs = __builtin_amdgcn_rsqf(ss[row] * (1.0f / 1024.0f) + 1e-6f);
#pragma unroll
                for (int bj = 0; bj < 2; ++bj) {
                    const f32x4 g = acc[ai][bj][m][0] * rs, up = acc[ai][bj][m][1] * rs; float a[4];
#pragma unroll
                    for (int j = 0; j < 4; ++j) a[j] = fsilu(g[j]) * up[j];
                    u32x2 o; o[0] = pk2(a[0], a[1]); o[1] = pk2(a[2], a[3]);
                    *(u32x2*)(act + (size_t)row * DFF + ((col0 + bj * 128) >> 1)) = o;
                }
            }
    }
};
struct EpiSsdIn {
    static constexpr bool PERM = true, AFTER_DRAIN = false;
    bf16_t* z; bf16_t* xbc; float* dt; const float* ss;
    DI void operator()(const f32x4 (&acc)[2][2][4][2], const pg8::Unit& u, int wr, int wc, int fr, int fq) const {
        const int row0 = u.pm * 256 + wr * 64 + fr, col0 = u.pn * 256 + wc * 32 + 8 * fq;
#pragma unroll
        for (int ai = 0; ai < 2; ++ai)
#pragma unroll
            for (int m = 0; m < 4; ++m) {
                const int row = row0 + ai * 128 + m * 16; const float rs = __builtin_amdgcn_rsqf(ss[row] * (1.0f / 1024.0f) + 1e-6f);
#pragma unroll
                for (int bj = 0; bj < 2; ++bj) {
                    const int c = col0 + bj * 128; const f32x4 v0 = acc[ai][bj][m][0] * rs, v1 = acc[ai][bj][m][1] * rs;
                    if (c < 6144) { u32x4 o; o[0] = pk2(v0[0], v0[1]); o[1] = pk2(v0[2], v0[3]); o[2] = pk2(v1[0], v1[1]); o[3] = pk2(v1[2], v1[3]);
                        if (c < DIN) *(u32x4*)(z + (size_t)row * DIN + c) = o; else *(u32x4*)(xbc + (size_t)row * XBCW + (c - DIN)) = o; }
                    else if (c < SINW) { *(f32x4*)(dt + (size_t)row * 32 + (c - 6144)) = v0; *(f32x4*)(dt + (size_t)row * 32 + (c - 6144) + 4) = v1; }
                }
            }
    }
};
constexpr int KST = 144, VST = 272, VST64 = 144;
constexpr int AT_K1 = 0, AT_K2 = 64 * KST, AT_V = 2 * 64 * KST, AT_STAGE = AT_V + 64 * VST;

DI void diff_tile(LAS unsigned char* lds, const bf16_t* proj, bf16_t* mixed, const float* subln, float lam, int b, int hd, int qt) {
    const int tid = threadIdx.x, w = __builtin_amdgcn_readfirstlane(tid >> 6), lane = tid & 63, qg = w & 3, mp = w >> 2, r = lane & 31, h = lane >> 5;
    const int q0 = qt * 128; const size_t rowb = (size_t)b * SEQ;
    bf16x8 qf[4];
    { const bf16_t* qp = proj + (rowb + q0 + 32 * qg + r) * AINW + hd * 128 + mp * 64 + 8 * h;
#pragma unroll
      for (int s = 0; s < 4; ++s) qf[s] = *(const bf16x8*)(qp + 16 * s); }
    f32x16 O[4];
#pragma unroll
    for (int i = 0; i < 4; ++i) O[i] = zero16();
    float mrun = -1e30f, lrun = 0.f;
    const int nsteps = 2 * (qt + 1);
    const bf16_t* src[4]; int dst[4];
#pragma unroll
    for (int i = 0; i < 2; ++i) { const int cid = tid + 512 * i, row = cid >> 4, c16 = cid & 15;
        src[i] = proj + (rowb + row) * AINW + 512 + hd * 128 + c16 * 8; dst[i] = (c16 < 8 ? AT_K1 : AT_K2) + row * KST + (c16 & 7) * 16;
        src[2 + i] = proj + (rowb + row) * AINW + 1024 + hd * 128 + c16 * 8; dst[2 + i] = AT_V + row * VST + c16 * 16; }
    u32x4 pf[4];
#pragma unroll
    for (int i = 0; i < 4; ++i) pf[i] = *(const u32x4*)(src[i]);
#pragma unroll
    for (int i = 0; i < 4; ++i) *(LAS u32x4*)(lds + dst[i]) = pf[i];
    __syncthreads();
    const int i16 = lane & 15, tq = i16 >> 2, tp = i16 & 3, g16 = (lane >> 4) & 1;
    const int troff = (4 * h + tq) * VST + (16 * g16 + 4 * tp) * 2;
    for (int j = 0; j < nsteps; ++j) {
        const bool more = (j + 1 < nsteps);
        if (more) {
#pragma unroll
            for (int i = 0; i < 4; ++i) pf[i] = *(const u32x4*)(src[i] + (size_t)(j + 1) * 64 * AINW);
        }
        const LAS unsigned char* base = lds + (j & 1) * AT_STAGE;
        const LAS unsigned char* Kb = base + (mp ? AT_K2 : AT_K1);
        const LAS unsigned char* Vb = base + AT_V;
        f32x16 S[2];
#pragma unroll
        for (int kt = 0; kt < 2; ++kt) { S[kt] = zero16();
#pragma unroll
            for (int s = 0; s < 4; ++s) { const bf16x8 kf = *(const LAS bf16x8*)(Kb + (32 * kt + r) * KST + (16 * s + 8 * h) * 2); S[kt] = MFMA32(kf, qf[s], S[kt]); } }
        const int qidx = q0 + 32 * qg + r, kbase = 64 * j;
        if (kbase + 63 > q0 + 32 * qg) {
#pragma unroll
            for (int kt = 0; kt < 2; ++kt)
#pragma unroll
                for (int i = 0; i < 16; ++i) if (kbase + 32 * kt + crow(i, h) > qidx) S[kt][i] = -1e30f;
        }
        float mx = S[0][0];
#pragma unroll
        for (int kt = 0; kt < 2; ++kt)
#pragma unroll
            for (int i = 0; i < 16; ++i) mx = fmaxf(mx, S[kt][i]);
        mx = fmaxf(mx, __shfl_xor(mx, 32));
        const float mnew = fmaxf(mrun, mx), alpha = fexp2(mrun - mnew); mrun = mnew;
        float ls = 0.f;
#pragma unroll
        for (int kt = 0; kt < 2; ++kt)
#pragma unroll
            for (int i = 0; i < 16; ++i) { const float pv = fexp2(S[kt][i] - mnew); S[kt][i] = pv; ls += pv; }
        lrun = lrun * alpha + ls;
#pragma unroll
        for (int vt = 0; vt < 4; ++vt) O[vt] = O[vt] * alpha;
#pragma unroll
        for (int kt = 0; kt < 2; ++kt)
#pragma unroll
            for (int s2 = 0; s2 < 2; ++s2) {
                const bf16x8 pfr = pack8(S[kt], s2);
                const LAS unsigned char* vrow = Vb + (32 * kt + 16 * s2) * VST + troff;
#pragma unroll
                for (int vt = 0; vt < 4; ++vt) { const bf16x8 vf = tr2(vrow + vt * 64, vrow + 8 * VST + vt * 64); O[vt] = MFMA32(vf, pfr, O[vt]); }
            }
        if (more) {
            LAS unsigned char* nb = lds + ((j + 1) & 1) * AT_STAGE;
#pragma unroll
            for (int i = 0; i < 4; ++i) *(LAS u32x4*)(nb + dst[i]) = pf[i];
        }
        __syncthreads();
    }
    lrun += __shfl_xor(lrun, 32);
    const float inv = frcp(lrun);
    LAS float* ex = (LAS float*)lds;
    if (mp == 1) {
        const float sc = inv * lam;
#pragma unroll
        for (int vt = 0; vt < 4; ++vt)
#pragma unroll
            for (int i = 0; i < 16; ++i) ex[(qg * 128 + 32 * vt + crow(i, h)) * 32 + r] = O[vt][i] * sc;
    }
    __syncthreads();
    if (mp == 0) {
        float sq = 0.f;
#pragma unroll
        for (int vt = 0; vt < 4; ++vt)
#pragma unroll
            for (int i = 0; i < 16; ++i) { const float o = O[vt][i] * inv - ex[(qg * 128 + 32 * vt + crow(i, h)) * 32 + r]; O[vt][i] = o; sq += o * o; }
        sq += __shfl_xor(sq, 32);
        const float rn = __builtin_amdgcn_rsqf(sq * (1.0f / 128.0f) + 1e-5f) * 0.8f;
        bf16_t* op = mixed + (rowb + q0 + 32 * qg + r) * DM + hd * 128;
#pragma unroll
        for (int vt = 0; vt < 4; ++vt)
#pragma unroll
            for (int gq = 0; gq < 4; ++gq) { const int v0 = 32 * vt + 8 * gq + 4 * h; const f32x4 wv = *(const f32x4*)(subln + v0);
                u32x2 o; o[0] = pk2(O[vt][4 * gq] * rn * wv[0], O[vt][4 * gq + 1] * rn * wv[1]); o[1] = pk2(O[vt][4 * gq + 2] * rn * wv[2], O[vt][4 * gq + 3] * rn * wv[3]);
                *(u32x2*)(op + v0) = o; }
    }
    __syncthreads();
}

constexpr int SB_K = 0, SB_V = 64 * KST, SB_STAGE = 2 * 64 * KST;
DI void sb_block(LAS unsigned char* lds, const bf16_t* proj, bf16_t* mixed, int b, int hs, int qb) {
    const int tid = threadIdx.x, w = __builtin_amdgcn_readfirstlane(tid >> 6), lane = tid & 63, r = lane & 31, h = lane >> 5;
    const int q0 = qb * 256; const size_t rowb = (size_t)b * SEQ;
    const int qidx = q0 + 32 * w + r;
    bf16x8 qf[4];
    { const bf16_t* qp = proj + (rowb + qidx) * AINW + 1536 + hs * 64 + 8 * h;
#pragma unroll
      for (int s = 0; s < 4; ++s) qf[s] = *(const bf16x8*)(qp + 16 * s); }
    f32x16 O[2]; O[0] = zero16(); O[1] = zero16();
    float carry = 1.0f;
    const int jmax = 4 * qb + 3;
    const int srow = tid >> 3, sc8 = tid & 7;
    const bf16_t* srcK = proj + (rowb + srow) * AINW + 2048 + hs * 64 + sc8 * 8;
    const bf16_t* srcV = proj + (rowb + srow) * AINW + 2560 + hs * 64 + sc8 * 8;
    const int dstK = SB_K + srow * KST + sc8 * 16, dstV = SB_V + srow * VST64 + sc8 * 16;
    u32x4 pk_ = *(const u32x4*)(srcK + (size_t)jmax * 64 * AINW), pv_ = *(const u32x4*)(srcV + (size_t)jmax * 64 * AINW);
    *(LAS u32x4*)(lds + dstK) = pk_; *(LAS u32x4*)(lds + dstV) = pv_;
    __syncthreads();
    const int i16 = lane & 15, tq = i16 >> 2, tp = i16 & 3, g16 = (lane >> 4) & 1;
    const int troff = (4 * h + tq) * VST64 + (16 * g16 + 4 * tp) * 2;
    int it = 0;
    for (int j = jmax; j >= 0; --j, ++it) {
        const bool more = (j > 0);
        if (more) { pk_ = *(const u32x4*)(srcK + (size_t)(j - 1) * 64 * AINW); pv_ = *(const u32x4*)(srcV + (size_t)(j - 1) * 64 * AINW); }
        const LAS unsigned char* base = lds + (it & 1) * SB_STAGE;
        const int kbase = 64 * j;
        if (kbase < q0 + 32 * w + 32) {
#pragma unroll
            for (int kt = 1; kt >= 0; --kt) {
                f32x16 S = zero16();
#pragma unroll
                for (int s = 0; s < 4; ++s) { const bf16x8 kf = *(const LAS bf16x8*)(base + SB_K + (32 * kt + r) * KST + (16 * s + 8 * h) * 2); S = MFMA32(kf, qf[s], S); }
                float T[4], sfx[16];
#pragma unroll
                for (int gq = 0; gq < 4; ++gq) {
                    float run = 1.0f;
#pragma unroll
                    for (int jj = 3; jj >= 0; --jj) {
                        const int i = 4 * gq + jj; const bool valid = (kbase + 32 * kt + crow(i, h)) < qidx;
                        const float zz = fmaxf(S[i], -60.0f); const float e = fexp2(-LOG2E * zz); const float sg = frcp(1.0f + e);
                        const float keep = valid ? e * sg : 1.0f;
                        S[i] = valid ? sg : 0.0f; sfx[i] = run; run *= keep;
                    }
                    T[gq] = run;
                }
                float To[4];
#pragma unroll
                for (int gq = 0; gq < 4; ++gq) To[gq] = __shfl_xor(T[gq], 32);
                float E[4]; float acc_hi = 1.0f;
#pragma unroll
                for (int gq = 3; gq >= 0; --gq) {
                    const float above_same = acc_hi;
                    E[gq] = (h == 0) ? above_same * To[gq] : above_same;
                    acc_hi = acc_hi * T[gq] * To[gq];
                }
#pragma unroll
                for (int i = 0; i < 16; ++i) S[i] = S[i] * carry * E[i >> 2] * sfx[i];
                carry *= acc_hi;
#pragma unroll
                for (int s2 = 0; s2 < 2; ++s2) {
                    const bf16x8 pfr = pack8(S, s2);
                    const LAS unsigned char* vrow = base + SB_V + (32 * kt + 16 * s2) * VST64 + troff;
#pragma unroll
                    for (int vt = 0; vt < 2; ++vt) { const bf16x8 vf = tr2(vrow + vt * 64, vrow + 8 * VST64 + vt * 64); O[vt] = MFMA32(vf, pfr, O[vt]); }
                }
            }
        }
        if (more) { LAS unsigned char* nb = lds + ((it + 1) & 1) * SB_STAGE; *(LAS u32x4*)(nb + dstK) = pk_; *(LAS u32x4*)(nb + dstV) = pv_; }
        const int done = (kbase < q0 + 32 * w + 32) && (carry < 1e-12f);
        const bool wdone = (__builtin_amdgcn_ballot_w64(done != 0) == ~0ull);
        LAS int* flg = (LAS int*)(lds + 2 * SB_STAGE) + (it & 1) * 8;
        if (lane == 0) flg[w] = wdone ? 1 : 0;
        __syncthreads();
        int all = 1;
#pragma unroll
        for (int ww = 0; ww < 8; ++ww) all &= flg[ww];
        if (all) break;
    }
    bf16_t* op = mixed + (rowb + qidx) * DM + 512 + hs * 64;
#pragma unroll
    for (int vt = 0; vt < 2; ++vt)
#pragma unroll
        for (int gq = 0; gq < 4; ++gq) { const int v0 = 32 * vt + 8 * gq + 4 * h;
            u32x2 o; o[0] = pk2(O[vt][4 * gq], O[vt][4 * gq + 1]); o[1] = pk2(O[vt][4 * gq + 2], O[vt][4 * gq + 3]); *(u32x2*)(op + v0) = o; }
    __syncthreads();
}
DI void attn_phase(LAS unsigned char* lds, const Params& p) {
    const bf16_t* proj = (const bf16_t*)(p.ws + O_PROJ); bf16_t* mixed = (bf16_t*)(p.ws + O_MIXED);
    const float lam = *(const float*)(p.ws + O_LAM);
    for (int it = blockIdx.x; it < 256; it += gridDim.x) {
        const int b = it >> 7, hd = (it >> 5) & 3, pr = it & 31;
        diff_tile(lds, proj, mixed, p.in[7], lam, b, hd, 63 - pr);
        diff_tile(lds, proj, mixed, p.in[7], lam, b, hd, pr);
    }
    for (int it = blockIdx.x; it < 512; it += gridDim.x) {
        const int b = it >> 8, hs = (it >> 5) & 7, qb = it & 31;
        sb_block(lds, proj, mixed, b, hs, qb);
    }
}
constexpr int SXS = 528, SBS = 272;
constexpr int L_SX = 0, L_SB = 128 * SXS, L_SC = L_SB + 128 * SBS, L_SDT = L_SC + 128 * SBS, L_SAC = L_SDT + 2048, L_SSQ = L_SAC + 2048;
static_assert(L_SSQ + 4096 <= LDS_BYTES, "lds");

DI void ssd_dt_acum(LAS unsigned char* lds, const float* DT, const float* dt_bias, const float* a_log, size_t t0, int g) {
    LAS float* sdt = (LAS float*)(lds + L_SDT); LAS float* sac = (LAS float*)(lds + L_SAC);
    const int tid = threadIdx.x, hh = tid >> 7, l = tid & 127, head = 4 * g + hh, w = tid >> 6, lane = tid & 63;
    const float raw = DT[(t0 + l) * 32 + head] + dt_bias[head];
    const float dt = fmaxf(raw, 0.f) + __logf(1.0f + __expf(-fabsf(raw)));
    sdt[hh * 128 + l] = dt; sac[hh * 128 + l] = -dt * __expf(a_log[head]);
    __syncthreads();
    if (w < 4) {
        const float v0 = sac[w * 128 + 2 * lane], v1 = sac[w * 128 + 2 * lane + 1]; float s = v0 + v1;
#pragma unroll
        for (int off = 1; off < 64; off <<= 1) { const float t = __shfl_up(s, off); if (lane >= off) s += t; }
        const float ex = s - (v0 + v1);
        sac[w * 128 + 2 * lane] = ex + v0; sac[w * 128 + 2 * lane + 1] = ex + v0 + v1;
    }
    __syncthreads();
}
template <int NT, class F> DI void conv_strip(const bf16_t* src, int nzero, const float* cw, const float* cb, int ch, F&& emit) {
    f32x4 wlo[4], whi[4];
#pragma unroll
    for (int k = 0; k < 4; ++k) { wlo[k] = *(const f32x4*)(cw + k * XBCW + ch); whi[k] = *(const f32x4*)(cw + k * XBCW + ch + 4); }
    const f32x4 blo = *(const f32x4*)(cb + ch), bhi = *(const f32x4*)(cb + ch + 4);
    u32x4 raw[NT + 3];
#pragma unroll
    for (int i = 0; i < NT + 3; ++i) { const int ii = (i < nzero) ? nzero : i; raw[i] = *(const u32x4*)(src + (ptrdiff_t)(ii - 3) * XBCW); if (i < nzero) raw[i] = (u32x4){0u, 0u, 0u, 0u}; }
#pragma unroll
    for (int t = 0; t < NT; ++t) {
        float o[8];
#pragma unroll
        for (int e = 0; e < 8; ++e) {
            float a = (e < 4) ? blo[e & 3] : bhi[e & 3];
#pragma unroll
            for (int k = 0; k < 4; ++k) { const unsigned d = raw[t + k][e >> 1]; const float xv = (e & 1) ? bfhi(d) : bflo(d); a += ((e < 4) ? wlo[k][e & 3] : whi[k][e & 3]) * xv; }
            o[e] = fsilu(a);
        }
        emit(t, o);
    }
}
DI u32x4 pack8f(const float* o) { u32x4 r; r[0] = pk2(o[0], o[1]); r[1] = pk2(o[2], o[3]); r[2] = pk2(o[4], o[5]); r[3] = pk2(o[6], o[7]); return r; }

template <bool XW, bool WITH_C> DI void ssd_stage(LAS unsigned char* lds, const bf16_t* xbc, const float* cw, const float* cb, size_t t0, int c, int g) {
    const int tid = threadIdx.x;
    LAS float* sdt = (LAS float*)(lds + L_SDT); LAS float* sac = (LAS float*)(lds + L_SAC);
    {
        const int c8 = tid & 31, tg = tid >> 5, l0 = 8 * tg, ch = 256 * g + 8 * c8, hh = c8 >> 3;
        const int nzero = (c == 0) ? (3 - l0 > 0 ? 3 - l0 : 0) : 0;
        const float alast = sac[hh * 128 + 127];
        conv_strip<8>(xbc + (t0 + l0) * XBCW + ch, nzero, cw, cb, ch, [&](int t, float* o) {
            if (XW) { const float wgt = sdt[hh * 128 + l0 + t] * __expf(alast - sac[hh * 128 + l0 + t]);
#pragma unroll
                for (int e = 0; e < 8; ++e) o[e] *= wgt; }
            *(LAS u32x4*)(lds + L_SX + (l0 + t) * SXS + c8 * 16) = pack8f(o); });
    }
    {
        const int c8 = tid & 15, tg = tid >> 4, l0 = 4 * tg;
        const int nzero = (c == 0) ? (3 - l0 > 0 ? 3 - l0 : 0) : 0;
        const int chb = DIN + 128 * g + 8 * c8;
        conv_strip<4>(xbc + (t0 + l0) * XBCW + chb, nzero, cw, cb, chb, [&](int t, float* o) { *(LAS u32x4*)(lds + L_SB + (l0 + t) * SBS + c8 * 16) = pack8f(o); });
        if (WITH_C) { const int chc = DIN + 1024 + 128 * g + 8 * c8;
            conv_strip<4>(xbc + (t0 + l0) * XBCW + chc, nzero, cw, cb, chc, [&](int t, float* o) { *(LAS u32x4*)(lds + L_SC + (l0 + t) * SBS + c8 * 16) = pack8f(o); }); }
    }
}
DI bf16_t* st_ptr(unsigned char* ws, int b) { return (bf16_t*)(ws + (b ? O_ST1 : O_ST0)); }

DI void ssd_states_phase(LAS unsigned char* lds, const Params& p) {
    const int tid = threadIdx.x, w = __builtin_amdgcn_readfirstlane(tid >> 6), lane = tid & 63, r = lane & 31, h = lane >> 5, hh = w >> 1, ph = w & 1;
    const bf16_t* xbc = (const bf16_t*)(p.ws + O_XBC); const float* DT = (const float*)(p.ws + O_DT); float* cdec = (float*)(p.ws + O_CDEC);
    const int i16 = lane & 15, tq = i16 >> 2, tp = i16 & 3, g16 = (lane >> 4) & 1;
    for (int it = blockIdx.x; it < 1024; it += gridDim.x) {
        const int b = it >> 9, c = (it >> 3) & 63, g = it & 7; const size_t t0 = (size_t)b * SEQ + (size_t)c * 128;
        ssd_dt_acum(lds, DT, p.in[13], p.in[14], t0, g);
        ssd_stage<true, false>(lds, xbc, p.in[11], p.in[12], t0, c, g);
        __syncthreads();
        f32x16 acc[4];
#pragma unroll
        for (int i = 0; i < 4; ++i) acc[i] = zero16();
        const LAS unsigned char* xa = lds + L_SX + (8 * h + tq) * SXS + (64 * hh + 32 * ph + 16 * g16 + 4 * tp) * 2;
        const LAS unsigned char* ba = lds + L_SB + (8 * h + tq) * SBS + (16 * g16 + 4 * tp) * 2;
#pragma unroll
        for (int s = 0; s < 8; ++s) {
            const bf16x8 af = tr2(xa + 16 * s * SXS, xa + (16 * s + 4) * SXS);
#pragma unroll
            for (int nt = 0; nt < 4; ++nt) { const bf16x8 bfr = tr2(ba + 16 * s * SBS + nt * 64, ba + (16 * s + 4) * SBS + nt * 64); acc[nt] = MFMA32(af, bfr, acc[nt]); }
        }
        bf16_t* st = st_ptr(p.ws, b) + ((size_t)(c * 32 + 4 * g + hh) * 64 + 32 * ph) * 128;
#pragma unroll
        for (int nt = 0; nt < 4; ++nt)
#pragma unroll
            for (int i = 0; i < 16; ++i) st[(size_t)crow(i, h) * 128 + 32 * nt + r] = (bf16_t)(pk2(acc[nt][i], 0.f) & 0xffffu);
        if (tid < 4) cdec[(b * 64 + c) * 32 + 4 * g + tid] = __expf(((LAS float*)(lds + L_SAC))[tid * 128 + 127]);
        __syncthreads();
    }
}
DI void ssd_scan_phase(const Params& p) {
    const float* cdec = (const float*)(p.ws + O_CDEC);
    for (int e = blockIdx.x * 512 + threadIdx.x; e < 2 * 32 * 64 * 32; e += gridDim.x * 512) {
        const int b = e >> 16, rem = e & 65535, head = rem >> 11;
        bf16_t* st = st_ptr(p.ws, b) + (size_t)rem * 4;
        float carry[4] = {0.f, 0.f, 0.f, 0.f};
        for (int c0 = 0; c0 < 64; c0 += 8) {
            u32x2 v[8]; float dc[8];
#pragma unroll
            for (int u = 0; u < 8; ++u) { v[u] = *(const u32x2*)(st + (size_t)(c0 + u) * 262144); dc[u] = cdec[(b * 64 + c0 + u) * 32 + head]; }
#pragma unroll
            for (int u = 0; u < 8; ++u) {
                u32x2 o; o[0] = pk2(carry[0], carry[1]); o[1] = pk2(carry[2], carry[3]); *(u32x2*)(st + (size_t)(c0 + u) * 262144) = o;
                carry[0] = carry[0] * dc[u] + bflo(v[u][0]); carry[1] = carry[1] * dc[u] + bfhi(v[u][0]); carry[2] = carry[2] * dc[u] + bflo(v[u][1]); carry[3] = carry[3] * dc[u] + bfhi(v[u][1]);
            }
        }
    }
}
DI void ssd_out_phase(LAS unsigned char* lds, const Params& p) {
    const int tid = threadIdx.x, w = __builtin_amdgcn_readfirstlane(tid >> 6), lane = tid & 63, r = lane & 31, h = lane >> 5, hh = w >> 1, ph = w & 1;
    const bf16_t* xbc = (const bf16_t*)(p.ws + O_XBC); const float* DT = (const float*)(p.ws + O_DT); bf16_t* zy = (bf16_t*)p.out;
    LAS float* sdt = (LAS float*)(lds + L_SDT); LAS float* sac = (LAS float*)(lds + L_SAC); LAS float* ssq = (LAS float*)(lds + L_SSQ);
    const int i16 = lane & 15, tq = i16 >> 2, tp = i16 & 3, g16 = (lane >> 4) & 1;
    for (int it = blockIdx.x; it < 1024; it += gridDim.x) {
        const int b = it >> 9, c = (it >> 3) & 63, g = it & 7, head = 4 * g + hh; const size_t t0 = (size_t)b * SEQ + (size_t)c * 128;
        ssd_dt_acum(lds, DT, p.in[13], p.in[14], t0, g);
        ssd_stage<false, true>(lds, xbc, p.in[11], p.in[12], t0, c, g);
        bf16x8 pvf[8];
        { const bf16_t* pp = st_ptr(p.ws, b) + ((size_t)(c * 32 + head) * 64 + 32 * ph + r) * 128 + 8 * h;
#pragma unroll
          for (int s = 0; s < 8; ++s) pvf[s] = *(const bf16x8*)(pp + 16 * s); }
        __syncthreads();
        f32x16 Y[4];
        const LAS unsigned char* xa = lds + L_SX + (4 * h + tq) * SXS + (64 * hh + 32 * ph + 16 * g16 + 4 * tp) * 2;
#pragma unroll
        for (int lt = 0; lt < 4; ++lt) {
            __builtin_amdgcn_sched_barrier(0);
            f32x16 y = zero16();
#pragma unroll
            for (int s = 0; s < 8; ++s) { const bf16x8 cfs = *(const LAS bf16x8*)(lds + L_SC + (32 * lt + r) * SBS + (16 * s + 8 * h) * 2); y = MFMA32(pvf[s], cfs, y); }
            Y[lt] = y * __expf(sac[hh * 128 + 32 * lt + r]);
        }
#pragma unroll
        for (int lt = 0; lt < 4; ++lt) {
            __builtin_amdgcn_sched_barrier(0);
            bf16x8 cf[8];
#pragma unroll
            for (int s = 0; s < 8; ++s) cf[s] = *(const LAS bf16x8*)(lds + L_SC + (32 * lt + r) * SBS + (16 * s + 8 * h) * 2);
            const float al = sac[hh * 128 + 32 * lt + r];
#pragma unroll
            for (int mt = 0; mt < 4; ++mt) {
                if (mt <= lt) {
                    __builtin_amdgcn_sched_barrier(0);
                    f32x16 X = zero16();
#pragma unroll
                    for (int s = 0; s < 8; ++s) { const bf16x8 bfr = *(const LAS bf16x8*)(lds + L_SB + (32 * mt + r) * SBS + (16 * s + 8 * h) * 2); X = MFMA32(bfr, cf[s], X); }
#pragma unroll
                    for (int gq = 0; gq < 4; ++gq) {
                        const f32x4 am = *(const LAS f32x4*)(sac + hh * 128 + 32 * mt + 8 * gq + 4 * h), dm = *(const LAS f32x4*)(sdt + hh * 128 + 32 * mt + 8 * gq + 4 * h);
#pragma unroll
                        for (int jj = 0; jj < 4; ++jj) { const int mrow = 32 * mt + 8 * gq + 4 * h + jj; const bool ok = (32 * lt + r) >= mrow;
                            const float dec = ok ? __expf(fminf(al - am[jj], 0.f)) * dm[jj] : 0.f; X[4 * gq + jj] *= dec; }
                    }
#pragma unroll
                    for (int s2 = 0; s2 < 2; ++s2) { const bf16x8 xs = pack8(X, s2);
                        const LAS unsigned char* xr = xa + (32 * mt + 16 * s2) * SXS; const bf16x8 xf = tr2(xr, xr + 8 * SXS); Y[lt] = MFMA32(xf, xs, Y[lt]); }
                }
            }
        }
        __builtin_amdgcn_sched_barrier(0);
        const float Dh = p.in[15][head];
        float sq[4];
#pragma unroll
        for (int lt = 0; lt < 4; ++lt) {
            const int l = 32 * lt + r; sq[lt] = 0.f;
#pragma unroll
            for (int gq = 0; gq < 4; ++gq) {
                const int chl = 64 * hh + 32 * ph + 8 * gq + 4 * h;
                const u32x2 xv = *(const LAS u32x2*)(lds + L_SX + l * SXS + chl * 2);
                const u32x2 zv = *(const u32x2*)(zy + (t0 + l) * DIN + 256 * g + chl);
                const float xf4[4] = {bflo(xv[0]), bfhi(xv[0]), bflo(xv[1]), bfhi(xv[1])}, zf4[4] = {bflo(zv[0]), bfhi(zv[0]), bflo(zv[1]), bfhi(zv[1])};
#pragma unroll
                for (int jj = 0; jj < 4; ++jj) { const float yv = (Y[lt][4 * gq + jj] + Dh * xf4[jj]) * fsilu(zf4[jj]); Y[lt][4 * gq + jj] = yv; sq[lt] += yv * yv; }
            }
            sq[lt] += __shfl_xor(sq[lt], 32);
            if (h == 0) ssq[w * 128 + l] = sq[lt];
        }
        __syncthreads();
#pragma unroll
        for (int lt = 0; lt < 4; ++lt) {
            const int l = 32 * lt + r; float tot = 0.f;
#pragma unroll
            for (int ww = 0; ww < 8; ++ww) tot += ssq[ww * 128 + l];
            const float rn = __builtin_amdgcn_rsqf(tot * (1.0f / 256.0f) + 1e-5f);
#pragma unroll
            for (int gq = 0; gq < 4; ++gq) {
                const int chl = 64 * hh + 32 * ph + 8 * gq + 4 * h; const f32x4 gw = *(const f32x4*)(p.in[16] + 256 * g + chl);
                u32x2 o; o[0] = pk2(Y[lt][4 * gq] * rn * gw[0], Y[lt][4 * gq + 1] * rn * gw[1]); o[1] = pk2(Y[lt][4 * gq + 2] * rn * gw[2], Y[lt][4 * gq + 3] * rn * gw[3]);
                *(u32x2*)(zy + (t0 + l) * DIN + 256 * g + chl) = o;
            }
        }
        __syncthreads();
    }
}
template <class Epi> DI void run_gemm(LAS unsigned char* lds, const bf16_t* A, const bf16_t* Bt, int N, int K, const Epi& E) {
    pg8::Gemm g; g.A = A; g.Bt = Bt; g.M = MT; g.N = N; g.K = K;
    pg8::StaticOrder S; S.init(MT, N, (int)gridDim.x, (int)blockIdx.x);
    pg8::gemm_phase<Epi, pg8::StaticOrder, false>((PG8_LAS unsigned char*)lds, g, S, E, nullptr);
}
__global__ void __launch_bounds__(512, 2) fwd_megakernel(Params p) {
    extern __shared__ __attribute__((aligned(16))) unsigned char shm[];
    LAS unsigned char* lds = (LAS unsigned char*)shm;
    cg::grid_group grid = cg::this_grid();
    unsigned char* ws = p.ws;
    bf16_t* hb = (bf16_t*)(ws + O_HB); float* ss = (float*)(ws + O_SS);
    phase0(lds, p);
    grid.sync();
    { EpiAttnIn E; E.O = (bf16_t*)(ws + O_PROJ); E.ss = ss; E.tab = (const f32x4*)(ws + O_ROPE); run_gemm(lds, hb, (const bf16_t*)(ws + W_AIN), AINW, DM, E); }
    grid.sync();
    attn_phase(lds, p);
    grid.sync();
    { EpiRes<true, false> E; E.xres = p.in[0]; E.hb = hb; E.outf = nullptr; E.ssn = ss + MT; run_gemm(lds, (const bf16_t*)(ws + O_MIXED), (const bf16_t*)(ws + W_AOUT), DM, DM, E); }
    grid.sync();
    { EpiGU E; E.act = (bf16_t*)(ws + O_ACT); E.ss = ss + MT; run_gemm(lds, hb, (const bf16_t*)(ws + W_GU0), 2 * DFF, DM, E); }
    grid.sync();
    { EpiRes<false, false> E; E.xres = nullptr; E.hb = hb; E.outf = nullptr; E.ssn = ss + 2 * MT; run_gemm(lds, (const bf16_t*)(ws + O_ACT), (const bf16_t*)(ws + W_DN0), DM, DFF, E); }
    grid.sync();
    { EpiSsdIn E; E.z = (bf16_t*)p.out; E.xbc = (bf16_t*)(ws + O_XBC); E.dt = (float*)(ws + O_DT); E.ss = ss + 2 * MT; run_gemm(lds, hb, (const bf16_t*)(ws + W_SIN), SINWP, DM, E); }
    grid.sync();
    ssd_states_phase(lds, p);
    grid.sync();
    ssd_scan_phase(p);
    grid.sync();
    ssd_out_phase(lds, p);
    grid.sync();
    { EpiRes<false, false> E; E.xres = nullptr; E.hb = hb; E.outf = nullptr; E.ssn = ss + 3 * MT; run_gemm(lds, (const bf16_t*)p.out, (const bf16_t*)(ws + W_SOUT), DM, DIN, E); }
    grid.sync();
    { EpiGU E; E.act = (bf16_t*)(ws + O_ACT); E.ss = ss + 3 * MT; run_gemm(lds, hb, (const bf16_t*)(ws + W_GU1), 2 * DFF, DM, E); }
    grid.sync();
    { EpiRes<false, true> E; E.xres = nullptr; E.hb = hb; E.outf = p.out; E.ssn = ss + 4 * MT; run_gemm(lds, (const bf16_t*)(ws + O_ACT), (const bf16_t*)(ws + W_DN1), DM, DFF, E); }
    grid.sync();
    {
        const float* ss4 = ss + 4 * MT; const f32x4* fw = (const f32x4*)p.in[22]; f32x4* o4 = (f32x4*)p.out;
        for (int i = blockIdx.x * 512 + threadIdx.x; i < MT * (DM / 4); i += gridDim.x * 512) {
            const int row = i >> 8; const float rs = __builtin_amdgcn_rsqf(ss4[row] * (1.0f / 1024.0f) + 1e-6f);
            o4[i] = o4[i] * rs * fw[i & 255];
        }
    }
}

extern "C" void kernel_launch(void* const* d_in, const int* in_sizes, int n_in, void* d_out, int out_size, void* d_ws, size_t ws_size, hipStream_t stream) {
    static int grid_blocks = 0;
    if (!grid_blocks) {
        int dev = 0, cus = 0, per_cu = 0;
        hipGetDevice(&dev);
        hipDeviceGetAttribute(&cus, hipDeviceAttributeMultiprocessorCount, dev);
        if (hipFuncSetAttribute((const void*)fwd_megakernel, hipFuncAttributeMaxDynamicSharedMemorySize, LDS_BYTES) != hipSuccess) fprintf(stderr, "hipFuncSetAttribute failed\n");
        if (hipOccupancyMaxActiveBlocksPerMultiprocessor(&per_cu, (const void*)fwd_megakernel, 512, LDS_BYTES) != hipSuccess || per_cu < 1) { fprintf(stderr, "occupancy query: %d\n", per_cu); per_cu = 1; }
        (void)hipGetLastError();
        grid_blocks = cus * per_cu;
        if (ws_size < 268435456ull || n_in != 23) fprintf(stderr, "unexpected ws_size %zu / n_in %d\n", ws_size, n_in);
    }
    Params p{};
    for (int i = 0; i < 23; ++i) p.in[i] = (const float*)d_in[i];
    p.out = (float*)d_out; p.ws = (unsigned char*)d_ws;
    void* args[] = {&p};
    hipError_t e = hipLaunchCooperativeKernel((const void*)fwd_megakernel, dim3(grid_blocks), dim3(512), args, LDS_BYTES, stream);
    if (e != hipSuccess) fprintf(stderr, "cooperative launch failed: %s (grid %d)\n", hipGetErrorString(e), grid_blocks);
}
#ifdef PHASE_TEST
__global__ void __launch_bounds__(512, 2) t_phase0(Params p) { extern __shared__ __attribute__((aligned(16))) unsigned char shm[]; phase0((LAS unsigned char*)shm, p); }
__global__ void __launch_bounds__(512, 2) t_attn_diff(Params p) { extern __shared__ __attribute__((aligned(16))) unsigned char shm[]; diff_tile((LAS unsigned char*)shm, (const bf16_t*)(p.ws + O_PROJ), (bf16_t*)(p.ws + O_MIXED), p.in[7], 0.3f, blockIdx.x & 1, blockIdx.y, blockIdx.z); }
__global__ void __launch_bounds__(512, 2) t_attn_sb(Params p) { extern __shared__ __attribute__((aligned(16))) unsigned char shm[]; sb_block((LAS unsigned char*)shm, (const bf16_t*)(p.ws + O_PROJ), (bf16_t*)(p.ws + O_MIXED), blockIdx.x & 1, blockIdx.y, blockIdx.z); }
__global__ void __launch_bounds__(512, 2) t_ssd_states(Params p) { extern __shared__ __attribute__((aligned(16))) unsigned char shm[]; ssd_states_phase((LAS unsigned char*)shm, p); }
__global__ void __launch_bounds__(512, 2) t_ssd_scan(Params p) { ssd_scan_phase(p); }
__global__ void __launch_bounds__(512, 2) t_ssd_out(Params p) { extern __shared__ __attribute__((aligned(16))) unsigned char shm[]; ssd_out_phase((LAS unsigned char*)shm, p); }
__global__ void __launch_bounds__(512, 2) t_gemm_ain(Params p) { extern __shared__ __attribute__((aligned(16))) unsigned char shm[]; EpiAttnIn E; E.O = (bf16_t*)(p.ws + O_PROJ); E.ss = (float*)(p.ws + O_SS); E.tab = (const f32x4*)(p.ws + O_ROPE); run_gemm((LAS unsigned char*)shm, (bf16_t*)(p.ws + O_HB), (const bf16_t*)(p.ws + W_AIN), AINW, DM, E); }
__global__ void __launch_bounds__(512, 2) t_gemm_res(Params p) { extern __shared__ __attribute__((aligned(16))) unsigned char shm[]; EpiRes<false, false> E; E.xres = nullptr; E.hb = (bf16_t*)(p.ws + O_HB); E.outf = nullptr; E.ssn = (float*)(p.ws + O_SS); run_gemm((LAS unsigned char*)shm, (bf16_t*)(p.ws + O_ACT), (const bf16_t*)(p.ws + W_DN0), DM, DFF, E); }
__global__ void __launch_bounds__(512, 2) t_gemm_gu(Params p) { extern __shared__ __attribute__((aligned(16))) unsigned char shm[]; EpiGU E; E.act = (bf16_t*)(p.ws + O_ACT); E.ss = (float*)(p.ws + O_SS); run_gemm((LAS unsigned char*)shm, (bf16_t*)(p.ws + O_HB), (const bf16_t*)(p.ws + W_GU0), 2 * DFF, DM, E); }
__global__ void __launch_bounds__(512, 2) t_gemm_ssdin(Params p) { extern __shared__ __attribute__((aligned(16))) unsigned char shm[]; EpiSsdIn E; E.z = (bf16_t*)p.out; E.xbc = (bf16_t*)(p.ws + O_XBC); E.dt = (float*)(p.ws + O_DT); E.ss = (float*)(p.ws + O_SS); run_gemm((LAS unsigned char*)shm, (bf16_t*)(p.ws + O_HB), (const bf16_t*)(p.ws + W_SIN), SINWP, DM, E); }
#endif
```

```cpp
#include <hip/hip_runtime.h>
#include <hip/hip_cooperative_groups.h>
#include <cstdio>
#include <cstdint>
namespace cg = cooperative_groups;
namespace pg8 {
#define PG8_LAS __attribute__((address_space(3)))
typedef unsigned short bf16_t;
typedef short bf16x8 __attribute__((ext_vector_type(8)));
typedef float f32x4 __attribute__((ext_vector_type(4)));
typedef unsigned u32x4 __attribute__((ext_vector_type(4)));
constexpr int BM = 256, BK = 64, HALF = 128, HTB = HALF * BK * 2  , STAGE_BYTES = 8 * HTB, NXCD = 8, WGM = 8;

__host__ __device__ __forceinline__ int lds_byte(int r, int c) { const int st = (r >> 4) * 2 + (c >> 5), rr = r & 15, cc = c & 31, ob = rr * 64 + cc * 2; return st * 1024 + (ob ^ (((ob >> 9) & 1) << 5)); }
__host__ __device__ __forceinline__ void stage_rc(int b, int& R, int& C) { const int st = b / 1024, sb = b % 1024, swz = sb ^ (((sb >> 9) & 1) << 5); R = (st >> 1) * 16 + swz / 64; C = (st & 1) * 32 + (swz % 64) / 2; }
__host__ __device__ __forceinline__ int perm32(int rho) { const int n = rho >> 4, i = rho & 15; return 8 * (i >> 2) + 4 * n + (i & 3); }

struct Unit { int pm, pn; };
struct Gemm { const bf16_t* A; const bf16_t* Bt; int M, N, K; };

struct StaticOrder {
    int nM, nN, nwg, G, c;
    __host__ __device__ void init(int M, int N, int G_, int c_) { nM = M / BM; nN = N / BM; nwg = nM * nN; G = G_; c = c_; }
    __host__ __device__ bool next(int i, Unit& u) const {
        const long L = (long)i * G + c; if (L >= nwg) return false;
        int wgid = (int)L; { const int q = nwg / NXCD, r = nwg % NXCD, xcd = wgid % NXCD, off = wgid / NXCD; wgid = (xcd < r ? xcd * (q + 1) : r * (q + 1) + (xcd - r) * q) + off; }
        const int nig = WGM * nN, gid = wgid / nig, fm = gid * WGM, gsz = (nM - fm) < WGM ? (nM - fm) : WGM;
        u.pm = fm + ((wgid % nig) % gsz); u.pn = (wgid % nig) / gsz; return true;
    }
    __device__ __forceinline__ void a_ready(const Unit&) const {}
    __device__ __forceinline__ void done(const Unit&) const {}
};

template <class Epi, class Sched, bool STAMP = false>
__device__ __forceinline__ void gemm_phase(PG8_LAS unsigned char* lds, const Gemm g, const Sched& S, const Epi& E, unsigned long long* stamps) {
    const int tid = threadIdx.x, wid = __builtin_amdgcn_readfirstlane(tid >> 6), lane = tid & 63, wr = wid >> 2, wc = wid & 3, fr = lane & 15, fq = lane >> 4;
    const int K = g.K, nt = K / BK;
    int ts_lo = 0, ts_hi = 0, nts = 0; const unsigned long long rt_entry = STAMP ? (unsigned long long)wall_clock64() : 0ull;
#define PG8_STAMP() do { if (STAMP && wid == 0 && nts < 64) { const unsigned long long _c = (unsigned long long)clock64(); \
        ts_lo = (lane == nts) ? (int)(unsigned)_c : ts_lo; ts_hi = (lane == nts) ? (int)(unsigned)(_c >> 32) : ts_hi; ++nts; } } while (0)
    PG8_STAMP();
    unsigned voffA[2], voffB[2];
#pragma unroll
    for (int i = 0; i < 2; ++i) { int R, C; stage_rc(tid * 16 + i * 8192, R, C); const int Rb = Epi::PERM ? ((R & ~31) + perm32(R & 31)) : R;
        voffA[i] = (unsigned)(R * K + C) * 2u; voffB[i] = (unsigned)(Rb * K + C) * 2u; }
    const size_t kstep = (size_t)(BK * 2);
    const size_t hstep = (size_t)HALF * K * 2;
    const size_t tstep = 2 * hstep;
    const unsigned ldsw = (unsigned)wid * 1024u;
    const int aoff = lds_byte(wr * 64 + fr, fq * 8), boff = lds_byte(wc * 32 + fr, fq * 8);
#define PG8_SA(b, h) (((b) * 2 + (h)) * HTB)
#define PG8_SB(b, h) ((4 + (b) * 2 + (h)) * HTB)
#define PG8_STAGE(bufoff, gbase, voff) do { _Pragma("unroll") for (int _i = 0; _i < 2; ++_i) \
        __builtin_amdgcn_global_load_lds((const unsigned*)((const char*)(gbase) + (voff)[_i]), (PG8_LAS unsigned*)(lds + (bufoff) + ldsw + _i * 8192), 16, 0, 0); } while (0)
#define PG8_LDA(dst, b, h) do { _Pragma("unroll") for (int m = 0; m < 4; ++m) _Pragma("unroll") for (int k = 0; k < 2; ++k) dst[m][k] = *(const PG8_LAS bf16x8*)(lds + PG8_SA(b, h) + aoff + m * 2048 + k * 1024); } while (0)
#define PG8_LDB(dst, b, h) do { _Pragma("unroll") for (int n = 0; n < 2; ++n) _Pragma("unroll") for (int k = 0; k < 2; ++k) dst[n][k] = *(const PG8_LAS bf16x8*)(lds + PG8_SB(b, h) + boff + n * 2048 + k * 1024); } while (0)
#define PG8_MMA(ai, bj, At, Bt) do { __builtin_amdgcn_s_setprio(1); _Pragma("unroll") for (int m = 0; m < 4; ++m) _Pragma("unroll") for (int n = 0; n < 2; ++n) _Pragma("unroll") for (int k = 0; k < 2; ++k) \
        acc[ai][bj][m][n] = __builtin_amdgcn_mfma_f32_16x16x32_bf16(Bt[n][k], At[m][k], acc[ai][bj][m][n], 0, 0, 0); __builtin_amdgcn_s_setprio(0); } while (0)
#define PG8_WAIT_V(n) asm volatile("s_waitcnt vmcnt(" #n ")" ::: "memory")
#define PG8_WAIT_L(n) asm volatile("s_waitcnt lgkmcnt(" #n ")" ::: "memory")
#define PG8_BAR __builtin_amdgcn_s_barrier()
#define PG8_SCHED __builtin_amdgcn_sched_barrier(0)
    Unit cur, nxt; int ui = 0;
    if (!S.next(0, cur)) return;
    f32x4 acc[2][2][4][2];
#pragma unroll
    for (int a = 0; a < 2; ++a)
#pragma unroll
        for (int b = 0; b < 2; ++b)
#pragma unroll
            for (int m = 0; m < 4; ++m)
#pragma unroll
                for (int n = 0; n < 2; ++n) acc[a][b][m][n] = (f32x4){0.f, 0.f, 0.f, 0.f};
    bf16x8 At[4][2], B0[2][2], B1[2][2];
    const char* cA = (const char*)g.A + (size_t)cur.pm * tstep; const char* cB = (const char*)g.Bt + (size_t)cur.pn * tstep;
    S.a_ready(cur);
    PG8_STAGE(PG8_SB(0, 0), cB, voffB); PG8_STAGE(PG8_SA(0, 0), cA, voffA); PG8_STAGE(PG8_SB(0, 1), cB + hstep, voffB); PG8_STAGE(PG8_SA(0, 1), cA + hstep, voffA);
    if (wr == 1) PG8_BAR;
    PG8_WAIT_V(4); PG8_BAR;
    PG8_STAGE(PG8_SB(1, 0), cB + kstep, voffB); PG8_STAGE(PG8_SA(1, 0), cA + kstep, voffA); PG8_STAGE(PG8_SB(1, 1), cB + hstep + kstep, voffB);
    PG8_WAIT_V(6); PG8_BAR;
    PG8_STAMP();
    for (;;) {
        const bool has_next = S.next(ui + 1, nxt);
        const char* nA = has_next ? (const char*)g.A + (size_t)nxt.pm * tstep : cA; const char* nB = has_next ? (const char*)g.Bt + (size_t)nxt.pn * tstep : cB;
        for (int t = 0; t < nt; t += 2) {
            const bool last = (t == nt - 2);
            const char* a1 = cA + (size_t)(t + 1) * kstep;
            const char* a2 = last ? nA : cA + (size_t)(t + 2) * kstep; const char* b2 = last ? nB : cB + (size_t)(t + 2) * kstep;
            const char* a3 = a2 + kstep; const char* b3 = b2 + kstep;
            if (last && has_next) S.a_ready(nxt);
            PG8_LDB(B0, 0, 0); PG8_SCHED; PG8_LDA(At, 0, 0); PG8_STAGE(PG8_SA(1, 1), a1 + hstep, voffA);
            PG8_WAIT_L(8); PG8_BAR; PG8_WAIT_L(0); PG8_MMA(0, 0, At, B0); PG8_BAR; PG8_SCHED;
            PG8_LDB(B1, 0, 1); PG8_STAGE(PG8_SB(0, 0), b2, voffB);
            PG8_BAR; PG8_WAIT_L(0); PG8_MMA(0, 1, At, B1); PG8_BAR;
            PG8_LDA(At, 0, 1); PG8_STAGE(PG8_SA(0, 0), a2, voffA);
            PG8_BAR; PG8_WAIT_L(0); PG8_MMA(1, 0, At, B0); PG8_BAR; PG8_SCHED;
            PG8_STAGE(PG8_SB(0, 1), b2 + hstep, voffB);
            PG8_WAIT_V(6); PG8_BAR; PG8_MMA(1, 1, At, B1); PG8_BAR;
            PG8_LDB(B0, 1, 0); PG8_SCHED; PG8_LDA(At, 1, 0); PG8_STAGE(PG8_SA(0, 1), a2 + hstep, voffA);
            PG8_WAIT_L(8); PG8_BAR; PG8_WAIT_L(0); PG8_MMA(0, 0, At, B0); PG8_BAR; PG8_SCHED;
            PG8_LDB(B1, 1, 1); PG8_STAGE(PG8_SB(1, 0), b3, voffB);
            PG8_BAR; PG8_WAIT_L(0); PG8_MMA(0, 1, At, B1); PG8_BAR;
            PG8_LDA(At, 1, 1); PG8_STAGE(PG8_SA(1, 0), a3, voffA);
            PG8_BAR; PG8_WAIT_L(0); PG8_MMA(1, 0, At, B0); PG8_BAR; PG8_SCHED;
            PG8_STAGE(PG8_SB(1, 1), b3 + hstep, voffB);
            PG8_WAIT_V(6); PG8_BAR; PG8_MMA(1, 1, At, B1); PG8_BAR;
        }
        PG8_STAMP();
        if constexpr (!Epi::AFTER_DRAIN) { E(acc, cur, wr, wc, fr, fq); S.done(cur); }
        PG8_STAMP();
        if (!has_next) break;
#pragma unroll
        for (int a = 0; a < 2; ++a)
#pragma unroll
            for (int b = 0; b < 2; ++b)
#pragma unroll
                for (int m = 0; m < 4; ++m)
#pragma unroll
                    for (int n = 0; n < 2; ++n) acc[a][b][m][n] = (f32x4){0.f, 0.f, 0.f, 0.f};
        cur = nxt; cA = nA; cB = nB; ++ui;
    }
    PG8_WAIT_V(0);
    if (wr == 0) PG8_BAR;
    PG8_BAR;
    if constexpr (Epi::AFTER_DRAIN) { E.fused(acc, cur, wr, wc, fr, fq, lds, wid, lane); S.done(cur); }
    PG8_STAMP();
    if (STAMP && wid == 0) { stamps[lane] = lane < nts ? (((unsigned long long)(unsigned)ts_hi << 32) | (unsigned)ts_lo) : 0ull;
        if (lane == 62) stamps[62] = rt_entry; if (lane == 63) stamps[63] = (unsigned long long)wall_clock64(); }
#undef PG8_STAMP
#undef PG8_SA
#undef PG8_SB
#undef PG8_STAGE
#undef PG8_LDA
#undef PG8_LDB
#undef PG8_MMA
#undef PG8_WAIT_V
#undef PG8_WAIT_L
#undef PG8_BAR
#undef PG8_SCHED
}
}
using pg8::bf16_t; using pg8::bf16x8; using pg8::f32x4;
typedef short s16x4 __attribute__((ext_vector_type(4)));
typedef float f32x16 __attribute__((ext_vector_type(16)));
typedef float f32x2 __attribute__((ext_vector_type(2)));
typedef __bf16 bf2_t __attribute__((ext_vector_type(2)));
typedef unsigned u32x2 __attribute__((ext_vector_type(2)));
typedef unsigned u32x4 __attribute__((ext_vector_type(4)));
#define LAS __attribute__((address_space(3)))
#define DI __device__ __forceinline__
#define MFMA32(a, b, c) __builtin_amdgcn_mfma_f32_32x32x16_bf16((a), (b), (c), 0, 0, 0)

DI unsigned pk2(float a, float b) { f32x2 v = {a, b}; bf2_t r = __builtin_convertvector(v, bf2_t); return __builtin_bit_cast(unsigned, r); }
DI float bflo(unsigned u) { return __uint_as_float(u << 16); }
DI float bfhi(unsigned u) { return __uint_as_float(u & 0xffff0000u); }
DI float fexp2(float x) { return __builtin_amdgcn_exp2f(x); }
DI float frcp(float x) { return __builtin_amdgcn_rcpf(x); }
DI float fsilu(float x) { return x * frcp(1.0f + fexp2(-1.44269504089f * x)); }
DI int crow(int i, int h) { return (i & 3) + 8 * (i >> 2) + 4 * h; }
DI s16x4 trr(const LAS unsigned char* p) { return __builtin_amdgcn_ds_read_tr16_b64_v4i16((LAS s16x4*)p); }
DI bf16x8 tr2(const LAS unsigned char* p0, const LAS unsigned char* p1) { s16x4 a = trr(p0), b = trr(p1); return __builtin_shufflevector(a, b, 0, 1, 2, 3, 4, 5, 6, 7); }
DI bf16x8 pack8(const f32x16& x, int s) {
    u32x4 p; p[0] = pk2(x[8 * s], x[8 * s + 1]); p[1] = pk2(x[8 * s + 2], x[8 * s + 3]); p[2] = pk2(x[8 * s + 4], x[8 * s + 5]); p[3] = pk2(x[8 * s + 6], x[8 * s + 7]);
    return __builtin_bit_cast(bf16x8, p);
}
DI f32x16 zero16() { f32x16 z; for (int i = 0; i < 16; ++i) z[i] = 0.f; return z; }

constexpr int MT = 16384, SEQ = 8192, DM = 1024, DFF = 2816, AINW = 3072, SINW = 6176, SINWP = 6400, DIN = 2048, XBCW = 4096;
constexpr float LOG2E = 1.44269504089f;
constexpr int LDS_BYTES = 147456;
constexpr size_t W_AIN = 0, W_AOUT = W_AIN + (size_t)AINW * DM * 2, W_GU0 = W_AOUT + (size_t)DM * DM * 2, W_DN0 = W_GU0 + (size_t)2 * DFF * DM * 2,
                 W_SIN = W_DN0 + (size_t)DM * DFF * 2, W_SOUT = W_SIN + (size_t)SINWP * DM * 2, W_GU1 = W_SOUT + (size_t)DM * DIN * 2, W_DN1 = W_GU1 + (size_t)2 * DFF * DM * 2,
                 O_HB = W_DN1 + (size_t)DM * DFF * 2, O_SS = O_HB + (size_t)MT * DM * 2, O_ROPE = O_SS + (size_t)5 * MT * 4, O_DT = O_ROPE + (size_t)SEQ * 32 * 8,
                 O_CDEC = O_DT + (size_t)MT * 32 * 4, O_LAM = O_CDEC + 16384, O_BAR = O_LAM + 256, O_R = 98566144;
static_assert(O_BAR + 16384 <= O_R, "map");
constexpr size_t O_PROJ = O_R, O_MIXED = O_PROJ + (size_t)MT * AINW * 2, O_ACT = O_R, O_XBC = O_R, O_ST1 = O_XBC + (size_t)MT * XBCW * 2, O_ST0 = 0;
constexpr size_t ST_BATCH = (size_t)64 * 32 * 64 * 128;
static_assert(O_ST1 + ST_BATCH * 2 <= 268435456ull, "ws");
static_assert(ST_BATCH * 2 <= W_SOUT, "st0 overlay");
static_assert(O_MIXED + (size_t)MT * DM * 2 <= 268435456ull, "ws2");

struct Params { const float* in[23]; float* out; unsigned char* ws; };
#include <cstdlib>
#include <vector>

#define XB_TMO      128
#define XB_XCNT(j)  (256  + 64 * (j))
#define XB_XSUB(j)  (1280 + 64 * (j))
#define XB_XGEN(j)  (2304 + 64 * (j))
#define XB_TOP      3328
#define XB_TOPGEN   3392
#define XCD_BAR_WORDS 3456
#define XB_SPIN_CAP (1u << 18)

__device__ __forceinline__ unsigned xb_ld(unsigned* p)              { return __hip_atomic_load(p, __ATOMIC_RELAXED, __HIP_MEMORY_SCOPE_AGENT); }
__device__ __forceinline__ unsigned xb_add(unsigned* p, unsigned v) { return __hip_atomic_fetch_add(p, v, __ATOMIC_RELAXED, __HIP_MEMORY_SCOPE_AGENT); }
__device__ __forceinline__ unsigned xb_xcc_id() { return (unsigned)__builtin_amdgcn_s_getreg((3 << 11) | 20) & 0xFu; }
#define XB_SPIN(cond, bar) do { unsigned _sp = 0; while (cond) { __builtin_amdgcn_s_sleep(1); \
    if ((++_sp & 255u) == 0u) { if (xb_ld(&(bar)[XB_TMO])) break; if (_sp > XB_SPIN_CAP) { atomicAdd(&(bar)[XB_TMO], 1u); break; } } } } while (0)

struct XcdBarrier {
    unsigned* bar; unsigned x;
    volatile LAS unsigned* st;
};

__device__ __forceinline__ XcdBarrier xcd_barrier_post(unsigned* bar, volatile LAS unsigned* st) {
    XcdBarrier b; b.bar = bar; b.x = xb_xcc_id(); b.st = st;
    if (threadIdx.x == 0) (void)xb_add(&bar[XB_XCNT(b.x)], 1u);
    return b;
}
__device__ __forceinline__ void xcd_barrier_complete(unsigned* bar, unsigned x, unsigned& nloc, unsigned& nx) {
    const unsigned G = gridDim.x * gridDim.y * gridDim.z;
    unsigned sum, cnt, mine, sp = 0u;
    for (;;) {
        sum = 0u; cnt = 0u; mine = 0u;
#pragma unroll
        for (unsigned j = 0; j < 16; ++j) { const unsigned c = xb_ld(&bar[XB_XCNT(j)]); sum += c; cnt += (c > 0u) ? 1u : 0u; mine = (j == x) ? c : mine; }
        if (sum == G) break;
        __builtin_amdgcn_s_sleep(1);
        if ((++sp & 255u) == 0u) { if (xb_ld(&bar[XB_TMO])) break; if (sp > XB_SPIN_CAP) { atomicAdd(&bar[XB_TMO], 1u); break; } }
    }
    nloc = mine > 0u ? mine : 1u; nx = cnt > 0u ? cnt : 1u;
}

__device__ __forceinline__ void xcd_barrier(const XcdBarrier& b) {
    asm volatile("s_waitcnt vmcnt(0)" ::: "memory");
    __syncthreads();
    if (threadIdx.x == 0) {
        unsigned* bar = b.bar;
        __builtin_amdgcn_s_waitcnt(0);
        unsigned nloc = b.st[0], nx = b.st[1];
        if (nloc == 0u) { xcd_barrier_complete(bar, b.x, nloc, nx); b.st[0] = nloc; b.st[1] = nx; }
        const unsigned old = xb_add(&bar[XB_XSUB(b.x)], 1u);
        const unsigned gen = old / nloc;
        if (old + 1u == (gen + 1u) * nloc) {
            __builtin_amdgcn_fence(__ATOMIC_RELEASE, "agent");
            asm volatile("s_waitcnt vmcnt(0)" ::: "memory");
            const unsigned og = xb_add(&bar[XB_TOP], 1u);
            const unsigned tg = og / nx;
            if (og + 1u == (tg + 1u) * nx) xb_add(&bar[XB_TOPGEN], 1u);
            else XB_SPIN(xb_ld(&bar[XB_TOPGEN]) == tg, bar);
            __builtin_amdgcn_fence(__ATOMIC_ACQUIRE, "agent");
            xb_add(&bar[XB_XGEN(b.x)], 1u);
            asm volatile("s_waitcnt vmcnt(0)" ::: "memory");
        } else {
            XB_SPIN(xb_ld(&bar[XB_XGEN(b.x)]) == gen, bar);
            __builtin_amdgcn_fence(__ATOMIC_ACQUIRE, "agent");
            asm volatile("s_waitcnt vmcnt(0)" ::: "memory");
        }
    }
    __syncthreads();
}
DI void wmap(int mode, int c, int& src, float& scale, int& which) {
    src = c; scale = 1.f; which = 0;
    if (mode == 0) {
        if (c < 1024) { const int base = c & ~63, cc = c & 63, g = cc >> 3, e = cc & 7; src = base + (e < 4 ? 4 * g + e : 32 + 4 * g + (e - 4)); }
        if (c < 512) scale = 0.125f * LOG2E; else if (c >= 1536 && c < 2048) scale = 0.125f;
    } else if (mode == 2) { src = 4 * (c >> 3) + (c & 3); which = (c >> 2) & 1; }
    else if (mode == 3) { if (c >= SINW) src = -1; }
}
DI void wconv_tile(LAS float* tile, int mode, const float* W0, const float* W1, const float* kscale, bf16_t* dst, int K, int ldw, int tix) {
    const int tid = threadIdx.x, nk = K >> 8, c0 = (tix / nk) * 64, k0 = (tix % nk) * 256;
    const int cc = tid & 63; int src, which; float sc; wmap(mode, c0 + cc, src, sc, which);
    const float* W = (which ? W1 : W0) + (src >= 0 ? src : 0);
    float v[32];
#pragma unroll
    for (int i = 0; i < 32; ++i) { const int kk = (tid >> 6) + 8 * i; v[i] = W[(size_t)(k0 + kk) * ldw]; }
#pragma unroll
    for (int i = 0; i < 32; ++i) { const int kk = (tid >> 6) + 8 * i; float x = (src >= 0) ? v[i] * sc : 0.f; if (kscale) x *= kscale[k0 + kk]; tile[kk * 65 + cc] = x; }
    __syncthreads();
#pragma unroll
    for (int i = 0; i < 16; ++i) {
        const int idx = tid + 512 * i, c2 = idx >> 7, k2 = (idx & 127) * 2;
        *(unsigned*)(dst + (size_t)(c0 + c2) * K + k0 + k2) = pk2(tile[k2 * 65 + c2], tile[(k2 + 1) * 65 + c2]);
    }
    __syncthreads();
}
DI void phase0(LAS unsigned char* lds, const Params& p) {
    const int tid = threadIdx.x, G = gridDim.x, bx = blockIdx.x;
    unsigned char* ws = p.ws;
    const int cnt[8] = {48 * 4, 16 * 4, 88 * 4, 16 * 11, 100 * 4, 16 * 8, 88 * 4, 16 * 11};
    int total = 0;
#pragma unroll
    for (int j = 0; j < 8; ++j) total += cnt[j];
    for (int t = bx; t < total; t += G) {
        int j = 0, tt = t;
#pragma unroll
        for (int q = 0; q < 7; ++q) if (j == q && tt >= cnt[q]) { tt -= cnt[q]; j = q + 1; }
        LAS float* tile = (LAS float*)lds;
        switch (j) {
        case 0: wconv_tile(tile, 0, p.in[2], nullptr, p.in[1], (bf16_t*)(ws + W_AIN), DM, AINW, tt); break;
        case 1: wconv_tile(tile, 1, p.in[8], nullptr, nullptr, (bf16_t*)(ws + W_AOUT), DM, DM, tt); break;
        case 2: wconv_tile(tile, 2, p.in[19], p.in[20], p.in[18], (bf16_t*)(ws + W_GU0), DM, DFF, tt); break;
        case 3: wconv_tile(tile, 1, p.in[21], nullptr, nullptr, (bf16_t*)(ws + W_DN0), DFF, DM, tt); break;
        case 4: wconv_tile(tile, 3, p.in[10], nullptr, p.in[9], (bf16_t*)(ws + W_SIN), DM, SINW, tt); break;
        case 5: wconv_tile(tile, 1, p.in[17], nullptr, nullptr, (bf16_t*)(ws + W_SOUT), DIN, DM, tt); break;
        case 6: wconv_tile(tile, 2, p.in[19] + (size_t)DM * DFF, p.in[20] + (size_t)DM * DFF, p.in[18] + DM, (bf16_t*)(ws + W_GU1), DM, DFF, tt); break;
        default: wconv_tile(tile, 1, p.in[21] + (size_t)DFF * DM, nullptr, nullptr, (bf16_t*)(ws + W_DN1), DFF, DM, tt); break;
        }
    }
    {
        const int wave = tid >> 6, lane = tid & 63; bf16_t* hb = (bf16_t*)(ws + O_HB); float* ss = (float*)(ws + O_SS);
        for (int row = bx * 8 + wave; row < MT; row += G * 8) {
            const float* xr = p.in[0] + (size_t)row * DM; float sq = 0.f;
#pragma unroll
            for (int i = 0; i < 4; ++i) { const f32x4 v = *(const f32x4*)(xr + lane * 4 + 256 * i); sq += v[0] * v[0] + v[1] * v[1] + v[2] * v[2] + v[3] * v[3];
                u32x2 o; o[0] = pk2(v[0], v[1]); o[1] = pk2(v[2], v[3]); *(u32x2*)(hb + (size_t)row * DM + lane * 4 + 256 * i) = o; }
#pragma unroll
            for (int o = 32; o >= 1; o >>= 1) sq += __shfl_xor(sq, o);
            if (lane == 0) ss[row] = sq;
        }
        for (int i = bx * 512 + tid; i < 4 * MT; i += G * 512) ss[MT + i] = 0.f;
        f32x2* tab = (f32x2*)(ws + O_ROPE);
        for (int i = bx * 512 + tid; i < SEQ * 32; i += G * 512) {
            const int pos = i >> 5, f = i & 31; const float inv = fexp2(-(float)f * 0.41524101186092f); const float ang = (float)pos * inv;
            double t = (double)ang * 0.15915494309189535; t -= floor(t); const float tf = (float)t;
            f32x2 cs; cs[0] = __builtin_amdgcn_cosf(tf); cs[1] = __builtin_amdgcn_sinf(tf); tab[i] = cs;
        }
        if (bx == 0 && tid == 0) { float s1 = 0.f, s2 = 0.f; for (int i = 0; i < 64; ++i) { s1 += p.in[3][i] * p.in[4][i]; s2 += p.in[5][i] * p.in[6][i]; }
            *(float*)(ws + O_LAM) = fexp2(s1 * LOG2E) - fexp2(s2 * LOG2E) + 0.2f; }
    }
}

struct EpiAttnIn {
    static constexpr bool PERM = true, AFTER_DRAIN = false;
    bf16_t* O; const float* ss; const f32x4* tab;
    DI void operator()(const f32x4 (&acc)[2][2][4][2], const pg8::Unit& u, int wr, int wc, int fr, int fq) const {
        const int row0 = u.pm * 256 + wr * 64 + fr, colt = u.pn * 256, col0 = colt + wc * 32 + 8 * fq;
        const int fb = 4 * (4 * (wc & 1) + fq);
#pragma unroll
        for (int ai = 0; ai < 2; ++ai)
#pragma unroll
            for (int m = 0; m < 4; ++m) {
                const int row = row0 + ai * 128 + m * 16; const float rs = __builtin_amdgcn_rsqf(ss[row] * (1.0f / 1024.0f) + 1e-6f);
                f32x4 c01 = {1.f, 0.f, 1.f, 0.f}, c23 = {1.f, 0.f, 1.f, 0.f};
                if (colt < 1024) { const int pos = row & (SEQ - 1); c01 = tab[(pos * 32 + fb) >> 1]; c23 = tab[((pos * 32 + fb) >> 1) + 1]; }
#pragma unroll
                for (int bj = 0; bj < 2; ++bj) {
                    f32x4 v0 = acc[ai][bj][m][0] * rs, v1 = acc[ai][bj][m][1] * rs;
                    if (colt < 1024) {
                        const float cs[4] = {c01[0], c01[2], c23[0], c23[2]}, sn[4] = {c01[1], c01[3], c23[1], c23[3]};
#pragma unroll
                        for (int j = 0; j < 4; ++j) { const float t1 = v0[j], t2 = v1[j]; v0[j] = t1 * cs[j] - t2 * sn[j]; v1[j] = t2 * cs[j] + t1 * sn[j]; }
                    }
                    u32x4 o; o[0] = pk2(v0[0], v0[1]); o[1] = pk2(v0[2], v0[3]); o[2] = pk2(v1[0], v1[1]); o[3] = pk2(v1[2], v1[3]);
                    *(u32x4*)(O + (size_t)row * AINW + col0 + bj * 128) = o;
                }
            }
    }
};
template <bool RES_F32, bool OUT_F32> struct EpiRes {
    static constexpr bool PERM = false, AFTER_DRAIN = false;
    const float* xres; bf16_t* hb; float* outf; float* ssn;
    DI void operator()(const f32x4 (&acc)[2][2][4][2], const pg8::Unit& u, int wr, int wc, int fr, int fq) const {
        const int row0 = u.pm * 256 + wr * 64 + fr, col0 = u.pn * 256 + wc * 32 + 4 * fq;
#pragma unroll
        for (int ai = 0; ai < 2; ++ai)
#pragma unroll
            for (int m = 0; m < 4; ++m) {
                const int row = row0 + ai * 128 + m * 16; float sq = 0.f;
#pragma unroll
                for (int bj = 0; bj < 2; ++bj)
#pragma unroll
                    for (int n = 0; n < 2; ++n) {
                        const size_t off = (size_t)row * DM + col0 + bj * 128 + n * 16; f32x4 r;
                        if (RES_F32) r = *(const f32x4*)(xres + off);
                        else { const u32x2 t = *(const u32x2*)(hb + off); r[0] = bflo(t[0]); r[1] = bfhi(t[0]); r[2] = bflo(t[1]); r[3] = bfhi(t[1]); }
                        const f32x4 v = r + acc[ai][bj][m][n];
                        sq += v[0] * v[0] + v[1] * v[1] + v[2] * v[2] + v[3] * v[3];
                        if (OUT_F32) *(f32x4*)(outf + off) = v;
                        else { u32x2 o; o[0] = pk2(v[0], v[1]); o[1] = pk2(v[2], v[3]); *(u32x2*)(hb + off) = o; }
                    }
                sq += __shfl_xor(sq, 16); sq += __shfl_xor(sq, 32);
                if (fq == 0) atomicAdd(ssn + row, sq);
            }
    }
};
struct EpiGU {
    static constexpr bool PERM = true, AFTER_DRAIN = false;
    bf16_t* act; const float* ss;
    DI void operator()(const f32x4 (&acc)[2][2][4][2], const pg8::Unit& u, int wr, int wc, int fr, int fq) const {
        const int row0 = u.pm * 256 + wr * 64 + fr, col0 = u.pn * 256 + wc * 32 + 8 * fq;
#pragma unroll
        for (int ai = 0; ai < 2; ++ai)
#pragma unroll
            for (int m = 0; m < 4; ++m) {
                const int row = row0 + ai * 128 + m * 16; const float rs = __builtin_amdgcn_rsqf(ss[row] * (1.0f / 1024.0f) + 1e-6f);
#pragma unroll
                for (int bj = 0; bj < 2; ++bj) {
                    const f32x4 g = acc[ai][bj][m][0] * rs, up = acc[ai][bj][m][1] * rs; float a[4];
#pragma unroll
                    for (int j = 0; j < 4; ++j) a[j] = fsilu(g[j]) * up[j];
                    u32x2 o; o[0] = pk2(a[0], a[1]); o[1] = pk2(a[2], a[3]);
                    *(u32x2*)(act + (size_t)row * DFF + ((col0 + bj * 128) >> 1)) = o;
                }
            }
    }
};
struct EpiSsdIn {
    static constexpr bool PERM = true, AFTER_DRAIN = false;
    bf16_t* z; bf16_t* xbc; float* dt; const float* ss;
    DI void operator()(const f32x4 (&acc)[2][2][4][2], const pg8::Unit& u, int wr, int wc, int fr, int fq) const {
        const int row0 = u.pm * 256 + wr * 64 + fr, col0 = u.pn * 256 + wc * 32 + 8 * fq;
#pragma unroll
        for (int ai = 0; ai < 2; ++ai)
#pragma unroll
            for (int m = 0; m < 4; ++m) {
                const int row = row0 + ai * 128 + m * 16; const float rs = __builtin_amdgcn_rsqf(ss[row] * (1.0f / 1024.0f) + 1e-6f);
#pragma unroll
                for (int bj = 0; bj < 2; ++bj) {
                    const int c = col0 + bj * 128; const f32x4 v0 = acc[ai][bj][m][0] * rs, v1 = acc[ai][bj][m][1] * rs;
                    if (c < 6144) { u32x4 o; o[0] = pk2(v0[0], v0[1]); o[1] = pk2(v0[2], v0[3]); o[2] = pk2(v1[0], v1[1]); o[3] = pk2(v1[2], v1[3]);
                        if (c < DIN) *(u32x4*)(z + (size_t)row * DIN + c) = o; else *(u32x4*)(xbc + (size_t)row * XBCW + (c - DIN)) = o; }
                    else if (c < SINW) { *(f32x4*)(dt + (size_t)row * 32 + (c - 6144)) = v0; *(f32x4*)(dt + (size_t)row * 32 + (c - 6144) + 4) = v1; }
                }
            }
    }
};
constexpr int KST = 144, VST = 272, VST64 = 144;
constexpr int AT_K1 = 0, AT_K2 = 64 * KST, AT_V = 2 * 64 * KST, AT_STAGE = AT_V + 64 * VST;

DI void diff_tile(LAS unsigned char* lds, const bf16_t* proj, bf16_t* mixed, const float* subln, float lam, int b, int hd, int qt) {
    const int tid = threadIdx.x, w = __builtin_amdgcn_readfirstlane(tid >> 6), lane = tid & 63, qg = w & 3, mp = w >> 2, r = lane & 31, h = lane >> 5;
    const int q0 = qt * 128; const size_t rowb = (size_t)b * SEQ;
    bf16x8 qf[4];
    { const bf16_t* qp = proj + (rowb + q0 + 32 * qg + r) * AINW + hd * 128 + mp * 64 + 8 * h;
#pragma unroll
      for (int s = 0; s < 4; ++s) qf[s] = *(const bf16x8*)(qp + 16 * s); }
    f32x16 O[4];
#pragma unroll
    for (int i = 0; i < 4; ++i) O[i] = zero16();
    float mrun = -1e30f, lrun = 0.f;
    const int nsteps = 2 * (qt + 1);
    const bf16_t* src[4]; int dst[4];
#pragma unroll
    for (int i = 0; i < 2; ++i) { const int cid = tid + 512 * i, row = cid >> 4, c16 = cid & 15;
        src[i] = proj + (rowb + row) * AINW + 512 + hd * 128 + c16 * 8; dst[i] = (c16 < 8 ? AT_K1 : AT_K2) + row * KST + (c16 & 7) * 16;
        src[2 + i] = proj + (rowb + row) * AINW + 1024 + hd * 128 + c16 * 8; dst[2 + i] = AT_V + row * VST + c16 * 16; }
    u32x4 pf[4];
#pragma unroll
    for (int i = 0; i < 4; ++i) pf[i] = *(const u32x4*)(src[i]);
#pragma unroll
    for (int i = 0; i < 4; ++i) *(LAS u32x4*)(lds + dst[i]) = pf[i];
    __syncthreads();
    const int i16 = lane & 15, tq = i16 >> 2, tp = i16 & 3, g16 = (lane >> 4) & 1;
    const int troff = (4 * h + tq) * VST + (16 * g16 + 4 * tp) * 2;
    for (int j = 0; j < nsteps; ++j) {
        const bool more = (j + 1 < nsteps);
        if (more) {
#pragma unroll
            for (int i = 0; i < 4; ++i) pf[i] = *(const u32x4*)(src[i] + (size_t)(j + 1) * 64 * AINW);
        }
        const LAS unsigned char* base = lds + (j & 1) * AT_STAGE;
        const LAS unsigned char* Kb = base + (mp ? AT_K2 : AT_K1);
        const LAS unsigned char* Vb = base + AT_V;
        f32x16 S[2];
#pragma unroll
        for (int kt = 0; kt < 2; ++kt) { S[kt] = zero16();
#pragma unroll
            for (int s = 0; s < 4; ++s) { const bf16x8 kf = *(const LAS bf16x8*)(Kb + (32 * kt + r) * KST + (16 * s + 8 * h) * 2); S[kt] = MFMA32(kf, qf[s], S[kt]); } }
        const int qidx = q0 + 32 * qg + r, kbase = 64 * j;
        if (kbase + 63 > q0 + 32 * qg) {
#pragma unroll
            for (int kt = 0; kt < 2; ++kt)
#pragma unroll
                for (int i = 0; i < 16; ++i) if (kbase + 32 * kt + crow(i, h) > qidx) S[kt][i] = -1e30f;
        }
        float mx = S[0][0];
#pragma unroll
        for (int kt = 0; kt < 2; ++kt)
#pragma unroll
            for (int i = 0; i < 16; ++i) mx = fmaxf(mx, S[kt][i]);
        mx = fmaxf(mx, __shfl_xor(mx, 32));
        const float mnew = fmaxf(mrun, mx), alpha = fexp2(mrun - mnew); mrun = mnew;
        float ls = 0.f;
#pragma unroll
        for (int kt = 0; kt < 2; ++kt)
#pragma unroll
            for (int i = 0; i < 16; ++i) { const float pv = fexp2(S[kt][i] - mnew); S[kt][i] = pv; ls += pv; }
        lrun = lrun * alpha + ls;
#pragma unroll
        for (int vt = 0; vt < 4; ++vt) O[vt] = O[vt] * alpha;
#pragma unroll
        for (int kt = 0; kt < 2; ++kt)
#pragma unroll
            for (int s2 = 0; s2 < 2; ++s2) {
                const bf16x8 pfr = pack8(S[kt], s2);
                const LAS unsigned char* vrow = Vb + (32 * kt + 16 * s2) * VST + troff;
#pragma unroll
                for (int vt = 0; vt < 4; ++vt) { const bf16x8 vf = tr2(vrow + vt * 64, vrow + 8 * VST + vt * 64); O[vt] = MFMA32(vf, pfr, O[vt]); }
            }
        if (more) {
            LAS unsigned char* nb = lds + ((j + 1) & 1) * AT_STAGE;
#pragma unroll
            for (int i = 0; i < 4; ++i) *(LAS u32x4*)(nb + dst[i]) = pf[i];
        }
        __syncthreads();
    }
    lrun += __shfl_xor(lrun, 32);
    const float inv = frcp(lrun);
    LAS float* ex = (LAS float*)lds;
    if (mp == 1) {
        const float sc = inv * lam;
#pragma unroll
        for (int vt = 0; vt < 4; ++vt)
#pragma unroll
            for (int i = 0; i < 16; ++i) ex[(qg * 128 + 32 * vt + crow(i, h)) * 32 + r] = O[vt][i] * sc;
    }
    __syncthreads();
    if (mp == 0) {
        float sq = 0.f;
#pragma unroll
        for (int vt = 0; vt < 4; ++vt)
#pragma unroll
            for (int i = 0; i < 16; ++i) { const float o = O[vt][i] * inv - ex[(qg * 128 + 32 * vt + crow(i, h)) * 32 + r]; O[vt][i] = o; sq += o * o; }
        sq += __shfl_xor(sq, 32);
        const float rn = __builtin_amdgcn_rsqf(sq * (1.0f / 128.0f) + 1e-5f) * 0.8f;
        bf16_t* op = mixed + (rowb + q0 + 32 * qg + r) * DM + hd * 128;
#pragma unroll
        for (int vt = 0; vt < 4; ++vt)
#pragma unroll
            for (int gq = 0; gq < 4; ++gq) { const int v0 = 32 * vt + 8 * gq + 4 * h; const f32x4 wv = *(const f32x4*)(subln + v0);
                u32x2 o; o[0] = pk2(O[vt][4 * gq] * rn * wv[0], O[vt][4 * gq + 1] * rn * wv[1]); o[1] = pk2(O[vt][4 * gq + 2] * rn * wv[2], O[vt][4 * gq + 3] * rn * wv[3]);
                *(u32x2*)(op + v0) = o; }
    }
    __syncthreads();
}

constexpr int SB_K = 0, SB_V = 64 * KST, SB_STAGE = 2 * 64 * KST;
DI void sb_block(LAS unsigned char* lds, const bf16_t* proj, bf16_t* mixed, int b, int hs, int qb) {
    const int tid = threadIdx.x, w = __builtin_amdgcn_readfirstlane(tid >> 6), lane = tid & 63, r = lane & 31, h = lane >> 5;
    const int q0 = qb * 256; const size_t rowb = (size_t)b * SEQ;
    const int qidx = q0 + 32 * w + r;
    bf16x8 qf[4];
    { const bf16_t* qp = proj + (rowb + qidx) * AINW + 1536 + hs * 64 + 8 * h;
#pragma unroll
      for (int s = 0; s < 4; ++s) qf[s] = *(const bf16x8*)(qp + 16 * s); }
    f32x16 O[2]; O[0] = zero16(); O[1] = zero16();
    float carry = 1.0f;
    const int jmax = 4 * qb + 3;
    const int srow = tid >> 3, sc8 = tid & 7;
    const bf16_t* srcK = proj + (rowb + srow) * AINW + 2048 + hs * 64 + sc8 * 8;
    const bf16_t* srcV = proj + (rowb + srow) * AINW + 2560 + hs * 64 + sc8 * 8;
    const int dstK = SB_K + srow * KST + sc8 * 16, dstV = SB_V + srow * VST64 + sc8 * 16;
    u32x4 pk_ = *(const u32x4*)(srcK + (size_t)jmax * 64 * AINW), pv_ = *(const u32x4*)(srcV + (size_t)jmax * 64 * AINW);
    *(LAS u32x4*)(lds + dstK) = pk_; *(LAS u32x4*)(lds + dstV) = pv_;
    __syncthreads();
    const int i16 = lane & 15, tq = i16 >> 2, tp = i16 & 3, g16 = (lane >> 4) & 1;
    const int troff = (4 * h + tq) * VST64 + (16 * g16 + 4 * tp) * 2;
    int it = 0;
    for (int j = jmax; j >= 0; --j, ++it) {
        const bool more = (j > 0);
        if (more) { pk_ = *(const u32x4*)(srcK + (size_t)(j - 1) * 64 * AINW); pv_ = *(const u32x4*)(srcV + (size_t)(j - 1) * 64 * AINW); }
        const LAS unsigned char* base = lds + (it & 1) * SB_STAGE;
        const int kbase = 64 * j;
        if (kbase < q0 + 32 * w + 32) {
#pragma unroll
            for (int kt = 1; kt >= 0; --kt) {
                f32x16 S = zero16();
#pragma unroll
                for (int s = 0; s < 4; ++s) { const bf16x8 kf = *(const LAS bf16x8*)(base + SB_K + (32 * kt + r) * KST + (16 * s + 8 * h) * 2); S = MFMA32(kf, qf[s], S); }
                float T[4], sfx[16];
#pragma unroll
                for (int gq = 0; gq < 4; ++gq) {
                    float run = 1.0f;
#pragma unroll
                    for (int jj = 3; jj >= 0; --jj) {
                        const int i = 4 * gq + jj; const bool valid = (kbase + 32 * kt + crow(i, h)) < qidx;
                        const float zz = fmaxf(S[i], -60.0f); const float e = fexp2(-LOG2E * zz); const float sg = frcp(1.0f + e);
                        const float keep = valid ? e * sg : 1.0f;
                        S[i] = valid ? sg : 0.0f; sfx[i] = run; run *= keep;
                    }
                    T[gq] = run;
                }
                float To[4];
#pragma unroll
                for (int gq = 0; gq < 4; ++gq) To[gq] = __shfl_xor(T[gq], 32);
                float E[4]; float acc_hi = 1.0f;
#pragma unroll
                for (int gq = 3; gq >= 0; --gq) {
                    const float above_same = acc_hi;
                    E[gq] = (h == 0) ? above_same * To[gq] : above_same;
                    acc_hi = acc_hi * T[gq] * To[gq];
                }
#pragma unroll
                for (int i = 0; i < 16; ++i) S[i] = S[i] * carry * E[i >> 2] * sfx[i];
                carry *= acc_hi;
#pragma unroll
                for (int s2 = 0; s2 < 2; ++s2) {
                    const bf16x8 pfr = pack8(S, s2);
                    const LAS unsigned char* vrow = base + SB_V + (32 * kt + 16 * s2) * VST64 + troff;
#pragma unroll
                    for (int vt = 0; vt < 2; ++vt) { const bf16x8 vf = tr2(vrow + vt * 64, vrow + 8 * VST64 + vt * 64); O[vt] = MFMA32(vf, pfr, O[vt]); }
                }
            }
        }
        if (more) { LAS unsigned char* nb = lds + ((it + 1) & 1) * SB_STAGE; *(LAS u32x4*)(nb + dstK) = pk_; *(LAS u32x4*)(nb + dstV) = pv_; }
        const int done = (kbase < q0 + 32 * w + 32) && (carry < 1e-12f);
        const bool wdone = (__builtin_amdgcn_ballot_w64(done != 0) == ~0ull);
        LAS int* flg = (LAS int*)(lds + 2 * SB_STAGE) + (it & 1) * 8;
        if (lane == 0) flg[w] = wdone ? 1 : 0;
        __syncthreads();
        int all = 1;
#pragma unroll
        for (int ww = 0; ww < 8; ++ww) all &= flg[ww];
        if (all) break;
    }
    bf16_t* op = mixed + (rowb + qidx) * DM + 512 + hs * 64;
#pragma unroll
    for (int vt = 0; vt < 2; ++vt)
#pragma unroll
        for (int gq = 0; gq < 4; ++gq) { const int v0 = 32 * vt + 8 * gq + 4 * h;
            u32x2 o; o[0] = pk2(O[vt][4 * gq], O[vt][4 * gq + 1]); o[1] = pk2(O[vt][4 * gq + 2], O[vt][4 * gq + 3]); *(u32x2*)(op + v0) = o; }
    __syncthreads();
}
DI void attn_phase(LAS unsigned char* lds, const Params& p) {
    const bf16_t* proj = (const bf16_t*)(p.ws + O_PROJ); bf16_t* mixed = (bf16_t*)(p.ws + O_MIXED);
    const float lam = *(const float*)(p.ws + O_LAM);
    for (int it = blockIdx.x; it < 256; it += gridDim.x) {
        const int b = it >> 7, hd = (it >> 5) & 3, pr = it & 31;
        diff_tile(lds, proj, mixed, p.in[7], lam, b, hd, 63 - pr);
        diff_tile(lds, proj, mixed, p.in[7], lam, b, hd, pr);
    }
    for (int it = blockIdx.x; it < 512; it += gridDim.x) {
        const int b = it >> 8, hs = (it >> 5) & 7, qb = it & 31;
        sb_block(lds, proj, mixed, b, hs, qb);
    }
}
constexpr int SXS = 528, SBS = 272;
constexpr int L_SX = 0, L_SB = 128 * SXS, L_SC = L_SB + 128 * SBS, L_SDT = L_SC + 128 * SBS, L_SAC = L_SDT + 2048, L_SSQ = L_SAC + 2048;
static_assert(L_SSQ + 4096 <= LDS_BYTES, "lds");

DI void ssd_dt_acum(LAS unsigned char* lds, const float* DT, const float* dt_bias, const float* a_log, size_t t0, int g) {
    LAS float* sdt = (LAS float*)(lds + L_SDT); LAS float* sac = (LAS float*)(lds + L_SAC);
    const int tid = threadIdx.x, hh = tid >> 7, l = tid & 127, head = 4 * g + hh, w = tid >> 6, lane = tid & 63;
    const float raw = DT[(t0 + l) * 32 + head] + dt_bias[head];
    const float dt = fmaxf(raw, 0.f) + __logf(1.0f + __expf(-fabsf(raw)));
    sdt[hh * 128 + l] = dt; sac[hh * 128 + l] = -dt * __expf(a_log[head]);
    __syncthreads();
    if (w < 4) {
        const float v0 = sac[w * 128 + 2 * lane], v1 = sac[w * 128 + 2 * lane + 1]; float s = v0 + v1;
#pragma unroll
        for (int off = 1; off < 64; off <<= 1) { const float t = __shfl_up(s, off); if (lane >= off) s += t; }
        const float ex = s - (v0 + v1);
        sac[w * 128 + 2 * lane] = ex + v0; sac[w * 128 + 2 * lane + 1] = ex + v0 + v1;
    }
    __syncthreads();
}
template <int NT, class F> DI void conv_strip(const bf16_t* src, int nzero, const float* cw, const float* cb, int ch, F&& emit) {
    f32x4 wlo[4], whi[4];
#pragma unroll
    for (int k = 0; k < 4; ++k) { wlo[k] = *(const f32x4*)(cw + k * XBCW + ch); whi[k] = *(const f32x4*)(cw + k * XBCW + ch + 4); }
    const f32x4 blo = *(const f32x4*)(cb + ch), bhi = *(const f32x4*)(cb + ch + 4);
    u32x4 raw[NT + 3];
#pragma unroll
    for (int i = 0; i < NT + 3; ++i) { const int ii = (i < nzero) ? nzero : i; raw[i] = *(const u32x4*)(src + (ptrdiff_t)(ii - 3) * XBCW); if (i < nzero) raw[i] = (u32x4){0u, 0u, 0u, 0u}; }
#pragma unroll
    for (int t = 0; t < NT; ++t) {
        float o[8];
#pragma unroll
        for (int e = 0; e < 8; ++e) {
            float a = (e < 4) ? blo[e & 3] : bhi[e & 3];
#pragma unroll
            for (int k = 0; k < 4; ++k) { const unsigned d = raw[t + k][e >> 1]; const float xv = (e & 1) ? bfhi(d) : bflo(d); a += ((e < 4) ? wlo[k][e & 3] : whi[k][e & 3]) * xv; }
            o[e] = fsilu(a);
        }
        emit(t, o);
    }
}
DI u32x4 pack8f(const float* o) { u32x4 r; r[0] = pk2(o[0], o[1]); r[1] = pk2(o[2], o[3]); r[2] = pk2(o[4], o[5]); r[3] = pk2(o[6], o[7]); return r; }

template <bool XW, bool WITH_C> DI void ssd_stage(LAS unsigned char* lds, const bf16_t* xbc, const float* cw, const float* cb, size_t t0, int c, int g) {
    const int tid = threadIdx.x;
    LAS float* sdt = (LAS float*)(lds + L_SDT); LAS float* sac = (LAS float*)(lds + L_SAC);
    {
        const int c8 = tid & 31, tg = tid >> 5, l0 = 8 * tg, ch = 256 * g + 8 * c8, hh = c8 >> 3;
        const int nzero = (c == 0) ? (3 - l0 > 0 ? 3 - l0 : 0) : 0;
        const float alast = sac[hh * 128 + 127];
        conv_strip<8>(xbc + (t0 + l0) * XBCW + ch, nzero, cw, cb, ch, [&](int t, float* o) {
            if (XW) { const float wgt = sdt[hh * 128 + l0 + t] * __expf(alast - sac[hh * 128 + l0 + t]);
#pragma unroll
                for (int e = 0; e < 8; ++e) o[e] *= wgt; }
            *(LAS u32x4*)(lds + L_SX + (l0 + t) * SXS + c8 * 16) = pack8f(o); });
    }
    {
        const int c8 = tid & 15, tg = tid >> 4, l0 = 4 * tg;
        const int nzero = (c == 0) ? (3 - l0 > 0 ? 3 - l0 : 0) : 0;
        const int chb = DIN + 128 * g + 8 * c8;
        conv_strip<4>(xbc + (t0 + l0) * XBCW + chb, nzero, cw, cb, chb, [&](int t, float* o) { *(LAS u32x4*)(lds + L_SB + (l0 + t) * SBS + c8 * 16) = pack8f(o); });
        if (WITH_C) { const int chc = DIN + 1024 + 128 * g + 8 * c8;
            conv_strip<4>(xbc + (t0 + l0) * XBCW + chc, nzero, cw, cb, chc, [&](int t, float* o) { *(LAS u32x4*)(lds + L_SC + (l0 + t) * SBS + c8 * 16) = pack8f(o); }); }
    }
}
DI bf16_t* st_ptr(unsigned char* ws, int b) { return (bf16_t*)(ws + (b ? O_ST1 : O_ST0)); }

DI void ssd_states_phase(LAS unsigned char* lds, const Params& p) {
    const int tid = threadIdx.x, w = __builtin_amdgcn_readfirstlane(tid >> 6), lane = tid & 63, r = lane & 31, h = lane >> 5, hh = w >> 1, ph = w & 1;
    const bf16_t* xbc = (const bf16_t*)(p.ws + O_XBC); const float* DT = (const float*)(p.ws + O_DT); float* cdec = (float*)(p.ws + O_CDEC);
    const int i16 = lane & 15, tq = i16 >> 2, tp = i16 & 3, g16 = (lane >> 4) & 1;
    for (int it = blockIdx.x; it < 1024; it += gridDim.x) {
        const int b = it >> 9, c = (it >> 3) & 63, g = it & 7; const size_t t0 = (size_t)b * SEQ + (size_t)c * 128;
        ssd_dt_acum(lds, DT, p.in[13], p.in[14], t0, g);
        ssd_stage<true, false>(lds, xbc, p.in[11], p.in[12], t0, c, g);
        __syncthreads();
        f32x16 acc[4];
#pragma unroll
        for (int i = 0; i < 4; ++i) acc[i] = zero16();
        const LAS unsigned char* xa = lds + L_SX + (8 * h + tq) * SXS + (64 * hh + 32 * ph + 16 * g16 + 4 * tp) * 2;
        const LAS unsigned char* ba = lds + L_SB + (8 * h + tq) * SBS + (16 * g16 + 4 * tp) * 2;
#pragma unroll
        for (int s = 0; s < 8; ++s) {
            const bf16x8 af = tr2(xa + 16 * s * SXS, xa + (16 * s + 4) * SXS);
#pragma unroll
            for (int nt = 0; nt < 4; ++nt) { const bf16x8 bfr = tr2(ba + 16 * s * SBS + nt * 64, ba + (16 * s + 4) * SBS + nt * 64); acc[nt] = MFMA32(af, bfr, acc[nt]); }
        }
        bf16_t* st = st_ptr(p.ws, b) + ((size_t)(c * 32 + 4 * g + hh) * 64 + 32 * ph) * 128;
#pragma unroll
        for (int nt = 0; nt < 4; ++nt)
#pragma unroll
            for (int i = 0; i < 16; ++i) st[(size_t)crow(i, h) * 128 + 32 * nt + r] = (bf16_t)(pk2(acc[nt][i], 0.f) & 0xffffu);
        if (tid < 4) cdec[(b * 64 + c) * 32 + 4 * g + tid] = __expf(((LAS float*)(lds + L_SAC))[tid * 128 + 127]);
        __syncthreads();
    }
}
DI void ssd_scan_phase(const Params& p) {
    const float* cdec = (const float*)(p.ws + O_CDEC);
    for (int e = blockIdx.x * 512 + threadIdx.x; e < 2 * 32 * 64 * 32; e += gridDim.x * 512) {
        const int b = e >> 16, rem = e & 65535, head = rem >> 11;
        bf16_t* st = st_ptr(p.ws, b) + (size_t)rem * 4;
        float carry[4] = {0.f, 0.f, 0.f, 0.f};
        for (int c0 = 0; c0 < 64; c0 += 8) {
            u32x2 v[8]; float dc[8];
#pragma unroll
            for (int u = 0; u < 8; ++u) { v[u] = *(const u32x2*)(st + (size_t)(c0 + u) * 262144); dc[u] = cdec[(b * 64 + c0 + u) * 32 + head]; }
#pragma unroll
            for (int u = 0; u < 8; ++u) {
                u32x2 o; o[0] = pk2(carry[0], carry[1]); o[1] = pk2(carry[2], carry[3]); *(u32x2*)(st + (size_t)(c0 + u) * 262144) = o;
                carry[0] = carry[0] * dc[u] + bflo(v[u][0]); carry[1] = carry[1] * dc[u] + bfhi(v[u][0]); carry[2] = carry[2] * dc[u] + bflo(v[u][1]); carry[3] = carry[3] * dc[u] + bfhi(v[u][1]);
            }
        }
    }
}
DI void ssd_out_phase(LAS unsigned char* lds, const Params& p) {
    const int tid = threadIdx.x, w = __builtin_amdgcn_readfirstlane(tid >> 6), lane = tid & 63, r = lane & 31, h = lane >> 5, hh = w >> 1, ph = w & 1;
    const bf16_t* xbc = (const bf16_t*)(p.ws + O_XBC); const float* DT = (const float*)(p.ws + O_DT); bf16_t* zy = (bf16_t*)p.out;
    LAS float* sdt = (LAS float*)(lds + L_SDT); LAS float* sac = (LAS float*)(lds + L_SAC); LAS float* ssq = (LAS float*)(lds + L_SSQ);
    const int i16 = lane & 15, tq = i16 >> 2, tp = i16 & 3, g16 = (lane >> 4) & 1;
    for (int it = blockIdx.x; it < 1024; it += gridDim.x) {
        const int b = it >> 9, c = (it >> 3) & 63, g = it & 7, head = 4 * g + hh; const size_t t0 = (size_t)b * SEQ + (size_t)c * 128;
        ssd_dt_acum(lds, DT, p.in[13], p.in[14], t0, g);
        ssd_stage<false, true>(lds, xbc, p.in[11], p.in[12], t0, c, g);
        bf16x8 pvf[8];
        { const bf16_t* pp = st_ptr(p.ws, b) + ((size_t)(c * 32 + head) * 64 + 32 * ph + r) * 128 + 8 * h;
#pragma unroll
          for (int s = 0; s < 8; ++s) pvf[s] = *(const bf16x8*)(pp + 16 * s); }
        __syncthreads();
        f32x16 Y[4];
        const LAS unsigned char* xa = lds + L_SX + (4 * h + tq) * SXS + (64 * hh + 32 * ph + 16 * g16 + 4 * tp) * 2;
#pragma unroll
        for (int lt = 0; lt < 4; ++lt) {
            __builtin_amdgcn_sched_barrier(0);
            f32x16 y = zero16();
#pragma unroll
            for (int s = 0; s < 8; ++s) { const bf16x8 cfs = *(const LAS bf16x8*)(lds + L_SC + (32 * lt + r) * SBS + (16 * s + 8 * h) * 2); y = MFMA32(pvf[s], cfs, y); }
            Y[lt] = y * __expf(sac[hh * 128 + 32 * lt + r]);
        }
#pragma unroll
        for (int lt = 0; lt < 4; ++lt) {
            __builtin_amdgcn_sched_barrier(0);
            bf16x8 cf[8];
#pragma unroll
            for (int s = 0; s < 8; ++s) cf[s] = *(const LAS bf16x8*)(lds + L_SC + (32 * lt + r) * SBS + (16 * s + 8 * h) * 2);
            const float al = sac[hh * 128 + 32 * lt + r];
#pragma unroll
            for (int mt = 0; mt < 4; ++mt) {
                if (mt <= lt) {
                    __builtin_amdgcn_sched_barrier(0);
                    f32x16 X = zero16();
#pragma unroll
                    for (int s = 0; s < 8; ++s) { const bf16x8 bfr = *(const LAS bf16x8*)(lds + L_SB + (32 * mt + r) * SBS + (16 * s + 8 * h) * 2); X = MFMA32(bfr, cf[s], X); }
#pragma unroll
                    for (int gq = 0; gq < 4; ++gq) {
                        const f32x4 am = *(const LAS f32x4*)(sac + hh * 128 + 32 * mt + 8 * gq + 4 * h), dm = *(const LAS f32x4*)(sdt + hh * 128 + 32 * mt + 8 * gq + 4 * h);
#pragma unroll
                        for (int jj = 0; jj < 4; ++jj) { const int mrow = 32 * mt + 8 * gq + 4 * h + jj; const bool ok = (32 * lt + r) >= mrow;
                            const float dec = ok ? __expf(fminf(al - am[jj], 0.f)) * dm[jj] : 0.f; X[4 * gq + jj] *= dec; }
                    }
#pragma unroll
                    for (int s2 = 0; s2 < 2; ++s2) { const bf16x8 xs = pack8(X, s2);
                        const LAS unsigned char* xr = xa + (32 * mt + 16 * s2) * SXS; const bf16x8 xf = tr2(xr, xr + 8 * SXS); Y[lt] = MFMA32(xf, xs, Y[lt]); }
                }
            }
        }
        __builtin_amdgcn_sched_barrier(0);
        const float Dh = p.in[15][head];
        float sq[4];
#pragma unroll
        for (int lt = 0; lt < 4; ++lt) {
            const int l = 32 * lt + r; sq[lt] = 0.f;
#pragma unroll
            for (int gq = 0; gq < 4; ++gq) {
                const int chl = 64 * hh + 32 * ph + 8 * gq + 4 * h;
                const u32x2 xv = *(const LAS u32x2*)(lds + L_SX + l * SXS + chl * 2);
                const u32x2 zv = *(const u32x2*)(zy + (t0 + l) * DIN + 256 * g + chl);
                const float xf4[4] = {bflo(xv[0]), bfhi(xv[0]), bflo(xv[1]), bfhi(xv[1])}, zf4[4] = {bflo(zv[0]), bfhi(zv[0]), bflo(zv[1]), bfhi(zv[1])};
#pragma unroll
                for (int jj = 0; jj < 4; ++jj) { const float yv = (Y[lt][4 * gq + jj] + Dh * xf4[jj]) * fsilu(zf4[jj]); Y[lt][4 * gq + jj] = yv; sq[lt] += yv * yv; }
            }
            sq[lt] += __shfl_xor(sq[lt], 32);
            if (h == 0) ssq[w * 128 + l] = sq[lt];
        }
        __syncthreads();
#pragma unroll
        for (int lt = 0; lt < 4; ++lt) {
            const int l = 32 * lt + r; float tot = 0.f;
#pragma unroll
            for (int ww = 0; ww < 8; ++ww) tot += ssq[ww * 128 + l];
            const float rn = __builtin_amdgcn_rsqf(tot * (1.0f / 256.0f) + 1e-5f);
#pragma unroll
            for (int gq = 0; gq < 4; ++gq) {
                const int chl = 64 * hh + 32 * ph + 8 * gq + 4 * h; const f32x4 gw = *(const f32x4*)(p.in[16] + 256 * g + chl);
                u32x2 o; o[0] = pk2(Y[lt][4 * gq] * rn * gw[0], Y[lt][4 * gq + 1] * rn * gw[1]); o[1] = pk2(Y[lt][4 * gq + 2] * rn * gw[2], Y[lt][4 * gq + 3] * rn * gw[3]);
                *(u32x2*)(zy + (t0 + l) * DIN + 256 * g + chl) = o;
            }
        }
        __syncthreads();
    }
}
template <class Epi> DI void run_gemm(LAS unsigned char* lds, const bf16_t* A, const bf16_t* Bt, int N, int K, const Epi& E) {
    pg8::Gemm g; g.A = A; g.Bt = Bt; g.M = MT; g.N = N; g.K = K;
    pg8::StaticOrder S; S.init(MT, N, (int)gridDim.x, (int)blockIdx.x);
    pg8::gemm_phase<Epi, pg8::StaticOrder, false>((PG8_LAS unsigned char*)lds, g, S, E, nullptr);
}
__global__ void __launch_bounds__(512, 2) fwd_megakernel(Params p) {
    extern __shared__ __attribute__((aligned(16))) unsigned char shm[];
    LAS unsigned char* lds = (LAS unsigned char*)shm;
    cg::grid_group grid = cg::this_grid();
    if (threadIdx.x < 4) ((LAS unsigned*)(lds + LDS_BYTES - 16))[threadIdx.x] = 0u;
    __syncthreads();
    const XcdBarrier xbar = xcd_barrier_post((unsigned*)(p.ws + O_BAR), (volatile LAS unsigned*)(lds + LDS_BYTES - 16));
#define GBAR() xcd_barrier(xbar)
    unsigned char* ws = p.ws;
    bf16_t* hb = (bf16_t*)(ws + O_HB); float* ss = (float*)(ws + O_SS);
    phase0(lds, p);
#ifdef DUP_P0
    GBAR(); phase0(lds, p);
#endif
    grid.sync();
    { EpiAttnIn E; E.O = (bf16_t*)(ws + O_PROJ); E.ss = ss; E.tab = (const f32x4*)(ws + O_ROPE); run_gemm(lds, hb, (const bf16_t*)(ws + W_AIN), AINW, DM, E); }
    GBAR();
    attn_phase(lds, p);
#ifdef DUP_ATTN
    GBAR(); attn_phase(lds, p);
#endif
    GBAR();
    { EpiRes<true, false> E; E.xres = p.in[0]; E.hb = hb; E.outf = nullptr; E.ssn = ss + MT; run_gemm(lds, (const bf16_t*)(ws + O_MIXED), (const bf16_t*)(ws + W_AOUT), DM, DM, E); }
    GBAR();
    { EpiGU E; E.act = (bf16_t*)(ws + O_ACT); E.ss = ss + MT; run_gemm(lds, hb, (const bf16_t*)(ws + W_GU0), 2 * DFF, DM, E); }
    GBAR();
    { EpiRes<false, false> E; E.xres = nullptr; E.hb = hb; E.outf = nullptr; E.ssn = ss + 2 * MT; run_gemm(lds, (const bf16_t*)(ws + O_ACT), (const bf16_t*)(ws + W_DN0), DM, DFF, E); }
    GBAR();
    { EpiSsdIn E; E.z = (bf16_t*)p.out; E.xbc = (bf16_t*)(ws + O_XBC); E.dt = (float*)(ws + O_DT); E.ss = ss + 2 * MT; run_gemm(lds, hb, (const bf16_t*)(ws + W_SIN), SINWP, DM, E); }
    GBAR();
    ssd_states_phase(lds, p);
#ifdef DUP_S2
    GBAR(); ssd_states_phase(lds, p);
#endif
    GBAR();
    ssd_scan_phase(p);
    GBAR();
    ssd_out_phase(lds, p);
    GBAR();
    { EpiRes<false, false> E; E.xres = nullptr; E.hb = hb; E.outf = nullptr; E.ssn = ss + 3 * MT; run_gemm(lds, (const bf16_t*)p.out, (const bf16_t*)(ws + W_SOUT), DM, DIN, E); }
    GBAR();
    { EpiGU E; E.act = (bf16_t*)(ws + O_ACT); E.ss = ss + 3 * MT; run_gemm(lds, hb, (const bf16_t*)(ws + W_GU1), 2 * DFF, DM, E); }
    GBAR();
    { EpiRes<false, true> E; E.xres = nullptr; E.hb = hb; E.outf = p.out; E.ssn = ss + 4 * MT; run_gemm(lds, (const bf16_t*)(ws + O_ACT), (const bf16_t*)(ws + W_DN1), DM, DFF, E); }
    GBAR();
    {
        const float* ss4 = ss + 4 * MT; const f32x4* fw = (const f32x4*)p.in[22]; f32x4* o4 = (f32x4*)p.out;
        for (int i = blockIdx.x * 512 + threadIdx.x; i < MT * (DM / 4); i += gridDim.x * 512) {
            const int row = i >> 8; const float rs = __builtin_amdgcn_rsqf(ss4[row] * (1.0f / 1024.0f) + 1e-6f);
            o4[i] = o4[i] * rs * fw[i & 255];
        }
    }
}

extern "C" void kernel_launch(void* const* d_in, const int* in_sizes, int n_in, void* d_out, int out_size, void* d_ws, size_t ws_size, hipStream_t stream) {
    static int grid_blocks = 0;
    if (!grid_blocks) {
        int dev = 0, cus = 0, per_cu = 0;
        hipGetDevice(&dev);
        hipDeviceGetAttribute(&cus, hipDeviceAttributeMultiprocessorCount, dev);
        if (hipFuncSetAttribute((const void*)fwd_megakernel, hipFuncAttributeMaxDynamicSharedMemorySize, LDS_BYTES) != hipSuccess) fprintf(stderr, "hipFuncSetAttribute failed\n");
        if (hipOccupancyMaxActiveBlocksPerMultiprocessor(&per_cu, (const void*)fwd_megakernel, 512, LDS_BYTES) != hipSuccess || per_cu < 1) { fprintf(stderr, "occupancy query: %d\n", per_cu); per_cu = 1; }
        (void)hipGetLastError();
        grid_blocks = cus * per_cu;
        if (ws_size < 268435456ull || n_in != 23) fprintf(stderr, "unexpected ws_size %zu / n_in %d\n", ws_size, n_in);
    }
    if (hipMemsetAsync((char*)d_ws + O_BAR, 0, XCD_BAR_WORDS * 4, stream) != hipSuccess) fprintf(stderr, "memset failed\n");
    Params p{};
    for (int i = 0; i < 23; ++i) p.in[i] = (const float*)d_in[i];
    p.out = (float*)d_out; p.ws = (unsigned char*)d_ws;
    void* args[] = {&p};
    hipError_t e = hipLaunchCooperativeKernel((const void*)fwd_megakernel, dim3(grid_blocks), dim3(512), args, LDS_BYTES, stream);
    if (e != hipSuccess) fprintf(stderr, "cooperative launch failed: %s (grid %d)\n", hipGetErrorString(e), grid_blocks);
}
#ifdef PHASE_TEST
__global__ void __launch_bounds__(512, 2) t_phase0(Params p) { extern __shared__ __attribute__((aligned(16))) unsigned char shm[]; phase0((LAS unsigned char*)shm, p); }
__global__ void __launch_bounds__(512, 2) t_attn_diff(Params p) { extern __shared__ __attribute__((aligned(16))) unsigned char shm[]; diff_tile((LAS unsigned char*)shm, (const bf16_t*)(p.ws + O_PROJ), (bf16_t*)(p.ws + O_MIXED), p.in[7], 0.3f, blockIdx.x & 1, blockIdx.y, blockIdx.z); }
__global__ void __launch_bounds__(512, 2) t_attn_sb(Params p) { extern __shared__ __attribute__((aligned(16))) unsigned char shm[]; sb_block((LAS unsigned char*)shm, (const bf16_t*)(p.ws + O_PROJ), (bf16_t*)(p.ws + O_MIXED), blockIdx.x & 1, blockIdx.y, blockIdx.z); }
__global__ void __launch_bounds__(512, 2) t_ssd_states(Params p) { extern __shared__ __attribute__((aligned(16))) unsigned char shm[]; ssd_states_phase((LAS unsigned char*)shm, p); }
__global__ void __launch_bounds__(512, 2) t_ssd_scan(Params p) { ssd_scan_phase(p); }
__global__ void __launch_bounds__(512, 2) t_ssd_out(Params p) { extern __shared__ __attribute__((aligned(16))) unsigned char shm[]; ssd_out_phase((LAS unsigned char*)shm, p); }
__global__ void __launch_bounds__(512, 2) t_gemm_ain(Params p) { extern __shared__ __attribute__((aligned(16))) unsigned char shm[]; EpiAttnIn E; E.O = (bf16_t*)(p.ws + O_PROJ); E.ss = (float*)(p.ws + O_SS); E.tab = (const f32x4*)(p.ws + O_ROPE); run_gemm((LAS unsigned char*)shm, (bf16_t*)(p.ws + O_HB), (const bf16_t*)(p.ws + W_AIN), AINW, DM, E); }
__global__ void __launch_bounds__(512, 2) t_gemm_res(Params p) { extern __shared__ __attribute__((aligned(16))) unsigned char shm[]; EpiRes<false, false> E; E.xres = nullptr; E.hb = (bf16_t*)(p.ws + O_HB); E.outf = nullptr; E.ssn = (float*)(p.ws + O_SS); run_gemm((LAS unsigned char*)shm, (bf16_t*)(p.ws + O_ACT), (const bf16_t*)(p.ws + W_DN0), DM, DFF, E); }
__global__ void __launch_bounds__(512, 2) t_gemm_gu(Params p) { extern __shared__ __attribute__((aligned(16))) unsigned char shm[]; EpiGU E; E.act = (bf16_t*)(p.ws + O_ACT); E.ss = (float*)(p.ws + O_SS); run_gemm((LAS unsigned char*)shm, (bf16_t*)(p.ws + O_HB), (const bf16_t*)(p.ws + W_GU0), 2 * DFF, DM, E); }
__global__ void __launch_bounds__(512, 2) t_gemm_ssdin(Params p) { extern __shared__ __attribute__((aligned(16))) unsigned char shm[]; EpiSsdIn E; E.z = (bf16_t*)p.out; E.xbc = (bf16_t*)(p.ws + O_XBC); E.dt = (float*)(p.ws + O_DT); E.ss = (float*)(p.ws + O_SS); run_gemm((LAS unsigned char*)shm, (bf16_t*)(p.ws + O_HB), (const bf16_t*)(p.ws + W_SIN), SINWP, DM, E); }
#endif
```

```cpp
#include <hip/hip_runtime.h>
#include <hip/hip_cooperative_groups.h>
#include <cstdio>
#include <cstdint>
namespace cg = cooperative_groups;
namespace pg8 {
#define PG8_LAS __attribute__((address_space(3)))
typedef unsigned short bf16_t;
typedef short bf16x8 __attribute__((ext_vector_type(8)));
typedef float f32x4 __attribute__((ext_vector_type(4)));
typedef unsigned u32x4 __attribute__((ext_vector_type(4)));
constexpr int BM = 256, BK = 64, HALF = 128, HTB = HALF * BK * 2  , STAGE_BYTES = 8 * HTB, NXCD = 8, WGM = 8;

__host__ __device__ __forceinline__ int lds_byte(int r, int c) { const int st = (r >> 4) * 2 + (c >> 5), rr = r & 15, cc = c & 31, ob = rr * 64 + cc * 2; return st * 1024 + (ob ^ (((ob >> 9) & 1) << 5)); }
__host__ __device__ __forceinline__ void stage_rc(int b, int& R, int& C) { const int st = b / 1024, sb = b % 1024, swz = sb ^ (((sb >> 9) & 1) << 5); R = (st >> 1) * 16 + swz / 64; C = (st & 1) * 32 + (swz % 64) / 2; }
__host__ __device__ __forceinline__ int perm32(int rho) { const int n = rho >> 4, i = rho & 15; return 8 * (i >> 2) + 4 * n + (i & 3); }

struct Unit { int pm, pn; };
struct Gemm { const bf16_t* A; const bf16_t* Bt; int M, N, K; };

struct StaticOrder {
    int nM, nN, nwg, G, c;
    __host__ __device__ void init(int M, int N, int G_, int c_) { nM = M / BM; nN = N / BM; nwg = nM * nN; G = G_; c = c_; }
    __host__ __device__ bool next(int i, Unit& u) const {
        const long L = (long)i * G + c; if (L >= nwg) return false;
        int wgid = (int)L; { const int q = nwg / NXCD, r = nwg % NXCD, xcd = wgid % NXCD, off = wgid / NXCD; wgid = (xcd < r ? xcd * (q + 1) : r * (q + 1) + (xcd - r) * q) + off; }
        const int nig = WGM * nN, gid = wgid / nig, fm = gid * WGM, gsz = (nM - fm) < WGM ? (nM - fm) : WGM;
        u.pm = fm + ((wgid % nig) % gsz); u.pn = (wgid % nig) / gsz; return true;
    }
    __device__ __forceinline__ void a_ready(const Unit&) const {}
    __device__ __forceinline__ void done(const Unit&) const {}
};

template <class Epi, class Sched, bool STAMP = false>
__device__ __forceinline__ void gemm_phase(PG8_LAS unsigned char* lds, const Gemm g, const Sched& S, const Epi& E, unsigned long long* stamps) {
    int tid_ = threadIdx.x; asm volatile("" : "+v"(tid_)); const int tid = tid_, wid = __builtin_amdgcn_readfirstlane(tid >> 6), lane = tid & 63, wr = wid >> 2, wc = wid & 3, fr = lane & 15, fq = lane >> 4;
    const int K = g.K, nt = K / BK;
    int ts_lo = 0, ts_hi = 0, nts = 0; const unsigned long long rt_entry = STAMP ? (unsigned long long)wall_clock64() : 0ull;
#define PG8_STAMP() do { if (STAMP && wid == 0 && nts < 64) { const unsigned long long _c = (unsigned long long)clock64(); \
        ts_lo = (lane == nts) ? (int)(unsigned)_c : ts_lo; ts_hi = (lane == nts) ? (int)(unsigned)(_c >> 32) : ts_hi; ++nts; } } while (0)
    PG8_STAMP();
    unsigned voffA[2], voffB[2];
#pragma unroll
    for (int i = 0; i < 2; ++i) { int R, C; stage_rc(tid * 16 + i * 8192, R, C); const int Rb = Epi::PERM ? ((R & ~31) + perm32(R & 31)) : R;
        voffA[i] = (unsigned)(R * K + C) * 2u; voffB[i] = (unsigned)(Rb * K + C) * 2u; }
    const size_t kstep = (size_t)(BK * 2);
    const size_t hstep = (size_t)HALF * K * 2;
    const size_t tstep = 2 * hstep;
    const unsigned ldsw = (unsigned)wid * 1024u;
    const int aoff = lds_byte(wr * 64 + fr, fq * 8), boff = lds_byte(wc * 32 + fr, fq * 8);
#define PG8_SA(b, h) (((b) * 2 + (h)) * HTB)
#define PG8_SB(b, h) ((4 + (b) * 2 + (h)) * HTB)
#define PG8_STAGE(bufoff, gbase, voff) do { _Pragma("unroll") for (int _i = 0; _i < 2; ++_i) \
        __builtin_amdgcn_global_load_lds((const unsigned*)((const char*)(gbase) + (voff)[_i]), (PG8_LAS unsigned*)(lds + (bufoff) + ldsw + _i * 8192), 16, 0, 0); } while (0)
#define PG8_LDA(dst, b, h) do { _Pragma("unroll") for (int m = 0; m < 4; ++m) _Pragma("unroll") for (int k = 0; k < 2; ++k) dst[m][k] = *(const PG8_LAS bf16x8*)(lds + PG8_SA(b, h) + aoff + m * 2048 + k * 1024); } while (0)
#define PG8_LDB(dst, b, h) do { _Pragma("unroll") for (int n = 0; n < 2; ++n) _Pragma("unroll") for (int k = 0; k < 2; ++k) dst[n][k] = *(const PG8_LAS bf16x8*)(lds + PG8_SB(b, h) + boff + n * 2048 + k * 1024); } while (0)
#define PG8_MMA(ai, bj, At, Bt) do { __builtin_amdgcn_s_setprio(1); _Pragma("unroll") for (int m = 0; m < 4; ++m) _Pragma("unroll") for (int n = 0; n < 2; ++n) _Pragma("unroll") for (int k = 0; k < 2; ++k) \
        acc[ai][bj][m][n] = __builtin_amdgcn_mfma_f32_16x16x32_bf16(Bt[n][k], At[m][k], acc[ai][bj][m][n], 0, 0, 0); __builtin_amdgcn_s_setprio(0); } while (0)
#define PG8_WAIT_V(n) asm volatile("s_waitcnt vmcnt(" #n ")" ::: "memory")
#define PG8_WAIT_L(n) asm volatile("s_waitcnt lgkmcnt(" #n ")" ::: "memory")
#define PG8_BAR __builtin_amdgcn_s_barrier()
#define PG8_SCHED __builtin_amdgcn_sched_barrier(0)
    Unit cur, nxt; int ui = 0;
    if (!S.next(0, cur)) return;
    f32x4 acc[2][2][4][2];
#pragma unroll
    for (int a = 0; a < 2; ++a)
#pragma unroll
        for (int b = 0; b < 2; ++b)
#pragma unroll
            for (int m = 0; m < 4; ++m)
#pragma unroll
                for (int n = 0; n < 2; ++n) acc[a][b][m][n] = (f32x4){0.f, 0.f, 0.f, 0.f};
    bf16x8 At[4][2], B0[2][2], B1[2][2];
    const char* cA = (const char*)g.A + (size_t)cur.pm * tstep; const char* cB = (const char*)g.Bt + (size_t)cur.pn * tstep;
    S.a_ready(cur);
    PG8_STAGE(PG8_SB(0, 0), cB, voffB); PG8_STAGE(PG8_SA(0, 0), cA, voffA); PG8_STAGE(PG8_SB(0, 1), cB + hstep, voffB); PG8_STAGE(PG8_SA(0, 1), cA + hstep, voffA);
    if (wr == 1) PG8_BAR;
    PG8_WAIT_V(4); PG8_BAR;
    PG8_STAGE(PG8_SB(1, 0), cB + kstep, voffB); PG8_STAGE(PG8_SA(1, 0), cA + kstep, voffA); PG8_STAGE(PG8_SB(1, 1), cB + hstep + kstep, voffB);
    PG8_WAIT_V(6); PG8_BAR;
    PG8_STAMP();
    for (;;) {
        const bool has_next = S.next(ui + 1, nxt);
        const char* nA = has_next ? (const char*)g.A + (size_t)nxt.pm * tstep : cA; const char* nB = has_next ? (const char*)g.Bt + (size_t)nxt.pn * tstep : cB;
        for (int t = 0; t < nt; t += 2) {
            const bool last = (t == nt - 2);
            const char* a1 = cA + (size_t)(t + 1) * kstep;
            const char* a2 = last ? nA : cA + (size_t)(t + 2) * kstep; const char* b2 = last ? nB : cB + (size_t)(t + 2) * kstep;
            const char* a3 = a2 + kstep; const char* b3 = b2 + kstep;
            if (last && has_next) S.a_ready(nxt);
            PG8_LDB(B0, 0, 0); PG8_SCHED; PG8_LDA(At, 0, 0); PG8_STAGE(PG8_SA(1, 1), a1 + hstep, voffA);
            PG8_WAIT_L(8); PG8_BAR; PG8_WAIT_L(0); PG8_MMA(0, 0, At, B0); PG8_BAR; PG8_SCHED;
            PG8_LDB(B1, 0, 1); PG8_STAGE(PG8_SB(0, 0), b2, voffB);
            PG8_BAR; PG8_WAIT_L(0); PG8_MMA(0, 1, At, B1); PG8_BAR;
            PG8_LDA(At, 0, 1); PG8_STAGE(PG8_SA(0, 0), a2, voffA);
            PG8_BAR; PG8_WAIT_L(0); PG8_MMA(1, 0, At, B0); PG8_BAR; PG8_SCHED;
            PG8_STAGE(PG8_SB(0, 1), b2 + hstep, voffB);
            PG8_WAIT_V(6); PG8_BAR; PG8_MMA(1, 1, At, B1); PG8_BAR;
            PG8_LDB(B0, 1, 0); PG8_SCHED; PG8_LDA(At, 1, 0); PG8_STAGE(PG8_SA(0, 1), a2 + hstep, voffA);
            PG8_WAIT_L(8); PG8_BAR; PG8_WAIT_L(0); PG8_MMA(0, 0, At, B0); PG8_BAR; PG8_SCHED;
            PG8_LDB(B1, 1, 1); PG8_STAGE(PG8_SB(1, 0), b3, voffB);
            PG8_BAR; PG8_WAIT_L(0); PG8_MMA(0, 1, At, B1); PG8_BAR;
            PG8_LDA(At, 1, 1); PG8_STAGE(PG8_SA(1, 0), a3, voffA);
            PG8_BAR; PG8_WAIT_L(0); PG8_MMA(1, 0, At, B0); PG8_BAR; PG8_SCHED;
            PG8_STAGE(PG8_SB(1, 1), b3 + hstep, voffB);
            PG8_WAIT_V(6); PG8_BAR; PG8_MMA(1, 1, At, B1); PG8_BAR;
        }
        PG8_STAMP();
        if constexpr (!Epi::AFTER_DRAIN) { E(acc, cur, wr, wc, fr, fq); S.done(cur); }
        PG8_STAMP();
        if (!has_next) break;
#pragma unroll
        for (int a = 0; a < 2; ++a)
#pragma unroll
            for (int b = 0; b < 2; ++b)
#pragma unroll
                for (int m = 0; m < 4; ++m)
#pragma unroll
                    for (int n = 0; n < 2; ++n) acc[a][b][m][n] = (f32x4){0.f, 0.f, 0.f, 0.f};
        cur = nxt; cA = nA; cB = nB; ++ui;
    }
    PG8_WAIT_V(0);
    if (wr == 0) PG8_BAR;
    PG8_BAR;
    if constexpr (Epi::AFTER_DRAIN) { E.fused(acc, cur, wr, wc, fr, fq, lds, wid, lane); S.done(cur); }
    PG8_STAMP();
    if (STAMP && wid == 0) { stamps[lane] = lane < nts ? (((unsigned long long)(unsigned)ts_hi << 32) | (unsigned)ts_lo) : 0ull;
        if (lane == 62) stamps[62] = rt_entry; if (lane == 63) stamps[63] = (unsigned long long)wall_clock64(); }
#undef PG8_STAMP
#undef PG8_SA
#undef PG8_SB
#undef PG8_STAGE
#undef PG8_LDA
#undef PG8_LDB
#undef PG8_MMA
#undef PG8_WAIT_V
#undef PG8_WAIT_L
#undef PG8_BAR
#undef PG8_SCHED
}
}
using pg8::bf16_t; using pg8::bf16x8; using pg8::f32x4;
typedef short s16x4 __attribute__((ext_vector_type(4)));
typedef float f32x16 __attribute__((ext_vector_type(16)));
typedef float f32x2 __attribute__((ext_vector_type(2)));
typedef __bf16 bf2_t __attribute__((ext_vector_type(2)));
typedef unsigned u32x2 __attribute__((ext_vector_type(2)));
typedef unsigned u32x4 __attribute__((ext_vector_type(4)));
#define LAS __attribute__((address_space(3)))
#define DI __device__ __forceinline__
#define MFMA32(a, b, c) __builtin_amdgcn_mfma_f32_32x32x16_bf16((a), (b), (c), 0, 0, 0)

DI int otid() { int t = threadIdx.x; asm volatile("" : "+v"(t)); return t; }
DI unsigned pk2(float a, float b) { f32x2 v = {a, b}; bf2_t r = __builtin_convertvector(v, bf2_t); return __builtin_bit_cast(unsigned, r); }
DI float bflo(unsigned u) { return __uint_as_float(u << 16); }
DI float bfhi(unsigned u) { return __uint_as_float(u & 0xffff0000u); }
DI float fexp2(float x) { return __builtin_amdgcn_exp2f(x); }
DI float frcp(float x) { return __builtin_amdgcn_rcpf(x); }
DI float fsilu(float x) { return x * frcp(1.0f + fexp2(-1.44269504089f * x)); }
DI int crow(int i, int h) { return (i & 3) + 8 * (i >> 2) + 4 * h; }
DI s16x4 trr(const LAS unsigned char* p) { return __builtin_amdgcn_ds_read_tr16_b64_v4i16((LAS s16x4*)p); }
DI bf16x8 tr2(const LAS unsigned char* p0, const LAS unsigned char* p1) { s16x4 a = trr(p0), b = trr(p1); return __builtin_shufflevector(a, b, 0, 1, 2, 3, 4, 5, 6, 7); }
DI bf16x8 pack8(const f32x16& x, int s) {
    u32x4 p; p[0] = pk2(x[8 * s], x[8 * s + 1]); p[1] = pk2(x[8 * s + 2], x[8 * s + 3]); p[2] = pk2(x[8 * s + 4], x[8 * s + 5]); p[3] = pk2(x[8 * s + 6], x[8 * s + 7]);
    return __builtin_bit_cast(bf16x8, p);
}
DI f32x16 zero16() { f32x16 z; for (int i = 0; i < 16; ++i) z[i] = 0.f; return z; }

constexpr int MT = 16384, SEQ = 8192, DM = 1024, DFF = 2816, AINW = 3072, SINW = 6176, SINWP = 6400, DIN = 2048, XBCW = 4096;
constexpr float LOG2E = 1.44269504089f;
constexpr int LDS_BYTES = 147456;
constexpr size_t W_AIN = 0, W_AOUT = W_AIN + (size_t)AINW * DM * 2, W_GU0 = W_AOUT + (size_t)DM * DM * 2, W_DN0 = W_GU0 + (size_t)2 * DFF * DM * 2,
                 W_SIN = W_DN0 + (size_t)DM * DFF * 2, W_SOUT = W_SIN + (size_t)SINWP * DM * 2, W_GU1 = W_SOUT + (size_t)DM * DIN * 2, W_DN1 = W_GU1 + (size_t)2 * DFF * DM * 2,
                 O_HB = W_DN1 + (size_t)DM * DFF * 2, O_SS = O_HB + (size_t)MT * DM * 2, O_ROPE = O_SS + (size_t)5 * MT * 4, O_DT = O_ROPE + (size_t)SEQ * 32 * 8,
                 O_CDEC = O_DT + (size_t)MT * 32 * 4, O_LAM = O_CDEC + 16384, O_BAR = O_LAM + 256, O_R = 98566144;
static_assert(O_BAR + 16384 <= O_R, "map");
constexpr size_t O_PROJ = O_R, O_MIXED = O_PROJ + (size_t)MT * AINW * 2, O_ACT = O_R, O_XBC = O_R, O_ST1 = O_XBC + (size_t)MT * XBCW * 2, O_ST0 = 0;
constexpr size_t ST_BATCH = (size_t)64 * 32 * 64 * 128;
static_assert(O_ST1 + ST_BATCH * 2 <= 268435456ull, "ws");
static_assert(ST_BATCH * 2 <= W_SOUT, "st0 overlay");
static_assert(O_MIXED + (size_t)MT * DM * 2 <= 268435456ull, "ws2");

struct Params { const float* in[23]; float* out; unsigned char* ws; };
#include <cstdlib>
#include <vector>

#define XB_TMO      128
#define XB_XCNT(j)  (256  + 64 * (j))
#define XB_XSUB(j)  (1280 + 64 * (j))
#define XB_XGEN(j)  (2304 + 64 * (j))
#define XB_TOP      3328
#define XB_TOPGEN   3392
#define XCD_BAR_WORDS 3456
#define XB_SPIN_CAP (1u << 18)

__device__ __forceinline__ unsigned xb_ld(unsigned* p)              { return __hip_atomic_load(p, __ATOMIC_RELAXED, __HIP_MEMORY_SCOPE_AGENT); }
__device__ __forceinline__ unsigned xb_add(unsigned* p, unsigned v) { return __hip_atomic_fetch_add(p, v, __ATOMIC_RELAXED, __HIP_MEMORY_SCOPE_AGENT); }
__device__ __forceinline__ unsigned xb_xcc_id() { return (unsigned)__builtin_amdgcn_s_getreg((3 << 11) | 20) & 0xFu; }
#define XB_SPIN(cond, bar) do { unsigned _sp = 0; while (cond) { __builtin_amdgcn_s_sleep(1); \
    if ((++_sp & 255u) == 0u) { if (xb_ld(&(bar)[XB_TMO])) break; if (_sp > XB_SPIN_CAP) { atomicAdd(&(bar)[XB_TMO], 1u); break; } } } } while (0)

struct XcdBarrier {
    unsigned* bar; unsigned x;
    volatile LAS unsigned* st;
};

__device__ __forceinline__ XcdBarrier xcd_barrier_post(unsigned* bar, volatile LAS unsigned* st) {
    XcdBarrier b; b.bar = bar; b.x = xb_xcc_id(); b.st = st;
    if (threadIdx.x == 0) (void)xb_add(&bar[XB_XCNT(b.x)], 1u);
    return b;
}
__device__ __forceinline__ void xcd_barrier_complete(unsigned* bar, unsigned x, unsigned& nloc, unsigned& nx) {
    const unsigned G = gridDim.x * gridDim.y * gridDim.z;
    unsigned sum, cnt, mine, sp = 0u;
    for (;;) {
        sum = 0u; cnt = 0u; mine = 0u;
#pragma unroll
        for (unsigned j = 0; j < 16; ++j) { const unsigned c = xb_ld(&bar[XB_XCNT(j)]); sum += c; cnt += (c > 0u) ? 1u : 0u; mine = (j == x) ? c : mine; }
        if (sum == G) break;
        __builtin_amdgcn_s_sleep(1);
        if ((++sp & 255u) == 0u) { if (xb_ld(&bar[XB_TMO])) break; if (sp > XB_SPIN_CAP) { atomicAdd(&bar[XB_TMO], 1u); break; } }
    }
    nloc = mine > 0u ? mine : 1u; nx = cnt > 0u ? cnt : 1u;
}

__device__ __forceinline__ void xcd_barrier(const XcdBarrier& b) {
    asm volatile("s_waitcnt vmcnt(0)" ::: "memory");
    __syncthreads();
    if (threadIdx.x == 0) {
        unsigned* bar = b.bar;
        __builtin_amdgcn_s_waitcnt(0);
        unsigned nloc = b.st[0], nx = b.st[1];
        if (nloc == 0u) { xcd_barrier_complete(bar, b.x, nloc, nx); b.st[0] = nloc; b.st[1] = nx; }
        const unsigned old = xb_add(&bar[XB_XSUB(b.x)], 1u);
        const unsigned gen = old / nloc;
        if (old + 1u == (gen + 1u) * nloc) {
            __builtin_amdgcn_fence(__ATOMIC_RELEASE, "agent");
            asm volatile("s_waitcnt vmcnt(0)" ::: "memory");
            const unsigned og = xb_add(&bar[XB_TOP], 1u);
            const unsigned tg = og / nx;
            if (og + 1u == (tg + 1u) * nx) xb_add(&bar[XB_TOPGEN], 1u);
            else XB_SPIN(xb_ld(&bar[XB_TOPGEN]) == tg, bar);
            __builtin_amdgcn_fence(__ATOMIC_ACQUIRE, "agent");
            xb_add(&bar[XB_XGEN(b.x)], 1u);
            asm volatile("s_waitcnt vmcnt(0)" ::: "memory");
        } else {
            XB_SPIN(xb_ld(&bar[XB_XGEN(b.x)]) == gen, bar);
            __builtin_amdgcn_fence(__ATOMIC_ACQUIRE, "agent");
            asm volatile("s_waitcnt vmcnt(0)" ::: "memory");
        }
    }
    __syncthreads();
}
DI void wmap(int mode, int c, int& src, float& scale, int& which) {
    src = c; scale = 1.f; which = 0;
    if (mode == 0) {
        if (c < 1024) { const int base = c & ~63, cc = c & 63, g = cc >> 3, e = cc & 7; src = base + (e < 4 ? 4 * g + e : 32 + 4 * g + (e - 4)); }
        if (c < 512) scale = 0.125f * LOG2E; else if (c >= 1536 && c < 2048) scale = 0.125f;
    } else if (mode == 2) { src = 4 * (c >> 3) + (c & 3); which = (c >> 2) & 1; }
    else if (mode == 3) { if (c >= SINW) src = -1; }
}
DI void wconv_tile(LAS float* tile, int mode, const float* W0, const float* W1, const float* kscale, bf16_t* dst, int K, int ldw, int tix) {
    const int tid = otid(), nk = K >> 8, c0 = (tix / nk) * 64, k0 = (tix % nk) * 256;
    const int cc = tid & 63; int src, which; float sc; wmap(mode, c0 + cc, src, sc, which);
    const float* W = (which ? W1 : W0) + (src >= 0 ? src : 0);
    float v[32];
#pragma unroll
    for (int i = 0; i < 32; ++i) { const int kk = (tid >> 6) + 8 * i; v[i] = W[(size_t)(k0 + kk) * ldw]; }
#pragma unroll
    for (int i = 0; i < 32; ++i) { const int kk = (tid >> 6) + 8 * i; float x = (src >= 0) ? v[i] * sc : 0.f; if (kscale) x *= kscale[k0 + kk]; tile[kk * 65 + cc] = x; }
    __syncthreads();
#pragma unroll
    for (int i = 0; i < 16; ++i) {
        const int idx = tid + 512 * i, c2 = idx >> 7, k2 = (idx & 127) * 2;
        *(unsigned*)(dst + (size_t)(c0 + c2) * K + k0 + k2) = pk2(tile[k2 * 65 + c2], tile[(k2 + 1) * 65 + c2]);
    }
    __syncthreads();
}
DI void phase0(LAS unsigned char* lds, const Params& p) {
    const int tid = otid(), G = gridDim.x, bx = blockIdx.x;
    unsigned char* ws = p.ws;
    const int cnt[8] = {48 * 4, 16 * 4, 88 * 4, 16 * 11, 100 * 4, 16 * 8, 88 * 4, 16 * 11};
    int total = 0;
#pragma unroll
    for (int j = 0; j < 8; ++j) total += cnt[j];
    for (int t = bx; t < total; t += G) {
        int j = 0, tt = t;
#pragma unroll
        for (int q = 0; q < 7; ++q) if (j == q && tt >= cnt[q]) { tt -= cnt[q]; j = q + 1; }
        LAS float* tile = (LAS float*)lds;
        switch (j) {
        case 0: wconv_tile(tile, 0, p.in[2], nullptr, p.in[1], (bf16_t*)(ws + W_AIN), DM, AINW, tt); break;
        case 1: wconv_tile(tile, 1, p.in[8], nullptr, nullptr, (bf16_t*)(ws + W_AOUT), DM, DM, tt); break;
        case 2: wconv_tile(tile, 2, p.in[19], p.in[20], p.in[18], (bf16_t*)(ws + W_GU0), DM, DFF, tt); break;
        case 3: wconv_tile(tile, 1, p.in[21], nullptr, nullptr, (bf16_t*)(ws + W_DN0), DFF, DM, tt); break;
        case 4: wconv_tile(tile, 3, p.in[10], nullptr, p.in[9], (bf16_t*)(ws + W_SIN), DM, SINW, tt); break;
        case 5: wconv_tile(tile, 1, p.in[17], nullptr, nullptr, (bf16_t*)(ws + W_SOUT), DIN, DM, tt); break;
        case 6: wconv_tile(tile, 2, p.in[19] + (size_t)DM * DFF, p.in[20] + (size_t)DM * DFF, p.in[18] + DM, (bf16_t*)(ws + W_GU1), DM, DFF, tt); break;
        default: wconv_tile(tile, 1, p.in[21] + (size_t)DFF * DM, nullptr, nullptr, (bf16_t*)(ws + W_DN1), DFF, DM, tt); break;
        }
    }
    {
        const int wave = tid >> 6, lane = tid & 63; bf16_t* hb = (bf16_t*)(ws + O_HB); float* ss = (float*)(ws + O_SS);
        for (int row = bx * 8 + wave; row < MT; row += G * 8) {
            const float* xr = p.in[0] + (size_t)row * DM; float sq = 0.f;
#pragma unroll
            for (int i = 0; i < 4; ++i) { const f32x4 v = *(const f32x4*)(xr + lane * 4 + 256 * i); sq += v[0] * v[0] + v[1] * v[1] + v[2] * v[2] + v[3] * v[3];
                u32x2 o; o[0] = pk2(v[0], v[1]); o[1] = pk2(v[2], v[3]); *(u32x2*)(hb + (size_t)row * DM + lane * 4 + 256 * i) = o; }
#pragma unroll
            for (int o = 32; o >= 1; o >>= 1) sq += __shfl_xor(sq, o);
            if (lane == 0) ss[row] = sq;
        }
        for (int i = bx * 512 + tid; i < 4 * MT; i += G * 512) ss[MT + i] = 0.f;
        f32x2* tab = (f32x2*)(ws + O_ROPE);
        for (int i = bx * 512 + tid; i < SEQ * 32; i += G * 512) {
            const int pos = i >> 5, f = i & 31; const float inv = fexp2(-(float)f * 0.41524101186092f); const float ang = (float)pos * inv;
            double t = (double)ang * 0.15915494309189535; t -= floor(t); const float tf = (float)t;
            f32x2 cs; cs[0] = __builtin_amdgcn_cosf(tf); cs[1] = __builtin_amdgcn_sinf(tf); tab[i] = cs;
        }
        if (bx == 0 && tid == 0) { float s1 = 0.f, s2 = 0.f; for (int i = 0; i < 64; ++i) { s1 += p.in[3][i] * p.in[4][i]; s2 += p.in[5][i] * p.in[6][i]; }
            *(float*)(ws + O_LAM) = fexp2(s1 * LOG2E) - fexp2(s2 * LOG2E) + 0.2f; }
    }
}

struct EpiAttnIn {
    static constexpr bool PERM = true, AFTER_DRAIN = false;
    bf16_t* O; const float* ss; const f32x4* tab;
    DI void operator()(const f32x4 (&acc)[2][2][4][2], const pg8::Unit& u, int wr, int wc, int fr, int fq) const {
        const int row0 = u.pm * 256 + wr * 64 + fr, colt = u.pn * 256, col0 = colt + wc * 32 + 8 * fq;
        const int fb = 4 * (4 * (wc & 1) + fq);
#pragma unroll
        for (int ai = 0; ai < 2; ++ai)
#pragma unroll
            for (int m = 0; m < 4; ++m) {
                const int row = row0 + ai * 128 + m * 16; const float rs = __builtin_amdgcn_rsqf(ss[row] * (1.0f / 1024.0f) + 1e-6f);
                f32x4 c01 = {1.f, 0.f, 1.f, 0.f}, c23 = {1.f, 0.f, 1.f, 0.f};
                if (colt < 1024) { const int pos = row & (SEQ - 1); c01 = tab[(pos * 32 + fb) >> 1]; c23 = tab[((pos * 32 + fb) >> 1) + 1]; }
#pragma unroll
                for (int bj = 0; bj < 2; ++bj) {
                    f32x4 v0 = acc[ai][bj][m][0] * rs, v1 = acc[ai][bj][m][1] * rs;
                    if (colt < 1024) {
                        const float cs[4] = {c01[0], c01[2], c23[0], c23[2]}, sn[4] = {c01[1], c01[3], c23[1], c23[3]};
#pragma unroll
                        for (int j = 0; j < 4; ++j) { const float t1 = v0[j], t2 = v1[j]; v0[j] = t1 * cs[j] - t2 * sn[j]; v1[j] = t2 * cs[j] + t1 * sn[j]; }
                    }
                    u32x4 o; o[0] = pk2(v0[0], v0[1]); o[1] = pk2(v0[2], v0[3]); o[2] = pk2(v1[0], v1[1]); o[3] = pk2(v1[2], v1[3]);
                    *(u32x4*)(O + (size_t)row * AINW + col0 + bj * 128) = o;
                }
            }
    }
};
template <bool RES_F32, bool OUT_F32> struct EpiRes {
    static constexpr bool PERM = false, AFTER_DRAIN = false;
    const float* xres; bf16_t* hb; float* outf; float* ssn;
    DI void operator()(const f32x4 (&acc)[2][2][4][2], const pg8::Unit& u, int wr, int wc, int fr, int fq) const {
        const int row0 = u.pm * 256 + wr * 64 + fr, col0 = u.pn * 256 + wc * 32 + 4 * fq;
#pragma unroll
        for (int ai = 0; ai < 2; ++ai)
#pragma unroll
            for (int m = 0; m < 4; ++m) {
                const int row = row0 + ai * 128 + m * 16; float sq = 0.f;
#pragma unroll
                for (int bj = 0; bj < 2; ++bj)
#pragma unroll
                    for (int n = 0; n < 2; ++n) {
                        const size_t off = (size_t)row * DM + col0 + bj * 128 + n * 16; f32x4 r;
                        if (RES_F32) r = *(const f32x4*)(xres + off);
                        else { const u32x2 t = *(const u32x2*)(hb + off); r[0] = bflo(t[0]); r[1] = bfhi(t[0]); r[2] = bflo(t[1]); r[3] = bfhi(t[1]); }
                        const f32x4 v = r + acc[ai][bj][m][n];
                        sq += v[0] * v[0] + v[1] * v[1] + v[2] * v[2] + v[3] * v[3];
                        if (OUT_F32) *(f32x4*)(outf + off) = v;
                        else { u32x2 o; o[0] = pk2(v[0], v[1]); o[1] = pk2(v[2], v[3]); *(u32x2*)(hb + off) = o; }
                    }
                sq += __shfl_xor(sq, 16); sq += __shfl_xor(sq, 32);
                if (fq == 0) atomicAdd(ssn + row, sq);
            }
    }
};
struct EpiGU {
    static constexpr bool PERM = true, AFTER_DRAIN = false;
    bf16_t* act; const float* ss;
    DI void operator()(const f32x4 (&acc)[2][2][4][2], const pg8::Unit& u, int wr, int wc, int fr, int fq) const {
        const int row0 = u.pm * 256 + wr * 64 + fr, col0 = u.pn * 256 + wc * 32 + 8 * fq;
#pragma unroll
        for (int ai = 0; ai < 2; ++ai)
#pragma unroll
            for (int m = 0; m < 4; ++m) {
                const int row = row0 + ai * 128 + m * 16; const float rs = __builtin_amdgcn_rsqf(ss[row] * (1.0f / 1024.0f) + 1e-6f);
#pragma unroll
                for (int bj = 0; bj < 2; ++bj) {
                    const f32x4 g = acc[ai][bj][m][0] * rs, up = acc[ai][bj][m][1] * rs; float a[4];
#pragma unroll
                    for (int j = 0; j < 4; ++j) a[j] = fsilu(g[j]) * up[j];
                    u32x2 o; o[0] = pk2(a[0], a[1]); o[1] = pk2(a[2], a[3]);
                    *(u32x2*)(act + (size_t)row * DFF + ((col0 + bj * 128) >> 1)) = o;
                }
            }
    }
};
struct EpiSsdIn {
    static constexpr bool PERM = true, AFTER_DRAIN = false;
    bf16_t* z; bf16_t* xbc; float* dt; const float* ss;
    DI void operator()(const f32x4 (&acc)[2][2][4][2], const pg8::Unit& u, int wr, int wc, int fr, int fq) const {
        const int row0 = u.pm * 256 + wr * 64 + fr, col0 = u.pn * 256 + wc * 32 + 8 * fq;
#pragma unroll
        for (int ai = 0; ai < 2; ++ai)
#pragma unroll
            for (int m = 0; m < 4; ++m) {
                const int row = row0 + ai * 128 + m * 16; const float rs = __builtin_amdgcn_rsqf(ss[row] * (1.0f / 1024.0f) + 1e-6f);
#pragma unroll
                for (int bj = 0; bj < 2; ++bj) {
                    const int c = col0 + bj * 128; const f32x4 v0 = acc[ai][bj][m][0] * rs, v1 = acc[ai][bj][m][1] * rs;
                    if (c < 6144) { u32x4 o; o[0] = pk2(v0[0], v0[1]); o[1] = pk2(v0[2], v0[3]); o[2] = pk2(v1[0], v1[1]); o[3] = pk2(v1[2], v1[3]);
                        if (c < DIN) *(u32x4*)(z + (size_t)row * DIN + c) = o; else *(u32x4*)(xbc + (size_t)row * XBCW + (c - DIN)) = o; }
                    else if (c < SINW) { *(f32x4*)(dt + (size_t)row * 32 + (c - 6144)) = v0; *(f32x4*)(dt + (size_t)row * 32 + (c - 6144) + 4) = v1; }
                }
            }
    }
};
constexpr int KST = 144, VST = 272, VST64 = 144;
constexpr int AT_K1 = 0, AT_K2 = 64 * KST, AT_V = 2 * 64 * KST, AT_STAGE = AT_V + 64 * VST;

DI void diff_tile(LAS unsigned char* lds, const bf16_t* proj, bf16_t* mixed, const float* subln, float lam, int b, int hd, int qt) {
    const int tid = otid(), w = __builtin_amdgcn_readfirstlane(tid >> 6), lane = tid & 63, qg = w & 3, mp = w >> 2, r = lane & 31, h = lane >> 5;
    const int q0 = qt * 128; const size_t rowb = (size_t)b * SEQ;
    bf16x8 qf[4];
    { const bf16_t* qp = proj + (rowb + q0 + 32 * qg + r) * AINW + hd * 128 + mp * 64 + 8 * h;
#pragma unroll
      for (int s = 0; s < 4; ++s) qf[s] = *(const bf16x8*)(qp + 16 * s); }
    f32x16 O[4];
#pragma unroll
    for (int i = 0; i < 4; ++i) O[i] = zero16();
    float mrun = 0.f, lrun = 0.f;
    const int nsteps = 2 * (qt + 1);
    const bf16_t* src[4]; int dst[4];
#pragma unroll
    for (int i = 0; i < 2; ++i) { const int cid = tid + 512 * i, row = cid >> 4, c16 = cid & 15;
        src[i] = proj + (rowb + row) * AINW + 512 + hd * 128 + c16 * 8; dst[i] = (c16 < 8 ? AT_K1 : AT_K2) + row * KST + (c16 & 7) * 16;
        src[2 + i] = proj + (rowb + row) * AINW + 1024 + hd * 128 + c16 * 8; dst[2 + i] = AT_V + row * VST + c16 * 16; }
    u32x4 pf[4];
#pragma unroll
    for (int i = 0; i < 4; ++i) pf[i] = *(const u32x4*)(src[i]);
#pragma unroll
    for (int i = 0; i < 4; ++i) *(LAS u32x4*)(lds + dst[i]) = pf[i];
    __syncthreads();
    const int i16 = lane & 15, tq = i16 >> 2, tp = i16 & 3, g16 = (lane >> 4) & 1;
    const int troff = (4 * h + tq) * VST + (16 * g16 + 4 * tp) * 2;
    for (int j = 0; j < nsteps; ++j) {
        const bool more = (j + 1 < nsteps);
        if (more) {
#pragma unroll
            for (int i = 0; i < 4; ++i) pf[i] = *(const u32x4*)(src[i] + (size_t)(j + 1) * 64 * AINW);
        }
        const LAS unsigned char* base = lds + (j & 1) * AT_STAGE;
        const LAS unsigned char* Kb = base + (mp ? AT_K2 : AT_K1);
        const LAS unsigned char* Vb = base + AT_V;
        f32x16 S[2];
        const float negm = -mrun;
#pragma unroll
        for (int kt = 0; kt < 2; ++kt) {
#pragma unroll
            for (int i = 0; i < 16; ++i) S[kt][i] = negm;
#pragma unroll
            for (int s = 0; s < 4; ++s) { const bf16x8 kf = *(const LAS bf16x8*)(Kb + (32 * kt + r) * KST + (16 * s + 8 * h) * 2); S[kt] = MFMA32(kf, qf[s], S[kt]); } }
        const int qidx = q0 + 32 * qg + r, kbase = 64 * j;
        if (kbase + 63 > q0 + 32 * qg) {
#pragma unroll
            for (int kt = 0; kt < 2; ++kt)
#pragma unroll
                for (int i = 0; i < 16; ++i) if (kbase + 32 * kt + crow(i, h) > qidx) S[kt][i] = -1e30f;
        }
        float mx = S[0][0];
#pragma unroll
        for (int kt = 0; kt < 2; ++kt)
#pragma unroll
            for (int i = 0; i < 16; ++i) mx = fmaxf(mx, S[kt][i]);
        mx = fmaxf(mx, __shfl_xor(mx, 32));
        if (j == 0 || __builtin_amdgcn_ballot_w64(mx > 8.0f) != 0ull) {
            const float d = (j == 0) ? mx : fmaxf(mx, 0.f);
            mrun += d;
            if (j != 0) { const float alpha = fexp2(-d); lrun *= alpha;
#pragma unroll
                for (int vt = 0; vt < 4; ++vt) O[vt] = O[vt] * alpha; }
#pragma unroll
            for (int kt = 0; kt < 2; ++kt)
#pragma unroll
                for (int i = 0; i < 16; ++i) S[kt][i] -= d;
        }
        float ls = 0.f;
#pragma unroll
        for (int kt = 0; kt < 2; ++kt)
#pragma unroll
            for (int i = 0; i < 16; ++i) { const float pv = fexp2(S[kt][i]); S[kt][i] = pv; ls += pv; }
        lrun += ls;
#pragma unroll
        for (int kt = 0; kt < 2; ++kt)
#pragma unroll
            for (int s2 = 0; s2 < 2; ++s2) {
                const bf16x8 pfr = pack8(S[kt], s2);
                const LAS unsigned char* vrow = Vb + (32 * kt + 16 * s2) * VST + troff;
#pragma unroll
                for (int vt = 0; vt < 4; ++vt) { const bf16x8 vf = tr2(vrow + vt * 64, vrow + 8 * VST + vt * 64); O[vt] = MFMA32(vf, pfr, O[vt]); }
            }
        if (more) {
            LAS unsigned char* nb = lds + ((j + 1) & 1) * AT_STAGE;
#pragma unroll
            for (int i = 0; i < 4; ++i) *(LAS u32x4*)(nb + dst[i]) = pf[i];
        }
        __syncthreads();
    }
    lrun += __shfl_xor(lrun, 32);
    const float inv = frcp(lrun);
    LAS float* ex = (LAS float*)lds;
    if (mp == 1) {
        const float sc = inv * lam;
#pragma unroll
        for (int vt = 0; vt < 4; ++vt)
#pragma unroll
            for (int i = 0; i < 16; ++i) ex[(qg * 128 + 32 * vt + crow(i, h)) * 32 + r] = O[vt][i] * sc;
    }
    __syncthreads();
    if (mp == 0) {
        float sq = 0.f;
#pragma unroll
        for (int vt = 0; vt < 4; ++vt)
#pragma unroll
            for (int i = 0; i < 16; ++i) { const float o = O[vt][i] * inv - ex[(qg * 128 + 32 * vt + crow(i, h)) * 32 + r]; O[vt][i] = o; sq += o * o; }
        sq += __shfl_xor(sq, 32);
        const float rn = __builtin_amdgcn_rsqf(sq * (1.0f / 128.0f) + 1e-5f) * 0.8f;
        bf16_t* op = mixed + (rowb + q0 + 32 * qg + r) * DM + hd * 128;
#pragma unroll
        for (int vt = 0; vt < 4; ++vt)
#pragma unroll
            for (int gq = 0; gq < 4; ++gq) { const int v0 = 32 * vt + 8 * gq + 4 * h; const f32x4 wv = *(const f32x4*)(subln + v0);
                u32x2 o; o[0] = pk2(O[vt][4 * gq] * rn * wv[0], O[vt][4 * gq + 1] * rn * wv[1]); o[1] = pk2(O[vt][4 * gq + 2] * rn * wv[2], O[vt][4 * gq + 3] * rn * wv[3]);
                *(u32x2*)(op + v0) = o; }
    }
    __syncthreads();
}

constexpr int SB_K = 0, SB_V = 64 * KST, SB_STAGE = 2 * 64 * KST;
DI void sb_block(LAS unsigned char* lds, const bf16_t* proj, bf16_t* mixed, int b, int hs, int qb) {
    const int tid = otid(), w = __builtin_amdgcn_readfirstlane(tid >> 6), lane = tid & 63, r = lane & 31, h = lane >> 5;
    const int q0 = qb * 256; const size_t rowb = (size_t)b * SEQ;
    const int qidx = q0 + 32 * w + r;
    bf16x8 qf[4];
    { const bf16_t* qp = proj + (rowb + qidx) * AINW + 1536 + hs * 64 + 8 * h;
#pragma unroll
      for (int s = 0; s < 4; ++s) qf[s] = *(const bf16x8*)(qp + 16 * s); }
    f32x16 O[2]; O[0] = zero16(); O[1] = zero16();
    float carry = 1.0f;
    const int jmax = 4 * qb + 3;
    const int srow = tid >> 3, sc8 = tid & 7;
    const bf16_t* srcK = proj + (rowb + srow) * AINW + 2048 + hs * 64 + sc8 * 8;
    const bf16_t* srcV = proj + (rowb + srow) * AINW + 2560 + hs * 64 + sc8 * 8;
    const int dstK = SB_K + srow * KST + sc8 * 16, dstV = SB_V + srow * VST64 + sc8 * 16;
    u32x4 pk_ = *(const u32x4*)(srcK + (size_t)jmax * 64 * AINW), pv_ = *(const u32x4*)(srcV + (size_t)jmax * 64 * AINW);
    *(LAS u32x4*)(lds + dstK) = pk_; *(LAS u32x4*)(lds + dstV) = pv_;
    __syncthreads();
    const int i16 = lane & 15, tq = i16 >> 2, tp = i16 & 3, g16 = (lane >> 4) & 1;
    const int troff = (4 * h + tq) * VST64 + (16 * g16 + 4 * tp) * 2;
    int it = 0;
    for (int j = jmax; j >= 0; --j, ++it) {
        const bool more = (j > 0);
        if (more) { pk_ = *(const u32x4*)(srcK + (size_t)(j - 1) * 64 * AINW); pv_ = *(const u32x4*)(srcV + (size_t)(j - 1) * 64 * AINW); }
        const LAS unsigned char* base = lds + (it & 1) * SB_STAGE;
        const int kbase = 64 * j;
        if (kbase < q0 + 32 * w + 32) {
#pragma unroll
            for (int kt = 1; kt >= 0; --kt) {
                f32x16 S = zero16();
#pragma unroll
                for (int s = 0; s < 4; ++s) { const bf16x8 kf = *(const LAS bf16x8*)(base + SB_K + (32 * kt + r) * KST + (16 * s + 8 * h) * 2); S = MFMA32(kf, qf[s], S); }
                float T[4], sfx[16];
#pragma unroll
                for (int gq = 0; gq < 4; ++gq) {
                    float run = 1.0f;
#pragma unroll
                    for (int jj = 3; jj >= 0; --jj) {
                        const int i = 4 * gq + jj; const bool valid = (kbase + 32 * kt + crow(i, h)) < qidx;
                        const float zz = fmaxf(S[i], -60.0f); const float e = fexp2(-LOG2E * zz); const float sg = frcp(1.0f + e);
                        const float keep = valid ? e * sg : 1.0f;
                        S[i] = valid ? sg : 0.0f; sfx[i] = run; run *= keep;
                    }
                    T[gq] = run;
                }
                float To[4];
#pragma unroll
                for (int gq = 0; gq < 4; ++gq) To[gq] = __shfl_xor(T[gq], 32);
                float E[4]; float acc_hi = 1.0f;
#pragma unroll
                for (int gq = 3; gq >= 0; --gq) {
                    const float above_same = acc_hi;
                    E[gq] = (h == 0) ? above_same * To[gq] : above_same;
                    acc_hi = acc_hi * T[gq] * To[gq];
                }
#pragma unroll
                for (int i = 0; i < 16; ++i) S[i] = S[i] * carry * E[i >> 2] * sfx[i];
                carry *= acc_hi;
#pragma unroll
                for (int s2 = 0; s2 < 2; ++s2) {
                    const bf16x8 pfr = pack8(S, s2);
                    const LAS unsigned char* vrow = base + SB_V + (32 * kt + 16 * s2) * VST64 + troff;
#pragma unroll
                    for (int vt = 0; vt < 2; ++vt) { const bf16x8 vf = tr2(vrow + vt * 64, vrow + 8 * VST64 + vt * 64); O[vt] = MFMA32(vf, pfr, O[vt]); }
                }
            }
        }
        if (more) { LAS unsigned char* nb = lds + ((it + 1) & 1) * SB_STAGE; *(LAS u32x4*)(nb + dstK) = pk_; *(LAS u32x4*)(nb + dstV) = pv_; }
        const int done = (kbase < q0 + 32 * w + 32) && (carry < 1e-12f);
        const bool wdone = (__builtin_amdgcn_ballot_w64(done != 0) == ~0ull);
        LAS int* flg = (LAS int*)(lds + 2 * SB_STAGE) + (it & 1) * 8;
        if (lane == 0) flg[w] = wdone ? 1 : 0;
        __syncthreads();
        int all = 1;
#pragma unroll
        for (int ww = 0; ww < 8; ++ww) all &= flg[ww];
        if (all) break;
    }
    bf16_t* op = mixed + (rowb + qidx) * DM + 512 + hs * 64;
#pragma unroll
    for (int vt = 0; vt < 2; ++vt)
#pragma unroll
        for (int gq = 0; gq < 4; ++gq) { const int v0 = 32 * vt + 8 * gq + 4 * h;
            u32x2 o; o[0] = pk2(O[vt][4 * gq], O[vt][4 * gq + 1]); o[1] = pk2(O[vt][4 * gq + 2], O[vt][4 * gq + 3]); *(u32x2*)(op + v0) = o; }
    __syncthreads();
}
DI void attn_phase(LAS unsigned char* lds, const Params& p) {
    const bf16_t* proj = (const bf16_t*)(p.ws + O_PROJ); bf16_t* mixed = (bf16_t*)(p.ws + O_MIXED);
    const float lam = *(const float*)(p.ws + O_LAM);
    for (int it = blockIdx.x; it < 256; it += gridDim.x) {
        const int b = it >> 7, hd = (it >> 5) & 3, pr = it & 31;
        diff_tile(lds, proj, mixed, p.in[7], lam, b, hd, 63 - pr);
        diff_tile(lds, proj, mixed, p.in[7], lam, b, hd, pr);
    }
    for (int it = blockIdx.x; it < 512; it += gridDim.x) {
        const int b = it >> 8, hs = (it >> 5) & 7, qb = it & 31;
        sb_block(lds, proj, mixed, b, hs, qb);
    }
}
constexpr int SXS = 528, SBS = 272;
constexpr int L_SX = 0, L_SB = 128 * SXS, L_SC = L_SB + 128 * SBS, L_SDT = L_SC + 128 * SBS, L_SAC = L_SDT + 2048, L_SSQ = L_SAC + 2048;
static_assert(L_SSQ + 4096 <= LDS_BYTES, "lds");

DI void ssd_dt_acum(LAS unsigned char* lds, const float* DT, const float* dt_bias, const float* a_log, size_t t0, int g) {
    LAS float* sdt = (LAS float*)(lds + L_SDT); LAS float* sac = (LAS float*)(lds + L_SAC);
    const int tid = otid(), hh = tid >> 7, l = tid & 127, head = 4 * g + hh, w = tid >> 6, lane = tid & 63;
    const float raw = DT[(t0 + l) * 32 + head] + dt_bias[head];
    const float dt = fmaxf(raw, 0.f) + __logf(1.0f + __expf(-fabsf(raw)));
    sdt[hh * 128 + l] = dt; sac[hh * 128 + l] = -dt * __expf(a_log[head]);
    __syncthreads();
    if (w < 4) {
        const float v0 = sac[w * 128 + 2 * lane], v1 = sac[w * 128 + 2 * lane + 1]; float s = v0 + v1;
#pragma unroll
        for (int off = 1; off < 64; off <<= 1) { const float t = __shfl_up(s, off); if (lane >= off) s += t; }
        const float ex = s - (v0 + v1);
        sac[w * 128 + 2 * lane] = ex + v0; sac[w * 128 + 2 * lane + 1] = ex + v0 + v1;
    }
    __syncthreads();
}
template <int NT, class F> DI void conv_strip(const bf16_t* src, int nzero, const float* cw, const float* cb, int ch, F&& emit) {
    f32x4 wlo[4], whi[4];
#pragma unroll
    for (int k = 0; k < 4; ++k) { wlo[k] = *(const f32x4*)(cw + k * XBCW + ch); whi[k] = *(const f32x4*)(cw + k * XBCW + ch + 4); }
    const f32x4 blo = *(const f32x4*)(cb + ch), bhi = *(const f32x4*)(cb + ch + 4);
    u32x4 raw[NT + 3];
#pragma unroll
    for (int i = 0; i < NT + 3; ++i) { const int ii = (i < nzero) ? nzero : i; raw[i] = *(const u32x4*)(src + (ptrdiff_t)(ii - 3) * XBCW); if (i < nzero) raw[i] = (u32x4){0u, 0u, 0u, 0u}; }
#pragma unroll
    for (int t = 0; t < NT; ++t) {
        float o[8];
#pragma unroll
        for (int e = 0; e < 8; ++e) {
            float a = (e < 4) ? blo[e & 3] : bhi[e & 3];
#pragma unroll
            for (int k = 0; k < 4; ++k) { const unsigned d = raw[t + k][e >> 1]; const float xv = (e & 1) ? bfhi(d) : bflo(d); a += ((e < 4) ? wlo[k][e & 3] : whi[k][e & 3]) * xv; }
            o[e] = fsilu(a);
        }
        emit(t, o);
    }
}
DI u32x4 pack8f(const float* o) { u32x4 r; r[0] = pk2(o[0], o[1]); r[1] = pk2(o[2], o[3]); r[2] = pk2(o[4], o[5]); r[3] = pk2(o[6], o[7]); return r; }

template <bool XW, bool WITH_C> DI void ssd_stage(LAS unsigned char* lds, const bf16_t* xbc, const float* cw, const float* cb, size_t t0, int c, int g) {
    const int tid = otid();
    LAS float* sdt = (LAS float*)(lds + L_SDT); LAS float* sac = (LAS float*)(lds + L_SAC);
    {
        const int c8 = tid & 31, tg = tid >> 5, l0 = 8 * tg, ch = 256 * g + 8 * c8, hh = c8 >> 3;
        const int nzero = (c == 0) ? (3 - l0 > 0 ? 3 - l0 : 0) : 0;
        const float alast = sac[hh * 128 + 127];
        conv_strip<8>(xbc + (t0 + l0) * XBCW + ch, nzero, cw, cb, ch, [&](int t, float* o) {
            if (XW) { const float wgt = sdt[hh * 128 + l0 + t] * __expf(alast - sac[hh * 128 + l0 + t]);
#pragma unroll
                for (int e = 0; e < 8; ++e) o[e] *= wgt; }
            *(LAS u32x4*)(lds + L_SX + (l0 + t) * SXS + c8 * 16) = pack8f(o); });
    }
    {
        const int c8 = tid & 15, tg = tid >> 4, l0 = 4 * tg;
        const int nzero = (c == 0) ? (3 - l0 > 0 ? 3 - l0 : 0) : 0;
        const int chb = DIN + 128 * g + 8 * c8;
        conv_strip<4>(xbc + (t0 + l0) * XBCW + chb, nzero, cw, cb, chb, [&](int t, float* o) { *(LAS u32x4*)(lds + L_SB + (l0 + t) * SBS + c8 * 16) = pack8f(o); });
        if (WITH_C) { const int chc = DIN + 1024 + 128 * g + 8 * c8;
            conv_strip<4>(xbc + (t0 + l0) * XBCW + chc, nzero, cw, cb, chc, [&](int t, float* o) { *(LAS u32x4*)(lds + L_SC + (l0 + t) * SBS + c8 * 16) = pack8f(o); }); }
    }
}
DI bf16_t* st_ptr(unsigned char* ws, int b) { return (bf16_t*)(ws + (b ? O_ST1 : O_ST0)); }

DI void ssd_states_phase(LAS unsigned char* lds, const Params& p) {
    const int tid = otid(), w = __builtin_amdgcn_readfirstlane(tid >> 6), lane = tid & 63, r = lane & 31, h = lane >> 5, hh = w >> 1, ph = w & 1;
    const bf16_t* xbc = (const bf16_t*)(p.ws + O_XBC); const float* DT = (const float*)(p.ws + O_DT); float* cdec = (float*)(p.ws + O_CDEC);
    const int i16 = lane & 15, tq = i16 >> 2, tp = i16 & 3, g16 = (lane >> 4) & 1;
    for (int it = blockIdx.x; it < 1024; it += gridDim.x) {
        const int b = it >> 9, c = (it >> 3) & 63, g = it & 7; const size_t t0 = (size_t)b * SEQ + (size_t)c * 128;
        ssd_dt_acum(lds, DT, p.in[13], p.in[14], t0, g);
        ssd_stage<true, false>(lds, xbc, p.in[11], p.in[12], t0, c, g);
        __syncthreads();
        f32x16 acc[4];
#pragma unroll
        for (int i = 0; i < 4; ++i) acc[i] = zero16();
        const LAS unsigned char* xa = lds + L_SX + (8 * h + tq) * SXS + (64 * hh + 32 * ph + 16 * g16 + 4 * tp) * 2;
        const LAS unsigned char* ba = lds + L_SB + (8 * h + tq) * SBS + (16 * g16 + 4 * tp) * 2;
#pragma unroll
        for (int s = 0; s < 8; ++s) {
            const bf16x8 af = tr2(xa + 16 * s * SXS, xa + (16 * s + 4) * SXS);
#pragma unroll
            for (int nt = 0; nt < 4; ++nt) { const bf16x8 bfr = tr2(ba + 16 * s * SBS + nt * 64, ba + (16 * s + 4) * SBS + nt * 64); acc[nt] = MFMA32(af, bfr, acc[nt]); }
        }
        bf16_t* st = st_ptr(p.ws, b) + ((size_t)(c * 32 + 4 * g + hh) * 64 + 32 * ph) * 128;
#pragma unroll
        for (int nt = 0; nt < 4; ++nt)
#pragma unroll
            for (int i = 0; i < 16; ++i) st[(size_t)crow(i, h) * 128 + 32 * nt + r] = (bf16_t)(pk2(acc[nt][i], 0.f) & 0xffffu);
        if (tid < 4) cdec[(b * 64 + c) * 32 + 4 * g + tid] = __expf(((LAS float*)(lds + L_SAC))[tid * 128 + 127]);
        __syncthreads();
    }
}
DI void ssd_scan_phase(const Params& p, const bool dry) {
    const float* cdec = (const float*)(p.ws + O_CDEC);
    for (int e = blockIdx.x * 512 + threadIdx.x; e < 2 * 32 * 64 * 32; e += gridDim.x * 512) {
        const int b = e >> 16, rem = e & 65535, head = rem >> 11;
        bf16_t* st = st_ptr(p.ws, b) + (size_t)rem * 4;
        float carry[4] = {0.f, 0.f, 0.f, 0.f};
        for (int c0 = 0; c0 < 64; c0 += 8) {
            u32x2 v[8]; float dc[8];
#pragma unroll
            for (int u = 0; u < 8; ++u) { v[u] = *(const u32x2*)(st + (size_t)(c0 + u) * 262144); dc[u] = cdec[(b * 64 + c0 + u) * 32 + head]; }
#pragma unroll
            for (int u = 0; u < 8; ++u) {
                u32x2 o; o[0] = pk2(carry[0], carry[1]); o[1] = pk2(carry[2], carry[3]); if (!dry) *(u32x2*)(st + (size_t)(c0 + u) * 262144) = o;
                carry[0] = carry[0] * dc[u] + bflo(v[u][0]); carry[1] = carry[1] * dc[u] + bfhi(v[u][0]); carry[2] = carry[2] * dc[u] + bflo(v[u][1]); carry[3] = carry[3] * dc[u] + bfhi(v[u][1]);
            }
        }
    }
}
DI void ssd_out_phase(LAS unsigned char* lds, const Params& p, const bool dry) {
    const int tid = otid(), w = __builtin_amdgcn_readfirstlane(tid >> 6), lane = tid & 63, r = lane & 31, h = lane >> 5, hh = w >> 1, ph = w & 1;
    const bf16_t* xbc = (const bf16_t*)(p.ws + O_XBC); const float* DT = (const float*)(p.ws + O_DT); bf16_t* zy = (bf16_t*)p.out;
    LAS float* sdt = (LAS float*)(lds + L_SDT); LAS float* sac = (LAS float*)(lds + L_SAC); LAS float* ssq = (LAS float*)(lds + L_SSQ);
    const int i16 = lane & 15, tq = i16 >> 2, tp = i16 & 3, g16 = (lane >> 4) & 1;
    for (int it = blockIdx.x; it < 1024; it += gridDim.x) {
        const int b = it >> 9, c = (it >> 3) & 63, g = it & 7, head = 4 * g + hh; const size_t t0 = (size_t)b * SEQ + (size_t)c * 128;
        ssd_dt_acum(lds, DT, p.in[13], p.in[14], t0, g);
        ssd_stage<false, true>(lds, xbc, p.in[11], p.in[12], t0, c, g);
        bf16x8 pvf[8];
        { const bf16_t* pp = st_ptr(p.ws, b) + ((size_t)(c * 32 + head) * 64 + 32 * ph + r) * 128 + 8 * h;
#pragma unroll
          for (int s = 0; s < 8; ++s) pvf[s] = *(const bf16x8*)(pp + 16 * s); }
        __syncthreads();
        f32x16 Y[4];
        const LAS unsigned char* xa = lds + L_SX + (4 * h + tq) * SXS + (64 * hh + 32 * ph + 16 * g16 + 4 * tp) * 2;
#pragma unroll
        for (int lt = 0; lt < 4; ++lt) {
            __builtin_amdgcn_sched_barrier(0);
            f32x16 y = zero16();
#pragma unroll
            for (int s = 0; s < 8; ++s) { const bf16x8 cfs = *(const LAS bf16x8*)(lds + L_SC + (32 * lt + r) * SBS + (16 * s + 8 * h) * 2); y = MFMA32(pvf[s], cfs, y); }
            Y[lt] = y * __expf(sac[hh * 128 + 32 * lt + r]);
        }
#pragma unroll
        for (int lt = 0; lt < 4; ++lt) {
            __builtin_amdgcn_sched_barrier(0);
            bf16x8 cf[8];
#pragma unroll
            for (int s = 0; s < 8; ++s) cf[s] = *(const LAS bf16x8*)(lds + L_SC + (32 * lt + r) * SBS + (16 * s + 8 * h) * 2);
            const float al = sac[hh * 128 + 32 * lt + r];
#pragma unroll
            for (int mt = 0; mt < 4; ++mt) {
                if (mt <= lt) {
                    __builtin_amdgcn_sched_barrier(0);
                    f32x16 X = zero16();
#pragma unroll
                    for (int s = 0; s < 8; ++s) { const bf16x8 bfr = *(const LAS bf16x8*)(lds + L_SB + (32 * mt + r) * SBS + (16 * s + 8 * h) * 2); X = MFMA32(bfr, cf[s], X); }
#pragma unroll
                    for (int gq = 0; gq < 4; ++gq) {
                        const f32x4 am = *(const LAS f32x4*)(sac + hh * 128 + 32 * mt + 8 * gq + 4 * h), dm = *(const LAS f32x4*)(sdt + hh * 128 + 32 * mt + 8 * gq + 4 * h);
#pragma unroll
                        for (int jj = 0; jj < 4; ++jj) { const int mrow = 32 * mt + 8 * gq + 4 * h + jj; const bool ok = (32 * lt + r) >= mrow;
                            const float dec = ok ? __expf(fminf(al - am[jj], 0.f)) * dm[jj] : 0.f; X[4 * gq + jj] *= dec; }
                    }
#pragma unroll
                    for (int s2 = 0; s2 < 2; ++s2) { const bf16x8 xs = pack8(X, s2);
                        const LAS unsigned char* xr = xa + (32 * mt + 16 * s2) * SXS; const bf16x8 xf = tr2(xr, xr + 8 * SXS); Y[lt] = MFMA32(xf, xs, Y[lt]); }
                }
            }
        }
        __builtin_amdgcn_sched_barrier(0);
        const float Dh = p.in[15][head];
        float sq[4];
#pragma unroll
        for (int lt = 0; lt < 4; ++lt) {
            const int l = 32 * lt + r; sq[lt] = 0.f;
#pragma unroll
            for (int gq = 0; gq < 4; ++gq) {
                const int chl = 64 * hh + 32 * ph + 8 * gq + 4 * h;
                const u32x2 xv = *(const LAS u32x2*)(lds + L_SX + l * SXS + chl * 2);
                const u32x2 zv = *(const u32x2*)(zy + (t0 + l) * DIN + 256 * g + chl);
                const float xf4[4] = {bflo(xv[0]), bfhi(xv[0]), bflo(xv[1]), bfhi(xv[1])}, zf4[4] = {bflo(zv[0]), bfhi(zv[0]), bflo(zv[1]), bfhi(zv[1])};
#pragma unroll
                for (int jj = 0; jj < 4; ++jj) { const float yv = (Y[lt][4 * gq + jj] + Dh * xf4[jj]) * fsilu(zf4[jj]); Y[lt][4 * gq + jj] = yv; sq[lt] += yv * yv; }
            }
            sq[lt] += __shfl_xor(sq[lt], 32);
            if (h == 0) ssq[w * 128 + l] = sq[lt];
        }
        __syncthreads();
#pragma unroll
        for (int lt = 0; lt < 4; ++lt) {
            const int l = 32 * lt + r; float tot = 0.f;
#pragma unroll
            for (int ww = 0; ww < 8; ++ww) tot += ssq[ww * 128 + l];
            const float rn = __builtin_amdgcn_rsqf(tot * (1.0f / 256.0f) + 1e-5f);
#pragma unroll
            for (int gq = 0; gq < 4; ++gq) {
                const int chl = 64 * hh + 32 * ph + 8 * gq + 4 * h; const f32x4 gw = *(const f32x4*)(p.in[16] + 256 * g + chl);
                u32x2 o; o[0] = pk2(Y[lt][4 * gq] * rn * gw[0], Y[lt][4 * gq + 1] * rn * gw[1]); o[1] = pk2(Y[lt][4 * gq + 2] * rn * gw[2], Y[lt][4 * gq + 3] * rn * gw[3]);
                if (!dry) *(u32x2*)(zy + (t0 + l) * DIN + 256 * g + chl) = o;
            }
        }
        __syncthreads();
    }
}
template <class Epi> DI void run_gemm(LAS unsigned char* lds, const bf16_t* A, const bf16_t* Bt, int N, int K, const Epi& E) {
    pg8::Gemm g; g.A = A; g.Bt = Bt; g.M = MT; g.N = N; g.K = K;
    pg8::StaticOrder S; S.init(MT, N, (int)gridDim.x, (int)blockIdx.x);
    pg8::gemm_phase<Epi, pg8::StaticOrder, false>((PG8_LAS unsigned char*)lds, g, S, E, nullptr);
}
#if defined(DRY_S3) || defined(DRY_S4)
#define DRYV (p.ws == nullptr)
#else
#define DRYV false
#endif
__global__ void __launch_bounds__(512, 2) fwd_megakernel(Params p) {
    extern __shared__ __attribute__((aligned(16))) unsigned char shm[];
    LAS unsigned char* lds = (LAS unsigned char*)shm;
    cg::grid_group grid = cg::this_grid();
    if (threadIdx.x < 4) ((LAS unsigned*)(lds + LDS_BYTES - 16))[threadIdx.x] = 0u;
    __syncthreads();
    const XcdBarrier xbar = xcd_barrier_post((unsigned*)(p.ws + O_BAR), (volatile LAS unsigned*)(lds + LDS_BYTES - 16));
#define GBAR() xcd_barrier(xbar)
    unsigned char* ws = p.ws;
    bf16_t* hb = (bf16_t*)(ws + O_HB); float* ss = (float*)(ws + O_SS);
    phase0(lds, p);
#ifdef DUP_P0
    GBAR(); phase0(lds, p);
#endif
    if (gridDim.x == 0x7fffffffu) grid.sync();
    GBAR();
    { EpiAttnIn E; E.O = (bf16_t*)(ws + O_PROJ); E.ss = ss; E.tab = (const f32x4*)(ws + O_ROPE); run_gemm(lds, hb, (const bf16_t*)(ws + W_AIN), AINW, DM, E); }
    GBAR();
    attn_phase(lds, p);
#ifdef DUP_ATTN
    GBAR(); attn_phase(lds, p);
#endif
    GBAR();
    { EpiRes<true, false> E; E.xres = p.in[0]; E.hb = hb; E.outf = nullptr; E.ssn = ss + MT; run_gemm(lds, (const bf16_t*)(ws + O_MIXED), (const bf16_t*)(ws + W_AOUT), DM, DM, E); }
    GBAR();
    { EpiGU E; E.act = (bf16_t*)(ws + O_ACT); E.ss = ss + MT; run_gemm(lds, hb, (const bf16_t*)(ws + W_GU0), 2 * DFF, DM, E); }
    GBAR();
    { EpiRes<false, false> E; E.xres = nullptr; E.hb = hb; E.outf = nullptr; E.ssn = ss + 2 * MT; run_gemm(lds, (const bf16_t*)(ws + O_ACT), (const bf16_t*)(ws + W_DN0), DM, DFF, E); }
    GBAR();
    { EpiSsdIn E; E.z = (bf16_t*)p.out; E.xbc = (bf16_t*)(ws + O_XBC); E.dt = (float*)(ws + O_DT); E.ss = ss + 2 * MT; run_gemm(lds, hb, (const bf16_t*)(ws + W_SIN), SINWP, DM, E); }
    GBAR();
    ssd_states_phase(lds, p);
#ifdef DUP_S2
    GBAR(); ssd_states_phase(lds, p);
#endif
    GBAR();
#ifdef DRY_S3
    ssd_scan_phase(p, p.ws != nullptr); GBAR();
#endif
    ssd_scan_phase(p, DRYV);
    GBAR();
#ifdef DRY_S4
    ssd_out_phase(lds, p, p.ws != nullptr); GBAR();
#endif
    ssd_out_phase(lds, p, DRYV);
    GBAR();
    { EpiRes<false, false> E; E.xres = nullptr; E.hb = hb; E.outf = nullptr; E.ssn = ss + 3 * MT; run_gemm(lds, (const bf16_t*)p.out, (const bf16_t*)(ws + W_SOUT), DM, DIN, E); }
    GBAR();
    { EpiGU E; E.act = (bf16_t*)(ws + O_ACT); E.ss = ss + 3 * MT; run_gemm(lds, hb, (const bf16_t*)(ws + W_GU1), 2 * DFF, DM, E); }
    GBAR();
    { EpiRes<false, true> E; E.xres = nullptr; E.hb = hb; E.outf = p.out; E.ssn = ss + 4 * MT; run_gemm(lds, (const bf16_t*)(ws + O_ACT), (const bf16_t*)(ws + W_DN1), DM, DFF, E); }
    GBAR();
    {
        const float* ss4 = ss + 4 * MT; const f32x4* fw = (const f32x4*)p.in[22]; f32x4* o4 = (f32x4*)p.out;
        for (int i = blockIdx.x * 512 + threadIdx.x; i < MT * (DM / 4); i += gridDim.x * 512) {
            const int row = i >> 8; const float rs = __builtin_amdgcn_rsqf(ss4[row] * (1.0f / 1024.0f) + 1e-6f);
            o4[i] = o4[i] * rs * fw[i & 255];
        }
    }
}

extern "C" void kernel_launch(void* const* d_in, const int* in_sizes, int n_in, void* d_out, int out_size, void* d_ws, size_t ws_size, hipStream_t stream) {
    static int grid_blocks = 0;
    if (!grid_blocks) {
        int dev = 0, cus = 0, per_cu = 0;
        hipGetDevice(&dev);
        hipDeviceGetAttribute(&cus, hipDeviceAttributeMultiprocessorCount, dev);
        if (hipFuncSetAttribute((const void*)fwd_megakernel, hipFuncAttributeMaxDynamicSharedMemorySize, LDS_BYTES) != hipSuccess) fprintf(stderr, "hipFuncSetAttribute failed\n");
        if (hipOccupancyMaxActiveBlocksPerMultiprocessor(&per_cu, (const void*)fwd_megakernel, 512, LDS_BYTES) != hipSuccess || per_cu < 1) { fprintf(stderr, "occupancy query: %d\n", per_cu); per_cu = 1; }
        (void)hipGetLastError();
        grid_blocks = cus * per_cu;
        if (ws_size < 268435456ull || n_in != 23) fprintf(stderr, "unexpected ws_size %zu / n_in %d\n", ws_size, n_in);
    }
    if (hipMemsetAsync((char*)d_ws + O_BAR, 0, XCD_BAR_WORDS * 4, stream) != hipSuccess) fprintf(stderr, "memset failed\n");
    Params p{};
    for (int i = 0; i < 23; ++i) p.in[i] = (const float*)d_in[i];
    p.out = (float*)d_out; p.ws = (unsigned char*)d_ws;
    void* args[] = {&p};
    hipError_t e = hipLaunchCooperativeKernel((const void*)fwd_megakernel, dim3(grid_blocks), dim3(512), args, LDS_BYTES, stream);
    if (e != hipSuccess) fprintf(stderr, "cooperative launch failed: %s (grid %d)\n", hipGetErrorString(e), grid_blocks);
}
#ifdef PHASE_TEST
__global__ void __launch_bounds__(512, 2) t_phase0(Params p) { extern __shared__ __attribute__((aligned(16))) unsigned char shm[]; phase0((LAS unsigned char*)shm, p); }
__global__ void __launch_bounds__(512, 2) t_attn_diff(Params p) { extern __shared__ __attribute__((aligned(16))) unsigned char shm[]; diff_tile((LAS unsigned char*)shm, (const bf16_t*)(p.ws + O_PROJ), (bf16_t*)(p.ws + O_MIXED), p.in[7], 0.3f, blockIdx.x & 1, blockIdx.y, blockIdx.z); }
__global__ void __launch_bounds__(512, 2) t_attn_sb(Params p) { extern __shared__ __attribute__((aligned(16))) unsigned char shm[]; sb_block((LAS unsigned char*)shm, (const bf16_t*)(p.ws + O_PROJ), (bf16_t*)(p.ws + O_MIXED), blockIdx.x & 1, blockIdx.y, blockIdx.z); }
__global__ void __launch_bounds__(512, 2) t_ssd_states(Params p) { extern __shared__ __attribute__((aligned(16))) unsigned char shm[]; ssd_states_phase((LAS unsigned char*)shm, p); }
__global__ void __launch_bounds__(512, 2) t_ssd_scan(Params p) { ssd_scan_phase(p, false); }
__global__ void __launch_bounds__(512, 2) t_ssd_out(Params p) { extern __shared__ __attribute__((aligned(16))) unsigned char shm[]; ssd_out_phase((LAS unsigned char*)shm, p, false); }
__global__ void __launch_bounds__(512, 2) t_gemm_ain(Params p) { extern __shared__ __attribute__((aligned(16))) unsigned char shm[]; EpiAttnIn E; E.O = (bf16_t*)(p.ws + O_PROJ); E.ss = (float*)(p.ws + O_SS); E.tab = (const f32x4*)(p.ws + O_ROPE); run_gemm((LAS unsigned char*)shm, (bf16_t*)(p.ws + O_HB), (const bf16_t*)(p.ws + W_AIN), AINW, DM, E); }
__global__ void __launch_bounds__(512, 2) t_gemm_res(Params p) { extern __shared__ __attribute__((aligned(16))) unsigned char shm[]; EpiRes<false, false> E; E.xres = nullptr; E.hb = (bf16_t*)(p.ws + O_HB); E.outf = nullptr; E.ssn = (float*)(p.ws + O_SS); run_gemm((LAS unsigned char*)shm, (bf16_t*)(p.ws + O_ACT), (const bf16_t*)(p.ws + W_DN0), DM, DFF, E); }
__global__ void __launch_bounds__(512, 2) t_gemm_gu(Params p) { extern __shared__ __attribute__((aligned(16))) unsigned char shm[]; EpiGU E; E.act = (bf16_t*)(p.ws + O_ACT); E.ss = (float*)(p.ws + O_SS); run_gemm((LAS unsigned char*)shm, (bf16_t*)(p.ws + O_HB), (const bf16_t*)(p.ws + W_GU0), 2 * DFF, DM, E); }
__global__ void __launch_bounds__(512, 2) t_gemm_ssdin(Params p) { extern __shared__ __attribute__((aligned(16))) unsigned char shm[]; EpiSsdIn E; E.z = (bf16_t*)p.out; E.xbc = (bf16_t*)(p.ws + O_XBC); E.dt = (float*)(p.ws + O_DT); E.ss = (float*)(p.ws + O_SS); run_gemm((LAS unsigned char*)shm, (bf16_t*)(p.ws + O_HB), (const bf16_t*)(p.ws + W_SIN), SINWP, DM, E); }
#endif
```

```cpp
#include <hip/hip_runtime.h>
#include <hip/hip_cooperative_groups.h>
#include <cstdio>
#include <cstdint>
namespace cg = cooperative_groups;
namespace pg8 {
#define PG8_LAS __attribute__((address_space(3)))
typedef unsigned short bf16_t;
typedef short bf16x8 __attribute__((ext_vector_type(8)));
typedef float f32x4 __attribute__((ext_vector_type(4)));
typedef unsigned u32x4 __attribute__((ext_vector_type(4)));
constexpr int BM = 256, BK = 64, HALF = 128, HTB = HALF * BK * 2  , STAGE_BYTES = 8 * HTB, NXCD = 8, WGM = 8;

__host__ __device__ __forceinline__ int lds_byte(int r, int c) { const int st = (r >> 4) * 2 + (c >> 5), rr = r & 15, cc = c & 31, ob = rr * 64 + cc * 2; return st * 1024 + (ob ^ (((ob >> 9) & 1) << 5)); }
__host__ __device__ __forceinline__ void stage_rc(int b, int& R, int& C) { const int st = b / 1024, sb = b % 1024, swz = sb ^ (((sb >> 9) & 1) << 5); R = (st >> 1) * 16 + swz / 64; C = (st & 1) * 32 + (swz % 64) / 2; }
__host__ __device__ __forceinline__ int perm32(int rho) { const int n = rho >> 4, i = rho & 15; return 8 * (i >> 2) + 4 * n + (i & 3); }

struct Unit { int pm, pn; };
struct Gemm { const bf16_t* A; const bf16_t* Bt; int M, N, K; };

struct StaticOrder {
    int nM, nN, nwg, G, c;
    __host__ __device__ void init(int M, int N, int G_, int c_) { nM = M / BM; nN = N / BM; nwg = nM * nN; G = G_; c = c_; }
    __host__ __device__ bool next(int i, Unit& u) const {
        const long L = (long)i * G + c; if (L >= nwg) return false;
        int wgid = (int)L; { const int q = nwg / NXCD, r = nwg % NXCD, xcd = wgid % NXCD, off = wgid / NXCD; wgid = (xcd < r ? xcd * (q + 1) : r * (q + 1) + (xcd - r) * q) + off; }
        const int nig = WGM * nN, gid = wgid / nig, fm = gid * WGM, gsz = (nM - fm) < WGM ? (nM - fm) : WGM;
        u.pm = fm + ((wgid % nig) % gsz); u.pn = (wgid % nig) / gsz; return true;
    }
    __device__ __forceinline__ void a_ready(const Unit&) const {}
    __device__ __forceinline__ void done(const Unit&) const {}
};

template <class Epi, class Sched, bool STAMP = false>
__device__ __forceinline__ void gemm_phase(PG8_LAS unsigned char* lds, const Gemm g, const Sched& S, const Epi& E, unsigned long long* stamps) {
    int tid_ = threadIdx.x; asm volatile("" : "+v"(tid_)); const int tid = tid_, wid = __builtin_amdgcn_readfirstlane(tid >> 6), lane = tid & 63, wr = wid >> 2, wc = wid & 3, fr = lane & 15, fq = lane >> 4;
    const int K = g.K, nt = K / BK;
    int ts_lo = 0, ts_hi = 0, nts = 0; const unsigned long long rt_entry = STAMP ? (unsigned long long)wall_clock64() : 0ull;
#define PG8_STAMP() do { if (STAMP && wid == 0 && nts < 64) { const unsigned long long _c = (unsigned long long)clock64(); \
        ts_lo = (lane == nts) ? (int)(unsigned)_c : ts_lo; ts_hi = (lane == nts) ? (int)(unsigned)(_c >> 32) : ts_hi; ++nts; } } while (0)
    PG8_STAMP();
    unsigned voffA[2], voffB[2];
#pragma unroll
    for (int i = 0; i < 2; ++i) { int R, C; stage_rc(tid * 16 + i * 8192, R, C); const int Rb = Epi::PERM ? ((R & ~31) + perm32(R & 31)) : R;
        voffA[i] = (unsigned)(R * K + C) * 2u; voffB[i] = (unsigned)(Rb * K + C) * 2u; }
    const size_t kstep = (size_t)(BK * 2);
    const size_t hstep = (size_t)HALF * K * 2;
    const size_t tstep = 2 * hstep;
    const unsigned ldsw = (unsigned)wid * 1024u;
    const int aoff = lds_byte(wr * 64 + fr, fq * 8), boff = lds_byte(wc * 32 + fr, fq * 8);
#define PG8_SA(b, h) (((b) * 2 + (h)) * HTB)
#define PG8_SB(b, h) ((4 + (b) * 2 + (h)) * HTB)
#define PG8_STAGE(bufoff, gbase, voff) do { _Pragma("unroll") for (int _i = 0; _i < 2; ++_i) \
        __builtin_amdgcn_global_load_lds((const unsigned*)((const char*)(gbase) + (voff)[_i]), (PG8_LAS unsigned*)(lds + (bufoff) + ldsw + _i * 8192), 16, 0, 0); } while (0)
#define PG8_LDA(dst, b, h) do { _Pragma("unroll") for (int m = 0; m < 4; ++m) _Pragma("unroll") for (int k = 0; k < 2; ++k) dst[m][k] = *(const PG8_LAS bf16x8*)(lds + PG8_SA(b, h) + aoff + m * 2048 + k * 1024); } while (0)
#define PG8_LDB(dst, b, h) do { _Pragma("unroll") for (int n = 0; n < 2; ++n) _Pragma("unroll") for (int k = 0; k < 2; ++k) dst[n][k] = *(const PG8_LAS bf16x8*)(lds + PG8_SB(b, h) + boff + n * 2048 + k * 1024); } while (0)
#define PG8_MMA(ai, bj, At, Bt) do { __builtin_amdgcn_s_setprio(1); _Pragma("unroll") for (int m = 0; m < 4; ++m) _Pragma("unroll") for (int n = 0; n < 2; ++n) _Pragma("unroll") for (int k = 0; k < 2; ++k) \
        acc[ai][bj][m][n] = __builtin_amdgcn_mfma_f32_16x16x32_bf16(Bt[n][k], At[m][k], acc[ai][bj][m][n], 0, 0, 0); __builtin_amdgcn_s_setprio(0); } while (0)
#define PG8_WAIT_V(n) asm volatile("s_waitcnt vmcnt(" #n ")" ::: "memory")
#define PG8_WAIT_L(n) asm volatile("s_waitcnt lgkmcnt(" #n ")" ::: "memory")
#define PG8_BAR __builtin_amdgcn_s_barrier()
#define PG8_SCHED __builtin_amdgcn_sched_barrier(0)
    Unit cur, nxt; int ui = 0;
    if (!S.next(0, cur)) return;
    f32x4 acc[2][2][4][2];
#pragma unroll
    for (int a = 0; a < 2; ++a)
#pragma unroll
        for (int b = 0; b < 2; ++b)
#pragma unroll
            for (int m = 0; m < 4; ++m)
#pragma unroll
                for (int n = 0; n < 2; ++n) acc[a][b][m][n] = (f32x4){0.f, 0.f, 0.f, 0.f};
    bf16x8 At[4][2], B0[2][2], B1[2][2];
    const char* cA = (const char*)g.A + (size_t)cur.pm * tstep; const char* cB = (const char*)g.Bt + (size_t)cur.pn * tstep;
    S.a_ready(cur);
    PG8_STAGE(PG8_SB(0, 0), cB, voffB); PG8_STAGE(PG8_SA(0, 0), cA, voffA); PG8_STAGE(PG8_SB(0, 1), cB + hstep, voffB); PG8_STAGE(PG8_SA(0, 1), cA + hstep, voffA);
    if (wr == 1) PG8_BAR;
    PG8_WAIT_V(4); PG8_BAR;
    PG8_STAGE(PG8_SB(1, 0), cB + kstep, voffB); PG8_STAGE(PG8_SA(1, 0), cA + kstep, voffA); PG8_STAGE(PG8_SB(1, 1), cB + hstep + kstep, voffB);
    PG8_WAIT_V(6); PG8_BAR;
    PG8_STAMP();
    for (;;) {
        const bool has_next = S.next(ui + 1, nxt);
        const char* nA = has_next ? (const char*)g.A + (size_t)nxt.pm * tstep : cA; const char* nB = has_next ? (const char*)g.Bt + (size_t)nxt.pn * tstep : cB;
        for (int t = 0; t < nt; t += 2) {
            const bool last = (t == nt - 2);
            const char* a1 = cA + (size_t)(t + 1) * kstep;
            const char* a2 = last ? nA : cA + (size_t)(t + 2) * kstep; const char* b2 = last ? nB : cB + (size_t)(t + 2) * kstep;
            const char* a3 = a2 + kstep; const char* b3 = b2 + kstep;
            if (last && has_next) S.a_ready(nxt);
            PG8_LDB(B0, 0, 0); PG8_SCHED; PG8_LDA(At, 0, 0); PG8_STAGE(PG8_SA(1, 1), a1 + hstep, voffA);
            PG8_WAIT_L(8); PG8_BAR; PG8_WAIT_L(0); PG8_MMA(0, 0, At, B0); PG8_BAR; PG8_SCHED;
            PG8_LDB(B1, 0, 1); PG8_STAGE(PG8_SB(0, 0), b2, voffB);
            PG8_BAR; PG8_WAIT_L(0); PG8_MMA(0, 1, At, B1); PG8_BAR;
            PG8_LDA(At, 0, 1); PG8_STAGE(PG8_SA(0, 0), a2, voffA);
            PG8_BAR; PG8_WAIT_L(0); PG8_MMA(1, 0, At, B0); PG8_BAR; PG8_SCHED;
            PG8_STAGE(PG8_SB(0, 1), b2 + hstep, voffB);
            PG8_WAIT_V(6); PG8_BAR; PG8_MMA(1, 1, At, B1); PG8_BAR;
            PG8_LDB(B0, 1, 0); PG8_SCHED; PG8_LDA(At, 1, 0); PG8_STAGE(PG8_SA(0, 1), a2 + hstep, voffA);
            PG8_WAIT_L(8); PG8_BAR; PG8_WAIT_L(0); PG8_MMA(0, 0, At, B0); PG8_BAR; PG8_SCHED;
            PG8_LDB(B1, 1, 1); PG8_STAGE(PG8_SB(1, 0), b3, voffB);
            PG8_BAR; PG8_WAIT_L(0); PG8_MMA(0, 1, At, B1); PG8_BAR;
            PG8_LDA(At, 1, 1); PG8_STAGE(PG8_SA(1, 0), a3, voffA);
            PG8_BAR; PG8_WAIT_L(0); PG8_MMA(1, 0, At, B0); PG8_BAR; PG8_SCHED;
            PG8_STAGE(PG8_SB(1, 1), b3 + hstep, voffB);
            PG8_WAIT_V(6); PG8_BAR; PG8_MMA(1, 1, At, B1); PG8_BAR;
        }
        PG8_STAMP();
        if constexpr (!Epi::AFTER_DRAIN) { E(acc, cur, wr, wc, fr, fq); S.done(cur); }
        PG8_STAMP();
        if (!has_next) break;
#pragma unroll
        for (int a = 0; a < 2; ++a)
#pragma unroll
            for (int b = 0; b < 2; ++b)
#pragma unroll
                for (int m = 0; m < 4; ++m)
#pragma unroll
                    for (int n = 0; n < 2; ++n) acc[a][b][m][n] = (f32x4){0.f, 0.f, 0.f, 0.f};
        cur = nxt; cA = nA; cB = nB; ++ui;
    }
    PG8_WAIT_V(0);
    if (wr == 0) PG8_BAR;
    PG8_BAR;
    if constexpr (Epi::AFTER_DRAIN) { E.fused(acc, cur, wr, wc, fr, fq, lds, wid, lane); S.done(cur); }
    PG8_STAMP();
    if (STAMP && wid == 0) { stamps[lane] = lane < nts ? (((unsigned long long)(unsigned)ts_hi << 32) | (unsigned)ts_lo) : 0ull;
        if (lane == 62) stamps[62] = rt_entry; if (lane == 63) stamps[63] = (unsigned long long)wall_clock64(); }
#undef PG8_STAMP
#undef PG8_SA
#undef PG8_SB
#undef PG8_STAGE
#undef PG8_LDA
#undef PG8_LDB
#undef PG8_MMA
#undef PG8_WAIT_V
#undef PG8_WAIT_L
#undef PG8_BAR
#undef PG8_SCHED
}
}
using pg8::bf16_t; using pg8::bf16x8; using pg8::f32x4;
typedef short s16x4 __attribute__((ext_vector_type(4)));
typedef float f32x16 __attribute__((ext_vector_type(16)));
typedef float f32x2 __attribute__((ext_vector_type(2)));
typedef __bf16 bf2_t __attribute__((ext_vector_type(2)));
typedef unsigned u32x2 __attribute__((ext_vector_type(2)));
typedef unsigned u32x4 __attribute__((ext_vector_type(4)));
#define LAS __attribute__((address_space(3)))
#define DI __device__ __forceinline__
#define MFMA32(a, b, c) __builtin_amdgcn_mfma_f32_32x32x16_bf16((a), (b), (c), 0, 0, 0)

DI int otid() { int t = threadIdx.x; asm volatile("" : "+v"(t)); return t; }
DI unsigned pk2(float a, float b) { f32x2 v = {a, b}; bf2_t r = __builtin_convertvector(v, bf2_t); return __builtin_bit_cast(unsigned, r); }
DI float bflo(unsigned u) { return __uint_as_float(u << 16); }
DI float bfhi(unsigned u) { return __uint_as_float(u & 0xffff0000u); }
DI float fexp2(float x) { return __builtin_amdgcn_exp2f(x); }
DI float frcp(float x) { return __builtin_amdgcn_rcpf(x); }
DI float fsilu(float x) { return x * frcp(1.0f + fexp2(-1.44269504089f * x)); }
DI int crow(int i, int h) { return (i & 3) + 8 * (i >> 2) + 4 * h; }
DI s16x4 trr(const LAS unsigned char* p) { return __builtin_amdgcn_ds_read_tr16_b64_v4i16((LAS s16x4*)p); }
DI bf16x8 tr2(const LAS unsigned char* p0, const LAS unsigned char* p1) { s16x4 a = trr(p0), b = trr(p1); return __builtin_shufflevector(a, b, 0, 1, 2, 3, 4, 5, 6, 7); }
DI bf16x8 pack8(const f32x16& x, int s) {
    u32x4 p; p[0] = pk2(x[8 * s], x[8 * s + 1]); p[1] = pk2(x[8 * s + 2], x[8 * s + 3]); p[2] = pk2(x[8 * s + 4], x[8 * s + 5]); p[3] = pk2(x[8 * s + 6], x[8 * s + 7]);
    return __builtin_bit_cast(bf16x8, p);
}
DI f32x16 zero16() { f32x16 z; for (int i = 0; i < 16; ++i) z[i] = 0.f; return z; }

constexpr int MT = 16384, SEQ = 8192, DM = 1024, DFF = 2816, AINW = 3072, SINW = 6176, SINWP = 6400, DIN = 2048, XBCW = 4096;
constexpr float LOG2E = 1.44269504089f;
constexpr int LDS_BYTES = 147456;
constexpr size_t W_AIN = 0, W_AOUT = W_AIN + (size_t)AINW * DM * 2, W_GU0 = W_AOUT + (size_t)DM * DM * 2, W_DN0 = W_GU0 + (size_t)2 * DFF * DM * 2,
                 W_SIN = W_DN0 + (size_t)DM * DFF * 2, W_SOUT = W_SIN + (size_t)SINWP * DM * 2, W_GU1 = W_SOUT + (size_t)DM * DIN * 2, W_DN1 = W_GU1 + (size_t)2 * DFF * DM * 2,
                 O_HB = W_DN1 + (size_t)DM * DFF * 2, O_SS = O_HB + (size_t)MT * DM * 2, O_ROPE = O_SS + (size_t)5 * MT * 4, O_DT = O_ROPE + (size_t)SEQ * 32 * 8,
                 O_CDEC = O_DT + (size_t)MT * 32 * 4, O_LAM = O_CDEC + 16384, O_BAR = O_LAM + 256, O_R = 98566144;
static_assert(O_BAR + 16384 <= O_R, "map");
constexpr size_t O_PROJ = O_R, O_MIXED = O_PROJ + (size_t)MT * AINW * 2, O_ACT = O_R, O_XBC = O_R, O_ST1 = O_XBC + (size_t)MT * XBCW * 2, O_ST0 = 0;
constexpr size_t ST_BATCH = (size_t)64 * 32 * 64 * 128;
static_assert(O_ST1 + ST_BATCH * 2 <= 268435456ull, "ws");
static_assert(ST_BATCH * 2 <= W_SOUT, "st0 overlay");
static_assert(O_MIXED + (size_t)MT * DM * 2 <= 268435456ull, "ws2");

struct Params { const float* in[23]; float* out; unsigned char* ws; };
#include <cstdlib>
#include <vector>

#define XB_TMO      128
#define XB_XCNT(j)  (256  + 64 * (j))
#define XB_XSUB(j)  (1280 + 64 * (j))
#define XB_XGEN(j)  (2304 + 64 * (j))
#define XB_TOP      3328
#define XB_TOPGEN   3392
#define XCD_BAR_WORDS 3456
#define XB_SPIN_CAP (1u << 18)

__device__ __forceinline__ unsigned xb_ld(unsigned* p)              { return __hip_atomic_load(p, __ATOMIC_RELAXED, __HIP_MEMORY_SCOPE_AGENT); }
__device__ __forceinline__ unsigned xb_add(unsigned* p, unsigned v) { return __hip_atomic_fetch_add(p, v, __ATOMIC_RELAXED, __HIP_MEMORY_SCOPE_AGENT); }
__device__ __forceinline__ unsigned xb_xcc_id() { return (unsigned)__builtin_amdgcn_s_getreg((3 << 11) | 20) & 0xFu; }
#define XB_SPIN(cond, bar) do { unsigned _sp = 0; while (cond) { __builtin_amdgcn_s_sleep(1); \
    if ((++_sp & 255u) == 0u) { if (xb_ld(&(bar)[XB_TMO])) break; if (_sp > XB_SPIN_CAP) { atomicAdd(&(bar)[XB_TMO], 1u); break; } } } } while (0)

struct XcdBarrier {
    unsigned* bar; unsigned x;
    volatile LAS unsigned* st;
};

__device__ __forceinline__ XcdBarrier xcd_barrier_post(unsigned* bar, volatile LAS unsigned* st) {
    XcdBarrier b; b.bar = bar; b.x = xb_xcc_id(); b.st = st;
    if (threadIdx.x == 0) (void)xb_add(&bar[XB_XCNT(b.x)], 1u);
    return b;
}
__device__ __forceinline__ void xcd_barrier_complete(unsigned* bar, unsigned x, unsigned& nloc, unsigned& nx) {
    const unsigned G = gridDim.x * gridDim.y * gridDim.z;
    unsigned sum, cnt, mine, sp = 0u;
    for (;;) {
        sum = 0u; cnt = 0u; mine = 0u;
#pragma unroll
        for (unsigned j = 0; j < 16; ++j) { const unsigned c = xb_ld(&bar[XB_XCNT(j)]); sum += c; cnt += (c > 0u) ? 1u : 0u; mine = (j == x) ? c : mine; }
        if (sum == G) break;
        __builtin_amdgcn_s_sleep(1);
        if ((++sp & 255u) == 0u) { if (xb_ld(&bar[XB_TMO])) break; if (sp > XB_SPIN_CAP) { atomicAdd(&bar[XB_TMO], 1u); break; } }
    }
    nloc = mine > 0u ? mine : 1u; nx = cnt > 0u ? cnt : 1u;
}

__device__ __forceinline__ void xcd_barrier(const XcdBarrier& b) {
    asm volatile("s_waitcnt vmcnt(0)" ::: "memory");
    __syncthreads();
    if (threadIdx.x == 0) {
        unsigned* bar = b.bar;
        __builtin_amdgcn_s_waitcnt(0);
        unsigned nloc = b.st[0], nx = b.st[1];
        if (nloc == 0u) { xcd_barrier_complete(bar, b.x, nloc, nx); b.st[0] = nloc; b.st[1] = nx; }
        const unsigned old = xb_add(&bar[XB_XSUB(b.x)], 1u);
        const unsigned gen = old / nloc;
        if (old + 1u == (gen + 1u) * nloc) {
            __builtin_amdgcn_fence(__ATOMIC_RELEASE, "agent");
            asm volatile("s_waitcnt vmcnt(0)" ::: "memory");
            const unsigned og = xb_add(&bar[XB_TOP], 1u);
            const unsigned tg = og / nx;
            if (og + 1u == (tg + 1u) * nx) xb_add(&bar[XB_TOPGEN], 1u);
            else XB_SPIN(xb_ld(&bar[XB_TOPGEN]) == tg, bar);
            __builtin_amdgcn_fence(__ATOMIC_ACQUIRE, "agent");
            xb_add(&bar[XB_XGEN(b.x)], 1u);
            asm volatile("s_waitcnt vmcnt(0)" ::: "memory");
        } else {
            XB_SPIN(xb_ld(&bar[XB_XGEN(b.x)]) == gen, bar);
            __builtin_amdgcn_fence(__ATOMIC_ACQUIRE, "agent");
            asm volatile("s_waitcnt vmcnt(0)" ::: "memory");
        }
    }
    __syncthreads();
}
DI void wmap(int mode, int c, int& src, float& scale, int& which) {
    src = c; scale = 1.f; which = 0;
    if (mode == 0) {
        if (c < 1024) { const int base = c & ~63, cc = c & 63, g = cc >> 3, e = cc & 7; src = base + (e < 4 ? 4 * g + e : 32 + 4 * g + (e - 4)); }
        if (c < 512) scale = 0.125f * LOG2E; else if (c >= 1536 && c < 2048) scale = 0.125f;
    } else if (mode == 2) { src = 4 * (c >> 3) + (c & 3); which = (c >> 2) & 1; }
    else if (mode == 3) { if (c >= SINW) src = -1; }
}
DI void wconv_tile(LAS float* tile, int mode, const float* W0, const float* W1, const float* kscale, bf16_t* dst, int K, int ldw, int tix) {
    const int tid = otid(), nk = K >> 8, c0 = (tix / nk) * 64, k0 = (tix % nk) * 256;
    const int cc = tid & 63; int src, which; float sc; wmap(mode, c0 + cc, src, sc, which);
    const float* W = (which ? W1 : W0) + (src >= 0 ? src : 0);
    float v[32];
#pragma unroll
    for (int i = 0; i < 32; ++i) { const int kk = (tid >> 6) + 8 * i; v[i] = W[(size_t)(k0 + kk) * ldw]; }
#pragma unroll
    for (int i = 0; i < 32; ++i) { const int kk = (tid >> 6) + 8 * i; float x = (src >= 0) ? v[i] * sc : 0.f; if (kscale) x *= kscale[k0 + kk]; tile[kk * 65 + cc] = x; }
    __syncthreads();
#pragma unroll
    for (int i = 0; i < 16; ++i) {
        const int idx = tid + 512 * i, c2 = idx >> 7, k2 = (idx & 127) * 2;
        *(unsigned*)(dst + (size_t)(c0 + c2) * K + k0 + k2) = pk2(tile[k2 * 65 + c2], tile[(k2 + 1) * 65 + c2]);
    }
    __syncthreads();
}
DI void phase0(LAS unsigned char* lds, const Params& p) {
    const int tid = otid(), G = gridDim.x, bx = blockIdx.x;
    unsigned char* ws = p.ws;
    const int cnt[8] = {48 * 4, 16 * 4, 88 * 4, 16 * 11, 100 * 4, 16 * 8, 88 * 4, 16 * 11};
    int total = 0;
#pragma unroll
    for (int j = 0; j < 8; ++j) total += cnt[j];
    for (int t = bx; t < total; t += G) {
        int j = 0, tt = t;
#pragma unroll
        for (int q = 0; q < 7; ++q) if (j == q && tt >= cnt[q]) { tt -= cnt[q]; j = q + 1; }
        LAS float* tile = (LAS float*)lds;
        switch (j) {
        case 0: wconv_tile(tile, 0, p.in[2], nullptr, p.in[1], (bf16_t*)(ws + W_AIN), DM, AINW, tt); break;
        case 1: wconv_tile(tile, 1, p.in[8], nullptr, nullptr, (bf16_t*)(ws + W_AOUT), DM, DM, tt); break;
        case 2: wconv_tile(tile, 2, p.in[19], p.in[20], p.in[18], (bf16_t*)(ws + W_GU0), DM, DFF, tt); break;
        case 3: wconv_tile(tile, 1, p.in[21], nullptr, nullptr, (bf16_t*)(ws + W_DN0), DFF, DM, tt); break;
        case 4: wconv_tile(tile, 3, p.in[10], nullptr, p.in[9], (bf16_t*)(ws + W_SIN), DM, SINW, tt); break;
        case 5: wconv_tile(tile, 1, p.in[17], nullptr, nullptr, (bf16_t*)(ws + W_SOUT), DIN, DM, tt); break;
        case 6: wconv_tile(tile, 2, p.in[19] + (size_t)DM * DFF, p.in[20] + (size_t)DM * DFF, p.in[18] + DM, (bf16_t*)(ws + W_GU1), DM, DFF, tt); break;
        default: wconv_tile(tile, 1, p.in[21] + (size_t)DFF * DM, nullptr, nullptr, (bf16_t*)(ws + W_DN1), DFF, DM, tt); break;
        }
    }
    {
        const int wave = tid >> 6, lane = tid & 63; bf16_t* hb = (bf16_t*)(ws + O_HB); float* ss = (float*)(ws + O_SS);
        for (int row = bx * 8 + wave; row < MT; row += G * 8) {
            const float* xr = p.in[0] + (size_t)row * DM; float sq = 0.f;
#pragma unroll
            for (int i = 0; i < 4; ++i) { const f32x4 v = *(const f32x4*)(xr + lane * 4 + 256 * i); sq += v[0] * v[0] + v[1] * v[1] + v[2] * v[2] + v[3] * v[3];
                u32x2 o; o[0] = pk2(v[0], v[1]); o[1] = pk2(v[2], v[3]); *(u32x2*)(hb + (size_t)row * DM + lane * 4 + 256 * i) = o; }
#pragma unroll
            for (int o = 32; o >= 1; o >>= 1) sq += __shfl_xor(sq, o);
            if (lane == 0) ss[row] = sq;
        }
        for (int i = bx * 512 + tid; i < 4 * MT; i += G * 512) ss[MT + i] = 0.f;
        f32x2* tab = (f32x2*)(ws + O_ROPE);
        for (int i = bx * 512 + tid; i < SEQ * 32; i += G * 512) {
            const int pos = i >> 5, f = i & 31; const float inv = fexp2(-(float)f * 0.41524101186092f); const float ang = (float)pos * inv;
            double t = (double)ang * 0.15915494309189535; t -= floor(t); const float tf = (float)t;
            f32x2 cs; cs[0] = __builtin_amdgcn_cosf(tf); cs[1] = __builtin_amdgcn_sinf(tf); tab[i] = cs;
        }
        if (bx == 0 && tid == 0) { float s1 = 0.f, s2 = 0.f; for (int i = 0; i < 64; ++i) { s1 += p.in[3][i] * p.in[4][i]; s2 += p.in[5][i] * p.in[6][i]; }
            *(float*)(ws + O_LAM) = fexp2(s1 * LOG2E) - fexp2(s2 * LOG2E) + 0.2f; }
    }
}

struct EpiAttnIn {
    static constexpr bool PERM = true, AFTER_DRAIN = false;
    bf16_t* O; const float* ss; const f32x4* tab;
    DI void operator()(const f32x4 (&acc)[2][2][4][2], const pg8::Unit& u, int wr, int wc, int fr, int fq) const {
        const int row0 = u.pm * 256 + wr * 64 + fr, colt = u.pn * 256, col0 = colt + wc * 32 + 8 * fq;
        const int fb = 4 * (4 * (wc & 1) + fq);
#pragma unroll
        for (int ai = 0; ai < 2; ++ai)
#pragma unroll
            for (int m = 0; m < 4; ++m) {
                const int row = row0 + ai * 128 + m * 16; const float rs = __builtin_amdgcn_rsqf(ss[row] * (1.0f / 1024.0f) + 1e-6f);
                f32x4 c01 = {1.f, 0.f, 1.f, 0.f}, c23 = {1.f, 0.f, 1.f, 0.f};
                if (colt < 1024) { const int pos = row & (SEQ - 1); c01 = tab[(pos * 32 + fb) >> 1]; c23 = tab[((pos * 32 + fb) >> 1) + 1]; }
#pragma unroll
                for (int bj = 0; bj < 2; ++bj) {
                    f32x4 v0 = acc[ai][bj][m][0] * rs, v1 = acc[ai][bj][m][1] * rs;
                    if (colt < 1024) {
                        const float cs[4] = {c01[0], c01[2], c23[0], c23[2]}, sn[4] = {c01[1], c01[3], c23[1], c23[3]};
#pragma unroll
                        for (int j = 0; j < 4; ++j) { const float t1 = v0[j], t2 = v1[j]; v0[j] = t1 * cs[j] - t2 * sn[j]; v1[j] = t2 * cs[j] + t1 * sn[j]; }
                    }
                    u32x4 o; o[0] = pk2(v0[0], v0[1]); o[1] = pk2(v0[2], v0[3]); o[2] = pk2(v1[0], v1[1]); o[3] = pk2(v1[2], v1[3]);
                    *(u32x4*)(O + (size_t)row * AINW + col0 + bj * 128) = o;
                }
            }
    }
};
template <bool RES_F32, bool OUT_F32> struct EpiRes {
    static constexpr bool PERM = false, AFTER_DRAIN = false;
    const float* xres; bf16_t* hb; float* outf; float* ssn;
    DI void operator()(const f32x4 (&acc)[2][2][4][2], const pg8::Unit& u, int wr, int wc, int fr, int fq) const {
        const int row0 = u.pm * 256 + wr * 64 + fr, col0 = u.pn * 256 + wc * 32 + 4 * fq;
#pragma unroll
        for (int ai = 0; ai < 2; ++ai)
#pragma unroll
            for (int m = 0; m < 4; ++m) {
                const int row = row0 + ai * 128 + m * 16; float sq = 0.f;
#pragma unroll
                for (int bj = 0; bj < 2; ++bj)
#pragma unroll
                    for (int n = 0; n < 2; ++n) {
                        const size_t off = (size_t)row * DM + col0 + bj * 128 + n * 16; f32x4 r;
                        if (RES_F32) r = *(const f32x4*)(xres + off);
                        else { const u32x2 t = *(const u32x2*)(hb + off); r[0] = bflo(t[0]); r[1] = bfhi(t[0]); r[2] = bflo(t[1]); r[3] = bfhi(t[1]); }
                        const f32x4 v = r + acc[ai][bj][m][n];
                        sq += v[0] * v[0] + v[1] * v[1] + v[2] * v[2] + v[3] * v[3];
                        if (OUT_F32) *(f32x4*)(outf + off) = v;
                        else { u32x2 o; o[0] = pk2(v[0], v[1]); o[1] = pk2(v[2], v[3]); *(u32x2*)(hb + off) = o; }
                    }
                sq += __shfl_xor(sq, 16); sq += __shfl_xor(sq, 32);
                if (fq == 0) atomicAdd(ssn + row, sq);
            }
    }
};
struct EpiGU {
    static constexpr bool PERM = true, AFTER_DRAIN = false;
    bf16_t* act; const float* ss;
    DI void operator()(const f32x4 (&acc)[2][2][4][2], const pg8::Unit& u, int wr, int wc, int fr, int fq) const {
        const int row0 = u.pm * 256 + wr * 64 + fr, col0 = u.pn * 256 + wc * 32 + 8 * fq;
#pragma unroll
        for (int ai = 0; ai < 2; ++ai)
#pragma unroll
            for (int m = 0; m < 4; ++m) {
                const int row = row0 + ai * 128 + m * 16; const float rs = __builtin_amdgcn_rsqf(ss[row] * (1.0f / 1024.0f) + 1e-6f);
#pragma unroll
                for (int bj = 0; bj < 2; ++bj) {
                    const f32x4 g = acc[ai][bj][m][0] * rs, up = acc[ai][bj][m][1] * rs; float a[4];
#pragma unroll
                    for (int j = 0; j < 4; ++j) a[j] = fsilu(g[j]) * up[j];
                    u32x2 o; o[0] = pk2(a[0], a[1]); o[1] = pk2(a[2], a[3]);
                    *(u32x2*)(act + (size_t)row * DFF + ((col0 + bj * 128) >> 1)) = o;
                }
            }
    }
};
struct EpiSsdIn {
    static constexpr bool PERM = true, AFTER_DRAIN = false;
    bf16_t* z; bf16_t* xbc; float* dt; const float* ss;
    DI void operator()(const f32x4 (&acc)[2][2][4][2], const pg8::Unit& u, int wr, int wc, int fr, int fq) const {
        const int row0 = u.pm * 256 + wr * 64 + fr, col0 = u.pn * 256 + wc * 32 + 8 * fq;
#pragma unroll
        for (int ai = 0; ai < 2; ++ai)
#pragma unroll
            for (int m = 0; m < 4; ++m) {
                const int row = row0 + ai * 128 + m * 16; const float rs = __builtin_amdgcn_rsqf(ss[row] * (1.0f / 1024.0f) + 1e-6f);
#pragma unroll
                for (int bj = 0; bj < 2; ++bj) {
                    const int c = col0 + bj * 128; const f32x4 v0 = acc[ai][bj][m][0] * rs, v1 = acc[ai][bj][m][1] * rs;
                    if (c < 6144) { u32x4 o; o[0] = pk2(v0[0], v0[1]); o[1] = pk2(v0[2], v0[3]); o[2] = pk2(v1[0], v1[1]); o[3] = pk2(v1[2], v1[3]);
                        if (c < DIN) *(u32x4*)(z + (size_t)row * DIN + c) = o; else *(u32x4*)(xbc + (size_t)row * XBCW + (c - DIN)) = o; }
                    else if (c < SINW) { *(f32x4*)(dt + (size_t)row * 32 + (c - 6144)) = v0; *(f32x4*)(dt + (size_t)row * 32 + (c - 6144) + 4) = v1; }
                }
            }
    }
};
constexpr int KST = 144, VST = 320, VST64 = 192;
constexpr int AT_K1 = 0, AT_K2 = 64 * KST, AT_V = 2 * 64 * KST, AT_STAGE = AT_V + 64 * VST;

DI void diff_qk(f32x16 (&S)[2], const LAS unsigned char* Kb, const bf16x8 (&qf)[4], float negm, int r, int h) {
#pragma unroll
    for (int kt = 0; kt < 2; ++kt) {
#pragma unroll
        for (int i = 0; i < 16; ++i) S[kt][i] = negm;
#pragma unroll
        for (int s = 0; s < 4; ++s) { const bf16x8 kf = *(const LAS bf16x8*)(Kb + (32 * kt + r) * KST + (16 * s + 8 * h) * 2); S[kt] = MFMA32(kf, qf[s], S[kt]); } }
}
DI float diff_mask_max(f32x16 (&S)[2], int kbase, int qlo, int qidx, int h) {
    if (kbase + 63 > qlo) {
#pragma unroll
        for (int kt = 0; kt < 2; ++kt)
#pragma unroll
            for (int i = 0; i < 16; ++i) if (kbase + 32 * kt + crow(i, h) > qidx) S[kt][i] = -1e30f;
    }
    float mx = S[0][0];
#pragma unroll
    for (int kt = 0; kt < 2; ++kt)
#pragma unroll
        for (int i = 0; i < 16; ++i) mx = fmaxf(mx, S[kt][i]);
    return fmaxf(mx, __shfl_xor(mx, 32));
}
DI void diff_tile(LAS unsigned char* lds, const bf16_t* proj, bf16_t* mixed, const float* subln, float lam, int b, int hd, int qt) {
    const int tid = otid(), w = __builtin_amdgcn_readfirstlane(tid >> 6), lane = tid & 63, qg = w & 3, mp = w >> 2, r = lane & 31, h = lane >> 5;
    const int q0 = qt * 128; const size_t rowb = (size_t)b * SEQ;
    bf16x8 qf[4];
    { const bf16_t* qp = proj + (rowb + q0 + 32 * qg + r) * AINW + hd * 128 + mp * 64 + 8 * h;
#pragma unroll
      for (int s = 0; s < 4; ++s) qf[s] = *(const bf16x8*)(qp + 16 * s); }
    f32x16 O[4];
#pragma unroll
    for (int i = 0; i < 4; ++i) O[i] = zero16();
    float mrun = 0.f, lrun = 0.f;
    const int nsteps = 2 * (qt + 1);
    const bf16_t* src[4]; int dst[4];
#pragma unroll
    for (int i = 0; i < 2; ++i) { const int cid = tid + 512 * i, row = cid >> 4, c16 = cid & 15;
        src[i] = proj + (rowb + row) * AINW + 512 + hd * 128 + c16 * 8; dst[i] = (c16 < 8 ? AT_K1 : AT_K2) + row * KST + (c16 & 7) * 16;
        src[2 + i] = proj + (rowb + row) * AINW + 1024 + hd * 128 + c16 * 8; dst[2 + i] = AT_V + row * VST + c16 * 16; }
    u32x4 pf[4];
#pragma unroll
    for (int i = 0; i < 4; ++i) pf[i] = *(const u32x4*)(src[i]);
#pragma unroll
    for (int i = 0; i < 4; ++i) *(LAS u32x4*)(lds + dst[i]) = pf[i];
#pragma unroll
    for (int i = 0; i < 4; ++i) pf[i] = *(const u32x4*)(src[i] + (size_t)64 * AINW);
    u32x4 pfA[4];
    if (nsteps > 2) {
#pragma unroll
        for (int i = 0; i < 4; ++i) pfA[i] = *(const u32x4*)(src[i] + (size_t)128 * AINW);
    } else {
#pragma unroll
        for (int i = 0; i < 4; ++i) pfA[i] = pf[i];
    }
    __syncthreads();
    const int i16 = lane & 15, tq = i16 >> 2, tp = i16 & 3, g16 = (lane >> 4) & 1;
    const int troff = (4 * h + tq) * VST + (16 * g16 + 4 * tp) * 2;
    const int qidx = q0 + 32 * qg + r, qlo = q0 + 32 * qg, koff = mp ? AT_K2 : AT_K1;
    bf16x8 P[2][2];
    {
        f32x16 S[2];
        diff_qk(S, lds + koff, qf, 0.f, r, h);
        const float mx = diff_mask_max(S, 0, qlo, qidx, h);
        mrun = mx; float ls = 0.f;
#pragma unroll
        for (int kt = 0; kt < 2; ++kt)
#pragma unroll
            for (int i = 0; i < 16; ++i) { const float pv = fexp2(S[kt][i] - mx); S[kt][i] = pv; ls += pv; }
        lrun = ls;
#pragma unroll
        for (int kt = 0; kt < 2; ++kt)
#pragma unroll
            for (int s2 = 0; s2 < 2; ++s2) P[kt][s2] = pack8(S[kt], s2);
    }
#pragma unroll
    for (int i = 0; i < 4; ++i) *(LAS u32x4*)(lds + AT_STAGE + dst[i]) = pf[i];
    __syncthreads();
    int bcur = 0, bnxt = 1, bnn = 2;
    for (int j = 0; j + 1 < nsteps; ++j) {
        if (j + 3 < nsteps) {
#pragma unroll
            for (int i = 0; i < 4; ++i) pf[i] = *(const u32x4*)(src[i] + (size_t)(j + 3) * 64 * AINW);
        }
        f32x16 S[2];
        diff_qk(S, lds + bnxt * AT_STAGE + koff, qf, -mrun, r, h);
        const float mx = diff_mask_max(S, 64 * (j + 1), qlo, qidx, h);
        const LAS unsigned char* Vb = lds + bcur * AT_STAGE + AT_V + troff;
        if (__builtin_amdgcn_ballot_w64(mx > 64.0f) != 0ull) {
            const float d = fmaxf(mx, 0.f), alpha = fexp2(-d); mrun += d; lrun *= alpha;
#pragma unroll
            for (int kt = 0; kt < 2; ++kt)
#pragma unroll
                for (int s2 = 0; s2 < 2; ++s2) {
                    const LAS unsigned char* vrow = Vb + (32 * kt + 16 * s2) * VST;
#pragma unroll
                    for (int vt = 0; vt < 4; ++vt) { const bf16x8 vf = tr2(vrow + vt * 64, vrow + 8 * VST + vt * 64); O[vt] = MFMA32(vf, P[kt][s2], O[vt]); }
                    P[kt][s2] = (bf16x8){0, 0, 0, 0, 0, 0, 0, 0};
                }
#pragma unroll
            for (int vt = 0; vt < 4; ++vt) O[vt] = O[vt] * alpha;
#pragma unroll
            for (int kt = 0; kt < 2; ++kt)
#pragma unroll
                for (int i = 0; i < 16; ++i) S[kt][i] -= d;
        }
        float ls = 0.f;
#pragma unroll
        for (int kt = 0; kt < 2; ++kt)
#pragma unroll
            for (int s2 = 0; s2 < 2; ++s2) {
                const LAS unsigned char* vrow = Vb + (32 * kt + 16 * s2) * VST;
#pragma unroll
                for (int vt = 0; vt < 4; ++vt) { const bf16x8 vf = tr2(vrow + vt * 64, vrow + 8 * VST + vt * 64); O[vt] = MFMA32(vf, P[kt][s2], O[vt]); }
#pragma unroll
                for (int i = 0; i < 8; ++i) { const float pv = fexp2(S[kt][8 * s2 + i]); S[kt][8 * s2 + i] = pv; ls += pv; }
            }
        lrun += ls;
        bf16x8 Pn[2][2];
#pragma unroll
        for (int kt = 0; kt < 2; ++kt)
#pragma unroll
            for (int s2 = 0; s2 < 2; ++s2) Pn[kt][s2] = pack8(S[kt], s2);
        __builtin_amdgcn_sched_group_barrier(0x100, 8, 0);
#pragma unroll
        for (int q = 0; q < 16; ++q) { __builtin_amdgcn_sched_group_barrier(0x008, 1, 0); __builtin_amdgcn_sched_group_barrier(0x100, 2, 0); __builtin_amdgcn_sched_group_barrier(0x002, 6, 0); }
#pragma unroll
        for (int kt = 0; kt < 2; ++kt)
#pragma unroll
            for (int s2 = 0; s2 < 2; ++s2) P[kt][s2] = Pn[kt][s2];
#pragma unroll
        for (int i = 0; i < 4; ++i) *(LAS u32x4*)(lds + bnn * AT_STAGE + dst[i]) = pfA[i];
#pragma unroll
        for (int i = 0; i < 4; ++i) pfA[i] = pf[i];
        __syncthreads();
        const int tb = bcur; bcur = bnxt; bnxt = bnn; bnn = tb;
    }
    {
        const LAS unsigned char* Vb = lds + bcur * AT_STAGE + AT_V + troff;
#pragma unroll
        for (int kt = 0; kt < 2; ++kt)
#pragma unroll
            for (int s2 = 0; s2 < 2; ++s2) {
                const LAS unsigned char* vrow = Vb + (32 * kt + 16 * s2) * VST;
#pragma unroll
                for (int vt = 0; vt < 4; ++vt) { const bf16x8 vf = tr2(vrow + vt * 64, vrow + 8 * VST + vt * 64); O[vt] = MFMA32(vf, P[kt][s2], O[vt]); }
            }
    }
    __syncthreads();
    lrun += __shfl_xor(lrun, 32);
    const float inv = frcp(lrun);
    LAS float* ex = (LAS float*)lds;
    if (mp == 1) {
        const float sc = inv * lam;
#pragma unroll
        for (int vt = 0; vt < 4; ++vt)
#pragma unroll
            for (int i = 0; i < 16; ++i) ex[(qg * 128 + 32 * vt + crow(i, h)) * 32 + r] = O[vt][i] * sc;
    }
    __syncthreads();
    if (mp == 0) {
        float sq = 0.f;
#pragma unroll
        for (int vt = 0; vt < 4; ++vt)
#pragma unroll
            for (int i = 0; i < 16; ++i) { const float o = O[vt][i] * inv - ex[(qg * 128 + 32 * vt + crow(i, h)) * 32 + r]; O[vt][i] = o; sq += o * o; }
        sq += __shfl_xor(sq, 32);
        const float rn = __builtin_amdgcn_rsqf(sq * (1.0f / 128.0f) + 1e-5f) * 0.8f;
        bf16_t* op = mixed + (rowb + q0 + 32 * qg + r) * DM + hd * 128;
#pragma unroll
        for (int vt = 0; vt < 4; ++vt)
#pragma unroll
            for (int gq = 0; gq < 4; ++gq) { const int v0 = 32 * vt + 8 * gq + 4 * h; const f32x4 wv = *(const f32x4*)(subln + v0);
                u32x2 o; o[0] = pk2(O[vt][4 * gq] * rn * wv[0], O[vt][4 * gq + 1] * rn * wv[1]); o[1] = pk2(O[vt][4 * gq + 2] * rn * wv[2], O[vt][4 * gq + 3] * rn * wv[3]);
                *(u32x2*)(op + v0) = o; }
    }
    __syncthreads();
}

constexpr int SB_K = 0, SB_V = 64 * KST, SB_STAGE = 64 * KST + 64 * VST64;
DI void sb_block(LAS unsigned char* lds, const bf16_t* proj, bf16_t* mixed, int b, int hs, int qb) {
    const int tid = otid(), w = __builtin_amdgcn_readfirstlane(tid >> 6), lane = tid & 63, r = lane & 31, h = lane >> 5;
    const int q0 = qb * 256; const size_t rowb = (size_t)b * SEQ;
    const int qidx = q0 + 32 * w + r;
    bf16x8 qf[4];
    { const bf16_t* qp = proj + (rowb + qidx) * AINW + 1536 + hs * 64 + 8 * h;
#pragma unroll
      for (int s = 0; s < 4; ++s) qf[s] = *(const bf16x8*)(qp + 16 * s); }
    f32x16 O[2]; O[0] = zero16(); O[1] = zero16();
    float carry = 1.0f;
    const int jmax = 4 * qb + 3;
    const int srow = tid >> 3, sc8 = tid & 7;
    const bf16_t* srcK = proj + (rowb + srow) * AINW + 2048 + hs * 64 + sc8 * 8;
    const bf16_t* srcV = proj + (rowb + srow) * AINW + 2560 + hs * 64 + sc8 * 8;
    const int dstK = SB_K + srow * KST + sc8 * 16, dstV = SB_V + srow * VST64 + sc8 * 16;
    u32x4 pk_ = *(const u32x4*)(srcK + (size_t)jmax * 64 * AINW), pv_ = *(const u32x4*)(srcV + (size_t)jmax * 64 * AINW);
    *(LAS u32x4*)(lds + dstK) = pk_; *(LAS u32x4*)(lds + dstV) = pv_;
    __syncthreads();
    const int i16 = lane & 15, tq = i16 >> 2, tp = i16 & 3, g16 = (lane >> 4) & 1;
    const int troff = (4 * h + tq) * VST64 + (16 * g16 + 4 * tp) * 2;
    int it = 0;
    for (int j = jmax; j >= 0; --j, ++it) {
        const bool more = (j > 0);
        if (more) { pk_ = *(const u32x4*)(srcK + (size_t)(j - 1) * 64 * AINW); pv_ = *(const u32x4*)(srcV + (size_t)(j - 1) * 64 * AINW); }
        const LAS unsigned char* base = lds + (it & 1) * SB_STAGE;
        const int kbase = 64 * j;
        if (kbase < q0 + 32 * w + 32) {
#pragma unroll
            for (int kt = 1; kt >= 0; --kt) {
                f32x16 S = zero16();
#pragma unroll
                for (int s = 0; s < 4; ++s) { const bf16x8 kf = *(const LAS bf16x8*)(base + SB_K + (32 * kt + r) * KST + (16 * s + 8 * h) * 2); S = MFMA32(kf, qf[s], S); }
                float T[4], sfx[16];
#pragma unroll
                for (int gq = 0; gq < 4; ++gq) {
                    float run = 1.0f;
#pragma unroll
                    for (int jj = 3; jj >= 0; --jj) {
                        const int i = 4 * gq + jj; const bool valid = (kbase + 32 * kt + crow(i, h)) < qidx;
                        const float zz = fmaxf(S[i], -60.0f); const float e = fexp2(-LOG2E * zz); const float sg = frcp(1.0f + e);
                        const float keep = valid ? e * sg : 1.0f;
                        S[i] = valid ? sg : 0.0f; sfx[i] = run; run *= keep;
                    }
                    T[gq] = run;
                }
                float To[4];
#pragma unroll
                for (int gq = 0; gq < 4; ++gq) To[gq] = __shfl_xor(T[gq], 32);
                float E[4]; float acc_hi = 1.0f;
#pragma unroll
                for (int gq = 3; gq >= 0; --gq) {
                    const float above_same = acc_hi;
                    E[gq] = (h == 0) ? above_same * To[gq] : above_same;
                    acc_hi = acc_hi * T[gq] * To[gq];
                }
#pragma unroll
                for (int i = 0; i < 16; ++i) S[i] = S[i] * carry * E[i >> 2] * sfx[i];
                carry *= acc_hi;
#pragma unroll
                for (int s2 = 0; s2 < 2; ++s2) {
                    const bf16x8 pfr = pack8(S, s2);
                    const LAS unsigned char* vrow = base + SB_V + (32 * kt + 16 * s2) * VST64 + troff;
#pragma unroll
                    for (int vt = 0; vt < 2; ++vt) { const bf16x8 vf = tr2(vrow + vt * 64, vrow + 8 * VST64 + vt * 64); O[vt] = MFMA32(vf, pfr, O[vt]); }
                }
            }
        }
        if (more) { LAS unsigned char* nb = lds + ((it + 1) & 1) * SB_STAGE; *(LAS u32x4*)(nb + dstK) = pk_; *(LAS u32x4*)(nb + dstV) = pv_; }
        const int done = (kbase < q0 + 32 * w + 32) && (carry < 1e-12f);
        const bool wdone = (__builtin_amdgcn_ballot_w64(done != 0) == ~0ull);
        LAS int* flg = (LAS int*)(lds + 2 * SB_STAGE) + (it & 1) * 8;
        if (lane == 0) flg[w] = wdone ? 1 : 0;
        __syncthreads();
        int all = 1;
#pragma unroll
        for (int ww = 0; ww < 8; ++ww) all &= flg[ww];
        if (all) break;
    }
    bf16_t* op = mixed + (rowb + qidx) * DM + 512 + hs * 64;
#pragma unroll
    for (int vt = 0; vt < 2; ++vt)
#pragma unroll
        for (int gq = 0; gq < 4; ++gq) { const int v0 = 32 * vt + 8 * gq + 4 * h;
            u32x2 o; o[0] = pk2(O[vt][4 * gq], O[vt][4 * gq + 1]); o[1] = pk2(O[vt][4 * gq + 2], O[vt][4 * gq + 3]); *(u32x2*)(op + v0) = o; }
    __syncthreads();
}
DI void attn_diff_all(LAS unsigned char* lds, const Params& p) {
    const bf16_t* proj = (const bf16_t*)(p.ws + O_PROJ); bf16_t* mixed = (bf16_t*)(p.ws + O_MIXED);
    const float lam = *(const float*)(p.ws + O_LAM);
    for (int it0 = blockIdx.x; it0 < 256; it0 += gridDim.x) {
        const int it = (it0 & 7) * 32 + (it0 >> 3);
        const int b = it >> 7, hd = (it >> 5) & 3, pr = it & 31;
        diff_tile(lds, proj, mixed, p.in[7], lam, b, hd, 63 - pr);
        diff_tile(lds, proj, mixed, p.in[7], lam, b, hd, pr);
    }
}
DI void attn_sb_all(LAS unsigned char* lds, const Params& p) {
    const bf16_t* proj = (const bf16_t*)(p.ws + O_PROJ); bf16_t* mixed = (bf16_t*)(p.ws + O_MIXED);
    for (int it0 = blockIdx.x; it0 < 512; it0 += gridDim.x) {
        const int it = (it0 & 7) * 64 + (it0 >> 3);
        const int b = it >> 8, hs = (it >> 5) & 7, qb = it & 31;
        sb_block(lds, proj, mixed, b, hs, qb);
    }
}
DI void attn_phase(LAS unsigned char* lds, const Params& p) {
    attn_diff_all(lds, p);
#ifdef DUP_DIFF
    attn_diff_all(lds, p);
#endif
    attn_sb_all(lds, p);
#ifdef DUP_SB
    attn_sb_all(lds, p);
#endif
}
constexpr int SXS = 528, SBS = 272;
constexpr int L_SX = 0, L_SB = 128 * SXS, L_SC = L_SB + 128 * SBS, L_SDT = L_SC + 128 * SBS, L_SAC = L_SDT + 2048, L_SSQ = L_SAC + 2048;
static_assert(L_SSQ + 4096 <= LDS_BYTES, "lds");

DI void ssd_dt_acum(LAS unsigned char* lds, const float* DT, const float* dt_bias, const float* a_log, size_t t0, int g) {
    LAS float* sdt = (LAS float*)(lds + L_SDT); LAS float* sac = (LAS float*)(lds + L_SAC);
    const int tid = otid(), hh = tid >> 7, l = tid & 127, head = 4 * g + hh, w = tid >> 6, lane = tid & 63;
    const float raw = DT[(t0 + l) * 32 + head] + dt_bias[head];
    const float dt = fmaxf(raw, 0.f) + __logf(1.0f + __expf(-fabsf(raw)));
    sdt[hh * 128 + l] = dt; sac[hh * 128 + l] = -dt * __expf(a_log[head]);
    __syncthreads();
    if (w < 4) {
        const float v0 = sac[w * 128 + 2 * lane], v1 = sac[w * 128 + 2 * lane + 1]; float s = v0 + v1;
#pragma unroll
        for (int off = 1; off < 64; off <<= 1) { const float t = __shfl_up(s, off); if (lane >= off) s += t; }
        const float ex = s - (v0 + v1);
        sac[w * 128 + 2 * lane] = ex + v0; sac[w * 128 + 2 * lane + 1] = ex + v0 + v1;
    }
    __syncthreads();
}
template <int NT, class F> DI void conv_strip(const bf16_t* src, int nzero, const float* cw, const float* cb, int ch, F&& emit) {
    f32x4 wlo[4], whi[4];
#pragma unroll
    for (int k = 0; k < 4; ++k) { wlo[k] = *(const f32x4*)(cw + k * XBCW + ch); whi[k] = *(const f32x4*)(cw + k * XBCW + ch + 4); }
    const f32x4 blo = *(const f32x4*)(cb + ch), bhi = *(const f32x4*)(cb + ch + 4);
    u32x4 raw[NT + 3];
#pragma unroll
    for (int i = 0; i < NT + 3; ++i) { const int ii = (i < nzero) ? nzero : i; raw[i] = *(const u32x4*)(src + (ptrdiff_t)(ii - 3) * XBCW); if (i < nzero) raw[i] = (u32x4){0u, 0u, 0u, 0u}; }
#pragma unroll
    for (int t = 0; t < NT; ++t) {
        float o[8];
#pragma unroll
        for (int e = 0; e < 8; ++e) {
            float a = (e < 4) ? blo[e & 3] : bhi[e & 3];
#pragma unroll
            for (int k = 0; k < 4; ++k) { const unsigned d = raw[t + k][e >> 1]; const float xv = (e & 1) ? bfhi(d) : bflo(d); a += ((e < 4) ? wlo[k][e & 3] : whi[k][e & 3]) * xv; }
            o[e] = fsilu(a);
        }
        emit(t, o);
    }
}
DI u32x4 pack8f(const float* o) { u32x4 r; r[0] = pk2(o[0], o[1]); r[1] = pk2(o[2], o[3]); r[2] = pk2(o[4], o[5]); r[3] = pk2(o[6], o[7]); return r; }

template <bool XW, bool WITH_C> DI void ssd_stage(LAS unsigned char* lds, const bf16_t* xbc, const float* cw, const float* cb, size_t t0, int c, int g) {
    const int tid = otid();
    LAS float* sdt = (LAS float*)(lds + L_SDT); LAS float* sac = (LAS float*)(lds + L_SAC);
    {
        const int c8 = tid & 31, tg = tid >> 5, l0 = 8 * tg, ch = 256 * g + 8 * c8, hh = c8 >> 3;
        const int nzero = (c == 0) ? (3 - l0 > 0 ? 3 - l0 : 0) : 0;
        const float alast = sac[hh * 128 + 127];
        conv_strip<8>(xbc + (t0 + l0) * XBCW + ch, nzero, cw, cb, ch, [&](int t, float* o) {
            if (XW) { const float wgt = sdt[hh * 128 + l0 + t] * __expf(alast - sac[hh * 128 + l0 + t]);
#pragma unroll
                for (int e = 0; e < 8; ++e) o[e] *= wgt; }
            *(LAS u32x4*)(lds + L_SX + (l0 + t) * SXS + c8 * 16) = pack8f(o); });
    }
    {
        const int c8 = tid & 15, tg = tid >> 4, l0 = 4 * tg;
        const int nzero = (c == 0) ? (3 - l0 > 0 ? 3 - l0 : 0) : 0;
        const int chb = DIN + 128 * g + 8 * c8;
        conv_strip<4>(xbc + (t0 + l0) * XBCW + chb, nzero, cw, cb, chb, [&](int t, float* o) { *(LAS u32x4*)(lds + L_SB + (l0 + t) * SBS + c8 * 16) = pack8f(o); });
        if (WITH_C) { const int chc = DIN + 1024 + 128 * g + 8 * c8;
            conv_strip<4>(xbc + (t0 + l0) * XBCW + chc, nzero, cw, cb, chc, [&](int t, float* o) { *(LAS u32x4*)(lds + L_SC + (l0 + t) * SBS + c8 * 16) = pack8f(o); }); }
    }
}
DI bf16_t* st_ptr(unsigned char* ws, int b) { return (bf16_t*)(ws + (b ? O_ST1 : O_ST0)); }

DI void ssd_states_phase(LAS unsigned char* lds, const Params& p) {
    const int tid = otid(), w = __builtin_amdgcn_readfirstlane(tid >> 6), lane = tid & 63, r = lane & 31, h = lane >> 5, hh = w >> 1, ph = w & 1;
    const bf16_t* xbc = (const bf16_t*)(p.ws + O_XBC); const float* DT = (const float*)(p.ws + O_DT); float* cdec = (float*)(p.ws + O_CDEC);
    const int i16 = lane & 15, tq = i16 >> 2, tp = i16 & 3, g16 = (lane >> 4) & 1;
    for (int it = blockIdx.x; it < 1024; it += gridDim.x) {
        const int b = it >> 9, c = (it >> 3) & 63, g = it & 7; const size_t t0 = (size_t)b * SEQ + (size_t)c * 128;
        ssd_dt_acum(lds, DT, p.in[13], p.in[14], t0, g);
        ssd_stage<true, false>(lds, xbc, p.in[11], p.in[12], t0, c, g);
        __syncthreads();
        f32x16 acc[4];
#pragma unroll
        for (int i = 0; i < 4; ++i) acc[i] = zero16();
        const LAS unsigned char* xa = lds + L_SX + (8 * h + tq) * SXS + (64 * hh + 32 * ph + 16 * g16 + 4 * tp) * 2;
        const LAS unsigned char* ba = lds + L_SB + (8 * h + tq) * SBS + (16 * g16 + 4 * tp) * 2;
#pragma unroll
        for (int s = 0; s < 8; ++s) {
            const bf16x8 af = tr2(xa + 16 * s * SXS, xa + (16 * s + 4) * SXS);
#pragma unroll
            for (int nt = 0; nt < 4; ++nt) { const bf16x8 bfr = tr2(ba + 16 * s * SBS + nt * 64, ba + (16 * s + 4) * SBS + nt * 64); acc[nt] = MFMA32(af, bfr, acc[nt]); }
        }
        bf16_t* st = st_ptr(p.ws, b) + ((size_t)(c * 32 + 4 * g + hh) * 64 + 32 * ph) * 128;
#pragma unroll
        for (int nt = 0; nt < 4; ++nt)
#pragma unroll
            for (int i = 0; i < 16; ++i) st[(size_t)crow(i, h) * 128 + 32 * nt + r] = (bf16_t)(pk2(acc[nt][i], 0.f) & 0xffffu);
        if (tid < 4) cdec[(b * 64 + c) * 32 + 4 * g + tid] = __expf(((LAS float*)(lds + L_SAC))[tid * 128 + 127]);
        __syncthreads();
    }
}
DI void ssd_scan_phase(const Params& p, const bool dry) {
    const float* cdec = (const float*)(p.ws + O_CDEC);
    for (int e = blockIdx.x * 512 + threadIdx.x; e < 2 * 32 * 64 * 32; e += gridDim.x * 512) {
        const int b = e >> 16, rem = e & 65535, head = rem >> 11;
        bf16_t* st = st_ptr(p.ws, b) + (size_t)rem * 4;
        float carry[4] = {0.f, 0.f, 0.f, 0.f};
        for (int c0 = 0; c0 < 64; c0 += 8) {
            u32x2 v[8]; float dc[8];
#pragma unroll
            for (int u = 0; u < 8; ++u) { v[u] = *(const u32x2*)(st + (size_t)(c0 + u) * 262144); dc[u] = cdec[(b * 64 + c0 + u) * 32 + head]; }
#pragma unroll
            for (int u = 0; u < 8; ++u) {
                u32x2 o; o[0] = pk2(carry[0], carry[1]); o[1] = pk2(carry[2], carry[3]); if (!dry) *(u32x2*)(st + (size_t)(c0 + u) * 262144) = o;
                carry[0] = carry[0] * dc[u] + bflo(v[u][0]); carry[1] = carry[1] * dc[u] + bfhi(v[u][0]); carry[2] = carry[2] * dc[u] + bflo(v[u][1]); carry[3] = carry[3] * dc[u] + bfhi(v[u][1]);
            }
        }
    }
}
DI void ssd_out_phase(LAS unsigned char* lds, const Params& p, const bool dry) {
    const int tid = otid(), w = __builtin_amdgcn_readfirstlane(tid >> 6), lane = tid & 63, r = lane & 31, h = lane >> 5, hh = w >> 1, ph = w & 1;
    const bf16_t* xbc = (const bf16_t*)(p.ws + O_XBC); const float* DT = (const float*)(p.ws + O_DT); bf16_t* zy = (bf16_t*)p.out;
    LAS float* sdt = (LAS float*)(lds + L_SDT); LAS float* sac = (LAS float*)(lds + L_SAC); LAS float* ssq = (LAS float*)(lds + L_SSQ);
    const int i16 = lane & 15, tq = i16 >> 2, tp = i16 & 3, g16 = (lane >> 4) & 1;
    for (int it = blockIdx.x; it < 1024; it += gridDim.x) {
        const int b = it >> 9, c = (it >> 3) & 63, g = it & 7, head = 4 * g + hh; const size_t t0 = (size_t)b * SEQ + (size_t)c * 128;
        ssd_dt_acum(lds, DT, p.in[13], p.in[14], t0, g);
        ssd_stage<false, true>(lds, xbc, p.in[11], p.in[12], t0, c, g);
        bf16x8 pvf[8];
        { const bf16_t* pp = st_ptr(p.ws, b) + ((size_t)(c * 32 + head) * 64 + 32 * ph + r) * 128 + 8 * h;
#pragma unroll
          for (int s = 0; s < 8; ++s) pvf[s] = *(const bf16x8*)(pp + 16 * s); }
        __syncthreads();
        f32x16 Y[4];
        const LAS unsigned char* xa = lds + L_SX + (4 * h + tq) * SXS + (64 * hh + 32 * ph + 16 * g16 + 4 * tp) * 2;
#pragma unroll
        for (int lt = 0; lt < 4; ++lt) {
            __builtin_amdgcn_sched_barrier(0);
            f32x16 y = zero16();
#pragma unroll
            for (int s = 0; s < 8; ++s) { const bf16x8 cfs = *(const LAS bf16x8*)(lds + L_SC + (32 * lt + r) * SBS + (16 * s + 8 * h) * 2); y = MFMA32(pvf[s], cfs, y); }
            Y[lt] = y * __expf(sac[hh * 128 + 32 * lt + r]);
        }
#pragma unroll
        for (int lt = 0; lt < 4; ++lt) {
            __builtin_amdgcn_sched_barrier(0);
            bf16x8 cf[8];
#pragma unroll
            for (int s = 0; s < 8; ++s) cf[s] = *(const LAS bf16x8*)(lds + L_SC + (32 * lt + r) * SBS + (16 * s + 8 * h) * 2);
            const float al = sac[hh * 128 + 32 * lt + r];
#pragma unroll
            for (int mt = 0; mt < 4; ++mt) {
                if (mt <= lt) {
                    __builtin_amdgcn_sched_barrier(0);
                    f32x16 X = zero16();
#pragma unroll
                    for (int s = 0; s < 8; ++s) { const bf16x8 bfr = *(const LAS bf16x8*)(lds + L_SB + (32 * mt + r) * SBS + (16 * s + 8 * h) * 2); X = MFMA32(bfr, cf[s], X); }
#pragma unroll
                    for (int gq = 0; gq < 4; ++gq) {
                        const f32x4 am = *(const LAS f32x4*)(sac + hh * 128 + 32 * mt + 8 * gq + 4 * h), dm = *(const LAS f32x4*)(sdt + hh * 128 + 32 * mt + 8 * gq + 4 * h);
#pragma unroll
                        for (int jj = 0; jj < 4; ++jj) { const int mrow = 32 * mt + 8 * gq + 4 * h + jj; const bool ok = (32 * lt + r) >= mrow;
                            const float dec = ok ? __expf(fminf(al - am[jj], 0.f)) * dm[jj] : 0.f; X[4 * gq + jj] *= dec; }
                    }
#pragma unroll
                    for (int s2 = 0; s2 < 2; ++s2) { const bf16x8 xs = pack8(X, s2);
                        const LAS unsigned char* xr = xa + (32 * mt + 16 * s2) * SXS; const bf16x8 xf = tr2(xr, xr + 8 * SXS); Y[lt] = MFMA32(xf, xs, Y[lt]); }
                }
            }
        }
        __builtin_amdgcn_sched_barrier(0);
        const float Dh = p.in[15][head];
        float sq[4];
#pragma unroll
        for (int lt = 0; lt < 4; ++lt) {
            const int l = 32 * lt + r; sq[lt] = 0.f;
#pragma unroll
            for (int gq = 0; gq < 4; ++gq) {
                const int chl = 64 * hh + 32 * ph + 8 * gq + 4 * h;
                const u32x2 xv = *(const LAS u32x2*)(lds + L_SX + l * SXS + chl * 2);
                const u32x2 zv = *(const u32x2*)(zy + (t0 + l) * DIN + 256 * g + chl);
                const float xf4[4] = {bflo(xv[0]), bfhi(xv[0]), bflo(xv[1]), bfhi(xv[1])}, zf4[4] = {bflo(zv[0]), bfhi(zv[0]), bflo(zv[1]), bfhi(zv[1])};
#pragma unroll
                for (int jj = 0; jj < 4; ++jj) { const float yv = (Y[lt][4 * gq + jj] + Dh * xf4[jj]) * fsilu(zf4[jj]); Y[lt][4 * gq + jj] = yv; sq[lt] += yv * yv; }
            }
            sq[lt] += __shfl_xor(sq[lt], 32);
            if (h == 0) ssq[w * 128 + l] = sq[lt];
        }
        __syncthreads();
#pragma unroll
        for (int lt = 0; lt < 4; ++lt) {
            const int l = 32 * lt + r; float tot = 0.f;
#pragma unroll
            for (int ww = 0; ww < 8; ++ww) tot += ssq[ww * 128 + l];
            const float rn = __builtin_amdgcn_rsqf(tot * (1.0f / 256.0f) + 1e-5f);
#pragma unroll
            for (int gq = 0; gq < 4; ++gq) {
                const int chl = 64 * hh + 32 * ph + 8 * gq + 4 * h; const f32x4 gw = *(const f32x4*)(p.in[16] + 256 * g + chl);
                u32x2 o; o[0] = pk2(Y[lt][4 * gq] * rn * gw[0], Y[lt][4 * gq + 1] * rn * gw[1]); o[1] = pk2(Y[lt][4 * gq + 2] * rn * gw[2], Y[lt][4 * gq + 3] * rn * gw[3]);
                if (!dry) *(u32x2*)(zy + (t0 + l) * DIN + 256 * g + chl) = o;
            }
        }
        __syncthreads();
    }
}
template <class Epi> DI void run_gemm(LAS unsigned char* lds, const bf16_t* A, const bf16_t* Bt, int N, int K, const Epi& E) {
    pg8::Gemm g; g.A = A; g.Bt = Bt; g.M = MT; g.N = N; g.K = K;
    pg8::StaticOrder S; S.init(MT, N, (int)gridDim.x, (int)blockIdx.x);
    pg8::gemm_phase<Epi, pg8::StaticOrder, false>((PG8_LAS unsigned char*)lds, g, S, E, nullptr);
}
#if defined(DRY_S3) || defined(DRY_S4)
#define DRYV (p.ws == nullptr)
#else
#define DRYV false
#endif
__global__ void __launch_bounds__(512, 2) fwd_megakernel(Params p) {
    extern __shared__ __attribute__((aligned(16))) unsigned char shm[];
    LAS unsigned char* lds = (LAS unsigned char*)shm;
    cg::grid_group grid = cg::this_grid();
    if (threadIdx.x < 4) ((LAS unsigned*)(lds + LDS_BYTES - 16))[threadIdx.x] = 0u;
    __syncthreads();
    const XcdBarrier xbar = xcd_barrier_post((unsigned*)(p.ws + O_BAR), (volatile LAS unsigned*)(lds + LDS_BYTES - 16));
#define GBAR() xcd_barrier(xbar)
    unsigned char* ws = p.ws;
    bf16_t* hb = (bf16_t*)(ws + O_HB); float* ss = (float*)(ws + O_SS);
    phase0(lds, p);
#ifdef DUP_P0
    GBAR(); phase0(lds, p);
#endif
    if (gridDim.x == 0x7fffffffu) grid.sync();
    GBAR();
    { EpiAttnIn E; E.O = (bf16_t*)(ws + O_PROJ); E.ss = ss; E.tab = (const f32x4*)(ws + O_ROPE); run_gemm(lds, hb, (const bf16_t*)(ws + W_AIN), AINW, DM, E); }
    GBAR();
    attn_phase(lds, p);
#ifdef DUP_ATTN
    GBAR(); attn_phase(lds, p);
#endif
    GBAR();
    { EpiRes<true, false> E; E.xres = p.in[0]; E.hb = hb; E.outf = nullptr; E.ssn = ss + MT; run_gemm(lds, (const bf16_t*)(ws + O_MIXED), (const bf16_t*)(ws + W_AOUT), DM, DM, E); }
    GBAR();
    { EpiGU E; E.act = (bf16_t*)(ws + O_ACT); E.ss = ss + MT; run_gemm(lds, hb, (const bf16_t*)(ws + W_GU0), 2 * DFF, DM, E); }
    GBAR();
    { EpiRes<false, false> E; E.xres = nullptr; E.hb = hb; E.outf = nullptr; E.ssn = ss + 2 * MT; run_gemm(lds, (const bf16_t*)(ws + O_ACT), (const bf16_t*)(ws + W_DN0), DM, DFF, E); }
    GBAR();
    { EpiSsdIn E; E.z = (bf16_t*)p.out; E.xbc = (bf16_t*)(ws + O_XBC); E.dt = (float*)(ws + O_DT); E.ss = ss + 2 * MT; run_gemm(lds, hb, (const bf16_t*)(ws + W_SIN), SINWP, DM, E); }
    GBAR();
    ssd_states_phase(lds, p);
#ifdef DUP_S2
    GBAR(); ssd_states_phase(lds, p);
#endif
    GBAR();
#ifdef DRY_S3
    ssd_scan_phase(p, p.ws != nullptr); GBAR();
#endif
    ssd_scan_phase(p, DRYV);
    GBAR();
#ifdef DRY_S4
    ssd_out_phase(lds, p, p.ws != nullptr); GBAR();
#endif
    ssd_out_phase(lds, p, DRYV);
    GBAR();
    { EpiRes<false, false> E; E.xres = nullptr; E.hb = hb; E.outf = nullptr; E.ssn = ss + 3 * MT; run_gemm(lds, (const bf16_t*)p.out, (const bf16_t*)(ws + W_SOUT), DM, DIN, E); }
    GBAR();
    { EpiGU E; E.act = (bf16_t*)(ws + O_ACT); E.ss = ss + 3 * MT; run_gemm(lds, hb, (const bf16_t*)(ws + W_GU1), 2 * DFF, DM, E); }
    GBAR();
    { EpiRes<false, true> E; E.xres = nullptr; E.hb = hb; E.outf = p.out; E.ssn = ss + 4 * MT; run_gemm(lds, (const bf16_t*)(ws + O_ACT), (const bf16_t*)(ws + W_DN1), DM, DFF, E); }
    GBAR();
    {
        const float* ss4 = ss + 4 * MT; const f32x4* fw = (const f32x4*)p.in[22]; f32x4* o4 = (f32x4*)p.out;
        for (int i = blockIdx.x * 512 + threadIdx.x; i < MT * (DM / 4); i += gridDim.x * 512) {
            const int row = i >> 8; const float rs = __builtin_amdgcn_rsqf(ss4[row] * (1.0f / 1024.0f) + 1e-6f);
            o4[i] = o4[i] * rs * fw[i & 255];
        }
    }
}

extern "C" void kernel_launch(void* const* d_in, const int* in_sizes, int n_in, void* d_out, int out_size, void* d_ws, size_t ws_size, hipStream_t stream) {
    static int grid_blocks = 0;
    if (!grid_blocks) {
        int dev = 0, cus = 0, per_cu = 0;
        hipGetDevice(&dev);
        hipDeviceGetAttribute(&cus, hipDeviceAttributeMultiprocessorCount, dev);
        if (hipFuncSetAttribute((const void*)fwd_megakernel, hipFuncAttributeMaxDynamicSharedMemorySize, LDS_BYTES) != hipSuccess) fprintf(stderr, "hipFuncSetAttribute failed\n");
        if (hipOccupancyMaxActiveBlocksPerMultiprocessor(&per_cu, (const void*)fwd_megakernel, 512, LDS_BYTES) != hipSuccess || per_cu < 1) { fprintf(stderr, "occupancy query: %d\n", per_cu); per_cu = 1; }
        (void)hipGetLastError();
        grid_blocks = cus * per_cu;
        if (ws_size < 268435456ull || n_in != 23) fprintf(stderr, "unexpected ws_size %zu / n_in %d\n", ws_size, n_in);
    }
    if (hipMemsetAsync((char*)d_ws + O_BAR, 0, XCD_BAR_WORDS * 4, stream) != hipSuccess) fprintf(stderr, "memset failed\n");
    Params p{};
    for (int i = 0; i < 23; ++i) p.in[i] = (const float*)d_in[i];
    p.out = (float*)d_out; p.ws = (unsigned char*)d_ws;
    void* args[] = {&p};
    hipError_t e = hipLaunchCooperativeKernel((const void*)fwd_megakernel, dim3(grid_blocks), dim3(512), args, LDS_BYTES, stream);
    if (e != hipSuccess) fprintf(stderr, "cooperative launch failed: %s (grid %d)\n", hipGetErrorString(e), grid_blocks);
}
#ifdef PHASE_TEST
__global__ void __launch_bounds__(512, 2) t_phase0(Params p) { extern __shared__ __attribute__((aligned(16))) unsigned char shm[]; phase0((LAS unsigned char*)shm, p); }
__global__ void __launch_bounds__(512, 2) t_attn_diff(Params p) { extern __shared__ __attribute__((aligned(16))) unsigned char shm[]; diff_tile((LAS unsigned char*)shm, (const bf16_t*)(p.ws + O_PROJ), (bf16_t*)(p.ws + O_MIXED), p.in[7], 0.3f, blockIdx.x & 1, blockIdx.y, blockIdx.z); }
__global__ void __launch_bounds__(512, 2) t_attn_sb(Params p) { extern __shared__ __attribute__((aligned(16))) unsigned char shm[]; sb_block((LAS unsigned char*)shm, (const bf16_t*)(p.ws + O_PROJ), (bf16_t*)(p.ws + O_MIXED), blockIdx.x & 1, blockIdx.y, blockIdx.z); }
__global__ void __launch_bounds__(512, 2) t_ssd_states(Params p) { extern __shared__ __attribute__((aligned(16))) unsigned char shm[]; ssd_states_phase((LAS unsigned char*)shm, p); }
__global__ void __launch_bounds__(512, 2) t_ssd_scan(Params p) { ssd_scan_phase(p, false); }
__global__ void __launch_bounds__(512, 2) t_ssd_out(Params p) { extern __shared__ __attribute__((aligned(16))) unsigned char shm[]; ssd_out_phase((LAS unsigned char*)shm, p, false); }
__global__ void __launch_bounds__(512, 2) t_gemm_ain(Params p) { extern __shared__ __attribute__((aligned(16))) unsigned char shm[]; EpiAttnIn E; E.O = (bf16_t*)(p.ws + O_PROJ); E.ss = (float*)(p.ws + O_SS); E.tab = (const f32x4*)(p.ws + O_ROPE); run_gemm((LAS unsigned char*)shm, (bf16_t*)(p.ws + O_HB), (const bf16_t*)(p.ws + W_AIN), AINW, DM, E); }
__global__ void __launch_bounds__(512, 2) t_gemm_res(Params p) { extern __shared__ __attribute__((aligned(16))) unsigned char shm[]; EpiRes<false, false> E; E.xres = nullptr; E.hb = (bf16_t*)(p.ws + O_HB); E.outf = nullptr; E.ssn = (float*)(p.ws + O_SS); run_gemm((LAS unsigned char*)shm, (bf16_t*)(p.ws + O_ACT), (const bf16_t*)(p.ws + W_DN0), DM, DFF, E); }
__global__ void __launch_bounds__(512, 2) t_gemm_gu(Params p) { extern __shared__ __attribute__((aligned(16))) unsigned char shm[]; EpiGU E; E.act = (bf16_t*)(p.ws + O_ACT); E.ss = (float*)(p.ws + O_SS); run_gemm((LAS unsigned char*)shm, (bf16_t*)(p.ws + O_HB), (const bf16_t*)(p.ws + W_GU0), 2 * DFF, DM, E); }
__global__ void __launch_bounds__(512, 2) t_gemm_ssdin(Params p) { extern __shared__ __attribute__((aligned(16))) unsigned char shm[]; EpiSsdIn E; E.z = (bf16_t*)p.out; E.xbc = (bf16_t*)(p.ws + O_XBC); E.dt = (float*)(p.ws + O_DT); E.ss = (float*)(p.ws + O_SS); run_gemm((LAS unsigned char*)shm, (bf16_t*)(p.ws + O_HB), (const bf16_t*)(p.ws + W_SIN), SINWP, DM, E); }
#endif
```

```cpp
#include <hip/hip_runtime.h>
#include <hip/hip_cooperative_groups.h>
#include <cstdio>
#include <cstdint>
namespace cg = cooperative_groups;
namespace pg8 {
#define PG8_LAS __attribute__((address_space(3)))
typedef unsigned short bf16_t;
typedef short bf16x8 __attribute__((ext_vector_type(8)));
typedef float f32x4 __attribute__((ext_vector_type(4)));
typedef unsigned u32x4 __attribute__((ext_vector_type(4)));
constexpr int BM = 256, BK = 64, HALF = 128, HTB = HALF * BK * 2  , STAGE_BYTES = 8 * HTB, NXCD = 8, WGM = 8;

__host__ __device__ __forceinline__ int lds_byte(int r, int c) { const int st = (r >> 4) * 2 + (c >> 5), rr = r & 15, cc = c & 31, ob = rr * 64 + cc * 2; return st * 1024 + (ob ^ (((ob >> 9) & 1) << 5)); }
__host__ __device__ __forceinline__ void stage_rc(int b, int& R, int& C) { const int st = b / 1024, sb = b % 1024, swz = sb ^ (((sb >> 9) & 1) << 5); R = (st >> 1) * 16 + swz / 64; C = (st & 1) * 32 + (swz % 64) / 2; }
__host__ __device__ __forceinline__ int perm32(int rho) { const int n = rho >> 4, i = rho & 15; return 8 * (i >> 2) + 4 * n + (i & 3); }

struct Unit { int pm, pn; };
struct Gemm { const bf16_t* A; const bf16_t* Bt; int M, N, K; };

struct StaticOrder {
    int nM, nN, nwg, G, c;
    __host__ __device__ void init(int M, int N, int G_, int c_) { nM = M / BM; nN = N / BM; nwg = nM * nN; G = G_; c = c_; }
    __host__ __device__ bool next(int i, Unit& u) const {
        const long L = (long)i * G + c; if (L >= nwg) return false;
        int wgid = (int)L; { const int q = nwg / NXCD, r = nwg % NXCD, xcd = wgid % NXCD, off = wgid / NXCD; wgid = (xcd < r ? xcd * (q + 1) : r * (q + 1) + (xcd - r) * q) + off; }
        const int nig = WGM * nN, gid = wgid / nig, fm = gid * WGM, gsz = (nM - fm) < WGM ? (nM - fm) : WGM;
        u.pm = fm + ((wgid % nig) % gsz); u.pn = (wgid % nig) / gsz; return true;
    }
    __device__ __forceinline__ void a_ready(const Unit&) const {}
    __device__ __forceinline__ void done(const Unit&) const {}
};

template <class Epi, class Sched, bool STAMP = false>
__device__ __forceinline__ void gemm_phase(PG8_LAS unsigned char* lds, const Gemm g, const Sched& S, const Epi& E, unsigned long long* stamps) {
    int tid_ = threadIdx.x; asm volatile("" : "+v"(tid_)); const int tid = tid_, wid = __builtin_amdgcn_readfirstlane(tid >> 6), lane = tid & 63, wr = wid >> 2, wc = wid & 3, fr = lane & 15, fq = lane >> 4;
    const int K = g.K, nt = K / BK;
    int ts_lo = 0, ts_hi = 0, nts = 0; const unsigned long long rt_entry = STAMP ? (unsigned long long)wall_clock64() : 0ull;
#define PG8_STAMP() do { if (STAMP && wid == 0 && nts < 64) { const unsigned long long _c = (unsigned long long)clock64(); \
        ts_lo = (lane == nts) ? (int)(unsigned)_c : ts_lo; ts_hi = (lane == nts) ? (int)(unsigned)(_c >> 32) : ts_hi; ++nts; } } while (0)
    PG8_STAMP();
    unsigned voffA[2], voffB[2];
#pragma unroll
    for (int i = 0; i < 2; ++i) { int R, C; stage_rc(tid * 16 + i * 8192, R, C); const int Rb = Epi::PERM ? ((R & ~31) + perm32(R & 31)) : R;
        voffA[i] = (unsigned)(R * K + C) * 2u; voffB[i] = (unsigned)(Rb * K + C) * 2u; }
    const size_t kstep = (size_t)(BK * 2);
    const size_t hstep = (size_t)HALF * K * 2;
    const size_t tstep = 2 * hstep;
    const unsigned ldsw = (unsigned)wid * 1024u;
    const int aoff = lds_byte(wr * 64 + fr, fq * 8), boff = lds_byte(wc * 32 + fr, fq * 8);
#define PG8_SA(b, h) (((b) * 2 + (h)) * HTB)
#define PG8_SB(b, h) ((4 + (b) * 2 + (h)) * HTB)
#define PG8_STAGE(bufoff, gbase, voff) do { _Pragma("unroll") for (int _i = 0; _i < 2; ++_i) \
        __builtin_amdgcn_global_load_lds((const unsigned*)((const char*)(gbase) + (voff)[_i]), (PG8_LAS unsigned*)(lds + (bufoff) + ldsw + _i * 8192), 16, 0, 0); } while (0)
#define PG8_LDA(dst, b, h) do { _Pragma("unroll") for (int m = 0; m < 4; ++m) _Pragma("unroll") for (int k = 0; k < 2; ++k) dst[m][k] = *(const PG8_LAS bf16x8*)(lds + PG8_SA(b, h) + aoff + m * 2048 + k * 1024); } while (0)
#define PG8_LDB(dst, b, h) do { _Pragma("unroll") for (int n = 0; n < 2; ++n) _Pragma("unroll") for (int k = 0; k < 2; ++k) dst[n][k] = *(const PG8_LAS bf16x8*)(lds + PG8_SB(b, h) + boff + n * 2048 + k * 1024); } while (0)
#define PG8_MMA(ai, bj, At, Bt) do { __builtin_amdgcn_s_setprio(1); _Pragma("unroll") for (int m = 0; m < 4; ++m) _Pragma("unroll") for (int n = 0; n < 2; ++n) _Pragma("unroll") for (int k = 0; k < 2; ++k) \
        acc[ai][bj][m][n] = __builtin_amdgcn_mfma_f32_16x16x32_bf16(Bt[n][k], At[m][k], acc[ai][bj][m][n], 0, 0, 0); __builtin_amdgcn_s_setprio(0); } while (0)
#define PG8_WAIT_V(n) asm volatile("s_waitcnt vmcnt(" #n ")" ::: "memory")
#define PG8_WAIT_L(n) asm volatile("s_waitcnt lgkmcnt(" #n ")" ::: "memory")
#define PG8_BAR __builtin_amdgcn_s_barrier()
#define PG8_SCHED __builtin_amdgcn_sched_barrier(0)
    Unit cur, nxt; int ui = 0;
    if (!S.next(0, cur)) return;
    f32x4 acc[2][2][4][2];
#pragma unroll
    for (int a = 0; a < 2; ++a)
#pragma unroll
        for (int b = 0; b < 2; ++b)
#pragma unroll
            for (int m = 0; m < 4; ++m)
#pragma unroll
                for (int n = 0; n < 2; ++n) acc[a][b][m][n] = (f32x4){0.f, 0.f, 0.f, 0.f};
    bf16x8 At[4][2], B0[2][2], B1[2][2];
    const char* cA = (const char*)g.A + (size_t)cur.pm * tstep; const char* cB = (const char*)g.Bt + (size_t)cur.pn * tstep;
    S.a_ready(cur);
    PG8_STAGE(PG8_SB(0, 0), cB, voffB); PG8_STAGE(PG8_SA(0, 0), cA, voffA); PG8_STAGE(PG8_SB(0, 1), cB + hstep, voffB); PG8_STAGE(PG8_SA(0, 1), cA + hstep, voffA);
    if (wr == 1) PG8_BAR;
    PG8_WAIT_V(4); PG8_BAR;
    PG8_STAGE(PG8_SB(1, 0), cB + kstep, voffB); PG8_STAGE(PG8_SA(1, 0), cA + kstep, voffA); PG8_STAGE(PG8_SB(1, 1), cB + hstep + kstep, voffB);
    PG8_WAIT_V(6); PG8_BAR;
    PG8_STAMP();
    for (;;) {
        const bool has_next = S.next(ui + 1, nxt);
        const char* nA = has_next ? (const char*)g.A + (size_t)nxt.pm * tstep : cA; const char* nB = has_next ? (const char*)g.Bt + (size_t)nxt.pn * tstep : cB;
        for (int t = 0; t < nt; t += 2) {
            const bool last = (t == nt - 2);
            const char* a1 = cA + (size_t)(t + 1) * kstep;
            const char* a2 = last ? nA : cA + (size_t)(t + 2) * kstep; const char* b2 = last ? nB : cB + (size_t)(t + 2) * kstep;
            const char* a3 = a2 + kstep; const char* b3 = b2 + kstep;
            if (last && has_next) S.a_ready(nxt);
            PG8_LDB(B0, 0, 0); PG8_SCHED; PG8_LDA(At, 0, 0); PG8_STAGE(PG8_SA(1, 1), a1 + hstep, voffA);
            PG8_WAIT_L(8); PG8_BAR; PG8_WAIT_L(0); PG8_MMA(0, 0, At, B0); PG8_BAR; PG8_SCHED;
            PG8_LDB(B1, 0, 1); PG8_STAGE(PG8_SB(0, 0), b2, voffB);
            PG8_BAR; PG8_WAIT_L(0); PG8_MMA(0, 1, At, B1); PG8_BAR;
            PG8_LDA(At, 0, 1); PG8_STAGE(PG8_SA(0, 0), a2, voffA);
            PG8_BAR; PG8_WAIT_L(0); PG8_MMA(1, 0, At, B0); PG8_BAR; PG8_SCHED;
            PG8_STAGE(PG8_SB(0, 1), b2 + hstep, voffB);
            PG8_WAIT_V(6); PG8_BAR; PG8_MMA(1, 1, At, B1); PG8_BAR;
            PG8_LDB(B0, 1, 0); PG8_SCHED; PG8_LDA(At, 1, 0); PG8_STAGE(PG8_SA(0, 1), a2 + hstep, voffA);
            PG8_WAIT_L(8); PG8_BAR; PG8_WAIT_L(0); PG8_MMA(0, 0, At, B0); PG8_BAR; PG8_SCHED;
            PG8_LDB(B1, 1, 1); PG8_STAGE(PG8_SB(1, 0), b3, voffB);
            PG8_BAR; PG8_WAIT_L(0); PG8_MMA(0, 1, At, B1); PG8_BAR;
            PG8_LDA(At, 1, 1); PG8_STAGE(PG8_SA(1, 0), a3, voffA);
            PG8_BAR; PG8_WAIT_L(0); PG8_MMA(1, 0, At, B0); PG8_BAR; PG8_SCHED;
            PG8_STAGE(PG8_SB(1, 1), b3 + hstep, voffB);
            PG8_WAIT_V(6); PG8_BAR; PG8_MMA(1, 1, At, B1); PG8_BAR;
        }
        PG8_STAMP();
        if constexpr (!Epi::AFTER_DRAIN) { E(acc, cur, wr, wc, fr, fq); S.done(cur); }
        PG8_STAMP();
        if (!has_next) break;
#pragma unroll
        for (int a = 0; a < 2; ++a)
#pragma unroll
            for (int b = 0; b < 2; ++b)
#pragma unroll
                for (int m = 0; m < 4; ++m)
#pragma unroll
                    for (int n = 0; n < 2; ++n) acc[a][b][m][n] = (f32x4){0.f, 0.f, 0.f, 0.f};
        cur = nxt; cA = nA; cB = nB; ++ui;
    }
    PG8_WAIT_V(0);
    if (wr == 0) PG8_BAR;
    PG8_BAR;
    if constexpr (Epi::AFTER_DRAIN) { E.fused(acc, cur, wr, wc, fr, fq, lds, wid, lane); S.done(cur); }
    PG8_STAMP();
    if (STAMP && wid == 0) { stamps[lane] = lane < nts ? (((unsigned long long)(unsigned)ts_hi << 32) | (unsigned)ts_lo) : 0ull;
        if (lane == 62) stamps[62] = rt_entry; if (lane == 63) stamps[63] = (unsigned long long)wall_clock64(); }
#undef PG8_STAMP
#undef PG8_SA
#undef PG8_SB
#undef PG8_STAGE
#undef PG8_LDA
#undef PG8_LDB
#undef PG8_MMA
#undef PG8_WAIT_V
#undef PG8_WAIT_L
#undef PG8_BAR
#undef PG8_SCHED
}
}
using pg8::bf16_t; using pg8::bf16x8; using pg8::f32x4;
typedef short s16x4 __attribute__((ext_vector_type(4)));
typedef float f32x16 __attribute__((ext_vector_type(16)));
typedef float f32x2 __attribute__((ext_vector_type(2)));
typedef __bf16 bf2_t __attribute__((ext_vector_type(2)));
typedef unsigned u32x2 __attribute__((ext_vector_type(2)));
typedef unsigned u32x4 __attribute__((ext_vector_type(4)));
#define LAS __attribute__((address_space(3)))
#define DI __device__ __forceinline__
#define MFMA32(a, b, c) __builtin_amdgcn_mfma_f32_32x32x16_bf16((a), (b), (c), 0, 0, 0)

DI int otid() { int t = threadIdx.x; asm volatile("" : "+v"(t)); return t; }
DI unsigned pk2(float a, float b) { f32x2 v = {a, b}; bf2_t r = __builtin_convertvector(v, bf2_t); return __builtin_bit_cast(unsigned, r); }
DI float bflo(unsigned u) { return __uint_as_float(u << 16); }
DI float bfhi(unsigned u) { return __uint_as_float(u & 0xffff0000u); }
DI float fexp2(float x) { return __builtin_amdgcn_exp2f(x); }
DI float frcp(float x) { return __builtin_amdgcn_rcpf(x); }
DI float fsilu(float x) { return x * frcp(1.0f + fexp2(-1.44269504089f * x)); }
DI int crow(int i, int h) { return (i & 3) + 8 * (i >> 2) + 4 * h; }
DI s16x4 trr(const LAS unsigned char* p) { return __builtin_amdgcn_ds_read_tr16_b64_v4i16((LAS s16x4*)p); }
DI bf16x8 tr2(const LAS unsigned char* p0, const LAS unsigned char* p1) { s16x4 a = trr(p0), b = trr(p1); return __builtin_shufflevector(a, b, 0, 1, 2, 3, 4, 5, 6, 7); }
DI bf16x8 pack8(const f32x16& x, int s) {
    u32x4 p; p[0] = pk2(x[8 * s], x[8 * s + 1]); p[1] = pk2(x[8 * s + 2], x[8 * s + 3]); p[2] = pk2(x[8 * s + 4], x[8 * s + 5]); p[3] = pk2(x[8 * s + 6], x[8 * s + 7]);
    return __builtin_bit_cast(bf16x8, p);
}
DI f32x16 zero16() { f32x16 z; for (int i = 0; i < 16; ++i) z[i] = 0.f; return z; }

constexpr int MT = 16384, SEQ = 8192, DM = 1024, DFF = 2816, AINW = 3072, SINW = 6176, SINWP = 6400, DIN = 2048, XBCW = 4096;
constexpr float LOG2E = 1.44269504089f;
constexpr int LDS_BYTES = 147456;
constexpr size_t W_AIN = 0, W_AOUT = W_AIN + (size_t)AINW * DM * 2, W_GU0 = W_AOUT + (size_t)DM * DM * 2, W_DN0 = W_GU0 + (size_t)2 * DFF * DM * 2,
                 W_SIN = W_DN0 + (size_t)DM * DFF * 2, W_SOUT = W_SIN + (size_t)SINWP * DM * 2, W_GU1 = W_SOUT + (size_t)DM * DIN * 2, W_DN1 = W_GU1 + (size_t)2 * DFF * DM * 2,
                 O_HB = W_DN1 + (size_t)DM * DFF * 2, O_SS = O_HB + (size_t)MT * DM * 2, O_ROPE = O_SS + (size_t)5 * MT * 4, O_DT = O_ROPE + (size_t)SEQ * 32 * 8,
                 O_CDEC = O_DT + (size_t)MT * 32 * 4, O_LAM = O_CDEC + 16384, O_BAR = O_LAM + 256, O_R = 98566144;
static_assert(O_BAR + 16384 <= O_R, "map");
constexpr size_t O_PROJ = O_R, O_MIXED = O_PROJ + (size_t)MT * AINW * 2, O_ACT = O_R, O_XBC = O_R, O_ST1 = O_XBC + (size_t)MT * XBCW * 2, O_ST0 = 0;
constexpr size_t ST_BATCH = (size_t)64 * 32 * 64 * 128;
static_assert(O_ST1 + ST_BATCH * 2 <= 268435456ull, "ws");
static_assert(ST_BATCH * 2 <= W_SOUT, "st0 overlay");
static_assert(O_MIXED + (size_t)MT * DM * 2 <= 268435456ull, "ws2");

struct Params { const float* in[23]; float* out; unsigned char* ws; };
#include <cstdlib>
#include <vector>

#define XB_TMO      128
#define XB_XCNT(j)  (256  + 64 * (j))
#define XB_XSUB(j)  (1280 + 64 * (j))
#define XB_XGEN(j)  (2304 + 64 * (j))
#define XB_TOP      3328
#define XB_TOPGEN   3392
#define XCD_BAR_WORDS 3456
#define XB_SPIN_CAP (1u << 18)

__device__ __forceinline__ unsigned xb_ld(unsigned* p)              { return __hip_atomic_load(p, __ATOMIC_RELAXED, __HIP_MEMORY_SCOPE_AGENT); }
__device__ __forceinline__ unsigned xb_add(unsigned* p, unsigned v) { return __hip_atomic_fetch_add(p, v, __ATOMIC_RELAXED, __HIP_MEMORY_SCOPE_AGENT); }
__device__ __forceinline__ unsigned xb_xcc_id() { return (unsigned)__builtin_amdgcn_s_getreg((3 << 11) | 20) & 0xFu; }
#define XB_SPIN(cond, bar) do { unsigned _sp = 0; while (cond) { __builtin_amdgcn_s_sleep(1); \
    if ((++_sp & 255u) == 0u) { if (xb_ld(&(bar)[XB_TMO])) break; if (_sp > XB_SPIN_CAP) { atomicAdd(&(bar)[XB_TMO], 1u); break; } } } } while (0)

struct XcdBarrier {
    unsigned* bar; unsigned x;
    volatile LAS unsigned* st;
};

__device__ __forceinline__ XcdBarrier xcd_barrier_post(unsigned* bar, volatile LAS unsigned* st) {
    XcdBarrier b; b.bar = bar; b.x = xb_xcc_id(); b.st = st;
    if (threadIdx.x == 0) (void)xb_add(&bar[XB_XCNT(b.x)], 1u);
    return b;
}
__device__ __forceinline__ void xcd_barrier_complete(unsigned* bar, unsigned x, unsigned& nloc, unsigned& nx) {
    const unsigned G = gridDim.x * gridDim.y * gridDim.z;
    unsigned sum, cnt, mine, sp = 0u;
    for (;;) {
        sum = 0u; cnt = 0u; mine = 0u;
#pragma unroll
        for (unsigned j = 0; j < 16; ++j) { const unsigned c = xb_ld(&bar[XB_XCNT(j)]); sum += c; cnt += (c > 0u) ? 1u : 0u; mine = (j == x) ? c : mine; }
        if (sum == G) break;
        __builtin_amdgcn_s_sleep(1);
        if ((++sp & 255u) == 0u) { if (xb_ld(&bar[XB_TMO])) break; if (sp > XB_SPIN_CAP) { atomicAdd(&bar[XB_TMO], 1u); break; } }
    }
    nloc = mine > 0u ? mine : 1u; nx = cnt > 0u ? cnt : 1u;
}

__device__ __forceinline__ void xcd_barrier(const XcdBarrier& b) {
    asm volatile("s_waitcnt vmcnt(0)" ::: "memory");
    __syncthreads();
    if (threadIdx.x == 0) {
        unsigned* bar = b.bar;
        __builtin_amdgcn_s_waitcnt(0);
        unsigned nloc = b.st[0], nx = b.st[1];
        if (nloc == 0u) { xcd_barrier_complete(bar, b.x, nloc, nx); b.st[0] = nloc; b.st[1] = nx; }
        const unsigned old = xb_add(&bar[XB_XSUB(b.x)], 1u);
        const unsigned gen = old / nloc;
        if (old + 1u == (gen + 1u) * nloc) {
            __builtin_amdgcn_fence(__ATOMIC_RELEASE, "agent");
            asm volatile("s_waitcnt vmcnt(0)" ::: "memory");
            const unsigned og = xb_add(&bar[XB_TOP], 1u);
            const unsigned tg = og / nx;
            if (og + 1u == (tg + 1u) * nx) xb_add(&bar[XB_TOPGEN], 1u);
            else XB_SPIN(xb_ld(&bar[XB_TOPGEN]) == tg, bar);
            __builtin_amdgcn_fence(__ATOMIC_ACQUIRE, "agent");
            xb_add(&bar[XB_XGEN(b.x)], 1u);
            asm volatile("s_waitcnt vmcnt(0)" ::: "memory");
        } else {
            XB_SPIN(xb_ld(&bar[XB_XGEN(b.x)]) == gen, bar);
            __builtin_amdgcn_fence(__ATOMIC_ACQUIRE, "agent");
            asm volatile("s_waitcnt vmcnt(0)" ::: "memory");
        }
    }
    __syncthreads();
}
DI void wmap(int mode, int c, int& src, float& scale, int& which) {
    src = c; scale = 1.f; which = 0;
    if (mode == 0) {
        if (c < 1024) { const int base = c & ~63, cc = c & 63, g = cc >> 3, e = cc & 7; src = base + (e < 4 ? 4 * g + e : 32 + 4 * g + (e - 4)); }
        if (c < 512) scale = 0.125f * LOG2E; else if (c >= 1536 && c < 2048) scale = 0.125f;
    } else if (mode == 2) { src = 4 * (c >> 3) + (c & 3); which = (c >> 2) & 1; }
    else if (mode == 3) { if (c >= SINW) src = -1; }
}
DI void wconv_tile(LAS float* tile, int mode, const float* W0, const float* W1, const float* kscale, bf16_t* dst, int K, int ldw, int tix) {
    const int tid = otid(), nk = K >> 8, c0 = (tix / nk) * 64, k0 = (tix % nk) * 256;
    const int cc = tid & 63; int src, which; float sc; wmap(mode, c0 + cc, src, sc, which);
    const float* W = (which ? W1 : W0) + (src >= 0 ? src : 0);
    float v[32];
#pragma unroll
    for (int i = 0; i < 32; ++i) { const int kk = (tid >> 6) + 8 * i; v[i] = W[(size_t)(k0 + kk) * ldw]; }
#pragma unroll
    for (int i = 0; i < 32; ++i) { const int kk = (tid >> 6) + 8 * i; float x = (src >= 0) ? v[i] * sc : 0.f; if (kscale) x *= kscale[k0 + kk]; tile[kk * 65 + cc] = x; }
    __syncthreads();
#pragma unroll
    for (int i = 0; i < 16; ++i) {
        const int idx = tid + 512 * i, c2 = idx >> 7, k2 = (idx & 127) * 2;
        *(unsigned*)(dst + (size_t)(c0 + c2) * K + k0 + k2) = pk2(tile[k2 * 65 + c2], tile[(k2 + 1) * 65 + c2]);
    }
    __syncthreads();
}
DI void phase0(LAS unsigned char* lds, const Params& p) {
    const int tid = otid(), G = gridDim.x, bx = blockIdx.x;
    unsigned char* ws = p.ws;
    const int cnt[8] = {48 * 4, 16 * 4, 88 * 4, 16 * 11, 100 * 4, 16 * 8, 88 * 4, 16 * 11};
    int total = 0;
#pragma unroll
    for (int j = 0; j < 8; ++j) total += cnt[j];
    for (int t = bx; t < total; t += G) {
        int j = 0, tt = t;
#pragma unroll
        for (int q = 0; q < 7; ++q) if (j == q && tt >= cnt[q]) { tt -= cnt[q]; j = q + 1; }
        LAS float* tile = (LAS float*)lds;
        switch (j) {
        case 0: wconv_tile(tile, 0, p.in[2], nullptr, p.in[1], (bf16_t*)(ws + W_AIN), DM, AINW, tt); break;
        case 1: wconv_tile(tile, 1, p.in[8], nullptr, nullptr, (bf16_t*)(ws + W_AOUT), DM, DM, tt); break;
        case 2: wconv_tile(tile, 2, p.in[19], p.in[20], p.in[18], (bf16_t*)(ws + W_GU0), DM, DFF, tt); break;
        case 3: wconv_tile(tile, 1, p.in[21], nullptr, nullptr, (bf16_t*)(ws + W_DN0), DFF, DM, tt); break;
        case 4: wconv_tile(tile, 3, p.in[10], nullptr, p.in[9], (bf16_t*)(ws + W_SIN), DM, SINW, tt); break;
        case 5: wconv_tile(tile, 1, p.in[17], nullptr, nullptr, (bf16_t*)(ws + W_SOUT), DIN, DM, tt); break;
        case 6: wconv_tile(tile, 2, p.in[19] + (size_t)DM * DFF, p.in[20] + (size_t)DM * DFF, p.in[18] + DM, (bf16_t*)(ws + W_GU1), DM, DFF, tt); break;
        default: wconv_tile(tile, 1, p.in[21] + (size_t)DFF * DM, nullptr, nullptr, (bf16_t*)(ws + W_DN1), DFF, DM, tt); break;
        }
    }
    {
        const int wave = tid >> 6, lane = tid & 63; bf16_t* hb = (bf16_t*)(ws + O_HB); float* ss = (float*)(ws + O_SS);
        for (int row = bx * 8 + wave; row < MT; row += G * 8) {
            const float* xr = p.in[0] + (size_t)row * DM; float sq = 0.f;
#pragma unroll
            for (int i = 0; i < 4; ++i) { const f32x4 v = *(const f32x4*)(xr + lane * 4 + 256 * i); sq += v[0] * v[0] + v[1] * v[1] + v[2] * v[2] + v[3] * v[3];
                u32x2 o; o[0] = pk2(v[0], v[1]); o[1] = pk2(v[2], v[3]); *(u32x2*)(hb + (size_t)row * DM + lane * 4 + 256 * i) = o; }
#pragma unroll
            for (int o = 32; o >= 1; o >>= 1) sq += __shfl_xor(sq, o);
            if (lane == 0) ss[row] = sq;
        }
        for (int i = bx * 512 + tid; i < 4 * MT; i += G * 512) ss[MT + i] = 0.f;
        f32x2* tab = (f32x2*)(ws + O_ROPE);
        for (int i = bx * 512 + tid; i < SEQ * 32; i += G * 512) {
            const int pos = i >> 5, f = i & 31; const float inv = fexp2(-(float)f * 0.41524101186092f); const float ang = (float)pos * inv;
            double t = (double)ang * 0.15915494309189535; t -= floor(t); const float tf = (float)t;
            f32x2 cs; cs[0] = __builtin_amdgcn_cosf(tf); cs[1] = __builtin_amdgcn_sinf(tf); tab[i] = cs;
        }
        if (bx == 0 && tid == 0) { float s1 = 0.f, s2 = 0.f; for (int i = 0; i < 64; ++i) { s1 += p.in[3][i] * p.in[4][i]; s2 += p.in[5][i] * p.in[6][i]; }
            *(float*)(ws + O_LAM) = fexp2(s1 * LOG2E) - fexp2(s2 * LOG2E) + 0.2f; }
    }
}

struct EpiAttnIn {
    static constexpr bool PERM = true, AFTER_DRAIN = false;
    bf16_t* O; const float* ss; const f32x4* tab;
    DI void operator()(const f32x4 (&acc)[2][2][4][2], const pg8::Unit& u, int wr, int wc, int fr, int fq) const {
        const int row0 = u.pm * 256 + wr * 64 + fr, colt = u.pn * 256, col0 = colt + wc * 32 + 8 * fq;
        const int fb = 4 * (4 * (wc & 1) + fq);
#pragma unroll
        for (int ai = 0; ai < 2; ++ai)
#pragma unroll
            for (int m = 0; m < 4; ++m) {
                const int row = row0 + ai * 128 + m * 16; const float rs = __builtin_amdgcn_rsqf(ss[row] * (1.0f / 1024.0f) + 1e-6f);
                f32x4 c01 = {1.f, 0.f, 1.f, 0.f}, c23 = {1.f, 0.f, 1.f, 0.f};
                if (colt < 1024) { const int pos = row & (SEQ - 1); c01 = tab[(pos * 32 + fb) >> 1]; c23 = tab[((pos * 32 + fb) >> 1) + 1]; }
#pragma unroll
                for (int bj = 0; bj < 2; ++bj) {
                    f32x4 v0 = acc[ai][bj][m][0] * rs, v1 = acc[ai][bj][m][1] * rs;
                    if (colt < 1024) {
                        const float cs[4] = {c01[0], c01[2], c23[0], c23[2]}, sn[4] = {c01[1], c01[3], c23[1], c23[3]};
#pragma unroll
                        for (int j = 0; j < 4; ++j) { const float t1 = v0[j], t2 = v1[j]; v0[j] = t1 * cs[j] - t2 * sn[j]; v1[j] = t2 * cs[j] + t1 * sn[j]; }
                    }
                    u32x4 o; o[0] = pk2(v0[0], v0[1]); o[1] = pk2(v0[2], v0[3]); o[2] = pk2(v1[0], v1[1]); o[3] = pk2(v1[2], v1[3]);
                    *(u32x4*)(O + (size_t)row * AINW + col0 + bj * 128) = o;
                }
            }
    }
};
template <bool RES_F32, bool OUT_F32> struct EpiRes {
    static constexpr bool PERM = false, AFTER_DRAIN = false;
    const float* xres; bf16_t* hb; float* outf; float* ssn;
    DI void operator()(const f32x4 (&acc)[2][2][4][2], const pg8::Unit& u, int wr, int wc, int fr, int fq) const {
        const int row0 = u.pm * 256 + wr * 64 + fr, col0 = u.pn * 256 + wc * 32 + 4 * fq;
#pragma unroll
        for (int ai = 0; ai < 2; ++ai)
#pragma unroll
            for (int m = 0; m < 4; ++m) {
                const int row = row0 + ai * 128 + m * 16; float sq = 0.f;
#pragma unroll
                for (int bj = 0; bj < 2; ++bj)
#pragma unroll
                    for (int n = 0; n < 2; ++n) {
                        const size_t off = (size_t)row * DM + col0 + bj * 128 + n * 16; f32x4 r;
                        if (RES_F32) r = *(const f32x4*)(xres + off);
                        else { const u32x2 t = *(const u32x2*)(hb + off); r[0] = bflo(t[0]); r[1] = bfhi(t[0]); r[2] = bflo(t[1]); r[3] = bfhi(t[1]); }
                        const f32x4 v = r + acc[ai][bj][m][n];
                        sq += v[0] * v[0] + v[1] * v[1] + v[2] * v[2] + v[3] * v[3];
                        if (OUT_F32) *(f32x4*)(outf + off) = v;
                        else { u32x2 o; o[0] = pk2(v[0], v[1]); o[1] = pk2(v[2], v[3]); *(u32x2*)(hb + off) = o; }
                    }
                sq += __shfl_xor(sq, 16); sq += __shfl_xor(sq, 32);
                if (fq == 0) atomicAdd(ssn + row, sq);
            }
    }
};
struct EpiGU {
    static constexpr bool PERM = true, AFTER_DRAIN = false;
    bf16_t* act; const float* ss;
    DI void operator()(const f32x4 (&acc)[2][2][4][2], const pg8::Unit& u, int wr, int wc, int fr, int fq) const {
        const int row0 = u.pm * 256 + wr * 64 + fr, col0 = u.pn * 256 + wc * 32 + 8 * fq;
#pragma unroll
        for (int ai = 0; ai < 2; ++ai)
#pragma unroll
            for (int m = 0; m < 4; ++m) {
                const int row = row0 + ai * 128 + m * 16; const float rs = __builtin_amdgcn_rsqf(ss[row] * (1.0f / 1024.0f) + 1e-6f);
#pragma unroll
                for (int bj = 0; bj < 2; ++bj) {
                    const f32x4 g = acc[ai][bj][m][0] * rs, up = acc[ai][bj][m][1] * rs; float a[4];
#pragma unroll
                    for (int j = 0; j < 4; ++j) a[j] = fsilu(g[j]) * up[j];
                    u32x2 o; o[0] = pk2(a[0], a[1]); o[1] = pk2(a[2], a[3]);
                    *(u32x2*)(act + (size_t)row * DFF + ((col0 + bj * 128) >> 1)) = o;
                }
            }
    }
};
struct EpiSsdIn {
    static constexpr bool PERM = true, AFTER_DRAIN = false;
    bf16_t* z; bf16_t* xbc; float* dt; const float* ss;
    DI void operator()(const f32x4 (&acc)[2][2][4][2], const pg8::Unit& u, int wr, int wc, int fr, int fq) const {
        const int row0 = u.pm * 256 + wr * 64 + fr, col0 = u.pn * 256 + wc * 32 + 8 * fq;
#pragma unroll
        for (int ai = 0; ai < 2; ++ai)
#pragma unroll
            for (int m = 0; m < 4; ++m) {
                const int row = row0 + ai * 128 + m * 16; const float rs = __builtin_amdgcn_rsqf(ss[row] * (1.0f / 1024.0f) + 1e-6f);
#pragma unroll
                for (int bj = 0; bj < 2; ++bj) {
                    const int c = col0 + bj * 128; const f32x4 v0 = acc[ai][bj][m][0] * rs, v1 = acc[ai][bj][m][1] * rs;
                    if (c < 6144) { u32x4 o; o[0] = pk2(v0[0], v0[1]); o[1] = pk2(v0[2], v0[3]); o[2] = pk2(v1[0], v1[1]); o[3] = pk2(v1[2], v1[3]);
                        if (c < DIN) *(u32x4*)(z + (size_t)row * DIN + c) = o; else *(u32x4*)(xbc + (size_t)row * XBCW + (c - DIN)) = o; }
                    else if (c < SINW) { *(f32x4*)(dt + (size_t)row * 32 + (c - 6144)) = v0; *(f32x4*)(dt + (size_t)row * 32 + (c - 6144) + 4) = v1; }
                }
            }
    }
};
constexpr int KST = 144, VST = 320, VST64 = 192;
constexpr int AT_K1 = 0, AT_K2 = 64 * KST, AT_V = 2 * 64 * KST, AT_STAGE = AT_V + 64 * VST;

DI void diff_tile(LAS unsigned char* lds, const bf16_t* proj, bf16_t* mixed, const float* subln, float lam, int b, int hd, int qt) {
    const int tid = otid(), w = __builtin_amdgcn_readfirstlane(tid >> 6), lane = tid & 63, qg = w & 3, mp = w >> 2, r = lane & 31, h = lane >> 5;
    const int q0 = qt * 128; const size_t rowb = (size_t)b * SEQ;
    bf16x8 qf[4];
    { const bf16_t* qp = proj + (rowb + q0 + 32 * qg + r) * AINW + hd * 128 + mp * 64 + 8 * h;
#pragma unroll
      for (int s = 0; s < 4; ++s) qf[s] = *(const bf16x8*)(qp + 16 * s); }
    f32x16 O[4];
#pragma unroll
    for (int i = 0; i < 4; ++i) O[i] = zero16();
    float mrun = 0.f, lrun = 0.f;
    const int nsteps = 2 * (qt + 1);
    const bf16_t* src[4]; int dst[4];
#pragma unroll
    for (int i = 0; i < 2; ++i) { const int cid = tid + 512 * i, row = cid >> 4, c16 = cid & 15;
        src[i] = proj + (rowb + row) * AINW + 512 + hd * 128 + c16 * 8; dst[i] = (c16 < 8 ? AT_K1 : AT_K2) + row * KST + (c16 & 7) * 16;
        src[2 + i] = proj + (rowb + row) * AINW + 1024 + hd * 128 + c16 * 8; dst[2 + i] = AT_V + row * VST + c16 * 16; }
    u32x4 pf[4];
#pragma unroll
    for (int i = 0; i < 4; ++i) pf[i] = *(const u32x4*)(src[i]);
#pragma unroll
    for (int i = 0; i < 4; ++i) *(LAS u32x4*)(lds + dst[i]) = pf[i];
    __syncthreads();
    const int i16 = lane & 15, tq = i16 >> 2, tp = i16 & 3, g16 = (lane >> 4) & 1;
    const int troff = (4 * h + tq) * VST + (16 * g16 + 4 * tp) * 2;
    for (int j = 0; j < nsteps; ++j) {
        const bool more = (j + 1 < nsteps);
        if (more) {
#pragma unroll
            for (int i = 0; i < 4; ++i) pf[i] = *(const u32x4*)(src[i] + (size_t)(j + 1) * 64 * AINW);
        }
        const LAS unsigned char* base = lds + (j & 1) * AT_STAGE;
        const LAS unsigned char* Kb = base + (mp ? AT_K2 : AT_K1);
        const LAS unsigned char* Vb = base + AT_V;
        f32x16 S[2];
        const float negm = -mrun;
#pragma unroll
        for (int kt = 0; kt < 2; ++kt) {
#pragma unroll
            for (int i = 0; i < 16; ++i) S[kt][i] = negm;
#pragma unroll
            for (int s = 0; s < 4; ++s) { const bf16x8 kf = *(const LAS bf16x8*)(Kb + (32 * kt + r) * KST + (16 * s + 8 * h) * 2); S[kt] = MFMA32(kf, qf[s], S[kt]); } }
        const int qidx = q0 + 32 * qg + r, kbase = 64 * j;
        if (kbase + 63 > q0 + 32 * qg) {
#pragma unroll
            for (int kt = 0; kt < 2; ++kt)
#pragma unroll
                for (int i = 0; i < 16; ++i) if (kbase + 32 * kt + crow(i, h) > qidx) S[kt][i] = -1e30f;
        }
        float mx = S[0][0];
#pragma unroll
        for (int kt = 0; kt < 2; ++kt)
#pragma unroll
            for (int i = 0; i < 16; ++i) mx = fmaxf(mx, S[kt][i]);
        mx = fmaxf(mx, __shfl_xor(mx, 32));
        if (j == 0 || __builtin_amdgcn_ballot_w64(mx > 8.0f) != 0ull) {
            const float d = (j == 0) ? mx : fmaxf(mx, 0.f);
            mrun += d;
            if (j != 0) { const float alpha = fexp2(-d); lrun *= alpha;
#pragma unroll
                for (int vt = 0; vt < 4; ++vt) O[vt] = O[vt] * alpha; }
#pragma unroll
            for (int kt = 0; kt < 2; ++kt)
#pragma unroll
                for (int i = 0; i < 16; ++i) S[kt][i] -= d;
        }
        float ls = 0.f;
#pragma unroll
        for (int kt = 0; kt < 2; ++kt)
#pragma unroll
            for (int i = 0; i < 16; ++i) { const float pv = fexp2(S[kt][i]); S[kt][i] = pv; ls += pv; }
        lrun += ls;
#pragma unroll
        for (int kt = 0; kt < 2; ++kt)
#pragma unroll
            for (int s2 = 0; s2 < 2; ++s2) {
                const bf16x8 pfr = pack8(S[kt], s2);
                const LAS unsigned char* vrow = Vb + (32 * kt + 16 * s2) * VST + troff;
#pragma unroll
                for (int vt = 0; vt < 4; ++vt) { const bf16x8 vf = tr2(vrow + vt * 64, vrow + 8 * VST + vt * 64); O[vt] = MFMA32(vf, pfr, O[vt]); }
            }
        if (more) {
            LAS unsigned char* nb = lds + ((j + 1) & 1) * AT_STAGE;
#pragma unroll
            for (int i = 0; i < 4; ++i) *(LAS u32x4*)(nb + dst[i]) = pf[i];
        }
        __syncthreads();
    }
    lrun += __shfl_xor(lrun, 32);
    const float inv = frcp(lrun);
    LAS float* ex = (LAS float*)lds;
    if (mp == 1) {
        const float sc = inv * lam;
#pragma unroll
        for (int vt = 0; vt < 4; ++vt)
#pragma unroll
            for (int i = 0; i < 16; ++i) ex[(qg * 128 + 32 * vt + crow(i, h)) * 32 + r] = O[vt][i] * sc;
    }
    __syncthreads();
    if (mp == 0) {
        float sq = 0.f;
#pragma unroll
        for (int vt = 0; vt < 4; ++vt)
#pragma unroll
            for (int i = 0; i < 16; ++i) { const float o = O[vt][i] * inv - ex[(qg * 128 + 32 * vt + crow(i, h)) * 32 + r]; O[vt][i] = o; sq += o * o; }
        sq += __shfl_xor(sq, 32);
        const float rn = __builtin_amdgcn_rsqf(sq * (1.0f / 128.0f) + 1e-5f) * 0.8f;
        bf16_t* op = mixed + (rowb + q0 + 32 * qg + r) * DM + hd * 128;
#pragma unroll
        for (int vt = 0; vt < 4; ++vt)
#pragma unroll
            for (int gq = 0; gq < 4; ++gq) { const int v0 = 32 * vt + 8 * gq + 4 * h; const f32x4 wv = *(const f32x4*)(subln + v0);
                u32x2 o; o[0] = pk2(O[vt][4 * gq] * rn * wv[0], O[vt][4 * gq + 1] * rn * wv[1]); o[1] = pk2(O[vt][4 * gq + 2] * rn * wv[2], O[vt][4 * gq + 3] * rn * wv[3]);
                *(u32x2*)(op + v0) = o; }
    }
    __syncthreads();
}

constexpr int SB_K = 0, SB_V = 64 * KST, SB_STAGE = 64 * KST + 64 * VST64;
DI void sb_block(LAS unsigned char* lds, const bf16_t* proj, bf16_t* mixed, int b, int hs, int qb) {
    const int tid = otid(), w = __builtin_amdgcn_readfirstlane(tid >> 6), lane = tid & 63, r = lane & 31, h = lane >> 5;
    const int q0 = qb * 256; const size_t rowb = (size_t)b * SEQ;
    const int qidx = q0 + 32 * w + r;
    bf16x8 qf[4];
    { const bf16_t* qp = proj + (rowb + qidx) * AINW + 1536 + hs * 64 + 8 * h;
#pragma unroll
      for (int s = 0; s < 4; ++s) qf[s] = *(const bf16x8*)(qp + 16 * s); }
    f32x16 O[2]; O[0] = zero16(); O[1] = zero16();
    float carry = 1.0f;
    const int jmax = 4 * qb + 3;
    const int srow = tid >> 3, sc8 = tid & 7;
    const bf16_t* srcK = proj + (rowb + srow) * AINW + 2048 + hs * 64 + sc8 * 8;
    const bf16_t* srcV = proj + (rowb + srow) * AINW + 2560 + hs * 64 + sc8 * 8;
    const int dstK = SB_K + srow * KST + sc8 * 16, dstV = SB_V + srow * VST64 + sc8 * 16;
    u32x4 pk_ = *(const u32x4*)(srcK + (size_t)jmax * 64 * AINW), pv_ = *(const u32x4*)(srcV + (size_t)jmax * 64 * AINW);
    *(LAS u32x4*)(lds + dstK) = pk_; *(LAS u32x4*)(lds + dstV) = pv_;
    __syncthreads();
    const int i16 = lane & 15, tq = i16 >> 2, tp = i16 & 3, g16 = (lane >> 4) & 1;
    const int troff = (4 * h + tq) * VST64 + (16 * g16 + 4 * tp) * 2;
    int it = 0;
    for (int j = jmax; j >= 0; --j, ++it) {
        const bool more = (j > 0);
        if (more) { pk_ = *(const u32x4*)(srcK + (size_t)(j - 1) * 64 * AINW); pv_ = *(const u32x4*)(srcV + (size_t)(j - 1) * 64 * AINW); }
        const LAS unsigned char* base = lds + (it & 1) * SB_STAGE;
        const int kbase = 64 * j;
        if (kbase < q0 + 32 * w + 32) {
#pragma unroll
            for (int kt = 1; kt >= 0; --kt) {
                f32x16 S = zero16();
#pragma unroll
                for (int s = 0; s < 4; ++s) { const bf16x8 kf = *(const LAS bf16x8*)(base + SB_K + (32 * kt + r) * KST + (16 * s + 8 * h) * 2); S = MFMA32(kf, qf[s], S); }
                float T[4], sfx[16];
#pragma unroll
                for (int gq = 0; gq < 4; ++gq) {
                    float run = 1.0f;
#pragma unroll
                    for (int jj = 3; jj >= 0; --jj) {
                        const int i = 4 * gq + jj; const bool valid = (kbase + 32 * kt + crow(i, h)) < qidx;
                        const float zz = fmaxf(S[i], -60.0f); const float e = fexp2(-LOG2E * zz); const float sg = frcp(1.0f + e);
                        const float keep = valid ? e * sg : 1.0f;
                        S[i] = valid ? sg : 0.0f; sfx[i] = run; run *= keep;
                    }
                    T[gq] = run;
                }
                float To[4];
#pragma unroll
                for (int gq = 0; gq < 4; ++gq) To[gq] = __shfl_xor(T[gq], 32);
                float E[4]; float acc_hi = 1.0f;
#pragma unroll
                for (int gq = 3; gq >= 0; --gq) {
                    const float above_same = acc_hi;
                    E[gq] = (h == 0) ? above_same * To[gq] : above_same;
                    acc_hi = acc_hi * T[gq] * To[gq];
                }
#pragma unroll
                for (int i = 0; i < 16; ++i) S[i] = S[i] * carry * E[i >> 2] * sfx[i];
                carry *= acc_hi;
#pragma unroll
                for (int s2 = 0; s2 < 2; ++s2) {
                    const bf16x8 pfr = pack8(S, s2);
                    const LAS unsigned char* vrow = base + SB_V + (32 * kt + 16 * s2) * VST64 + troff;
#pragma unroll
                    for (int vt = 0; vt < 2; ++vt) { const bf16x8 vf = tr2(vrow + vt * 64, vrow + 8 * VST64 + vt * 64); O[vt] = MFMA32(vf, pfr, O[vt]); }
                }
            }
        }
        if (more) { LAS unsigned char* nb = lds + ((it + 1) & 1) * SB_STAGE; *(LAS u32x4*)(nb + dstK) = pk_; *(LAS u32x4*)(nb + dstV) = pv_; }
        const int done = (kbase < q0 + 32 * w + 32) && (carry < 1e-12f);
        const bool wdone = (__builtin_amdgcn_ballot_w64(done != 0) == ~0ull);
        LAS int* flg = (LAS int*)(lds + 2 * SB_STAGE) + (it & 1) * 8;
        if (lane == 0) flg[w] = wdone ? 1 : 0;
        __syncthreads();
        int all = 1;
#pragma unroll
        for (int ww = 0; ww < 8; ++ww) all &= flg[ww];
        if (all) break;
    }
    bf16_t* op = mixed + (rowb + qidx) * DM + 512 + hs * 64;
#pragma unroll
    for (int vt = 0; vt < 2; ++vt)
#pragma unroll
        for (int gq = 0; gq < 4; ++gq) { const int v0 = 32 * vt + 8 * gq + 4 * h;
            u32x2 o; o[0] = pk2(O[vt][4 * gq], O[vt][4 * gq + 1]); o[1] = pk2(O[vt][4 * gq + 2], O[vt][4 * gq + 3]); *(u32x2*)(op + v0) = o; }
    __syncthreads();
}
DI void attn_phase(LAS unsigned char* lds, const Params& p) {
    const bf16_t* proj = (const bf16_t*)(p.ws + O_PROJ); bf16_t* mixed = (bf16_t*)(p.ws + O_MIXED);
    const float lam = *(const float*)(p.ws + O_LAM);
    for (int it0 = blockIdx.x; it0 < 256; it0 += gridDim.x) {
        const int it = (it0 & 7) * 32 + (it0 >> 3);
        const int b = it >> 7, hd = (it >> 5) & 3, pr = it & 31;
        diff_tile(lds, proj, mixed, p.in[7], lam, b, hd, 63 - pr);
        diff_tile(lds, proj, mixed, p.in[7], lam, b, hd, pr);
    }
    for (int it0 = blockIdx.x; it0 < 512; it0 += gridDim.x) {
        const int it = (it0 & 7) * 64 + (it0 >> 3);
        const int b = it >> 8, hs = (it >> 5) & 7, qb = it & 31;
        sb_block(lds, proj, mixed, b, hs, qb);
    }
}
constexpr int SXS = 528, SBS = 272;
constexpr int L_SX = 0, L_SB = 128 * SXS, L_SC = L_SB + 128 * SBS, L_SDT = L_SC + 128 * SBS, L_SAC = L_SDT + 2048, L_SSQ = L_SAC + 2048;
static_assert(L_SSQ + 4096 <= LDS_BYTES, "lds");

DI void ssd_dt_acum(LAS unsigned char* lds, const float* DT, const float* dt_bias, const float* a_log, size_t t0, int g) {
    LAS float* sdt = (LAS float*)(lds + L_SDT); LAS float* sac = (LAS float*)(lds + L_SAC);
    const int tid = otid(), hh = tid >> 7, l = tid & 127, head = 4 * g + hh, w = tid >> 6, lane = tid & 63;
    const float raw = DT[(t0 + l) * 32 + head] + dt_bias[head];
    const float dt = fmaxf(raw, 0.f) + __logf(1.0f + __expf(-fabsf(raw)));
    sdt[hh * 128 + l] = dt; sac[hh * 128 + l] = -dt * __expf(a_log[head]);
    __syncthreads();
    if (w < 4) {
        const float v0 = sac[w * 128 + 2 * lane], v1 = sac[w * 128 + 2 * lane + 1]; float s = v0 + v1;
#pragma unroll
        for (int off = 1; off < 64; off <<= 1) { const float t = __shfl_up(s, off); if (lane >= off) s += t; }
        const float ex = s - (v0 + v1);
        sac[w * 128 + 2 * lane] = ex + v0; sac[w * 128 + 2 * lane + 1] = ex + v0 + v1;
    }
    __syncthreads();
}
template <int NT, class F> DI void conv_strip(const bf16_t* src, int nzero, const float* cw, const float* cb, int ch, F&& emit) {
    f32x4 wlo[4], whi[4];
#pragma unroll
    for (int k = 0; k < 4; ++k) { wlo[k] = *(const f32x4*)(cw + k * XBCW + ch); whi[k] = *(const f32x4*)(cw + k * XBCW + ch + 4); }
    const f32x4 blo = *(const f32x4*)(cb + ch), bhi = *(const f32x4*)(cb + ch + 4);
    u32x4 raw[NT + 3];
#pragma unroll
    for (int i = 0; i < NT + 3; ++i) { const int ii = (i < nzero) ? nzero : i; raw[i] = *(const u32x4*)(src + (ptrdiff_t)(ii - 3) * XBCW); if (i < nzero) raw[i] = (u32x4){0u, 0u, 0u, 0u}; }
#pragma unroll
    for (int t = 0; t < NT; ++t) {
        float o[8];
#pragma unroll
        for (int e = 0; e < 8; ++e) {
            float a = (e < 4) ? blo[e & 3] : bhi[e & 3];
#pragma unroll
            for (int k = 0; k < 4; ++k) { const unsigned d = raw[t + k][e >> 1]; const float xv = (e & 1) ? bfhi(d) : bflo(d); a += ((e < 4) ? wlo[k][e & 3] : whi[k][e & 3]) * xv; }
            o[e] = fsilu(a);
        }
        emit(t, o);
    }
}
DI u32x4 pack8f(const float* o) { u32x4 r; r[0] = pk2(o[0], o[1]); r[1] = pk2(o[2], o[3]); r[2] = pk2(o[4], o[5]); r[3] = pk2(o[6], o[7]); return r; }

template <bool XW, bool WITH_C> DI void ssd_stage(LAS unsigned char* lds, const bf16_t* xbc, const float* cw, const float* cb, size_t t0, int c, int g) {
    const int tid = otid();
    LAS float* sdt = (LAS float*)(lds + L_SDT); LAS float* sac = (LAS float*)(lds + L_SAC);
    {
        const int c8 = tid & 31, tg = tid >> 5, l0 = 8 * tg, ch = 256 * g + 8 * c8, hh = c8 >> 3;
        const int nzero = (c == 0) ? (3 - l0 > 0 ? 3 - l0 : 0) : 0;
        const float alast = sac[hh * 128 + 127];
        conv_strip<8>(xbc + (t0 + l0) * XBCW + ch, nzero, cw, cb, ch, [&](int t, float* o) {
            if (XW) { const float wgt = sdt[hh * 128 + l0 + t] * __expf(alast - sac[hh * 128 + l0 + t]);
#pragma unroll
                for (int e = 0; e < 8; ++e) o[e] *= wgt; }
            *(LAS u32x4*)(lds + L_SX + (l0 + t) * SXS + c8 * 16) = pack8f(o); });
    }
    {
        const int c8 = tid & 15, tg = tid >> 4, l0 = 4 * tg;
        const int nzero = (c == 0) ? (3 - l0 > 0 ? 3 - l0 : 0) : 0;
        const int chb = DIN + 128 * g + 8 * c8;
        conv_strip<4>(xbc + (t0 + l0) * XBCW + chb, nzero, cw, cb, chb, [&](int t, float* o) { *(LAS u32x4*)(lds + L_SB + (l0 + t) * SBS + c8 * 16) = pack8f(o); });
        if (WITH_C) { const int chc = DIN + 1024 + 128 * g + 8 * c8;
            conv_strip<4>(xbc + (t0 + l0) * XBCW + chc, nzero, cw, cb, chc, [&](int t, float* o) { *(LAS u32x4*)(lds + L_SC + (l0 + t) * SBS + c8 * 16) = pack8f(o); }); }
    }
}
DI bf16_t* st_ptr(unsigned char* ws, int b) { return (bf16_t*)(ws + (b ? O_ST1 : O_ST0)); }

DI void ssd_states_phase(LAS unsigned char* lds, const Params& p) {
    const int tid = otid(), w = __builtin_amdgcn_readfirstlane(tid >> 6), lane = tid & 63, r = lane & 31, h = lane >> 5, hh = w >> 1, ph = w & 1;
    const bf16_t* xbc = (const bf16_t*)(p.ws + O_XBC); const float* DT = (const float*)(p.ws + O_DT); float* cdec = (float*)(p.ws + O_CDEC);
    const int i16 = lane & 15, tq = i16 >> 2, tp = i16 & 3, g16 = (lane >> 4) & 1;
    for (int it = blockIdx.x; it < 1024; it += gridDim.x) {
        const int b = it >> 9, c = (it >> 3) & 63, g = it & 7; const size_t t0 = (size_t)b * SEQ + (size_t)c * 128;
        ssd_dt_acum(lds, DT, p.in[13], p.in[14], t0, g);
        ssd_stage<true, false>(lds, xbc, p.in[11], p.in[12], t0, c, g);
        __syncthreads();
        f32x16 acc[4];
#pragma unroll
        for (int i = 0; i < 4; ++i) acc[i] = zero16();
        const LAS unsigned char* xa = lds + L_SX + (8 * h + tq) * SXS + (64 * hh + 32 * ph + 16 * g16 + 4 * tp) * 2;
        const LAS unsigned char* ba = lds + L_SB + (8 * h + tq) * SBS + (16 * g16 + 4 * tp) * 2;
#pragma unroll
        for (int s = 0; s < 8; ++s) {
            const bf16x8 af = tr2(xa + 16 * s * SXS, xa + (16 * s + 4) * SXS);
#pragma unroll
            for (int nt = 0; nt < 4; ++nt) { const bf16x8 bfr = tr2(ba + 16 * s * SBS + nt * 64, ba + (16 * s + 4) * SBS + nt * 64); acc[nt] = MFMA32(af, bfr, acc[nt]); }
        }
        bf16_t* st = st_ptr(p.ws, b) + ((size_t)(c * 32 + 4 * g + hh) * 64 + 32 * ph) * 128;
#pragma unroll
        for (int nt = 0; nt < 4; ++nt)
#pragma unroll
            for (int i = 0; i < 16; ++i) st[(size_t)crow(i, h) * 128 + 32 * nt + r] = (bf16_t)(pk2(acc[nt][i], 0.f) & 0xffffu);
        if (tid < 4) cdec[(b * 64 + c) * 32 + 4 * g + tid] = __expf(((LAS float*)(lds + L_SAC))[tid * 128 + 127]);
        __syncthreads();
    }
}
DI void ssd_scan_phase(const Params& p, const bool dry) {
    const float* cdec = (const float*)(p.ws + O_CDEC);
    for (int e = blockIdx.x * 512 + threadIdx.x; e < 2 * 32 * 64 * 32; e += gridDim.x * 512) {
        const int b = e >> 16, rem = e & 65535, head = rem >> 11;
        bf16_t* st = st_ptr(p.ws, b) + (size_t)rem * 4;
        float carry[4] = {0.f, 0.f, 0.f, 0.f};
        for (int c0 = 0; c0 < 64; c0 += 8) {
            u32x2 v[8]; float dc[8];
#pragma unroll
            for (int u = 0; u < 8; ++u) { v[u] = *(const u32x2*)(st + (size_t)(c0 + u) * 262144); dc[u] = cdec[(b * 64 + c0 + u) * 32 + head]; }
#pragma unroll
            for (int u = 0; u < 8; ++u) {
                u32x2 o; o[0] = pk2(carry[0], carry[1]); o[1] = pk2(carry[2], carry[3]); if (!dry) *(u32x2*)(st + (size_t)(c0 + u) * 262144) = o;
                carry[0] = carry[0] * dc[u] + bflo(v[u][0]); carry[1] = carry[1] * dc[u] + bfhi(v[u][0]); carry[2] = carry[2] * dc[u] + bflo(v[u][1]); carry[3] = carry[3] * dc[u] + bfhi(v[u][1]);
            }
        }
    }
}
DI void ssd_out_phase(LAS unsigned char* lds, const Params& p, const bool dry) {
    const int tid = otid(), w = __builtin_amdgcn_readfirstlane(tid >> 6), lane = tid & 63, r = lane & 31, h = lane >> 5, hh = w >> 1, ph = w & 1;
    const bf16_t* xbc = (const bf16_t*)(p.ws + O_XBC); const float* DT = (const float*)(p.ws + O_DT); bf16_t* zy = (bf16_t*)p.out;
    LAS float* sdt = (LAS float*)(lds + L_SDT); LAS float* sac = (LAS float*)(lds + L_SAC); LAS float* ssq = (LAS float*)(lds + L_SSQ);
    const int i16 = lane & 15, tq = i16 >> 2, tp = i16 & 3, g16 = (lane >> 4) & 1;
    for (int it = blockIdx.x; it < 1024; it += gridDim.x) {
        const int b = it >> 9, c = (it >> 3) & 63, g = it & 7, head = 4 * g + hh; const size_t t0 = (size_t)b * SEQ + (size_t)c * 128;
        ssd_dt_acum(lds, DT, p.in[13], p.in[14], t0, g);
        ssd_stage<false, true>(lds, xbc, p.in[11], p.in[12], t0, c, g);
        bf16x8 pvf[8];
        { const bf16_t* pp = st_ptr(p.ws, b) + ((size_t)(c * 32 + head) * 64 + 32 * ph + r) * 128 + 8 * h;
#pragma unroll
          for (int s = 0; s < 8; ++s) pvf[s] = *(const bf16x8*)(pp + 16 * s); }
        __syncthreads();
        f32x16 Y[4];
        const LAS unsigned char* xa = lds + L_SX + (4 * h + tq) * SXS + (64 * hh + 32 * ph + 16 * g16 + 4 * tp) * 2;
#pragma unroll
        for (int lt = 0; lt < 4; ++lt) {
            __builtin_amdgcn_sched_barrier(0);
            f32x16 y = zero16();
#pragma unroll
            for (int s = 0; s < 8; ++s) { const bf16x8 cfs = *(const LAS bf16x8*)(lds + L_SC + (32 * lt + r) * SBS + (16 * s + 8 * h) * 2); y = MFMA32(pvf[s], cfs, y); }
            Y[lt] = y * __expf(sac[hh * 128 + 32 * lt + r]);
        }
#pragma unroll
        for (int lt = 0; lt < 4; ++lt) {
            __builtin_amdgcn_sched_barrier(0);
            bf16x8 cf[8];
#pragma unroll
            for (int s = 0; s < 8; ++s) cf[s] = *(const LAS bf16x8*)(lds + L_SC + (32 * lt + r) * SBS + (16 * s + 8 * h) * 2);
            const float al = sac[hh * 128 + 32 * lt + r];
#pragma unroll
            for (int mt = 0; mt < 4; ++mt) {
                if (mt <= lt) {
                    __builtin_amdgcn_sched_barrier(0);
                    f32x16 X = zero16();
#pragma unroll
                    for (int s = 0; s < 8; ++s) { const bf16x8 bfr = *(const LAS bf16x8*)(lds + L_SB + (32 * mt + r) * SBS + (16 * s + 8 * h) * 2); X = MFMA32(bfr, cf[s], X); }
#pragma unroll
                    for (int gq = 0; gq < 4; ++gq) {
                        const f32x4 am = *(const LAS f32x4*)(sac + hh * 128 + 32 * mt + 8 * gq + 4 * h), dm = *(const LAS f32x4*)(sdt + hh * 128 + 32 * mt + 8 * gq + 4 * h);
#pragma unroll
                        for (int jj = 0; jj < 4; ++jj) { const int mrow = 32 * mt + 8 * gq + 4 * h + jj; const bool ok = (32 * lt + r) >= mrow;
                            const float dec = ok ? __expf(fminf(al - am[jj], 0.f)) * dm[jj] : 0.f; X[4 * gq + jj] *= dec; }
                    }
#pragma unroll
                    for (int s2 = 0; s2 < 2; ++s2) { const bf16x8 xs = pack8(X, s2);
                        const LAS unsigned char* xr = xa + (32 * mt + 16 * s2) * SXS; const bf16x8 xf = tr2(xr, xr + 8 * SXS); Y[lt] = MFMA32(xf, xs, Y[lt]); }
                }
            }
        }
        __builtin_amdgcn_sched_barrier(0);
        const float Dh = p.in[15][head];
        float sq[4];
#pragma unroll
        for (int lt = 0; lt < 4; ++lt) {
            const int l = 32 * lt + r; sq[lt] = 0.f;
#pragma unroll
            for (int gq = 0; gq < 4; ++gq) {
                const int chl = 64 * hh + 32 * ph + 8 * gq + 4 * h;
                const u32x2 xv = *(const LAS u32x2*)(lds + L_SX + l * SXS + chl * 2);
                const u32x2 zv = *(const u32x2*)(zy + (t0 + l) * DIN + 256 * g + chl);
                const float xf4[4] = {bflo(xv[0]), bfhi(xv[0]), bflo(xv[1]), bfhi(xv[1])}, zf4[4] = {bflo(zv[0]), bfhi(zv[0]), bflo(zv[1]), bfhi(zv[1])};
#pragma unroll
                for (int jj = 0; jj < 4; ++jj) { const float yv = (Y[lt][4 * gq + jj] + Dh * xf4[jj]) * fsilu(zf4[jj]); Y[lt][4 * gq + jj] = yv; sq[lt] += yv * yv; }
            }
            sq[lt] += __shfl_xor(sq[lt], 32);
            if (h == 0) ssq[w * 128 + l] = sq[lt];
        }
        __syncthreads();
#pragma unroll
        for (int lt = 0; lt < 4; ++lt) {
            const int l = 32 * lt + r; float tot = 0.f;
#pragma unroll
            for (int ww = 0; ww < 8; ++ww) tot += ssq[ww * 128 + l];
            const float rn = __builtin_amdgcn_rsqf(tot * (1.0f / 256.0f) + 1e-5f);
#pragma unroll
            for (int gq = 0; gq < 4; ++gq) {
                const int chl = 64 * hh + 32 * ph + 8 * gq + 4 * h; const f32x4 gw = *(const f32x4*)(p.in[16] + 256 * g + chl);
                u32x2 o; o[0] = pk2(Y[lt][4 * gq] * rn * gw[0], Y[lt][4 * gq + 1] * rn * gw[1]); o[1] = pk2(Y[lt][4 * gq + 2] * rn * gw[2], Y[lt][4 * gq + 3] * rn * gw[3]);
                if (!dry) *(u32x2*)(zy + (t0 + l) * DIN + 256 * g + chl) = o;
            }
        }
        __syncthreads();
    }
}
template <class Epi> DI void run_gemm(LAS unsigned char* lds, const bf16_t* A, const bf16_t* Bt, int N, int K, const Epi& E) {
    pg8::Gemm g; g.A = A; g.Bt = Bt; g.M = MT; g.N = N; g.K = K;
    pg8::StaticOrder S; S.init(MT, N, (int)gridDim.x, (int)blockIdx.x);
    pg8::gemm_phase<Epi, pg8::StaticOrder, false>((PG8_LAS unsigned char*)lds, g, S, E, nullptr);
}
#if defined(DRY_S3) || defined(DRY_S4)
#define DRYV (p.ws == nullptr)
#else
#define DRYV false
#endif
__global__ void __launch_bounds__(512, 2) fwd_megakernel(Params p) {
    extern __shared__ __attribute__((aligned(16))) unsigned char shm[];
    LAS unsigned char* lds = (LAS unsigned char*)shm;
    cg::grid_group grid = cg::this_grid();
    if (threadIdx.x < 4) ((LAS unsigned*)(lds + LDS_BYTES - 16))[threadIdx.x] = 0u;
    __syncthreads();
    const XcdBarrier xbar = xcd_barrier_post((unsigned*)(p.ws + O_BAR), (volatile LAS unsigned*)(lds + LDS_BYTES - 16));
#define GBAR() xcd_barrier(xbar)
    unsigned char* ws = p.ws;
    bf16_t* hb = (bf16_t*)(ws + O_HB); float* ss = (float*)(ws + O_SS);
    phase0(lds, p);
#ifdef DUP_P0
    GBAR(); phase0(lds, p);
#endif
    if (gridDim.x == 0x7fffffffu) grid.sync();
    GBAR();
    { EpiAttnIn E; E.O = (bf16_t*)(ws + O_PROJ); E.ss = ss; E.tab = (const f32x4*)(ws + O_ROPE); run_gemm(lds, hb, (const bf16_t*)(ws + W_AIN), AINW, DM, E); }
    GBAR();
    attn_phase(lds, p);
#ifdef DUP_ATTN
    GBAR(); attn_phase(lds, p);
#endif
    GBAR();
    { EpiRes<true, false> E; E.xres = p.in[0]; E.hb = hb; E.outf = nullptr; E.ssn = ss + MT; run_gemm(lds, (const bf16_t*)(ws + O_MIXED), (const bf16_t*)(ws + W_AOUT), DM, DM, E); }
    GBAR();
    { EpiGU E; E.act = (bf16_t*)(ws + O_ACT); E.ss = ss + MT; run_gemm(lds, hb, (const bf16_t*)(ws + W_GU0), 2 * DFF, DM, E); }
    GBAR();
    { EpiRes<false, false> E; E.xres = nullptr; E.hb = hb; E.outf = nullptr; E.ssn = ss + 2 * MT; run_gemm(lds, (const bf16_t*)(ws + O_ACT), (const bf16_t*)(ws + W_DN0), DM, DFF, E); }
    GBAR();
    { EpiSsdIn E; E.z = (bf16_t*)p.out; E.xbc = (bf16_t*)(ws + O_XBC); E.dt = (float*)(ws + O_DT); E.ss = ss + 2 * MT; run_gemm(lds, hb, (const bf16_t*)(ws + W_SIN), SINWP, DM, E); }
    GBAR();
    ssd_states_phase(lds, p);
#ifdef DUP_S2
    GBAR(); ssd_states_phase(lds, p);
#endif
    GBAR();
#ifdef DRY_S3
    ssd_scan_phase(p, p.ws != nullptr); GBAR();
#endif
    ssd_scan_phase(p, DRYV);
    GBAR();
#ifdef DRY_S4
    ssd_out_phase(lds, p, p.ws != nullptr); GBAR();
#endif
    ssd_out_phase(lds, p, DRYV);
    GBAR();
    { EpiRes<false, false> E; E.xres = nullptr; E.hb = hb; E.outf = nullptr; E.ssn = ss + 3 * MT; run_gemm(lds, (const bf16_t*)p.out, (const bf16_t*)(ws + W_SOUT), DM, DIN, E); }
    GBAR();
    { EpiGU E; E.act = (bf16_t*)(ws + O_ACT); E.ss = ss + 3 * MT; run_gemm(lds, hb, (const bf16_t*)(ws + W_GU1), 2 * DFF, DM, E); }
    GBAR();
    { EpiRes<false, true> E; E.xres = nullptr; E.hb = hb; E.outf = p.out; E.ssn = ss + 4 * MT; run_gemm(lds, (const bf16_t*)(ws + O_ACT), (const bf16_t*)(ws + W_DN1), DM, DFF, E); }
    GBAR();
    {
        const float* ss4 = ss + 4 * MT; const f32x4* fw = (const f32x4*)p.in[22]; f32x4* o4 = (f32x4*)p.out;
        for (int i = blockIdx.x * 512 + threadIdx.x; i < MT * (DM / 4); i += gridDim.x * 512) {
            const int row = i >> 8; const float rs = __builtin_amdgcn_rsqf(ss4[row] * (1.0f / 1024.0f) + 1e-6f);
            o4[i] = o4[i] * rs * fw[i & 255];
        }
    }
}

extern "C" void kernel_launch(void* const* d_in, const int* in_sizes, int n_in, void* d_out, int out_size, void* d_ws, size_t ws_size, hipStream_t stream) {
    static int grid_blocks = 0;
    if (!grid_blocks) {
        int dev = 0, cus = 0, per_cu = 0;
        hipGetDevice(&dev);
        hipDeviceGetAttribute(&cus, hipDeviceAttributeMultiprocessorCount, dev);
        if (hipFuncSetAttribute((const void*)fwd_megakernel, hipFuncAttributeMaxDynamicSharedMemorySize, LDS_BYTES) != hipSuccess) fprintf(stderr, "hipFuncSetAttribute failed\n");
        if (hipOccupancyMaxActiveBlocksPerMultiprocessor(&per_cu, (const void*)fwd_megakernel, 512, LDS_BYTES) != hipSuccess || per_cu < 1) { fprintf(stderr, "occupancy query: %d\n", per_cu); per_cu = 1; }
        (void)hipGetLastError();
        grid_blocks = cus * per_cu;
        if (ws_size < 268435456ull || n_in != 23) fprintf(stderr, "unexpected ws_size %zu / n_in %d\n", ws_size, n_in);
    }
    if (hipMemsetAsync((char*)d_ws + O_BAR, 0, XCD_BAR_WORDS * 4, stream) != hipSuccess) fprintf(stderr, "memset failed\n");
    Params p{};
    for (int i = 0; i < 23; ++i) p.in[i] = (const float*)d_in[i];
    p.out = (float*)d_out; p.ws = (unsigned char*)d_ws;
    void* args[] = {&p};
    hipError_t e = hipLaunchCooperativeKernel((const void*)fwd_megakernel, dim3(grid_blocks), dim3(512), args, LDS_BYTES, stream);
    if (e != hipSuccess) fprintf(stderr, "cooperative launch failed: %s (grid %d)\n", hipGetErrorString(e), grid_blocks);
}
#ifdef PHASE_TEST
__global__ void __launch_bounds__(512, 2) t_phase0(Params p) { extern __shared__ __attribute__((aligned(16))) unsigned char shm[]; phase0((LAS unsigned char*)shm, p); }
__global__ void __launch_bounds__(512, 2) t_attn_diff(Params p) { extern __shared__ __attribute__((aligned(16))) unsigned char shm[]; diff_tile((LAS unsigned char*)shm, (const bf16_t*)(p.ws + O_PROJ), (bf16_t*)(p.ws + O_MIXED), p.in[7], 0.3f, blockIdx.x & 1, blockIdx.y, blockIdx.z); }
__global__ void __launch_bounds__(512, 2) t_attn_sb(Params p) { extern __shared__ __attribute__((aligned(16))) unsigned char shm[]; sb_block((LAS unsigned char*)shm, (const bf16_t*)(p.ws + O_PROJ), (bf16_t*)(p.ws + O_MIXED), blockIdx.x & 1, blockIdx.y, blockIdx.z); }
__global__ void __launch_bounds__(512, 2) t_ssd_states(Params p) { extern __shared__ __attribute__((aligned(16))) unsigned char shm[]; ssd_states_phase((LAS unsigned char*)shm, p); }
__global__ void __launch_bounds__(512, 2) t_ssd_scan(Params p) { ssd_scan_phase(p, false); }
__global__ void __launch_bounds__(512, 2) t_ssd_out(Params p) { extern __shared__ __attribute__((aligned(16))) unsigned char shm[]; ssd_out_phase((LAS unsigned char*)shm, p, false); }
__global__ void __launch_bounds__(512, 2) t_gemm_ain(Params p) { extern __shared__ __attribute__((aligned(16))) unsigned char shm[]; EpiAttnIn E; E.O = (bf16_t*)(p.ws + O_PROJ); E.ss = (float*)(p.ws + O_SS); E.tab = (const f32x4*)(p.ws + O_ROPE); run_gemm((LAS unsigned char*)shm, (bf16_t*)(p.ws + O_HB), (const bf16_t*)(p.ws + W_AIN), AINW, DM, E); }
__global__ void __launch_bounds__(512, 2) t_gemm_res(Params p) { extern __shared__ __attribute__((aligned(16))) unsigned char shm[]; EpiRes<false, false> E; E.xres = nullptr; E.hb = (bf16_t*)(p.ws + O_HB); E.outf = nullptr; E.ssn = (float*)(p.ws + O_SS); run_gemm((LAS unsigned char*)shm, (bf16_t*)(p.ws + O_ACT), (const bf16_t*)(p.ws + W_DN0), DM, DFF, E); }
__global__ void __launch_bounds__(512, 2) t_gemm_gu(Params p) { extern __shared__ __attribute__((aligned(16))) unsigned char shm[]; EpiGU E; E.act = (bf16_t*)(p.ws + O_ACT); E.ss = (float*)(p.ws + O_SS); run_gemm((LAS unsigned char*)shm, (bf16_t*)(p.ws + O_HB), (const bf16_t*)(p.ws + W_GU0), 2 * DFF, DM, E); }
__global__ void __launch_bounds__(512, 2) t_gemm_ssdin(Params p) { extern __shared__ __attribute__((aligned(16))) unsigned char shm[]; EpiSsdIn E; E.z = (bf16_t*)p.out; E.xbc = (bf16_t*)(p.ws + O_XBC); E.dt = (float*)(p.ws + O_DT); E.ss = (float*)(p.ws + O_SS); run_gemm((LAS unsigned char*)shm, (bf16_t*)(p.ws + O_HB), (const bf16_t*)(p.ws + W_SIN), SINWP, DM, E); }
#endif
```

```cpp
#include <hip/hip_runtime.h>
#include <hip/hip_cooperative_groups.h>
#include <cstdio>
#include <cstdint>
namespace cg = cooperative_groups;
namespace pg8 {
#define PG8_LAS __attribute__((address_space(3)))
typedef unsigned short bf16_t;
typedef short bf16x8 __attribute__((ext_vector_type(8)));
typedef float f32x4 __attribute__((ext_vector_type(4)));
typedef unsigned u32x4 __attribute__((ext_vector_type(4)));
constexpr int BM = 256, BK = 64, HALF = 128, HTB = HALF * BK * 2  , STAGE_BYTES = 8 * HTB, NXCD = 8, WGM = 8;

__host__ __device__ __forceinline__ int lds_byte(int r, int c) { const int st = (r >> 4) * 2 + (c >> 5), rr = r & 15, cc = c & 31, ob = rr * 64 + cc * 2; return st * 1024 + (ob ^ (((ob >> 9) & 1) << 5)); }
__host__ __device__ __forceinline__ void stage_rc(int b, int& R, int& C) { const int st = b / 1024, sb = b % 1024, swz = sb ^ (((sb >> 9) & 1) << 5); R = (st >> 1) * 16 + swz / 64; C = (st & 1) * 32 + (swz % 64) / 2; }
__host__ __device__ __forceinline__ int perm32(int rho) { const int n = rho >> 4, i = rho & 15; return 8 * (i >> 2) + 4 * n + (i & 3); }

struct Unit { int pm, pn; };
struct Gemm { const bf16_t* A; const bf16_t* Bt; int M, N, K; };

struct StaticOrder {
    int nM, nN, nwg, G, c;
    __host__ __device__ void init(int M, int N, int G_, int c_) { nM = M / BM; nN = N / BM; nwg = nM * nN; G = G_; c = c_; }
    __host__ __device__ bool next(int i, Unit& u) const {
        const long L = (long)i * G + c; if (L >= nwg) return false;
        int wgid = (int)L; { const int q = nwg / NXCD, r = nwg % NXCD, xcd = wgid % NXCD, off = wgid / NXCD; wgid = (xcd < r ? xcd * (q + 1) : r * (q + 1) + (xcd - r) * q) + off; }
        const int nig = WGM * nN, gid = wgid / nig, fm = gid * WGM, gsz = (nM - fm) < WGM ? (nM - fm) : WGM;
        u.pm = fm + ((wgid % nig) % gsz); u.pn = (wgid % nig) / gsz; return true;
    }
    __device__ __forceinline__ void a_ready(const Unit&) const {}
    __device__ __forceinline__ void done(const Unit&) const {}
};

template <class Epi, class Sched, bool STAMP = false>
__device__ __forceinline__ void gemm_phase(PG8_LAS unsigned char* lds, const Gemm g, const Sched& S, const Epi& E, unsigned long long* stamps) {
    int tid_ = threadIdx.x; asm volatile("" : "+v"(tid_)); const int tid = tid_, wid = __builtin_amdgcn_readfirstlane(tid >> 6), lane = tid & 63, wr = wid >> 2, wc = wid & 3, fr = lane & 15, fq = lane >> 4;
    const int K = g.K, nt = K / BK;
    int ts_lo = 0, ts_hi = 0, nts = 0; const unsigned long long rt_entry = STAMP ? (unsigned long long)wall_clock64() : 0ull;
#define PG8_STAMP() do { if (STAMP && wid == 0 && nts < 64) { const unsigned long long _c = (unsigned long long)clock64(); \
        ts_lo = (lane == nts) ? (int)(unsigned)_c : ts_lo; ts_hi = (lane == nts) ? (int)(unsigned)(_c >> 32) : ts_hi; ++nts; } } while (0)
    PG8_STAMP();
    unsigned voffA[2], voffB[2];
#pragma unroll
    for (int i = 0; i < 2; ++i) { int R, C; stage_rc(tid * 16 + i * 8192, R, C); const int Rb = Epi::PERM ? ((R & ~31) + perm32(R & 31)) : R;
        voffA[i] = (unsigned)(R * K + C) * 2u; voffB[i] = (unsigned)(Rb * K + C) * 2u; }
    const size_t kstep = (size_t)(BK * 2);
    const size_t hstep = (size_t)HALF * K * 2;
    const size_t tstep = 2 * hstep;
    const unsigned ldsw = (unsigned)wid * 1024u;
    const int aoff = lds_byte(wr * 64 + fr, fq * 8), boff = lds_byte(wc * 32 + fr, fq * 8);
#define PG8_SA(b, h) (((b) * 2 + (h)) * HTB)
#define PG8_SB(b, h) ((4 + (b) * 2 + (h)) * HTB)
#define PG8_STAGE(bufoff, gbase, voff) do { _Pragma("unroll") for (int _i = 0; _i < 2; ++_i) \
        __builtin_amdgcn_global_load_lds((const unsigned*)((const char*)(gbase) + (voff)[_i]), (PG8_LAS unsigned*)(lds + (bufoff) + ldsw + _i * 8192), 16, 0, 0); } while (0)
#define PG8_LDA(dst, b, h) do { _Pragma("unroll") for (int m = 0; m < 4; ++m) _Pragma("unroll") for (int k = 0; k < 2; ++k) dst[m][k] = *(const PG8_LAS bf16x8*)(lds + PG8_SA(b, h) + aoff + m * 2048 + k * 1024); } while (0)
#define PG8_LDB(dst, b, h) do { _Pragma("unroll") for (int n = 0; n < 2; ++n) _Pragma("unroll") for (int k = 0; k < 2; ++k) dst[n][k] = *(const PG8_LAS bf16x8*)(lds + PG8_SB(b, h) + boff + n * 2048 + k * 1024); } while (0)
#define PG8_MMA(ai, bj, At, Bt) do { __builtin_amdgcn_s_setprio(1); _Pragma("unroll") for (int m = 0; m < 4; ++m) _Pragma("unroll") for (int n = 0; n < 2; ++n) _Pragma("unroll") for (int k = 0; k < 2; ++k) \
        acc[ai][bj][m][n] = __builtin_amdgcn_mfma_f32_16x16x32_bf16(Bt[n][k], At[m][k], acc[ai][bj][m][n], 0, 0, 0); __builtin_amdgcn_s_setprio(0); } while (0)
#define PG8_WAIT_V(n) asm volatile("s_waitcnt vmcnt(" #n ")" ::: "memory")
#define PG8_WAIT_L(n) asm volatile("s_waitcnt lgkmcnt(" #n ")" ::: "memory")
#define PG8_BAR __builtin_amdgcn_s_barrier()
#define PG8_SCHED __builtin_amdgcn_sched_barrier(0)
    Unit cur, nxt; int ui = 0;
    if (!S.next(0, cur)) return;
    f32x4 acc[2][2][4][2];
#pragma unroll
    for (int a = 0; a < 2; ++a)
#pragma unroll
        for (int b = 0; b < 2; ++b)
#pragma unroll
            for (int m = 0; m < 4; ++m)
#pragma unroll
                for (int n = 0; n < 2; ++n) acc[a][b][m][n] = (f32x4){0.f, 0.f, 0.f, 0.f};
    bf16x8 At[4][2], B0[2][2], B1[2][2];
    const char* cA = (const char*)g.A + (size_t)cur.pm * tstep; const char* cB = (const char*)g.Bt + (size_t)cur.pn * tstep;
    S.a_ready(cur);
    PG8_STAGE(PG8_SB(0, 0), cB, voffB); PG8_STAGE(PG8_SA(0, 0), cA, voffA); PG8_STAGE(PG8_SB(0, 1), cB + hstep, voffB); PG8_STAGE(PG8_SA(0, 1), cA + hstep, voffA);
    if (wr == 1) PG8_BAR;
    PG8_WAIT_V(4); PG8_BAR;
    PG8_STAGE(PG8_SB(1, 0), cB + kstep, voffB); PG8_STAGE(PG8_SA(1, 0), cA + kstep, voffA); PG8_STAGE(PG8_SB(1, 1), cB + hstep + kstep, voffB);
    PG8_WAIT_V(6); PG8_BAR;
    PG8_STAMP();
    for (;;) {
        const bool has_next = S.next(ui + 1, nxt);
        const char* nA = has_next ? (const char*)g.A + (size_t)nxt.pm * tstep : cA; const char* nB = has_next ? (const char*)g.Bt + (size_t)nxt.pn * tstep : cB;
        for (int t = 0; t < nt; t += 2) {
            const bool last = (t == nt - 2);
            const char* a1 = cA + (size_t)(t + 1) * kstep;
            const char* a2 = last ? nA : cA + (size_t)(t + 2) * kstep; const char* b2 = last ? nB : cB + (size_t)(t + 2) * kstep;
            const char* a3 = a2 + kstep; const char* b3 = b2 + kstep;
            if (last && has_next) S.a_ready(nxt);
            PG8_LDB(B0, 0, 0); PG8_SCHED; PG8_LDA(At, 0, 0); PG8_STAGE(PG8_SA(1, 1), a1 + hstep, voffA);
            PG8_WAIT_L(8); PG8_BAR; PG8_WAIT_L(0); PG8_MMA(0, 0, At, B0); PG8_BAR; PG8_SCHED;
            PG8_LDB(B1, 0, 1); PG8_STAGE(PG8_SB(0, 0), b2, voffB);
            PG8_BAR; PG8_WAIT_L(0); PG8_MMA(0, 1, At, B1); PG8_BAR;
            PG8_LDA(At, 0, 1); PG8_STAGE(PG8_SA(0, 0), a2, voffA);
            PG8_BAR; PG8_WAIT_L(0); PG8_MMA(1, 0, At, B0); PG8_BAR; PG8_SCHED;
            PG8_STAGE(PG8_SB(0, 1), b2 + hstep, voffB);
            PG8_WAIT_V(6); PG8_BAR; PG8_MMA(1, 1, At, B1); PG8_BAR;
            PG8_LDB(B0, 1, 0); PG8_SCHED; PG8_LDA(At, 1, 0); PG8_STAGE(PG8_SA(0, 1), a2 + hstep, voffA);
            PG8_WAIT_L(8); PG8_BAR; PG8_WAIT_L(0); PG8_MMA(0, 0, At, B0); PG8_BAR; PG8_SCHED;
            PG8_LDB(B1, 1, 1); PG8_STAGE(PG8_SB(1, 0), b3, voffB);
            PG8_BAR; PG8_WAIT_L(0); PG8_MMA(0, 1, At, B1); PG8_BAR;
            PG8_LDA(At, 1, 1); PG8_STAGE(PG8_SA(1, 0), a3, voffA);
            PG8_BAR; PG8_WAIT_L(0); PG8_MMA(1, 0, At, B0); PG8_BAR; PG8_SCHED;
            PG8_STAGE(PG8_SB(1, 1), b3 + hstep, voffB);
            PG8_WAIT_V(6); PG8_BAR; PG8_MMA(1, 1, At, B1); PG8_BAR;
        }
        PG8_STAMP();
        if constexpr (!Epi::AFTER_DRAIN) { E(acc, cur, wr, wc, fr, fq); S.done(cur); }
        PG8_STAMP();
        if (!has_next) break;
#pragma unroll
        for (int a = 0; a < 2; ++a)
#pragma unroll
            for (int b = 0; b < 2; ++b)
#pragma unroll
                for (int m = 0; m < 4; ++m)
#pragma unroll
                    for (int n = 0; n < 2; ++n) acc[a][b][m][n] = (f32x4){0.f, 0.f, 0.f, 0.f};
        cur = nxt; cA = nA; cB = nB; ++ui;
    }
    PG8_WAIT_V(0);
    if (wr == 0) PG8_BAR;
    PG8_BAR;
    if constexpr (Epi::AFTER_DRAIN) { E.fused(acc, cur, wr, wc, fr, fq, lds, wid, lane); S.done(cur); }
    PG8_STAMP();
    if (STAMP && wid == 0) { stamps[lane] = lane < nts ? (((unsigned long long)(unsigned)ts_hi << 32) | (unsigned)ts_lo) : 0ull;
        if (lane == 62) stamps[62] = rt_entry; if (lane == 63) stamps[63] = (unsigned long long)wall_clock64(); }
#undef PG8_STAMP
#undef PG8_SA
#undef PG8_SB
#undef PG8_STAGE
#undef PG8_LDA
#undef PG8_LDB
#undef PG8_MMA
#undef PG8_WAIT_V
#undef PG8_WAIT_L
#undef PG8_BAR
#undef PG8_SCHED
}
}
using pg8::bf16_t; using pg8::bf16x8; using pg8::f32x4;
typedef short s16x4 __attribute__((ext_vector_type(4)));
typedef float f32x16 __attribute__((ext_vector_type(16)));
typedef float f32x2 __attribute__((ext_vector_type(2)));
typedef __bf16 bf2_t __attribute__((ext_vector_type(2)));
typedef unsigned u32x2 __attribute__((ext_vector_type(2)));
typedef unsigned u32x4 __attribute__((ext_vector_type(4)));
#define LAS __attribute__((address_space(3)))
#define DI __device__ __forceinline__
#define MFMA32(a, b, c) __builtin_amdgcn_mfma_f32_32x32x16_bf16((a), (b), (c), 0, 0, 0)

DI int otid() { int t = threadIdx.x; asm volatile("" : "+v"(t)); return t; }
DI unsigned pk2(float a, float b) { f32x2 v = {a, b}; bf2_t r = __builtin_convertvector(v, bf2_t); return __builtin_bit_cast(unsigned, r); }
DI float bflo(unsigned u) { return __uint_as_float(u << 16); }
DI float bfhi(unsigned u) { return __uint_as_float(u & 0xffff0000u); }
DI float fexp2(float x) { return __builtin_amdgcn_exp2f(x); }
DI float frcp(float x) { return __builtin_amdgcn_rcpf(x); }
DI float fsilu(float x) { return x * frcp(1.0f + fexp2(-1.44269504089f * x)); }
DI int crow(int i, int h) { return (i & 3) + 8 * (i >> 2) + 4 * h; }
DI s16x4 trr(const LAS unsigned char* p) { return __builtin_amdgcn_ds_read_tr16_b64_v4i16((LAS s16x4*)p); }
DI bf16x8 tr2(const LAS unsigned char* p0, const LAS unsigned char* p1) { s16x4 a = trr(p0), b = trr(p1); return __builtin_shufflevector(a, b, 0, 1, 2, 3, 4, 5, 6, 7); }
DI bf16x8 pack8(const f32x16& x, int s) {
    u32x4 p; p[0] = pk2(x[8 * s], x[8 * s + 1]); p[1] = pk2(x[8 * s + 2], x[8 * s + 3]); p[2] = pk2(x[8 * s + 4], x[8 * s + 5]); p[3] = pk2(x[8 * s + 6], x[8 * s + 7]);
    return __builtin_bit_cast(bf16x8, p);
}
DI f32x16 zero16() { f32x16 z; for (int i = 0; i < 16; ++i) z[i] = 0.f; return z; }

constexpr int MT = 16384, SEQ = 8192, DM = 1024, DFF = 2816, AINW = 3072, SINW = 6176, SINWP = 6400, DIN = 2048, XBCW = 4096;
constexpr float LOG2E = 1.44269504089f;
constexpr int LDS_BYTES = 155648;
constexpr size_t W_AIN = 0, W_AOUT = W_AIN + (size_t)AINW * DM * 2, W_GU0 = W_AOUT + (size_t)DM * DM * 2, W_DN0 = W_GU0 + (size_t)2 * DFF * DM * 2,
                 W_SIN = W_DN0 + (size_t)DM * DFF * 2, W_SOUT = W_SIN + (size_t)SINWP * DM * 2, W_GU1 = W_SOUT + (size_t)DM * DIN * 2, W_DN1 = W_GU1 + (size_t)2 * DFF * DM * 2,
                 O_HB = W_DN1 + (size_t)DM * DFF * 2, O_SS = O_HB + (size_t)MT * DM * 2, O_ROPE = O_SS + (size_t)5 * MT * 4, O_DT = O_ROPE + (size_t)SEQ * 32 * 8,
                 O_CDEC = O_DT + (size_t)MT * 32 * 4, O_LAM = O_CDEC + 16384, O_BAR = O_LAM + 256, O_R = 98566144;
static_assert(O_BAR + 16384 <= O_R, "map");
constexpr size_t O_PROJ = O_R, O_MIXED = O_PROJ + (size_t)MT * AINW * 2, O_ACT = O_R, O_XBC = O_R, O_ST1 = O_XBC + (size_t)MT * XBCW * 2, O_ST0 = 0;
constexpr size_t ST_BATCH = (size_t)64 * 32 * 64 * 128;
static_assert(O_ST1 + ST_BATCH * 2 <= 268435456ull, "ws");
static_assert(ST_BATCH * 2 <= W_SOUT, "st0 overlay");
static_assert(O_MIXED + (size_t)MT * DM * 2 <= 268435456ull, "ws2");

struct Params { const float* in[23]; float* out; unsigned char* ws; };
#include <cstdlib>
#include <vector>

#define XB_TMO      128
#define XB_XCNT(j)  (256  + 64 * (j))
#define XB_XSUB(j)  (1280 + 64 * (j))
#define XB_XGEN(j)  (2304 + 64 * (j))
#define XB_TOP      3328
#define XB_TOPGEN   3392
#define XCD_BAR_WORDS 3456
#define XB_SPIN_CAP (1u << 18)

__device__ __forceinline__ unsigned xb_ld(unsigned* p)              { return __hip_atomic_load(p, __ATOMIC_RELAXED, __HIP_MEMORY_SCOPE_AGENT); }
__device__ __forceinline__ unsigned xb_add(unsigned* p, unsigned v) { return __hip_atomic_fetch_add(p, v, __ATOMIC_RELAXED, __HIP_MEMORY_SCOPE_AGENT); }
__device__ __forceinline__ unsigned xb_xcc_id() { return (unsigned)__builtin_amdgcn_s_getreg((3 << 11) | 20) & 0xFu; }
#define XB_SPIN(cond, bar) do { unsigned _sp = 0; while (cond) { __builtin_amdgcn_s_sleep(1); \
    if ((++_sp & 255u) == 0u) { if (xb_ld(&(bar)[XB_TMO])) break; if (_sp > XB_SPIN_CAP) { atomicAdd(&(bar)[XB_TMO], 1u); break; } } } } while (0)

struct XcdBarrier {
    unsigned* bar; unsigned x;
    volatile LAS unsigned* st;
};

__device__ __forceinline__ XcdBarrier xcd_barrier_post(unsigned* bar, volatile LAS unsigned* st) {
    XcdBarrier b; b.bar = bar; b.x = xb_xcc_id(); b.st = st;
    if (threadIdx.x == 0) (void)xb_add(&bar[XB_XCNT(b.x)], 1u);
    return b;
}
__device__ __forceinline__ void xcd_barrier_complete(unsigned* bar, unsigned x, unsigned& nloc, unsigned& nx) {
    const unsigned G = gridDim.x * gridDim.y * gridDim.z;
    unsigned sum, cnt, mine, sp = 0u;
    for (;;) {
        sum = 0u; cnt = 0u; mine = 0u;
#pragma unroll
        for (unsigned j = 0; j < 16; ++j) { const unsigned c = xb_ld(&bar[XB_XCNT(j)]); sum += c; cnt += (c > 0u) ? 1u : 0u; mine = (j == x) ? c : mine; }
        if (sum == G) break;
        __builtin_amdgcn_s_sleep(1);
        if ((++sp & 255u) == 0u) { if (xb_ld(&bar[XB_TMO])) break; if (sp > XB_SPIN_CAP) { atomicAdd(&bar[XB_TMO], 1u); break; } }
    }
    nloc = mine > 0u ? mine : 1u; nx = cnt > 0u ? cnt : 1u;
}

__device__ __forceinline__ void xcd_barrier(const XcdBarrier& b) {
    asm volatile("s_waitcnt vmcnt(0)" ::: "memory");
    __syncthreads();
    if (threadIdx.x == 0) {
        unsigned* bar = b.bar;
        __builtin_amdgcn_s_waitcnt(0);
        unsigned nloc = b.st[0], nx = b.st[1];
        if (nloc == 0u) { xcd_barrier_complete(bar, b.x, nloc, nx); b.st[0] = nloc; b.st[1] = nx; }
        const unsigned old = xb_add(&bar[XB_XSUB(b.x)], 1u);
        const unsigned gen = old / nloc;
        if (old + 1u == (gen + 1u) * nloc) {
            __builtin_amdgcn_fence(__ATOMIC_RELEASE, "agent");
            asm volatile("s_waitcnt vmcnt(0)" ::: "memory");
            const unsigned og = xb_add(&bar[XB_TOP], 1u);
            const unsigned tg = og / nx;
            if (og + 1u == (tg + 1u) * nx) xb_add(&bar[XB_TOPGEN], 1u);
            else XB_SPIN(xb_ld(&bar[XB_TOPGEN]) == tg, bar);
            __builtin_amdgcn_fence(__ATOMIC_ACQUIRE, "agent");
            xb_add(&bar[XB_XGEN(b.x)], 1u);
            asm volatile("s_waitcnt vmcnt(0)" ::: "memory");
        } else {
            XB_SPIN(xb_ld(&bar[XB_XGEN(b.x)]) == gen, bar);
            __builtin_amdgcn_fence(__ATOMIC_ACQUIRE, "agent");
            asm volatile("s_waitcnt vmcnt(0)" ::: "memory");
        }
    }
    __syncthreads();
}
DI void wmap(int mode, int c, int& src, float& scale, int& which) {
    src = c; scale = 1.f; which = 0;
    if (mode == 0) {
        if (c < 1024) { const int base = c & ~63, cc = c & 63, g = cc >> 3, e = cc & 7; src = base + (e < 4 ? 4 * g + e : 32 + 4 * g + (e - 4)); }
        if (c < 512) scale = 0.125f * LOG2E; else if (c >= 1536 && c < 2048) scale = 0.125f;
    } else if (mode == 2) { src = 4 * (c >> 3) + (c & 3); which = (c >> 2) & 1; }
    else if (mode == 3) { if (c >= SINW) src = -1; }
}
DI void wconv_tile(LAS float* tile, int mode, const float* W0, const float* W1, const float* kscale, bf16_t* dst, int K, int ldw, int tix) {
    const int tid = otid(), nk = K >> 8, c0 = (tix / nk) * 64, k0 = (tix % nk) * 256;
    const int cc = tid & 63; int src, which; float sc; wmap(mode, c0 + cc, src, sc, which);
    const float* W = (which ? W1 : W0) + (src >= 0 ? src : 0);
    float v[32];
#pragma unroll
    for (int i = 0; i < 32; ++i) { const int kk = (tid >> 6) + 8 * i; v[i] = W[(size_t)(k0 + kk) * ldw]; }
#pragma unroll
    for (int i = 0; i < 32; ++i) { const int kk = (tid >> 6) + 8 * i; float x = (src >= 0) ? v[i] * sc : 0.f; if (kscale) x *= kscale[k0 + kk]; tile[kk * 65 + cc] = x; }
    __syncthreads();
#pragma unroll
    for (int i = 0; i < 16; ++i) {
        const int idx = tid + 512 * i, c2 = idx >> 7, k2 = (idx & 127) * 2;
        *(unsigned*)(dst + (size_t)(c0 + c2) * K + k0 + k2) = pk2(tile[k2 * 65 + c2], tile[(k2 + 1) * 65 + c2]);
    }
    __syncthreads();
}
DI void phase0(LAS unsigned char* lds, const Params& p) {
    const int tid = otid(), G = gridDim.x, bx = blockIdx.x;
    unsigned char* ws = p.ws;
    const int cnt[8] = {48 * 4, 16 * 4, 88 * 4, 16 * 11, 100 * 4, 16 * 8, 88 * 4, 16 * 11};
    int total = 0;
#pragma unroll
    for (int j = 0; j < 8; ++j) total += cnt[j];
    for (int t = bx; t < total; t += G) {
        int j = 0, tt = t;
#pragma unroll
        for (int q = 0; q < 7; ++q) if (j == q && tt >= cnt[q]) { tt -= cnt[q]; j = q + 1; }
        LAS float* tile = (LAS float*)lds;
        switch (j) {
        case 0: wconv_tile(tile, 0, p.in[2], nullptr, p.in[1], (bf16_t*)(ws + W_AIN), DM, AINW, tt); break;
        case 1: wconv_tile(tile, 1, p.in[8], nullptr, nullptr, (bf16_t*)(ws + W_AOUT), DM, DM, tt); break;
        case 2: wconv_tile(tile, 2, p.in[19], p.in[20], p.in[18], (bf16_t*)(ws + W_GU0), DM, DFF, tt); break;
        case 3: wconv_tile(tile, 1, p.in[21], nullptr, nullptr, (bf16_t*)(ws + W_DN0), DFF, DM, tt); break;
        case 4: wconv_tile(tile, 3, p.in[10], nullptr, p.in[9], (bf16_t*)(ws + W_SIN), DM, SINW, tt); break;
        case 5: wconv_tile(tile, 1, p.in[17], nullptr, nullptr, (bf16_t*)(ws + W_SOUT), DIN, DM, tt); break;
        case 6: wconv_tile(tile, 2, p.in[19] + (size_t)DM * DFF, p.in[20] + (size_t)DM * DFF, p.in[18] + DM, (bf16_t*)(ws + W_GU1), DM, DFF, tt); break;
        default: wconv_tile(tile, 1, p.in[21] + (size_t)DFF * DM, nullptr, nullptr, (bf16_t*)(ws + W_DN1), DFF, DM, tt); break;
        }
    }
    {
        const int wave = tid >> 6, lane = tid & 63; bf16_t* hb = (bf16_t*)(ws + O_HB); float* ss = (float*)(ws + O_SS);
        for (int row = bx * 8 + wave; row < MT; row += G * 8) {
            const float* xr = p.in[0] + (size_t)row * DM; float sq = 0.f;
#pragma unroll
            for (int i = 0; i < 4; ++i) { const f32x4 v = *(const f32x4*)(xr + lane * 4 + 256 * i); sq += v[0] * v[0] + v[1] * v[1] + v[2] * v[2] + v[3] * v[3];
                u32x2 o; o[0] = pk2(v[0], v[1]); o[1] = pk2(v[2], v[3]); *(u32x2*)(hb + (size_t)row * DM + lane * 4 + 256 * i) = o; }
#pragma unroll
            for (int o = 32; o >= 1; o >>= 1) sq += __shfl_xor(sq, o);
            if (lane == 0) ss[row] = sq;
        }
        for (int i = bx * 512 + tid; i < 4 * MT; i += G * 512) ss[MT + i] = 0.f;
        f32x2* tab = (f32x2*)(ws + O_ROPE);
        for (int i = bx * 512 + tid; i < SEQ * 32; i += G * 512) {
            const int pos = i >> 5, f = i & 31; const float inv = fexp2(-(float)f * 0.41524101186092f); const float ang = (float)pos * inv;
            double t = (double)ang * 0.15915494309189535; t -= floor(t); const float tf = (float)t;
            f32x2 cs; cs[0] = __builtin_amdgcn_cosf(tf); cs[1] = __builtin_amdgcn_sinf(tf); tab[i] = cs;
        }
        if (bx == 0 && tid == 0) { float s1 = 0.f, s2 = 0.f; for (int i = 0; i < 64; ++i) { s1 += p.in[3][i] * p.in[4][i]; s2 += p.in[5][i] * p.in[6][i]; }
            *(float*)(ws + O_LAM) = fexp2(s1 * LOG2E) - fexp2(s2 * LOG2E) + 0.2f; }
    }
}

struct EpiAttnIn {
    static constexpr bool PERM = true, AFTER_DRAIN = false;
    bf16_t* O; const float* ss; const f32x4* tab;
    DI void operator()(const f32x4 (&acc)[2][2][4][2], const pg8::Unit& u, int wr, int wc, int fr, int fq) const {
        const int row0 = u.pm * 256 + wr * 64 + fr, colt = u.pn * 256, col0 = colt + wc * 32 + 8 * fq;
        const int fb = 4 * (4 * (wc & 1) + fq);
#pragma unroll
        for (int ai = 0; ai < 2; ++ai)
#pragma unroll
            for (int m = 0; m < 4; ++m) {
                const int row = row0 + ai * 128 + m * 16; const float rs = __builtin_amdgcn_rsqf(ss[row] * (1.0f / 1024.0f) + 1e-6f);
                f32x4 c01 = {1.f, 0.f, 1.f, 0.f}, c23 = {1.f, 0.f, 1.f, 0.f};
                if (colt < 1024) { const int pos = row & (SEQ - 1); c01 = tab[(pos * 32 + fb) >> 1]; c23 = tab[((pos * 32 + fb) >> 1) + 1]; }
#pragma unroll
                for (int bj = 0; bj < 2; ++bj) {
                    f32x4 v0 = acc[ai][bj][m][0] * rs, v1 = acc[ai][bj][m][1] * rs;
                    if (colt < 1024) {
                        const float cs[4] = {c01[0], c01[2], c23[0], c23[2]}, sn[4] = {c01[1], c01[3], c23[1], c23[3]};
#pragma unroll
                        for (int j = 0; j < 4; ++j) { const float t1 = v0[j], t2 = v1[j]; v0[j] = t1 * cs[j] - t2 * sn[j]; v1[j] = t2 * cs[j] + t1 * sn[j]; }
                    }
                    u32x4 o; o[0] = pk2(v0[0], v0[1]); o[1] = pk2(v0[2], v0[3]); o[2] = pk2(v1[0], v1[1]); o[3] = pk2(v1[2], v1[3]);
                    *(u32x4*)(O + (size_t)row * AINW + col0 + bj * 128) = o;
                }
            }
    }
};
template <bool RES_F32, bool OUT_F32> struct EpiRes {
    static constexpr bool PERM = false, AFTER_DRAIN = false;
    const float* xres; bf16_t* hb; float* outf; float* ssn;
    DI void operator()(const f32x4 (&acc)[2][2][4][2], const pg8::Unit& u, int wr, int wc, int fr, int fq) const {
        const int row0 = u.pm * 256 + wr * 64 + fr, col0 = u.pn * 256 + wc * 32 + 4 * fq;
#pragma unroll
        for (int ai = 0; ai < 2; ++ai)
#pragma unroll
            for (int m = 0; m < 4; ++m) {
                const int row = row0 + ai * 128 + m * 16; float sq = 0.f;
#pragma unroll
                for (int bj = 0; bj < 2; ++bj)
#pragma unroll
                    for (int n = 0; n < 2; ++n) {
                        const size_t off = (size_t)row * DM + col0 + bj * 128 + n * 16; f32x4 r;
                        if (RES_F32) r = *(const f32x4*)(xres + off);
                        else { const u32x2 t = *(const u32x2*)(hb + off); r[0] = bflo(t[0]); r[1] = bfhi(t[0]); r[2] = bflo(t[1]); r[3] = bfhi(t[1]); }
                        const f32x4 v = r + acc[ai][bj][m][n];
                        sq += v[0] * v[0] + v[1] * v[1] + v[2] * v[2] + v[3] * v[3];
                        if (OUT_F32) *(f32x4*)(outf + off) = v;
                        else { u32x2 o; o[0] = pk2(v[0], v[1]); o[1] = pk2(v[2], v[3]); *(u32x2*)(hb + off) = o; }
                    }
                sq += __shfl_xor(sq, 16); sq += __shfl_xor(sq, 32);
                if (fq == 0) atomicAdd(ssn + row, sq);
            }
    }
};
struct EpiGU {
    static constexpr bool PERM = true, AFTER_DRAIN = false;
    bf16_t* act; const float* ss;
    DI void operator()(const f32x4 (&acc)[2][2][4][2], const pg8::Unit& u, int wr, int wc, int fr, int fq) const {
        const int row0 = u.pm * 256 + wr * 64 + fr, col0 = u.pn * 256 + wc * 32 + 8 * fq;
#pragma unroll
        for (int ai = 0; ai < 2; ++ai)
#pragma unroll
            for (int m = 0; m < 4; ++m) {
                const int row = row0 + ai * 128 + m * 16; const float rs = __builtin_amdgcn_rsqf(ss[row] * (1.0f / 1024.0f) + 1e-6f);
#pragma unroll
                for (int bj = 0; bj < 2; ++bj) {
                    const f32x4 g = acc[ai][bj][m][0] * rs, up = acc[ai][bj][m][1] * rs; float a[4];
#pragma unroll
                    for (int j = 0; j < 4; ++j) a[j] = fsilu(g[j]) * up[j];
                    u32x2 o; o[0] = pk2(a[0], a[1]); o[1] = pk2(a[2], a[3]);
                    *(u32x2*)(act + (size_t)row * DFF + ((col0 + bj * 128) >> 1)) = o;
                }
            }
    }
};
struct EpiSsdIn {
    static constexpr bool PERM = true, AFTER_DRAIN = false;
    bf16_t* z; bf16_t* xbc; float* dt; const float* ss;
    DI void operator()(const f32x4 (&acc)[2][2][4][2], const pg8::Unit& u, int wr, int wc, int fr, int fq) const {
        const int row0 = u.pm * 256 + wr * 64 + fr, col0 = u.pn * 256 + wc * 32 + 8 * fq;
#pragma unroll
        for (int ai = 0; ai < 2; ++ai)
#pragma unroll
            for (int m = 0; m < 4; ++m) {
                const int row = row0 + ai * 128 + m * 16; const float rs = __builtin_amdgcn_rsqf(ss[row] * (1.0f / 1024.0f) + 1e-6f);
#pragma unroll
                for (int bj = 0; bj < 2; ++bj) {
                    const int c = col0 + bj * 128; const f32x4 v0 = acc[ai][bj][m][0] * rs, v1 = acc[ai][bj][m][1] * rs;
                    if (c < 6144) { u32x4 o; o[0] = pk2(v0[0], v0[1]); o[1] = pk2(v0[2], v0[3]); o[2] = pk2(v1[0], v1[1]); o[3] = pk2(v1[2], v1[3]);
                        if (c < DIN) *(u32x4*)(z + (size_t)row * DIN + c) = o; else *(u32x4*)(xbc + (size_t)row * XBCW + (c - DIN)) = o; }
                }
            }
    }
};
constexpr int KST = 144, VST = 320, VST64 = 192;
constexpr int AT_K1 = 0, AT_K2 = 64 * KST, AT_V = 2 * 64 * KST, AT_STAGE = AT_V + 64 * VST;

DI void diff_tile(LAS unsigned char* lds, const bf16_t* proj, bf16_t* mixed, const float* subln, float lam, int b, int hd, int qt) {
    const int tid = otid(), w = __builtin_amdgcn_readfirstlane(tid >> 6), lane = tid & 63, qg = w & 3, mp = w >> 2, r = lane & 31, h = lane >> 5;
    const int q0 = qt * 128; const size_t rowb = (size_t)b * SEQ;
    bf16x8 qf[4];
    { const bf16_t* qp = proj + (rowb + q0 + 32 * qg + r) * AINW + hd * 128 + mp * 64 + 8 * h;
#pragma unroll
      for (int s = 0; s < 4; ++s) qf[s] = *(const bf16x8*)(qp + 16 * s); }
    f32x16 O[4];
#pragma unroll
    for (int i = 0; i < 4; ++i) O[i] = zero16();
    float mrun = 0.f, lrun = 0.f;
    const int nsteps = 2 * (qt + 1);
    const bf16_t* src[4]; int dst[4];
#pragma unroll
    for (int i = 0; i < 2; ++i) { const int cid = tid + 512 * i, row = cid >> 4, c16 = cid & 15;
        src[i] = proj + (rowb + row) * AINW + 512 + hd * 128 + c16 * 8; dst[i] = (c16 < 8 ? AT_K1 : AT_K2) + row * KST + (c16 & 7) * 16;
        src[2 + i] = proj + (rowb + row) * AINW + 1024 + hd * 128 + c16 * 8; dst[2 + i] = AT_V + row * VST + c16 * 16; }
    u32x4 pf[4];
#pragma unroll
    for (int i = 0; i < 4; ++i) pf[i] = *(const u32x4*)(src[i]);
#pragma unroll
    for (int i = 0; i < 4; ++i) *(LAS u32x4*)(lds + dst[i]) = pf[i];
    __syncthreads();
    const int i16 = lane & 15, tq = i16 >> 2, tp = i16 & 3, g16 = (lane >> 4) & 1;
    const int troff = (4 * h + tq) * VST + (16 * g16 + 4 * tp) * 2;
    for (int j = 0; j < nsteps; ++j) {
        const bool more = (j + 1 < nsteps);
        if (more) {
#pragma unroll
            for (int i = 0; i < 4; ++i) pf[i] = *(const u32x4*)(src[i] + (size_t)(j + 1) * 64 * AINW);
        }
        const LAS unsigned char* base = lds + (j & 1) * AT_STAGE;
        const LAS unsigned char* Kb = base + (mp ? AT_K2 : AT_K1);
        const LAS unsigned char* Vb = base + AT_V;
        f32x16 S[2];
        const float negm = -mrun;
#pragma unroll
        for (int kt = 0; kt < 2; ++kt) {
#pragma unroll
            for (int i = 0; i < 16; ++i) S[kt][i] = negm;
#pragma unroll
            for (int s = 0; s < 4; ++s) { const bf16x8 kf = *(const LAS bf16x8*)(Kb + (32 * kt + r) * KST + (16 * s + 8 * h) * 2); S[kt] = MFMA32(kf, qf[s], S[kt]); } }
        const int qidx = q0 + 32 * qg + r, kbase = 64 * j;
        if (kbase + 63 > q0 + 32 * qg) {
#pragma unroll
            for (int kt = 0; kt < 2; ++kt)
#pragma unroll
                for (int i = 0; i < 16; ++i) if (kbase + 32 * kt + crow(i, h) > qidx) S[kt][i] = -1e30f;
        }
        float mx = S[0][0];
#pragma unroll
        for (int kt = 0; kt < 2; ++kt)
#pragma unroll
            for (int i = 0; i < 16; ++i) mx = fmaxf(mx, S[kt][i]);
        mx = fmaxf(mx, __shfl_xor(mx, 32));
        if (j == 0 || __builtin_amdgcn_ballot_w64(mx > 8.0f) != 0ull) {
            const float d = (j == 0) ? mx : fmaxf(mx, 0.f);
            mrun += d;
            if (j != 0) { const float alpha = fexp2(-d); lrun *= alpha;
#pragma unroll
                for (int vt = 0; vt < 4; ++vt) O[vt] = O[vt] * alpha; }
#pragma unroll
            for (int kt = 0; kt < 2; ++kt)
#pragma unroll
                for (int i = 0; i < 16; ++i) S[kt][i] -= d;
        }
        float ls = 0.f;
#pragma unroll
        for (int kt = 0; kt < 2; ++kt)
#pragma unroll
            for (int i = 0; i < 16; ++i) { const float pv = fexp2(S[kt][i]); S[kt][i] = pv; ls += pv; }
        lrun += ls;
#pragma unroll
        for (int kt = 0; kt < 2; ++kt)
#pragma unroll
            for (int s2 = 0; s2 < 2; ++s2) {
                const bf16x8 pfr = pack8(S[kt], s2);
                const LAS unsigned char* vrow = Vb + (32 * kt + 16 * s2) * VST + troff;
#pragma unroll
                for (int vt = 0; vt < 4; ++vt) { const bf16x8 vf = tr2(vrow + vt * 64, vrow + 8 * VST + vt * 64); O[vt] = MFMA32(vf, pfr, O[vt]); }
            }
        if (more) {
            LAS unsigned char* nb = lds + ((j + 1) & 1) * AT_STAGE;
#pragma unroll
            for (int i = 0; i < 4; ++i) *(LAS u32x4*)(nb + dst[i]) = pf[i];
        }
        __syncthreads();
    }
    lrun += __shfl_xor(lrun, 32);
    const float inv = frcp(lrun);
    LAS float* ex = (LAS float*)lds;
    if (mp == 1) {
        const float sc = inv * lam;
#pragma unroll
        for (int vt = 0; vt < 4; ++vt)
#pragma unroll
            for (int i = 0; i < 16; ++i) ex[(qg * 128 + 32 * vt + crow(i, h)) * 32 + r] = O[vt][i] * sc;
    }
    __syncthreads();
    if (mp == 0) {
        float sq = 0.f;
#pragma unroll
        for (int vt = 0; vt < 4; ++vt)
#pragma unroll
            for (int i = 0; i < 16; ++i) { const float o = O[vt][i] * inv - ex[(qg * 128 + 32 * vt + crow(i, h)) * 32 + r]; O[vt][i] = o; sq += o * o; }
        sq += __shfl_xor(sq, 32);
        const float rn = __builtin_amdgcn_rsqf(sq * (1.0f / 128.0f) + 1e-5f) * 0.8f;
        bf16_t* op = mixed + (rowb + q0 + 32 * qg + r) * DM + hd * 128;
#pragma unroll
        for (int vt = 0; vt < 4; ++vt)
#pragma unroll
            for (int gq = 0; gq < 4; ++gq) { const int v0 = 32 * vt + 8 * gq + 4 * h; const f32x4 wv = *(const f32x4*)(subln + v0);
                u32x2 o; o[0] = pk2(O[vt][4 * gq] * rn * wv[0], O[vt][4 * gq + 1] * rn * wv[1]); o[1] = pk2(O[vt][4 * gq + 2] * rn * wv[2], O[vt][4 * gq + 3] * rn * wv[3]);
                *(u32x2*)(op + v0) = o; }
    }
    __syncthreads();
}

constexpr int SB_K = 0, SB_V = 64 * KST, SB_STAGE = 64 * KST + 64 * VST64;
DI void sb_block(LAS unsigned char* lds, const bf16_t* proj, bf16_t* mixed, int b, int hs, int qb) {
    const int tid = otid(), w = __builtin_amdgcn_readfirstlane(tid >> 6), lane = tid & 63, r = lane & 31, h = lane >> 5;
    const int q0 = qb * 256; const size_t rowb = (size_t)b * SEQ;
    const int qidx = q0 + 32 * w + r;
    bf16x8 qf[4];
    { const bf16_t* qp = proj + (rowb + qidx) * AINW + 1536 + hs * 64 + 8 * h;
#pragma unroll
      for (int s = 0; s < 4; ++s) qf[s] = *(const bf16x8*)(qp + 16 * s); }
    f32x16 O[2]; O[0] = zero16(); O[1] = zero16();
    float carry = 1.0f;
    const int jmax = 4 * qb + 3;
    const int srow = tid >> 3, sc8 = tid & 7;
    const bf16_t* srcK = proj + (rowb + srow) * AINW + 2048 + hs * 64 + sc8 * 8;
    const bf16_t* srcV = proj + (rowb + srow) * AINW + 2560 + hs * 64 + sc8 * 8;
    const int dstK = SB_K + srow * KST + sc8 * 16, dstV = SB_V + srow * VST64 + sc8 * 16;
    u32x4 pk_ = *(const u32x4*)(srcK + (size_t)jmax * 64 * AINW), pv_ = *(const u32x4*)(srcV + (size_t)jmax * 64 * AINW);
    *(LAS u32x4*)(lds + dstK) = pk_; *(LAS u32x4*)(lds + dstV) = pv_;
    __syncthreads();
    const int i16 = lane & 15, tq = i16 >> 2, tp = i16 & 3, g16 = (lane >> 4) & 1;
    const int troff = (4 * h + tq) * VST64 + (16 * g16 + 4 * tp) * 2;
    int it = 0;
    for (int j = jmax; j >= 0; --j, ++it) {
        const bool more = (j > 0);
        if (more) { pk_ = *(const u32x4*)(srcK + (size_t)(j - 1) * 64 * AINW); pv_ = *(const u32x4*)(srcV + (size_t)(j - 1) * 64 * AINW); }
        const LAS unsigned char* base = lds + (it & 1) * SB_STAGE;
        const int kbase = 64 * j;
        if (kbase < q0 + 32 * w + 32) {
#pragma unroll
            for (int kt = 1; kt >= 0; --kt) {
                f32x16 S = zero16();
#pragma unroll
                for (int s = 0; s < 4; ++s) { const bf16x8 kf = *(const LAS bf16x8*)(base + SB_K + (32 * kt + r) * KST + (16 * s + 8 * h) * 2); S = MFMA32(kf, qf[s], S); }
                float T[4], sfx[16];
#pragma unroll
                for (int gq = 0; gq < 4; ++gq) {
                    float run = 1.0f;
#pragma unroll
                    for (int jj = 3; jj >= 0; --jj) {
                        const int i = 4 * gq + jj; const bool valid = (kbase + 32 * kt + crow(i, h)) < qidx;
                        const float zz = fmaxf(S[i], -60.0f); const float e = fexp2(-LOG2E * zz); const float sg = frcp(1.0f + e);
                        const float keep = valid ? e * sg : 1.0f;
                        S[i] = valid ? sg : 0.0f; sfx[i] = run; run *= keep;
                    }
                    T[gq] = run;
                }
                float To[4];
#pragma unroll
                for (int gq = 0; gq < 4; ++gq) To[gq] = __shfl_xor(T[gq], 32);
                float E[4]; float acc_hi = 1.0f;
#pragma unroll
                for (int gq = 3; gq >= 0; --gq) {
                    const float above_same = acc_hi;
                    E[gq] = (h == 0) ? above_same * To[gq] : above_same;
                    acc_hi = acc_hi * T[gq] * To[gq];
                }
#pragma unroll
                for (int i = 0; i < 16; ++i) S[i] = S[i] * carry * E[i >> 2] * sfx[i];
                carry *= acc_hi;
#pragma unroll
                for (int s2 = 0; s2 < 2; ++s2) {
                    const bf16x8 pfr = pack8(S, s2);
                    const LAS unsigned char* vrow = base + SB_V + (32 * kt + 16 * s2) * VST64 + troff;
#pragma unroll
                    for (int vt = 0; vt < 2; ++vt) { const bf16x8 vf = tr2(vrow + vt * 64, vrow + 8 * VST64 + vt * 64); O[vt] = MFMA32(vf, pfr, O[vt]); }
                }
            }
        }
        if (more) { LAS unsigned char* nb = lds + ((it + 1) & 1) * SB_STAGE; *(LAS u32x4*)(nb + dstK) = pk_; *(LAS u32x4*)(nb + dstV) = pv_; }
        const int done = (kbase < q0 + 32 * w + 32) && (carry < 1e-12f);
        const bool wdone = (__builtin_amdgcn_ballot_w64(done != 0) == ~0ull);
        LAS int* flg = (LAS int*)(lds + 2 * SB_STAGE) + (it & 1) * 8;
        if (lane == 0) flg[w] = wdone ? 1 : 0;
        __syncthreads();
        int all = 1;
#pragma unroll
        for (int ww = 0; ww < 8; ++ww) all &= flg[ww];
        if (all) break;
    }
    bf16_t* op = mixed + (rowb + qidx) * DM + 512 + hs * 64;
#pragma unroll
    for (int vt = 0; vt < 2; ++vt)
#pragma unroll
        for (int gq = 0; gq < 4; ++gq) { const int v0 = 32 * vt + 8 * gq + 4 * h;
            u32x2 o; o[0] = pk2(O[vt][4 * gq], O[vt][4 * gq + 1]); o[1] = pk2(O[vt][4 * gq + 2], O[vt][4 * gq + 3]); *(u32x2*)(op + v0) = o; }
    __syncthreads();
}
DI void attn_phase(LAS unsigned char* lds, const Params& p) {
    const bf16_t* proj = (const bf16_t*)(p.ws + O_PROJ); bf16_t* mixed = (bf16_t*)(p.ws + O_MIXED);
    const float lam = *(const float*)(p.ws + O_LAM);
    for (int it0 = blockIdx.x; it0 < 256; it0 += gridDim.x) {
        const int it = (it0 & 7) * 32 + (it0 >> 3);
        const int b = it >> 7, hd = (it >> 5) & 3, pr = it & 31;
        diff_tile(lds, proj, mixed, p.in[7], lam, b, hd, 63 - pr);
        diff_tile(lds, proj, mixed, p.in[7], lam, b, hd, pr);
    }
    for (int it0 = blockIdx.x; it0 < 512; it0 += gridDim.x) {
        const int it = (it0 & 7) * 64 + (it0 >> 3);
        const int b = it >> 8, hs = (it >> 5) & 7, qb = it & 31;
        sb_block(lds, proj, mixed, b, hs, qb);
    }
}
constexpr int SXS = 528, SXS2 = 576, SBS = 272, SBS2 = 320;
constexpr int L_SX = 0, L_SB = 128 * SXS2, L_SC = L_SB + 128 * SBS, L_SDT = L_SC + 128 * SBS, L_SAC = L_SDT + 2048, L_SSQ = L_SAC + 2048;
static_assert(L_SSQ + 4096 <= LDS_BYTES, "lds");

DI void ssd_dt_acum(LAS unsigned char* lds, const float* DT, const float* dt_bias, const float* a_log, size_t t0, int g) {
    LAS float* sdt = (LAS float*)(lds + L_SDT); LAS float* sac = (LAS float*)(lds + L_SAC);
    const int tid = otid(), hh = tid >> 7, l = tid & 127, head = 4 * g + hh, w = tid >> 6, lane = tid & 63;
    const float raw = DT[(t0 + l) * 32 + head] + dt_bias[head];
    const float dt = fmaxf(raw, 0.f) + __logf(1.0f + __expf(-fabsf(raw)));
    sdt[hh * 128 + l] = dt; sac[hh * 128 + l] = -dt * __expf(a_log[head]);
    __syncthreads();
    if (w < 4) {
        const float v0 = sac[w * 128 + 2 * lane], v1 = sac[w * 128 + 2 * lane + 1]; float s = v0 + v1;
#pragma unroll
        for (int off = 1; off < 64; off <<= 1) { const float t = __shfl_up(s, off); if (lane >= off) s += t; }
        const float ex = s - (v0 + v1);
        sac[w * 128 + 2 * lane] = ex + v0; sac[w * 128 + 2 * lane + 1] = ex + v0 + v1;
    }
    __syncthreads();
}
template <int NT, class F> DI void conv_strip(const bf16_t* src, int nzero, const float* cw, const float* cb, int ch, F&& emit) {
    f32x4 wlo[4], whi[4];
#pragma unroll
    for (int k = 0; k < 4; ++k) { wlo[k] = *(const f32x4*)(cw + k * XBCW + ch); whi[k] = *(const f32x4*)(cw + k * XBCW + ch + 4); }
    const f32x4 blo = *(const f32x4*)(cb + ch), bhi = *(const f32x4*)(cb + ch + 4);
    u32x4 raw[NT + 3];
#pragma unroll
    for (int i = 0; i < NT + 3; ++i) { const int ii = (i < nzero) ? nzero : i; raw[i] = *(const u32x4*)(src + (ptrdiff_t)(ii - 3) * XBCW); if (i < nzero) raw[i] = (u32x4){0u, 0u, 0u, 0u}; }
#pragma unroll
    for (int t = 0; t < NT; ++t) {
        float o[8];
#pragma unroll
        for (int e = 0; e < 8; ++e) {
            float a = (e < 4) ? blo[e & 3] : bhi[e & 3];
#pragma unroll
            for (int k = 0; k < 4; ++k) { const unsigned d = raw[t + k][e >> 1]; const float xv = (e & 1) ? bfhi(d) : bflo(d); a += ((e < 4) ? wlo[k][e & 3] : whi[k][e & 3]) * xv; }
            o[e] = fsilu(a);
        }
        emit(t, o);
    }
}
DI u32x4 pack8f(const float* o) { u32x4 r; r[0] = pk2(o[0], o[1]); r[1] = pk2(o[2], o[3]); r[2] = pk2(o[4], o[5]); r[3] = pk2(o[6], o[7]); return r; }

template <bool XW, bool WITH_C> DI void ssd_stage(LAS unsigned char* lds, const bf16_t* xbc, const float* cw, const float* cb, size_t t0, int c, int g) {
    const int tid = otid();
    LAS float* sdt = (LAS float*)(lds + L_SDT); LAS float* sac = (LAS float*)(lds + L_SAC);
    {
        const int c8 = tid & 31, tg = tid >> 5, l0 = 8 * tg, ch = 256 * g + 8 * c8, hh = c8 >> 3;
        const int nzero = (c == 0) ? (3 - l0 > 0 ? 3 - l0 : 0) : 0;
        const float alast = sac[hh * 128 + 127];
        conv_strip<8>(xbc + (t0 + l0) * XBCW + ch, nzero, cw, cb, ch, [&](int t, float* o) {
            if (XW) { const float wgt = sdt[hh * 128 + l0 + t] * __expf(alast - sac[hh * 128 + l0 + t]);
#pragma unroll
                for (int e = 0; e < 8; ++e) o[e] *= wgt; }
            *(LAS u32x4*)(lds + L_SX + (l0 + t) * (XW ? SXS2 : SXS) + c8 * 16) = pack8f(o); });
    }
    {
        const int c8 = tid & 15, tg = tid >> 4, l0 = 4 * tg;
        const int nzero = (c == 0) ? (3 - l0 > 0 ? 3 - l0 : 0) : 0;
        const int chb = DIN + 128 * g + 8 * c8;
        conv_strip<4>(xbc + (t0 + l0) * XBCW + chb, nzero, cw, cb, chb, [&](int t, float* o) { *(LAS u32x4*)(lds + L_SB + (l0 + t) * (XW ? SBS2 : SBS) + c8 * 16) = pack8f(o); });
        if (WITH_C) { const int chc = DIN + 1024 + 128 * g + 8 * c8;
            conv_strip<4>(xbc + (t0 + l0) * XBCW + chc, nzero, cw, cb, chc, [&](int t, float* o) { *(LAS u32x4*)(lds + L_SC + (l0 + t) * SBS + c8 * 16) = pack8f(o); }); }
    }
}
DI bf16_t* st_ptr(unsigned char* ws, int b) { return (bf16_t*)(ws + (b ? O_ST1 : O_ST0)); }

DI void ssd_states_phase(LAS unsigned char* lds, const Params& p) {
    const int tid = otid(), w = __builtin_amdgcn_readfirstlane(tid >> 6), lane = tid & 63, r = lane & 31, h = lane >> 5, hh = w >> 1, ph = w & 1;
    const bf16_t* xbc = (const bf16_t*)(p.ws + O_XBC); const float* DT = (const float*)(p.ws + O_DT); float* cdec = (float*)(p.ws + O_CDEC);
    const int i16 = lane & 15, tq = i16 >> 2, tp = i16 & 3, g16 = (lane >> 4) & 1;
    for (int it = blockIdx.x; it < 1024; it += gridDim.x) {
        const int b = it >> 9, c = (it >> 3) & 63, g = it & 7; const size_t t0 = (size_t)b * SEQ + (size_t)c * 128;
        ssd_dt_acum(lds, DT, p.in[13], p.in[14], t0, g);
        ssd_stage<true, false>(lds, xbc, p.in[11], p.in[12], t0, c, g);
        __syncthreads();
        f32x16 acc[4];
#pragma unroll
        for (int i = 0; i < 4; ++i) acc[i] = zero16();
        const LAS unsigned char* xa = lds + L_SX + (8 * h + tq) * SXS2 + (64 * hh + 32 * ph + 16 * g16 + 4 * tp) * 2;
        const LAS unsigned char* ba = lds + L_SB + (8 * h + tq) * SBS2 + (16 * g16 + 4 * tp) * 2;
#pragma unroll
        for (int s = 0; s < 8; ++s) {
            const bf16x8 af = tr2(xa + 16 * s * SXS2, xa + (16 * s + 4) * SXS2);
#pragma unroll
            for (int nt = 0; nt < 4; ++nt) { const bf16x8 bfr = tr2(ba + 16 * s * SBS2 + nt * 64, ba + (16 * s + 4) * SBS2 + nt * 64); acc[nt] = MFMA32(af, bfr, acc[nt]); }
        }
        bf16_t* st = st_ptr(p.ws, b) + ((size_t)(c * 32 + 4 * g + hh) * 64 + 32 * ph) * 128;
#pragma unroll
        for (int nt = 0; nt < 4; ++nt)
#pragma unroll
            for (int i = 0; i < 16; ++i) st[(size_t)crow(i, h) * 128 + 32 * nt + r] = (bf16_t)(pk2(acc[nt][i], 0.f) & 0xffffu);
        if (tid < 4) cdec[(b * 64 + c) * 32 + 4 * g + tid] = __expf(((LAS float*)(lds + L_SAC))[tid * 128 + 127]);
        __syncthreads();
    }
}
DI void ssd_scan_phase(const Params& p, const bool dry) {
    const float* cdec = (const float*)(p.ws + O_CDEC);
    for (int e = blockIdx.x * 512 + threadIdx.x; e < 2 * 32 * 64 * 32; e += gridDim.x * 512) {
        const int b = e >> 16, rem = e & 65535, head = rem >> 11;
        bf16_t* st = st_ptr(p.ws, b) + (size_t)rem * 4;
        float carry[4] = {0.f, 0.f, 0.f, 0.f};
        for (int c0 = 0; c0 < 64; c0 += 8) {
            u32x2 v[8]; float dc[8];
#pragma unroll
            for (int u = 0; u < 8; ++u) { v[u] = *(const u32x2*)(st + (size_t)(c0 + u) * 262144); dc[u] = cdec[(b * 64 + c0 + u) * 32 + head]; }
#pragma unroll
            for (int u = 0; u < 8; ++u) {
                u32x2 o; o[0] = pk2(carry[0], carry[1]); o[1] = pk2(carry[2], carry[3]); if (!dry) *(u32x2*)(st + (size_t)(c0 + u) * 262144) = o;
                carry[0] = carry[0] * dc[u] + bflo(v[u][0]); carry[1] = carry[1] * dc[u] + bfhi(v[u][0]); carry[2] = carry[2] * dc[u] + bflo(v[u][1]); carry[3] = carry[3] * dc[u] + bfhi(v[u][1]);
            }
        }
    }
}
DI void ssd_out_phase(LAS unsigned char* lds, const Params& p, const bool dry) {
    const int tid = otid(), w = __builtin_amdgcn_readfirstlane(tid >> 6), lane = tid & 63, r = lane & 31, h = lane >> 5, hh = w >> 1, ph = w & 1;
    const bf16_t* xbc = (const bf16_t*)(p.ws + O_XBC); const float* DT = (const float*)(p.ws + O_DT); bf16_t* zy = (bf16_t*)p.out;
    LAS float* sdt = (LAS float*)(lds + L_SDT); LAS float* sac = (LAS float*)(lds + L_SAC); LAS float* ssq = (LAS float*)(lds + L_SSQ);
    const int i16 = lane & 15, tq = i16 >> 2, tp = i16 & 3, g16 = (lane >> 4) & 1;
    for (int it = blockIdx.x; it < 1024; it += gridDim.x) {
        const int b = it >> 9, c = (it >> 3) & 63, g = it & 7, head = 4 * g + hh; const size_t t0 = (size_t)b * SEQ + (size_t)c * 128;
        ssd_dt_acum(lds, DT, p.in[13], p.in[14], t0, g);
        ssd_stage<false, true>(lds, xbc, p.in[11], p.in[12], t0, c, g);
        bf16x8 pvf[8];
        { const bf16_t* pp = st_ptr(p.ws, b) + ((size_t)(c * 32 + head) * 64 + 32 * ph + r) * 128 + 8 * h;
#pragma unroll
          for (int s = 0; s < 8; ++s) pvf[s] = *(const bf16x8*)(pp + 16 * s); }
        __syncthreads();
        f32x16 Y[4];
        const LAS unsigned char* xa = lds + L_SX + (4 * h + tq) * SXS + (64 * hh + 32 * ph + 16 * g16 + 4 * tp) * 2;
#pragma unroll
        for (int lt = 0; lt < 4; ++lt) {
            __builtin_amdgcn_sched_barrier(0);
            f32x16 y = zero16();
#pragma unroll
            for (int s = 0; s < 8; ++s) { const bf16x8 cfs = *(const LAS bf16x8*)(lds + L_SC + (32 * lt + r) * SBS + (16 * s + 8 * h) * 2); y = MFMA32(pvf[s], cfs, y); }
            Y[lt] = y * __expf(sac[hh * 128 + 32 * lt + r]);
        }
#pragma unroll
        for (int lt = 0; lt < 4; ++lt) {
            __builtin_amdgcn_sched_barrier(0);
            bf16x8 cf[8];
#pragma unroll
            for (int s = 0; s < 8; ++s) cf[s] = *(const LAS bf16x8*)(lds + L_SC + (32 * lt + r) * SBS + (16 * s + 8 * h) * 2);
            const float al = sac[hh * 128 + 32 * lt + r];
#pragma unroll
            for (int mt = 0; mt < 4; ++mt) {
                if (mt <= lt) {
                    __builtin_amdgcn_sched_barrier(0);
                    f32x16 X = zero16();
#pragma unroll
                    for (int s = 0; s < 8; ++s) { const bf16x8 bfr = *(const LAS bf16x8*)(lds + L_SB + (32 * mt + r) * SBS + (16 * s + 8 * h) * 2); X = MFMA32(bfr, cf[s], X); }
#pragma unroll
                    for (int gq = 0; gq < 4; ++gq) {
                        const f32x4 am = *(const LAS f32x4*)(sac + hh * 128 + 32 * mt + 8 * gq + 4 * h), dm = *(const LAS f32x4*)(sdt + hh * 128 + 32 * mt + 8 * gq + 4 * h);
#pragma unroll
                        for (int jj = 0; jj < 4; ++jj) { const int mrow = 32 * mt + 8 * gq + 4 * h + jj; const bool ok = (32 * lt + r) >= mrow;
                            const float dec = ok ? __expf(fminf(al - am[jj], 0.f)) * dm[jj] : 0.f; X[4 * gq + jj] *= dec; }
                    }
#pragma unroll
                    for (int s2 = 0; s2 < 2; ++s2) { const bf16x8 xs = pack8(X, s2);
                        const LAS unsigned char* xr = xa + (32 * mt + 16 * s2) * SXS; const bf16x8 xf = tr2(xr, xr + 8 * SXS); Y[lt] = MFMA32(xf, xs, Y[lt]); }
                }
            }
        }
        __builtin_amdgcn_sched_barrier(0);
        const float Dh = p.in[15][head];
        float sq[4];
#pragma unroll
        for (int lt = 0; lt < 4; ++lt) {
            const int l = 32 * lt + r; sq[lt] = 0.f;
#pragma unroll
            for (int gq = 0; gq < 4; ++gq) {
                const int chl = 64 * hh + 32 * ph + 8 * gq + 4 * h;
                const u32x2 xv = *(const LAS u32x2*)(lds + L_SX + l * SXS + chl * 2);
                const u32x2 zv = *(const u32x2*)(zy + (t0 + l) * DIN + 256 * g + chl);
                const float xf4[4] = {bflo(xv[0]), bfhi(xv[0]), bflo(xv[1]), bfhi(xv[1])}, zf4[4] = {bflo(zv[0]), bfhi(zv[0]), bflo(zv[1]), bfhi(zv[1])};
#pragma unroll
                for (int jj = 0; jj < 4; ++jj) { const float yv = (Y[lt][4 * gq + jj] + Dh * xf4[jj]) * fsilu(zf4[jj]); Y[lt][4 * gq + jj] = yv; sq[lt] += yv * yv; }
            }
            sq[lt] += __shfl_xor(sq[lt], 32);
            if (h == 0) ssq[w * 128 + l] = sq[lt];
        }
        __syncthreads();
#pragma unroll
        for (int lt = 0; lt < 4; ++lt) {
            const int l = 32 * lt + r; float tot = 0.f;
#pragma unroll
            for (int ww = 0; ww < 8; ++ww) tot += ssq[ww * 128 + l];
            const float rn = __builtin_amdgcn_rsqf(tot * (1.0f / 256.0f) + 1e-5f);
#pragma unroll
            for (int gq = 0; gq < 4; ++gq) {
                const int chl = 64 * hh + 32 * ph + 8 * gq + 4 * h; const f32x4 gw = *(const f32x4*)(p.in[16] + 256 * g + chl);
                u32x2 o; o[0] = pk2(Y[lt][4 * gq] * rn * gw[0], Y[lt][4 * gq + 1] * rn * gw[1]); o[1] = pk2(Y[lt][4 * gq + 2] * rn * gw[2], Y[lt][4 * gq + 3] * rn * gw[3]);
                if (!dry) *(u32x2*)(zy + (t0 + l) * DIN + 256 * g + chl) = o;
            }
        }
        __syncthreads();
    }
}
DI void dt_proj(LAS unsigned char* lds, const Params& p) {
    const int tid = otid(), w = __builtin_amdgcn_readfirstlane(tid >> 6), lane = tid & 63, r = lane & 31, h = lane >> 5, rt = w & 1, kq = w >> 1;
    const bf16_t* hb = (const bf16_t*)(p.ws + O_HB); const bf16_t* wt = (const bf16_t*)(p.ws + W_SIN) + (size_t)6144 * DM;
    const float* ss = (const float*)(p.ws + O_SS) + 2 * MT; float* dt = (float*)(p.ws + O_DT);
    LAS float* part = (LAS float*)lds;
    for (int rb = blockIdx.x; rb < MT / 64; rb += gridDim.x) {
        const bf16_t* ap = hb + (size_t)(rb * 64 + rt * 32 + r) * DM + kq * 256 + 8 * h;
        const bf16_t* bp = wt + (size_t)r * DM + kq * 256 + 8 * h;
        bf16x8 af[16], bfr[16];
#pragma unroll
        for (int s = 0; s < 16; ++s) { af[s] = *(const bf16x8*)(ap + 16 * s); bfr[s] = *(const bf16x8*)(bp + 16 * s); }
        f32x16 acc = zero16();
#pragma unroll
        for (int s = 0; s < 16; ++s) acc = MFMA32(af[s], bfr[s], acc);
#pragma unroll
        for (int i = 0; i < 16; ++i) part[((kq * 2 + rt) * 32 + crow(i, h)) * 32 + r] = acc[i];
        __syncthreads();
#pragma unroll
        for (int q = 0; q < 4; ++q) {
            const int o = tid + 512 * q, row = o >> 5, col = o & 31;
            float v = 0.f;
#pragma unroll
            for (int k = 0; k < 4; ++k) v += part[((k * 2 + (row >> 5)) * 32 + (row & 31)) * 32 + col];
            const int grow = rb * 64 + row;
            dt[(size_t)grow * 32 + col] = v * __builtin_amdgcn_rsqf(ss[grow] * (1.0f / 1024.0f) + 1e-6f);
        }
        __syncthreads();
    }
}
template <class Epi> DI void run_gemm(LAS unsigned char* lds, const bf16_t* A, const bf16_t* Bt, int N, int K, const Epi& E) {
    pg8::Gemm g; g.A = A; g.Bt = Bt; g.M = MT; g.N = N; g.K = K;
    pg8::StaticOrder S; S.init(MT, N, (int)gridDim.x, (int)blockIdx.x);
    pg8::gemm_phase<Epi, pg8::StaticOrder, false>((PG8_LAS unsigned char*)lds, g, S, E, nullptr);
}
#if defined(DRY_S3) || defined(DRY_S4)
#define DRYV (p.ws == nullptr)
#else
#define DRYV false
#endif
__global__ void __launch_bounds__(512, 2) fwd_megakernel(Params p) {
    extern __shared__ __attribute__((aligned(16))) unsigned char shm[];
    LAS unsigned char* lds = (LAS unsigned char*)shm;
    cg::grid_group grid = cg::this_grid();
    if (threadIdx.x < 4) ((LAS unsigned*)(lds + LDS_BYTES - 16))[threadIdx.x] = 0u;
    __syncthreads();
    const XcdBarrier xbar = xcd_barrier_post((unsigned*)(p.ws + O_BAR), (volatile LAS unsigned*)(lds + LDS_BYTES - 16));
#define GBAR() xcd_barrier(xbar)
    unsigned char* ws = p.ws;
    bf16_t* hb = (bf16_t*)(ws + O_HB); float* ss = (float*)(ws + O_SS);
    phase0(lds, p);
#ifdef DUP_P0
    GBAR(); phase0(lds, p);
#endif
    if (gridDim.x == 0x7fffffffu) grid.sync();
    GBAR();
    { EpiAttnIn E; E.O = (bf16_t*)(ws + O_PROJ); E.ss = ss; E.tab = (const f32x4*)(ws + O_ROPE); run_gemm(lds, hb, (const bf16_t*)(ws + W_AIN), AINW, DM, E); }
    GBAR();
    attn_phase(lds, p);
#ifdef DUP_ATTN
    GBAR(); attn_phase(lds, p);
#endif
    GBAR();
    { EpiRes<true, false> E; E.xres = p.in[0]; E.hb = hb; E.outf = nullptr; E.ssn = ss + MT; run_gemm(lds, (const bf16_t*)(ws + O_MIXED), (const bf16_t*)(ws + W_AOUT), DM, DM, E); }
    GBAR();
    { EpiGU E; E.act = (bf16_t*)(ws + O_ACT); E.ss = ss + MT; run_gemm(lds, hb, (const bf16_t*)(ws + W_GU0), 2 * DFF, DM, E); }
    GBAR();
    { EpiRes<false, false> E; E.xres = nullptr; E.hb = hb; E.outf = nullptr; E.ssn = ss + 2 * MT; run_gemm(lds, (const bf16_t*)(ws + O_ACT), (const bf16_t*)(ws + W_DN0), DM, DFF, E); }
    GBAR();
    { EpiSsdIn E; E.z = (bf16_t*)p.out; E.xbc = (bf16_t*)(ws + O_XBC); E.dt = (float*)(ws + O_DT); E.ss = ss + 2 * MT; dt_proj(lds, p); run_gemm(lds, hb, (const bf16_t*)(ws + W_SIN), 6144, DM, E); }
    GBAR();
    ssd_states_phase(lds, p);
#ifdef DUP_S2
    GBAR(); ssd_states_phase(lds, p);
#endif
    GBAR();
#ifdef DRY_S3
    ssd_scan_phase(p, p.ws != nullptr); GBAR();
#endif
    ssd_scan_phase(p, DRYV);
    GBAR();
#ifdef DRY_S4
    ssd_out_phase(lds, p, p.ws != nullptr); GBAR();
#endif
    ssd_out_phase(lds, p, DRYV);
    GBAR();
    { EpiRes<false, false> E; E.xres = nullptr; E.hb = hb; E.outf = nullptr; E.ssn = ss + 3 * MT; run_gemm(lds, (const bf16_t*)p.out, (const bf16_t*)(ws + W_SOUT), DM, DIN, E); }
    GBAR();
    { EpiGU E; E.act = (bf16_t*)(ws + O_ACT); E.ss = ss + 3 * MT; run_gemm(lds, hb, (const bf16_t*)(ws + W_GU1), 2 * DFF, DM, E); }
    GBAR();
    { EpiRes<false, true> E; E.xres = nullptr; E.hb = hb; E.outf = p.out; E.ssn = ss + 4 * MT; run_gemm(lds, (const bf16_t*)(ws + O_ACT), (const bf16_t*)(ws + W_DN1), DM, DFF, E); }
    GBAR();
    {
        const float* ss4 = ss + 4 * MT; const f32x4* fw = (const f32x4*)p.in[22]; f32x4* o4 = (f32x4*)p.out;
        for (int i = blockIdx.x * 512 + threadIdx.x; i < MT * (DM / 4); i += gridDim.x * 512) {
            const int row = i >> 8; const float rs = __builtin_amdgcn_rsqf(ss4[row] * (1.0f / 1024.0f) + 1e-6f);
            o4[i] = o4[i] * rs * fw[i & 255];
        }
    }
}

extern "C" void kernel_launch(void* const* d_in, const int* in_sizes, int n_in, void* d_out, int out_size, void* d_ws, size_t ws_size, hipStream_t stream) {
    static int grid_blocks = 0;
    if (!grid_blocks) {
        int dev = 0, cus = 0, per_cu = 0;
        hipGetDevice(&dev);
        hipDeviceGetAttribute(&cus, hipDeviceAttributeMultiprocessorCount, dev);
        if (hipFuncSetAttribute((const void*)fwd_megakernel, hipFuncAttributeMaxDynamicSharedMemorySize, LDS_BYTES) != hipSuccess) fprintf(stderr, "hipFuncSetAttribute failed\n");
        if (hipOccupancyMaxActiveBlocksPerMultiprocessor(&per_cu, (const void*)fwd_megakernel, 512, LDS_BYTES) != hipSuccess || per_cu < 1) { fprintf(stderr, "occupancy query: %d\n", per_cu); per_cu = 1; }
        (void)hipGetLastError();
        grid_blocks = cus * per_cu;
        if (ws_size < 268435456ull || n_in != 23) fprintf(stderr, "unexpected ws_size %zu / n_in %d\n", ws_size, n_in);
    }
    if (hipMemsetAsync((char*)d_ws + O_BAR, 0, XCD_BAR_WORDS * 4, stream) != hipSuccess) fprintf(stderr, "memset failed\n");
    Params p{};
    for (int i = 0; i < 23; ++i) p.in[i] = (const float*)d_in[i];
    p.out = (float*)d_out; p.ws = (unsigned char*)d_ws;
    void* args[] = {&p};
    hipError_t e = hipLaunchCooperativeKernel((const void*)fwd_megakernel, dim3(grid_blocks), dim3(512), args, LDS_BYTES, stream);
    if (e != hipSuccess) fprintf(stderr, "cooperative launch failed: %s (grid %d)\n", hipGetErrorString(e), grid_blocks);
}
#ifdef PHASE_TEST
__global__ void __launch_bounds__(512, 2) t_phase0(Params p) { extern __shared__ __attribute__((aligned(16))) unsigned char shm[]; phase0((LAS unsigned char*)shm, p); }
__global__ void __launch_bounds__(512, 2) t_attn_diff(Params p) { extern __shared__ __attribute__((aligned(16))) unsigned char shm[]; diff_tile((LAS unsigned char*)shm, (const bf16_t*)(p.ws + O_PROJ), (bf16_t*)(p.ws + O_MIXED), p.in[7], 0.3f, blockIdx.x & 1, blockIdx.y, blockIdx.z); }
__global__ void __launch_bounds__(512, 2) t_attn_sb(Params p) { extern __shared__ __attribute__((aligned(16))) unsigned char shm[]; sb_block((LAS unsigned char*)shm, (const bf16_t*)(p.ws + O_PROJ), (bf16_t*)(p.ws + O_MIXED), blockIdx.x & 1, blockIdx.y, blockIdx.z); }
__global__ void __launch_bounds__(512, 2) t_ssd_states(Params p) { extern __shared__ __attribute__((aligned(16))) unsigned char shm[]; ssd_states_phase((LAS unsigned char*)shm, p); }
__global__ void __launch_bounds__(512, 2) t_ssd_scan(Params p) { ssd_scan_phase(p, false); }
__global__ void __launch_bounds__(512, 2) t_ssd_out(Params p) { extern __shared__ __attribute__((aligned(16))) unsigned char shm[]; ssd_out_phase((LAS unsigned char*)shm, p, false); }
__global__ void __launch_bounds__(512, 2) t_gemm_ain(Params p) { extern __shared__ __attribute__((aligned(16))) unsigned char shm[]; EpiAttnIn E; E.O = (bf16_t*)(p.ws + O_PROJ); E.ss = (float*)(p.ws + O_SS); E.tab = (const f32x4*)(p.ws + O_ROPE); run_gemm((LAS unsigned char*)shm, (bf16_t*)(p.ws + O_HB), (const bf16_t*)(p.ws + W_AIN), AINW, DM, E); }
__global__ void __launch_bounds__(512, 2) t_gemm_res(Params p) { extern __shared__ __attribute__((aligned(16))) unsigned char shm[]; EpiRes<false, false> E; E.xres = nullptr; E.hb = (bf16_t*)(p.ws + O_HB); E.outf = nullptr; E.ssn = (float*)(p.ws + O_SS); run_gemm((LAS unsigned char*)shm, (bf16_t*)(p.ws + O_ACT), (const bf16_t*)(p.ws + W_DN0), DM, DFF, E); }
__global__ void __launch_bounds__(512, 2) t_gemm_gu(Params p) { extern __shared__ __attribute__((aligned(16))) unsigned char shm[]; EpiGU E; E.act = (bf16_t*)(p.ws + O_ACT); E.ss = (float*)(p.ws + O_SS); run_gemm((LAS unsigned char*)shm, (bf16_t*)(p.ws + O_HB), (const bf16_t*)(p.ws + W_GU0), 2 * DFF, DM, E); }
__global__ void __launch_bounds__(512, 2) t_gemm_ssdin(Params p) { extern __shared__ __attribute__((aligned(16))) unsigned char shm[]; EpiSsdIn E; E.z = (bf16_t*)p.out; E.xbc = (bf16_t*)(p.ws + O_XBC); E.dt = (float*)(p.ws + O_DT); E.ss = (float*)(p.ws + O_SS); run_gemm((LAS unsigned char*)shm, (bf16_t*)(p.ws + O_HB), (const bf16_t*)(p.ws + W_SIN), SINWP, DM, E); }
#endif
```

```cpp
#include <hip/hip_runtime.h>
#include <hip/hip_cooperative_groups.h>
#include <cstdio>
#include <cstdint>
namespace cg = cooperative_groups;
namespace pg8 {
#define PG8_LAS __attribute__((address_space(3)))
typedef unsigned short bf16_t;
typedef short bf16x8 __attribute__((ext_vector_type(8)));
typedef float f32x4 __attribute__((ext_vector_type(4)));
typedef unsigned u32x4 __attribute__((ext_vector_type(4)));
constexpr int BM = 256, BK = 64, HALF = 128, HTB = HALF * BK * 2  , STAGE_BYTES = 8 * HTB, NXCD = 8, WGM = 8;

__host__ __device__ __forceinline__ int lds_byte(int r, int c) { const int st = (r >> 4) * 2 + (c >> 5), rr = r & 15, cc = c & 31, ob = rr * 64 + cc * 2; return st * 1024 + (ob ^ (((ob >> 9) & 1) << 5)); }
__host__ __device__ __forceinline__ void stage_rc(int b, int& R, int& C) { const int st = b / 1024, sb = b % 1024, swz = sb ^ (((sb >> 9) & 1) << 5); R = (st >> 1) * 16 + swz / 64; C = (st & 1) * 32 + (swz % 64) / 2; }
__host__ __device__ __forceinline__ int perm32(int rho) { const int n = rho >> 4, i = rho & 15; return 8 * (i >> 2) + 4 * n + (i & 3); }

struct Unit { int pm, pn; };
struct Gemm { const bf16_t* A; const bf16_t* Bt; int M, N, K; };

struct StaticOrder {
    int nM, nN, nwg, G, c;
    __host__ __device__ void init(int M, int N, int G_, int c_) { nM = M / BM; nN = N / BM; nwg = nM * nN; G = G_; c = c_; }
    __host__ __device__ bool next(int i, Unit& u) const {
        const long L = (long)i * G + c; if (L >= nwg) return false;
        int wgid = (int)L; { const int q = nwg / NXCD, r = nwg % NXCD, xcd = wgid % NXCD, off = wgid / NXCD; wgid = (xcd < r ? xcd * (q + 1) : r * (q + 1) + (xcd - r) * q) + off; }
        const int nig = WGM * nN, gid = wgid / nig, fm = gid * WGM, gsz = (nM - fm) < WGM ? (nM - fm) : WGM;
        u.pm = fm + ((wgid % nig) % gsz); u.pn = (wgid % nig) / gsz; return true;
    }
    __device__ __forceinline__ void a_ready(const Unit&) const {}
    __device__ __forceinline__ void done(const Unit&) const {}
};

template <class Epi, class Sched, bool STAMP = false>
__device__ __forceinline__ void gemm_phase(PG8_LAS unsigned char* lds, const Gemm g, const Sched& S, const Epi& E, unsigned long long* stamps) {
    int tid_ = threadIdx.x; asm volatile("" : "+v"(tid_)); const int tid = tid_, wid = __builtin_amdgcn_readfirstlane(tid >> 6), lane = tid & 63, wr = wid >> 2, wc = wid & 3, fr = lane & 15, fq = lane >> 4;
    const int K = g.K, nt = K / BK;
    int ts_lo = 0, ts_hi = 0, nts = 0; const unsigned long long rt_entry = STAMP ? (unsigned long long)wall_clock64() : 0ull;
#define PG8_STAMP() do { if (STAMP && wid == 0 && nts < 64) { const unsigned long long _c = (unsigned long long)clock64(); \
        ts_lo = (lane == nts) ? (int)(unsigned)_c : ts_lo; ts_hi = (lane == nts) ? (int)(unsigned)(_c >> 32) : ts_hi; ++nts; } } while (0)
    PG8_STAMP();
    unsigned voffA[2], voffB[2];
#pragma unroll
    for (int i = 0; i < 2; ++i) { int R, C; stage_rc(tid * 16 + i * 8192, R, C); const int Rb = Epi::PERM ? ((R & ~31) + perm32(R & 31)) : R;
        voffA[i] = (unsigned)(R * K + C) * 2u; voffB[i] = (unsigned)(Rb * K + C) * 2u; }
    const size_t kstep = (size_t)(BK * 2);
    const size_t hstep = (size_t)HALF * K * 2;
    const size_t tstep = 2 * hstep;
    const unsigned ldsw = (unsigned)wid * 1024u;
    const int aoff = lds_byte(wr * 64 + fr, fq * 8), boff = lds_byte(wc * 32 + fr, fq * 8);
#define PG8_SA(b, h) (((b) * 2 + (h)) * HTB)
#define PG8_SB(b, h) ((4 + (b) * 2 + (h)) * HTB)
#define PG8_STAGE(bufoff, gbase, voff) do { _Pragma("unroll") for (int _i = 0; _i < 2; ++_i) \
        __builtin_amdgcn_global_load_lds((const unsigned*)((const char*)(gbase) + (voff)[_i]), (PG8_LAS unsigned*)(lds + (bufoff) + ldsw + _i * 8192), 16, 0, 0); } while (0)
#define PG8_LDA(dst, b, h) do { _Pragma("unroll") for (int m = 0; m < 4; ++m) _Pragma("unroll") for (int k = 0; k < 2; ++k) dst[m][k] = *(const PG8_LAS bf16x8*)(lds + PG8_SA(b, h) + aoff + m * 2048 + k * 1024); } while (0)
#define PG8_LDB(dst, b, h) do { _Pragma("unroll") for (int n = 0; n < 2; ++n) _Pragma("unroll") for (int k = 0; k < 2; ++k) dst[n][k] = *(const PG8_LAS bf16x8*)(lds + PG8_SB(b, h) + boff + n * 2048 + k * 1024); } while (0)
#define PG8_MMA(ai, bj, At, Bt) do { __builtin_amdgcn_s_setprio(1); _Pragma("unroll") for (int m = 0; m < 4; ++m) _Pragma("unroll") for (int n = 0; n < 2; ++n) _Pragma("unroll") for (int k = 0; k < 2; ++k) \
        acc[ai][bj][m][n] = __builtin_amdgcn_mfma_f32_16x16x32_bf16(Bt[n][k], At[m][k], acc[ai][bj][m][n], 0, 0, 0); __builtin_amdgcn_s_setprio(0); } while (0)
#define PG8_WAIT_V(n) asm volatile("s_waitcnt vmcnt(" #n ")" ::: "memory")
#define PG8_WAIT_L(n) asm volatile("s_waitcnt lgkmcnt(" #n ")" ::: "memory")
#define PG8_BAR __builtin_amdgcn_s_barrier()
#define PG8_SCHED __builtin_amdgcn_sched_barrier(0)
    Unit cur, nxt; int ui = 0;
    if (!S.next(0, cur)) return;
    f32x4 acc[2][2][4][2];
#pragma unroll
    for (int a = 0; a < 2; ++a)
#pragma unroll
        for (int b = 0; b < 2; ++b)
#pragma unroll
            for (int m = 0; m < 4; ++m)
#pragma unroll
                for (int n = 0; n < 2; ++n) acc[a][b][m][n] = (f32x4){0.f, 0.f, 0.f, 0.f};
    bf16x8 At[4][2], B0[2][2], B1[2][2];
    const char* cA = (const char*)g.A + (size_t)cur.pm * tstep; const char* cB = (const char*)g.Bt + (size_t)cur.pn * tstep;
    S.a_ready(cur);
    PG8_STAGE(PG8_SB(0, 0), cB, voffB); PG8_STAGE(PG8_SA(0, 0), cA, voffA); PG8_STAGE(PG8_SB(0, 1), cB + hstep, voffB); PG8_STAGE(PG8_SA(0, 1), cA + hstep, voffA);
    if (wr == 1) PG8_BAR;
    PG8_WAIT_V(4); PG8_BAR;
    PG8_STAGE(PG8_SB(1, 0), cB + kstep, voffB); PG8_STAGE(PG8_SA(1, 0), cA + kstep, voffA); PG8_STAGE(PG8_SB(1, 1), cB + hstep + kstep, voffB);
    PG8_WAIT_V(6); PG8_BAR;
    PG8_STAMP();
    for (;;) {
        const bool has_next = S.next(ui + 1, nxt);
        const char* nA = has_next ? (const char*)g.A + (size_t)nxt.pm * tstep : cA; const char* nB = has_next ? (const char*)g.Bt + (size_t)nxt.pn * tstep : cB;
        for (int t = 0; t < nt; t += 2) {
            const bool last = (t == nt - 2);
            const char* a1 = cA + (size_t)(t + 1) * kstep;
            const char* a2 = last ? nA : cA + (size_t)(t + 2) * kstep; const char* b2 = last ? nB : cB + (size_t)(t + 2) * kstep;
            const char* a3 = a2 + kstep; const char* b3 = b2 + kstep;
            if (last && has_next) S.a_ready(nxt);
            PG8_LDB(B0, 0, 0); PG8_SCHED; PG8_LDA(At, 0, 0); PG8_STAGE(PG8_SA(1, 1), a1 + hstep, voffA);
            PG8_WAIT_L(8); PG8_BAR; PG8_WAIT_L(0); PG8_MMA(0, 0, At, B0); PG8_BAR; PG8_SCHED;
            PG8_LDB(B1, 0, 1); PG8_STAGE(PG8_SB(0, 0), b2, voffB);
            PG8_BAR; PG8_WAIT_L(0); PG8_MMA(0, 1, At, B1); PG8_BAR;
            PG8_LDA(At, 0, 1); PG8_STAGE(PG8_SA(0, 0), a2, voffA);
            PG8_BAR; PG8_WAIT_L(0); PG8_MMA(1, 0, At, B0); PG8_BAR; PG8_SCHED;
            PG8_STAGE(PG8_SB(0, 1), b2 + hstep, voffB);
            PG8_WAIT_V(6); PG8_BAR; PG8_MMA(1, 1, At, B1); PG8_BAR;
            PG8_LDB(B0, 1, 0); PG8_SCHED; PG8_LDA(At, 1, 0); PG8_STAGE(PG8_SA(0, 1), a2 + hstep, voffA);
            PG8_WAIT_L(8); PG8_BAR; PG8_WAIT_L(0); PG8_MMA(0, 0, At, B0); PG8_BAR; PG8_SCHED;
            PG8_LDB(B1, 1, 1); PG8_STAGE(PG8_SB(1, 0), b3, voffB);
            PG8_BAR; PG8_WAIT_L(0); PG8_MMA(0, 1, At, B1); PG8_BAR;
            PG8_LDA(At, 1, 1); PG8_STAGE(PG8_SA(1, 0), a3, voffA);
            PG8_BAR; PG8_WAIT_L(0); PG8_MMA(1, 0, At, B0); PG8_BAR; PG8_SCHED;
            PG8_STAGE(PG8_SB(1, 1), b3 + hstep, voffB);
            PG8_WAIT_V(6); PG8_BAR; PG8_MMA(1, 1, At, B1); PG8_BAR;
        }
        PG8_STAMP();
        if constexpr (!Epi::AFTER_DRAIN) { E(acc, cur, wr, wc, fr, fq); S.done(cur); }
        PG8_STAMP();
        if (!has_next) break;
#pragma unroll
        for (int a = 0; a < 2; ++a)
#pragma unroll
            for (int b = 0; b < 2; ++b)
#pragma unroll
                for (int m = 0; m < 4; ++m)
#pragma unroll
                    for (int n = 0; n < 2; ++n) acc[a][b][m][n] = (f32x4){0.f, 0.f, 0.f, 0.f};
        cur = nxt; cA = nA; cB = nB; ++ui;
    }
    PG8_WAIT_V(0);
    if (wr == 0) PG8_BAR;
    PG8_BAR;
    if constexpr (Epi::AFTER_DRAIN) { E.fused(acc, cur, wr, wc, fr, fq, lds, wid, lane); S.done(cur); }
    PG8_STAMP();
    if (STAMP && wid == 0) { stamps[lane] = lane < nts ? (((unsigned long long)(unsigned)ts_hi << 32) | (unsigned)ts_lo) : 0ull;
        if (lane == 62) stamps[62] = rt_entry; if (lane == 63) stamps[63] = (unsigned long long)wall_clock64(); }
#undef PG8_STAMP
#undef PG8_SA
#undef PG8_SB
#undef PG8_STAGE
#undef PG8_LDA
#undef PG8_LDB
#undef PG8_MMA
#undef PG8_WAIT_V
#undef PG8_WAIT_L
#undef PG8_BAR
#undef PG8_SCHED
}
}
using pg8::bf16_t; using pg8::bf16x8; using pg8::f32x4;
typedef short s16x4 __attribute__((ext_vector_type(4)));
typedef float f32x16 __attribute__((ext_vector_type(16)));
typedef float f32x2 __attribute__((ext_vector_type(2)));
typedef __bf16 bf2_t __attribute__((ext_vector_type(2)));
typedef unsigned u32x2 __attribute__((ext_vector_type(2)));
typedef unsigned u32x4 __attribute__((ext_vector_type(4)));
#define LAS __attribute__((address_space(3)))
#define DI __device__ __forceinline__
#define MFMA32(a, b, c) __builtin_amdgcn_mfma_f32_32x32x16_bf16((a), (b), (c), 0, 0, 0)

DI int otid() { int t = threadIdx.x; asm volatile("" : "+v"(t)); return t; }
DI unsigned pk2(float a, float b) { f32x2 v = {a, b}; bf2_t r = __builtin_convertvector(v, bf2_t); return __builtin_bit_cast(unsigned, r); }
DI float bflo(unsigned u) { return __uint_as_float(u << 16); }
DI float bfhi(unsigned u) { return __uint_as_float(u & 0xffff0000u); }
DI float fexp2(float x) { return __builtin_amdgcn_exp2f(x); }
DI float frcp(float x) { return __builtin_amdgcn_rcpf(x); }
DI float fsilu(float x) { return x * frcp(1.0f + fexp2(-1.44269504089f * x)); }
DI int crow(int i, int h) { return (i & 3) + 8 * (i >> 2) + 4 * h; }
DI s16x4 trr(const LAS unsigned char* p) { return __builtin_amdgcn_ds_read_tr16_b64_v4i16((LAS s16x4*)p); }
DI bf16x8 tr2(const LAS unsigned char* p0, const LAS unsigned char* p1) { s16x4 a = trr(p0), b = trr(p1); return __builtin_shufflevector(a, b, 0, 1, 2, 3, 4, 5, 6, 7); }
DI bf16x8 pack8(const f32x16& x, int s) {
    u32x4 p; p[0] = pk2(x[8 * s], x[8 * s + 1]); p[1] = pk2(x[8 * s + 2], x[8 * s + 3]); p[2] = pk2(x[8 * s + 4], x[8 * s + 5]); p[3] = pk2(x[8 * s + 6], x[8 * s + 7]);
    return __builtin_bit_cast(bf16x8, p);
}
DI f32x16 zero16() { f32x16 z; for (int i = 0; i < 16; ++i) z[i] = 0.f; return z; }

constexpr int MT = 16384, SEQ = 8192, DM = 1024, DFF = 2816, AINW = 3072, SINW = 6176, SINWP = 6400, DIN = 2048, XBCW = 4096;
constexpr float LOG2E = 1.44269504089f;
constexpr int LDS_BYTES = 155648;
constexpr size_t W_AIN = 0, W_AOUT = W_AIN + (size_t)AINW * DM * 2, W_GU0 = W_AOUT + (size_t)DM * DM * 2, W_DN0 = W_GU0 + (size_t)2 * DFF * DM * 2,
                 W_SIN = W_DN0 + (size_t)DM * DFF * 2, W_SOUT = W_SIN + (size_t)SINWP * DM * 2, W_GU1 = W_SOUT + (size_t)DM * DIN * 2, W_DN1 = W_GU1 + (size_t)2 * DFF * DM * 2,
                 O_HB = W_DN1 + (size_t)DM * DFF * 2, O_SS = O_HB + (size_t)MT * DM * 2, O_ROPE = O_SS + (size_t)5 * MT * 4, O_DT = O_ROPE + (size_t)SEQ * 32 * 8,
                 O_CDEC = O_DT + (size_t)MT * 32 * 4, O_LAM = O_CDEC + 16384, O_BAR = O_LAM + 256, O_R = 98566144;
static_assert(O_BAR + 20480 <= O_R, "map");
constexpr size_t O_PROJ = O_R, O_MIXED = O_PROJ + (size_t)MT * AINW * 2, O_ACT = O_R, O_XBC = O_R, O_ST1 = O_XBC + (size_t)MT * XBCW * 2, O_ST0 = 0;
constexpr size_t ST_BATCH = (size_t)64 * 32 * 64 * 128;
static_assert(O_ST1 + ST_BATCH * 2 <= 268435456ull, "ws");
static_assert(ST_BATCH * 2 <= W_SOUT, "st0 overlay");
static_assert(O_MIXED + (size_t)MT * DM * 2 <= 268435456ull, "ws2");

struct Params { const float* in[23]; float* out; unsigned char* ws; };
#include <cstdlib>
#include <vector>

#define XB_TMO      128
#define XB_XCNT(j)  (256  + 64 * (j))
#define XB_XSUB(j)  (1280 + 64 * (j))
#define XB_XGEN(j)  (2304 + 64 * (j))
#define XB_TOP      3328
#define XB_TOPGEN   3392
#define XCD_BAR_WORDS 3456
#define XB_SPIN_CAP (1u << 18)

__device__ __forceinline__ unsigned xb_ld(unsigned* p)              { return __hip_atomic_load(p, __ATOMIC_RELAXED, __HIP_MEMORY_SCOPE_AGENT); }
__device__ __forceinline__ unsigned xb_add(unsigned* p, unsigned v) { return __hip_atomic_fetch_add(p, v, __ATOMIC_RELAXED, __HIP_MEMORY_SCOPE_AGENT); }
__device__ __forceinline__ unsigned xb_xcc_id() { return (unsigned)__builtin_amdgcn_s_getreg((3 << 11) | 20) & 0xFu; }
#define XB_SPIN(cond, bar) do { unsigned _sp = 0; while (cond) { __builtin_amdgcn_s_sleep(1); \
    if ((++_sp & 255u) == 0u) { if (xb_ld(&(bar)[XB_TMO])) break; if (_sp > XB_SPIN_CAP) { atomicAdd(&(bar)[XB_TMO], 1u); break; } } } } while (0)

struct XcdBarrier {
    unsigned* bar; unsigned x;
    volatile LAS unsigned* st;
};

__device__ __forceinline__ XcdBarrier xcd_barrier_post(unsigned* bar, volatile LAS unsigned* st) {
    XcdBarrier b; b.bar = bar; b.x = xb_xcc_id(); b.st = st;
    if (threadIdx.x == 0) (void)xb_add(&bar[XB_XCNT(b.x)], 1u);
    return b;
}
__device__ __forceinline__ void xcd_barrier_complete(unsigned* bar, unsigned x, unsigned& nloc, unsigned& nx) {
    const unsigned G = gridDim.x * gridDim.y * gridDim.z;
    unsigned sum, cnt, mine, sp = 0u;
    for (;;) {
        sum = 0u; cnt = 0u; mine = 0u;
#pragma unroll
        for (unsigned j = 0; j < 16; ++j) { const unsigned c = xb_ld(&bar[XB_XCNT(j)]); sum += c; cnt += (c > 0u) ? 1u : 0u; mine = (j == x) ? c : mine; }
        if (sum == G) break;
        __builtin_amdgcn_s_sleep(1);
        if ((++sp & 255u) == 0u) { if (xb_ld(&bar[XB_TMO])) break; if (sp > XB_SPIN_CAP) { atomicAdd(&bar[XB_TMO], 1u); break; } }
    }
    nloc = mine > 0u ? mine : 1u; nx = cnt > 0u ? cnt : 1u;
}

__device__ __forceinline__ void xcd_barrier(const XcdBarrier& b) {
    asm volatile("s_waitcnt vmcnt(0)" ::: "memory");
    __syncthreads();
    if (threadIdx.x == 0) {
        unsigned* bar = b.bar;
        __builtin_amdgcn_s_waitcnt(0);
        unsigned nloc = b.st[0], nx = b.st[1];
        if (nloc == 0u) { xcd_barrier_complete(bar, b.x, nloc, nx); b.st[0] = nloc; b.st[1] = nx; }
        const unsigned old = xb_add(&bar[XB_XSUB(b.x)], 1u);
        const unsigned gen = old / nloc;
        if (old + 1u == (gen + 1u) * nloc) {
            __builtin_amdgcn_fence(__ATOMIC_RELEASE, "agent");
            asm volatile("s_waitcnt vmcnt(0)" ::: "memory");
            const unsigned og = xb_add(&bar[XB_TOP], 1u);
            const unsigned tg = og / nx;
            if (og + 1u == (tg + 1u) * nx) xb_add(&bar[XB_TOPGEN], 1u);
            else XB_SPIN(xb_ld(&bar[XB_TOPGEN]) == tg, bar);
            __builtin_amdgcn_fence(__ATOMIC_ACQUIRE, "agent");
            xb_add(&bar[XB_XGEN(b.x)], 1u);
            asm volatile("s_waitcnt vmcnt(0)" ::: "memory");
        } else {
            XB_SPIN(xb_ld(&bar[XB_XGEN(b.x)]) == gen, bar);
            __builtin_amdgcn_fence(__ATOMIC_ACQUIRE, "agent");
            asm volatile("s_waitcnt vmcnt(0)" ::: "memory");
        }
    }
    __syncthreads();
}
DI void wmap(int mode, int c, int& src, float& scale, int& which) {
    src = c; scale = 1.f; which = 0;
    if (mode == 0) {
        if (c < 1024) { const int base = c & ~63, cc = c & 63, g = cc >> 3, e = cc & 7; src = base + (e < 4 ? 4 * g + e : 32 + 4 * g + (e - 4)); }
        if (c < 512) scale = 0.125f * LOG2E; else if (c >= 1536 && c < 2048) scale = 0.125f;
    } else if (mode == 2) { src = 4 * (c >> 3) + (c & 3); which = (c >> 2) & 1; }
    else if (mode == 3) { if (c >= SINW) src = -1; }
}
struct WJob { int mode, K, ldw, tix; const float* W0; const float* W1; const float* ks; bf16_t* dst; };
DI WJob wjob(const Params& p, int t) {
    unsigned char* ws = p.ws;
    const int cnt[8] = {48 * 4, 16 * 4, 88 * 4, 16 * 11, 100 * 4, 16 * 8, 88 * 4, 16 * 11};
    int j = 0, tt = t;
#pragma unroll
    for (int q = 0; q < 7; ++q) if (j == q && tt >= cnt[q]) { tt -= cnt[q]; j = q + 1; }
    WJob J; J.tix = tt; J.W1 = nullptr; J.ks = nullptr;
    switch (j) {
    case 0: J.mode = 0; J.W0 = p.in[2]; J.ks = p.in[1]; J.dst = (bf16_t*)(ws + W_AIN); J.K = DM; J.ldw = AINW; break;
    case 1: J.mode = 1; J.W0 = p.in[8]; J.dst = (bf16_t*)(ws + W_AOUT); J.K = DM; J.ldw = DM; break;
    case 2: J.mode = 2; J.W0 = p.in[19]; J.W1 = p.in[20]; J.ks = p.in[18]; J.dst = (bf16_t*)(ws + W_GU0); J.K = DM; J.ldw = DFF; break;
    case 3: J.mode = 1; J.W0 = p.in[21]; J.dst = (bf16_t*)(ws + W_DN0); J.K = DFF; J.ldw = DM; break;
    case 4: J.mode = 3; J.W0 = p.in[10]; J.ks = p.in[9]; J.dst = (bf16_t*)(ws + W_SIN); J.K = DM; J.ldw = SINW; break;
    case 5: J.mode = 1; J.W0 = p.in[17]; J.dst = (bf16_t*)(ws + W_SOUT); J.K = DIN; J.ldw = DM; break;
    case 6: J.mode = 2; J.W0 = p.in[19] + (size_t)DM * DFF; J.W1 = p.in[20] + (size_t)DM * DFF; J.ks = p.in[18] + DM; J.dst = (bf16_t*)(ws + W_GU1); J.K = DM; J.ldw = DFF; break;
    default: J.mode = 1; J.W0 = p.in[21] + (size_t)DFF * DM; J.dst = (bf16_t*)(ws + W_DN1); J.K = DFF; J.ldw = DM; break;
    }
    return J;
}
DI void wtile_load(const WJob& J, int tid, float (&v)[32], float& sc, int& srcok) {
    const int nk = J.K >> 8, c0 = (J.tix / nk) * 64, k0 = (J.tix % nk) * 256, cc = tid & 63; int src, which; wmap(J.mode, c0 + cc, src, sc, which);
    const float* W = (which ? J.W1 : J.W0) + (src >= 0 ? src : 0); srcok = (src >= 0);
#pragma unroll
    for (int i = 0; i < 32; ++i) { const int kk = (tid >> 6) + 8 * i; v[i] = W[(size_t)(k0 + kk) * J.ldw]; }
}
DI void wtile_store(LAS float* tile, const WJob& J, int tid, const float (&v)[32], float sc, int srcok) {
    const int nk = J.K >> 8, c0 = (J.tix / nk) * 64, k0 = (J.tix % nk) * 256, cc = tid & 63;
#pragma unroll
    for (int i = 0; i < 32; ++i) { const int kk = (tid >> 6) + 8 * i; float x = srcok ? v[i] * sc : 0.f; if (J.ks) x *= J.ks[k0 + kk]; tile[kk * 65 + cc] = x; }
    __syncthreads();
#pragma unroll
    for (int i = 0; i < 16; ++i) {
        const int idx = tid + 512 * i, c2 = idx >> 7, k2 = (idx & 127) * 2;
        *(unsigned*)(J.dst + (size_t)(c0 + c2) * J.K + k0 + k2) = pk2(tile[k2 * 65 + c2], tile[(k2 + 1) * 65 + c2]);
    }
    __syncthreads();
}
DI void wconv_jobs(LAS unsigned char* lds, const Params& p, int wi, int nb) {
    const int tid = otid(); const int total = 48 * 4 + 16 * 4 + 2 * (88 * 4 + 16 * 11) + 100 * 4 + 16 * 8;
    if (wi >= total) return;
    WJob J = wjob(p, wi); float v[32]; float sc; int ok;
    wtile_load(J, tid, v, sc, ok);
    for (int t = wi; t < total; t += nb) {
        const bool more = (t + nb < total);
        WJob Jn = J; float vn[32]; float scn = 0.f; int okn = 0;
        if (more) { Jn = wjob(p, t + nb); wtile_load(Jn, tid, vn, scn, okn); }
        wtile_store((LAS float*)lds, J, tid, v, sc, ok);
        if (more) { J = Jn; sc = scn; ok = okn;
#pragma unroll
            for (int i = 0; i < 32; ++i) v[i] = vn[i]; }
    }
}
DI void phase0(LAS unsigned char* lds, const Params& p) {
    const int tid = otid(), G = gridDim.x, bx = blockIdx.x;
    unsigned char* ws = p.ws;
    wconv_jobs(lds, p, bx, G);
    {
        const int wave = tid >> 6, lane = tid & 63; bf16_t* hb = (bf16_t*)(ws + O_HB); float* ss = (float*)(ws + O_SS);
        for (int row0 = (bx * 8 + wave) * 2; row0 < MT; row0 += G * 16) {
            f32x4 v[2][4];
#pragma unroll
            for (int q = 0; q < 2; ++q)
#pragma unroll
                for (int i = 0; i < 4; ++i) v[q][i] = *(const f32x4*)(p.in[0] + (size_t)(row0 + q) * DM + lane * 4 + 256 * i);
#pragma unroll
            for (int q = 0; q < 2; ++q) {
                float sq = 0.f;
#pragma unroll
                for (int i = 0; i < 4; ++i) { const f32x4 x = v[q][i]; sq += x[0] * x[0] + x[1] * x[1] + x[2] * x[2] + x[3] * x[3];
                    u32x2 o; o[0] = pk2(x[0], x[1]); o[1] = pk2(x[2], x[3]); *(u32x2*)(hb + (size_t)(row0 + q) * DM + lane * 4 + 256 * i) = o; }
#pragma unroll
                for (int o = 32; o >= 1; o >>= 1) sq += __shfl_xor(sq, o);
                if (lane == 0) ss[row0 + q] = sq;
            }
        }
        for (int i = bx * 512 + tid; i < 4 * MT; i += G * 512) ss[MT + i] = 0.f;
        f32x2* tab = (f32x2*)(ws + O_ROPE);
        for (int i = bx * 512 + tid; i < SEQ * 32; i += G * 512) {
            const int pos = i >> 5, f = i & 31; const float inv = fexp2(-(float)f * 0.41524101186092f); const float ang = (float)pos * inv;
            double t = (double)ang * 0.15915494309189535; t -= floor(t); const float tf = (float)t;
            f32x2 cs; cs[0] = __builtin_amdgcn_cosf(tf); cs[1] = __builtin_amdgcn_sinf(tf); tab[i] = cs;
        }
        if (bx == 0 && tid == 0) { float s1 = 0.f, s2 = 0.f; for (int i = 0; i < 64; ++i) { s1 += p.in[3][i] * p.in[4][i]; s2 += p.in[5][i] * p.in[6][i]; }
            *(float*)(ws + O_LAM) = fexp2(s1 * LOG2E) - fexp2(s2 * LOG2E) + 0.2f; }
    }
}

struct EpiAttnIn {
    static constexpr bool PERM = true, AFTER_DRAIN = false;
    bf16_t* O; const float* ss; const f32x4* tab;
    DI void operator()(const f32x4 (&acc)[2][2][4][2], const pg8::Unit& u, int wr, int wc, int fr, int fq) const {
        const int row0 = u.pm * 256 + wr * 64 + fr, colt = u.pn * 256, col0 = colt + wc * 32 + 8 * fq;
        const int fb = 4 * (4 * (wc & 1) + fq);
#pragma unroll
        for (int ai = 0; ai < 2; ++ai)
#pragma unroll
            for (int m = 0; m < 4; ++m) {
                const int row = row0 + ai * 128 + m * 16; const float rs = __builtin_amdgcn_rsqf(ss[row] * (1.0f / 1024.0f) + 1e-6f);
                f32x4 c01 = {1.f, 0.f, 1.f, 0.f}, c23 = {1.f, 0.f, 1.f, 0.f};
                if (colt < 1024) { const int pos = row & (SEQ - 1); c01 = tab[(pos * 32 + fb) >> 1]; c23 = tab[((pos * 32 + fb) >> 1) + 1]; }
#pragma unroll
                for (int bj = 0; bj < 2; ++bj) {
                    f32x4 v0 = acc[ai][bj][m][0] * rs, v1 = acc[ai][bj][m][1] * rs;
                    if (colt < 1024) {
                        const float cs[4] = {c01[0], c01[2], c23[0], c23[2]}, sn[4] = {c01[1], c01[3], c23[1], c23[3]};
#pragma unroll
                        for (int j = 0; j < 4; ++j) { const float t1 = v0[j], t2 = v1[j]; v0[j] = t1 * cs[j] - t2 * sn[j]; v1[j] = t2 * cs[j] + t1 * sn[j]; }
                    }
                    u32x4 o; o[0] = pk2(v0[0], v0[1]); o[1] = pk2(v0[2], v0[3]); o[2] = pk2(v1[0], v1[1]); o[3] = pk2(v1[2], v1[3]);
                    *(u32x4*)(O + (size_t)row * AINW + col0 + bj * 128) = o;
                }
            }
    }
};
template <bool RES_F32, bool OUT_F32> struct EpiRes {
    static constexpr bool PERM = false, AFTER_DRAIN = false;
    const float* xres; bf16_t* hb; float* outf; float* ssn;
    DI void operator()(const f32x4 (&acc)[2][2][4][2], const pg8::Unit& u, int wr, int wc, int fr, int fq) const {
        const int row0 = u.pm * 256 + wr * 64 + fr, col0 = u.pn * 256 + wc * 32 + 4 * fq;
#pragma unroll
        for (int ai = 0; ai < 2; ++ai)
#pragma unroll
            for (int m = 0; m < 4; ++m) {
                const int row = row0 + ai * 128 + m * 16; float sq = 0.f;
#pragma unroll
                for (int bj = 0; bj < 2; ++bj)
#pragma unroll
                    for (int n = 0; n < 2; ++n) {
                        const size_t off = (size_t)row * DM + col0 + bj * 128 + n * 16; f32x4 r;
                        if (RES_F32) r = *(const f32x4*)(xres + off);
                        else { const u32x2 t = *(const u32x2*)(hb + off); r[0] = bflo(t[0]); r[1] = bfhi(t[0]); r[2] = bflo(t[1]); r[3] = bfhi(t[1]); }
                        const f32x4 v = r + acc[ai][bj][m][n];
                        sq += v[0] * v[0] + v[1] * v[1] + v[2] * v[2] + v[3] * v[3];
                        if (OUT_F32) *(f32x4*)(outf + off) = v;
                        else { u32x2 o; o[0] = pk2(v[0], v[1]); o[1] = pk2(v[2], v[3]); *(u32x2*)(hb + off) = o; }
                    }
                sq += __shfl_xor(sq, 16); sq += __shfl_xor(sq, 32);
                if (fq == 0) atomicAdd(ssn + row, sq);
            }
    }
};
struct EpiGU {
    static constexpr bool PERM = true, AFTER_DRAIN = false;
    bf16_t* act; const float* ss;
    DI void operator()(const f32x4 (&acc)[2][2][4][2], const pg8::Unit& u, int wr, int wc, int fr, int fq) const {
        const int row0 = u.pm * 256 + wr * 64 + fr, col0 = u.pn * 256 + wc * 32 + 8 * fq;
#pragma unroll
        for (int ai = 0; ai < 2; ++ai)
#pragma unroll
            for (int m = 0; m < 4; ++m) {
                const int row = row0 + ai * 128 + m * 16; const float rs = __builtin_amdgcn_rsqf(ss[row] * (1.0f / 1024.0f) + 1e-6f);
#pragma unroll
                for (int bj = 0; bj < 2; ++bj) {
                    const f32x4 g = acc[ai][bj][m][0] * rs, up = acc[ai][bj][m][1] * rs; float a[4];
#pragma unroll
                    for (int j = 0; j < 4; ++j) a[j] = fsilu(g[j]) * up[j];
                    u32x2 o; o[0] = pk2(a[0], a[1]); o[1] = pk2(a[2], a[3]);
                    *(u32x2*)(act + (size_t)row * DFF + ((col0 + bj * 128) >> 1)) = o;
                }
            }
    }
};
struct EpiSsdIn {
    static constexpr bool PERM = true, AFTER_DRAIN = false;
    bf16_t* z; bf16_t* xbc; float* dt; const float* ss;
    DI void operator()(const f32x4 (&acc)[2][2][4][2], const pg8::Unit& u, int wr, int wc, int fr, int fq) const {
        const int row0 = u.pm * 256 + wr * 64 + fr, col0 = u.pn * 256 + wc * 32 + 8 * fq;
#pragma unroll
        for (int ai = 0; ai < 2; ++ai)
#pragma unroll
            for (int m = 0; m < 4; ++m) {
                const int row = row0 + ai * 128 + m * 16; const float rs = __builtin_amdgcn_rsqf(ss[row] * (1.0f / 1024.0f) + 1e-6f);
#pragma unroll
                for (int bj = 0; bj < 2; ++bj) {
                    const int c = col0 + bj * 128; const f32x4 v0 = acc[ai][bj][m][0] * rs, v1 = acc[ai][bj][m][1] * rs;
                    if (c < 6144) { u32x4 o; o[0] = pk2(v0[0], v0[1]); o[1] = pk2(v0[2], v0[3]); o[2] = pk2(v1[0], v1[1]); o[3] = pk2(v1[2], v1[3]);
                        if (c < DIN) *(u32x4*)(z + (size_t)row * DIN + c) = o; else *(u32x4*)(xbc + (size_t)row * XBCW + (c - DIN)) = o; }
                }
            }
    }
};

struct EpiFinal {
    static constexpr bool PERM = false, AFTER_DRAIN = true;
    const bf16_t* hb; float* outf; float* ssn; unsigned* cnt; const float* fw;
    DI void operator()(const f32x4 (&)[2][2][4][2], const pg8::Unit&, int, int, int, int) const {}
    DI void fused(f32x4 (&acc)[2][2][4][2], const pg8::Unit& u, int wr, int wc, int fr, int fq, PG8_LAS unsigned char*, int, int) const {
        const int row0 = u.pm * 256 + wr * 64 + fr, col0 = u.pn * 256 + wc * 32 + 4 * fq;
#pragma unroll
        for (int ai = 0; ai < 2; ++ai)
#pragma unroll
            for (int m = 0; m < 4; ++m) {
                const int row = row0 + ai * 128 + m * 16; float sq = 0.f;
#pragma unroll
                for (int bj = 0; bj < 2; ++bj)
#pragma unroll
                    for (int n = 0; n < 2; ++n) {
                        const size_t off = (size_t)row * DM + col0 + bj * 128 + n * 16;
                        const u32x2 t = *(const u32x2*)(hb + off); f32x4 r; r[0] = bflo(t[0]); r[1] = bfhi(t[0]); r[2] = bflo(t[1]); r[3] = bfhi(t[1]);
                        const f32x4 v = r + acc[ai][bj][m][n]; acc[ai][bj][m][n] = v;
                        sq += v[0] * v[0] + v[1] * v[1] + v[2] * v[2] + v[3] * v[3];
                    }
                sq += __shfl_xor(sq, 16); sq += __shfl_xor(sq, 32);
                if (fq == 0) atomicAdd(ssn + row, sq);
            }
        asm volatile("s_waitcnt vmcnt(0)" ::: "memory");
        __syncthreads();
        unsigned* c = cnt + 16 * u.pm;
        if (threadIdx.x == 0) {
            __builtin_amdgcn_fence(__ATOMIC_RELEASE, "agent"); asm volatile("s_waitcnt vmcnt(0)" ::: "memory");
            __hip_atomic_fetch_add(c, 1u, __ATOMIC_RELAXED, __HIP_MEMORY_SCOPE_AGENT);
            unsigned spins = 0;
            while (__hip_atomic_load(c, __ATOMIC_RELAXED, __HIP_MEMORY_SCOPE_AGENT) < 4u && ++spins < (1u << 22)) __builtin_amdgcn_s_sleep(2);
            __builtin_amdgcn_fence(__ATOMIC_ACQUIRE, "agent"); asm volatile("s_waitcnt vmcnt(0)" ::: "memory");
        }
        __syncthreads();
#pragma unroll
        for (int ai = 0; ai < 2; ++ai)
#pragma unroll
            for (int m = 0; m < 4; ++m) {
                const int row = row0 + ai * 128 + m * 16;
                const float rs = __builtin_amdgcn_rsqf(__hip_atomic_load(ssn + row, __ATOMIC_RELAXED, __HIP_MEMORY_SCOPE_AGENT) * (1.0f / 1024.0f) + 1e-6f);
#pragma unroll
                for (int bj = 0; bj < 2; ++bj)
#pragma unroll
                    for (int n = 0; n < 2; ++n) {
                        const int col = col0 + bj * 128 + n * 16; const f32x4 w = *(const f32x4*)(fw + col);
                        *(f32x4*)(outf + (size_t)row * DM + col) = acc[ai][bj][m][n] * rs * w;
                    }
            }
    }
};
constexpr int KST = 144, VST = 320, VST64 = 192;
constexpr int AT_K1 = 0, AT_K2 = 64 * KST, AT_V = 2 * 64 * KST, AT_STAGE = AT_V + 64 * VST;

DI void diff_tile(LAS unsigned char* lds, const bf16_t* proj, bf16_t* mixed, const float* subln, float lam, int b, int hd, int qt) {
    const int tid = otid(), w = __builtin_amdgcn_readfirstlane(tid >> 6), lane = tid & 63, qg = w & 3, mp = w >> 2, r = lane & 31, h = lane >> 5;
    const int q0 = qt * 128; const size_t rowb = (size_t)b * SEQ;
    bf16x8 qf[4];
    { const bf16_t* qp = proj + (rowb + q0 + 32 * qg + r) * AINW + hd * 128 + mp * 64 + 8 * h;
#pragma unroll
      for (int s = 0; s < 4; ++s) qf[s] = *(const bf16x8*)(qp + 16 * s); }
    f32x16 O[4];
#pragma unroll
    for (int i = 0; i < 4; ++i) O[i] = zero16();
    float mrun = 0.f, lrun = 0.f;
    const int nsteps = 2 * (qt + 1);
    const bf16_t* src[4]; int dst[4];
#pragma unroll
    for (int i = 0; i < 2; ++i) { const int cid = tid + 512 * i, row = cid >> 4, c16 = cid & 15;
        src[i] = proj + (rowb + row) * AINW + 512 + hd * 128 + c16 * 8; dst[i] = (c16 < 8 ? AT_K1 : AT_K2) + row * KST + (c16 & 7) * 16;
        src[2 + i] = proj + (rowb + row) * AINW + 1024 + hd * 128 + c16 * 8; dst[2 + i] = AT_V + row * VST + c16 * 16; }
    u32x4 pf[4];
#pragma unroll
    for (int i = 0; i < 4; ++i) pf[i] = *(const u32x4*)(src[i]);
#pragma unroll
    for (int i = 0; i < 4; ++i) *(LAS u32x4*)(lds + dst[i]) = pf[i];
    __syncthreads();
    const int i16 = lane & 15, tq = i16 >> 2, tp = i16 & 3, g16 = (lane >> 4) & 1;
    const int troff = (4 * h + tq) * VST + (16 * g16 + 4 * tp) * 2;
    for (int j = 0; j < nsteps; ++j) {
        const bool more = (j + 1 < nsteps);
        if (more) {
#pragma unroll
            for (int i = 0; i < 4; ++i) pf[i] = *(const u32x4*)(src[i] + (size_t)(j + 1) * 64 * AINW);
        }
        const LAS unsigned char* base = lds + (j & 1) * AT_STAGE;
        const LAS unsigned char* Kb = base + (mp ? AT_K2 : AT_K1);
        const LAS unsigned char* Vb = base + AT_V;
        f32x16 S[2];
        const float negm = -mrun;
#pragma unroll
        for (int kt = 0; kt < 2; ++kt) {
#pragma unroll
            for (int i = 0; i < 16; ++i) S[kt][i] = negm;
#pragma unroll
            for (int s = 0; s < 4; ++s) { const bf16x8 kf = *(const LAS bf16x8*)(Kb + (32 * kt + r) * KST + (16 * s + 8 * h) * 2); S[kt] = MFMA32(kf, qf[s], S[kt]); } }
        const int qidx = q0 + 32 * qg + r, kbase = 64 * j;
        if (kbase + 63 > q0 + 32 * qg) {
#pragma unroll
            for (int kt = 0; kt < 2; ++kt)
#pragma unroll
                for (int i = 0; i < 16; ++i) if (kbase + 32 * kt + crow(i, h) > qidx) S[kt][i] = -1e30f;
        }
        float mx = S[0][0];
#pragma unroll
        for (int kt = 0; kt < 2; ++kt)
#pragma unroll
            for (int i = 0; i < 16; ++i) mx = fmaxf(mx, S[kt][i]);
        mx = fmaxf(mx, __shfl_xor(mx, 32));
        if (j == 0 || __builtin_amdgcn_ballot_w64(mx > 8.0f) != 0ull) {
            const float d = (j == 0) ? mx : fmaxf(mx, 0.f);
            mrun += d;
            if (j != 0) { const float alpha = fexp2(-d); lrun *= alpha;
#pragma unroll
                for (int vt = 0; vt < 4; ++vt) O[vt] = O[vt] * alpha; }
#pragma unroll
            for (int kt = 0; kt < 2; ++kt)
#pragma unroll
                for (int i = 0; i < 16; ++i) S[kt][i] -= d;
        }
        float ls = 0.f;
#pragma unroll
        for (int kt = 0; kt < 2; ++kt)
#pragma unroll
            for (int i = 0; i < 16; ++i) { const float pv = fexp2(S[kt][i]); S[kt][i] = pv; ls += pv; }
        lrun += ls;
#pragma unroll
        for (int kt = 0; kt < 2; ++kt)
#pragma unroll
            for (int s2 = 0; s2 < 2; ++s2) {
                const bf16x8 pfr = pack8(S[kt], s2);
                const LAS unsigned char* vrow = Vb + (32 * kt + 16 * s2) * VST + troff;
#pragma unroll
                for (int vt = 0; vt < 4; ++vt) { const bf16x8 vf = tr2(vrow + vt * 64, vrow + 8 * VST + vt * 64); O[vt] = MFMA32(vf, pfr, O[vt]); }
            }
        if (more) {
            LAS unsigned char* nb = lds + ((j + 1) & 1) * AT_STAGE;
#pragma unroll
            for (int i = 0; i < 4; ++i) *(LAS u32x4*)(nb + dst[i]) = pf[i];
        }
        __syncthreads();
    }
    lrun += __shfl_xor(lrun, 32);
    const float inv = frcp(lrun);
    LAS float* ex = (LAS float*)lds;
    if (mp == 1) {
        const float sc = inv * lam;
#pragma unroll
        for (int vt = 0; vt < 4; ++vt)
#pragma unroll
            for (int i = 0; i < 16; ++i) ex[(qg * 128 + 32 * vt + crow(i, h)) * 32 + r] = O[vt][i] * sc;
    }
    __syncthreads();
    if (mp == 0) {
        float sq = 0.f;
#pragma unroll
        for (int vt = 0; vt < 4; ++vt)
#pragma unroll
            for (int i = 0; i < 16; ++i) { const float o = O[vt][i] * inv - ex[(qg * 128 + 32 * vt + crow(i, h)) * 32 + r]; O[vt][i] = o; sq += o * o; }
        sq += __shfl_xor(sq, 32);
        const float rn = __builtin_amdgcn_rsqf(sq * (1.0f / 128.0f) + 1e-5f) * 0.8f;
        bf16_t* op = mixed + (rowb + q0 + 32 * qg + r) * DM + hd * 128;
#pragma unroll
        for (int vt = 0; vt < 4; ++vt)
#pragma unroll
            for (int gq = 0; gq < 4; ++gq) { const int v0 = 32 * vt + 8 * gq + 4 * h; const f32x4 wv = *(const f32x4*)(subln + v0);
                u32x2 o; o[0] = pk2(O[vt][4 * gq] * rn * wv[0], O[vt][4 * gq + 1] * rn * wv[1]); o[1] = pk2(O[vt][4 * gq + 2] * rn * wv[2], O[vt][4 * gq + 3] * rn * wv[3]);
                *(u32x2*)(op + v0) = o; }
    }
    __syncthreads();
}

constexpr int SB_K = 0, SB_V = 64 * KST, SB_STAGE = 64 * KST + 64 * VST64;
DI void sb_block(LAS unsigned char* lds, const bf16_t* proj, bf16_t* mixed, int b, int hs, int qb) {
    const int tid = otid(), w = __builtin_amdgcn_readfirstlane(tid >> 6), lane = tid & 63, r = lane & 31, h = lane >> 5;
    const int q0 = qb * 256; const size_t rowb = (size_t)b * SEQ;
    const int qidx = q0 + 32 * w + r;
    bf16x8 qf[4];
    { const bf16_t* qp = proj + (rowb + qidx) * AINW + 1536 + hs * 64 + 8 * h;
#pragma unroll
      for (int s = 0; s < 4; ++s) qf[s] = *(const bf16x8*)(qp + 16 * s); }
    f32x16 O[2]; O[0] = zero16(); O[1] = zero16();
    float carry = 1.0f;
    const int jmax = 4 * qb + 3;
    const int srow = tid >> 3, sc8 = tid & 7;
    const bf16_t* srcK = proj + (rowb + srow) * AINW + 2048 + hs * 64 + sc8 * 8;
    const bf16_t* srcV = proj + (rowb + srow) * AINW + 2560 + hs * 64 + sc8 * 8;
    const int dstK = SB_K + srow * KST + sc8 * 16, dstV = SB_V + srow * VST64 + sc8 * 16;
    u32x4 pk_ = *(const u32x4*)(srcK + (size_t)jmax * 64 * AINW), pv_ = *(const u32x4*)(srcV + (size_t)jmax * 64 * AINW);
    *(LAS u32x4*)(lds + dstK) = pk_; *(LAS u32x4*)(lds + dstV) = pv_;
    __syncthreads();
    const int i16 = lane & 15, tq = i16 >> 2, tp = i16 & 3, g16 = (lane >> 4) & 1;
    const int troff = (4 * h + tq) * VST64 + (16 * g16 + 4 * tp) * 2;
    int it = 0;
    for (int j = jmax; j >= 0; --j, ++it) {
        const bool more = (j > 0);
        if (more) { pk_ = *(const u32x4*)(srcK + (size_t)(j - 1) * 64 * AINW); pv_ = *(const u32x4*)(srcV + (size_t)(j - 1) * 64 * AINW); }
        const LAS unsigned char* base = lds + (it & 1) * SB_STAGE;
        const int kbase = 64 * j;
        if (kbase < q0 + 32 * w + 32) {
#pragma unroll
            for (int kt = 1; kt >= 0; --kt) {
                f32x16 S = zero16();
#pragma unroll
                for (int s = 0; s < 4; ++s) { const bf16x8 kf = *(const LAS bf16x8*)(base + SB_K + (32 * kt + r) * KST + (16 * s + 8 * h) * 2); S = MFMA32(kf, qf[s], S); }
                float T[4], sfx[16];
#pragma unroll
                for (int gq = 0; gq < 4; ++gq) {
                    float run = 1.0f;
#pragma unroll
                    for (int jj = 3; jj >= 0; --jj) {
                        const int i = 4 * gq + jj; const bool valid = (kbase + 32 * kt + crow(i, h)) < qidx;
                        const float zz = fmaxf(S[i], -60.0f); const float e = fexp2(-LOG2E * zz); const float sg = frcp(1.0f + e);
                        const float keep = valid ? e * sg : 1.0f;
                        S[i] = valid ? sg : 0.0f; sfx[i] = run; run *= keep;
                    }
                    T[gq] = run;
                }
                float To[4];
#pragma unroll
                for (int gq = 0; gq < 4; ++gq) To[gq] = __shfl_xor(T[gq], 32);
                float E[4]; float acc_hi = 1.0f;
#pragma unroll
                for (int gq = 3; gq >= 0; --gq) {
                    const float above_same = acc_hi;
                    E[gq] = (h == 0) ? above_same * To[gq] : above_same;
                    acc_hi = acc_hi * T[gq] * To[gq];
                }
#pragma unroll
                for (int i = 0; i < 16; ++i) S[i] = S[i] * carry * E[i >> 2] * sfx[i];
                carry *= acc_hi;
#pragma unroll
                for (int s2 = 0; s2 < 2; ++s2) {
                    const bf16x8 pfr = pack8(S, s2);
                    const LAS unsigned char* vrow = base + SB_V + (32 * kt + 16 * s2) * VST64 + troff;
#pragma unroll
                    for (int vt = 0; vt < 2; ++vt) { const bf16x8 vf = tr2(vrow + vt * 64, vrow + 8 * VST64 + vt * 64); O[vt] = MFMA32(vf, pfr, O[vt]); }
                }
            }
        }
        if (more) { LAS unsigned char* nb = lds + ((it + 1) & 1) * SB_STAGE; *(LAS u32x4*)(nb + dstK) = pk_; *(LAS u32x4*)(nb + dstV) = pv_; }
        const int done = (kbase < q0 + 32 * w + 32) && (carry < 1e-12f);
        const bool wdone = (__builtin_amdgcn_ballot_w64(done != 0) == ~0ull);
        LAS int* flg = (LAS int*)(lds + 2 * SB_STAGE) + (it & 1) * 8;
        if (lane == 0) flg[w] = wdone ? 1 : 0;
        __syncthreads();
        int all = 1;
#pragma unroll
        for (int ww = 0; ww < 8; ++ww) all &= flg[ww];
        if (all) break;
    }
    bf16_t* op = mixed + (rowb + qidx) * DM + 512 + hs * 64;
#pragma unroll
    for (int vt = 0; vt < 2; ++vt)
#pragma unroll
        for (int gq = 0; gq < 4; ++gq) { const int v0 = 32 * vt + 8 * gq + 4 * h;
            u32x2 o; o[0] = pk2(O[vt][4 * gq], O[vt][4 * gq + 1]); o[1] = pk2(O[vt][4 * gq + 2], O[vt][4 * gq + 3]); *(u32x2*)(op + v0) = o; }
    __syncthreads();
}
DI void attn_phase(LAS unsigned char* lds, const Params& p) {
    const bf16_t* proj = (const bf16_t*)(p.ws + O_PROJ); bf16_t* mixed = (bf16_t*)(p.ws + O_MIXED);
    const float lam = *(const float*)(p.ws + O_LAM);
    for (int it0 = blockIdx.x; it0 < 256; it0 += gridDim.x) {
        const int it = (it0 & 7) * 32 + (it0 >> 3);
        const int b = it >> 7, hd = (it >> 5) & 3, pr = it & 31;
        diff_tile(lds, proj, mixed, p.in[7], lam, b, hd, 63 - pr);
        diff_tile(lds, proj, mixed, p.in[7], lam, b, hd, pr);
    }
    for (int it0 = blockIdx.x; it0 < 512; it0 += gridDim.x) {
        const int it = (it0 & 7) * 64 + (it0 >> 3);
        const int b = it >> 8, hs = (it >> 5) & 7, qb = it & 31;
        sb_block(lds, proj, mixed, b, hs, qb);
    }
}
constexpr int SXS = 528, SXS2 = 576, SBS = 272, SBS2 = 320;
constexpr int L_SX = 0, L_SB = 128 * SXS2, L_SC = L_SB + 128 * SBS, L_SDT = L_SC + 128 * SBS, L_SAC = L_SDT + 2048, L_SSQ = L_SAC + 2048;
static_assert(L_SSQ + 4096 <= LDS_BYTES, "lds");

DI void ssd_dt_acum(LAS unsigned char* lds, const float* DT, const float* dt_bias, const float* a_log, size_t t0, int g) {
    LAS float* sdt = (LAS float*)(lds + L_SDT); LAS float* sac = (LAS float*)(lds + L_SAC);
    const int tid = otid(), hh = tid >> 7, l = tid & 127, head = 4 * g + hh, w = tid >> 6, lane = tid & 63;
    const float raw = DT[(t0 + l) * 32 + head] + dt_bias[head];
    const float dt = fmaxf(raw, 0.f) + __logf(1.0f + __expf(-fabsf(raw)));
    sdt[hh * 128 + l] = dt; sac[hh * 128 + l] = -dt * __expf(a_log[head]);
    __syncthreads();
    if (w < 4) {
        const float v0 = sac[w * 128 + 2 * lane], v1 = sac[w * 128 + 2 * lane + 1]; float s = v0 + v1;
#pragma unroll
        for (int off = 1; off < 64; off <<= 1) { const float t = __shfl_up(s, off); if (lane >= off) s += t; }
        const float ex = s - (v0 + v1);
        sac[w * 128 + 2 * lane] = ex + v0; sac[w * 128 + 2 * lane + 1] = ex + v0 + v1;
    }
    __syncthreads();
}
template <int NT, class F> DI void conv_strip(const bf16_t* src, int nzero, const float* cw, const float* cb, int ch, F&& emit) {
    f32x4 wlo[4], whi[4];
#pragma unroll
    for (int k = 0; k < 4; ++k) { wlo[k] = *(const f32x4*)(cw + k * XBCW + ch); whi[k] = *(const f32x4*)(cw + k * XBCW + ch + 4); }
    const f32x4 blo = *(const f32x4*)(cb + ch), bhi = *(const f32x4*)(cb + ch + 4);
    u32x4 raw[NT + 3];
#pragma unroll
    for (int i = 0; i < NT + 3; ++i) { const int ii = (i < nzero) ? nzero : i; raw[i] = *(const u32x4*)(src + (ptrdiff_t)(ii - 3) * XBCW); if (i < nzero) raw[i] = (u32x4){0u, 0u, 0u, 0u}; }
#pragma unroll
    for (int t = 0; t < NT; ++t) {
        float o[8];
#pragma unroll
        for (int e = 0; e < 8; ++e) {
            float a = (e < 4) ? blo[e & 3] : bhi[e & 3];
#pragma unroll
            for (int k = 0; k < 4; ++k) { const unsigned d = raw[t + k][e >> 1]; const float xv = (e & 1) ? bfhi(d) : bflo(d); a += ((e < 4) ? wlo[k][e & 3] : whi[k][e & 3]) * xv; }
            o[e] = fsilu(a);
        }
        emit(t, o);
    }
}
DI u32x4 pack8f(const float* o) { u32x4 r; r[0] = pk2(o[0], o[1]); r[1] = pk2(o[2], o[3]); r[2] = pk2(o[4], o[5]); r[3] = pk2(o[6], o[7]); return r; }

template <bool XW, bool WITH_C> DI void ssd_stage(LAS unsigned char* lds, const bf16_t* xbc, const float* cw, const float* cb, size_t t0, int c, int g) {
    const int tid = otid();
    LAS float* sdt = (LAS float*)(lds + L_SDT); LAS float* sac = (LAS float*)(lds + L_SAC);
    {
        const int c8 = tid & 31, tg = tid >> 5, l0 = 8 * tg, ch = 256 * g + 8 * c8, hh = c8 >> 3;
        const int nzero = (c == 0) ? (3 - l0 > 0 ? 3 - l0 : 0) : 0;
        const float alast = sac[hh * 128 + 127];
        conv_strip<8>(xbc + (t0 + l0) * XBCW + ch, nzero, cw, cb, ch, [&](int t, float* o) {
            if (XW) { const float wgt = sdt[hh * 128 + l0 + t] * __expf(alast - sac[hh * 128 + l0 + t]);
#pragma unroll
                for (int e = 0; e < 8; ++e) o[e] *= wgt; }
            *(LAS u32x4*)(lds + L_SX + (l0 + t) * (XW ? SXS2 : SXS) + c8 * 16) = pack8f(o); });
    }
    {
        const int c8 = tid & 15, tg = tid >> 4, l0 = 4 * tg;
        const int nzero = (c == 0) ? (3 - l0 > 0 ? 3 - l0 : 0) : 0;
        const int chb = DIN + 128 * g + 8 * c8;
        conv_strip<4>(xbc + (t0 + l0) * XBCW + chb, nzero, cw, cb, chb, [&](int t, float* o) { *(LAS u32x4*)(lds + L_SB + (l0 + t) * (XW ? SBS2 : SBS) + c8 * 16) = pack8f(o); });
        if (WITH_C) { const int chc = DIN + 1024 + 128 * g + 8 * c8;
            conv_strip<4>(xbc + (t0 + l0) * XBCW + chc, nzero, cw, cb, chc, [&](int t, float* o) { *(LAS u32x4*)(lds + L_SC + (l0 + t) * SBS + c8 * 16) = pack8f(o); }); }
    }
}
DI bf16_t* st_ptr(unsigned char* ws, int b) { return (bf16_t*)(ws + (b ? O_ST1 : O_ST0)); }

DI void ssd_states_phase(LAS unsigned char* lds, const Params& p) {
    const int tid = otid(), w = __builtin_amdgcn_readfirstlane(tid >> 6), lane = tid & 63, r = lane & 31, h = lane >> 5, hh = w >> 1, ph = w & 1;
    const bf16_t* xbc = (const bf16_t*)(p.ws + O_XBC); const float* DT = (const float*)(p.ws + O_DT); float* cdec = (float*)(p.ws + O_CDEC);
    const int i16 = lane & 15, tq = i16 >> 2, tp = i16 & 3, g16 = (lane >> 4) & 1;
    for (int it = blockIdx.x; it < 1024; it += gridDim.x) {
        const int b = it >> 9, c = (it >> 3) & 63, g = it & 7; const size_t t0 = (size_t)b * SEQ + (size_t)c * 128;
        ssd_dt_acum(lds, DT, p.in[13], p.in[14], t0, g);
        ssd_stage<true, false>(lds, xbc, p.in[11], p.in[12], t0, c, g);
        __syncthreads();
        f32x16 acc[4];
#pragma unroll
        for (int i = 0; i < 4; ++i) acc[i] = zero16();
        const LAS unsigned char* xa = lds + L_SX + (8 * h + tq) * SXS2 + (64 * hh + 32 * ph + 16 * g16 + 4 * tp) * 2;
        const LAS unsigned char* ba = lds + L_SB + (8 * h + tq) * SBS2 + (16 * g16 + 4 * tp) * 2;
#pragma unroll
        for (int s = 0; s < 8; ++s) {
            const bf16x8 af = tr2(xa + 16 * s * SXS2, xa + (16 * s + 4) * SXS2);
#pragma unroll
            for (int nt = 0; nt < 4; ++nt) { const bf16x8 bfr = tr2(ba + 16 * s * SBS2 + nt * 64, ba + (16 * s + 4) * SBS2 + nt * 64); acc[nt] = MFMA32(af, bfr, acc[nt]); }
        }
        bf16_t* st = st_ptr(p.ws, b) + ((size_t)(c * 32 + 4 * g + hh) * 64 + 32 * ph) * 128;
#pragma unroll
        for (int nt = 0; nt < 4; ++nt)
#pragma unroll
            for (int i = 0; i < 16; ++i) st[(size_t)crow(i, h) * 128 + 32 * nt + r] = (bf16_t)(pk2(acc[nt][i], 0.f) & 0xffffu);
        if (tid < 4) cdec[(b * 64 + c) * 32 + 4 * g + tid] = __expf(((LAS float*)(lds + L_SAC))[tid * 128 + 127]);
        __syncthreads();
    }
}
DI void ssd_scan_phase(const Params& p, const bool dry) {
    const float* cdec = (const float*)(p.ws + O_CDEC);
    for (int e = blockIdx.x * 512 + threadIdx.x; e < 2 * 32 * 64 * 32; e += gridDim.x * 512) {
        const int b = e >> 16, rem = e & 65535, head = rem >> 11;
        bf16_t* st = st_ptr(p.ws, b) + (size_t)rem * 4;
        float carry[4] = {0.f, 0.f, 0.f, 0.f};
        for (int c0 = 0; c0 < 64; c0 += 8) {
            u32x2 v[8]; float dc[8];
#pragma unroll
            for (int u = 0; u < 8; ++u) { v[u] = *(const u32x2*)(st + (size_t)(c0 + u) * 262144); dc[u] = cdec[(b * 64 + c0 + u) * 32 + head]; }
#pragma unroll
            for (int u = 0; u < 8; ++u) {
                u32x2 o; o[0] = pk2(carry[0], carry[1]); o[1] = pk2(carry[2], carry[3]); if (!dry) *(u32x2*)(st + (size_t)(c0 + u) * 262144) = o;
                carry[0] = carry[0] * dc[u] + bflo(v[u][0]); carry[1] = carry[1] * dc[u] + bfhi(v[u][0]); carry[2] = carry[2] * dc[u] + bflo(v[u][1]); carry[3] = carry[3] * dc[u] + bfhi(v[u][1]);
            }
        }
    }
}
DI void ssd_out_phase(LAS unsigned char* lds, const Params& p, const bool dry) {
    const int tid = otid(), w = __builtin_amdgcn_readfirstlane(tid >> 6), lane = tid & 63, r = lane & 31, h = lane >> 5, hh = w >> 1, ph = w & 1;
    const bf16_t* xbc = (const bf16_t*)(p.ws + O_XBC); const float* DT = (const float*)(p.ws + O_DT); bf16_t* zy = (bf16_t*)p.out;
    LAS float* sdt = (LAS float*)(lds + L_SDT); LAS float* sac = (LAS float*)(lds + L_SAC); LAS float* ssq = (LAS float*)(lds + L_SSQ);
    const int i16 = lane & 15, tq = i16 >> 2, tp = i16 & 3, g16 = (lane >> 4) & 1;
    for (int it = blockIdx.x; it < 1024; it += gridDim.x) {
        const int b = it >> 9, c = (it >> 3) & 63, g = it & 7, head = 4 * g + hh; const size_t t0 = (size_t)b * SEQ + (size_t)c * 128;
        ssd_dt_acum(lds, DT, p.in[13], p.in[14], t0, g);
        ssd_stage<false, true>(lds, xbc, p.in[11], p.in[12], t0, c, g);
        bf16x8 pvf[8];
        { const bf16_t* pp = st_ptr(p.ws, b) + ((size_t)(c * 32 + head) * 64 + 32 * ph + r) * 128 + 8 * h;
#pragma unroll
          for (int s = 0; s < 8; ++s) pvf[s] = *(const bf16x8*)(pp + 16 * s); }
        __syncthreads();
        f32x16 Y[4];
        const LAS unsigned char* xa = lds + L_SX + (4 * h + tq) * SXS + (64 * hh + 32 * ph + 16 * g16 + 4 * tp) * 2;
#pragma unroll
        for (int lt = 0; lt < 4; ++lt) {
            __builtin_amdgcn_sched_barrier(0);
            f32x16 y = zero16();
#pragma unroll
            for (int s = 0; s < 8; ++s) { const bf16x8 cfs = *(const LAS bf16x8*)(lds + L_SC + (32 * lt + r) * SBS + (16 * s + 8 * h) * 2); y = MFMA32(pvf[s], cfs, y); }
            Y[lt] = y * __expf(sac[hh * 128 + 32 * lt + r]);
        }
#pragma unroll
        for (int lt = 0; lt < 4; ++lt) {
            __builtin_amdgcn_sched_barrier(0);
            bf16x8 cf[8];
#pragma unroll
            for (int s = 0; s < 8; ++s) cf[s] = *(const LAS bf16x8*)(lds + L_SC + (32 * lt + r) * SBS + (16 * s + 8 * h) * 2);
            const float al = sac[hh * 128 + 32 * lt + r];
#pragma unroll
            for (int mt = 0; mt < 4; ++mt) {
                if (mt <= lt) {
                    __builtin_amdgcn_sched_barrier(0);
                    f32x16 X = zero16();
#pragma unroll
                    for (int s = 0; s < 8; ++s) { const bf16x8 bfr = *(const LAS bf16x8*)(lds + L_SB + (32 * mt + r) * SBS + (16 * s + 8 * h) * 2); X = MFMA32(bfr, cf[s], X); }
#pragma unroll
                    for (int gq = 0; gq < 4; ++gq) {
                        const f32x4 am = *(const LAS f32x4*)(sac + hh * 128 + 32 * mt + 8 * gq + 4 * h), dm = *(const LAS f32x4*)(sdt + hh * 128 + 32 * mt + 8 * gq + 4 * h);
#pragma unroll
                        for (int jj = 0; jj < 4; ++jj) { const int mrow = 32 * mt + 8 * gq + 4 * h + jj; const bool ok = (32 * lt + r) >= mrow;
                            const float dec = ok ? __expf(fminf(al - am[jj], 0.f)) * dm[jj] : 0.f; X[4 * gq + jj] *= dec; }
                    }
#pragma unroll
                    for (int s2 = 0; s2 < 2; ++s2) { const bf16x8 xs = pack8(X, s2);
                        const LAS unsigned char* xr = xa + (32 * mt + 16 * s2) * SXS; const bf16x8 xf = tr2(xr, xr + 8 * SXS); Y[lt] = MFMA32(xf, xs, Y[lt]); }
                }
            }
        }
        __builtin_amdgcn_sched_barrier(0);
        const float Dh = p.in[15][head];
        float sq[4];
#pragma unroll
        for (int lt = 0; lt < 4; ++lt) {
            const int l = 32 * lt + r; sq[lt] = 0.f;
#pragma unroll
            for (int gq = 0; gq < 4; ++gq) {
                const int chl = 64 * hh + 32 * ph + 8 * gq + 4 * h;
                const u32x2 xv = *(const LAS u32x2*)(lds + L_SX + l * SXS + chl * 2);
                const u32x2 zv = *(const u32x2*)(zy + (t0 + l) * DIN + 256 * g + chl);
                const float xf4[4] = {bflo(xv[0]), bfhi(xv[0]), bflo(xv[1]), bfhi(xv[1])}, zf4[4] = {bflo(zv[0]), bfhi(zv[0]), bflo(zv[1]), bfhi(zv[1])};
#pragma unroll
                for (int jj = 0; jj < 4; ++jj) { const float yv = (Y[lt][4 * gq + jj] + Dh * xf4[jj]) * fsilu(zf4[jj]); Y[lt][4 * gq + jj] = yv; sq[lt] += yv * yv; }
            }
            sq[lt] += __shfl_xor(sq[lt], 32);
            if (h == 0) ssq[w * 128 + l] = sq[lt];
        }
        __syncthreads();
#pragma unroll
        for (int lt = 0; lt < 4; ++lt) {
            const int l = 32 * lt + r; float tot = 0.f;
#pragma unroll
            for (int ww = 0; ww < 8; ++ww) tot += ssq[ww * 128 + l];
            const float rn = __builtin_amdgcn_rsqf(tot * (1.0f / 256.0f) + 1e-5f);
#pragma unroll
            for (int gq = 0; gq < 4; ++gq) {
                const int chl = 64 * hh + 32 * ph + 8 * gq + 4 * h; const f32x4 gw = *(const f32x4*)(p.in[16] + 256 * g + chl);
                u32x2 o; o[0] = pk2(Y[lt][4 * gq] * rn * gw[0], Y[lt][4 * gq + 1] * rn * gw[1]); o[1] = pk2(Y[lt][4 * gq + 2] * rn * gw[2], Y[lt][4 * gq + 3] * rn * gw[3]);
                if (!dry) *(u32x2*)(zy + (t0 + l) * DIN + 256 * g + chl) = o;
            }
        }
        __syncthreads();
    }
}
DI void dt_proj(LAS unsigned char* lds, const Params& p) {
    const int tid = otid(), w = __builtin_amdgcn_readfirstlane(tid >> 6), lane = tid & 63, r = lane & 31, h = lane >> 5, rt = w & 1, kq = w >> 1;
    const bf16_t* hb = (const bf16_t*)(p.ws + O_HB); const bf16_t* wt = (const bf16_t*)(p.ws + W_SIN) + (size_t)6144 * DM;
    const float* ss = (const float*)(p.ws + O_SS) + 2 * MT; float* dt = (float*)(p.ws + O_DT);
    LAS float* part = (LAS float*)lds;
    for (int rb = blockIdx.x; rb < MT / 64; rb += gridDim.x) {
        const bf16_t* ap = hb + (size_t)(rb * 64 + rt * 32 + r) * DM + kq * 256 + 8 * h;
        const bf16_t* bp = wt + (size_t)r * DM + kq * 256 + 8 * h;
        bf16x8 af[16], bfr[16];
#pragma unroll
        for (int s = 0; s < 16; ++s) { af[s] = *(const bf16x8*)(ap + 16 * s); bfr[s] = *(const bf16x8*)(bp + 16 * s); }
        f32x16 acc = zero16();
#pragma unroll
        for (int s = 0; s < 16; ++s) acc = MFMA32(af[s], bfr[s], acc);
#pragma unroll
        for (int i = 0; i < 16; ++i) part[((kq * 2 + rt) * 32 + crow(i, h)) * 32 + r] = acc[i];
        __syncthreads();
#pragma unroll
        for (int q = 0; q < 4; ++q) {
            const int o = tid + 512 * q, row = o >> 5, col = o & 31;
            float v = 0.f;
#pragma unroll
            for (int k = 0; k < 4; ++k) v += part[((k * 2 + (row >> 5)) * 32 + (row & 31)) * 32 + col];
            const int grow = rb * 64 + row;
            dt[(size_t)grow * 32 + col] = v * __builtin_amdgcn_rsqf(ss[grow] * (1.0f / 1024.0f) + 1e-6f);
        }
        __syncthreads();
    }
}
template <class Epi> DI void run_gemm(LAS unsigned char* lds, const bf16_t* A, const bf16_t* Bt, int N, int K, const Epi& E) {
    pg8::Gemm g; g.A = A; g.Bt = Bt; g.M = MT; g.N = N; g.K = K;
    pg8::StaticOrder S; S.init(MT, N, (int)gridDim.x, (int)blockIdx.x);
    pg8::gemm_phase<Epi, pg8::StaticOrder, false>((PG8_LAS unsigned char*)lds, g, S, E, nullptr);
}
#if defined(DRY_S3) || defined(DRY_S4)
#define DRYV (p.ws == nullptr)
#else
#define DRYV false
#endif
__global__ void __launch_bounds__(512, 2) fwd_megakernel(Params p) {
    extern __shared__ __attribute__((aligned(16))) unsigned char shm[];
    LAS unsigned char* lds = (LAS unsigned char*)shm;
    cg::grid_group grid = cg::this_grid();
    if (threadIdx.x < 4) ((LAS unsigned*)(lds + LDS_BYTES - 16))[threadIdx.x] = 0u;
    __syncthreads();
    const XcdBarrier xbar = xcd_barrier_post((unsigned*)(p.ws + O_BAR), (volatile LAS unsigned*)(lds + LDS_BYTES - 16));
#define GBAR() xcd_barrier(xbar)
    unsigned char* ws = p.ws;
    bf16_t* hb = (bf16_t*)(ws + O_HB); float* ss = (float*)(ws + O_SS);
    phase0(lds, p);
#ifdef DUP_P0
    GBAR(); phase0(lds, p);
#endif
    if (gridDim.x == 0x7fffffffu) grid.sync();
    GBAR();
    { EpiAttnIn E; E.O = (bf16_t*)(ws + O_PROJ); E.ss = ss; E.tab = (const f32x4*)(ws + O_ROPE); run_gemm(lds, hb, (const bf16_t*)(ws + W_AIN), AINW, DM, E); }
    GBAR();
    attn_phase(lds, p);
#ifdef DUP_ATTN
    GBAR(); attn_phase(lds, p);
#endif
    GBAR();
    { EpiRes<true, false> E; E.xres = p.in[0]; E.hb = hb; E.outf = nullptr; E.ssn = ss + MT; run_gemm(lds, (const bf16_t*)(ws + O_MIXED), (const bf16_t*)(ws + W_AOUT), DM, DM, E); }
    GBAR();
    { EpiGU E; E.act = (bf16_t*)(ws + O_ACT); E.ss = ss + MT; run_gemm(lds, hb, (const bf16_t*)(ws + W_GU0), 2 * DFF, DM, E); }
    GBAR();
    { EpiRes<false, false> E; E.xres = nullptr; E.hb = hb; E.outf = nullptr; E.ssn = ss + 2 * MT; run_gemm(lds, (const bf16_t*)(ws + O_ACT), (const bf16_t*)(ws + W_DN0), DM, DFF, E); }
    GBAR();
    { EpiSsdIn E; E.z = (bf16_t*)p.out; E.xbc = (bf16_t*)(ws + O_XBC); E.dt = (float*)(ws + O_DT); E.ss = ss + 2 * MT; dt_proj(lds, p); run_gemm(lds, hb, (const bf16_t*)(ws + W_SIN), 6144, DM, E); }
    GBAR();
    ssd_states_phase(lds, p);
#ifdef DUP_S2
    GBAR(); ssd_states_phase(lds, p);
#endif
    GBAR();
#ifdef DRY_S3
    ssd_scan_phase(p, p.ws != nullptr); GBAR();
#endif
    ssd_scan_phase(p, DRYV);
    GBAR();
#ifdef DRY_S4
    ssd_out_phase(lds, p, p.ws != nullptr); GBAR();
#endif
    ssd_out_phase(lds, p, DRYV);
    GBAR();
    { EpiRes<false, false> E; E.xres = nullptr; E.hb = hb; E.outf = nullptr; E.ssn = ss + 3 * MT; run_gemm(lds, (const bf16_t*)p.out, (const bf16_t*)(ws + W_SOUT), DM, DIN, E); }
    GBAR();
    { EpiGU E; E.act = (bf16_t*)(ws + O_ACT); E.ss = ss + 3 * MT; run_gemm(lds, hb, (const bf16_t*)(ws + W_GU1), 2 * DFF, DM, E); }
    GBAR();
    if (gridDim.x == 256) {
        EpiFinal E; E.hb = hb; E.outf = p.out; E.ssn = ss + 4 * MT; E.cnt = (unsigned*)(ws + O_BAR) + XCD_BAR_WORDS; E.fw = p.in[22];
        run_gemm(lds, (const bf16_t*)(ws + O_ACT), (const bf16_t*)(ws + W_DN1), DM, DFF, E);
    } else {
        { EpiRes<false, true> E; E.xres = nullptr; E.hb = hb; E.outf = p.out; E.ssn = ss + 4 * MT; run_gemm(lds, (const bf16_t*)(ws + O_ACT), (const bf16_t*)(ws + W_DN1), DM, DFF, E); }
        GBAR();
        const float* ss4 = ss + 4 * MT; const f32x4* fw = (const f32x4*)p.in[22]; f32x4* o4 = (f32x4*)p.out;
        for (int i = blockIdx.x * 512 + threadIdx.x; i < MT * (DM / 4); i += gridDim.x * 512) {
            const int row = i >> 8; const float rs = __builtin_amdgcn_rsqf(ss4[row] * (1.0f / 1024.0f) + 1e-6f);
            o4[i] = o4[i] * rs * fw[i & 255];
        }
    }
}

extern "C" void kernel_launch(void* const* d_in, const int* in_sizes, int n_in, void* d_out, int out_size, void* d_ws, size_t ws_size, hipStream_t stream) {
    static int grid_blocks = 0;
    if (!grid_blocks) {
        int dev = 0, cus = 0, per_cu = 0;
        hipGetDevice(&dev);
        hipDeviceGetAttribute(&cus, hipDeviceAttributeMultiprocessorCount, dev);
        if (hipFuncSetAttribute((const void*)fwd_megakernel, hipFuncAttributeMaxDynamicSharedMemorySize, LDS_BYTES) != hipSuccess) fprintf(stderr, "hipFuncSetAttribute failed\n");
        if (hipOccupancyMaxActiveBlocksPerMultiprocessor(&per_cu, (const void*)fwd_megakernel, 512, LDS_BYTES) != hipSuccess || per_cu < 1) { fprintf(stderr, "occupancy query: %d\n", per_cu); per_cu = 1; }
        (void)hipGetLastError();
        grid_blocks = cus * per_cu;
        if (ws_size < 268435456ull || n_in != 23) fprintf(stderr, "unexpected ws_size %zu / n_in %d\n", ws_size, n_in);
    }
    if (hipMemsetAsync((char*)d_ws + O_BAR, 0, 20480, stream) != hipSuccess) fprintf(stderr, "memset failed\n");
    Params p{};
    for (int i = 0; i < 23; ++i) p.in[i] = (const float*)d_in[i];
    p.out = (float*)d_out; p.ws = (unsigned char*)d_ws;
    void* args[] = {&p};
    hipError_t e = hipLaunchCooperativeKernel((const void*)fwd_megakernel, dim3(grid_blocks), dim3(512), args, LDS_BYTES, stream);
    if (e != hipSuccess) fprintf(stderr, "cooperative launch failed: %s (grid %d)\n", hipGetErrorString(e), grid_blocks);
}
#ifdef PHASE_TEST
__global__ void __launch_bounds__(512, 2) t_phase0(Params p) { extern __shared__ __attribute__((aligned(16))) unsigned char shm[]; phase0((LAS unsigned char*)shm, p); }
__global__ void __launch_bounds__(512, 2) t_attn_diff(Params p) { extern __shared__ __attribute__((aligned(16))) unsigned char shm[]; diff_tile((LAS unsigned char*)shm, (const bf16_t*)(p.ws + O_PROJ), (bf16_t*)(p.ws + O_MIXED), p.in[7], 0.3f, blockIdx.x & 1, blockIdx.y, blockIdx.z); }
__global__ void __launch_bounds__(512, 2) t_attn_sb(Params p) { extern __shared__ __attribute__((aligned(16))) unsigned char shm[]; sb_block((LAS unsigned char*)shm, (const bf16_t*)(p.ws + O_PROJ), (bf16_t*)(p.ws + O_MIXED), blockIdx.x & 1, blockIdx.y, blockIdx.z); }
__global__ void __launch_bounds__(512, 2) t_ssd_states(Params p) { extern __shared__ __attribute__((aligned(16))) unsigned char shm[]; ssd_states_phase((LAS unsigned char*)shm, p); }
__global__ void __launch_bounds__(512, 2) t_ssd_scan(Params p) { ssd_scan_phase(p, false); }
__global__ void __launch_bounds__(512, 2) t_ssd_out(Params p) { extern __shared__ __attribute__((aligned(16))) unsigned char shm[]; ssd_out_phase((LAS unsigned char*)shm, p, false); }
__global__ void __launch_bounds__(512, 2) t_gemm_ain(Params p) { extern __shared__ __attribute__((aligned(16))) unsigned char shm[]; EpiAttnIn E; E.O = (bf16_t*)(p.ws + O_PROJ); E.ss = (float*)(p.ws + O_SS); E.tab = (const f32x4*)(p.ws + O_ROPE); run_gemm((LAS unsigned char*)shm, (bf16_t*)(p.ws + O_HB), (const bf16_t*)(p.ws + W_AIN), AINW, DM, E); }
__global__ void __launch_bounds__(512, 2) t_gemm_res(Params p) { extern __shared__ __attribute__((aligned(16))) unsigned char shm[]; EpiRes<false, false> E; E.xres = nullptr; E.hb = (bf16_t*)(p.ws + O_HB); E.outf = nullptr; E.ssn = (float*)(p.ws + O_SS); run_gemm((LAS unsigned char*)shm, (bf16_t*)(p.ws + O_ACT), (const bf16_t*)(p.ws + W_DN0), DM, DFF, E); }
__global__ void __launch_bounds__(512, 2) t_gemm_gu(Params p) { extern __shared__ __attribute__((aligned(16))) unsigned char shm[]; EpiGU E; E.act = (bf16_t*)(p.ws + O_ACT); E.ss = (float*)(p.ws + O_SS); run_gemm((LAS unsigned char*)shm, (bf16_t*)(p.ws + O_HB), (const bf16_t*)(p.ws + W_GU0), 2 * DFF, DM, E); }
__global__ void __launch_bounds__(512, 2) t_gemm_ssdin(Params p) { extern __shared__ __attribute__((aligned(16))) unsigned char shm[]; EpiSsdIn E; E.z = (bf16_t*)p.out; E.xbc = (bf16_t*)(p.ws + O_XBC); E.dt = (float*)(p.ws + O_DT); E.ss = (float*)(p.ws + O_SS); run_gemm((LAS unsigned char*)shm, (bf16_t*)(p.ws + O_HB), (const bf16_t*)(p.ws + W_SIN), SINWP, DM, E); }
#endif
```

```cpp
#include <hip/hip_runtime.h>
#include <hip/hip_cooperative_groups.h>
#include <cstdio>
#include <cstdint>
namespace cg = cooperative_groups;
namespace pg8 {
#define PG8_LAS __attribute__((address_space(3)))
typedef unsigned short bf16_t;
typedef short bf16x8 __attribute__((ext_vector_type(8)));
typedef float f32x4 __attribute__((ext_vector_type(4)));
typedef unsigned u32x4 __attribute__((ext_vector_type(4)));
constexpr int BM = 256, BK = 64, HALF = 128, HTB = HALF * BK * 2  , STAGE_BYTES = 8 * HTB, NXCD = 8, WGM = 8;

__host__ __device__ __forceinline__ int lds_byte(int r, int c) { const int st = (r >> 4) * 2 + (c >> 5), rr = r & 15, cc = c & 31, ob = rr * 64 + cc * 2; return st * 1024 + (ob ^ (((ob >> 9) & 1) << 5)); }
__host__ __device__ __forceinline__ void stage_rc(int b, int& R, int& C) { const int st = b / 1024, sb = b % 1024, swz = sb ^ (((sb >> 9) & 1) << 5); R = (st >> 1) * 16 + swz / 64; C = (st & 1) * 32 + (swz % 64) / 2; }
__host__ __device__ __forceinline__ int perm32(int rho) { const int n = rho >> 4, i = rho & 15; return 8 * (i >> 2) + 4 * n + (i & 3); }

struct Unit { int pm, pn; };
struct Gemm { const bf16_t* A; const bf16_t* Bt; int M, N, K; };

struct StaticOrder {
    int nM, nN, nwg, G, c;
    __host__ __device__ void init(int M, int N, int G_, int c_) { nM = M / BM; nN = N / BM; nwg = nM * nN; G = G_; c = c_; }
    __host__ __device__ bool next(int i, Unit& u) const {
        const long L = (long)i * G + c; if (L >= nwg) return false;
        int wgid = (int)L; { const int q = nwg / NXCD, r = nwg % NXCD, xcd = wgid % NXCD, off = wgid / NXCD; wgid = (xcd < r ? xcd * (q + 1) : r * (q + 1) + (xcd - r) * q) + off; }
        const int nig = WGM * nN, gid = wgid / nig, fm = gid * WGM, gsz = (nM - fm) < WGM ? (nM - fm) : WGM;
        u.pm = fm + ((wgid % nig) % gsz); u.pn = (wgid % nig) / gsz; return true;
    }
    __device__ __forceinline__ void a_ready(const Unit&) const {}
    __device__ __forceinline__ void done(const Unit&) const {}
};

template <class Epi, class Sched, bool STAMP = false>
__device__ __forceinline__ void gemm_phase(PG8_LAS unsigned char* lds, const Gemm g, const Sched& S, const Epi& E, unsigned long long* stamps) {
    int tid_ = threadIdx.x; asm volatile("" : "+v"(tid_)); const int tid = tid_, wid = __builtin_amdgcn_readfirstlane(tid >> 6), lane = tid & 63, wr = wid >> 2, wc = wid & 3, fr = lane & 15, fq = lane >> 4;
    const int K = g.K, nt = K / BK;
    int ts_lo = 0, ts_hi = 0, nts = 0; const unsigned long long rt_entry = STAMP ? (unsigned long long)wall_clock64() : 0ull;
#define PG8_STAMP() do { if (STAMP && wid == 0 && nts < 64) { const unsigned long long _c = (unsigned long long)clock64(); \
        ts_lo = (lane == nts) ? (int)(unsigned)_c : ts_lo; ts_hi = (lane == nts) ? (int)(unsigned)(_c >> 32) : ts_hi; ++nts; } } while (0)
    PG8_STAMP();
    unsigned voffA[2], voffB[2];
#pragma unroll
    for (int i = 0; i < 2; ++i) { int R, C; stage_rc(tid * 16 + i * 8192, R, C); const int Rb = Epi::PERM ? ((R & ~31) + perm32(R & 31)) : R;
        voffA[i] = (unsigned)(R * K + C) * 2u; voffB[i] = (unsigned)(Rb * K + C) * 2u; }
    const size_t kstep = (size_t)(BK * 2);
    const size_t hstep = (size_t)HALF * K * 2;
    const size_t tstep = 2 * hstep;
    const unsigned ldsw = (unsigned)wid * 1024u;
    const int aoff = lds_byte(wr * 64 + fr, fq * 8), boff = lds_byte(wc * 32 + fr, fq * 8);
#define PG8_SA(b, h) (((b) * 2 + (h)) * HTB)
#define PG8_SB(b, h) ((4 + (b) * 2 + (h)) * HTB)
#define PG8_STAGE(bufoff, gbase, voff) do { _Pragma("unroll") for (int _i = 0; _i < 2; ++_i) \
        __builtin_amdgcn_global_load_lds((const unsigned*)((const char*)(gbase) + (voff)[_i]), (PG8_LAS unsigned*)(lds + (bufoff) + ldsw + _i * 8192), 16, 0, 0); } while (0)
#define PG8_LDA(dst, b, h) do { _Pragma("unroll") for (int m = 0; m < 4; ++m) _Pragma("unroll") for (int k = 0; k < 2; ++k) dst[m][k] = *(const PG8_LAS bf16x8*)(lds + PG8_SA(b, h) + aoff + m * 2048 + k * 1024); } while (0)
#define PG8_LDB(dst, b, h) do { _Pragma("unroll") for (int n = 0; n < 2; ++n) _Pragma("unroll") for (int k = 0; k < 2; ++k) dst[n][k] = *(const PG8_LAS bf16x8*)(lds + PG8_SB(b, h) + boff + n * 2048 + k * 1024); } while (0)
#define PG8_MMA(ai, bj, At, Bt) do { __builtin_amdgcn_s_setprio(1); _Pragma("unroll") for (int m = 0; m < 4; ++m) _Pragma("unroll") for (int n = 0; n < 2; ++n) _Pragma("unroll") for (int k = 0; k < 2; ++k) \
        acc[ai][bj][m][n] = __builtin_amdgcn_mfma_f32_16x16x32_bf16(Bt[n][k], At[m][k], acc[ai][bj][m][n], 0, 0, 0); __builtin_amdgcn_s_setprio(0); } while (0)
#define PG8_WAIT_V(n) asm volatile("s_waitcnt vmcnt(" #n ")" ::: "memory")
#define PG8_WAIT_L(n) asm volatile("s_waitcnt lgkmcnt(" #n ")" ::: "memory")
#define PG8_BAR __builtin_amdgcn_s_barrier()
#define PG8_SCHED __builtin_amdgcn_sched_barrier(0)
    Unit cur, nxt; int ui = 0;
    if (!S.next(0, cur)) return;
    f32x4 acc[2][2][4][2];
#pragma unroll
    for (int a = 0; a < 2; ++a)
#pragma unroll
        for (int b = 0; b < 2; ++b)
#pragma unroll
            for (int m = 0; m < 4; ++m)
#pragma unroll
                for (int n = 0; n < 2; ++n) acc[a][b][m][n] = (f32x4){0.f, 0.f, 0.f, 0.f};
    bf16x8 At[4][2], B0[2][2], B1[2][2];
    const char* cA = (const char*)g.A + (size_t)cur.pm * tstep; const char* cB = (const char*)g.Bt + (size_t)cur.pn * tstep;
    S.a_ready(cur);
    PG8_STAGE(PG8_SB(0, 0), cB, voffB); PG8_STAGE(PG8_SA(0, 0), cA, voffA); PG8_STAGE(PG8_SB(0, 1), cB + hstep, voffB); PG8_STAGE(PG8_SA(0, 1), cA + hstep, voffA);
    if (wr == 1) PG8_BAR;
    PG8_WAIT_V(4); PG8_BAR;
    PG8_STAGE(PG8_SB(1, 0), cB + kstep, voffB); PG8_STAGE(PG8_SA(1, 0), cA + kstep, voffA); PG8_STAGE(PG8_SB(1, 1), cB + hstep + kstep, voffB);
    PG8_WAIT_V(6); PG8_BAR;
    PG8_STAMP();
    for (;;) {
        const bool has_next = S.next(ui + 1, nxt);
        const char* nA = has_next ? (const char*)g.A + (size_t)nxt.pm * tstep : cA; const char* nB = has_next ? (const char*)g.Bt + (size_t)nxt.pn * tstep : cB;
        for (int t = 0; t < nt; t += 2) {
            const bool last = (t == nt - 2);
            const char* a1 = cA + (size_t)(t + 1) * kstep;
            const char* a2 = last ? nA : cA + (size_t)(t + 2) * kstep; const char* b2 = last ? nB : cB + (size_t)(t + 2) * kstep;
            const char* a3 = a2 + kstep; const char* b3 = b2 + kstep;
            if (last && has_next) S.a_ready(nxt);
            PG8_LDB(B0, 0, 0); PG8_SCHED; PG8_LDA(At, 0, 0); PG8_STAGE(PG8_SA(1, 1), a1 + hstep, voffA);
            PG8_WAIT_L(8); PG8_BAR; PG8_WAIT_L(0); PG8_MMA(0, 0, At, B0); PG8_BAR; PG8_SCHED;
            PG8_LDB(B1, 0, 1); PG8_STAGE(PG8_SB(0, 0), b2, voffB);
            PG8_BAR; PG8_WAIT_L(0); PG8_MMA(0, 1, At, B1); PG8_BAR;
            PG8_LDA(At, 0, 1); PG8_STAGE(PG8_SA(0, 0), a2, voffA);
            PG8_BAR; PG8_WAIT_L(0); PG8_MMA(1, 0, At, B0); PG8_BAR; PG8_SCHED;
            PG8_STAGE(PG8_SB(0, 1), b2 + hstep, voffB);
            PG8_WAIT_V(6); PG8_BAR; PG8_MMA(1, 1, At, B1); PG8_BAR;
            PG8_LDB(B0, 1, 0); PG8_SCHED; PG8_LDA(At, 1, 0); PG8_STAGE(PG8_SA(0, 1), a2 + hstep, voffA);
            PG8_WAIT_L(8); PG8_BAR; PG8_WAIT_L(0); PG8_MMA(0, 0, At, B0); PG8_BAR; PG8_SCHED;
            PG8_LDB(B1, 1, 1); PG8_STAGE(PG8_SB(1, 0), b3, voffB);
            PG8_BAR; PG8_WAIT_L(0); PG8_MMA(0, 1, At, B1); PG8_BAR;
            PG8_LDA(At, 1, 1); PG8_STAGE(PG8_SA(1, 0), a3, voffA);
            PG8_BAR; PG8_WAIT_L(0); PG8_MMA(1, 0, At, B0); PG8_BAR; PG8_SCHED;
            PG8_STAGE(PG8_SB(1, 1), b3 + hstep, voffB);
            PG8_WAIT_V(6); PG8_BAR; PG8_MMA(1, 1, At, B1); PG8_BAR;
        }
        PG8_STAMP();
        if constexpr (!Epi::AFTER_DRAIN) { E(acc, cur, wr, wc, fr, fq); S.done(cur); }
        PG8_STAMP();
        if (!has_next) break;
#pragma unroll
        for (int a = 0; a < 2; ++a)
#pragma unroll
            for (int b = 0; b < 2; ++b)
#pragma unroll
                for (int m = 0; m < 4; ++m)
#pragma unroll
                    for (int n = 0; n < 2; ++n) acc[a][b][m][n] = (f32x4){0.f, 0.f, 0.f, 0.f};
        cur = nxt; cA = nA; cB = nB; ++ui;
    }
    PG8_WAIT_V(0);
    if (wr == 0) PG8_BAR;
    PG8_BAR;
    if constexpr (Epi::AFTER_DRAIN) { E.fused(acc, cur, wr, wc, fr, fq, lds, wid, lane); S.done(cur); }
    PG8_STAMP();
    if (STAMP && wid == 0) { stamps[lane] = lane < nts ? (((unsigned long long)(unsigned)ts_hi << 32) | (unsigned)ts_lo) : 0ull;
        if (lane == 62) stamps[62] = rt_entry; if (lane == 63) stamps[63] = (unsigned long long)wall_clock64(); }
#undef PG8_STAMP
#undef PG8_SA
#undef PG8_SB
#undef PG8_STAGE
#undef PG8_LDA
#undef PG8_LDB
#undef PG8_MMA
#undef PG8_WAIT_V
#undef PG8_WAIT_L
#undef PG8_BAR
#undef PG8_SCHED
}
}
using pg8::bf16_t; using pg8::bf16x8; using pg8::f32x4;
typedef short s16x4 __attribute__((ext_vector_type(4)));
typedef float f32x16 __attribute__((ext_vector_type(16)));
typedef float f32x2 __attribute__((ext_vector_type(2)));
typedef __bf16 bf2_t __attribute__((ext_vector_type(2)));
typedef unsigned u32x2 __attribute__((ext_vector_type(2)));
typedef unsigned u32x4 __attribute__((ext_vector_type(4)));
#define LAS __attribute__((address_space(3)))
#define DI __device__ __forceinline__
#define MFMA32(a, b, c) __builtin_amdgcn_mfma_f32_32x32x16_bf16((a), (b), (c), 0, 0, 0)

DI int otid() { int t = threadIdx.x; asm volatile("" : "+v"(t)); return t; }
DI unsigned pk2(float a, float b) { f32x2 v = {a, b}; bf2_t r = __builtin_convertvector(v, bf2_t); return __builtin_bit_cast(unsigned, r); }
DI float bflo(unsigned u) { return __uint_as_float(u << 16); }
DI float bfhi(unsigned u) { return __uint_as_float(u & 0xffff0000u); }
DI float fexp2(float x) { return __builtin_amdgcn_exp2f(x); }
DI float frcp(float x) { return __builtin_amdgcn_rcpf(x); }
DI float fsilu(float x) { return x * frcp(1.0f + fexp2(-1.44269504089f * x)); }
DI int crow(int i, int h) { return (i & 3) + 8 * (i >> 2) + 4 * h; }
DI s16x4 trr(const LAS unsigned char* p) { return __builtin_amdgcn_ds_read_tr16_b64_v4i16((LAS s16x4*)p); }
DI bf16x8 tr2(const LAS unsigned char* p0, const LAS unsigned char* p1) { s16x4 a = trr(p0), b = trr(p1); return __builtin_shufflevector(a, b, 0, 1, 2, 3, 4, 5, 6, 7); }
DI bf16x8 pack8(const f32x16& x, int s) {
    u32x4 p; p[0] = pk2(x[8 * s], x[8 * s + 1]); p[1] = pk2(x[8 * s + 2], x[8 * s + 3]); p[2] = pk2(x[8 * s + 4], x[8 * s + 5]); p[3] = pk2(x[8 * s + 6], x[8 * s + 7]);
    return __builtin_bit_cast(bf16x8, p);
}
DI f32x16 zero16() { f32x16 z; for (int i = 0; i < 16; ++i) z[i] = 0.f; return z; }

constexpr int MT = 16384, SEQ = 8192, DM = 1024, DFF = 2816, AINW = 3072, SINW = 6176, SINWP = 6400, DIN = 2048, XBCW = 4096;
constexpr float LOG2E = 1.44269504089f;
constexpr int LDS_BYTES = 155648;
constexpr size_t W_AIN = 0, W_AOUT = W_AIN + (size_t)AINW * DM * 2, W_GU0 = W_AOUT + (size_t)DM * DM * 2, W_DN0 = W_GU0 + (size_t)2 * DFF * DM * 2,
                 W_SIN = W_DN0 + (size_t)DM * DFF * 2, W_SOUT = W_SIN + (size_t)SINWP * DM * 2, W_GU1 = W_SOUT + (size_t)DM * DIN * 2, W_DN1 = W_GU1 + (size_t)2 * DFF * DM * 2,
                 O_HB = W_DN1 + (size_t)DM * DFF * 2, O_SS = O_HB + (size_t)MT * DM * 2, O_ROPE = O_SS + (size_t)5 * MT * 4, O_DT = O_ROPE + (size_t)SEQ * 32 * 8,
                 O_CDEC = O_DT + (size_t)MT * 32 * 4, O_LAM = O_CDEC + 16384, O_BAR = O_LAM + 256, O_R = 98566144;
static_assert(O_BAR + 20480 <= O_R, "map");
constexpr size_t O_PROJ = O_R, O_MIXED = O_PROJ + (size_t)MT * AINW * 2, O_ACT = O_R, O_XBC = O_R, O_ST1 = O_XBC + (size_t)MT * XBCW * 2, O_ST0 = 0;
constexpr size_t ST_BATCH = (size_t)64 * 32 * 64 * 128;
static_assert(O_ST1 + ST_BATCH * 2 <= 268435456ull, "ws");
static_assert(ST_BATCH * 2 <= W_SOUT, "st0 overlay");
static_assert(O_MIXED + (size_t)MT * DM * 2 <= 268435456ull, "ws2");

struct Params { const float* in[23]; float* out; unsigned char* ws; };
#include <cstdlib>
#include <vector>

#define XB_TMO      128
#define XB_XCNT(j)  (256  + 64 * (j))
#define XB_XSUB(j)  (1280 + 64 * (j))
#define XB_XGEN(j)  (2304 + 64 * (j))
#define XB_TOP      3328
#define XB_TOPGEN   3392
#define XCD_BAR_WORDS 3456
#define XB_SPIN_CAP (1u << 18)

__device__ __forceinline__ unsigned xb_ld(unsigned* p)              { return __hip_atomic_load(p, __ATOMIC_RELAXED, __HIP_MEMORY_SCOPE_AGENT); }
__device__ __forceinline__ unsigned xb_add(unsigned* p, unsigned v) { return __hip_atomic_fetch_add(p, v, __ATOMIC_RELAXED, __HIP_MEMORY_SCOPE_AGENT); }
__device__ __forceinline__ unsigned xb_xcc_id() { return (unsigned)__builtin_amdgcn_s_getreg((3 << 11) | 20) & 0xFu; }
#define XB_SPIN(cond, bar) do { unsigned _sp = 0; while (cond) { __builtin_amdgcn_s_sleep(1); \
    if ((++_sp & 255u) == 0u) { if (xb_ld(&(bar)[XB_TMO])) break; if (_sp > XB_SPIN_CAP) { atomicAdd(&(bar)[XB_TMO], 1u); break; } } } } while (0)

struct XcdBarrier {
    unsigned* bar; unsigned x;
    volatile LAS unsigned* st;
};

__device__ __forceinline__ XcdBarrier xcd_barrier_post(unsigned* bar, volatile LAS unsigned* st) {
    XcdBarrier b; b.bar = bar; b.x = xb_xcc_id(); b.st = st;
    if (threadIdx.x == 0) (void)xb_add(&bar[XB_XCNT(b.x)], 1u);
    return b;
}
__device__ __forceinline__ void xcd_barrier_complete(unsigned* bar, unsigned x, unsigned& nloc, unsigned& nx) {
    const unsigned G = gridDim.x * gridDim.y * gridDim.z;
    unsigned sum, cnt, mine, sp = 0u;
    for (;;) {
        sum = 0u; cnt = 0u; mine = 0u;
#pragma unroll
        for (unsigned j = 0; j < 16; ++j) { const unsigned c = xb_ld(&bar[XB_XCNT(j)]); sum += c; cnt += (c > 0u) ? 1u : 0u; mine = (j == x) ? c : mine; }
        if (sum == G) break;
        __builtin_amdgcn_s_sleep(1);
        if ((++sp & 255u) == 0u) { if (xb_ld(&bar[XB_TMO])) break; if (sp > XB_SPIN_CAP) { atomicAdd(&bar[XB_TMO], 1u); break; } }
    }
    nloc = mine > 0u ? mine : 1u; nx = cnt > 0u ? cnt : 1u;
}

__device__ __forceinline__ void xcd_barrier(const XcdBarrier& b) {
    asm volatile("s_waitcnt vmcnt(0)" ::: "memory");
    __syncthreads();
    if (threadIdx.x == 0) {
        unsigned* bar = b.bar;
        __builtin_amdgcn_s_waitcnt(0);
        unsigned nloc = b.st[0], nx = b.st[1];
        if (nloc == 0u) { xcd_barrier_complete(bar, b.x, nloc, nx); b.st[0] = nloc; b.st[1] = nx; }
        const unsigned old = xb_add(&bar[XB_XSUB(b.x)], 1u);
        const unsigned gen = old / nloc;
        if (old + 1u == (gen + 1u) * nloc) {
            __builtin_amdgcn_fence(__ATOMIC_RELEASE, "agent");
            asm volatile("s_waitcnt vmcnt(0)" ::: "memory");
            const unsigned og = xb_add(&bar[XB_TOP], 1u);
            const unsigned tg = og / nx;
            if (og + 1u == (tg + 1u) * nx) xb_add(&bar[XB_TOPGEN], 1u);
            else XB_SPIN(xb_ld(&bar[XB_TOPGEN]) == tg, bar);
            __builtin_amdgcn_fence(__ATOMIC_ACQUIRE, "agent");
            xb_add(&bar[XB_XGEN(b.x)], 1u);
            asm volatile("s_waitcnt vmcnt(0)" ::: "memory");
        } else {
            XB_SPIN(xb_ld(&bar[XB_XGEN(b.x)]) == gen, bar);
            __builtin_amdgcn_fence(__ATOMIC_ACQUIRE, "agent");
            asm volatile("s_waitcnt vmcnt(0)" ::: "memory");
        }
    }
    __syncthreads();
}
DI void wmap(int mode, int c, int& src, float& scale, int& which) {
    src = c; scale = 1.f; which = 0;
    if (mode == 0) {
        if (c < 1024) { const int base = c & ~63, cc = c & 63, g = cc >> 3, e = cc & 7; src = base + (e < 4 ? 4 * g + e : 32 + 4 * g + (e - 4)); }
        if (c < 512) scale = 0.125f * LOG2E; else if (c >= 1536 && c < 2048) scale = 0.125f;
    } else if (mode == 2) { src = 4 * (c >> 3) + (c & 3); which = (c >> 2) & 1; }
    else if (mode == 3) { if (c >= SINW) src = -1; }
}
struct WJob { int mode, K, ldw, tix; const float* W0; const float* W1; const float* ks; bf16_t* dst; };
DI WJob wjob(const Params& p, int t) {
    unsigned char* ws = p.ws;
    const int cnt[8] = {48 * 4, 16 * 4, 88 * 4, 16 * 11, 100 * 4, 16 * 8, 88 * 4, 16 * 11};
    int j = 0, tt = t;
#pragma unroll
    for (int q = 0; q < 7; ++q) if (j == q && tt >= cnt[q]) { tt -= cnt[q]; j = q + 1; }
    WJob J; J.tix = tt; J.W1 = nullptr; J.ks = nullptr;
    switch (j) {
    case 0: J.mode = 0; J.W0 = p.in[2]; J.ks = p.in[1]; J.dst = (bf16_t*)(ws + W_AIN); J.K = DM; J.ldw = AINW; break;
    case 1: J.mode = 1; J.W0 = p.in[8]; J.dst = (bf16_t*)(ws + W_AOUT); J.K = DM; J.ldw = DM; break;
    case 2: J.mode = 2; J.W0 = p.in[19]; J.W1 = p.in[20]; J.ks = p.in[18]; J.dst = (bf16_t*)(ws + W_GU0); J.K = DM; J.ldw = DFF; break;
    case 3: J.mode = 1; J.W0 = p.in[21]; J.dst = (bf16_t*)(ws + W_DN0); J.K = DFF; J.ldw = DM; break;
    case 4: J.mode = 3; J.W0 = p.in[10]; J.ks = p.in[9]; J.dst = (bf16_t*)(ws + W_SIN); J.K = DM; J.ldw = SINW; break;
    case 5: J.mode = 1; J.W0 = p.in[17]; J.dst = (bf16_t*)(ws + W_SOUT); J.K = DIN; J.ldw = DM; break;
    case 6: J.mode = 2; J.W0 = p.in[19] + (size_t)DM * DFF; J.W1 = p.in[20] + (size_t)DM * DFF; J.ks = p.in[18] + DM; J.dst = (bf16_t*)(ws + W_GU1); J.K = DM; J.ldw = DFF; break;
    default: J.mode = 1; J.W0 = p.in[21] + (size_t)DFF * DM; J.dst = (bf16_t*)(ws + W_DN1); J.K = DFF; J.ldw = DM; break;
    }
    return J;
}
DI void wtile_load(const WJob& J, int tid, float (&v)[32], float& sc, int& srcok) {
    const int nk = J.K >> 8, c0 = (J.tix / nk) * 64, k0 = (J.tix % nk) * 256, cc = tid & 63; int src, which; wmap(J.mode, c0 + cc, src, sc, which);
    const float* W = (which ? J.W1 : J.W0) + (src >= 0 ? src : 0); srcok = (src >= 0);
#pragma unroll
    for (int i = 0; i < 32; ++i) { const int kk = (tid >> 6) + 8 * i; v[i] = W[(size_t)(k0 + kk) * J.ldw]; }
}
DI void wtile_store(LAS float* tile, const WJob& J, int tid, const float (&v)[32], float sc, int srcok) {
    const int nk = J.K >> 8, c0 = (J.tix / nk) * 64, k0 = (J.tix % nk) * 256, cc = tid & 63;
#pragma unroll
    for (int i = 0; i < 32; ++i) { const int kk = (tid >> 6) + 8 * i; float x = srcok ? v[i] * sc : 0.f; if (J.ks) x *= J.ks[k0 + kk]; tile[kk * 65 + cc] = x; }
    __syncthreads();
#pragma unroll
    for (int i = 0; i < 16; ++i) {
        const int idx = tid + 512 * i, c2 = idx >> 7, k2 = (idx & 127) * 2;
        *(unsigned*)(J.dst + (size_t)(c0 + c2) * J.K + k0 + k2) = pk2(tile[k2 * 65 + c2], tile[(k2 + 1) * 65 + c2]);
    }
    __syncthreads();
}
DI void wconv_jobs(LAS unsigned char* lds, const Params& p, int wi, int nb) {
    const int tid = otid(); const int total = 48 * 4 + 16 * 4 + 2 * (88 * 4 + 16 * 11) + 100 * 4 + 16 * 8;
    if (wi >= total) return;
    WJob J = wjob(p, wi); float v[32]; float sc; int ok;
    wtile_load(J, tid, v, sc, ok);
    for (int t = wi; t < total; t += nb) {
        const bool more = (t + nb < total);
        WJob Jn = J; float vn[32]; float scn = 0.f; int okn = 0;
        if (more) { Jn = wjob(p, t + nb); wtile_load(Jn, tid, vn, scn, okn); }
        wtile_store((LAS float*)lds, J, tid, v, sc, ok);
        if (more) { J = Jn; sc = scn; ok = okn;
#pragma unroll
            for (int i = 0; i < 32; ++i) v[i] = vn[i]; }
    }
}
DI void phase0(LAS unsigned char* lds, const Params& p) {
    const int tid = otid(), G = gridDim.x, bx = blockIdx.x;
    unsigned char* ws = p.ws;
    wconv_jobs(lds, p, bx, G);
    {
        const int wave = tid >> 6, lane = tid & 63; bf16_t* hb = (bf16_t*)(ws + O_HB); float* ss = (float*)(ws + O_SS);
        for (int row0 = (bx * 8 + wave) * 2; row0 < MT; row0 += G * 16) {
            f32x4 v[2][4];
#pragma unroll
            for (int q = 0; q < 2; ++q)
#pragma unroll
                for (int i = 0; i < 4; ++i) v[q][i] = *(const f32x4*)(p.in[0] + (size_t)(row0 + q) * DM + lane * 4 + 256 * i);
#pragma unroll
            for (int q = 0; q < 2; ++q) {
                float sq = 0.f;
#pragma unroll
                for (int i = 0; i < 4; ++i) { const f32x4 x = v[q][i]; sq += x[0] * x[0] + x[1] * x[1] + x[2] * x[2] + x[3] * x[3];
                    u32x2 o; o[0] = pk2(x[0], x[1]); o[1] = pk2(x[2], x[3]); *(u32x2*)(hb + (size_t)(row0 + q) * DM + lane * 4 + 256 * i) = o; }
#pragma unroll
                for (int o = 32; o >= 1; o >>= 1) sq += __shfl_xor(sq, o);
                if (lane == 0) ss[row0 + q] = sq;
            }
        }
        for (int i = bx * 512 + tid; i < 4 * MT; i += G * 512) ss[MT + i] = 0.f;
        f32x2* tab = (f32x2*)(ws + O_ROPE);
        for (int i = bx * 512 + tid; i < SEQ * 32; i += G * 512) {
            const int pos = i >> 5, f = i & 31; const float inv = fexp2(-(float)f * 0.41524101186092f); const float ang = (float)pos * inv;
            double t = (double)ang * 0.15915494309189535; t -= floor(t); const float tf = (float)t;
            f32x2 cs; cs[0] = __builtin_amdgcn_cosf(tf); cs[1] = __builtin_amdgcn_sinf(tf); tab[i] = cs;
        }
        if (bx == 0 && tid == 0) { float s1 = 0.f, s2 = 0.f; for (int i = 0; i < 64; ++i) { s1 += p.in[3][i] * p.in[4][i]; s2 += p.in[5][i] * p.in[6][i]; }
            *(float*)(ws + O_LAM) = fexp2(s1 * LOG2E) - fexp2(s2 * LOG2E) + 0.2f; }
    }
}

struct EpiAttnIn {
    static constexpr bool PERM = true, AFTER_DRAIN = false;
    bf16_t* O; const float* ss; const f32x4* tab;
    DI void operator()(const f32x4 (&acc)[2][2][4][2], const pg8::Unit& u, int wr, int wc, int fr, int fq) const {
        const int row0 = u.pm * 256 + wr * 64 + fr, colt = u.pn * 256, col0 = colt + wc * 32 + 8 * fq;
        const int fb = 4 * (4 * (wc & 1) + fq);
#pragma unroll
        for (int ai = 0; ai < 2; ++ai)
#pragma unroll
            for (int m = 0; m < 4; ++m) {
                const int row = row0 + ai * 128 + m * 16; const float rs = __builtin_amdgcn_rsqf(ss[row] * (1.0f / 1024.0f) + 1e-6f);
                f32x4 c01 = {1.f, 0.f, 1.f, 0.f}, c23 = {1.f, 0.f, 1.f, 0.f};
                if (colt < 1024) { const int pos = row & (SEQ - 1); c01 = tab[(pos * 32 + fb) >> 1]; c23 = tab[((pos * 32 + fb) >> 1) + 1]; }
#pragma unroll
                for (int bj = 0; bj < 2; ++bj) {
                    f32x4 v0 = acc[ai][bj][m][0] * rs, v1 = acc[ai][bj][m][1] * rs;
                    if (colt < 1024) {
                        const float cs[4] = {c01[0], c01[2], c23[0], c23[2]}, sn[4] = {c01[1], c01[3], c23[1], c23[3]};
#pragma unroll
                        for (int j = 0; j < 4; ++j) { const float t1 = v0[j], t2 = v1[j]; v0[j] = t1 * cs[j] - t2 * sn[j]; v1[j] = t2 * cs[j] + t1 * sn[j]; }
                    }
                    u32x4 o; o[0] = pk2(v0[0], v0[1]); o[1] = pk2(v0[2], v0[3]); o[2] = pk2(v1[0], v1[1]); o[3] = pk2(v1[2], v1[3]);
                    *(u32x4*)(O + (size_t)row * AINW + col0 + bj * 128) = o;
                }
            }
    }
};
template <bool RES_F32, bool OUT_F32> struct EpiRes {
    static constexpr bool PERM = false, AFTER_DRAIN = false;
    const float* xres; bf16_t* hb; float* outf; float* ssn;
    DI void operator()(const f32x4 (&acc)[2][2][4][2], const pg8::Unit& u, int wr, int wc, int fr, int fq) const {
        const int row0 = u.pm * 256 + wr * 64 + fr, col0 = u.pn * 256 + wc * 32 + 4 * fq;
#pragma unroll
        for (int ai = 0; ai < 2; ++ai)
#pragma unroll
            for (int m = 0; m < 4; ++m) {
                const int row = row0 + ai * 128 + m * 16; float sq = 0.f;
#pragma unroll
                for (int bj = 0; bj < 2; ++bj)
#pragma unroll
                    for (int n = 0; n < 2; ++n) {
                        const size_t off = (size_t)row * DM + col0 + bj * 128 + n * 16; f32x4 r;
                        if (RES_F32) r = *(const f32x4*)(xres + off);
                        else { const u32x2 t = *(const u32x2*)(hb + off); r[0] = bflo(t[0]); r[1] = bfhi(t[0]); r[2] = bflo(t[1]); r[3] = bfhi(t[1]); }
                        const f32x4 v = r + acc[ai][bj][m][n];
                        sq += v[0] * v[0] + v[1] * v[1] + v[2] * v[2] + v[3] * v[3];
                        if (OUT_F32) *(f32x4*)(outf + off) = v;
                        else { u32x2 o; o[0] = pk2(v[0], v[1]); o[1] = pk2(v[2], v[3]); *(u32x2*)(hb + off) = o; }
                    }
                sq += __shfl_xor(sq, 16); sq += __shfl_xor(sq, 32);
                if (fq == 0) atomicAdd(ssn + row, sq);
            }
    }
};
struct EpiGU {
    static constexpr bool PERM = true, AFTER_DRAIN = false;
    bf16_t* act; const float* ss;
    DI void operator()(const f32x4 (&acc)[2][2][4][2], const pg8::Unit& u, int wr, int wc, int fr, int fq) const {
        const int row0 = u.pm * 256 + wr * 64 + fr, col0 = u.pn * 256 + wc * 32 + 8 * fq;
#pragma unroll
        for (int ai = 0; ai < 2; ++ai)
#pragma unroll
            for (int m = 0; m < 4; ++m) {
                const int row = row0 + ai * 128 + m * 16; const float rs = __builtin_amdgcn_rsqf(ss[row] * (1.0f / 1024.0f) + 1e-6f);
#pragma unroll
                for (int bj = 0; bj < 2; ++bj) {
                    const f32x4 g = acc[ai][bj][m][0] * rs, up = acc[ai][bj][m][1] * rs; float a[4];
#pragma unroll
                    for (int j = 0; j < 4; ++j) a[j] = fsilu(g[j]) * up[j];
                    u32x2 o; o[0] = pk2(a[0], a[1]); o[1] = pk2(a[2], a[3]);
                    *(u32x2*)(act + (size_t)row * DFF + ((col0 + bj * 128) >> 1)) = o;
                }
            }
    }
};
struct EpiSsdIn {
    static constexpr bool PERM = true, AFTER_DRAIN = false;
    bf16_t* z; bf16_t* xbc; float* dt; const float* ss;
    DI void operator()(const f32x4 (&acc)[2][2][4][2], const pg8::Unit& u, int wr, int wc, int fr, int fq) const {
        const int row0 = u.pm * 256 + wr * 64 + fr, col0 = u.pn * 256 + wc * 32 + 8 * fq;
#pragma unroll
        for (int ai = 0; ai < 2; ++ai)
#pragma unroll
            for (int m = 0; m < 4; ++m) {
                const int row = row0 + ai * 128 + m * 16; const float rs = __builtin_amdgcn_rsqf(ss[row] * (1.0f / 1024.0f) + 1e-6f);
#pragma unroll
                for (int bj = 0; bj < 2; ++bj) {
                    const int c = col0 + bj * 128; const f32x4 v0 = acc[ai][bj][m][0] * rs, v1 = acc[ai][bj][m][1] * rs;
                    if (c < 6144) { u32x4 o; o[0] = pk2(v0[0], v0[1]); o[1] = pk2(v0[2], v0[3]); o[2] = pk2(v1[0], v1[1]); o[3] = pk2(v1[2], v1[3]);
                        if (c < DIN) *(u32x4*)(z + (size_t)row * DIN + c) = o; else *(u32x4*)(xbc + (size_t)row * XBCW + (c - DIN)) = o; }
                }
            }
    }
};

struct EpiFinal {
    static constexpr bool PERM = false, AFTER_DRAIN = true;
    const bf16_t* hb; float* outf; float* ssn; unsigned* cnt; const float* fw;
    DI void operator()(const f32x4 (&)[2][2][4][2], const pg8::Unit&, int, int, int, int) const {}
    DI void fused(f32x4 (&acc)[2][2][4][2], const pg8::Unit& u, int wr, int wc, int fr, int fq, PG8_LAS unsigned char*, int, int) const {
        const int row0 = u.pm * 256 + wr * 64 + fr, col0 = u.pn * 256 + wc * 32 + 4 * fq;
#pragma unroll
        for (int ai = 0; ai < 2; ++ai)
#pragma unroll
            for (int m = 0; m < 4; ++m) {
                const int row = row0 + ai * 128 + m * 16; float sq = 0.f;
#pragma unroll
                for (int bj = 0; bj < 2; ++bj)
#pragma unroll
                    for (int n = 0; n < 2; ++n) {
                        const size_t off = (size_t)row * DM + col0 + bj * 128 + n * 16;
                        const u32x2 t = *(const u32x2*)(hb + off); f32x4 r; r[0] = bflo(t[0]); r[1] = bfhi(t[0]); r[2] = bflo(t[1]); r[3] = bfhi(t[1]);
                        const f32x4 v = r + acc[ai][bj][m][n]; acc[ai][bj][m][n] = v;
                        sq += v[0] * v[0] + v[1] * v[1] + v[2] * v[2] + v[3] * v[3];
                    }
                sq += __shfl_xor(sq, 16); sq += __shfl_xor(sq, 32);
                if (fq == 0) atomicAdd(ssn + row, sq);
            }
        asm volatile("s_waitcnt vmcnt(0)" ::: "memory");
        __syncthreads();
        unsigned* c = cnt + 16 * u.pm;
        if (threadIdx.x == 0) {
            __builtin_amdgcn_fence(__ATOMIC_RELEASE, "agent"); asm volatile("s_waitcnt vmcnt(0)" ::: "memory");
            __hip_atomic_fetch_add(c, 1u, __ATOMIC_RELAXED, __HIP_MEMORY_SCOPE_AGENT);
            unsigned spins = 0;
            while (__hip_atomic_load(c, __ATOMIC_RELAXED, __HIP_MEMORY_SCOPE_AGENT) < 4u && ++spins < (1u << 22)) __builtin_amdgcn_s_sleep(2);
            __builtin_amdgcn_fence(__ATOMIC_ACQUIRE, "agent"); asm volatile("s_waitcnt vmcnt(0)" ::: "memory");
        }
        __syncthreads();
#pragma unroll
        for (int ai = 0; ai < 2; ++ai)
#pragma unroll
            for (int m = 0; m < 4; ++m) {
                const int row = row0 + ai * 128 + m * 16;
                const float rs = __builtin_amdgcn_rsqf(__hip_atomic_load(ssn + row, __ATOMIC_RELAXED, __HIP_MEMORY_SCOPE_AGENT) * (1.0f / 1024.0f) + 1e-6f);
#pragma unroll
                for (int bj = 0; bj < 2; ++bj)
#pragma unroll
                    for (int n = 0; n < 2; ++n) {
                        const int col = col0 + bj * 128 + n * 16; const f32x4 w = *(const f32x4*)(fw + col);
                        *(f32x4*)(outf + (size_t)row * DM + col) = acc[ai][bj][m][n] * rs * w;
                    }
            }
    }
};
constexpr int KST = 144, VST = 320, VST64 = 192;
constexpr int AT_K1 = 0, AT_K2 = 64 * KST, AT_V = 2 * 64 * KST, AT_STAGE = AT_V + 64 * VST;

DI void diff_tile(LAS unsigned char* lds, const bf16_t* proj, bf16_t* mixed, const float* subln, float lam, int b, int hd, int qt) {
    const int tid = otid(), w = __builtin_amdgcn_readfirstlane(tid >> 6), lane = tid & 63, qg = w & 3, mp = w >> 2, r = lane & 31, h = lane >> 5;
    const int q0 = qt * 128; const size_t rowb = (size_t)b * SEQ;
    bf16x8 qf[4];
    { const bf16_t* qp = proj + (rowb + q0 + 32 * qg + r) * AINW + hd * 128 + mp * 64 + 8 * h;
#pragma unroll
      for (int s = 0; s < 4; ++s) qf[s] = *(const bf16x8*)(qp + 16 * s); }
    f32x16 O[4];
#pragma unroll
    for (int i = 0; i < 4; ++i) O[i] = zero16();
    float mrun = 0.f, lrun = 0.f;
    const int nsteps = 2 * (qt + 1);
    const bf16_t* src[4]; int dst[4];
#pragma unroll
    for (int i = 0; i < 2; ++i) { const int cid = tid + 512 * i, row = cid >> 4, c16 = cid & 15;
        src[i] = proj + (rowb + row) * AINW + 512 + hd * 128 + c16 * 8; dst[i] = (c16 < 8 ? AT_K1 : AT_K2) + row * KST + (c16 & 7) * 16;
        src[2 + i] = proj + (rowb + row) * AINW + 1024 + hd * 128 + c16 * 8; dst[2 + i] = AT_V + row * VST + c16 * 16; }
    u32x4 pf[4];
#pragma unroll
    for (int i = 0; i < 4; ++i) pf[i] = *(const u32x4*)(src[i]);
#pragma unroll
    for (int i = 0; i < 4; ++i) *(LAS u32x4*)(lds + dst[i]) = pf[i];
    __syncthreads();
    const int i16 = lane & 15, tq = i16 >> 2, tp = i16 & 3, g16 = (lane >> 4) & 1;
    const int troff = (4 * h + tq) * VST + (16 * g16 + 4 * tp) * 2;
    for (int j = 0; j < nsteps; ++j) {
        const bool more = (j + 1 < nsteps);
        if (more) {
#pragma unroll
            for (int i = 0; i < 4; ++i) pf[i] = *(const u32x4*)(src[i] + (size_t)(j + 1) * 64 * AINW);
        }
        const LAS unsigned char* base = lds + (j & 1) * AT_STAGE;
        const LAS unsigned char* Kb = base + (mp ? AT_K2 : AT_K1);
        const LAS unsigned char* Vb = base + AT_V;
        f32x16 S[2];
        const float negm = -mrun;
#pragma unroll
        for (int kt = 0; kt < 2; ++kt) {
#pragma unroll
            for (int i = 0; i < 16; ++i) S[kt][i] = negm;
#pragma unroll
            for (int s = 0; s < 4; ++s) { const bf16x8 kf = *(const LAS bf16x8*)(Kb + (32 * kt + r) * KST + (16 * s + 8 * h) * 2); S[kt] = MFMA32(kf, qf[s], S[kt]); } }
        const int qidx = q0 + 32 * qg + r, kbase = 64 * j;
        if (kbase + 63 > q0 + 32 * qg) {
#pragma unroll
            for (int kt = 0; kt < 2; ++kt)
#pragma unroll
                for (int i = 0; i < 16; ++i) if (kbase + 32 * kt + crow(i, h) > qidx) S[kt][i] = -1e30f;
        }
        float mx = S[0][0];
#pragma unroll
        for (int kt = 0; kt < 2; ++kt)
#pragma unroll
            for (int i = 0; i < 16; ++i) mx = fmaxf(mx, S[kt][i]);
        mx = fmaxf(mx, __shfl_xor(mx, 32));
        if (j == 0 || __builtin_amdgcn_ballot_w64(mx > 8.0f) != 0ull) {
            const float d = (j == 0) ? mx : fmaxf(mx, 0.f);
            mrun += d;
            if (j != 0) { const float alpha = fexp2(-d); lrun *= alpha;
#pragma unroll
                for (int vt = 0; vt < 4; ++vt) O[vt] = O[vt] * alpha; }
#pragma unroll
            for (int kt = 0; kt < 2; ++kt)
#pragma unroll
                for (int i = 0; i < 16; ++i) S[kt][i] -= d;
        }
        float ls = 0.f;
#pragma unroll
        for (int kt = 0; kt < 2; ++kt)
#pragma unroll
            for (int i = 0; i < 16; ++i) { const float pv = fexp2(S[kt][i]); S[kt][i] = pv; ls += pv; }
        lrun += ls;
#pragma unroll
        for (int kt = 0; kt < 2; ++kt)
#pragma unroll
            for (int s2 = 0; s2 < 2; ++s2) {
                const bf16x8 pfr = pack8(S[kt], s2);
                const LAS unsigned char* vrow = Vb + (32 * kt + 16 * s2) * VST + troff;
#pragma unroll
                for (int vt = 0; vt < 4; ++vt) { const bf16x8 vf = tr2(vrow + vt * 64, vrow + 8 * VST + vt * 64); O[vt] = MFMA32(vf, pfr, O[vt]); }
            }
        if (more) {
            LAS unsigned char* nb = lds + ((j + 1) & 1) * AT_STAGE;
#pragma unroll
            for (int i = 0; i < 4; ++i) *(LAS u32x4*)(nb + dst[i]) = pf[i];
        }
        __syncthreads();
    }
    lrun += __shfl_xor(lrun, 32);
    const float inv = frcp(lrun);
    LAS float* ex = (LAS float*)lds;
    if (mp == 1) {
        const float sc = inv * lam;
#pragma unroll
        for (int vt = 0; vt < 4; ++vt)
#pragma unroll
            for (int i = 0; i < 16; ++i) ex[(qg * 128 + 32 * vt + crow(i, h)) * 32 + r] = O[vt][i] * sc;
    }
    __syncthreads();
    if (mp == 0) {
        float sq = 0.f;
#pragma unroll
        for (int vt = 0; vt < 4; ++vt)
#pragma unroll
            for (int i = 0; i < 16; ++i) { const float o = O[vt][i] * inv - ex[(qg * 128 + 32 * vt + crow(i, h)) * 32 + r]; O[vt][i] = o; sq += o * o; }
        sq += __shfl_xor(sq, 32);
        const float rn = __builtin_amdgcn_rsqf(sq * (1.0f / 128.0f) + 1e-5f) * 0.8f;
        bf16_t* op = mixed + (rowb + q0 + 32 * qg + r) * DM + hd * 128;
#pragma unroll
        for (int vt = 0; vt < 4; ++vt)
#pragma unroll
            for (int gq = 0; gq < 4; ++gq) { const int v0 = 32 * vt + 8 * gq + 4 * h; const f32x4 wv = *(const f32x4*)(subln + v0);
                u32x2 o; o[0] = pk2(O[vt][4 * gq] * rn * wv[0], O[vt][4 * gq + 1] * rn * wv[1]); o[1] = pk2(O[vt][4 * gq + 2] * rn * wv[2], O[vt][4 * gq + 3] * rn * wv[3]);
                *(u32x2*)(op + v0) = o; }
    }
    __syncthreads();
}

constexpr int SB_K = 0, SB_V = 64 * KST, SB_STAGE = 64 * KST + 64 * VST64;
DI void sb_block(LAS unsigned char* lds, const bf16_t* proj, bf16_t* mixed, int b, int hs, int qb) {
    const int tid = otid(), w = __builtin_amdgcn_readfirstlane(tid >> 6), lane = tid & 63, r = lane & 31, h = lane >> 5;
    const int q0 = qb * 256; const size_t rowb = (size_t)b * SEQ;
    const int qidx = q0 + 32 * w + r;
    bf16x8 qf[4];
    { const bf16_t* qp = proj + (rowb + qidx) * AINW + 1536 + hs * 64 + 8 * h;
#pragma unroll
      for (int s = 0; s < 4; ++s) qf[s] = *(const bf16x8*)(qp + 16 * s); }
    f32x16 O[2]; O[0] = zero16(); O[1] = zero16();
    float carry = 1.0f;
    const int jmax = 4 * qb + 3;
    const int srow = tid >> 3, sc8 = tid & 7;
    const bf16_t* srcK = proj + (rowb + srow) * AINW + 2048 + hs * 64 + sc8 * 8;
    const bf16_t* srcV = proj + (rowb + srow) * AINW + 2560 + hs * 64 + sc8 * 8;
    const int dstK = SB_K + srow * KST + sc8 * 16, dstV = SB_V + srow * VST64 + sc8 * 16;
    u32x4 pk_ = *(const u32x4*)(srcK + (size_t)jmax * 64 * AINW), pv_ = *(const u32x4*)(srcV + (size_t)jmax * 64 * AINW);
    *(LAS u32x4*)(lds + dstK) = pk_; *(LAS u32x4*)(lds + dstV) = pv_;
    __syncthreads();
    const int i16 = lane & 15, tq = i16 >> 2, tp = i16 & 3, g16 = (lane >> 4) & 1;
    const int troff = (4 * h + tq) * VST64 + (16 * g16 + 4 * tp) * 2;
    int it = 0;
    for (int j = jmax; j >= 0; --j, ++it) {
        const bool more = (j > 0);
        if (more) { pk_ = *(const u32x4*)(srcK + (size_t)(j - 1) * 64 * AINW); pv_ = *(const u32x4*)(srcV + (size_t)(j - 1) * 64 * AINW); }
        const LAS unsigned char* base = lds + (it & 1) * SB_STAGE;
        const int kbase = 64 * j;
        if (kbase < q0 + 32 * w + 32) {
#pragma unroll
            for (int kt = 1; kt >= 0; --kt) {
                f32x16 S = zero16();
#pragma unroll
                for (int s = 0; s < 4; ++s) { const bf16x8 kf = *(const LAS bf16x8*)(base + SB_K + (32 * kt + r) * KST + (16 * s + 8 * h) * 2); S = MFMA32(kf, qf[s], S); }
                float T[4], sfx[16];
#pragma unroll
                for (int gq = 0; gq < 4; ++gq) {
                    float run = 1.0f;
#pragma unroll
                    for (int jj = 3; jj >= 0; --jj) {
                        const int i = 4 * gq + jj; const bool valid = (kbase + 32 * kt + crow(i, h)) < qidx;
                        const float zz = fmaxf(S[i], -60.0f); const float e = fexp2(-LOG2E * zz); const float sg = frcp(1.0f + e);
                        const float keep = valid ? e * sg : 1.0f;
                        S[i] = valid ? sg : 0.0f; sfx[i] = run; run *= keep;
                    }
                    T[gq] = run;
                }
                float To[4];
#pragma unroll
                for (int gq = 0; gq < 4; ++gq) To[gq] = __shfl_xor(T[gq], 32);
                float E[4]; float acc_hi = 1.0f;
#pragma unroll
                for (int gq = 3; gq >= 0; --gq) {
                    const float above_same = acc_hi;
                    E[gq] = (h == 0) ? above_same * To[gq] : above_same;
                    acc_hi = acc_hi * T[gq] * To[gq];
                }
#pragma unroll
                for (int i = 0; i < 16; ++i) S[i] = S[i] * carry * E[i >> 2] * sfx[i];
                carry *= acc_hi;
#pragma unroll
                for (int s2 = 0; s2 < 2; ++s2) {
                    const bf16x8 pfr = pack8(S, s2);
                    const LAS unsigned char* vrow = base + SB_V + (32 * kt + 16 * s2) * VST64 + troff;
#pragma unroll
                    for (int vt = 0; vt < 2; ++vt) { const bf16x8 vf = tr2(vrow + vt * 64, vrow + 8 * VST64 + vt * 64); O[vt] = MFMA32(vf, pfr, O[vt]); }
                }
            }
        }
        if (more) { LAS unsigned char* nb = lds + ((it + 1) & 1) * SB_STAGE; *(LAS u32x4*)(nb + dstK) = pk_; *(LAS u32x4*)(nb + dstV) = pv_; }
        const int done = (kbase < q0 + 32 * w + 32) && (carry < 1e-12f);
        const bool wdone = (__builtin_amdgcn_ballot_w64(done != 0) == ~0ull);
        LAS int* flg = (LAS int*)(lds + 2 * SB_STAGE) + (it & 1) * 8;
        if (lane == 0) flg[w] = wdone ? 1 : 0;
        __syncthreads();
        int all = 1;
#pragma unroll
        for (int ww = 0; ww < 8; ++ww) all &= flg[ww];
        if (all) break;
    }
    bf16_t* op = mixed + (rowb + qidx) * DM + 512 + hs * 64;
#pragma unroll
    for (int vt = 0; vt < 2; ++vt)
#pragma unroll
        for (int gq = 0; gq < 4; ++gq) { const int v0 = 32 * vt + 8 * gq + 4 * h;
            u32x2 o; o[0] = pk2(O[vt][4 * gq], O[vt][4 * gq + 1]); o[1] = pk2(O[vt][4 * gq + 2], O[vt][4 * gq + 3]); *(u32x2*)(op + v0) = o; }
    __syncthreads();
}
DI void attn_phase(LAS unsigned char* lds, const Params& p) {
    const bf16_t* proj = (const bf16_t*)(p.ws + O_PROJ); bf16_t* mixed = (bf16_t*)(p.ws + O_MIXED);
    const float lam = *(const float*)(p.ws + O_LAM);
    for (int it0 = blockIdx.x; it0 < 256; it0 += gridDim.x) {
        const int it = (it0 & 7) * 32 + (it0 >> 3);
        const int b = it >> 7, hd = (it >> 5) & 3, pr = it & 31;
        diff_tile(lds, proj, mixed, p.in[7], lam, b, hd, 63 - pr);
        diff_tile(lds, proj, mixed, p.in[7], lam, b, hd, pr);
    }
    for (int it0 = blockIdx.x; it0 < 512; it0 += gridDim.x) {
        const int it = (it0 & 7) * 64 + (it0 >> 3);
        const int b = it >> 8, hs = (it >> 5) & 7, qb = it & 31;
        sb_block(lds, proj, mixed, b, hs, qb);
    }
}
constexpr int SXS = 528, SXS2 = 576, SBS = 272, SBS2 = 320;
constexpr int L_SX = 0, L_SB = 128 * SXS2, L_SC = L_SB + 128 * SBS, L_SDT = L_SC + 128 * SBS, L_SAC = L_SDT + 2048, L_SSQ = L_SAC + 2048;
static_assert(L_SSQ + 4096 <= LDS_BYTES, "lds");

DI void ssd_dt_acum(LAS unsigned char* lds, const float* DT, const float* dt_bias, const float* a_log, size_t t0, int g) {
    LAS float* sdt = (LAS float*)(lds + L_SDT); LAS float* sac = (LAS float*)(lds + L_SAC);
    const int tid = otid(), hh = tid >> 7, l = tid & 127, head = 4 * g + hh, w = tid >> 6, lane = tid & 63;
    const float raw = DT[(t0 + l) * 32 + head] + dt_bias[head];
    const float dt = fmaxf(raw, 0.f) + __logf(1.0f + __expf(-fabsf(raw)));
    sdt[hh * 128 + l] = dt; sac[hh * 128 + l] = -dt * __expf(a_log[head]);
    __syncthreads();
    if (w < 4) {
        const float v0 = sac[w * 128 + 2 * lane], v1 = sac[w * 128 + 2 * lane + 1]; float s = v0 + v1;
#pragma unroll
        for (int off = 1; off < 64; off <<= 1) { const float t = __shfl_up(s, off); if (lane >= off) s += t; }
        const float ex = s - (v0 + v1);
        sac[w * 128 + 2 * lane] = ex + v0; sac[w * 128 + 2 * lane + 1] = ex + v0 + v1;
    }
    __syncthreads();
}
template <int NT, class F> DI void conv_strip(const bf16_t* src, int nzero, const float* cw, const float* cb, int ch, F&& emit) {
    f32x4 wlo[4], whi[4];
#pragma unroll
    for (int k = 0; k < 4; ++k) { wlo[k] = *(const f32x4*)(cw + k * XBCW + ch); whi[k] = *(const f32x4*)(cw + k * XBCW + ch + 4); }
    const f32x4 blo = *(const f32x4*)(cb + ch), bhi = *(const f32x4*)(cb + ch + 4);
    u32x4 raw[NT + 3];
#pragma unroll
    for (int i = 0; i < NT + 3; ++i) { const int ii = (i < nzero) ? nzero : i; raw[i] = *(const u32x4*)(src + (ptrdiff_t)(ii - 3) * XBCW); if (i < nzero) raw[i] = (u32x4){0u, 0u, 0u, 0u}; }
#pragma unroll
    for (int t = 0; t < NT; ++t) {
        float o[8];
#pragma unroll
        for (int e = 0; e < 8; ++e) {
            float a = (e < 4) ? blo[e & 3] : bhi[e & 3];
#pragma unroll
            for (int k = 0; k < 4; ++k) { const unsigned d = raw[t + k][e >> 1]; const float xv = (e & 1) ? bfhi(d) : bflo(d); a += ((e < 4) ? wlo[k][e & 3] : whi[k][e & 3]) * xv; }
            o[e] = fsilu(a);
        }
        emit(t, o);
    }
}
DI u32x4 pack8f(const float* o) { u32x4 r; r[0] = pk2(o[0], o[1]); r[1] = pk2(o[2], o[3]); r[2] = pk2(o[4], o[5]); r[3] = pk2(o[6], o[7]); return r; }

template <bool XW, bool WITH_C> DI void ssd_stage(LAS unsigned char* lds, const bf16_t* xbc, const float* cw, const float* cb, size_t t0, int c, int g) {
    const int tid = otid();
    LAS float* sdt = (LAS float*)(lds + L_SDT); LAS float* sac = (LAS float*)(lds + L_SAC);
    {
        const int c8 = tid & 31, tg = tid >> 5, l0 = 8 * tg, ch = 256 * g + 8 * c8, hh = c8 >> 3;
        const int nzero = (c == 0) ? (3 - l0 > 0 ? 3 - l0 : 0) : 0;
        const float alast = sac[hh * 128 + 127];
        conv_strip<8>(xbc + (t0 + l0) * XBCW + ch, nzero, cw, cb, ch, [&](int t, float* o) {
            if (XW) { const float wgt = sdt[hh * 128 + l0 + t] * __expf(alast - sac[hh * 128 + l0 + t]);
#pragma unroll
                for (int e = 0; e < 8; ++e) o[e] *= wgt; }
            *(LAS u32x4*)(lds + L_SX + (l0 + t) * (XW ? SXS2 : SXS) + c8 * 16) = pack8f(o); });
    }
    {
        const int c8 = tid & 15, tg = tid >> 4, l0 = 4 * tg;
        const int nzero = (c == 0) ? (3 - l0 > 0 ? 3 - l0 : 0) : 0;
        const int chb = DIN + 128 * g + 8 * c8;
        conv_strip<4>(xbc + (t0 + l0) * XBCW + chb, nzero, cw, cb, chb, [&](int t, float* o) { *(LAS u32x4*)(lds + L_SB + (l0 + t) * (XW ? SBS2 : SBS) + c8 * 16) = pack8f(o); });
        if (WITH_C) { const int chc = DIN + 1024 + 128 * g + 8 * c8;
            conv_strip<4>(xbc + (t0 + l0) * XBCW + chc, nzero, cw, cb, chc, [&](int t, float* o) { *(LAS u32x4*)(lds + L_SC + (l0 + t) * SBS + c8 * 16) = pack8f(o); }); }
    }
}
DI bf16_t* st_ptr(unsigned char* ws, int b) { return (bf16_t*)(ws + (b ? O_ST1 : O_ST0)); }

DI void ssd_states_phase(LAS unsigned char* lds, const Params& p) {
    const int tid = otid(), w = __builtin_amdgcn_readfirstlane(tid >> 6), lane = tid & 63, r = lane & 31, h = lane >> 5, hh = w >> 1, ph = w & 1;
    const bf16_t* xbc = (const bf16_t*)(p.ws + O_XBC); const float* DT = (const float*)(p.ws + O_DT); float* cdec = (float*)(p.ws + O_CDEC);
    const int i16 = lane & 15, tq = i16 >> 2, tp = i16 & 3, g16 = (lane >> 4) & 1;
    for (int it = blockIdx.x; it < 1024; it += gridDim.x) {
        const int b = it >> 9, c = (it >> 3) & 63, g = it & 7; const size_t t0 = (size_t)b * SEQ + (size_t)c * 128;
        ssd_dt_acum(lds, DT, p.in[13], p.in[14], t0, g);
        ssd_stage<true, false>(lds, xbc, p.in[11], p.in[12], t0, c, g);
        __syncthreads();
        f32x16 acc[4];
#pragma unroll
        for (int i = 0; i < 4; ++i) acc[i] = zero16();
        const LAS unsigned char* xa = lds + L_SX + (8 * h + tq) * SXS2 + (64 * hh + 32 * ph + 16 * g16 + 4 * tp) * 2;
        const LAS unsigned char* ba = lds + L_SB + (8 * h + tq) * SBS2 + (16 * g16 + 4 * tp) * 2;
#pragma unroll
        for (int s = 0; s < 8; ++s) {
            const bf16x8 af = tr2(xa + 16 * s * SXS2, xa + (16 * s + 4) * SXS2);
#pragma unroll
            for (int nt = 0; nt < 4; ++nt) { const bf16x8 bfr = tr2(ba + 16 * s * SBS2 + nt * 64, ba + (16 * s + 4) * SBS2 + nt * 64); acc[nt] = MFMA32(af, bfr, acc[nt]); }
        }
        bf16_t* st = st_ptr(p.ws, b) + ((size_t)(c * 32 + 4 * g + hh) * 64 + 32 * ph) * 128;
#pragma unroll
        for (int nt = 0; nt < 4; ++nt)
#pragma unroll
            for (int i = 0; i < 16; ++i) st[(size_t)crow(i, h) * 128 + 32 * nt + r] = (bf16_t)(pk2(acc[nt][i], 0.f) & 0xffffu);
        if (tid < 4) cdec[(b * 64 + c) * 32 + 4 * g + tid] = __expf(((LAS float*)(lds + L_SAC))[tid * 128 + 127]);
        __syncthreads();
    }
}
DI void ssd_scan_phase(const Params& p, const bool dry) {
    const float* cdec = (const float*)(p.ws + O_CDEC);
    for (int e = blockIdx.x * 512 + threadIdx.x; e < 2 * 32 * 64 * 32; e += gridDim.x * 512) {
        const int b = e >> 16, rem = e & 65535, head = rem >> 11;
        bf16_t* st = st_ptr(p.ws, b) + (size_t)rem * 4;
        float carry[4] = {0.f, 0.f, 0.f, 0.f};
        for (int c0 = 0; c0 < 64; c0 += 16) {
            u32x2 v[16]; float dc[16];
#pragma unroll
            for (int u = 0; u < 16; ++u) { v[u] = *(const u32x2*)(st + (size_t)(c0 + u) * 262144); dc[u] = cdec[(b * 64 + c0 + u) * 32 + head]; }
#pragma unroll
            for (int u = 0; u < 16; ++u) {
                u32x2 o; o[0] = pk2(carry[0], carry[1]); o[1] = pk2(carry[2], carry[3]); if (!dry) *(u32x2*)(st + (size_t)(c0 + u) * 262144) = o;
                carry[0] = carry[0] * dc[u] + bflo(v[u][0]); carry[1] = carry[1] * dc[u] + bfhi(v[u][0]); carry[2] = carry[2] * dc[u] + bflo(v[u][1]); carry[3] = carry[3] * dc[u] + bfhi(v[u][1]);
            }
        }
    }
}
DI void ssd_out_phase(LAS unsigned char* lds, const Params& p, const bool dry) {
    const int tid = otid(), w = __builtin_amdgcn_readfirstlane(tid >> 6), lane = tid & 63, r = lane & 31, h = lane >> 5, hh = w >> 1, ph = w & 1;
    const bf16_t* xbc = (const bf16_t*)(p.ws + O_XBC); const float* DT = (const float*)(p.ws + O_DT); bf16_t* zy = (bf16_t*)p.out;
    LAS float* sdt = (LAS float*)(lds + L_SDT); LAS float* sac = (LAS float*)(lds + L_SAC); LAS float* ssq = (LAS float*)(lds + L_SSQ);
    const int i16 = lane & 15, tq = i16 >> 2, tp = i16 & 3, g16 = (lane >> 4) & 1;
    for (int it = blockIdx.x; it < 1024; it += gridDim.x) {
        const int b = it >> 9, c = (it >> 3) & 63, g = it & 7, head = 4 * g + hh; const size_t t0 = (size_t)b * SEQ + (size_t)c * 128;
        ssd_dt_acum(lds, DT, p.in[13], p.in[14], t0, g);
        ssd_stage<false, true>(lds, xbc, p.in[11], p.in[12], t0, c, g);
        bf16x8 pvf[8];
        { const bf16_t* pp = st_ptr(p.ws, b) + ((size_t)(c * 32 + head) * 64 + 32 * ph + r) * 128 + 8 * h;
#pragma unroll
          for (int s = 0; s < 8; ++s) pvf[s] = *(const bf16x8*)(pp + 16 * s); }
        __syncthreads();
        f32x16 Y[4];
        const LAS unsigned char* xa = lds + L_SX + (4 * h + tq) * SXS + (64 * hh + 32 * ph + 16 * g16 + 4 * tp) * 2;
#pragma unroll
        for (int lt = 0; lt < 4; ++lt) {
            __builtin_amdgcn_sched_barrier(0);
            f32x16 y = zero16();
#pragma unroll
            for (int s = 0; s < 8; ++s) { const bf16x8 cfs = *(const LAS bf16x8*)(lds + L_SC + (32 * lt + r) * SBS + (16 * s + 8 * h) * 2); y = MFMA32(pvf[s], cfs, y); }
            Y[lt] = y * __expf(sac[hh * 128 + 32 * lt + r]);
        }
#pragma unroll
        for (int lt = 0; lt < 4; ++lt) {
            __builtin_amdgcn_sched_barrier(0);
            bf16x8 cf[8];
#pragma unroll
            for (int s = 0; s < 8; ++s) cf[s] = *(const LAS bf16x8*)(lds + L_SC + (32 * lt + r) * SBS + (16 * s + 8 * h) * 2);
            const float al = sac[hh * 128 + 32 * lt + r];
#pragma unroll
            for (int mt = 0; mt < 4; ++mt) {
                if (mt <= lt) {
                    __builtin_amdgcn_sched_barrier(0);
                    f32x16 X = zero16();
#pragma unroll
                    for (int s = 0; s < 8; ++s) { const bf16x8 bfr = *(const LAS bf16x8*)(lds + L_SB + (32 * mt + r) * SBS + (16 * s + 8 * h) * 2); X = MFMA32(bfr, cf[s], X); }
#pragma unroll
                    for (int gq = 0; gq < 4; ++gq) {
                        const f32x4 am = *(const LAS f32x4*)(sac + hh * 128 + 32 * mt + 8 * gq + 4 * h), dm = *(const LAS f32x4*)(sdt + hh * 128 + 32 * mt + 8 * gq + 4 * h);
#pragma unroll
                        for (int jj = 0; jj < 4; ++jj) { const int mrow = 32 * mt + 8 * gq + 4 * h + jj; const bool ok = (32 * lt + r) >= mrow;
                            const float dec = ok ? __expf(fminf(al - am[jj], 0.f)) * dm[jj] : 0.f; X[4 * gq + jj] *= dec; }
                    }
#pragma unroll
                    for (int s2 = 0; s2 < 2; ++s2) { const bf16x8 xs = pack8(X, s2);
                        const LAS unsigned char* xr = xa + (32 * mt + 16 * s2) * SXS; const bf16x8 xf = tr2(xr, xr + 8 * SXS); Y[lt] = MFMA32(xf, xs, Y[lt]); }
                }
            }
        }
        __builtin_amdgcn_sched_barrier(0);
        const float Dh = p.in[15][head];
        float sq[4];
#pragma unroll
        for (int lt = 0; lt < 4; ++lt) {
            const int l = 32 * lt + r; sq[lt] = 0.f;
#pragma unroll
            for (int gq = 0; gq < 4; ++gq) {
                const int chl = 64 * hh + 32 * ph + 8 * gq + 4 * h;
                const u32x2 xv = *(const LAS u32x2*)(lds + L_SX + l * SXS + chl * 2);
                const u32x2 zv = *(const u32x2*)(zy + (t0 + l) * DIN + 256 * g + chl);
                const float xf4[4] = {bflo(xv[0]), bfhi(xv[0]), bflo(xv[1]), bfhi(xv[1])}, zf4[4] = {bflo(zv[0]), bfhi(zv[0]), bflo(zv[1]), bfhi(zv[1])};
#pragma unroll
                for (int jj = 0; jj < 4; ++jj) { const float yv = (Y[lt][4 * gq + jj] + Dh * xf4[jj]) * fsilu(zf4[jj]); Y[lt][4 * gq + jj] = yv; sq[lt] += yv * yv; }
            }
            sq[lt] += __shfl_xor(sq[lt], 32);
            if (h == 0) ssq[w * 128 + l] = sq[lt];
        }
        __syncthreads();
#pragma unroll
        for (int lt = 0; lt < 4; ++lt) {
            const int l = 32 * lt + r; float tot = 0.f;
#pragma unroll
            for (int ww = 0; ww < 8; ++ww) tot += ssq[ww * 128 + l];
            const float rn = __builtin_amdgcn_rsqf(tot * (1.0f / 256.0f) + 1e-5f);
#pragma unroll
            for (int gq = 0; gq < 4; ++gq) {
                const int chl = 64 * hh + 32 * ph + 8 * gq + 4 * h; const f32x4 gw = *(const f32x4*)(p.in[16] + 256 * g + chl);
                u32x2 o; o[0] = pk2(Y[lt][4 * gq] * rn * gw[0], Y[lt][4 * gq + 1] * rn * gw[1]); o[1] = pk2(Y[lt][4 * gq + 2] * rn * gw[2], Y[lt][4 * gq + 3] * rn * gw[3]);
                if (!dry) *(u32x2*)(zy + (t0 + l) * DIN + 256 * g + chl) = o;
            }
        }
        __syncthreads();
    }
}
DI void dt_proj(LAS unsigned char* lds, const Params& p) {
    const int tid = otid(), w = __builtin_amdgcn_readfirstlane(tid >> 6), lane = tid & 63, r = lane & 31, h = lane >> 5, rt = w & 1, kq = w >> 1;
    const bf16_t* hb = (const bf16_t*)(p.ws + O_HB); const bf16_t* wt = (const bf16_t*)(p.ws + W_SIN) + (size_t)6144 * DM;
    const float* ss = (const float*)(p.ws + O_SS) + 2 * MT; float* dt = (float*)(p.ws + O_DT);
    LAS float* part = (LAS float*)lds;
    for (int rb = blockIdx.x; rb < MT / 64; rb += gridDim.x) {
        const bf16_t* ap = hb + (size_t)(rb * 64 + rt * 32 + r) * DM + kq * 256 + 8 * h;
        const bf16_t* bp = wt + (size_t)r * DM + kq * 256 + 8 * h;
        bf16x8 af[16], bfr[16];
#pragma unroll
        for (int s = 0; s < 16; ++s) { af[s] = *(const bf16x8*)(ap + 16 * s); bfr[s] = *(const bf16x8*)(bp + 16 * s); }
        f32x16 acc = zero16();
#pragma unroll
        for (int s = 0; s < 16; ++s) acc = MFMA32(af[s], bfr[s], acc);
#pragma unroll
        for (int i = 0; i < 16; ++i) part[((kq * 2 + rt) * 32 + crow(i, h)) * 32 + r] = acc[i];
        __syncthreads();
#pragma unroll
        for (int q = 0; q < 4; ++q) {
            const int o = tid + 512 * q, row = o >> 5, col = o & 31;
            float v = 0.f;
#pragma unroll
            for (int k = 0; k < 4; ++k) v += part[((k * 2 + (row >> 5)) * 32 + (row & 31)) * 32 + col];
            const int grow = rb * 64 + row;
            dt[(size_t)grow * 32 + col] = v * __builtin_amdgcn_rsqf(ss[grow] * (1.0f / 1024.0f) + 1e-6f);
        }
        __syncthreads();
    }
}
template <class Epi> DI void run_gemm(LAS unsigned char* lds, const bf16_t* A, const bf16_t* Bt, int N, int K, const Epi& E) {
    pg8::Gemm g; g.A = A; g.Bt = Bt; g.M = MT; g.N = N; g.K = K;
    pg8::StaticOrder S; S.init(MT, N, (int)gridDim.x, (int)blockIdx.x);
    pg8::gemm_phase<Epi, pg8::StaticOrder, false>((PG8_LAS unsigned char*)lds, g, S, E, nullptr);
}
#if defined(DRY_S3) || defined(DRY_S4)
#define DRYV (p.ws == nullptr)
#else
#define DRYV false
#endif
__global__ void __launch_bounds__(512, 2) fwd_megakernel(Params p) {
    extern __shared__ __attribute__((aligned(16))) unsigned char shm[];
    LAS unsigned char* lds = (LAS unsigned char*)shm;
    cg::grid_group grid = cg::this_grid();
    if (threadIdx.x < 4) ((LAS unsigned*)(lds + LDS_BYTES - 16))[threadIdx.x] = 0u;
    __syncthreads();
    const XcdBarrier xbar = xcd_barrier_post((unsigned*)(p.ws + O_BAR), (volatile LAS unsigned*)(lds + LDS_BYTES - 16));
#define GBAR() xcd_barrier(xbar)
    unsigned char* ws = p.ws;
    bf16_t* hb = (bf16_t*)(ws + O_HB); float* ss = (float*)(ws + O_SS);
    phase0(lds, p);
#ifdef DUP_P0
    GBAR(); phase0(lds, p);
#endif
    if (gridDim.x == 0x7fffffffu) grid.sync();
    GBAR();
    { EpiAttnIn E; E.O = (bf16_t*)(ws + O_PROJ); E.ss = ss; E.tab = (const f32x4*)(ws + O_ROPE); run_gemm(lds, hb, (const bf16_t*)(ws + W_AIN), AINW, DM, E); }
    GBAR();
    attn_phase(lds, p);
#ifdef DUP_ATTN
    GBAR(); attn_phase(lds, p);
#endif
    GBAR();
    { EpiRes<true, false> E; E.xres = p.in[0]; E.hb = hb; E.outf = nullptr; E.ssn = ss + MT; run_gemm(lds, (const bf16_t*)(ws + O_MIXED), (const bf16_t*)(ws + W_AOUT), DM, DM, E); }
    GBAR();
    { EpiGU E; E.act = (bf16_t*)(ws + O_ACT); E.ss = ss + MT; run_gemm(lds, hb, (const bf16_t*)(ws + W_GU0), 2 * DFF, DM, E); }
    GBAR();
    { EpiRes<false, false> E; E.xres = nullptr; E.hb = hb; E.outf = nullptr; E.ssn = ss + 2 * MT; run_gemm(lds, (const bf16_t*)(ws + O_ACT), (const bf16_t*)(ws + W_DN0), DM, DFF, E); }
    GBAR();
    { EpiSsdIn E; E.z = (bf16_t*)p.out; E.xbc = (bf16_t*)(ws + O_XBC); E.dt = (float*)(ws + O_DT); E.ss = ss + 2 * MT; dt_proj(lds, p); run_gemm(lds, hb, (const bf16_t*)(ws + W_SIN), 6144, DM, E); }
    GBAR();
    ssd_states_phase(lds, p);
#ifdef DUP_S2
    GBAR(); ssd_states_phase(lds, p);
#endif
    GBAR();
#ifdef DRY_S3
    ssd_scan_phase(p, p.ws != nullptr); GBAR();
#endif
    ssd_scan_phase(p, DRYV);
    GBAR();
#ifdef DRY_S4
    ssd_out_phase(lds, p, p.ws != nullptr); GBAR();
#endif
    ssd_out_phase(lds, p, DRYV);
    GBAR();
    { EpiRes<false, false> E; E.xres = nullptr; E.hb = hb; E.outf = nullptr; E.ssn = ss + 3 * MT; run_gemm(lds, (const bf16_t*)p.out, (const bf16_t*)(ws + W_SOUT), DM, DIN, E); }
    GBAR();
    { EpiGU E; E.act = (bf16_t*)(ws + O_ACT); E.ss = ss + 3 * MT; run_gemm(lds, hb, (const bf16_t*)(ws + W_GU1), 2 * DFF, DM, E); }
    GBAR();
    if (gridDim.x == 256) {
        EpiFinal E; E.hb = hb; E.outf = p.out; E.ssn = ss + 4 * MT; E.cnt = (unsigned*)(ws + O_BAR) + XCD_BAR_WORDS; E.fw = p.in[22];
        run_gemm(lds, (const bf16_t*)(ws + O_ACT), (const bf16_t*)(ws + W_DN1), DM, DFF, E);
    } else {
        { EpiRes<false, true> E; E.xres = nullptr; E.hb = hb; E.outf = p.out; E.ssn = ss + 4 * MT; run_gemm(lds, (const bf16_t*)(ws + O_ACT), (const bf16_t*)(ws + W_DN1), DM, DFF, E); }
        GBAR();
        const float* ss4 = ss + 4 * MT; const f32x4* fw = (const f32x4*)p.in[22]; f32x4* o4 = (f32x4*)p.out;
        for (int i = blockIdx.x * 512 + threadIdx.x; i < MT * (DM / 4); i += gridDim.x * 512) {
            const int row = i >> 8; const float rs = __builtin_amdgcn_rsqf(ss4[row] * (1.0f / 1024.0f) + 1e-6f);
            o4[i] = o4[i] * rs * fw[i & 255];
        }
    }
}

extern "C" void kernel_launch(void* const* d_in, const int* in_sizes, int n_in, void* d_out, int out_size, void* d_ws, size_t ws_size, hipStream_t stream) {
    static int grid_blocks = 0;
    if (!grid_blocks) {
        int dev = 0, cus = 0, per_cu = 0;
        hipGetDevice(&dev);
        hipDeviceGetAttribute(&cus, hipDeviceAttributeMultiprocessorCount, dev);
        if (hipFuncSetAttribute((const void*)fwd_megakernel, hipFuncAttributeMaxDynamicSharedMemorySize, LDS_BYTES) != hipSuccess) fprintf(stderr, "hipFuncSetAttribute failed\n");
        if (hipOccupancyMaxActiveBlocksPerMultiprocessor(&per_cu, (const void*)fwd_megakernel, 512, LDS_BYTES) != hipSuccess || per_cu < 1) { fprintf(stderr, "occupancy query: %d\n", per_cu); per_cu = 1; }
        (void)hipGetLastError();
        grid_blocks = cus * per_cu;
        if (ws_size < 268435456ull || n_in != 23) fprintf(stderr, "unexpected ws_size %zu / n_in %d\n", ws_size, n_in);
    }
    if (hipMemsetAsync((char*)d_ws + O_BAR, 0, 20480, stream) != hipSuccess) fprintf(stderr, "memset failed\n");
    Params p{};
    for (int i = 0; i < 23; ++i) p.in[i] = (const float*)d_in[i];
    p.out = (float*)d_out; p.ws = (unsigned char*)d_ws;
    void* args[] = {&p};
    hipError_t e = hipLaunchCooperativeKernel((const void*)fwd_megakernel, dim3(grid_blocks), dim3(512), args, LDS_BYTES, stream);
    if (e != hipSuccess) fprintf(stderr, "cooperative launch failed: %s (grid %d)\n", hipGetErrorString(e), grid_blocks);
}
#ifdef PHASE_TEST
__global__ void __launch_bounds__(512, 2) t_phase0(Params p) { extern __shared__ __attribute__((aligned(16))) unsigned char shm[]; phase0((LAS unsigned char*)shm, p); }
__global__ void __launch_bounds__(512, 2) t_attn_diff(Params p) { extern __shared__ __attribute__((aligned(16))) unsigned char shm[]; diff_tile((LAS unsigned char*)shm, (const bf16_t*)(p.ws + O_PROJ), (bf16_t*)(p.ws + O_MIXED), p.in[7], 0.3f, blockIdx.x & 1, blockIdx.y, blockIdx.z); }
__global__ void __launch_bounds__(512, 2) t_attn_sb(Params p) { extern __shared__ __attribute__((aligned(16))) unsigned char shm[]; sb_block((LAS unsigned char*)shm, (const bf16_t*)(p.ws + O_PROJ), (bf16_t*)(p.ws + O_MIXED), blockIdx.x & 1, blockIdx.y, blockIdx.z); }
__global__ void __launch_bounds__(512, 2) t_ssd_states(Params p) { extern __shared__ __attribute__((aligned(16))) unsigned char shm[]; ssd_states_phase((LAS unsigned char*)shm, p); }
__global__ void __launch_bounds__(512, 2) t_ssd_scan(Params p) { ssd_scan_phase(p, false); }
__global__ void __launch_bounds__(512, 2) t_ssd_out(Params p) { extern __shared__ __attribute__((aligned(16))) unsigned char shm[]; ssd_out_phase((LAS unsigned char*)shm, p, false); }
__global__ void __launch_bounds__(512, 2) t_gemm_ain(Params p) { extern __shared__ __attribute__((aligned(16))) unsigned char shm[]; EpiAttnIn E; E.O = (bf16_t*)(p.ws + O_PROJ); E.ss = (float*)(p.ws + O_SS); E.tab = (const f32x4*)(p.ws + O_ROPE); run_gemm((LAS unsigned char*)shm, (bf16_t*)(p.ws + O_HB), (const bf16_t*)(p.ws + W_AIN), AINW, DM, E); }
__global__ void __launch_bounds__(512, 2) t_gemm_res(Params p) { extern __shared__ __attribute__((aligned(16))) unsigned char shm[]; EpiRes<false, false> E; E.xres = nullptr; E.hb = (bf16_t*)(p.ws + O_HB); E.outf = nullptr; E.ssn = (float*)(p.ws + O_SS); run_gemm((LAS unsigned char*)shm, (bf16_t*)(p.ws + O_ACT), (const bf16_t*)(p.ws + W_DN0), DM, DFF, E); }
__global__ void __launch_bounds__(512, 2) t_gemm_gu(Params p) { extern __shared__ __attribute__((aligned(16))) unsigned char shm[]; EpiGU E; E.act = (bf16_t*)(p.ws + O_ACT); E.ss = (float*)(p.ws + O_SS); run_gemm((LAS unsigned char*)shm, (bf16_t*)(p.ws + O_HB), (const bf16_t*)(p.ws + W_GU0), 2 * DFF, DM, E); }
__global__ void __launch_bounds__(512, 2) t_gemm_ssdin(Params p) { extern __shared__ __attribute__((aligned(16))) unsigned char shm[]; EpiSsdIn E; E.z = (bf16_t*)p.out; E.xbc = (bf16_t*)(p.ws + O_XBC); E.dt = (float*)(p.ws + O_DT); E.ss = (float*)(p.ws + O_SS); run_gemm((LAS unsigned char*)shm, (bf16_t*)(p.ws + O_HB), (const bf16_t*)(p.ws + W_SIN), SINWP, DM, E); }
#endif
```

```cpp
#include <hip/hip_runtime.h>
#include <hip/hip_cooperative_groups.h>
#include <cstdio>
#include <cstdint>
namespace cg = cooperative_groups;
namespace pg8 {
#define PG8_LAS __attribute__((address_space(3)))
typedef unsigned short bf16_t;
typedef short bf16x8 __attribute__((ext_vector_type(8)));
typedef float f32x4 __attribute__((ext_vector_type(4)));
typedef unsigned u32x4 __attribute__((ext_vector_type(4)));
constexpr int BM = 256, BK = 64, HALF = 128, HTB = HALF * BK * 2  , STAGE_BYTES = 8 * HTB, NXCD = 8, WGM = 8;

__host__ __device__ __forceinline__ int lds_byte(int r, int c) { const int st = (r >> 4) * 2 + (c >> 5), rr = r & 15, cc = c & 31, ob = rr * 64 + cc * 2; return st * 1024 + (ob ^ (((ob >> 9) & 1) << 5)); }
__host__ __device__ __forceinline__ void stage_rc(int b, int& R, int& C) { const int st = b / 1024, sb = b % 1024, swz = sb ^ (((sb >> 9) & 1) << 5); R = (st >> 1) * 16 + swz / 64; C = (st & 1) * 32 + (swz % 64) / 2; }
__host__ __device__ __forceinline__ int perm32(int rho) { const int n = rho >> 4, i = rho & 15; return 8 * (i >> 2) + 4 * n + (i & 3); }

struct Unit { int pm, pn; };
struct Gemm { const bf16_t* A; const bf16_t* Bt; int M, N, K; };

struct StaticOrder {
    int nM, nN, nwg, G, c;
    __host__ __device__ void init(int M, int N, int G_, int c_) { nM = M / BM; nN = N / BM; nwg = nM * nN; G = G_; c = c_; }
    __host__ __device__ bool next(int i, Unit& u) const {
        const long L = (long)i * G + c; if (L >= nwg) return false;
        int wgid = (int)L; { const int q = nwg / NXCD, r = nwg % NXCD, xcd = wgid % NXCD, off = wgid / NXCD; wgid = (xcd < r ? xcd * (q + 1) : r * (q + 1) + (xcd - r) * q) + off; }
        const int nig = WGM * nN, gid = wgid / nig, fm = gid * WGM, gsz = (nM - fm) < WGM ? (nM - fm) : WGM;
        u.pm = fm + ((wgid % nig) % gsz); u.pn = (wgid % nig) / gsz; return true;
    }
    __device__ __forceinline__ void a_ready(const Unit&) const {}
    __device__ __forceinline__ void done(const Unit&) const {}
};

template <class Epi, class Sched, bool ALIGN_EPI = false, bool SP2 = false>
__device__ __forceinline__ void gemm_phase(PG8_LAS unsigned char* lds, const Gemm g, const Sched& S, const Epi& E) {
    int tid_ = threadIdx.x; asm volatile("" : "+v"(tid_)); const int tid = tid_, wid = __builtin_amdgcn_readfirstlane(tid >> 6), lane = tid & 63, wr = wid >> 2, wc = wid & 3, fr = lane & 15, fq = lane >> 4;
    const int K = g.K, nt = K / BK;
    unsigned voffA[2], voffB[2];
#pragma unroll
    for (int i = 0; i < 2; ++i) { int R, C; stage_rc(tid * 16 + i * 8192, R, C); const int Rb = Epi::PERM ? ((R & ~31) + perm32(R & 31)) : R;
        voffA[i] = (unsigned)(R * K + C) * 2u; voffB[i] = (unsigned)(Rb * K + C) * 2u; }
    const size_t kstep = (size_t)(BK * 2);
    const size_t hstep = (size_t)HALF * K * 2;
    const size_t tstep = 2 * hstep;
    const unsigned ldsw = (unsigned)wid * 1024u;
    const int aoff = lds_byte(wr * 64 + fr, fq * 8), boff = lds_byte(wc * 32 + fr, fq * 8);
#define PG8_SA(b, h) (((b) * 2 + (h)) * HTB)
#define PG8_SB(b, h) ((4 + (b) * 2 + (h)) * HTB)
#define PG8_STAGE(bufoff, gbase, voff) do { _Pragma("unroll") for (int _i = 0; _i < 2; ++_i) \
        __builtin_amdgcn_global_load_lds((const unsigned*)((const char*)(gbase) + (voff)[_i]), (PG8_LAS unsigned*)(lds + (bufoff) + ldsw + _i * 8192), 16, 0, 0); } while (0)
#define PG8_LDA(dst, b, h) do { _Pragma("unroll") for (int m = 0; m < 4; ++m) _Pragma("unroll") for (int k = 0; k < 2; ++k) dst[m][k] = *(const PG8_LAS bf16x8*)(lds + PG8_SA(b, h) + aoff + m * 2048 + k * 1024); } while (0)
#define PG8_LDB(dst, b, h) do { _Pragma("unroll") for (int n = 0; n < 2; ++n) _Pragma("unroll") for (int k = 0; k < 2; ++k) dst[n][k] = *(const PG8_LAS bf16x8*)(lds + PG8_SB(b, h) + boff + n * 2048 + k * 1024); } while (0)
#define PG8_MMA(ai, bj, At, Bt) do { __builtin_amdgcn_s_setprio(1); _Pragma("unroll") for (int m = 0; m < 4; ++m) _Pragma("unroll") for (int n = 0; n < 2; ++n) _Pragma("unroll") for (int k = 0; k < 2; ++k) \
        acc[ai][bj][m][n] = __builtin_amdgcn_mfma_f32_16x16x32_bf16(Bt[n][k], At[m][k], acc[ai][bj][m][n], 0, 0, 0); __builtin_amdgcn_s_setprio(0); } while (0)
#define PG8_WAIT_V(n) asm volatile("s_waitcnt vmcnt(" #n ")" ::: "memory")
#define PG8_WAIT_L(n) asm volatile("s_waitcnt lgkmcnt(" #n ")" ::: "memory")
#define PG8_BAR __builtin_amdgcn_s_barrier()
#define PG8_SCHED __builtin_amdgcn_sched_barrier(0)
    Unit cur, nxt; int ui = 0;
    if (!S.next(0, cur)) return;
    f32x4 acc[2][2][4][2];
#pragma unroll
    for (int a = 0; a < 2; ++a)
#pragma unroll
        for (int b = 0; b < 2; ++b)
#pragma unroll
            for (int m = 0; m < 4; ++m)
#pragma unroll
                for (int n = 0; n < 2; ++n) acc[a][b][m][n] = (f32x4){0.f, 0.f, 0.f, 0.f};
    bf16x8 At[4][2], B0[2][2], B1[2][2];
    const char* cA = (const char*)g.A + (size_t)cur.pm * tstep; const char* cB = (const char*)g.Bt + (size_t)cur.pn * tstep;
    S.a_ready(cur);
    if constexpr (SP2) {
        PG8_STAGE(PG8_SB(0, 0), cB, voffB); PG8_STAGE(PG8_SB(0, 1), cB + hstep, voffB); PG8_STAGE(PG8_SA(0, 0), cA, voffA); PG8_STAGE(PG8_SA(0, 1), cA + hstep, voffA);
        if (wr == 1) PG8_BAR;
        PG8_WAIT_V(2); PG8_BAR;
        PG8_STAGE(PG8_SB(1, 0), cB + kstep, voffB); PG8_STAGE(PG8_SA(1, 0), cA + kstep, voffA); PG8_STAGE(PG8_SB(1, 1), cB + hstep + kstep, voffB);
        PG8_WAIT_V(6); PG8_BAR;
    } else {
        PG8_STAGE(PG8_SB(0, 0), cB, voffB); PG8_STAGE(PG8_SA(0, 0), cA, voffA); PG8_STAGE(PG8_SB(0, 1), cB + hstep, voffB); PG8_STAGE(PG8_SA(0, 1), cA + hstep, voffA);
        if (wr == 1) PG8_BAR;
        PG8_WAIT_V(4); PG8_BAR;
        PG8_STAGE(PG8_SB(1, 0), cB + kstep, voffB); PG8_STAGE(PG8_SA(1, 0), cA + kstep, voffA); PG8_STAGE(PG8_SB(1, 1), cB + hstep + kstep, voffB);
        PG8_WAIT_V(6); PG8_BAR;
    }
    for (;;) {
        const bool has_next = S.next(ui + 1, nxt);
        const char* nA = has_next ? (const char*)g.A + (size_t)nxt.pm * tstep : cA; const char* nB = has_next ? (const char*)g.Bt + (size_t)nxt.pn * tstep : cB;
        for (int t = 0; t < nt; t += 2) {
            const bool last = (t == nt - 2);
            const char* a1 = cA + (size_t)(t + 1) * kstep;
            const char* a2 = last ? nA : cA + (size_t)(t + 2) * kstep; const char* b2 = last ? nB : cB + (size_t)(t + 2) * kstep;
            const char* a3 = a2 + kstep; const char* b3 = b2 + kstep;
            if (last && has_next) S.a_ready(nxt);
            if constexpr (SP2) {
            PG8_LDB(B0, 0, 0); PG8_LDB(B1, 0, 1); PG8_SCHED; PG8_LDA(At, 0, 0); PG8_STAGE(PG8_SA(1, 1), a1 + hstep, voffA);
            PG8_WAIT_V(8); PG8_WAIT_L(0); PG8_BAR; PG8_MMA(0, 0, At, B0); PG8_MMA(0, 1, At, B1); PG8_BAR; PG8_SCHED;
            PG8_LDA(At, 0, 1); PG8_STAGE(PG8_SB(0, 0), b2, voffB); PG8_STAGE(PG8_SB(0, 1), b2 + hstep, voffB); PG8_STAGE(PG8_SA(0, 0), a2, voffA);
            PG8_WAIT_V(8); PG8_WAIT_L(0); PG8_BAR; PG8_MMA(1, 0, At, B0); PG8_MMA(1, 1, At, B1); PG8_BAR; PG8_SCHED;
            PG8_LDB(B0, 1, 0); PG8_LDB(B1, 1, 1); PG8_SCHED; PG8_LDA(At, 1, 0); PG8_STAGE(PG8_SA(0, 1), a2 + hstep, voffA);
            PG8_WAIT_V(8); PG8_WAIT_L(0); PG8_BAR; PG8_MMA(0, 0, At, B0); PG8_MMA(0, 1, At, B1); PG8_BAR; PG8_SCHED;
            PG8_LDA(At, 1, 1); PG8_STAGE(PG8_SB(1, 0), b3, voffB); PG8_STAGE(PG8_SB(1, 1), b3 + hstep, voffB); PG8_STAGE(PG8_SA(1, 0), a3, voffA);
            PG8_WAIT_V(8); PG8_WAIT_L(0); PG8_BAR; PG8_MMA(1, 0, At, B0); PG8_MMA(1, 1, At, B1); PG8_BAR; PG8_SCHED;
            } else {
            PG8_LDB(B0, 0, 0); PG8_SCHED; PG8_LDA(At, 0, 0); PG8_STAGE(PG8_SA(1, 1), a1 + hstep, voffA);
            PG8_WAIT_L(8); PG8_BAR; PG8_WAIT_L(0); PG8_MMA(0, 0, At, B0); PG8_BAR; PG8_SCHED;
            PG8_LDB(B1, 0, 1); PG8_STAGE(PG8_SB(0, 0), b2, voffB);
            PG8_BAR; PG8_WAIT_L(0); PG8_MMA(0, 1, At, B1); PG8_BAR;
            PG8_LDA(At, 0, 1); PG8_STAGE(PG8_SA(0, 0), a2, voffA);
            PG8_BAR; PG8_WAIT_L(0); PG8_MMA(1, 0, At, B0); PG8_BAR; PG8_SCHED;
            PG8_STAGE(PG8_SB(0, 1), b2 + hstep, voffB);
            PG8_WAIT_V(6); PG8_BAR; PG8_MMA(1, 1, At, B1); PG8_BAR;
            PG8_LDB(B0, 1, 0); PG8_SCHED; PG8_LDA(At, 1, 0); PG8_STAGE(PG8_SA(0, 1), a2 + hstep, voffA);
            PG8_WAIT_L(8); PG8_BAR; PG8_WAIT_L(0); PG8_MMA(0, 0, At, B0); PG8_BAR; PG8_SCHED;
            PG8_LDB(B1, 1, 1); PG8_STAGE(PG8_SB(1, 0), b3, voffB);
            PG8_BAR; PG8_WAIT_L(0); PG8_MMA(0, 1, At, B1); PG8_BAR;
            PG8_LDA(At, 1, 1); PG8_STAGE(PG8_SA(1, 0), a3, voffA);
            PG8_BAR; PG8_WAIT_L(0); PG8_MMA(1, 0, At, B0); PG8_BAR; PG8_SCHED;
            PG8_STAGE(PG8_SB(1, 1), b3 + hstep, voffB);
            PG8_WAIT_V(6); PG8_BAR; PG8_MMA(1, 1, At, B1); PG8_BAR;
            }
        }
        if constexpr (ALIGN_EPI) { if (wr == 0) PG8_BAR; }
        if constexpr (!Epi::AFTER_DRAIN) { E(acc, cur, wr, wc, fr, fq); S.done(cur); }
        if (!has_next) break;
#pragma unroll
        for (int a = 0; a < 2; ++a)
#pragma unroll
            for (int b = 0; b < 2; ++b)
#pragma unroll
                for (int m = 0; m < 4; ++m)
#pragma unroll
                    for (int n = 0; n < 2; ++n) acc[a][b][m][n] = (f32x4){0.f, 0.f, 0.f, 0.f};
        cur = nxt; cA = nA; cB = nB; ++ui;
        if constexpr (ALIGN_EPI) { if (wr == 1) PG8_BAR; }
    }
    PG8_WAIT_V(0);
    if constexpr (!ALIGN_EPI) { if (wr == 0) PG8_BAR; }
    PG8_BAR;
    if constexpr (Epi::AFTER_DRAIN) { E.fused(acc, cur, wr, wc, fr, fq, lds, wid, lane); S.done(cur); }
#undef PG8_SA
#undef PG8_SB
#undef PG8_STAGE
#undef PG8_LDA
#undef PG8_LDB
#undef PG8_MMA
#undef PG8_WAIT_V
#undef PG8_WAIT_L
#undef PG8_BAR
#undef PG8_SCHED
}
}
using pg8::bf16_t; using pg8::bf16x8; using pg8::f32x4;
typedef short s16x4 __attribute__((ext_vector_type(4)));
typedef float f32x16 __attribute__((ext_vector_type(16)));
typedef float f32x2 __attribute__((ext_vector_type(2)));
typedef __bf16 bf2_t __attribute__((ext_vector_type(2)));
typedef unsigned u32x2 __attribute__((ext_vector_type(2)));
typedef unsigned u32x4 __attribute__((ext_vector_type(4)));
#define LAS __attribute__((address_space(3)))
#define DI __device__ __forceinline__
#define MFMA32(a, b, c) __builtin_amdgcn_mfma_f32_32x32x16_bf16((a), (b), (c), 0, 0, 0)

DI int otid() { int t = threadIdx.x; asm volatile("" : "+v"(t)); return t; }
DI unsigned pk2(float a, float b) { f32x2 v = {a, b}; bf2_t r = __builtin_convertvector(v, bf2_t); return __builtin_bit_cast(unsigned, r); }
DI float bflo(unsigned u) { return __uint_as_float(u << 16); }
DI float bfhi(unsigned u) { return __uint_as_float(u & 0xffff0000u); }
DI float fexp2(float x) { return __builtin_amdgcn_exp2f(x); }
DI float frcp(float x) { return __builtin_amdgcn_rcpf(x); }
DI float fsilu(float x) { return x * frcp(1.0f + fexp2(-1.44269504089f * x)); }
DI int crow(int i, int h) { return (i & 3) + 8 * (i >> 2) + 4 * h; }
DI s16x4 trr(const LAS unsigned char* p) { return __builtin_amdgcn_ds_read_tr16_b64_v4i16((LAS s16x4*)p); }
DI bf16x8 tr2(const LAS unsigned char* p0, const LAS unsigned char* p1) { s16x4 a = trr(p0), b = trr(p1); return __builtin_shufflevector(a, b, 0, 1, 2, 3, 4, 5, 6, 7); }
DI bf16x8 pack8(const f32x16& x, int s) {
    u32x4 p; p[0] = pk2(x[8 * s], x[8 * s + 1]); p[1] = pk2(x[8 * s + 2], x[8 * s + 3]); p[2] = pk2(x[8 * s + 4], x[8 * s + 5]); p[3] = pk2(x[8 * s + 6], x[8 * s + 7]);
    return __builtin_bit_cast(bf16x8, p);
}
DI f32x16 zero16() { f32x16 z; for (int i = 0; i < 16; ++i) z[i] = 0.f; return z; }

constexpr int MT = 16384, SEQ = 8192, DM = 1024, DFF = 2816, AINW = 3072, SINW = 6176, SINWP = 6400, DIN = 2048, XBCW = 4096;
constexpr float LOG2E = 1.44269504089f;
constexpr int LDS_BYTES = 155648;
constexpr size_t W_AIN = 0, W_AOUT = W_AIN + (size_t)AINW * DM * 2, W_GU0 = W_AOUT + (size_t)DM * DM * 2, W_DN0 = W_GU0 + (size_t)2 * DFF * DM * 2,
                 W_SIN = W_DN0 + (size_t)DM * DFF * 2, W_SOUT = W_SIN + (size_t)SINWP * DM * 2, W_GU1 = W_SOUT + (size_t)DM * DIN * 2, W_DN1 = W_GU1 + (size_t)2 * DFF * DM * 2,
                 O_HB = W_DN1 + (size_t)DM * DFF * 2, O_SS = O_HB + (size_t)MT * DM * 2, O_ROPE = O_SS + (size_t)5 * MT * 4, O_DT = O_ROPE + (size_t)SEQ * 32 * 8,
                 O_CDEC = O_DT + (size_t)MT * 32 * 4, O_LAM = O_CDEC + 16384, O_BAR = O_LAM + 256, O_R = 98566144;
static_assert(O_BAR + 20480 <= O_R, "map");
constexpr size_t O_PROJ = O_R, O_MIXED = O_PROJ + (size_t)MT * AINW * 2, O_ACT = O_R, O_XBC = O_R, O_ST1 = O_XBC + (size_t)MT * XBCW * 2, O_ST0 = 0;
constexpr size_t ST_BATCH = (size_t)64 * 32 * 64 * 128;
static_assert(O_ST1 + ST_BATCH * 2 <= 268435456ull, "ws");
static_assert(ST_BATCH * 2 <= W_SOUT, "st0 overlay");
static_assert(O_MIXED + (size_t)MT * DM * 2 <= 268435456ull, "ws2");

struct Params { const float* in[23]; float* out; unsigned char* ws; };
#include <cstdlib>
#include <vector>

#define XB_TMO      128
#define XB_XCNT(j)  (256  + 64 * (j))
#define XB_XSUB(j)  (1280 + 64 * (j))
#define XB_XGEN(j)  (2304 + 64 * (j))
#define XB_TOP      3328
#define XB_TOPGEN   3392
#define XCD_BAR_WORDS 3456
#define XB_SPIN_CAP (1u << 18)

__device__ __forceinline__ unsigned xb_ld(unsigned* p)              { return __hip_atomic_load(p, __ATOMIC_RELAXED, __HIP_MEMORY_SCOPE_AGENT); }
__device__ __forceinline__ unsigned xb_add(unsigned* p, unsigned v) { return __hip_atomic_fetch_add(p, v, __ATOMIC_RELAXED, __HIP_MEMORY_SCOPE_AGENT); }
__device__ __forceinline__ unsigned xb_xcc_id() { return (unsigned)__builtin_amdgcn_s_getreg((3 << 11) | 20) & 0xFu; }
#define XB_SPIN(cond, bar) do { unsigned _sp = 0; while (cond) { __builtin_amdgcn_s_sleep(1); \
    if ((++_sp & 255u) == 0u) { if (xb_ld(&(bar)[XB_TMO])) break; if (_sp > XB_SPIN_CAP) { atomicAdd(&(bar)[XB_TMO], 1u); break; } } } } while (0)

struct XcdBarrier {
    unsigned* bar; unsigned x;
    volatile LAS unsigned* st;
};

__device__ __forceinline__ XcdBarrier xcd_barrier_post(unsigned* bar, volatile LAS unsigned* st) {
    XcdBarrier b; b.bar = bar; b.x = xb_xcc_id(); b.st = st;
    if (threadIdx.x == 0) (void)xb_add(&bar[XB_XCNT(b.x)], 1u);
    return b;
}
__device__ __forceinline__ void xcd_barrier_complete(unsigned* bar, unsigned x, unsigned& nloc, unsigned& nx) {
    const unsigned G = gridDim.x * gridDim.y * gridDim.z;
    unsigned sum, cnt, mine, sp = 0u;
    for (;;) {
        sum = 0u; cnt = 0u; mine = 0u;
#pragma unroll
        for (unsigned j = 0; j < 16; ++j) { const unsigned c = xb_ld(&bar[XB_XCNT(j)]); sum += c; cnt += (c > 0u) ? 1u : 0u; mine = (j == x) ? c : mine; }
        if (sum == G) break;
        __builtin_amdgcn_s_sleep(1);
        if ((++sp & 255u) == 0u) { if (xb_ld(&bar[XB_TMO])) break; if (sp > XB_SPIN_CAP) { atomicAdd(&bar[XB_TMO], 1u); break; } }
    }
    nloc = mine > 0u ? mine : 1u; nx = cnt > 0u ? cnt : 1u;
}

__device__ __forceinline__ void xcd_barrier(const XcdBarrier& b) {
    asm volatile("s_waitcnt vmcnt(0)" ::: "memory");
    __syncthreads();
    if (threadIdx.x == 0) {
        unsigned* bar = b.bar;
        __builtin_amdgcn_s_waitcnt(0);
        unsigned nloc = b.st[0], nx = b.st[1];
        if (nloc == 0u) { xcd_barrier_complete(bar, b.x, nloc, nx); b.st[0] = nloc; b.st[1] = nx; }
        const unsigned old = xb_add(&bar[XB_XSUB(b.x)], 1u);
        const unsigned gen = old / nloc;
        if (old + 1u == (gen + 1u) * nloc) {
            __builtin_amdgcn_fence(__ATOMIC_RELEASE, "agent");
            asm volatile("s_waitcnt vmcnt(0)" ::: "memory");
            const unsigned og = xb_add(&bar[XB_TOP], 1u);
            const unsigned tg = og / nx;
            if (og + 1u == (tg + 1u) * nx) xb_add(&bar[XB_TOPGEN], 1u);
            else XB_SPIN(xb_ld(&bar[XB_TOPGEN]) == tg, bar);
            __builtin_amdgcn_fence(__ATOMIC_ACQUIRE, "agent");
            xb_add(&bar[XB_XGEN(b.x)], 1u);
            asm volatile("s_waitcnt vmcnt(0)" ::: "memory");
        } else {
            XB_SPIN(xb_ld(&bar[XB_XGEN(b.x)]) == gen, bar);
            __builtin_amdgcn_fence(__ATOMIC_ACQUIRE, "agent");
            asm volatile("s_waitcnt vmcnt(0)" ::: "memory");
        }
    }
    __syncthreads();
}
DI void wmap(int mode, int c, int& src, float& scale, int& which) {
    src = c; scale = 1.f; which = 0;
    if (mode == 0) {
        if (c < 1024) { const int base = c & ~63, cc = c & 63, g = cc >> 3, e = cc & 7; src = base + (e < 4 ? 4 * g + e : 32 + 4 * g + (e - 4)); }
        if (c < 512) scale = 0.125f * LOG2E; else if (c >= 1536 && c < 2048) scale = 0.125f;
    } else if (mode == 2) { src = 4 * (c >> 3) + (c & 3); which = (c >> 2) & 1; }
    else if (mode == 3) { if (c >= SINW) src = -1; }
}
struct WJob { int mode, K, ldw, tix; const float* W0; const float* W1; const float* ks; bf16_t* dst; };
DI WJob wjob(const Params& p, int t) {
    unsigned char* ws = p.ws;
    const int cnt[8] = {48 * 4, 16 * 4, 88 * 4, 16 * 11, 100 * 4, 16 * 8, 88 * 4, 16 * 11};
    int j = 0, tt = t;
#pragma unroll
    for (int q = 0; q < 7; ++q) if (j == q && tt >= cnt[q]) { tt -= cnt[q]; j = q + 1; }
    WJob J; J.tix = tt; J.W1 = nullptr; J.ks = nullptr;
    switch (j) {
    case 0: J.mode = 0; J.W0 = p.in[2]; J.ks = p.in[1]; J.dst = (bf16_t*)(ws + W_AIN); J.K = DM; J.ldw = AINW; break;
    case 1: J.mode = 1; J.W0 = p.in[8]; J.dst = (bf16_t*)(ws + W_AOUT); J.K = DM; J.ldw = DM; break;
    case 2: J.mode = 2; J.W0 = p.in[19]; J.W1 = p.in[20]; J.ks = p.in[18]; J.dst = (bf16_t*)(ws + W_GU0); J.K = DM; J.ldw = DFF; break;
    case 3: J.mode = 1; J.W0 = p.in[21]; J.dst = (bf16_t*)(ws + W_DN0); J.K = DFF; J.ldw = DM; break;
    case 4: J.mode = 3; J.W0 = p.in[10]; J.ks = p.in[9]; J.dst = (bf16_t*)(ws + W_SIN); J.K = DM; J.ldw = SINW; break;
    case 5: J.mode = 1; J.W0 = p.in[17]; J.dst = (bf16_t*)(ws + W_SOUT); J.K = DIN; J.ldw = DM; break;
    case 6: J.mode = 2; J.W0 = p.in[19] + (size_t)DM * DFF; J.W1 = p.in[20] + (size_t)DM * DFF; J.ks = p.in[18] + DM; J.dst = (bf16_t*)(ws + W_GU1); J.K = DM; J.ldw = DFF; break;
    default: J.mode = 1; J.W0 = p.in[21] + (size_t)DFF * DM; J.dst = (bf16_t*)(ws + W_DN1); J.K = DFF; J.ldw = DM; break;
    }
    return J;
}
DI void wtile_load(const WJob& J, int tid, float (&v)[32], float& sc, int& srcok) {
    const int nk = J.K >> 8, c0 = (J.tix / nk) * 64, k0 = (J.tix % nk) * 256, cc = tid & 63; int src, which; wmap(J.mode, c0 + cc, src, sc, which);
    const float* W = (which ? J.W1 : J.W0) + (src >= 0 ? src : 0); srcok = (src >= 0);
#pragma unroll
    for (int i = 0; i < 32; ++i) { const int kk = (tid >> 6) + 8 * i; v[i] = W[(size_t)(k0 + kk) * J.ldw]; }
}
DI void wtile_store(LAS float* tile, const WJob& J, int tid, const float (&v)[32], float sc, int srcok) {
    const int nk = J.K >> 8, c0 = (J.tix / nk) * 64, k0 = (J.tix % nk) * 256, cc = tid & 63;
#pragma unroll
    for (int i = 0; i < 32; ++i) { const int kk = (tid >> 6) + 8 * i; float x = srcok ? v[i] * sc : 0.f; if (J.ks) x *= J.ks[k0 + kk]; tile[kk * 65 + cc] = x; }
    __syncthreads();
#pragma unroll
    for (int i = 0; i < 16; ++i) {
        const int idx = tid + 512 * i, c2 = idx >> 7, k2 = (idx & 127) * 2;
        *(unsigned*)(J.dst + (size_t)(c0 + c2) * J.K + k0 + k2) = pk2(tile[k2 * 65 + c2], tile[(k2 + 1) * 65 + c2]);
    }
    __syncthreads();
}
DI void wconv_jobs(LAS unsigned char* lds, const Params& p, int wi, int nb) {
    const int tid = otid(); const int total = 48 * 4 + 16 * 4 + 2 * (88 * 4 + 16 * 11) + 100 * 4 + 16 * 8;
    if (wi >= total) return;
    WJob J = wjob(p, wi); float v[32]; float sc; int ok;
    wtile_load(J, tid, v, sc, ok);
    for (int t = wi; t < total; t += nb) {
        const bool more = (t + nb < total);
        WJob Jn = J; float vn[32]; float scn = 0.f; int okn = 0;
        if (more) { Jn = wjob(p, t + nb); wtile_load(Jn, tid, vn, scn, okn); }
        wtile_store((LAS float*)lds, J, tid, v, sc, ok);
        if (more) { J = Jn; sc = scn; ok = okn;
#pragma unroll
            for (int i = 0; i < 32; ++i) v[i] = vn[i]; }
    }
}
DI void phase0(LAS unsigned char* lds, const Params& p) {
    const int tid = otid(), G = gridDim.x, bx = blockIdx.x;
    unsigned char* ws = p.ws;
    wconv_jobs(lds, p, bx, G);
    {
        const int wave = tid >> 6, lane = tid & 63; bf16_t* hb = (bf16_t*)(ws + O_HB); float* ss = (float*)(ws + O_SS);
        for (int row0 = (bx * 8 + wave) * 2; row0 < MT; row0 += G * 16) {
            f32x4 v[2][4];
#pragma unroll
            for (int q = 0; q < 2; ++q)
#pragma unroll
                for (int i = 0; i < 4; ++i) v[q][i] = *(const f32x4*)(p.in[0] + (size_t)(row0 + q) * DM + lane * 4 + 256 * i);
#pragma unroll
            for (int q = 0; q < 2; ++q) {
                float sq = 0.f;
#pragma unroll
                for (int i = 0; i < 4; ++i) { const f32x4 x = v[q][i]; sq += x[0] * x[0] + x[1] * x[1] + x[2] * x[2] + x[3] * x[3];
                    u32x2 o; o[0] = pk2(x[0], x[1]); o[1] = pk2(x[2], x[3]); *(u32x2*)(hb + (size_t)(row0 + q) * DM + lane * 4 + 256 * i) = o; }
#pragma unroll
                for (int o = 32; o >= 1; o >>= 1) sq += __shfl_xor(sq, o);
                if (lane == 0) ss[row0 + q] = sq;
            }
        }
        for (int i = bx * 512 + tid; i < 4 * MT; i += G * 512) ss[MT + i] = 0.f;
        f32x2* tab = (f32x2*)(ws + O_ROPE);
        for (int i = bx * 512 + tid; i < SEQ * 32; i += G * 512) {
            const int pos = i >> 5, f = i & 31; const float inv = fexp2(-(float)f * 0.41524101186092f); const float ang = (float)pos * inv;
            double t = (double)ang * 0.15915494309189535; t -= floor(t); const float tf = (float)t;
            f32x2 cs; cs[0] = __builtin_amdgcn_cosf(tf); cs[1] = __builtin_amdgcn_sinf(tf); tab[i] = cs;
        }
        if (bx == 0 && tid == 0) { float s1 = 0.f, s2 = 0.f; for (int i = 0; i < 64; ++i) { s1 += p.in[3][i] * p.in[4][i]; s2 += p.in[5][i] * p.in[6][i]; }
            *(float*)(ws + O_LAM) = fexp2(s1 * LOG2E) - fexp2(s2 * LOG2E) + 0.2f; }
    }
}

struct EpiAttnIn {
    static constexpr bool PERM = true, AFTER_DRAIN = false;
    bf16_t* O; const float* ss; const f32x4* tab;
    DI void operator()(const f32x4 (&acc)[2][2][4][2], const pg8::Unit& u, int wr, int wc, int fr, int fq) const {
        const int row0 = u.pm * 256 + wr * 64 + fr, colt = u.pn * 256, col0 = colt + wc * 32 + 8 * fq;
        const int fb = 4 * (4 * (wc & 1) + fq);
#pragma unroll
        for (int ai = 0; ai < 2; ++ai)
#pragma unroll
            for (int m = 0; m < 4; ++m) {
                const int row = row0 + ai * 128 + m * 16; const float rs = __builtin_amdgcn_rsqf(ss[row] * (1.0f / 1024.0f) + 1e-6f);
                f32x4 c01 = {1.f, 0.f, 1.f, 0.f}, c23 = {1.f, 0.f, 1.f, 0.f};
                if (colt < 1024) { const int pos = row & (SEQ - 1); c01 = tab[(pos * 32 + fb) >> 1]; c23 = tab[((pos * 32 + fb) >> 1) + 1]; }
#pragma unroll
                for (int bj = 0; bj < 2; ++bj) {
                    f32x4 v0 = acc[ai][bj][m][0] * rs, v1 = acc[ai][bj][m][1] * rs;
                    if (colt < 1024) {
                        const float cs[4] = {c01[0], c01[2], c23[0], c23[2]}, sn[4] = {c01[1], c01[3], c23[1], c23[3]};
#pragma unroll
                        for (int j = 0; j < 4; ++j) { const float t1 = v0[j], t2 = v1[j]; v0[j] = t1 * cs[j] - t2 * sn[j]; v1[j] = t2 * cs[j] + t1 * sn[j]; }
                    }
                    u32x4 o; o[0] = pk2(v0[0], v0[1]); o[1] = pk2(v0[2], v0[3]); o[2] = pk2(v1[0], v1[1]); o[3] = pk2(v1[2], v1[3]);
                    *(u32x4*)(O + (size_t)row * AINW + col0 + bj * 128) = o;
                }
            }
    }
};
template <bool RES_F32, bool OUT_F32> struct EpiRes {
    static constexpr bool PERM = false, AFTER_DRAIN = false;
    const float* xres; bf16_t* hb; float* outf; float* ssn;
    DI void operator()(const f32x4 (&acc)[2][2][4][2], const pg8::Unit& u, int wr, int wc, int fr, int fq) const {
        const int row0 = u.pm * 256 + wr * 64 + fr, col0 = u.pn * 256 + wc * 32 + 4 * fq;
#pragma unroll
        for (int ai = 0; ai < 2; ++ai)
#pragma unroll
            for (int m = 0; m < 4; ++m) {
                const int row = row0 + ai * 128 + m * 16; float sq = 0.f;
#pragma unroll
                for (int bj = 0; bj < 2; ++bj)
#pragma unroll
                    for (int n = 0; n < 2; ++n) {
                        const size_t off = (size_t)row * DM + col0 + bj * 128 + n * 16; f32x4 r;
                        if (RES_F32) r = *(const f32x4*)(xres + off);
                        else { const u32x2 t = *(const u32x2*)(hb + off); r[0] = bflo(t[0]); r[1] = bfhi(t[0]); r[2] = bflo(t[1]); r[3] = bfhi(t[1]); }
                        const f32x4 v = r + acc[ai][bj][m][n];
                        sq += v[0] * v[0] + v[1] * v[1] + v[2] * v[2] + v[3] * v[3];
                        if (OUT_F32) *(f32x4*)(outf + off) = v;
                        else { u32x2 o; o[0] = pk2(v[0], v[1]); o[1] = pk2(v[2], v[3]); *(u32x2*)(hb + off) = o; }
                    }
                sq += __shfl_xor(sq, 16); sq += __shfl_xor(sq, 32);
                if (fq == 0) atomicAdd(ssn + row, sq);
            }
    }
};
struct EpiGU {
    static constexpr bool PERM = true, AFTER_DRAIN = false;
    bf16_t* act; const float* ss;
    DI void operator()(const f32x4 (&acc)[2][2][4][2], const pg8::Unit& u, int wr, int wc, int fr, int fq) const {
        const int row0 = u.pm * 256 + wr * 64 + fr, col0 = u.pn * 256 + wc * 32 + 8 * fq;
#pragma unroll
        for (int ai = 0; ai < 2; ++ai)
#pragma unroll
            for (int m = 0; m < 4; ++m) {
                const int row = row0 + ai * 128 + m * 16; const float rs = __builtin_amdgcn_rsqf(ss[row] * (1.0f / 1024.0f) + 1e-6f);
#pragma unroll
                for (int bj = 0; bj < 2; ++bj) {
                    const f32x4 g = acc[ai][bj][m][0] * rs, up = acc[ai][bj][m][1] * rs; float a[4];
#pragma unroll
                    for (int j = 0; j < 4; ++j) a[j] = fsilu(g[j]) * up[j];
                    u32x2 o; o[0] = pk2(a[0], a[1]); o[1] = pk2(a[2], a[3]);
                    *(u32x2*)(act + (size_t)row * DFF + ((col0 + bj * 128) >> 1)) = o;
                }
            }
    }
};
struct EpiSsdIn {
    static constexpr bool PERM = true, AFTER_DRAIN = false;
    bf16_t* z; bf16_t* xbc; float* dt; const float* ss;
    DI void operator()(const f32x4 (&acc)[2][2][4][2], const pg8::Unit& u, int wr, int wc, int fr, int fq) const {
        const int row0 = u.pm * 256 + wr * 64 + fr, col0 = u.pn * 256 + wc * 32 + 8 * fq;
#pragma unroll
        for (int ai = 0; ai < 2; ++ai)
#pragma unroll
            for (int m = 0; m < 4; ++m) {
                const int row = row0 + ai * 128 + m * 16; const float rs = __builtin_amdgcn_rsqf(ss[row] * (1.0f / 1024.0f) + 1e-6f);
#pragma unroll
                for (int bj = 0; bj < 2; ++bj) {
                    const int c = col0 + bj * 128; const f32x4 v0 = acc[ai][bj][m][0] * rs, v1 = acc[ai][bj][m][1] * rs;
                    if (c < 6144) { u32x4 o; o[0] = pk2(v0[0], v0[1]); o[1] = pk2(v0[2], v0[3]); o[2] = pk2(v1[0], v1[1]); o[3] = pk2(v1[2], v1[3]);
                        if (c < DIN) *(u32x4*)(z + (size_t)row * DIN + c) = o; else *(u32x4*)(xbc + (size_t)row * XBCW + (c - DIN)) = o; }
                }
            }
    }
};

struct EpiFinal {
    static constexpr bool PERM = false, AFTER_DRAIN = true;
    const bf16_t* hb; float* outf; float* ssn; unsigned* cnt; const float* fw;
    DI void operator()(const f32x4 (&)[2][2][4][2], const pg8::Unit&, int, int, int, int) const {}
    DI void fused(f32x4 (&acc)[2][2][4][2], const pg8::Unit& u, int wr, int wc, int fr, int fq, PG8_LAS unsigned char*, int, int) const {
        const int row0 = u.pm * 256 + wr * 64 + fr, col0 = u.pn * 256 + wc * 32 + 4 * fq;
#pragma unroll
        for (int ai = 0; ai < 2; ++ai)
#pragma unroll
            for (int m = 0; m < 4; ++m) {
                const int row = row0 + ai * 128 + m * 16; float sq = 0.f;
#pragma unroll
                for (int bj = 0; bj < 2; ++bj)
#pragma unroll
                    for (int n = 0; n < 2; ++n) {
                        const size_t off = (size_t)row * DM + col0 + bj * 128 + n * 16;
                        const u32x2 t = *(const u32x2*)(hb + off); f32x4 r; r[0] = bflo(t[0]); r[1] = bfhi(t[0]); r[2] = bflo(t[1]); r[3] = bfhi(t[1]);
                        const f32x4 v = r + acc[ai][bj][m][n]; acc[ai][bj][m][n] = v;
                        sq += v[0] * v[0] + v[1] * v[1] + v[2] * v[2] + v[3] * v[3];
                    }
                sq += __shfl_xor(sq, 16); sq += __shfl_xor(sq, 32);
                if (fq == 0) atomicAdd(ssn + row, sq);
            }
        asm volatile("s_waitcnt vmcnt(0)" ::: "memory");
        __syncthreads();
        unsigned* c = cnt + 16 * u.pm;
        if (threadIdx.x == 0) {
            __builtin_amdgcn_fence(__ATOMIC_RELEASE, "agent"); asm volatile("s_waitcnt vmcnt(0)" ::: "memory");
            __hip_atomic_fetch_add(c, 1u, __ATOMIC_RELAXED, __HIP_MEMORY_SCOPE_AGENT);
            unsigned spins = 0;
            while (__hip_atomic_load(c, __ATOMIC_RELAXED, __HIP_MEMORY_SCOPE_AGENT) < 4u && ++spins < (1u << 22)) __builtin_amdgcn_s_sleep(2);
            __builtin_amdgcn_fence(__ATOMIC_ACQUIRE, "agent"); asm volatile("s_waitcnt vmcnt(0)" ::: "memory");
        }
        __syncthreads();
#pragma unroll
        for (int ai = 0; ai < 2; ++ai)
#pragma unroll
            for (int m = 0; m < 4; ++m) {
                const int row = row0 + ai * 128 + m * 16;
                const float rs = __builtin_amdgcn_rsqf(__hip_atomic_load(ssn + row, __ATOMIC_RELAXED, __HIP_MEMORY_SCOPE_AGENT) * (1.0f / 1024.0f) + 1e-6f);
#pragma unroll
                for (int bj = 0; bj < 2; ++bj)
#pragma unroll
                    for (int n = 0; n < 2; ++n) {
                        const int col = col0 + bj * 128 + n * 16; const f32x4 w = *(const f32x4*)(fw + col);
                        *(f32x4*)(outf + (size_t)row * DM + col) = acc[ai][bj][m][n] * rs * w;
                    }
            }
    }
};
constexpr int KST = 144, VST = 320, VST64 = 192;
constexpr int AT_K1 = 0, AT_K2 = 64 * KST, AT_V = 2 * 64 * KST, AT_STAGE = AT_V + 64 * VST;

DI void diff_tile(LAS unsigned char* lds, const bf16_t* proj, bf16_t* mixed, const float* subln, float lam, int b, int hd, int qt) {
    const int tid = otid(), w = __builtin_amdgcn_readfirstlane(tid >> 6), lane = tid & 63, qg = w & 3, mp = w >> 2, r = lane & 31, h = lane >> 5;
    const int q0 = qt * 128; const size_t rowb = (size_t)b * SEQ;
    bf16x8 qf[4];
    { const bf16_t* qp = proj + (rowb + q0 + 32 * qg + r) * AINW + hd * 128 + mp * 64 + 8 * h;
#pragma unroll
      for (int s = 0; s < 4; ++s) qf[s] = *(const bf16x8*)(qp + 16 * s); }
    f32x16 O[4];
#pragma unroll
    for (int i = 0; i < 4; ++i) O[i] = zero16();
    float mrun = 0.f, lrun = 0.f;
    const int nsteps = 2 * (qt + 1);
    const bf16_t* src[4]; int dst[4];
#pragma unroll
    for (int i = 0; i < 2; ++i) { const int cid = tid + 512 * i, row = cid >> 4, c16 = cid & 15;
        src[i] = proj + (rowb + row) * AINW + 512 + hd * 128 + c16 * 8; dst[i] = (c16 < 8 ? AT_K1 : AT_K2) + row * KST + (c16 & 7) * 16;
        src[2 + i] = proj + (rowb + row) * AINW + 1024 + hd * 128 + c16 * 8; dst[2 + i] = AT_V + row * VST + c16 * 16; }
    u32x4 pf[4];
#pragma unroll
    for (int i = 0; i < 4; ++i) pf[i] = *(const u32x4*)(src[i]);
#pragma unroll
    for (int i = 0; i < 4; ++i) *(LAS u32x4*)(lds + dst[i]) = pf[i];
    __syncthreads();
    const int i16 = lane & 15, tq = i16 >> 2, tp = i16 & 3, g16 = (lane >> 4) & 1;
    const int troff = (4 * h + tq) * VST + (16 * g16 + 4 * tp) * 2;
    for (int j = 0; j < nsteps; ++j) {
        const bool more = (j + 1 < nsteps);
        if (more) {
#pragma unroll
            for (int i = 0; i < 4; ++i) pf[i] = *(const u32x4*)(src[i] + (size_t)(j + 1) * 64 * AINW);
        }
        const LAS unsigned char* base = lds + (j & 1) * AT_STAGE;
        const LAS unsigned char* Kb = base + (mp ? AT_K2 : AT_K1);
        const LAS unsigned char* Vb = base + AT_V;
        f32x16 S[2];
        const float negm = -mrun;
#pragma unroll
        for (int kt = 0; kt < 2; ++kt) {
#pragma unroll
            for (int i = 0; i < 16; ++i) S[kt][i] = negm;
#pragma unroll
            for (int s = 0; s < 4; ++s) { const bf16x8 kf = *(const LAS bf16x8*)(Kb + (32 * kt + r) * KST + (16 * s + 8 * h) * 2); S[kt] = MFMA32(kf, qf[s], S[kt]); } }
        const int qidx = q0 + 32 * qg + r, kbase = 64 * j;
        if (kbase + 63 > q0 + 32 * qg) {
#pragma unroll
            for (int kt = 0; kt < 2; ++kt)
#pragma unroll
                for (int i = 0; i < 16; ++i) if (kbase + 32 * kt + crow(i, h) > qidx) S[kt][i] = -1e30f;
        }
        float mx = S[0][0];
#pragma unroll
        for (int kt = 0; kt < 2; ++kt)
#pragma unroll
            for (int i = 0; i < 16; ++i) mx = fmaxf(mx, S[kt][i]);
        mx = fmaxf(mx, __shfl_xor(mx, 32));
        if (j == 0 || __builtin_amdgcn_ballot_w64(mx > 8.0f) != 0ull) {
            const float d = (j == 0) ? mx : fmaxf(mx, 0.f);
            mrun += d;
            if (j != 0) { const float alpha = fexp2(-d); lrun *= alpha;
#pragma unroll
                for (int vt = 0; vt < 4; ++vt) O[vt] = O[vt] * alpha; }
#pragma unroll
            for (int kt = 0; kt < 2; ++kt)
#pragma unroll
                for (int i = 0; i < 16; ++i) S[kt][i] -= d;
        }
        float ls = 0.f;
#pragma unroll
        for (int kt = 0; kt < 2; ++kt)
#pragma unroll
            for (int i = 0; i < 16; ++i) { const float pv = fexp2(S[kt][i]); S[kt][i] = pv; ls += pv; }
        lrun += ls;
#pragma unroll
        for (int kt = 0; kt < 2; ++kt)
#pragma unroll
            for (int s2 = 0; s2 < 2; ++s2) {
                const bf16x8 pfr = pack8(S[kt], s2);
                const LAS unsigned char* vrow = Vb + (32 * kt + 16 * s2) * VST + troff;
#pragma unroll
                for (int vt = 0; vt < 4; ++vt) { const bf16x8 vf = tr2(vrow + vt * 64, vrow + 8 * VST + vt * 64); O[vt] = MFMA32(vf, pfr, O[vt]); }
            }
        if (more) {
            LAS unsigned char* nb = lds + ((j + 1) & 1) * AT_STAGE;
#pragma unroll
            for (int i = 0; i < 4; ++i) *(LAS u32x4*)(nb + dst[i]) = pf[i];
        }
        __syncthreads();
    }
    lrun += __shfl_xor(lrun, 32);
    const float inv = frcp(lrun);
    LAS float* ex = (LAS float*)lds;
    if (mp == 1) {
        const float sc = inv * lam;
#pragma unroll
        for (int vt = 0; vt < 4; ++vt)
#pragma unroll
            for (int i = 0; i < 16; ++i) ex[(qg * 128 + 32 * vt + crow(i, h)) * 32 + r] = O[vt][i] * sc;
    }
    __syncthreads();
    if (mp == 0) {
        float sq = 0.f;
#pragma unroll
        for (int vt = 0; vt < 4; ++vt)
#pragma unroll
            for (int i = 0; i < 16; ++i) { const float o = O[vt][i] * inv - ex[(qg * 128 + 32 * vt + crow(i, h)) * 32 + r]; O[vt][i] = o; sq += o * o; }
        sq += __shfl_xor(sq, 32);
        const float rn = __builtin_amdgcn_rsqf(sq * (1.0f / 128.0f) + 1e-5f) * 0.8f;
        bf16_t* op = mixed + (rowb + q0 + 32 * qg + r) * DM + hd * 128;
#pragma unroll
        for (int vt = 0; vt < 4; ++vt)
#pragma unroll
            for (int gq = 0; gq < 4; ++gq) { const int v0 = 32 * vt + 8 * gq + 4 * h; const f32x4 wv = *(const f32x4*)(subln + v0);
                u32x2 o; o[0] = pk2(O[vt][4 * gq] * rn * wv[0], O[vt][4 * gq + 1] * rn * wv[1]); o[1] = pk2(O[vt][4 * gq + 2] * rn * wv[2], O[vt][4 * gq + 3] * rn * wv[3]);
                *(u32x2*)(op + v0) = o; }
    }
    __syncthreads();
}

constexpr int SB_K = 0, SB_V = 64 * KST, SB_STAGE = 64 * KST + 64 * VST64;
DI void sb_block(LAS unsigned char* lds, const bf16_t* proj, bf16_t* mixed, int b, int hs, int qb) {
    const int tid = otid(), w = __builtin_amdgcn_readfirstlane(tid >> 6), lane = tid & 63, r = lane & 31, h = lane >> 5;
    const int q0 = qb * 256; const size_t rowb = (size_t)b * SEQ;
    const int qidx = q0 + 32 * w + r;
    bf16x8 qf[4];
    { const bf16_t* qp = proj + (rowb + qidx) * AINW + 1536 + hs * 64 + 8 * h;
#pragma unroll
      for (int s = 0; s < 4; ++s) qf[s] = *(const bf16x8*)(qp + 16 * s); }
    f32x16 O[2]; O[0] = zero16(); O[1] = zero16();
    float carry = 1.0f;
    const int jmax = 4 * qb + 3;
    const int srow = tid >> 3, sc8 = tid & 7;
    const bf16_t* srcK = proj + (rowb + srow) * AINW + 2048 + hs * 64 + sc8 * 8;
    const bf16_t* srcV = proj + (rowb + srow) * AINW + 2560 + hs * 64 + sc8 * 8;
    const int dstK = SB_K + srow * KST + sc8 * 16, dstV = SB_V + srow * VST64 + sc8 * 16;
    u32x4 pk_ = *(const u32x4*)(srcK + (size_t)jmax * 64 * AINW), pv_ = *(const u32x4*)(srcV + (size_t)jmax * 64 * AINW);
    *(LAS u32x4*)(lds + dstK) = pk_; *(LAS u32x4*)(lds + dstV) = pv_;
    __syncthreads();
    const int i16 = lane & 15, tq = i16 >> 2, tp = i16 & 3, g16 = (lane >> 4) & 1;
    const int troff = (4 * h + tq) * VST64 + (16 * g16 + 4 * tp) * 2;
    int it = 0;
    for (int j = jmax; j >= 0; --j, ++it) {
        const bool more = (j > 0);
        if (more) { pk_ = *(const u32x4*)(srcK + (size_t)(j - 1) * 64 * AINW); pv_ = *(const u32x4*)(srcV + (size_t)(j - 1) * 64 * AINW); }
        const LAS unsigned char* base = lds + (it & 1) * SB_STAGE;
        const int kbase = 64 * j;
        if (kbase < q0 + 32 * w + 32) {
#pragma unroll
            for (int kt = 1; kt >= 0; --kt) {
                f32x16 S = zero16();
#pragma unroll
                for (int s = 0; s < 4; ++s) { const bf16x8 kf = *(const LAS bf16x8*)(base + SB_K + (32 * kt + r) * KST + (16 * s + 8 * h) * 2); S = MFMA32(kf, qf[s], S); }
                float T[4], sfx[16];
#pragma unroll
                for (int gq = 0; gq < 4; ++gq) {
                    float run = 1.0f;
#pragma unroll
                    for (int jj = 3; jj >= 0; --jj) {
                        const int i = 4 * gq + jj; const bool valid = (kbase + 32 * kt + crow(i, h)) < qidx;
                        const float zz = fmaxf(S[i], -60.0f); const float e = fexp2(-LOG2E * zz); const float sg = frcp(1.0f + e);
                        const float keep = valid ? e * sg : 1.0f;
                        S[i] = valid ? sg : 0.0f; sfx[i] = run; run *= keep;
                    }
                    T[gq] = run;
                }
                float To[4];
#pragma unroll
                for (int gq = 0; gq < 4; ++gq) To[gq] = __shfl_xor(T[gq], 32);
                float E[4]; float acc_hi = 1.0f;
#pragma unroll
                for (int gq = 3; gq >= 0; --gq) {
                    const float above_same = acc_hi;
                    E[gq] = (h == 0) ? above_same * To[gq] : above_same;
                    acc_hi = acc_hi * T[gq] * To[gq];
                }
#pragma unroll
                for (int i = 0; i < 16; ++i) S[i] = S[i] * carry * E[i >> 2] * sfx[i];
                carry *= acc_hi;
#pragma unroll
                for (int s2 = 0; s2 < 2; ++s2) {
                    const bf16x8 pfr = pack8(S, s2);
                    const LAS unsigned char* vrow = base + SB_V + (32 * kt + 16 * s2) * VST64 + troff;
#pragma unroll
                    for (int vt = 0; vt < 2; ++vt) { const bf16x8 vf = tr2(vrow + vt * 64, vrow + 8 * VST64 + vt * 64); O[vt] = MFMA32(vf, pfr, O[vt]); }
                }
            }
        }
        if (more) { LAS unsigned char* nb = lds + ((it + 1) & 1) * SB_STAGE; *(LAS u32x4*)(nb + dstK) = pk_; *(LAS u32x4*)(nb + dstV) = pv_; }
        const int done = (kbase < q0 + 32 * w + 32) && (carry < 1e-12f);
        const bool wdone = (__builtin_amdgcn_ballot_w64(done != 0) == ~0ull);
        LAS int* flg = (LAS int*)(lds + 2 * SB_STAGE) + (it & 1) * 8;
        if (lane == 0) flg[w] = wdone ? 1 : 0;
        __syncthreads();
        int all = 1;
#pragma unroll
        for (int ww = 0; ww < 8; ++ww) all &= flg[ww];
        if (all) break;
    }
    bf16_t* op = mixed + (rowb + qidx) * DM + 512 + hs * 64;
#pragma unroll
    for (int vt = 0; vt < 2; ++vt)
#pragma unroll
        for (int gq = 0; gq < 4; ++gq) { const int v0 = 32 * vt + 8 * gq + 4 * h;
            u32x2 o; o[0] = pk2(O[vt][4 * gq], O[vt][4 * gq + 1]); o[1] = pk2(O[vt][4 * gq + 2], O[vt][4 * gq + 3]); *(u32x2*)(op + v0) = o; }
    __syncthreads();
}
DI void attn_phase(LAS unsigned char* lds, const Params& p) {
    const bf16_t* proj = (const bf16_t*)(p.ws + O_PROJ); bf16_t* mixed = (bf16_t*)(p.ws + O_MIXED);
    const float lam = *(const float*)(p.ws + O_LAM);
    for (int it0 = blockIdx.x; it0 < 256; it0 += gridDim.x) {
        const int it = (it0 & 7) * 32 + (it0 >> 3);
        const int b = it >> 7, hd = (it >> 5) & 3, pr = it & 31;
        diff_tile(lds, proj, mixed, p.in[7], lam, b, hd, 63 - pr);
        diff_tile(lds, proj, mixed, p.in[7], lam, b, hd, pr);
    }
    for (int it0 = blockIdx.x; it0 < 512; it0 += gridDim.x) {
        const int it = (it0 & 7) * 64 + (it0 >> 3);
        const int b = it >> 8, hs = (it >> 5) & 7, qb = it & 31;
        sb_block(lds, proj, mixed, b, hs, qb);
    }
}
constexpr int SXS = 528, SXS2 = 576, SBS = 272, SBS2 = 320;
constexpr int L_SX = 0, L_SB = 128 * SXS2, L_SC = L_SB + 128 * SBS, L_SDT = L_SC + 128 * SBS, L_SAC = L_SDT + 2048, L_SSQ = L_SAC + 2048;
static_assert(L_SSQ + 4096 <= LDS_BYTES, "lds");

DI void ssd_dt_acum(LAS unsigned char* lds, const float* DT, const float* dt_bias, const float* a_log, size_t t0, int g) {
    LAS float* sdt = (LAS float*)(lds + L_SDT); LAS float* sac = (LAS float*)(lds + L_SAC);
    const int tid = otid(), hh = tid >> 7, l = tid & 127, head = 4 * g + hh, w = tid >> 6, lane = tid & 63;
    const float raw = DT[(t0 + l) * 32 + head] + dt_bias[head];
    const float dt = fmaxf(raw, 0.f) + __logf(1.0f + __expf(-fabsf(raw)));
    sdt[hh * 128 + l] = dt; sac[hh * 128 + l] = -dt * __expf(a_log[head]);
    __syncthreads();
    if (w < 4) {
        const float v0 = sac[w * 128 + 2 * lane], v1 = sac[w * 128 + 2 * lane + 1]; float s = v0 + v1;
#pragma unroll
        for (int off = 1; off < 64; off <<= 1) { const float t = __shfl_up(s, off); if (lane >= off) s += t; }
        const float ex = s - (v0 + v1);
        sac[w * 128 + 2 * lane] = ex + v0; sac[w * 128 + 2 * lane + 1] = ex + v0 + v1;
    }
    __syncthreads();
}
template <int NT, class F> DI void conv_strip(const bf16_t* src, int nzero, const float* cw, const float* cb, int ch, F&& emit) {
    f32x4 wlo[4], whi[4];
#pragma unroll
    for (int k = 0; k < 4; ++k) { wlo[k] = *(const f32x4*)(cw + k * XBCW + ch); whi[k] = *(const f32x4*)(cw + k * XBCW + ch + 4); }
    const f32x4 blo = *(const f32x4*)(cb + ch), bhi = *(const f32x4*)(cb + ch + 4);
    u32x4 raw[NT + 3];
#pragma unroll
    for (int i = 0; i < NT + 3; ++i) { const int ii = (i < nzero) ? nzero : i; raw[i] = *(const u32x4*)(src + (ptrdiff_t)(ii - 3) * XBCW); if (i < nzero) raw[i] = (u32x4){0u, 0u, 0u, 0u}; }
#pragma unroll
    for (int t = 0; t < NT; ++t) {
        float o[8];
#pragma unroll
        for (int e = 0; e < 8; ++e) {
            float a = (e < 4) ? blo[e & 3] : bhi[e & 3];
#pragma unroll
            for (int k = 0; k < 4; ++k) { const unsigned d = raw[t + k][e >> 1]; const float xv = (e & 1) ? bfhi(d) : bflo(d); a += ((e < 4) ? wlo[k][e & 3] : whi[k][e & 3]) * xv; }
            o[e] = fsilu(a);
        }
        emit(t, o);
    }
}
DI u32x4 pack8f(const float* o) { u32x4 r; r[0] = pk2(o[0], o[1]); r[1] = pk2(o[2], o[3]); r[2] = pk2(o[4], o[5]); r[3] = pk2(o[6], o[7]); return r; }

template <bool XW, bool WITH_C> DI void ssd_stage(LAS unsigned char* lds, const bf16_t* xbc, const float* cw, const float* cb, size_t t0, int c, int g) {
    const int tid = otid();
    LAS float* sdt = (LAS float*)(lds + L_SDT); LAS float* sac = (LAS float*)(lds + L_SAC);
    {
        const int c8 = tid & 31, tg = tid >> 5, l0 = 8 * tg, ch = 256 * g + 8 * c8, hh = c8 >> 3;
        const int nzero = (c == 0) ? (3 - l0 > 0 ? 3 - l0 : 0) : 0;
        const float alast = sac[hh * 128 + 127];
        conv_strip<8>(xbc + (t0 + l0) * XBCW + ch, nzero, cw, cb, ch, [&](int t, float* o) {
            if (XW) { const float wgt = sdt[hh * 128 + l0 + t] * __expf(alast - sac[hh * 128 + l0 + t]);
#pragma unroll
                for (int e = 0; e < 8; ++e) o[e] *= wgt; }
            *(LAS u32x4*)(lds + L_SX + (l0 + t) * (XW ? SXS2 : SXS) + c8 * 16) = pack8f(o); });
    }
    {
        const int c8 = tid & 15, tg = tid >> 4, l0 = 4 * tg;
        const int nzero = (c == 0) ? (3 - l0 > 0 ? 3 - l0 : 0) : 0;
        const int chb = DIN + 128 * g + 8 * c8;
        conv_strip<4>(xbc + (t0 + l0) * XBCW + chb, nzero, cw, cb, chb, [&](int t, float* o) { *(LAS u32x4*)(lds + L_SB + (l0 + t) * (XW ? SBS2 : SBS) + c8 * 16) = pack8f(o); });
        if (WITH_C) { const int chc = DIN + 1024 + 128 * g + 8 * c8;
            conv_strip<4>(xbc + (t0 + l0) * XBCW + chc, nzero, cw, cb, chc, [&](int t, float* o) { *(LAS u32x4*)(lds + L_SC + (l0 + t) * SBS + c8 * 16) = pack8f(o); }); }
    }
}
DI bf16_t* st_ptr(unsigned char* ws, int b) { return (bf16_t*)(ws + (b ? O_ST1 : O_ST0)); }

DI void ssd_states_phase(LAS unsigned char* lds, const Params& p) {
    const int tid = otid(), w = __builtin_amdgcn_readfirstlane(tid >> 6), lane = tid & 63, r = lane & 31, h = lane >> 5, hh = w >> 1, ph = w & 1;
    const bf16_t* xbc = (const bf16_t*)(p.ws + O_XBC); const float* DT = (const float*)(p.ws + O_DT); float* cdec = (float*)(p.ws + O_CDEC);
    const int i16 = lane & 15, tq = i16 >> 2, tp = i16 & 3, g16 = (lane >> 4) & 1;
    for (int it = blockIdx.x; it < 1024; it += gridDim.x) {
        const int b = it >> 9, c = (it >> 3) & 63, g = it & 7; const size_t t0 = (size_t)b * SEQ + (size_t)c * 128;
        ssd_dt_acum(lds, DT, p.in[13], p.in[14], t0, g);
        ssd_stage<true, false>(lds, xbc, p.in[11], p.in[12], t0, c, g);
        __syncthreads();
        f32x16 acc[4];
#pragma unroll
        for (int i = 0; i < 4; ++i) acc[i] = zero16();
        const LAS unsigned char* xa = lds + L_SX + (8 * h + tq) * SXS2 + (64 * hh + 32 * ph + 16 * g16 + 4 * tp) * 2;
        const LAS unsigned char* ba = lds + L_SB + (8 * h + tq) * SBS2 + (16 * g16 + 4 * tp) * 2;
#pragma unroll
        for (int s = 0; s < 8; ++s) {
            const bf16x8 af = tr2(xa + 16 * s * SXS2, xa + (16 * s + 4) * SXS2);
#pragma unroll
            for (int nt = 0; nt < 4; ++nt) { const bf16x8 bfr = tr2(ba + 16 * s * SBS2 + nt * 64, ba + (16 * s + 4) * SBS2 + nt * 64); acc[nt] = MFMA32(af, bfr, acc[nt]); }
        }
        bf16_t* st = st_ptr(p.ws, b) + ((size_t)(c * 32 + 4 * g + hh) * 64 + 32 * ph) * 128;
#pragma unroll
        for (int nt = 0; nt < 4; ++nt)
#pragma unroll
            for (int i = 0; i < 16; ++i) st[(size_t)crow(i, h) * 128 + 32 * nt + r] = (bf16_t)(pk2(acc[nt][i], 0.f) & 0xffffu);
        if (tid < 4) cdec[(b * 64 + c) * 32 + 4 * g + tid] = __expf(((LAS float*)(lds + L_SAC))[tid * 128 + 127]);
        __syncthreads();
    }
}
DI void ssd_scan_phase(const Params& p, const bool dry) {
    const float* cdec = (const float*)(p.ws + O_CDEC);
    for (int e = blockIdx.x * 512 + threadIdx.x; e < 2 * 32 * 64 * 32; e += gridDim.x * 512) {
        const int b = e >> 16, rem = e & 65535, head = rem >> 11;
        bf16_t* st = st_ptr(p.ws, b) + (size_t)rem * 4;
        float carry[4] = {0.f, 0.f, 0.f, 0.f};
        for (int c0 = 0; c0 < 64; c0 += 8) {
            u32x2 v[8]; float dc[8];
#pragma unroll
            for (int u = 0; u < 8; ++u) { v[u] = *(const u32x2*)(st + (size_t)(c0 + u) * 262144); dc[u] = cdec[(b * 64 + c0 + u) * 32 + head]; }
#pragma unroll
            for (int u = 0; u < 8; ++u) {
                u32x2 o; o[0] = pk2(carry[0], carry[1]); o[1] = pk2(carry[2], carry[3]); if (!dry) *(u32x2*)(st + (size_t)(c0 + u) * 262144) = o;
                carry[0] = carry[0] * dc[u] + bflo(v[u][0]); carry[1] = carry[1] * dc[u] + bfhi(v[u][0]); carry[2] = carry[2] * dc[u] + bflo(v[u][1]); carry[3] = carry[3] * dc[u] + bfhi(v[u][1]);
            }
        }
    }
}
DI void ssd_out_phase(LAS unsigned char* lds, const Params& p, const bool dry) {
    const int tid = otid(), w = __builtin_amdgcn_readfirstlane(tid >> 6), lane = tid & 63, r = lane & 31, h = lane >> 5, hh = w >> 1, ph = w & 1;
    const bf16_t* xbc = (const bf16_t*)(p.ws + O_XBC); const float* DT = (const float*)(p.ws + O_DT); bf16_t* zy = (bf16_t*)p.out;
    LAS float* sdt = (LAS float*)(lds + L_SDT); LAS float* sac = (LAS float*)(lds + L_SAC); LAS float* ssq = (LAS float*)(lds + L_SSQ);
    const int i16 = lane & 15, tq = i16 >> 2, tp = i16 & 3, g16 = (lane >> 4) & 1;
    for (int it = blockIdx.x; it < 1024; it += gridDim.x) {
        const int b = it >> 9, c = (it >> 3) & 63, g = it & 7, head = 4 * g + hh; const size_t t0 = (size_t)b * SEQ + (size_t)c * 128;
        ssd_dt_acum(lds, DT, p.in[13], p.in[14], t0, g);
        ssd_stage<false, true>(lds, xbc, p.in[11], p.in[12], t0, c, g);
        bf16x8 pvf[8];
        { const bf16_t* pp = st_ptr(p.ws, b) + ((size_t)(c * 32 + head) * 64 + 32 * ph + r) * 128 + 8 * h;
#pragma unroll
          for (int s = 0; s < 8; ++s) pvf[s] = *(const bf16x8*)(pp + 16 * s); }
        __syncthreads();
        f32x16 Y[4];
        const LAS unsigned char* xa = lds + L_SX + (4 * h + tq) * SXS + (64 * hh + 32 * ph + 16 * g16 + 4 * tp) * 2;
#pragma unroll
        for (int lt = 0; lt < 4; ++lt) {
            __builtin_amdgcn_sched_barrier(0);
            f32x16 y = zero16();
#pragma unroll
            for (int s = 0; s < 8; ++s) { const bf16x8 cfs = *(const LAS bf16x8*)(lds + L_SC + (32 * lt + r) * SBS + (16 * s + 8 * h) * 2); y = MFMA32(pvf[s], cfs, y); }
            Y[lt] = y * __expf(sac[hh * 128 + 32 * lt + r]);
        }
#pragma unroll
        for (int lt = 0; lt < 4; ++lt) {
            __builtin_amdgcn_sched_barrier(0);
            bf16x8 cf[8];
#pragma unroll
            for (int s = 0; s < 8; ++s) cf[s] = *(const LAS bf16x8*)(lds + L_SC + (32 * lt + r) * SBS + (16 * s + 8 * h) * 2);
            const float al = sac[hh * 128 + 32 * lt + r];
#pragma unroll
            for (int mt = 0; mt < 4; ++mt) {
                if (mt <= lt) {
                    __builtin_amdgcn_sched_barrier(0);
                    f32x16 X = zero16();
#pragma unroll
                    for (int s = 0; s < 8; ++s) { const bf16x8 bfr = *(const LAS bf16x8*)(lds + L_SB + (32 * mt + r) * SBS + (16 * s + 8 * h) * 2); X = MFMA32(bfr, cf[s], X); }
#pragma unroll
                    for (int gq = 0; gq < 4; ++gq) {
                        const f32x4 am = *(const LAS f32x4*)(sac + hh * 128 + 32 * mt + 8 * gq + 4 * h), dm = *(const LAS f32x4*)(sdt + hh * 128 + 32 * mt + 8 * gq + 4 * h);
#pragma unroll
                        for (int jj = 0; jj < 4; ++jj) { const int mrow = 32 * mt + 8 * gq + 4 * h + jj; const bool ok = (32 * lt + r) >= mrow;
                            const float dec = ok ? __expf(fminf(al - am[jj], 0.f)) * dm[jj] : 0.f; X[4 * gq + jj] *= dec; }
                    }
#pragma unroll
                    for (int s2 = 0; s2 < 2; ++s2) { const bf16x8 xs = pack8(X, s2);
                        const LAS unsigned char* xr = xa + (32 * mt + 16 * s2) * SXS; const bf16x8 xf = tr2(xr, xr + 8 * SXS); Y[lt] = MFMA32(xf, xs, Y[lt]); }
                }
            }
        }
        __builtin_amdgcn_sched_barrier(0);
        const float Dh = p.in[15][head];
        float sq[4];
#pragma unroll
        for (int lt = 0; lt < 4; ++lt) {
            const int l = 32 * lt + r; sq[lt] = 0.f;
#pragma unroll
            for (int gq = 0; gq < 4; ++gq) {
                const int chl = 64 * hh + 32 * ph + 8 * gq + 4 * h;
                const u32x2 xv = *(const LAS u32x2*)(lds + L_SX + l * SXS + chl * 2);
                const u32x2 zv = *(const u32x2*)(zy + (t0 + l) * DIN + 256 * g + chl);
                const float xf4[4] = {bflo(xv[0]), bfhi(xv[0]), bflo(xv[1]), bfhi(xv[1])}, zf4[4] = {bflo(zv[0]), bfhi(zv[0]), bflo(zv[1]), bfhi(zv[1])};
#pragma unroll
                for (int jj = 0; jj < 4; ++jj) { const float yv = (Y[lt][4 * gq + jj] + Dh * xf4[jj]) * fsilu(zf4[jj]); Y[lt][4 * gq + jj] = yv; sq[lt] += yv * yv; }
            }
            sq[lt] += __shfl_xor(sq[lt], 32);
            if (h == 0) ssq[w * 128 + l] = sq[lt];
        }
        __syncthreads();
#pragma unroll
        for (int lt = 0; lt < 4; ++lt) {
            const int l = 32 * lt + r; float tot = 0.f;
#pragma unroll
            for (int ww = 0; ww < 8; ++ww) tot += ssq[ww * 128 + l];
            const float rn = __builtin_amdgcn_rsqf(tot * (1.0f / 256.0f) + 1e-5f);
#pragma unroll
            for (int gq = 0; gq < 4; ++gq) {
                const int chl = 64 * hh + 32 * ph + 8 * gq + 4 * h; const f32x4 gw = *(const f32x4*)(p.in[16] + 256 * g + chl);
                u32x2 o; o[0] = pk2(Y[lt][4 * gq] * rn * gw[0], Y[lt][4 * gq + 1] * rn * gw[1]); o[1] = pk2(Y[lt][4 * gq + 2] * rn * gw[2], Y[lt][4 * gq + 3] * rn * gw[3]);
                if (!dry) *(u32x2*)(zy + (t0 + l) * DIN + 256 * g + chl) = o;
            }
        }
        __syncthreads();
    }
}
DI void dt_proj(LAS unsigned char* lds, const Params& p) {
    const int tid = otid(), w = __builtin_amdgcn_readfirstlane(tid >> 6), lane = tid & 63, r = lane & 31, h = lane >> 5, rt = w & 1, kq = w >> 1;
    const bf16_t* hb = (const bf16_t*)(p.ws + O_HB); const bf16_t* wt = (const bf16_t*)(p.ws + W_SIN) + (size_t)6144 * DM;
    const float* ss = (const float*)(p.ws + O_SS) + 2 * MT; float* dt = (float*)(p.ws + O_DT);
    LAS float* part = (LAS float*)lds;
    for (int rb = blockIdx.x; rb < MT / 64; rb += gridDim.x) {
        const bf16_t* ap = hb + (size_t)(rb * 64 + rt * 32 + r) * DM + kq * 256 + 8 * h;
        const bf16_t* bp = wt + (size_t)r * DM + kq * 256 + 8 * h;
        bf16x8 af[16], bfr[16];
#pragma unroll
        for (int s = 0; s < 16; ++s) { af[s] = *(const bf16x8*)(ap + 16 * s); bfr[s] = *(const bf16x8*)(bp + 16 * s); }
        f32x16 acc = zero16();
#pragma unroll
        for (int s = 0; s < 16; ++s) acc = MFMA32(af[s], bfr[s], acc);
#pragma unroll
        for (int i = 0; i < 16; ++i) part[((kq * 2 + rt) * 32 + crow(i, h)) * 32 + r] = acc[i];
        __syncthreads();
#pragma unroll
        for (int q = 0; q < 4; ++q) {
            const int o = tid + 512 * q, row = o >> 5, col = o & 31;
            float v = 0.f;
#pragma unroll
            for (int k = 0; k < 4; ++k) v += part[((k * 2 + (row >> 5)) * 32 + (row & 31)) * 32 + col];
            const int grow = rb * 64 + row;
            dt[(size_t)grow * 32 + col] = v * __builtin_amdgcn_rsqf(ss[grow] * (1.0f / 1024.0f) + 1e-6f);
        }
        __syncthreads();
    }
}
template <class Epi> DI void run_gemm(LAS unsigned char* lds, const bf16_t* A, const bf16_t* Bt, int N, int K, const Epi& E) {
    pg8::Gemm g; g.A = A; g.Bt = Bt; g.M = MT; g.N = N; g.K = K;
    pg8::StaticOrder S; S.init(MT, N, (int)gridDim.x, (int)blockIdx.x);
    pg8::gemm_phase<Epi, pg8::StaticOrder, !Epi::AFTER_DRAIN, true>((PG8_LAS unsigned char*)lds, g, S, E);
}
#if defined(DRY_S3) || defined(DRY_S4)
#define DRYV (p.ws == nullptr)
#else
#define DRYV false
#endif
__global__ void __launch_bounds__(512, 2) fwd_megakernel(Params p) {
    extern __shared__ __attribute__((aligned(16))) unsigned char shm[];
    LAS unsigned char* lds = (LAS unsigned char*)shm;
    cg::grid_group grid = cg::this_grid();
    if (threadIdx.x < 4) ((LAS unsigned*)(lds + LDS_BYTES - 16))[threadIdx.x] = 0u;
    __syncthreads();
    const XcdBarrier xbar = xcd_barrier_post((unsigned*)(p.ws + O_BAR), (volatile LAS unsigned*)(lds + LDS_BYTES - 16));
#define GBAR() xcd_barrier(xbar)
    unsigned char* ws = p.ws;
    bf16_t* hb = (bf16_t*)(ws + O_HB); float* ss = (float*)(ws + O_SS);
    phase0(lds, p);
#ifdef DUP_P0
    GBAR(); phase0(lds, p);
#endif
    if (gridDim.x == 0x7fffffffu) grid.sync();
    GBAR();
    { EpiAttnIn E; E.O = (bf16_t*)(ws + O_PROJ); E.ss = ss; E.tab = (const f32x4*)(ws + O_ROPE); run_gemm(lds, hb, (const bf16_t*)(ws + W_AIN), AINW, DM, E); }
    GBAR();
    attn_phase(lds, p);
#ifdef DUP_ATTN
    GBAR(); attn_phase(lds, p);
#endif
    GBAR();
    { EpiRes<true, false> E; E.xres = p.in[0]; E.hb = hb; E.outf = nullptr; E.ssn = ss + MT; run_gemm(lds, (const bf16_t*)(ws + O_MIXED), (const bf16_t*)(ws + W_AOUT), DM, DM, E); }
    GBAR();
    { EpiGU E; E.act = (bf16_t*)(ws + O_ACT); E.ss = ss + MT; run_gemm(lds, hb, (const bf16_t*)(ws + W_GU0), 2 * DFF, DM, E); }
    GBAR();
    { EpiRes<false, false> E; E.xres = nullptr; E.hb = hb; E.outf = nullptr; E.ssn = ss + 2 * MT; run_gemm(lds, (const bf16_t*)(ws + O_ACT), (const bf16_t*)(ws + W_DN0), DM, DFF, E); }
    GBAR();
    { EpiSsdIn E; E.z = (bf16_t*)p.out; E.xbc = (bf16_t*)(ws + O_XBC); E.dt = (float*)(ws + O_DT); E.ss = ss + 2 * MT; dt_proj(lds, p); run_gemm(lds, hb, (const bf16_t*)(ws + W_SIN), 6144, DM, E); }
    GBAR();
    ssd_states_phase(lds, p);
#ifdef DUP_S2
    GBAR(); ssd_states_phase(lds, p);
#endif
    GBAR();
#ifdef DRY_S3
    ssd_scan_phase(p, p.ws != nullptr); GBAR();
#endif
    ssd_scan_phase(p, DRYV);
    GBAR();
#ifdef DRY_S4
    ssd_out_phase(lds, p, p.ws != nullptr); GBAR();
#endif
    ssd_out_phase(lds, p, DRYV);
    GBAR();
    { EpiRes<false, false> E; E.xres = nullptr; E.hb = hb; E.outf = nullptr; E.ssn = ss + 3 * MT; run_gemm(lds, (const bf16_t*)p.out, (const bf16_t*)(ws + W_SOUT), DM, DIN, E); }
    GBAR();
    { EpiGU E; E.act = (bf16_t*)(ws + O_ACT); E.ss = ss + 3 * MT; run_gemm(lds, hb, (const bf16_t*)(ws + W_GU1), 2 * DFF, DM, E); }
    GBAR();
    if (gridDim.x == 256) {
        EpiFinal E; E.hb = hb; E.outf = p.out; E.ssn = ss + 4 * MT; E.cnt = (unsigned*)(ws + O_BAR) + XCD_BAR_WORDS; E.fw = p.in[22];
        run_gemm(lds, (const bf16_t*)(ws + O_ACT), (const bf16_t*)(ws + W_DN1), DM, DFF, E);
    } else {
        { EpiRes<false, true> E; E.xres = nullptr; E.hb = hb; E.outf = p.out; E.ssn = ss + 4 * MT; run_gemm(lds, (const bf16_t*)(ws + O_ACT), (const bf16_t*)(ws + W_DN1), DM, DFF, E); }
        GBAR();
        const float* ss4 = ss + 4 * MT; const f32x4* fw = (const f32x4*)p.in[22]; f32x4* o4 = (f32x4*)p.out;
        for (int i = blockIdx.x * 512 + threadIdx.x; i < MT * (DM / 4); i += gridDim.x * 512) {
            const int row = i >> 8; const float rs = __builtin_amdgcn_rsqf(ss4[row] * (1.0f / 1024.0f) + 1e-6f);
            o4[i] = o4[i] * rs * fw[i & 255];
        }
    }
}

extern "C" void kernel_launch(void* const* d_in, const int* in_sizes, int n_in, void* d_out, int out_size, void* d_ws, size_t ws_size, hipStream_t stream) {
    static int grid_blocks = 0;
    if (!grid_blocks) {
        int dev = 0, cus = 0, per_cu = 0;
        hipGetDevice(&dev);
        hipDeviceGetAttribute(&cus, hipDeviceAttributeMultiprocessorCount, dev);
        if (hipFuncSetAttribute((const void*)fwd_megakernel, hipFuncAttributeMaxDynamicSharedMemorySize, LDS_BYTES) != hipSuccess) fprintf(stderr, "hipFuncSetAttribute failed\n");
        if (hipOccupancyMaxActiveBlocksPerMultiprocessor(&per_cu, (const void*)fwd_megakernel, 512, LDS_BYTES) != hipSuccess || per_cu < 1) { fprintf(stderr, "occupancy query: %d\n", per_cu); per_cu = 1; }
        (void)hipGetLastError();
        grid_blocks = cus * per_cu;
        if (ws_size < 268435456ull || n_in != 23) fprintf(stderr, "unexpected ws_size %zu / n_in %d\n", ws_size, n_in);
    }
    if (hipMemsetAsync((char*)d_ws + O_BAR, 0, 20480, stream) != hipSuccess) fprintf(stderr, "memset failed\n");
    Params p{};
    for (int i = 0; i < 23; ++i) p.in[i] = (const float*)d_in[i];
    p.out = (float*)d_out; p.ws = (unsigned char*)d_ws;
    void* args[] = {&p};
    hipError_t e = hipLaunchCooperativeKernel((const void*)fwd_megakernel, dim3(grid_blocks), dim3(512), args, LDS_BYTES, stream);
    if (e != hipSuccess) fprintf(stderr, "cooperative launch failed: %s (grid %d)\n", hipGetErrorString(e), grid_blocks);
}
#ifdef PHASE_TEST
__global__ void __launch_bounds__(512, 2) t_phase0(Params p) { extern __shared__ __attribute__((aligned(16))) unsigned char shm[]; phase0((LAS unsigned char*)shm, p); }
__global__ void __launch_bounds__(512, 2) t_attn_diff(Params p) { extern __shared__ __attribute__((aligned(16))) unsigned char shm[]; diff_tile((LAS unsigned char*)shm, (const bf16_t*)(p.ws + O_PROJ), (bf16_t*)(p.ws + O_MIXED), p.in[7], 0.3f, blockIdx.x & 1, blockIdx.y, blockIdx.z); }
__global__ void __launch_bounds__(512, 2) t_attn_sb(Params p) { extern __shared__ __attribute__((aligned(16))) unsigned char shm[]; sb_block((LAS unsigned char*)shm, (const bf16_t*)(p.ws + O_PROJ), (bf16_t*)(p.ws + O_MIXED), blockIdx.x & 1, blockIdx.y, blockIdx.z); }
__global__ void __launch_bounds__(512, 2) t_ssd_states(Params p) { extern __shared__ __attribute__((aligned(16))) unsigned char shm[]; ssd_states_phase((LAS unsigned char*)shm, p); }
__global__ void __launch_bounds__(512, 2) t_ssd_scan(Params p) { ssd_scan_phase(p, false); }
__global__ void __launch_bounds__(512, 2) t_ssd_out(Params p) { extern __shared__ __attribute__((aligned(16))) unsigned char shm[]; ssd_out_phase((LAS unsigned char*)shm, p, false); }
__global__ void __launch_bounds__(512, 2) t_gemm_ain(Params p) { extern __shared__ __attribute__((aligned(16))) unsigned char shm[]; EpiAttnIn E; E.O = (bf16_t*)(p.ws + O_PROJ); E.ss = (float*)(p.ws + O_SS); E.tab = (const f32x4*)(p.ws + O_ROPE); run_gemm((LAS unsigned char*)shm, (bf16_t*)(p.ws + O_HB), (const bf16_t*)(p.ws + W_AIN), AINW, DM, E); }
__global__ void __launch_bounds__(512, 2) t_gemm_res(Params p) { extern __shared__ __attribute__((aligned(16))) unsigned char shm[]; EpiRes<false, false> E; E.xres = nullptr; E.hb = (bf16_t*)(p.ws + O_HB); E.outf = nullptr; E.ssn = (float*)(p.ws + O_SS); run_gemm((LAS unsigned char*)shm, (bf16_t*)(p.ws + O_ACT), (const bf16_t*)(p.ws + W_DN0), DM, DFF, E); }
__global__ void __launch_bounds__(512, 2) t_gemm_gu(Params p) { extern __shared__ __attribute__((aligned(16))) unsigned char shm[]; EpiGU E; E.act = (bf16_t*)(p.ws + O_ACT); E.ss = (float*)(p.ws + O_SS); run_gemm((LAS unsigned char*)shm, (bf16_t*)(p.ws + O_HB), (const bf16_t*)(p.ws + W_GU0), 2 * DFF, DM, E); }
__global__ void __launch_bounds__(512, 2) t_gemm_ssdin(Params p) { extern __shared__ __attribute__((aligned(16))) unsigned char shm[]; EpiSsdIn E; E.z = (bf16_t*)p.out; E.xbc = (bf16_t*)(p.ws + O_XBC); E.dt = (float*)(p.ws + O_DT); E.ss = (float*)(p.ws + O_SS); run_gemm((LAS unsigned char*)shm, (bf16_t*)(p.ws + O_HB), (const bf16_t*)(p.ws + W_SIN), SINWP, DM, E); }
#endif
```

```cpp
#include <hip/hip_runtime.h>
#include <hip/hip_cooperative_groups.h>
#include <cstdio>
#include <cstdint>
namespace cg = cooperative_groups;
namespace pg8 {
#define PG8_LAS __attribute__((address_space(3)))
typedef unsigned short bf16_t;
typedef short bf16x8 __attribute__((ext_vector_type(8)));
typedef float f32x4 __attribute__((ext_vector_type(4)));
typedef unsigned u32x4 __attribute__((ext_vector_type(4)));
constexpr int BM = 256, BK = 64, HALF = 128, HTB = HALF * BK * 2  , STAGE_BYTES = 8 * HTB, NXCD = 8, WGM = 8;

__host__ __device__ __forceinline__ int lds_byte(int r, int c) { const int st = (r >> 4) * 2 + (c >> 5), rr = r & 15, cc = c & 31, ob = rr * 64 + cc * 2; return st * 1024 + (ob ^ (((ob >> 9) & 1) << 5)); }
__host__ __device__ __forceinline__ void stage_rc(int b, int& R, int& C) { const int st = b / 1024, sb = b % 1024, swz = sb ^ (((sb >> 9) & 1) << 5); R = (st >> 1) * 16 + swz / 64; C = (st & 1) * 32 + (swz % 64) / 2; }
__host__ __device__ __forceinline__ int perm32(int rho) { const int n = rho >> 4, i = rho & 15; return 8 * (i >> 2) + 4 * n + (i & 3); }

struct Unit { int pm, pn; };
struct Gemm { const bf16_t* A; const bf16_t* Bt; int M, N, K; };

struct StaticOrder {
    int nM, nN, nwg, G, c;
    __host__ __device__ void init(int M, int N, int G_, int c_) { nM = M / BM; nN = N / BM; nwg = nM * nN; G = G_; c = c_; }
    __host__ __device__ bool next(int i, Unit& u) const {
        const long L = (long)i * G + c; if (L >= nwg) return false;
        int wgid = (int)L; { const int q = nwg / NXCD, r = nwg % NXCD, xcd = wgid % NXCD, off = wgid / NXCD; wgid = (xcd < r ? xcd * (q + 1) : r * (q + 1) + (xcd - r) * q) + off; }
        const int nig = WGM * nN, gid = wgid / nig, fm = gid * WGM, gsz = (nM - fm) < WGM ? (nM - fm) : WGM;
        u.pm = fm + ((wgid % nig) % gsz); u.pn = (wgid % nig) / gsz; return true;
    }
    __device__ __forceinline__ void a_ready(const Unit&) const {}
    __device__ __forceinline__ void done(const Unit&) const {}
};

template <class Epi, class Sched, bool ALIGN_EPI = false, bool SP2 = false>
__device__ __forceinline__ void gemm_phase(PG8_LAS unsigned char* lds, const Gemm g, const Sched& S, const Epi& E) {
    int tid_ = threadIdx.x; asm volatile("" : "+v"(tid_)); const int tid = tid_, wid = __builtin_amdgcn_readfirstlane(tid >> 6), lane = tid & 63, wr = wid >> 2, wc = wid & 3, fr = lane & 15, fq = lane >> 4;
    const int K = g.K, nt = K / BK;
    unsigned voffA[2], voffB[2];
#pragma unroll
    for (int i = 0; i < 2; ++i) { int R, C; stage_rc(tid * 16 + i * 8192, R, C); const int Rb = Epi::PERM ? ((R & ~31) + perm32(R & 31)) : R;
        voffA[i] = (unsigned)(R * K + C) * 2u; voffB[i] = (unsigned)(Rb * K + C) * 2u; }
    const size_t kstep = (size_t)(BK * 2);
    const size_t hstep = (size_t)HALF * K * 2;
    const size_t tstep = 2 * hstep;
    const unsigned ldsw = (unsigned)wid * 1024u;
    const int aoff = lds_byte(wr * 64 + fr, fq * 8), boff = lds_byte(wc * 32 + fr, fq * 8);
#define PG8_SA(b, h) (((b) * 2 + (h)) * HTB)
#define PG8_SB(b, h) ((4 + (b) * 2 + (h)) * HTB)
#define PG8_STAGE(bufoff, gbase, voff) do { _Pragma("unroll") for (int _i = 0; _i < 2; ++_i) \
        __builtin_amdgcn_global_load_lds((const unsigned*)((const char*)(gbase) + (voff)[_i]), (PG8_LAS unsigned*)(lds + (bufoff) + ldsw + _i * 8192), 16, 0, 0); } while (0)
#define PG8_LDA(dst, b, h) do { _Pragma("unroll") for (int m = 0; m < 4; ++m) _Pragma("unroll") for (int k = 0; k < 2; ++k) dst[m][k] = *(const PG8_LAS bf16x8*)(lds + PG8_SA(b, h) + aoff + m * 2048 + k * 1024); } while (0)
#define PG8_LDB(dst, b, h) do { _Pragma("unroll") for (int n = 0; n < 2; ++n) _Pragma("unroll") for (int k = 0; k < 2; ++k) dst[n][k] = *(const PG8_LAS bf16x8*)(lds + PG8_SB(b, h) + boff + n * 2048 + k * 1024); } while (0)
#define PG8_MMA(ai, bj, At, Bt) do { __builtin_amdgcn_s_setprio(1); _Pragma("unroll") for (int m = 0; m < 4; ++m) _Pragma("unroll") for (int n = 0; n < 2; ++n) _Pragma("unroll") for (int k = 0; k < 2; ++k) \
        acc[ai][bj][m][n] = __builtin_amdgcn_mfma_f32_16x16x32_bf16(Bt[n][k], At[m][k], acc[ai][bj][m][n], 0, 0, 0); __builtin_amdgcn_s_setprio(0); } while (0)
#define PG8_WAIT_V(n) asm volatile("s_waitcnt vmcnt(" #n ")" ::: "memory")
#define PG8_WAIT_L(n) asm volatile("s_waitcnt lgkmcnt(" #n ")" ::: "memory")
#define PG8_BAR __builtin_amdgcn_s_barrier()
#define PG8_SCHED __builtin_amdgcn_sched_barrier(0)
    Unit cur, nxt; int ui = 0;
    if (!S.next(0, cur)) return;
    f32x4 acc[2][2][4][2];
#pragma unroll
    for (int a = 0; a < 2; ++a)
#pragma unroll
        for (int b = 0; b < 2; ++b)
#pragma unroll
            for (int m = 0; m < 4; ++m)
#pragma unroll
                for (int n = 0; n < 2; ++n) acc[a][b][m][n] = (f32x4){0.f, 0.f, 0.f, 0.f};
    bf16x8 At[4][2], B0[2][2], B1[2][2];
    float epre[8]; E.pre(cur, wr, fr, epre);
    const char* cA = (const char*)g.A + (size_t)cur.pm * tstep; const char* cB = (const char*)g.Bt + (size_t)cur.pn * tstep;
    S.a_ready(cur);
    if constexpr (SP2) {
        PG8_STAGE(PG8_SB(0, 0), cB, voffB); PG8_STAGE(PG8_SB(0, 1), cB + hstep, voffB); PG8_STAGE(PG8_SA(0, 0), cA, voffA); PG8_STAGE(PG8_SA(0, 1), cA + hstep, voffA);
        if (wr == 1) PG8_BAR;
        PG8_WAIT_V(2); PG8_BAR;
        PG8_STAGE(PG8_SB(1, 0), cB + kstep, voffB); PG8_STAGE(PG8_SA(1, 0), cA + kstep, voffA); PG8_STAGE(PG8_SB(1, 1), cB + hstep + kstep, voffB);
        PG8_WAIT_V(6); PG8_BAR;
    } else {
        PG8_STAGE(PG8_SB(0, 0), cB, voffB); PG8_STAGE(PG8_SA(0, 0), cA, voffA); PG8_STAGE(PG8_SB(0, 1), cB + hstep, voffB); PG8_STAGE(PG8_SA(0, 1), cA + hstep, voffA);
        if (wr == 1) PG8_BAR;
        PG8_WAIT_V(4); PG8_BAR;
        PG8_STAGE(PG8_SB(1, 0), cB + kstep, voffB); PG8_STAGE(PG8_SA(1, 0), cA + kstep, voffA); PG8_STAGE(PG8_SB(1, 1), cB + hstep + kstep, voffB);
        PG8_WAIT_V(6); PG8_BAR;
    }
    for (;;) {
        const bool has_next = S.next(ui + 1, nxt);
        const char* nA = has_next ? (const char*)g.A + (size_t)nxt.pm * tstep : cA; const char* nB = has_next ? (const char*)g.Bt + (size_t)nxt.pn * tstep : cB;
        for (int t = 0; t < nt; t += 2) {
            const bool last = (t == nt - 2);
            const char* a1 = cA + (size_t)(t + 1) * kstep;
            const char* a2 = last ? nA : cA + (size_t)(t + 2) * kstep; const char* b2 = last ? nB : cB + (size_t)(t + 2) * kstep;
            const char* a3 = a2 + kstep; const char* b3 = b2 + kstep;
            if (last && has_next) S.a_ready(nxt);
            if constexpr (SP2) {
            PG8_LDB(B0, 0, 0); PG8_LDB(B1, 0, 1); PG8_SCHED; PG8_LDA(At, 0, 0); PG8_STAGE(PG8_SA(1, 1), a1 + hstep, voffA);
            PG8_WAIT_V(8); PG8_WAIT_L(0); PG8_BAR; PG8_MMA(0, 0, At, B0); PG8_MMA(0, 1, At, B1); PG8_BAR; PG8_SCHED;
            PG8_LDA(At, 0, 1); PG8_STAGE(PG8_SB(0, 0), b2, voffB); PG8_STAGE(PG8_SB(0, 1), b2 + hstep, voffB); PG8_STAGE(PG8_SA(0, 0), a2, voffA);
            PG8_WAIT_V(8); PG8_WAIT_L(0); PG8_BAR; PG8_MMA(1, 0, At, B0); PG8_MMA(1, 1, At, B1); PG8_BAR; PG8_SCHED;
            PG8_LDB(B0, 1, 0); PG8_LDB(B1, 1, 1); PG8_SCHED; PG8_LDA(At, 1, 0); PG8_STAGE(PG8_SA(0, 1), a2 + hstep, voffA);
            PG8_WAIT_V(8); PG8_WAIT_L(0); PG8_BAR; PG8_MMA(0, 0, At, B0); PG8_MMA(0, 1, At, B1); PG8_BAR; PG8_SCHED;
            PG8_LDA(At, 1, 1); PG8_STAGE(PG8_SB(1, 0), b3, voffB); PG8_STAGE(PG8_SB(1, 1), b3 + hstep, voffB); PG8_STAGE(PG8_SA(1, 0), a3, voffA);
            PG8_WAIT_V(8); PG8_WAIT_L(0); PG8_BAR; PG8_MMA(1, 0, At, B0); PG8_MMA(1, 1, At, B1); PG8_BAR; PG8_SCHED;
            } else {
            PG8_LDB(B0, 0, 0); PG8_SCHED; PG8_LDA(At, 0, 0); PG8_STAGE(PG8_SA(1, 1), a1 + hstep, voffA);
            PG8_WAIT_L(8); PG8_BAR; PG8_WAIT_L(0); PG8_MMA(0, 0, At, B0); PG8_BAR; PG8_SCHED;
            PG8_LDB(B1, 0, 1); PG8_STAGE(PG8_SB(0, 0), b2, voffB);
            PG8_BAR; PG8_WAIT_L(0); PG8_MMA(0, 1, At, B1); PG8_BAR;
            PG8_LDA(At, 0, 1); PG8_STAGE(PG8_SA(0, 0), a2, voffA);
            PG8_BAR; PG8_WAIT_L(0); PG8_MMA(1, 0, At, B0); PG8_BAR; PG8_SCHED;
            PG8_STAGE(PG8_SB(0, 1), b2 + hstep, voffB);
            PG8_WAIT_V(6); PG8_BAR; PG8_MMA(1, 1, At, B1); PG8_BAR;
            PG8_LDB(B0, 1, 0); PG8_SCHED; PG8_LDA(At, 1, 0); PG8_STAGE(PG8_SA(0, 1), a2 + hstep, voffA);
            PG8_WAIT_L(8); PG8_BAR; PG8_WAIT_L(0); PG8_MMA(0, 0, At, B0); PG8_BAR; PG8_SCHED;
            PG8_LDB(B1, 1, 1); PG8_STAGE(PG8_SB(1, 0), b3, voffB);
            PG8_BAR; PG8_WAIT_L(0); PG8_MMA(0, 1, At, B1); PG8_BAR;
            PG8_LDA(At, 1, 1); PG8_STAGE(PG8_SA(1, 0), a3, voffA);
            PG8_BAR; PG8_WAIT_L(0); PG8_MMA(1, 0, At, B0); PG8_BAR; PG8_SCHED;
            PG8_STAGE(PG8_SB(1, 1), b3 + hstep, voffB);
            PG8_WAIT_V(6); PG8_BAR; PG8_MMA(1, 1, At, B1); PG8_BAR;
            }
        }
        if constexpr (ALIGN_EPI) { if (wr == 0) PG8_BAR; }
        if constexpr (!Epi::AFTER_DRAIN) { E(acc, cur, wr, wc, fr, fq, epre); S.done(cur); }
        if (!has_next) break;
        E.pre(nxt, wr, fr, epre);
#pragma unroll
        for (int a = 0; a < 2; ++a)
#pragma unroll
            for (int b = 0; b < 2; ++b)
#pragma unroll
                for (int m = 0; m < 4; ++m)
#pragma unroll
                    for (int n = 0; n < 2; ++n) acc[a][b][m][n] = (f32x4){0.f, 0.f, 0.f, 0.f};
        cur = nxt; cA = nA; cB = nB; ++ui;
        if constexpr (ALIGN_EPI) { if (wr == 1) PG8_BAR; }
    }
    PG8_WAIT_V(0);
    if constexpr (!ALIGN_EPI) { if (wr == 0) PG8_BAR; }
    PG8_BAR;
    if constexpr (Epi::AFTER_DRAIN) { E.fused(acc, cur, wr, wc, fr, fq, lds, wid, lane); S.done(cur); }
#undef PG8_SA
#undef PG8_SB
#undef PG8_STAGE
#undef PG8_LDA
#undef PG8_LDB
#undef PG8_MMA
#undef PG8_WAIT_V
#undef PG8_WAIT_L
#undef PG8_BAR
#undef PG8_SCHED
}
}
using pg8::bf16_t; using pg8::bf16x8; using pg8::f32x4;
typedef short s16x4 __attribute__((ext_vector_type(4)));
typedef float f32x16 __attribute__((ext_vector_type(16)));
typedef float f32x2 __attribute__((ext_vector_type(2)));
typedef __bf16 bf2_t __attribute__((ext_vector_type(2)));
typedef unsigned u32x2 __attribute__((ext_vector_type(2)));
typedef unsigned u32x4 __attribute__((ext_vector_type(4)));
#define LAS __attribute__((address_space(3)))
#define DI __device__ __forceinline__
#define MFMA32(a, b, c) __builtin_amdgcn_mfma_f32_32x32x16_bf16((a), (b), (c), 0, 0, 0)

DI int otid() { int t = threadIdx.x; asm volatile("" : "+v"(t)); return t; }
DI unsigned pk2(float a, float b) { f32x2 v = {a, b}; bf2_t r = __builtin_convertvector(v, bf2_t); return __builtin_bit_cast(unsigned, r); }
DI float bflo(unsigned u) { return __uint_as_float(u << 16); }
DI float bfhi(unsigned u) { return __uint_as_float(u & 0xffff0000u); }
DI float fexp2(float x) { return __builtin_amdgcn_exp2f(x); }
DI float frcp(float x) { return __builtin_amdgcn_rcpf(x); }
DI float fsilu(float x) { return x * frcp(1.0f + fexp2(-1.44269504089f * x)); }
DI int crow(int i, int h) { return (i & 3) + 8 * (i >> 2) + 4 * h; }
DI s16x4 trr(const LAS unsigned char* p) { return __builtin_amdgcn_ds_read_tr16_b64_v4i16((LAS s16x4*)p); }
DI bf16x8 tr2(const LAS unsigned char* p0, const LAS unsigned char* p1) { s16x4 a = trr(p0), b = trr(p1); return __builtin_shufflevector(a, b, 0, 1, 2, 3, 4, 5, 6, 7); }
DI bf16x8 pack8(const f32x16& x, int s) {
    u32x4 p; p[0] = pk2(x[8 * s], x[8 * s + 1]); p[1] = pk2(x[8 * s + 2], x[8 * s + 3]); p[2] = pk2(x[8 * s + 4], x[8 * s + 5]); p[3] = pk2(x[8 * s + 6], x[8 * s + 7]);
    return __builtin_bit_cast(bf16x8, p);
}
DI f32x16 zero16() { f32x16 z; for (int i = 0; i < 16; ++i) z[i] = 0.f; return z; }

constexpr int MT = 16384, SEQ = 8192, DM = 1024, DFF = 2816, AINW = 3072, SINW = 6176, SINWP = 6400, DIN = 2048, XBCW = 4096;
constexpr float LOG2E = 1.44269504089f;
constexpr int LDS_BYTES = 155648;
constexpr size_t W_AIN = 0, W_AOUT = W_AIN + (size_t)AINW * DM * 2, W_GU0 = W_AOUT + (size_t)DM * DM * 2, W_DN0 = W_GU0 + (size_t)2 * DFF * DM * 2,
                 W_SIN = W_DN0 + (size_t)DM * DFF * 2, W_SOUT = W_SIN + (size_t)SINWP * DM * 2, W_GU1 = W_SOUT + (size_t)DM * DIN * 2, W_DN1 = W_GU1 + (size_t)2 * DFF * DM * 2,
                 O_HB = W_DN1 + (size_t)DM * DFF * 2, O_SS = O_HB + (size_t)MT * DM * 2, O_ROPE = O_SS + (size_t)5 * MT * 4, O_DT = O_ROPE + (size_t)SEQ * 32 * 8,
                 O_CDEC = O_DT + (size_t)MT * 32 * 4, O_LAM = O_CDEC + 16384, O_BAR = O_LAM + 256, O_R = 98566144;
static_assert(O_BAR + 20480 <= O_R, "map");
constexpr size_t O_PROJ = O_R, O_MIXED = O_PROJ + (size_t)MT * AINW * 2, O_ACT = O_R, O_XBC = O_R, O_ST1 = O_XBC + (size_t)MT * XBCW * 2, O_ST0 = 0;
constexpr size_t ST_BATCH = (size_t)64 * 32 * 64 * 128;
static_assert(O_ST1 + ST_BATCH * 2 <= 268435456ull, "ws");
static_assert(ST_BATCH * 2 <= W_SOUT, "st0 overlay");
static_assert(O_MIXED + (size_t)MT * DM * 2 <= 268435456ull, "ws2");

struct Params { const float* in[23]; float* out; unsigned char* ws; };
#include <cstdlib>
#include <vector>

#define XB_TMO      128
#define XB_XCNT(j)  (256  + 64 * (j))
#define XB_XSUB(j)  (1280 + 64 * (j))
#define XB_XGEN(j)  (2304 + 64 * (j))
#define XB_TOP      3328
#define XB_TOPGEN   3392
#define XCD_BAR_WORDS 3456
#define XB_SPIN_CAP (1u << 18)

__device__ __forceinline__ unsigned xb_ld(unsigned* p)              { return __hip_atomic_load(p, __ATOMIC_RELAXED, __HIP_MEMORY_SCOPE_AGENT); }
__device__ __forceinline__ unsigned xb_add(unsigned* p, unsigned v) { return __hip_atomic_fetch_add(p, v, __ATOMIC_RELAXED, __HIP_MEMORY_SCOPE_AGENT); }
__device__ __forceinline__ unsigned xb_xcc_id() { return (unsigned)__builtin_amdgcn_s_getreg((3 << 11) | 20) & 0xFu; }
#define XB_SPIN(cond, bar) do { unsigned _sp = 0; while (cond) { __builtin_amdgcn_s_sleep(1); \
    if ((++_sp & 255u) == 0u) { if (xb_ld(&(bar)[XB_TMO])) break; if (_sp > XB_SPIN_CAP) { atomicAdd(&(bar)[XB_TMO], 1u); break; } } } } while (0)

struct XcdBarrier {
    unsigned* bar; unsigned x;
    volatile LAS unsigned* st;
};

__device__ __forceinline__ XcdBarrier xcd_barrier_post(unsigned* bar, volatile LAS unsigned* st) {
    XcdBarrier b; b.bar = bar; b.x = xb_xcc_id(); b.st = st;
    if (threadIdx.x == 0) (void)xb_add(&bar[XB_XCNT(b.x)], 1u);
    return b;
}
__device__ __forceinline__ void xcd_barrier_complete(unsigned* bar, unsigned x, unsigned& nloc, unsigned& nx) {
    const unsigned G = gridDim.x * gridDim.y * gridDim.z;
    unsigned sum, cnt, mine, sp = 0u;
    for (;;) {
        sum = 0u; cnt = 0u; mine = 0u;
#pragma unroll
        for (unsigned j = 0; j < 16; ++j) { const unsigned c = xb_ld(&bar[XB_XCNT(j)]); sum += c; cnt += (c > 0u) ? 1u : 0u; mine = (j == x) ? c : mine; }
        if (sum == G) break;
        __builtin_amdgcn_s_sleep(1);
        if ((++sp & 255u) == 0u) { if (xb_ld(&bar[XB_TMO])) break; if (sp > XB_SPIN_CAP) { atomicAdd(&bar[XB_TMO], 1u); break; } }
    }
    nloc = mine > 0u ? mine : 1u; nx = cnt > 0u ? cnt : 1u;
}

__device__ __forceinline__ void xcd_barrier(const XcdBarrier& b) {
    asm volatile("s_waitcnt vmcnt(0)" ::: "memory");
    __syncthreads();
    if (threadIdx.x == 0) {
        unsigned* bar = b.bar;
        __builtin_amdgcn_s_waitcnt(0);
        unsigned nloc = b.st[0], nx = b.st[1];
        if (nloc == 0u) { xcd_barrier_complete(bar, b.x, nloc, nx); b.st[0] = nloc; b.st[1] = nx; }
        const unsigned old = xb_add(&bar[XB_XSUB(b.x)], 1u);
        const unsigned gen = old / nloc;
        if (old + 1u == (gen + 1u) * nloc) {
            __builtin_amdgcn_fence(__ATOMIC_RELEASE, "agent");
            asm volatile("s_waitcnt vmcnt(0)" ::: "memory");
            const unsigned og = xb_add(&bar[XB_TOP], 1u);
            const unsigned tg = og / nx;
            if (og + 1u == (tg + 1u) * nx) xb_add(&bar[XB_TOPGEN], 1u);
            else XB_SPIN(xb_ld(&bar[XB_TOPGEN]) == tg, bar);
            __builtin_amdgcn_fence(__ATOMIC_ACQUIRE, "agent");
            xb_add(&bar[XB_XGEN(b.x)], 1u);
            asm volatile("s_waitcnt vmcnt(0)" ::: "memory");
        } else {
            XB_SPIN(xb_ld(&bar[XB_XGEN(b.x)]) == gen, bar);
            __builtin_amdgcn_fence(__ATOMIC_ACQUIRE, "agent");
            asm volatile("s_waitcnt vmcnt(0)" ::: "memory");
        }
    }
    __syncthreads();
}
DI void wmap(int mode, int c, int& src, float& scale, int& which) {
    src = c; scale = 1.f; which = 0;
    if (mode == 0) {
        if (c < 1024) { const int base = c & ~63, cc = c & 63, g = cc >> 3, e = cc & 7; src = base + (e < 4 ? 4 * g + e : 32 + 4 * g + (e - 4)); }
        if (c < 512) scale = 0.125f * LOG2E; else if (c >= 1536 && c < 2048) scale = 0.125f;
    } else if (mode == 2) { src = 4 * (c >> 3) + (c & 3); which = (c >> 2) & 1; }
    else if (mode == 3) { if (c >= SINW) src = -1; }
}
struct WJob { int mode, K, ldw, tix; const float* W0; const float* W1; const float* ks; bf16_t* dst; };
DI WJob wjob(const Params& p, int t) {
    unsigned char* ws = p.ws;
    const int cnt[8] = {48 * 4, 16 * 4, 88 * 4, 16 * 11, 100 * 4, 16 * 8, 88 * 4, 16 * 11};
    int j = 0, tt = t;
#pragma unroll
    for (int q = 0; q < 7; ++q) if (j == q && tt >= cnt[q]) { tt -= cnt[q]; j = q + 1; }
    WJob J; J.tix = tt; J.W1 = nullptr; J.ks = nullptr;
    switch (j) {
    case 0: J.mode = 0; J.W0 = p.in[2]; J.ks = p.in[1]; J.dst = (bf16_t*)(ws + W_AIN); J.K = DM; J.ldw = AINW; break;
    case 1: J.mode = 1; J.W0 = p.in[8]; J.dst = (bf16_t*)(ws + W_AOUT); J.K = DM; J.ldw = DM; break;
    case 2: J.mode = 2; J.W0 = p.in[19]; J.W1 = p.in[20]; J.ks = p.in[18]; J.dst = (bf16_t*)(ws + W_GU0); J.K = DM; J.ldw = DFF; break;
    case 3: J.mode = 1; J.W0 = p.in[21]; J.dst = (bf16_t*)(ws + W_DN0); J.K = DFF; J.ldw = DM; break;
    case 4: J.mode = 3; J.W0 = p.in[10]; J.ks = p.in[9]; J.dst = (bf16_t*)(ws + W_SIN); J.K = DM; J.ldw = SINW; break;
    case 5: J.mode = 1; J.W0 = p.in[17]; J.dst = (bf16_t*)(ws + W_SOUT); J.K = DIN; J.ldw = DM; break;
    case 6: J.mode = 2; J.W0 = p.in[19] + (size_t)DM * DFF; J.W1 = p.in[20] + (size_t)DM * DFF; J.ks = p.in[18] + DM; J.dst = (bf16_t*)(ws + W_GU1); J.K = DM; J.ldw = DFF; break;
    default: J.mode = 1; J.W0 = p.in[21] + (size_t)DFF * DM; J.dst = (bf16_t*)(ws + W_DN1); J.K = DFF; J.ldw = DM; break;
    }
    return J;
}
DI void wtile_load(const WJob& J, int tid, float (&v)[32], float& sc, int& srcok) {
    const int nk = J.K >> 8, c0 = (J.tix / nk) * 64, k0 = (J.tix % nk) * 256, cc = tid & 63; int src, which; wmap(J.mode, c0 + cc, src, sc, which);
    const float* W = (which ? J.W1 : J.W0) + (src >= 0 ? src : 0); srcok = (src >= 0);
#pragma unroll
    for (int i = 0; i < 32; ++i) { const int kk = (tid >> 6) + 8 * i; v[i] = W[(size_t)(k0 + kk) * J.ldw]; }
}
DI void wtile_store(LAS float* tile, const WJob& J, int tid, const float (&v)[32], float sc, int srcok) {
    const int nk = J.K >> 8, c0 = (J.tix / nk) * 64, k0 = (J.tix % nk) * 256, cc = tid & 63;
#pragma unroll
    for (int i = 0; i < 32; ++i) { const int kk = (tid >> 6) + 8 * i; float x = srcok ? v[i] * sc : 0.f; if (J.ks) x *= J.ks[k0 + kk]; tile[kk * 65 + cc] = x; }
    __syncthreads();
#pragma unroll
    for (int i = 0; i < 16; ++i) {
        const int idx = tid + 512 * i, c2 = idx >> 7, k2 = (idx & 127) * 2;
        *(unsigned*)(J.dst + (size_t)(c0 + c2) * J.K + k0 + k2) = pk2(tile[k2 * 65 + c2], tile[(k2 + 1) * 65 + c2]);
    }
    __syncthreads();
}
DI void wconv_jobs(LAS unsigned char* lds, const Params& p, int wi, int nb) {
    const int tid = otid(); const int total = 48 * 4 + 16 * 4 + 2 * (88 * 4 + 16 * 11) + 100 * 4 + 16 * 8;
    if (wi >= total) return;
    WJob J = wjob(p, wi); float v[32]; float sc; int ok;
    wtile_load(J, tid, v, sc, ok);
    for (int t = wi; t < total; t += nb) {
        const bool more = (t + nb < total);
        WJob Jn = J; float vn[32]; float scn = 0.f; int okn = 0;
        if (more) { Jn = wjob(p, t + nb); wtile_load(Jn, tid, vn, scn, okn); }
        wtile_store((LAS float*)lds, J, tid, v, sc, ok);
        if (more) { J = Jn; sc = scn; ok = okn;
#pragma unroll
            for (int i = 0; i < 32; ++i) v[i] = vn[i]; }
    }
}
DI void phase0(LAS unsigned char* lds, const Params& p) {
    const int tid = otid(), G = gridDim.x, bx = blockIdx.x;
    unsigned char* ws = p.ws;
    wconv_jobs(lds, p, bx, G);
    {
        const int wave = tid >> 6, lane = tid & 63; bf16_t* hb = (bf16_t*)(ws + O_HB); float* ss = (float*)(ws + O_SS);
        for (int row0 = (bx * 8 + wave) * 2; row0 < MT; row0 += G * 16) {
            f32x4 v[2][4];
#pragma unroll
            for (int q = 0; q < 2; ++q)
#pragma unroll
                for (int i = 0; i < 4; ++i) v[q][i] = *(const f32x4*)(p.in[0] + (size_t)(row0 + q) * DM + lane * 4 + 256 * i);
#pragma unroll
            for (int q = 0; q < 2; ++q) {
                float sq = 0.f;
#pragma unroll
                for (int i = 0; i < 4; ++i) { const f32x4 x = v[q][i]; sq += x[0] * x[0] + x[1] * x[1] + x[2] * x[2] + x[3] * x[3];
                    u32x2 o; o[0] = pk2(x[0], x[1]); o[1] = pk2(x[2], x[3]); *(u32x2*)(hb + (size_t)(row0 + q) * DM + lane * 4 + 256 * i) = o; }
#pragma unroll
                for (int o = 32; o >= 1; o >>= 1) sq += __shfl_xor(sq, o);
                if (lane == 0) ss[row0 + q] = sq;
            }
        }
        for (int i = bx * 512 + tid; i < 4 * MT; i += G * 512) ss[MT + i] = 0.f;
        f32x2* tab = (f32x2*)(ws + O_ROPE);
        for (int i = bx * 512 + tid; i < SEQ * 32; i += G * 512) {
            const int pos = i >> 5, f = i & 31; const float inv = fexp2(-(float)f * 0.41524101186092f); const float ang = (float)pos * inv;
            double t = (double)ang * 0.15915494309189535; t -= floor(t); const float tf = (float)t;
            f32x2 cs; cs[0] = __builtin_amdgcn_cosf(tf); cs[1] = __builtin_amdgcn_sinf(tf); tab[i] = cs;
        }
        if (bx == 0 && tid == 0) { float s1 = 0.f, s2 = 0.f; for (int i = 0; i < 64; ++i) { s1 += p.in[3][i] * p.in[4][i]; s2 += p.in[5][i] * p.in[6][i]; }
            *(float*)(ws + O_LAM) = fexp2(s1 * LOG2E) - fexp2(s2 * LOG2E) + 0.2f; }
    }
}

struct EpiAttnIn {
    static constexpr bool PERM = true, AFTER_DRAIN = false;
    bf16_t* O; const float* ss; const f32x4* tab;
    DI void pre(const pg8::Unit& u, int wr, int fr, float (&e)[8]) const {
#pragma unroll
        for (int ai = 0; ai < 2; ++ai)
#pragma unroll
            for (int m = 0; m < 4; ++m) e[ai * 4 + m] = ss[u.pm * 256 + wr * 64 + fr + ai * 128 + m * 16];
    }
    DI void operator()(const f32x4 (&acc)[2][2][4][2], const pg8::Unit& u, int wr, int wc, int fr, int fq, const float (&epre)[8]) const {
        const int row0 = u.pm * 256 + wr * 64 + fr, colt = u.pn * 256, col0 = colt + wc * 32 + 8 * fq;
        const int fb = 4 * (4 * (wc & 1) + fq);
#pragma unroll
        for (int ai = 0; ai < 2; ++ai)
#pragma unroll
            for (int m = 0; m < 4; ++m) {
                const int row = row0 + ai * 128 + m * 16; const float rs = __builtin_amdgcn_rsqf(epre[ai * 4 + m] * (1.0f / 1024.0f) + 1e-6f);
                f32x4 c01 = {1.f, 0.f, 1.f, 0.f}, c23 = {1.f, 0.f, 1.f, 0.f};
                if (colt < 1024) { const int pos = row & (SEQ - 1); c01 = tab[(pos * 32 + fb) >> 1]; c23 = tab[((pos * 32 + fb) >> 1) + 1]; }
#pragma unroll
                for (int bj = 0; bj < 2; ++bj) {
                    f32x4 v0 = acc[ai][bj][m][0] * rs, v1 = acc[ai][bj][m][1] * rs;
                    if (colt < 1024) {
                        const float cs[4] = {c01[0], c01[2], c23[0], c23[2]}, sn[4] = {c01[1], c01[3], c23[1], c23[3]};
#pragma unroll
                        for (int j = 0; j < 4; ++j) { const float t1 = v0[j], t2 = v1[j]; v0[j] = t1 * cs[j] - t2 * sn[j]; v1[j] = t2 * cs[j] + t1 * sn[j]; }
                    }
                    u32x4 o; o[0] = pk2(v0[0], v0[1]); o[1] = pk2(v0[2], v0[3]); o[2] = pk2(v1[0], v1[1]); o[3] = pk2(v1[2], v1[3]);
                    *(u32x4*)(O + (size_t)row * AINW + col0 + bj * 128) = o;
                }
            }
    }
};
template <bool RES_F32, bool OUT_F32> struct EpiRes {
    static constexpr bool PERM = false, AFTER_DRAIN = false;
    const float* xres; bf16_t* hb; float* outf; float* ssn;
    DI void pre(const pg8::Unit&, int, int, float (&)[8]) const {}
    DI void operator()(const f32x4 (&acc)[2][2][4][2], const pg8::Unit& u, int wr, int wc, int fr, int fq, const float (&epre)[8]) const {
        const int row0 = u.pm * 256 + wr * 64 + fr, col0 = u.pn * 256 + wc * 32 + 4 * fq;
#pragma unroll
        for (int ai = 0; ai < 2; ++ai)
#pragma unroll
            for (int m = 0; m < 4; ++m) {
                const int row = row0 + ai * 128 + m * 16; float sq = 0.f;
#pragma unroll
                for (int bj = 0; bj < 2; ++bj)
#pragma unroll
                    for (int n = 0; n < 2; ++n) {
                        const size_t off = (size_t)row * DM + col0 + bj * 128 + n * 16; f32x4 r;
                        if (RES_F32) r = *(const f32x4*)(xres + off);
                        else { const u32x2 t = *(const u32x2*)(hb + off); r[0] = bflo(t[0]); r[1] = bfhi(t[0]); r[2] = bflo(t[1]); r[3] = bfhi(t[1]); }
                        const f32x4 v = r + acc[ai][bj][m][n];
                        sq += v[0] * v[0] + v[1] * v[1] + v[2] * v[2] + v[3] * v[3];
                        if (OUT_F32) *(f32x4*)(outf + off) = v;
                        else { u32x2 o; o[0] = pk2(v[0], v[1]); o[1] = pk2(v[2], v[3]); *(u32x2*)(hb + off) = o; }
                    }
                sq += __shfl_xor(sq, 16); sq += __shfl_xor(sq, 32);
                if (fq == 0) atomicAdd(ssn + row, sq);
            }
    }
};
struct EpiGU {
    static constexpr bool PERM = true, AFTER_DRAIN = false;
    bf16_t* act; const float* ss;
    DI void pre(const pg8::Unit& u, int wr, int fr, float (&e)[8]) const {
#pragma unroll
        for (int ai = 0; ai < 2; ++ai)
#pragma unroll
            for (int m = 0; m < 4; ++m) e[ai * 4 + m] = ss[u.pm * 256 + wr * 64 + fr + ai * 128 + m * 16];
    }
    DI void operator()(const f32x4 (&acc)[2][2][4][2], const pg8::Unit& u, int wr, int wc, int fr, int fq, const float (&epre)[8]) const {
        const int row0 = u.pm * 256 + wr * 64 + fr, col0 = u.pn * 256 + wc * 32 + 8 * fq;
#pragma unroll
        for (int ai = 0; ai < 2; ++ai)
#pragma unroll
            for (int m = 0; m < 4; ++m) {
                const int row = row0 + ai * 128 + m * 16; const float rs = __builtin_amdgcn_rsqf(epre[ai * 4 + m] * (1.0f / 1024.0f) + 1e-6f);
#pragma unroll
                for (int bj = 0; bj < 2; ++bj) {
                    const f32x4 g = acc[ai][bj][m][0] * rs, up = acc[ai][bj][m][1] * rs; float a[4];
#pragma unroll
                    for (int j = 0; j < 4; ++j) a[j] = fsilu(g[j]) * up[j];
                    u32x2 o; o[0] = pk2(a[0], a[1]); o[1] = pk2(a[2], a[3]);
                    *(u32x2*)(act + (size_t)row * DFF + ((col0 + bj * 128) >> 1)) = o;
                }
            }
    }
};
struct EpiSsdIn {
    static constexpr bool PERM = true, AFTER_DRAIN = false;
    bf16_t* z; bf16_t* xbc; float* dt; const float* ss;
    DI void pre(const pg8::Unit& u, int wr, int fr, float (&e)[8]) const {
#pragma unroll
        for (int ai = 0; ai < 2; ++ai)
#pragma unroll
            for (int m = 0; m < 4; ++m) e[ai * 4 + m] = ss[u.pm * 256 + wr * 64 + fr + ai * 128 + m * 16];
    }
    DI void operator()(const f32x4 (&acc)[2][2][4][2], const pg8::Unit& u, int wr, int wc, int fr, int fq, const float (&epre)[8]) const {
        const int row0 = u.pm * 256 + wr * 64 + fr, col0 = u.pn * 256 + wc * 32 + 8 * fq;
#pragma unroll
        for (int ai = 0; ai < 2; ++ai)
#pragma unroll
            for (int m = 0; m < 4; ++m) {
                const int row = row0 + ai * 128 + m * 16; const float rs = __builtin_amdgcn_rsqf(epre[ai * 4 + m] * (1.0f / 1024.0f) + 1e-6f);
#pragma unroll
                for (int bj = 0; bj < 2; ++bj) {
                    const int c = col0 + bj * 128; const f32x4 v0 = acc[ai][bj][m][0] * rs, v1 = acc[ai][bj][m][1] * rs;
                    if (c < 6144) { u32x4 o; o[0] = pk2(v0[0], v0[1]); o[1] = pk2(v0[2], v0[3]); o[2] = pk2(v1[0], v1[1]); o[3] = pk2(v1[2], v1[3]);
                        if (c < DIN) *(u32x4*)(z + (size_t)row * DIN + c) = o; else *(u32x4*)(xbc + (size_t)row * XBCW + (c - DIN)) = o; }
                }
            }
    }
};

struct EpiFinal {
    static constexpr bool PERM = false, AFTER_DRAIN = true;
    const bf16_t* hb; float* outf; float* ssn; unsigned* cnt; const float* fw;
    DI void operator()(const f32x4 (&)[2][2][4][2], const pg8::Unit&, int, int, int, int, const float (&)[8]) const {}
    DI void pre(const pg8::Unit&, int, int, float (&)[8]) const {}
    DI void fused(f32x4 (&acc)[2][2][4][2], const pg8::Unit& u, int wr, int wc, int fr, int fq, PG8_LAS unsigned char*, int, int) const {
        const int row0 = u.pm * 256 + wr * 64 + fr, col0 = u.pn * 256 + wc * 32 + 4 * fq;
#pragma unroll
        for (int ai = 0; ai < 2; ++ai)
#pragma unroll
            for (int m = 0; m < 4; ++m) {
                const int row = row0 + ai * 128 + m * 16; float sq = 0.f;
#pragma unroll
                for (int bj = 0; bj < 2; ++bj)
#pragma unroll
                    for (int n = 0; n < 2; ++n) {
                        const size_t off = (size_t)row * DM + col0 + bj * 128 + n * 16;
                        const u32x2 t = *(const u32x2*)(hb + off); f32x4 r; r[0] = bflo(t[0]); r[1] = bfhi(t[0]); r[2] = bflo(t[1]); r[3] = bfhi(t[1]);
                        const f32x4 v = r + acc[ai][bj][m][n]; acc[ai][bj][m][n] = v;
                        sq += v[0] * v[0] + v[1] * v[1] + v[2] * v[2] + v[3] * v[3];
                    }
                sq += __shfl_xor(sq, 16); sq += __shfl_xor(sq, 32);
                if (fq == 0) atomicAdd(ssn + row, sq);
            }
        asm volatile("s_waitcnt vmcnt(0)" ::: "memory");
        __syncthreads();
        unsigned* c = cnt + 16 * u.pm;
        if (threadIdx.x == 0) {
            __builtin_amdgcn_fence(__ATOMIC_RELEASE, "agent"); asm volatile("s_waitcnt vmcnt(0)" ::: "memory");
            __hip_atomic_fetch_add(c, 1u, __ATOMIC_RELAXED, __HIP_MEMORY_SCOPE_AGENT);
            unsigned spins = 0;
            while (__hip_atomic_load(c, __ATOMIC_RELAXED, __HIP_MEMORY_SCOPE_AGENT) < 4u && ++spins < (1u << 22)) __builtin_amdgcn_s_sleep(2);
            __builtin_amdgcn_fence(__ATOMIC_ACQUIRE, "agent"); asm volatile("s_waitcnt vmcnt(0)" ::: "memory");
        }
        __syncthreads();
#pragma unroll
        for (int ai = 0; ai < 2; ++ai)
#pragma unroll
            for (int m = 0; m < 4; ++m) {
                const int row = row0 + ai * 128 + m * 16;
                const float rs = __builtin_amdgcn_rsqf(__hip_atomic_load(ssn + row, __ATOMIC_RELAXED, __HIP_MEMORY_SCOPE_AGENT) * (1.0f / 1024.0f) + 1e-6f);
#pragma unroll
                for (int bj = 0; bj < 2; ++bj)
#pragma unroll
                    for (int n = 0; n < 2; ++n) {
                        const int col = col0 + bj * 128 + n * 16; const f32x4 w = *(const f32x4*)(fw + col);
                        *(f32x4*)(outf + (size_t)row * DM + col) = acc[ai][bj][m][n] * rs * w;
                    }
            }
    }
};
constexpr int KST = 144, VST = 320, VST64 = 192;
constexpr int AT_K1 = 0, AT_K2 = 64 * KST, AT_V = 2 * 64 * KST, AT_STAGE = AT_V + 64 * VST;

DI void diff_tile(LAS unsigned char* lds, const bf16_t* proj, bf16_t* mixed, const float* subln, float lam, int b, int hd, int qt) {
    const int tid = otid(), w = __builtin_amdgcn_readfirstlane(tid >> 6), lane = tid & 63, qg = w & 3, mp = w >> 2, r = lane & 31, h = lane >> 5;
    const int q0 = qt * 128; const size_t rowb = (size_t)b * SEQ;
    bf16x8 qf[4];
    { const bf16_t* qp = proj + (rowb + q0 + 32 * qg + r) * AINW + hd * 128 + mp * 64 + 8 * h;
#pragma unroll
      for (int s = 0; s < 4; ++s) qf[s] = *(const bf16x8*)(qp + 16 * s); }
    f32x16 O[4];
#pragma unroll
    for (int i = 0; i < 4; ++i) O[i] = zero16();
    float mrun = 0.f, lrun = 0.f;
    const int nsteps = 2 * (qt + 1);
    const bf16_t* src[4]; int dst[4];
#pragma unroll
    for (int i = 0; i < 2; ++i) { const int cid = tid + 512 * i, row = cid >> 4, c16 = cid & 15;
        src[i] = proj + (rowb + row) * AINW + 512 + hd * 128 + c16 * 8; dst[i] = (c16 < 8 ? AT_K1 : AT_K2) + row * KST + (c16 & 7) * 16;
        src[2 + i] = proj + (rowb + row) * AINW + 1024 + hd * 128 + c16 * 8; dst[2 + i] = AT_V + row * VST + c16 * 16; }
    u32x4 pf[4];
#pragma unroll
    for (int i = 0; i < 4; ++i) pf[i] = *(const u32x4*)(src[i]);
#pragma unroll
    for (int i = 0; i < 4; ++i) *(LAS u32x4*)(lds + dst[i]) = pf[i];
    __syncthreads();
    const int i16 = lane & 15, tq = i16 >> 2, tp = i16 & 3, g16 = (lane >> 4) & 1;
    const int troff = (4 * h + tq) * VST + (16 * g16 + 4 * tp) * 2;
    for (int j = 0; j < nsteps; ++j) {
        const bool more = (j + 1 < nsteps);
        if (more) {
#pragma unroll
            for (int i = 0; i < 4; ++i) pf[i] = *(const u32x4*)(src[i] + (size_t)(j + 1) * 64 * AINW);
        }
        const LAS unsigned char* base = lds + (j & 1) * AT_STAGE;
        const LAS unsigned char* Kb = base + (mp ? AT_K2 : AT_K1);
        const LAS unsigned char* Vb = base + AT_V;
        f32x16 S[2];
        const float negm = -mrun;
#pragma unroll
        for (int kt = 0; kt < 2; ++kt) {
#pragma unroll
            for (int i = 0; i < 16; ++i) S[kt][i] = negm;
#pragma unroll
            for (int s = 0; s < 4; ++s) { const bf16x8 kf = *(const LAS bf16x8*)(Kb + (32 * kt + r) * KST + (16 * s + 8 * h) * 2); S[kt] = MFMA32(kf, qf[s], S[kt]); } }
        const int qidx = q0 + 32 * qg + r, kbase = 64 * j;
        if (kbase + 63 > q0 + 32 * qg) {
#pragma unroll
            for (int kt = 0; kt < 2; ++kt)
#pragma unroll
                for (int i = 0; i < 16; ++i) if (kbase + 32 * kt + crow(i, h) > qidx) S[kt][i] = -1e30f;
        }
        float mx = S[0][0];
#pragma unroll
        for (int kt = 0; kt < 2; ++kt)
#pragma unroll
            for (int i = 0; i < 16; ++i) mx = fmaxf(mx, S[kt][i]);
        mx = fmaxf(mx, __shfl_xor(mx, 32));
        if (j == 0 || __builtin_amdgcn_ballot_w64(mx > 8.0f) != 0ull) {
            const float d = (j == 0) ? mx : fmaxf(mx, 0.f);
            mrun += d;
            if (j != 0) { const float alpha = fexp2(-d); lrun *= alpha;
#pragma unroll
                for (int vt = 0; vt < 4; ++vt) O[vt] = O[vt] * alpha; }
#pragma unroll
            for (int kt = 0; kt < 2; ++kt)
#pragma unroll
                for (int i = 0; i < 16; ++i) S[kt][i] -= d;
        }
        float ls = 0.f;
#pragma unroll
        for (int kt = 0; kt < 2; ++kt)
#pragma unroll
            for (int i = 0; i < 16; ++i) { const float pv = fexp2(S[kt][i]); S[kt][i] = pv; ls += pv; }
        lrun += ls;
#pragma unroll
        for (int kt = 0; kt < 2; ++kt)
#pragma unroll
            for (int s2 = 0; s2 < 2; ++s2) {
                const bf16x8 pfr = pack8(S[kt], s2);
                const LAS unsigned char* vrow = Vb + (32 * kt + 16 * s2) * VST + troff;
#pragma unroll
                for (int vt = 0; vt < 4; ++vt) { const bf16x8 vf = tr2(vrow + vt * 64, vrow + 8 * VST + vt * 64); O[vt] = MFMA32(vf, pfr, O[vt]); }
            }
        if (more) {
            LAS unsigned char* nb = lds + ((j + 1) & 1) * AT_STAGE;
#pragma unroll
            for (int i = 0; i < 4; ++i) *(LAS u32x4*)(nb + dst[i]) = pf[i];
        }
        __syncthreads();
    }
    lrun += __shfl_xor(lrun, 32);
    const float inv = frcp(lrun);
    LAS float* ex = (LAS float*)lds;
    if (mp == 1) {
        const float sc = inv * lam;
#pragma unroll
        for (int vt = 0; vt < 4; ++vt)
#pragma unroll
            for (int i = 0; i < 16; ++i) ex[(qg * 128 + 32 * vt + crow(i, h)) * 32 + r] = O[vt][i] * sc;
    }
    __syncthreads();
    if (mp == 0) {
        float sq = 0.f;
#pragma unroll
        for (int vt = 0; vt < 4; ++vt)
#pragma unroll
            for (int i = 0; i < 16; ++i) { const float o = O[vt][i] * inv - ex[(qg * 128 + 32 * vt + crow(i, h)) * 32 + r]; O[vt][i] = o; sq += o * o; }
        sq += __shfl_xor(sq, 32);
        const float rn = __builtin_amdgcn_rsqf(sq * (1.0f / 128.0f) + 1e-5f) * 0.8f;
        bf16_t* op = mixed + (rowb + q0 + 32 * qg + r) * DM + hd * 128;
#pragma unroll
        for (int vt = 0; vt < 4; ++vt)
#pragma unroll
            for (int gq = 0; gq < 4; ++gq) { const int v0 = 32 * vt + 8 * gq + 4 * h; const f32x4 wv = *(const f32x4*)(subln + v0);
                u32x2 o; o[0] = pk2(O[vt][4 * gq] * rn * wv[0], O[vt][4 * gq + 1] * rn * wv[1]); o[1] = pk2(O[vt][4 * gq + 2] * rn * wv[2], O[vt][4 * gq + 3] * rn * wv[3]);
                *(u32x2*)(op + v0) = o; }
    }
    __syncthreads();
}

constexpr int SB_K = 0, SB_V = 64 * KST, SB_STAGE = 64 * KST + 64 * VST64;
DI void sb_block(LAS unsigned char* lds, const bf16_t* proj, bf16_t* mixed, int b, int hs, int qb) {
    const int tid = otid(), w = __builtin_amdgcn_readfirstlane(tid >> 6), lane = tid & 63, r = lane & 31, h = lane >> 5;
    const int q0 = qb * 256; const size_t rowb = (size_t)b * SEQ;
    const int qidx = q0 + 32 * w + r;
    bf16x8 qf[4];
    { const bf16_t* qp = proj + (rowb + qidx) * AINW + 1536 + hs * 64 + 8 * h;
#pragma unroll
      for (int s = 0; s < 4; ++s) qf[s] = *(const bf16x8*)(qp + 16 * s); }
    f32x16 O[2]; O[0] = zero16(); O[1] = zero16();
    float carry = 1.0f;
    const int jmax = 4 * qb + 3;
    const int srow = tid >> 3, sc8 = tid & 7;
    const bf16_t* srcK = proj + (rowb + srow) * AINW + 2048 + hs * 64 + sc8 * 8;
    const bf16_t* srcV = proj + (rowb + srow) * AINW + 2560 + hs * 64 + sc8 * 8;
    const int dstK = SB_K + srow * KST + sc8 * 16, dstV = SB_V + srow * VST64 + sc8 * 16;
    u32x4 pk_ = *(const u32x4*)(srcK + (size_t)jmax * 64 * AINW), pv_ = *(const u32x4*)(srcV + (size_t)jmax * 64 * AINW);
    *(LAS u32x4*)(lds + dstK) = pk_; *(LAS u32x4*)(lds + dstV) = pv_;
    __syncthreads();
    const int i16 = lane & 15, tq = i16 >> 2, tp = i16 & 3, g16 = (lane >> 4) & 1;
    const int troff = (4 * h + tq) * VST64 + (16 * g16 + 4 * tp) * 2;
    int it = 0;
    for (int j = jmax; j >= 0; --j, ++it) {
        const bool more = (j > 0);
        if (more) { pk_ = *(const u32x4*)(srcK + (size_t)(j - 1) * 64 * AINW); pv_ = *(const u32x4*)(srcV + (size_t)(j - 1) * 64 * AINW); }
        const LAS unsigned char* base = lds + (it & 1) * SB_STAGE;
        const int kbase = 64 * j;
        if (kbase < q0 + 32 * w + 32) {
#pragma unroll
            for (int kt = 1; kt >= 0; --kt) {
                f32x16 S = zero16();
#pragma unroll
                for (int s = 0; s < 4; ++s) { const bf16x8 kf = *(const LAS bf16x8*)(base + SB_K + (32 * kt + r) * KST + (16 * s + 8 * h) * 2); S = MFMA32(kf, qf[s], S); }
                float T[4], sfx[16];
#pragma unroll
                for (int gq = 0; gq < 4; ++gq) {
                    float run = 1.0f;
#pragma unroll
                    for (int jj = 3; jj >= 0; --jj) {
                        const int i = 4 * gq + jj; const bool valid = (kbase + 32 * kt + crow(i, h)) < qidx;
                        const float zz = fmaxf(S[i], -60.0f); const float e = fexp2(-LOG2E * zz); const float sg = frcp(1.0f + e);
                        const float keep = valid ? e * sg : 1.0f;
                        S[i] = valid ? sg : 0.0f; sfx[i] = run; run *= keep;
                    }
                    T[gq] = run;
                }
                float To[4];
#pragma unroll
                for (int gq = 0; gq < 4; ++gq) To[gq] = __shfl_xor(T[gq], 32);
                float E[4]; float acc_hi = 1.0f;
#pragma unroll
                for (int gq = 3; gq >= 0; --gq) {
                    const float above_same = acc_hi;
                    E[gq] = (h == 0) ? above_same * To[gq] : above_same;
                    acc_hi = acc_hi * T[gq] * To[gq];
                }
#pragma unroll
                for (int i = 0; i < 16; ++i) S[i] = S[i] * carry * E[i >> 2] * sfx[i];
                carry *= acc_hi;
#pragma unroll
                for (int s2 = 0; s2 < 2; ++s2) {
                    const bf16x8 pfr = pack8(S, s2);
                    const LAS unsigned char* vrow = base + SB_V + (32 * kt + 16 * s2) * VST64 + troff;
#pragma unroll
                    for (int vt = 0; vt < 2; ++vt) { const bf16x8 vf = tr2(vrow + vt * 64, vrow + 8 * VST64 + vt * 64); O[vt] = MFMA32(vf, pfr, O[vt]); }
                }
            }
        }
        if (more) { LAS unsigned char* nb = lds + ((it + 1) & 1) * SB_STAGE; *(LAS u32x4*)(nb + dstK) = pk_; *(LAS u32x4*)(nb + dstV) = pv_; }
        const int done = (kbase < q0 + 32 * w + 32) && (carry < 1e-12f);
        const bool wdone = (__builtin_amdgcn_ballot_w64(done != 0) == ~0ull);
        LAS int* flg = (LAS int*)(lds + 2 * SB_STAGE) + (it & 1) * 8;
        if (lane == 0) flg[w] = wdone ? 1 : 0;
        __syncthreads();
        int all = 1;
#pragma unroll
        for (int ww = 0; ww < 8; ++ww) all &= flg[ww];
        if (all) break;
    }
    bf16_t* op = mixed + (rowb + qidx) * DM + 512 + hs * 64;
#pragma unroll
    for (int vt = 0; vt < 2; ++vt)
#pragma unroll
        for (int gq = 0; gq < 4; ++gq) { const int v0 = 32 * vt + 8 * gq + 4 * h;
            u32x2 o; o[0] = pk2(O[vt][4 * gq], O[vt][4 * gq + 1]); o[1] = pk2(O[vt][4 * gq + 2], O[vt][4 * gq + 3]); *(u32x2*)(op + v0) = o; }
    __syncthreads();
}
DI void attn_phase(LAS unsigned char* lds, const Params& p) {
    const bf16_t* proj = (const bf16_t*)(p.ws + O_PROJ); bf16_t* mixed = (bf16_t*)(p.ws + O_MIXED);
    const float lam = *(const float*)(p.ws + O_LAM);
    for (int it0 = blockIdx.x; it0 < 256; it0 += gridDim.x) {
        const int it = (it0 & 7) * 32 + (it0 >> 3);
        const int b = it >> 7, hd = (it >> 5) & 3, pr = it & 31;
        diff_tile(lds, proj, mixed, p.in[7], lam, b, hd, 63 - pr);
        diff_tile(lds, proj, mixed, p.in[7], lam, b, hd, pr);
    }
    for (int it0 = blockIdx.x; it0 < 512; it0 += gridDim.x) {
        const int it = (it0 & 7) * 64 + (it0 >> 3);
        const int b = it >> 8, hs = (it >> 5) & 7, qb = it & 31;
        sb_block(lds, proj, mixed, b, hs, qb);
    }
}
constexpr int SXS = 528, SXS2 = 576, SBS = 272, SBS2 = 320;
constexpr int L_SX = 0, L_SB = 128 * SXS2, L_SC = L_SB + 128 * SBS, L_SDT = L_SC + 128 * SBS, L_SAC = L_SDT + 2048, L_SSQ = L_SAC + 2048;
static_assert(L_SSQ + 4096 <= LDS_BYTES, "lds");

DI void ssd_dt_acum(LAS unsigned char* lds, const float* DT, const float* dt_bias, const float* a_log, size_t t0, int g) {
    LAS float* sdt = (LAS float*)(lds + L_SDT); LAS float* sac = (LAS float*)(lds + L_SAC);
    const int tid = otid(), hh = tid >> 7, l = tid & 127, head = 4 * g + hh, w = tid >> 6, lane = tid & 63;
    const float raw = DT[(t0 + l) * 32 + head] + dt_bias[head];
    const float dt = fmaxf(raw, 0.f) + __logf(1.0f + __expf(-fabsf(raw)));
    sdt[hh * 128 + l] = dt; sac[hh * 128 + l] = -dt * __expf(a_log[head]);
    __syncthreads();
    if (w < 4) {
        const float v0 = sac[w * 128 + 2 * lane], v1 = sac[w * 128 + 2 * lane + 1]; float s = v0 + v1;
#pragma unroll
        for (int off = 1; off < 64; off <<= 1) { const float t = __shfl_up(s, off); if (lane >= off) s += t; }
        const float ex = s - (v0 + v1);
        sac[w * 128 + 2 * lane] = ex + v0; sac[w * 128 + 2 * lane + 1] = ex + v0 + v1;
    }
    __syncthreads();
}
template <int NT, class F> DI void conv_strip(const bf16_t* src, int nzero, const float* cw, const float* cb, int ch, F&& emit) {
    f32x4 wlo[4], whi[4];
#pragma unroll
    for (int k = 0; k < 4; ++k) { wlo[k] = *(const f32x4*)(cw + k * XBCW + ch); whi[k] = *(const f32x4*)(cw + k * XBCW + ch + 4); }
    const f32x4 blo = *(const f32x4*)(cb + ch), bhi = *(const f32x4*)(cb + ch + 4);
    u32x4 raw[NT + 3];
#pragma unroll
    for (int i = 0; i < NT + 3; ++i) { const int ii = (i < nzero) ? nzero : i; raw[i] = *(const u32x4*)(src + (ptrdiff_t)(ii - 3) * XBCW); if (i < nzero) raw[i] = (u32x4){0u, 0u, 0u, 0u}; }
#pragma unroll
    for (int t = 0; t < NT; ++t) {
        float o[8];
#pragma unroll
        for (int e = 0; e < 8; ++e) {
            float a = (e < 4) ? blo[e & 3] : bhi[e & 3];
#pragma unroll
            for (int k = 0; k < 4; ++k) { const unsigned d = raw[t + k][e >> 1]; const float xv = (e & 1) ? bfhi(d) : bflo(d); a += ((e < 4) ? wlo[k][e & 3] : whi[k][e & 3]) * xv; }
            o[e] = fsilu(a);
        }
        emit(t, o);
    }
}
DI u32x4 pack8f(const float* o) { u32x4 r; r[0] = pk2(o[0], o[1]); r[1] = pk2(o[2], o[3]); r[2] = pk2(o[4], o[5]); r[3] = pk2(o[6], o[7]); return r; }

template <bool XW, bool WITH_C> DI void ssd_stage(LAS unsigned char* lds, const bf16_t* xbc, const float* cw, const float* cb, size_t t0, int c, int g) {
    const int tid = otid();
    LAS float* sdt = (LAS float*)(lds + L_SDT); LAS float* sac = (LAS float*)(lds + L_SAC);
    {
        const int c8 = tid & 31, tg = tid >> 5, l0 = 8 * tg, ch = 256 * g + 8 * c8, hh = c8 >> 3;
        const int nzero = (c == 0) ? (3 - l0 > 0 ? 3 - l0 : 0) : 0;
        const float alast = sac[hh * 128 + 127];
        conv_strip<8>(xbc + (t0 + l0) * XBCW + ch, nzero, cw, cb, ch, [&](int t, float* o) {
            if (XW) { const float wgt = sdt[hh * 128 + l0 + t] * __expf(alast - sac[hh * 128 + l0 + t]);
#pragma unroll
                for (int e = 0; e < 8; ++e) o[e] *= wgt; }
            *(LAS u32x4*)(lds + L_SX + (l0 + t) * (XW ? SXS2 : SXS) + c8 * 16) = pack8f(o); });
    }
    {
        const int c8 = tid & 15, tg = tid >> 4, l0 = 4 * tg;
        const int nzero = (c == 0) ? (3 - l0 > 0 ? 3 - l0 : 0) : 0;
        const int chb = DIN + 128 * g + 8 * c8;
        conv_strip<4>(xbc + (t0 + l0) * XBCW + chb, nzero, cw, cb, chb, [&](int t, float* o) { *(LAS u32x4*)(lds + L_SB + (l0 + t) * (XW ? SBS2 : SBS) + c8 * 16) = pack8f(o); });
        if (WITH_C) { const int chc = DIN + 1024 + 128 * g + 8 * c8;
            conv_strip<4>(xbc + (t0 + l0) * XBCW + chc, nzero, cw, cb, chc, [&](int t, float* o) { *(LAS u32x4*)(lds + L_SC + (l0 + t) * SBS + c8 * 16) = pack8f(o); }); }
    }
}
DI bf16_t* st_ptr(unsigned char* ws, int b) { return (bf16_t*)(ws + (b ? O_ST1 : O_ST0)); }

DI void ssd_states_phase(LAS unsigned char* lds, const Params& p) {
    const int tid = otid(), w = __builtin_amdgcn_readfirstlane(tid >> 6), lane = tid & 63, r = lane & 31, h = lane >> 5, hh = w >> 1, ph = w & 1;
    const bf16_t* xbc = (const bf16_t*)(p.ws + O_XBC); const float* DT = (const float*)(p.ws + O_DT); float* cdec = (float*)(p.ws + O_CDEC);
    const int i16 = lane & 15, tq = i16 >> 2, tp = i16 & 3, g16 = (lane >> 4) & 1;
    for (int it = blockIdx.x; it < 1024; it += gridDim.x) {
        const int b = it >> 9, c = (it >> 3) & 63, g = it & 7; const size_t t0 = (size_t)b * SEQ + (size_t)c * 128;
        ssd_dt_acum(lds, DT, p.in[13], p.in[14], t0, g);
        ssd_stage<true, false>(lds, xbc, p.in[11], p.in[12], t0, c, g);
        __syncthreads();
        f32x16 acc[4];
#pragma unroll
        for (int i = 0; i < 4; ++i) acc[i] = zero16();
        const LAS unsigned char* xa = lds + L_SX + (8 * h + tq) * SXS2 + (64 * hh + 32 * ph + 16 * g16 + 4 * tp) * 2;
        const LAS unsigned char* ba = lds + L_SB + (8 * h + tq) * SBS2 + (16 * g16 + 4 * tp) * 2;
#pragma unroll
        for (int s = 0; s < 8; ++s) {
            const bf16x8 af = tr2(xa + 16 * s * SXS2, xa + (16 * s + 4) * SXS2);
#pragma unroll
            for (int nt = 0; nt < 4; ++nt) { const bf16x8 bfr = tr2(ba + 16 * s * SBS2 + nt * 64, ba + (16 * s + 4) * SBS2 + nt * 64); acc[nt] = MFMA32(af, bfr, acc[nt]); }
        }
        bf16_t* st = st_ptr(p.ws, b) + ((size_t)(c * 32 + 4 * g + hh) * 64 + 32 * ph) * 128;
#pragma unroll
        for (int nt = 0; nt < 4; ++nt)
#pragma unroll
            for (int i = 0; i < 16; ++i) st[(size_t)crow(i, h) * 128 + 32 * nt + r] = (bf16_t)(pk2(acc[nt][i], 0.f) & 0xffffu);
        if (tid < 4) cdec[(b * 64 + c) * 32 + 4 * g + tid] = __expf(((LAS float*)(lds + L_SAC))[tid * 128 + 127]);
        __syncthreads();
    }
}
DI void ssd_scan_phase(const Params& p, const bool dry) {
    const float* cdec = (const float*)(p.ws + O_CDEC);
    for (int e = blockIdx.x * 512 + threadIdx.x; e < 2 * 32 * 64 * 32; e += gridDim.x * 512) {
        const int b = e >> 16, rem = e & 65535, head = rem >> 11;
        bf16_t* st = st_ptr(p.ws, b) + (size_t)rem * 4;
        float carry[4] = {0.f, 0.f, 0.f, 0.f};
        for (int c0 = 0; c0 < 64; c0 += 8) {
            u32x2 v[8]; float dc[8];
#pragma unroll
            for (int u = 0; u < 8; ++u) { v[u] = *(const u32x2*)(st + (size_t)(c0 + u) * 262144); dc[u] = cdec[(b * 64 + c0 + u) * 32 + head]; }
#pragma unroll
            for (int u = 0; u < 8; ++u) {
                u32x2 o; o[0] = pk2(carry[0], carry[1]); o[1] = pk2(carry[2], carry[3]); if (!dry) *(u32x2*)(st + (size_t)(c0 + u) * 262144) = o;
                carry[0] = carry[0] * dc[u] + bflo(v[u][0]); carry[1] = carry[1] * dc[u] + bfhi(v[u][0]); carry[2] = carry[2] * dc[u] + bflo(v[u][1]); carry[3] = carry[3] * dc[u] + bfhi(v[u][1]);
            }
        }
    }
}
DI void ssd_out_phase(LAS unsigned char* lds, const Params& p, const bool dry) {
    const int tid = otid(), w = __builtin_amdgcn_readfirstlane(tid >> 6), lane = tid & 63, r = lane & 31, h = lane >> 5, hh = w >> 1, ph = w & 1;
    const bf16_t* xbc = (const bf16_t*)(p.ws + O_XBC); const float* DT = (const float*)(p.ws + O_DT); bf16_t* zy = (bf16_t*)p.out;
    LAS float* sdt = (LAS float*)(lds + L_SDT); LAS float* sac = (LAS float*)(lds + L_SAC); LAS float* ssq = (LAS float*)(lds + L_SSQ);
    const int i16 = lane & 15, tq = i16 >> 2, tp = i16 & 3, g16 = (lane >> 4) & 1;
    for (int it = blockIdx.x; it < 1024; it += gridDim.x) {
        const int b = it >> 9, c = (it >> 3) & 63, g = it & 7, head = 4 * g + hh; const size_t t0 = (size_t)b * SEQ + (size_t)c * 128;
        ssd_dt_acum(lds, DT, p.in[13], p.in[14], t0, g);
        ssd_stage<false, true>(lds, xbc, p.in[11], p.in[12], t0, c, g);
        bf16x8 pvf[8];
        { const bf16_t* pp = st_ptr(p.ws, b) + ((size_t)(c * 32 + head) * 64 + 32 * ph + r) * 128 + 8 * h;
#pragma unroll
          for (int s = 0; s < 8; ++s) pvf[s] = *(const bf16x8*)(pp + 16 * s); }
        __syncthreads();
        f32x16 Y[4];
        const LAS unsigned char* xa = lds + L_SX + (4 * h + tq) * SXS + (64 * hh + 32 * ph + 16 * g16 + 4 * tp) * 2;
#pragma unroll
        for (int lt = 0; lt < 4; ++lt) {
            __builtin_amdgcn_sched_barrier(0);
            f32x16 y = zero16();
#pragma unroll
            for (int s = 0; s < 8; ++s) { const bf16x8 cfs = *(const LAS bf16x8*)(lds + L_SC + (32 * lt + r) * SBS + (16 * s + 8 * h) * 2); y = MFMA32(pvf[s], cfs, y); }
            Y[lt] = y * __expf(sac[hh * 128 + 32 * lt + r]);
        }
#pragma unroll
        for (int lt = 0; lt < 4; ++lt) {
            __builtin_amdgcn_sched_barrier(0);
            bf16x8 cf[8];
#pragma unroll
            for (int s = 0; s < 8; ++s) cf[s] = *(const LAS bf16x8*)(lds + L_SC + (32 * lt + r) * SBS + (16 * s + 8 * h) * 2);
            const float al = sac[hh * 128 + 32 * lt + r];
#pragma unroll
            for (int mt = 0; mt < 4; ++mt) {
                if (mt <= lt) {
                    __builtin_amdgcn_sched_barrier(0);
                    f32x16 X = zero16();
#pragma unroll
                    for (int s = 0; s < 8; ++s) { const bf16x8 bfr = *(const LAS bf16x8*)(lds + L_SB + (32 * mt + r) * SBS + (16 * s + 8 * h) * 2); X = MFMA32(bfr, cf[s], X); }
#pragma unroll
                    for (int gq = 0; gq < 4; ++gq) {
                        const f32x4 am = *(const LAS f32x4*)(sac + hh * 128 + 32 * mt + 8 * gq + 4 * h), dm = *(const LAS f32x4*)(sdt + hh * 128 + 32 * mt + 8 * gq + 4 * h);
#pragma unroll
                        for (int jj = 0; jj < 4; ++jj) { const int mrow = 32 * mt + 8 * gq + 4 * h + jj; const bool ok = (32 * lt + r) >= mrow;
                            const float dec = ok ? __expf(fminf(al - am[jj], 0.f)) * dm[jj] : 0.f; X[4 * gq + jj] *= dec; }
                    }
#pragma unroll
                    for (int s2 = 0; s2 < 2; ++s2) { const bf16x8 xs = pack8(X, s2);
                        const LAS unsigned char* xr = xa + (32 * mt + 16 * s2) * SXS; const bf16x8 xf = tr2(xr, xr + 8 * SXS); Y[lt] = MFMA32(xf, xs, Y[lt]); }
                }
            }
        }
        __builtin_amdgcn_sched_barrier(0);
        const float Dh = p.in[15][head];
        float sq[4];
#pragma unroll
        for (int lt = 0; lt < 4; ++lt) {
            const int l = 32 * lt + r; sq[lt] = 0.f;
#pragma unroll
            for (int gq = 0; gq < 4; ++gq) {
                const int chl = 64 * hh + 32 * ph + 8 * gq + 4 * h;
                const u32x2 xv = *(const LAS u32x2*)(lds + L_SX + l * SXS + chl * 2);
                const u32x2 zv = *(const u32x2*)(zy + (t0 + l) * DIN + 256 * g + chl);
                const float xf4[4] = {bflo(xv[0]), bfhi(xv[0]), bflo(xv[1]), bfhi(xv[1])}, zf4[4] = {bflo(zv[0]), bfhi(zv[0]), bflo(zv[1]), bfhi(zv[1])};
#pragma unroll
                for (int jj = 0; jj < 4; ++jj) { const float yv = (Y[lt][4 * gq + jj] + Dh * xf4[jj]) * fsilu(zf4[jj]); Y[lt][4 * gq + jj] = yv; sq[lt] += yv * yv; }
            }
            sq[lt] += __shfl_xor(sq[lt], 32);
            if (h == 0) ssq[w * 128 + l] = sq[lt];
        }
        __syncthreads();
#pragma unroll
        for (int lt = 0; lt < 4; ++lt) {
            const int l = 32 * lt + r; float tot = 0.f;
#pragma unroll
            for (int ww = 0; ww < 8; ++ww) tot += ssq[ww * 128 + l];
            const float rn = __builtin_amdgcn_rsqf(tot * (1.0f / 256.0f) + 1e-5f);
#pragma unroll
            for (int gq = 0; gq < 4; ++gq) {
                const int chl = 64 * hh + 32 * ph + 8 * gq + 4 * h; const f32x4 gw = *(const f32x4*)(p.in[16] + 256 * g + chl);
                u32x2 o; o[0] = pk2(Y[lt][4 * gq] * rn * gw[0], Y[lt][4 * gq + 1] * rn * gw[1]); o[1] = pk2(Y[lt][4 * gq + 2] * rn * gw[2], Y[lt][4 * gq + 3] * rn * gw[3]);
                if (!dry) *(u32x2*)(zy + (t0 + l) * DIN + 256 * g + chl) = o;
            }
        }
        __syncthreads();
    }
}
DI void dt_proj(LAS unsigned char* lds, const Params& p) {
    const int tid = otid(), w = __builtin_amdgcn_readfirstlane(tid >> 6), lane = tid & 63, r = lane & 31, h = lane >> 5, rt = w & 1, kq = w >> 1;
    const bf16_t* hb = (const bf16_t*)(p.ws + O_HB); const bf16_t* wt = (const bf16_t*)(p.ws + W_SIN) + (size_t)6144 * DM;
    const float* ss = (const float*)(p.ws + O_SS) + 2 * MT; float* dt = (float*)(p.ws + O_DT);
    LAS float* part = (LAS float*)lds;
    for (int rb = blockIdx.x; rb < MT / 64; rb += gridDim.x) {
        const bf16_t* ap = hb + (size_t)(rb * 64 + rt * 32 + r) * DM + kq * 256 + 8 * h;
        const bf16_t* bp = wt + (size_t)r * DM + kq * 256 + 8 * h;
        bf16x8 af[16], bfr[16];
#pragma unroll
        for (int s = 0; s < 16; ++s) { af[s] = *(const bf16x8*)(ap + 16 * s); bfr[s] = *(const bf16x8*)(bp + 16 * s); }
        f32x16 acc = zero16();
#pragma unroll
        for (int s = 0; s < 16; ++s) acc = MFMA32(af[s], bfr[s], acc);
#pragma unroll
        for (int i = 0; i < 16; ++i) part[((kq * 2 + rt) * 32 + crow(i, h)) * 32 + r] = acc[i];
        __syncthreads();
#pragma unroll
        for (int q = 0; q < 4; ++q) {
            const int o = tid + 512 * q, row = o >> 5, col = o & 31;
            float v = 0.f;
#pragma unroll
            for (int k = 0; k < 4; ++k) v += part[((k * 2 + (row >> 5)) * 32 + (row & 31)) * 32 + col];
            const int grow = rb * 64 + row;
            dt[(size_t)grow * 32 + col] = v * __builtin_amdgcn_rsqf(ss[grow] * (1.0f / 1024.0f) + 1e-6f);
        }
        __syncthreads();
    }
}
template <class Epi> DI void run_gemm(LAS unsigned char* lds, const bf16_t* A, const bf16_t* Bt, int N, int K, const Epi& E) {
    pg8::Gemm g; g.A = A; g.Bt = Bt; g.M = MT; g.N = N; g.K = K;
    pg8::StaticOrder S; S.init(MT, N, (int)gridDim.x, (int)blockIdx.x);
    pg8::gemm_phase<Epi, pg8::StaticOrder, !Epi::AFTER_DRAIN, true>((PG8_LAS unsigned char*)lds, g, S, E);
}
#if defined(DRY_S3) || defined(DRY_S4)
#define DRYV (p.ws == nullptr)
#else
#define DRYV false
#endif
__global__ void __launch_bounds__(512, 2) fwd_megakernel(Params p) {
    extern __shared__ __attribute__((aligned(16))) unsigned char shm[];
    LAS unsigned char* lds = (LAS unsigned char*)shm;
    cg::grid_group grid = cg::this_grid();
    if (threadIdx.x < 4) ((LAS unsigned*)(lds + LDS_BYTES - 16))[threadIdx.x] = 0u;
    __syncthreads();
    const XcdBarrier xbar = xcd_barrier_post((unsigned*)(p.ws + O_BAR), (volatile LAS unsigned*)(lds + LDS_BYTES - 16));
#define GBAR() xcd_barrier(xbar)
    unsigned char* ws = p.ws;
    bf16_t* hb = (bf16_t*)(ws + O_HB); float* ss = (float*)(ws + O_SS);
    phase0(lds, p);
#ifdef DUP_P0
    GBAR(); phase0(lds, p);
#endif
    if (gridDim.x == 0x7fffffffu) grid.sync();
    GBAR();
    { EpiAttnIn E; E.O = (bf16_t*)(ws + O_PROJ); E.ss = ss; E.tab = (const f32x4*)(ws + O_ROPE); run_gemm(lds, hb, (const bf16_t*)(ws + W_AIN), AINW, DM, E); }
    GBAR();
    attn_phase(lds, p);
#ifdef DUP_ATTN
    GBAR(); attn_phase(lds, p);
#endif
    GBAR();
    { EpiRes<true, false> E; E.xres = p.in[0]; E.hb = hb; E.outf = nullptr; E.ssn = ss + MT; run_gemm(lds, (const bf16_t*)(ws + O_MIXED), (const bf16_t*)(ws + W_AOUT), DM, DM, E); }
    GBAR();
    { EpiGU E; E.act = (bf16_t*)(ws + O_ACT); E.ss = ss + MT; run_gemm(lds, hb, (const bf16_t*)(ws + W_GU0), 2 * DFF, DM, E); }
    GBAR();
    { EpiRes<false, false> E; E.xres = nullptr; E.hb = hb; E.outf = nullptr; E.ssn = ss + 2 * MT; run_gemm(lds, (const bf16_t*)(ws + O_ACT), (const bf16_t*)(ws + W_DN0), DM, DFF, E); }
    GBAR();
    { EpiSsdIn E; E.z = (bf16_t*)p.out; E.xbc = (bf16_t*)(ws + O_XBC); E.dt = (float*)(ws + O_DT); E.ss = ss + 2 * MT; dt_proj(lds, p); run_gemm(lds, hb, (const bf16_t*)(ws + W_SIN), 6144, DM, E); }
    GBAR();
    ssd_states_phase(lds, p);
#ifdef DUP_S2
    GBAR(); ssd_states_phase(lds, p);
#endif
    GBAR();
#ifdef DRY_S3
    ssd_scan_phase(p, p.ws != nullptr); GBAR();
#endif
    ssd_scan_phase(p, DRYV);
    GBAR();
#ifdef DRY_S4
    ssd_out_phase(lds, p, p.ws != nullptr); GBAR();
#endif
    ssd_out_phase(lds, p, DRYV);
    GBAR();
    { EpiRes<false, false> E; E.xres = nullptr; E.hb = hb; E.outf = nullptr; E.ssn = ss + 3 * MT; run_gemm(lds, (const bf16_t*)p.out, (const bf16_t*)(ws + W_SOUT), DM, DIN, E); }
    GBAR();
    { EpiGU E; E.act = (bf16_t*)(ws + O_ACT); E.ss = ss + 3 * MT; run_gemm(lds, hb, (const bf16_t*)(ws + W_GU1), 2 * DFF, DM, E); }
    GBAR();
    if (gridDim.x == 256) {
        EpiFinal E; E.hb = hb; E.outf = p.out; E.ssn = ss + 4 * MT; E.cnt = (unsigned*)(ws + O_BAR) + XCD_BAR_WORDS; E.fw = p.in[22];
        run_gemm(lds, (const bf16_t*)(ws + O_ACT), (const bf16_t*)(ws + W_DN1), DM, DFF, E);
    } else {
        { EpiRes<false, true> E; E.xres = nullptr; E.hb = hb; E.outf = p.out; E.ssn = ss + 4 * MT; run_gemm(lds, (const bf16_t*)(ws + O_ACT), (const bf16_t*)(ws + W_DN1), DM, DFF, E); }
        GBAR();
        const float* ss4 = ss + 4 * MT; const f32x4* fw = (const f32x4*)p.in[22]; f32x4* o4 = (f32x4*)p.out;
        for (int i = blockIdx.x * 512 + threadIdx.x; i < MT * (DM / 4); i += gridDim.x * 512) {
            const int row = i >> 8; const float rs = __builtin_amdgcn_rsqf(ss4[row] * (1.0f / 1024.0f) + 1e-6f);
            o4[i] = o4[i] * rs * fw[i & 255];
        }
    }
}

extern "C" void kernel_launch(void* const* d_in, const int* in_sizes, int n_in, void* d_out, int out_size, void* d_ws, size_t ws_size, hipStream_t stream) {
    static int grid_blocks = 0;
    if (!grid_blocks) {
        int dev = 0, cus = 0, per_cu = 0;
        hipGetDevice(&dev);
        hipDeviceGetAttribute(&cus, hipDeviceAttributeMultiprocessorCount, dev);
        if (hipFuncSetAttribute((const void*)fwd_megakernel, hipFuncAttributeMaxDynamicSharedMemorySize, LDS_BYTES) != hipSuccess) fprintf(stderr, "hipFuncSetAttribute failed\n");
        if (hipOccupancyMaxActiveBlocksPerMultiprocessor(&per_cu, (const void*)fwd_megakernel, 512, LDS_BYTES) != hipSuccess || per_cu < 1) { fprintf(stderr, "occupancy query: %d\n", per_cu); per_cu = 1; }
        (void)hipGetLastError();
        grid_blocks = cus * per_cu;
        if (ws_size < 268435456ull || n_in != 23) fprintf(stderr, "unexpected ws_size %zu / n_in %d\n", ws_size, n_in);
    }
    if (hipMemsetAsync((char*)d_ws + O_BAR, 0, 20480, stream) != hipSuccess) fprintf(stderr, "memset failed\n");
    Params p{};
    for (int i = 0; i < 23; ++i) p.in[i] = (const float*)d_in[i];
    p.out = (float*)d_out; p.ws = (unsigned char*)d_ws;
    void* args[] = {&p};
    hipError_t e = hipLaunchCooperativeKernel((const void*)fwd_megakernel, dim3(grid_blocks), dim3(512), args, LDS_BYTES, stream);
    if (e != hipSuccess) fprintf(stderr, "cooperative launch failed: %s (grid %d)\n", hipGetErrorString(e), grid_blocks);
}
#ifdef PHASE_TEST
__global__ void __launch_bounds__(512, 2) t_phase0(Params p) { extern __shared__ __attribute__((aligned(16))) unsigned char shm[]; phase0((LAS unsigned char*)shm, p); }
__global__ void __launch_bounds__(512, 2) t_attn_diff(Params p) { extern __shared__ __attribute__((aligned(16))) unsigned char shm[]; diff_tile((LAS unsigned char*)shm, (const bf16_t*)(p.ws + O_PROJ), (bf16_t*)(p.ws + O_MIXED), p.in[7], 0.3f, blockIdx.x & 1, blockIdx.y, blockIdx.z); }
__global__ void __launch_bounds__(512, 2) t_attn_sb(Params p) { extern __shared__ __attribute__((aligned(16))) unsigned char shm[]; sb_block((LAS unsigned char*)shm, (const bf16_t*)(p.ws + O_PROJ), (bf16_t*)(p.ws + O_MIXED), blockIdx.x & 1, blockIdx.y, blockIdx.z); }
__global__ void __launch_bounds__(512, 2) t_ssd_states(Params p) { extern __shared__ __attribute__((aligned(16))) unsigned char shm[]; ssd_states_phase((LAS unsigned char*)shm, p); }
__global__ void __launch_bounds__(512, 2) t_ssd_scan(Params p) { ssd_scan_phase(p, false); }
__global__ void __launch_bounds__(512, 2) t_ssd_out(Params p) { extern __shared__ __attribute__((aligned(16))) unsigned char shm[]; ssd_out_phase((LAS unsigned char*)shm, p, false); }
__global__ void __launch_bounds__(512, 2) t_gemm_ain(Params p) { extern __shared__ __attribute__((aligned(16))) unsigned char shm[]; EpiAttnIn E; E.O = (bf16_t*)(p.ws + O_PROJ); E.ss = (float*)(p.ws + O_SS); E.tab = (const f32x4*)(p.ws + O_ROPE); run_gemm((LAS unsigned char*)shm, (bf16_t*)(p.ws + O_HB), (const bf16_t*)(p.ws + W_AIN), AINW, DM, E); }
__global__ void __launch_bounds__(512, 2) t_gemm_res(Params p) { extern __shared__ __attribute__((aligned(16))) unsigned char shm[]; EpiRes<false, false> E; E.xres = nullptr; E.hb = (bf16_t*)(p.ws + O_HB); E.outf = nullptr; E.ssn = (float*)(p.ws + O_SS); run_gemm((LAS unsigned char*)shm, (bf16_t*)(p.ws + O_ACT), (const bf16_t*)(p.ws + W_DN0), DM, DFF, E); }
__global__ void __launch_bounds__(512, 2) t_gemm_gu(Params p) { extern __shared__ __attribute__((aligned(16))) unsigned char shm[]; EpiGU E; E.act = (bf16_t*)(p.ws + O_ACT); E.ss = (float*)(p.ws + O_SS); run_gemm((LAS unsigned char*)shm, (bf16_t*)(p.ws + O_HB), (const bf16_t*)(p.ws + W_GU0), 2 * DFF, DM, E); }
__global__ void __launch_bounds__(512, 2) t_gemm_ssdin(Params p) { extern __shared__ __attribute__((aligned(16))) unsigned char shm[]; EpiSsdIn E; E.z = (bf16_t*)p.out; E.xbc = (bf16_t*)(p.ws + O_XBC); E.dt = (float*)(p.ws + O_DT); E.ss = (float*)(p.ws + O_SS); run_gemm((LAS unsigned char*)shm, (bf16_t*)(p.ws + O_HB), (const bf16_t*)(p.ws + W_SIN), SINWP, DM, E); }
#endif
```

```cpp
#include <hip/hip_runtime.h>
#include <hip/hip_cooperative_groups.h>
#include <cstdio>
#include <cstdint>
namespace cg = cooperative_groups;
namespace pg8 {
#define PG8_LAS __attribute__((address_space(3)))
typedef unsigned short bf16_t;
typedef short bf16x8 __attribute__((ext_vector_type(8)));
typedef float f32x4 __attribute__((ext_vector_type(4)));
typedef unsigned u32x4 __attribute__((ext_vector_type(4)));
constexpr int BM = 256, BK = 64, HALF = 128, HTB = HALF * BK * 2  , STAGE_BYTES = 8 * HTB, NXCD = 8, WGM = 8;

__host__ __device__ __forceinline__ int lds_byte(int r, int c) { const int st = (r >> 4) * 2 + (c >> 5), rr = r & 15, cc = c & 31, ob = rr * 64 + cc * 2; return st * 1024 + (ob ^ (((ob >> 9) & 1) << 5)); }
__host__ __device__ __forceinline__ void stage_rc(int b, int& R, int& C) { const int st = b / 1024, sb = b % 1024, swz = sb ^ (((sb >> 9) & 1) << 5); R = (st >> 1) * 16 + swz / 64; C = (st & 1) * 32 + (swz % 64) / 2; }
__host__ __device__ __forceinline__ int perm32(int rho) { const int n = rho >> 4, i = rho & 15; return 8 * (i >> 2) + 4 * n + (i & 3); }

struct Unit { int pm, pn; };
struct Gemm { const bf16_t* A; const bf16_t* Bt; int M, N, K; };

struct StaticOrder {
    int nM, nN, nwg, G, c;
    __host__ __device__ void init(int M, int N, int G_, int c_) { nM = M / BM; nN = N / BM; nwg = nM * nN; G = G_; c = c_; }
    __host__ __device__ bool next(int i, Unit& u) const {
        const long L = (long)i * G + c; if (L >= nwg) return false;
        int wgid = (int)L; { const int q = nwg / NXCD, r = nwg % NXCD, xcd = wgid % NXCD, off = wgid / NXCD; wgid = (xcd < r ? xcd * (q + 1) : r * (q + 1) + (xcd - r) * q) + off; }
        const int nig = WGM * nN, gid = wgid / nig, fm = gid * WGM, gsz = (nM - fm) < WGM ? (nM - fm) : WGM;
        u.pm = fm + ((wgid % nig) % gsz); u.pn = (wgid % nig) / gsz; return true;
    }
    __device__ __forceinline__ void a_ready(const Unit&) const {}
    __device__ __forceinline__ void done(const Unit&) const {}
};

template <class Epi, class Sched, bool ALIGN_EPI = false, bool SP2 = false>
__device__ __forceinline__ void gemm_phase(PG8_LAS unsigned char* lds, const Gemm g, const Sched& S, const Epi& E) {
    int tid_ = threadIdx.x; asm volatile("" : "+v"(tid_)); const int tid = tid_, wid = __builtin_amdgcn_readfirstlane(tid >> 6), lane = tid & 63, wr = wid >> 2, wc = wid & 3, fr = lane & 15, fq = lane >> 4;
    const int K = g.K, nt = K / BK;
    unsigned voffA[2], voffB[2];
#pragma unroll
    for (int i = 0; i < 2; ++i) { int R, C; stage_rc(tid * 16 + i * 8192, R, C); const int Rb = Epi::PERM ? ((R & ~31) + perm32(R & 31)) : R;
        voffA[i] = (unsigned)(R * K + C) * 2u; voffB[i] = (unsigned)(Rb * K + C) * 2u; }
    const size_t kstep = (size_t)(BK * 2);
    const size_t hstep = (size_t)HALF * K * 2;
    const size_t tstep = 2 * hstep;
    const unsigned ldsw = (unsigned)wid * 1024u;
    const int aoff = lds_byte(wr * 64 + fr, fq * 8), boff = lds_byte(wc * 32 + fr, fq * 8);
#define PG8_SA(b, h) (((b) * 2 + (h)) * HTB)
#define PG8_SB(b, h) ((4 + (b) * 2 + (h)) * HTB)
#define PG8_STAGE(bufoff, gbase, voff) do { _Pragma("unroll") for (int _i = 0; _i < 2; ++_i) \
        __builtin_amdgcn_global_load_lds((const unsigned*)((const char*)(gbase) + (voff)[_i]), (PG8_LAS unsigned*)(lds + (bufoff) + ldsw + _i * 8192), 16, 0, 0); } while (0)
#define PG8_LDA(dst, b, h) do { _Pragma("unroll") for (int m = 0; m < 4; ++m) _Pragma("unroll") for (int k = 0; k < 2; ++k) dst[m][k] = *(const PG8_LAS bf16x8*)(lds + PG8_SA(b, h) + aoff + m * 2048 + k * 1024); } while (0)
#define PG8_LDB(dst, b, h) do { _Pragma("unroll") for (int n = 0; n < 2; ++n) _Pragma("unroll") for (int k = 0; k < 2; ++k) dst[n][k] = *(const PG8_LAS bf16x8*)(lds + PG8_SB(b, h) + boff + n * 2048 + k * 1024); } while (0)
#define PG8_MMA(ai, bj, At, Bt) do { __builtin_amdgcn_s_setprio(1); _Pragma("unroll") for (int m = 0; m < 4; ++m) _Pragma("unroll") for (int n = 0; n < 2; ++n) _Pragma("unroll") for (int k = 0; k < 2; ++k) \
        acc[ai][bj][m][n] = __builtin_amdgcn_mfma_f32_16x16x32_bf16(Bt[n][k], At[m][k], acc[ai][bj][m][n], 0, 0, 0); __builtin_amdgcn_s_setprio(0); } while (0)
#define PG8_WAIT_V(n) asm volatile("s_waitcnt vmcnt(" #n ")" ::: "memory")
#define PG8_WAIT_L(n) asm volatile("s_waitcnt lgkmcnt(" #n ")" ::: "memory")
#define PG8_BAR __builtin_amdgcn_s_barrier()
#define PG8_SCHED __builtin_amdgcn_sched_barrier(0)
    Unit cur, nxt; int ui = 0;
    if (!S.next(0, cur)) return;
    f32x4 acc[2][2][4][2];
#pragma unroll
    for (int a = 0; a < 2; ++a)
#pragma unroll
        for (int b = 0; b < 2; ++b)
#pragma unroll
            for (int m = 0; m < 4; ++m)
#pragma unroll
                for (int n = 0; n < 2; ++n) acc[a][b][m][n] = (f32x4){0.f, 0.f, 0.f, 0.f};
    bf16x8 At[4][2], B0[2][2], B1[2][2];
    float epre[8]; E.pre(cur, wr, fr, epre);
    const char* cA = (const char*)g.A + (size_t)cur.pm * tstep; const char* cB = (const char*)g.Bt + (size_t)cur.pn * tstep;
    S.a_ready(cur);
    if constexpr (SP2) {
        PG8_STAGE(PG8_SB(0, 0), cB, voffB); PG8_STAGE(PG8_SB(0, 1), cB + hstep, voffB); PG8_STAGE(PG8_SA(0, 0), cA, voffA); PG8_STAGE(PG8_SA(0, 1), cA + hstep, voffA);
        if (wr == 1) PG8_BAR;
        PG8_WAIT_V(2); PG8_BAR;
        PG8_STAGE(PG8_SB(1, 0), cB + kstep, voffB); PG8_STAGE(PG8_SA(1, 0), cA + kstep, voffA); PG8_STAGE(PG8_SB(1, 1), cB + hstep + kstep, voffB);
        PG8_WAIT_V(6); PG8_BAR;
    } else {
        PG8_STAGE(PG8_SB(0, 0), cB, voffB); PG8_STAGE(PG8_SA(0, 0), cA, voffA); PG8_STAGE(PG8_SB(0, 1), cB + hstep, voffB); PG8_STAGE(PG8_SA(0, 1), cA + hstep, voffA);
        if (wr == 1) PG8_BAR;
        PG8_WAIT_V(4); PG8_BAR;
        PG8_STAGE(PG8_SB(1, 0), cB + kstep, voffB); PG8_STAGE(PG8_SA(1, 0), cA + kstep, voffA); PG8_STAGE(PG8_SB(1, 1), cB + hstep + kstep, voffB);
        PG8_WAIT_V(6); PG8_BAR;
    }
    for (;;) {
        const bool has_next = S.next(ui + 1, nxt);
        const char* nA = has_next ? (const char*)g.A + (size_t)nxt.pm * tstep : cA; const char* nB = has_next ? (const char*)g.Bt + (size_t)nxt.pn * tstep : cB;
        for (int t = 0; t < nt; t += 2) {
            const bool last = (t == nt - 2);
            const char* a1 = cA + (size_t)(t + 1) * kstep;
            const char* a2 = last ? nA : cA + (size_t)(t + 2) * kstep; const char* b2 = last ? nB : cB + (size_t)(t + 2) * kstep;
            const char* a3 = a2 + kstep; const char* b3 = b2 + kstep;
            if (last && has_next) S.a_ready(nxt);
            if constexpr (SP2) {
            PG8_LDB(B0, 0, 0); PG8_LDB(B1, 0, 1); PG8_SCHED; PG8_LDA(At, 0, 0); PG8_STAGE(PG8_SA(1, 1), a1 + hstep, voffA);
            PG8_WAIT_V(8); PG8_WAIT_L(0); PG8_BAR; PG8_MMA(0, 0, At, B0); PG8_MMA(0, 1, At, B1); PG8_BAR; PG8_SCHED;
            PG8_LDA(At, 0, 1); PG8_STAGE(PG8_SB(0, 0), b2, voffB); PG8_STAGE(PG8_SB(0, 1), b2 + hstep, voffB); PG8_STAGE(PG8_SA(0, 0), a2, voffA);
            PG8_WAIT_V(8); PG8_WAIT_L(0); PG8_BAR; PG8_MMA(1, 0, At, B0); PG8_MMA(1, 1, At, B1); PG8_BAR; PG8_SCHED;
            PG8_LDB(B0, 1, 0); PG8_LDB(B1, 1, 1); PG8_SCHED; PG8_LDA(At, 1, 0); PG8_STAGE(PG8_SA(0, 1), a2 + hstep, voffA);
            PG8_WAIT_V(8); PG8_WAIT_L(0); PG8_BAR; PG8_MMA(0, 0, At, B0); PG8_MMA(0, 1, At, B1); PG8_BAR; PG8_SCHED;
            PG8_LDA(At, 1, 1); PG8_STAGE(PG8_SB(1, 0), b3, voffB); PG8_STAGE(PG8_SB(1, 1), b3 + hstep, voffB); PG8_STAGE(PG8_SA(1, 0), a3, voffA);
            PG8_WAIT_V(8); PG8_WAIT_L(0); PG8_BAR; PG8_MMA(1, 0, At, B0); PG8_MMA(1, 1, At, B1); PG8_BAR; PG8_SCHED;
            } else {
            PG8_LDB(B0, 0, 0); PG8_SCHED; PG8_LDA(At, 0, 0); PG8_STAGE(PG8_SA(1, 1), a1 + hstep, voffA);
            PG8_WAIT_L(8); PG8_BAR; PG8_WAIT_L(0); PG8_MMA(0, 0, At, B0); PG8_BAR; PG8_SCHED;
            PG8_LDB(B1, 0, 1); PG8_STAGE(PG8_SB(0, 0), b2, voffB);
            PG8_BAR; PG8_WAIT_L(0); PG8_MMA(0, 1, At, B1); PG8_BAR;
            PG8_LDA(At, 0, 1); PG8_STAGE(PG8_SA(0, 0), a2, voffA);
            PG8_BAR; PG8_WAIT_L(0); PG8_MMA(1, 0, At, B0); PG8_BAR; PG8_SCHED;
            PG8_STAGE(PG8_SB(0, 1), b2 + hstep, voffB);
            PG8_WAIT_V(6); PG8_BAR; PG8_MMA(1, 1, At, B1); PG8_BAR;
            PG8_LDB(B0, 1, 0); PG8_SCHED; PG8_LDA(At, 1, 0); PG8_STAGE(PG8_SA(0, 1), a2 + hstep, voffA);
            PG8_WAIT_L(8); PG8_BAR; PG8_WAIT_L(0); PG8_MMA(0, 0, At, B0); PG8_BAR; PG8_SCHED;
            PG8_LDB(B1, 1, 1); PG8_STAGE(PG8_SB(1, 0), b3, voffB);
            PG8_BAR; PG8_WAIT_L(0); PG8_MMA(0, 1, At, B1); PG8_BAR;
            PG8_LDA(At, 1, 1); PG8_STAGE(PG8_SA(1, 0), a3, voffA);
            PG8_BAR; PG8_WAIT_L(0); PG8_MMA(1, 0, At, B0); PG8_BAR; PG8_SCHED;
            PG8_STAGE(PG8_SB(1, 1), b3 + hstep, voffB);
            PG8_WAIT_V(6); PG8_BAR; PG8_MMA(1, 1, At, B1); PG8_BAR;
            }
        }
        if constexpr (ALIGN_EPI) { if (wr == 0) PG8_BAR; }
        if constexpr (!Epi::AFTER_DRAIN) { E(acc, cur, wr, wc, fr, fq, epre); S.done(cur); }
        if (!has_next) break;
        E.pre(nxt, wr, fr, epre);
#pragma unroll
        for (int a = 0; a < 2; ++a)
#pragma unroll
            for (int b = 0; b < 2; ++b)
#pragma unroll
                for (int m = 0; m < 4; ++m)
#pragma unroll
                    for (int n = 0; n < 2; ++n) acc[a][b][m][n] = (f32x4){0.f, 0.f, 0.f, 0.f};
        cur = nxt; cA = nA; cB = nB; ++ui;
        if constexpr (ALIGN_EPI) { if (wr == 1) PG8_BAR; }
    }
    PG8_WAIT_V(0);
    if constexpr (!ALIGN_EPI) { if (wr == 0) PG8_BAR; }
    PG8_BAR;
    if constexpr (Epi::AFTER_DRAIN) { E.fused(acc, cur, wr, wc, fr, fq, lds, wid, lane); S.done(cur); }
#undef PG8_SA
#undef PG8_SB
#undef PG8_STAGE
#undef PG8_LDA
#undef PG8_LDB
#undef PG8_MMA
#undef PG8_WAIT_V
#undef PG8_WAIT_L
#undef PG8_BAR
#undef PG8_SCHED
}
}
using pg8::bf16_t; using pg8::bf16x8; using pg8::f32x4;
typedef short s16x4 __attribute__((ext_vector_type(4)));
typedef float f32x16 __attribute__((ext_vector_type(16)));
typedef float f32x2 __attribute__((ext_vector_type(2)));
typedef __bf16 bf2_t __attribute__((ext_vector_type(2)));
typedef unsigned u32x2 __attribute__((ext_vector_type(2)));
typedef unsigned u32x4 __attribute__((ext_vector_type(4)));
#define LAS __attribute__((address_space(3)))
#define DI __device__ __forceinline__
#define MFMA32(a, b, c) __builtin_amdgcn_mfma_f32_32x32x16_bf16((a), (b), (c), 0, 0, 0)

DI int otid() { int t = threadIdx.x; asm volatile("" : "+v"(t)); return t; }
DI unsigned pk2(float a, float b) { f32x2 v = {a, b}; bf2_t r = __builtin_convertvector(v, bf2_t); return __builtin_bit_cast(unsigned, r); }
DI float bflo(unsigned u) { return __uint_as_float(u << 16); }
DI float bfhi(unsigned u) { return __uint_as_float(u & 0xffff0000u); }
DI float fexp2(float x) { return __builtin_amdgcn_exp2f(x); }
DI float frcp(float x) { return __builtin_amdgcn_rcpf(x); }
DI float fsilu(float x) { return x * frcp(1.0f + fexp2(-1.44269504089f * x)); }
DI int crow(int i, int h) { return (i & 3) + 8 * (i >> 2) + 4 * h; }
DI s16x4 trr(const LAS unsigned char* p) { return __builtin_amdgcn_ds_read_tr16_b64_v4i16((LAS s16x4*)p); }
DI bf16x8 tr2(const LAS unsigned char* p0, const LAS unsigned char* p1) { s16x4 a = trr(p0), b = trr(p1); return __builtin_shufflevector(a, b, 0, 1, 2, 3, 4, 5, 6, 7); }
DI bf16x8 pack8(const f32x16& x, int s) {
    u32x4 p; p[0] = pk2(x[8 * s], x[8 * s + 1]); p[1] = pk2(x[8 * s + 2], x[8 * s + 3]); p[2] = pk2(x[8 * s + 4], x[8 * s + 5]); p[3] = pk2(x[8 * s + 6], x[8 * s + 7]);
    return __builtin_bit_cast(bf16x8, p);
}
DI f32x16 zero16() { f32x16 z; for (int i = 0; i < 16; ++i) z[i] = 0.f; return z; }

constexpr int MT = 16384, SEQ = 8192, DM = 1024, DFF = 2816, AINW = 3072, SINW = 6176, SINWP = 6400, DIN = 2048, XBCW = 4096;
constexpr float LOG2E = 1.44269504089f;
constexpr int LDS_BYTES = 155648;
constexpr size_t W_AIN = 0, W_AOUT = W_AIN + (size_t)AINW * DM * 2, W_GU0 = W_AOUT + (size_t)DM * DM * 2, W_DN0 = W_GU0 + (size_t)2 * DFF * DM * 2,
                 W_SIN = W_DN0 + (size_t)DM * DFF * 2, W_SOUT = W_SIN + (size_t)SINWP * DM * 2, W_GU1 = W_SOUT + (size_t)DM * DIN * 2, W_DN1 = W_GU1 + (size_t)2 * DFF * DM * 2,
                 O_HB = W_DN1 + (size_t)DM * DFF * 2, O_SS = O_HB + (size_t)MT * DM * 2, O_ROPE = O_SS + (size_t)5 * MT * 4, O_DT = O_ROPE + (size_t)SEQ * 32 * 8,
                 O_CDEC = O_DT + (size_t)MT * 32 * 4, O_LAM = O_CDEC + 16384, O_BAR = O_LAM + 256, O_R = 98566144;
static_assert(O_BAR + 20480 <= O_R, "map");
constexpr size_t O_PROJ = O_R, O_MIXED = O_PROJ + (size_t)MT * AINW * 2, O_ACT = O_R, O_XBC = O_R, O_ST1 = O_XBC + (size_t)MT * XBCW * 2, O_ST0 = 0;
constexpr size_t ST_BATCH = (size_t)64 * 32 * 64 * 128;
static_assert(O_ST1 + ST_BATCH * 2 <= 268435456ull, "ws");
static_assert(ST_BATCH * 2 <= W_SOUT, "st0 overlay");
static_assert(O_MIXED + (size_t)MT * DM * 2 <= 268435456ull, "ws2");

struct Params { const float* in[23]; float* out; unsigned char* ws; };
#include <cstdlib>
#include <vector>

#define XB_TMO      128
#define XB_XCNT(j)  (256  + 64 * (j))
#define XB_XSUB(j)  (1280 + 64 * (j))
#define XB_XGEN(j)  (2304 + 64 * (j))
#define XB_TOP      3328
#define XB_TOPGEN   3392
#define XCD_BAR_WORDS 3456
#define XB_SPIN_CAP (1u << 18)

__device__ __forceinline__ unsigned xb_ld(unsigned* p)              { return __hip_atomic_load(p, __ATOMIC_RELAXED, __HIP_MEMORY_SCOPE_AGENT); }
__device__ __forceinline__ unsigned xb_add(unsigned* p, unsigned v) { return __hip_atomic_fetch_add(p, v, __ATOMIC_RELAXED, __HIP_MEMORY_SCOPE_AGENT); }
__device__ __forceinline__ unsigned xb_xcc_id() { return (unsigned)__builtin_amdgcn_s_getreg((3 << 11) | 20) & 0xFu; }
#define XB_SPIN(cond, bar) do { unsigned _sp = 0; while (cond) { __builtin_amdgcn_s_sleep(1); \
    if ((++_sp & 255u) == 0u) { if (xb_ld(&(bar)[XB_TMO])) break; if (_sp > XB_SPIN_CAP) { atomicAdd(&(bar)[XB_TMO], 1u); break; } } } } while (0)

struct XcdBarrier {
    unsigned* bar; unsigned x;
    volatile LAS unsigned* st;
};

__device__ __forceinline__ XcdBarrier xcd_barrier_post(unsigned* bar, volatile LAS unsigned* st) {
    XcdBarrier b; b.bar = bar; b.x = xb_xcc_id(); b.st = st;
    if (threadIdx.x == 0) (void)xb_add(&bar[XB_XCNT(b.x)], 1u);
    return b;
}
__device__ __forceinline__ void xcd_barrier_complete(unsigned* bar, unsigned x, unsigned& nloc, unsigned& nx) {
    const unsigned G = gridDim.x * gridDim.y * gridDim.z;
    unsigned sum, cnt, mine, sp = 0u;
    for (;;) {
        sum = 0u; cnt = 0u; mine = 0u;
#pragma unroll
        for (unsigned j = 0; j < 16; ++j) { const unsigned c = xb_ld(&bar[XB_XCNT(j)]); sum += c; cnt += (c > 0u) ? 1u : 0u; mine = (j == x) ? c : mine; }
        if (sum == G) break;
        __builtin_amdgcn_s_sleep(1);
        if ((++sp & 255u) == 0u) { if (xb_ld(&bar[XB_TMO])) break; if (sp > XB_SPIN_CAP) { atomicAdd(&bar[XB_TMO], 1u); break; } }
    }
    nloc = mine > 0u ? mine : 1u; nx = cnt > 0u ? cnt : 1u;
}

__device__ __forceinline__ void xcd_barrier(const XcdBarrier& b) {
    asm volatile("s_waitcnt vmcnt(0)" ::: "memory");
    __syncthreads();
    if (threadIdx.x == 0) {
        unsigned* bar = b.bar;
        __builtin_amdgcn_s_waitcnt(0);
        unsigned nloc = b.st[0], nx = b.st[1];
        if (nloc == 0u) { xcd_barrier_complete(bar, b.x, nloc, nx); b.st[0] = nloc; b.st[1] = nx; }
        const unsigned old = xb_add(&bar[XB_XSUB(b.x)], 1u);
        const unsigned gen = old / nloc;
        if (old + 1u == (gen + 1u) * nloc) {
            __builtin_amdgcn_fence(__ATOMIC_RELEASE, "agent");
            asm volatile("s_waitcnt vmcnt(0)" ::: "memory");
            const unsigned og = xb_add(&bar[XB_TOP], 1u);
            const unsigned tg = og / nx;
            if (og + 1u == (tg + 1u) * nx) xb_add(&bar[XB_TOPGEN], 1u);
            else XB_SPIN(xb_ld(&bar[XB_TOPGEN]) == tg, bar);
            __builtin_amdgcn_fence(__ATOMIC_ACQUIRE, "agent");
            xb_add(&bar[XB_XGEN(b.x)], 1u);
            asm volatile("s_waitcnt vmcnt(0)" ::: "memory");
        } else {
            XB_SPIN(xb_ld(&bar[XB_XGEN(b.x)]) == gen, bar);
            __builtin_amdgcn_fence(__ATOMIC_ACQUIRE, "agent");
            asm volatile("s_waitcnt vmcnt(0)" ::: "memory");
        }
    }
    __syncthreads();
}
DI void wmap(int mode, int c, int& src, float& scale, int& which) {
    src = c; scale = 1.f; which = 0;
    if (mode == 0) {
        if (c < 1024) { const int base = c & ~63, cc = c & 63, g = cc >> 3, e = cc & 7; src = base + (e < 4 ? 4 * g + e : 32 + 4 * g + (e - 4)); }
        if (c < 512) scale = 0.125f * LOG2E; else if (c >= 1536 && c < 2048) scale = 0.125f;
    } else if (mode == 2) { src = 128 * (c >> 8) + (c & 127); which = (c >> 7) & 1; }
    else if (mode == 3) { if (c >= SINW) src = -1; }
}
struct WJob { int mode, K, ldw, tix; const float* W0; const float* W1; const float* ks; bf16_t* dst; };
DI WJob wjob(const Params& p, int t) {
    unsigned char* ws = p.ws;
    const int cnt[8] = {48 * 4, 16 * 4, 88 * 4, 16 * 11, 100 * 4, 16 * 8, 88 * 4, 16 * 11};
    int j = 0, tt = t;
#pragma unroll
    for (int q = 0; q < 7; ++q) if (j == q && tt >= cnt[q]) { tt -= cnt[q]; j = q + 1; }
    WJob J; J.tix = tt; J.W1 = nullptr; J.ks = nullptr;
    switch (j) {
    case 0: J.mode = 0; J.W0 = p.in[2]; J.ks = p.in[1]; J.dst = (bf16_t*)(ws + W_AIN); J.K = DM; J.ldw = AINW; break;
    case 1: J.mode = 1; J.W0 = p.in[8]; J.dst = (bf16_t*)(ws + W_AOUT); J.K = DM; J.ldw = DM; break;
    case 2: J.mode = 2; J.W0 = p.in[19]; J.W1 = p.in[20]; J.ks = p.in[18]; J.dst = (bf16_t*)(ws + W_GU0); J.K = DM; J.ldw = DFF; break;
    case 3: J.mode = 1; J.W0 = p.in[21]; J.dst = (bf16_t*)(ws + W_DN0); J.K = DFF; J.ldw = DM; break;
    case 4: J.mode = 3; J.W0 = p.in[10]; J.ks = p.in[9]; J.dst = (bf16_t*)(ws + W_SIN); J.K = DM; J.ldw = SINW; break;
    case 5: J.mode = 1; J.W0 = p.in[17]; J.dst = (bf16_t*)(ws + W_SOUT); J.K = DIN; J.ldw = DM; break;
    case 6: J.mode = 2; J.W0 = p.in[19] + (size_t)DM * DFF; J.W1 = p.in[20] + (size_t)DM * DFF; J.ks = p.in[18] + DM; J.dst = (bf16_t*)(ws + W_GU1); J.K = DM; J.ldw = DFF; break;
    default: J.mode = 1; J.W0 = p.in[21] + (size_t)DFF * DM; J.dst = (bf16_t*)(ws + W_DN1); J.K = DFF; J.ldw = DM; break;
    }
    return J;
}
DI void wtile_load(const WJob& J, int tid, float (&v)[32], float& sc, int& srcok) {
    const int nk = J.K >> 8, c0 = (J.tix / nk) * 64, k0 = (J.tix % nk) * 256, cc = tid & 63; int src, which; wmap(J.mode, c0 + cc, src, sc, which);
    const float* W = (which ? J.W1 : J.W0) + (src >= 0 ? src : 0); srcok = (src >= 0);
#pragma unroll
    for (int i = 0; i < 32; ++i) { const int kk = (tid >> 6) + 8 * i; v[i] = W[(size_t)(k0 + kk) * J.ldw]; }
}
DI void wtile_store(LAS float* tile, const WJob& J, int tid, const float (&v)[32], float sc, int srcok) {
    const int nk = J.K >> 8, c0 = (J.tix / nk) * 64, k0 = (J.tix % nk) * 256, cc = tid & 63;
#pragma unroll
    for (int i = 0; i < 32; ++i) { const int kk = (tid >> 6) + 8 * i; float x = srcok ? v[i] * sc : 0.f; if (J.ks) x *= J.ks[k0 + kk]; tile[kk * 65 + cc] = x; }
    __syncthreads();
#pragma unroll
    for (int i = 0; i < 16; ++i) {
        const int idx = tid + 512 * i, c2 = idx >> 7, k2 = (idx & 127) * 2;
        *(unsigned*)(J.dst + (size_t)(c0 + c2) * J.K + k0 + k2) = pk2(tile[k2 * 65 + c2], tile[(k2 + 1) * 65 + c2]);
    }
    __syncthreads();
}
DI void wconv_jobs(LAS unsigned char* lds, const Params& p, int wi, int nb) {
    const int tid = otid(); const int total = 48 * 4 + 16 * 4 + 2 * (88 * 4 + 16 * 11) + 100 * 4 + 16 * 8;
    if (wi >= total) return;
    WJob J = wjob(p, wi); float v[32]; float sc; int ok;
    wtile_load(J, tid, v, sc, ok);
    for (int t = wi; t < total; t += nb) {
        const bool more = (t + nb < total);
        WJob Jn = J; float vn[32]; float scn = 0.f; int okn = 0;
        if (more) { Jn = wjob(p, t + nb); wtile_load(Jn, tid, vn, scn, okn); }
        wtile_store((LAS float*)lds, J, tid, v, sc, ok);
        if (more) { J = Jn; sc = scn; ok = okn;
#pragma unroll
            for (int i = 0; i < 32; ++i) v[i] = vn[i]; }
    }
}
DI void phase0(LAS unsigned char* lds, const Params& p) {
    const int tid = otid(), G = gridDim.x, bx = blockIdx.x;
    unsigned char* ws = p.ws;
    wconv_jobs(lds, p, bx, G);
    {
        const int wave = tid >> 6, lane = tid & 63; bf16_t* hb = (bf16_t*)(ws + O_HB); float* ss = (float*)(ws + O_SS);
        for (int row0 = (bx * 8 + wave) * 2; row0 < MT; row0 += G * 16) {
            f32x4 v[2][4];
#pragma unroll
            for (int q = 0; q < 2; ++q)
#pragma unroll
                for (int i = 0; i < 4; ++i) v[q][i] = *(const f32x4*)(p.in[0] + (size_t)(row0 + q) * DM + lane * 4 + 256 * i);
#pragma unroll
            for (int q = 0; q < 2; ++q) {
                float sq = 0.f;
#pragma unroll
                for (int i = 0; i < 4; ++i) { const f32x4 x = v[q][i]; sq += x[0] * x[0] + x[1] * x[1] + x[2] * x[2] + x[3] * x[3];
                    u32x2 o; o[0] = pk2(x[0], x[1]); o[1] = pk2(x[2], x[3]); *(u32x2*)(hb + (size_t)(row0 + q) * DM + lane * 4 + 256 * i) = o; }
#pragma unroll
                for (int o = 32; o >= 1; o >>= 1) sq += __shfl_xor(sq, o);
                if (lane == 0) ss[row0 + q] = sq;
            }
        }
        for (int i = bx * 512 + tid; i < 4 * MT; i += G * 512) ss[MT + i] = 0.f;
        f32x2* tab = (f32x2*)(ws + O_ROPE);
        for (int i = bx * 512 + tid; i < SEQ * 32; i += G * 512) {
            const int pos = i >> 5, f = i & 31; const float inv = fexp2(-(float)f * 0.41524101186092f); const float ang = (float)pos * inv;
            double t = (double)ang * 0.15915494309189535; t -= floor(t); const float tf = (float)t;
            f32x2 cs; cs[0] = __builtin_amdgcn_cosf(tf); cs[1] = __builtin_amdgcn_sinf(tf); tab[i] = cs;
        }
        if (bx == 0 && tid == 0) { float s1 = 0.f, s2 = 0.f; for (int i = 0; i < 64; ++i) { s1 += p.in[3][i] * p.in[4][i]; s2 += p.in[5][i] * p.in[6][i]; }
            *(float*)(ws + O_LAM) = fexp2(s1 * LOG2E) - fexp2(s2 * LOG2E) + 0.2f; }
    }
}

struct EpiAttnIn {
    static constexpr bool PERM = true, AFTER_DRAIN = false;
    bf16_t* O; const float* ss; const f32x4* tab;
    DI void pre(const pg8::Unit& u, int wr, int fr, float (&e)[8]) const {
#pragma unroll
        for (int ai = 0; ai < 2; ++ai)
#pragma unroll
            for (int m = 0; m < 4; ++m) e[ai * 4 + m] = ss[u.pm * 256 + wr * 64 + fr + ai * 128 + m * 16];
    }
    DI void operator()(const f32x4 (&acc)[2][2][4][2], const pg8::Unit& u, int wr, int wc, int fr, int fq, const float (&epre)[8]) const {
        const int row0 = u.pm * 256 + wr * 64 + fr, colt = u.pn * 256, col0 = colt + wc * 32 + 8 * fq;
        const int fb = 4 * (4 * (wc & 1) + fq);
#pragma unroll
        for (int ai = 0; ai < 2; ++ai)
#pragma unroll
            for (int m = 0; m < 4; ++m) {
                const int row = row0 + ai * 128 + m * 16; const float rs = __builtin_amdgcn_rsqf(epre[ai * 4 + m] * (1.0f / 1024.0f) + 1e-6f);
                f32x4 c01 = {1.f, 0.f, 1.f, 0.f}, c23 = {1.f, 0.f, 1.f, 0.f};
                if (colt < 1024) { const int pos = row & (SEQ - 1); c01 = tab[(pos * 32 + fb) >> 1]; c23 = tab[((pos * 32 + fb) >> 1) + 1]; }
#pragma unroll
                for (int bj = 0; bj < 2; ++bj) {
                    f32x4 v0 = acc[ai][bj][m][0] * rs, v1 = acc[ai][bj][m][1] * rs;
                    if (colt < 1024) {
                        const float cs[4] = {c01[0], c01[2], c23[0], c23[2]}, sn[4] = {c01[1], c01[3], c23[1], c23[3]};
#pragma unroll
                        for (int j = 0; j < 4; ++j) { const float t1 = v0[j], t2 = v1[j]; v0[j] = t1 * cs[j] - t2 * sn[j]; v1[j] = t2 * cs[j] + t1 * sn[j]; }
                    }
                    u32x4 o; o[0] = pk2(v0[0], v0[1]); o[1] = pk2(v0[2], v0[3]); o[2] = pk2(v1[0], v1[1]); o[3] = pk2(v1[2], v1[3]);
                    *(u32x4*)(O + (size_t)row * AINW + col0 + bj * 128) = o;
                }
            }
    }
};
template <bool RES_F32, bool OUT_F32> struct EpiRes {
    static constexpr bool PERM = false, AFTER_DRAIN = false;
    const float* xres; bf16_t* hb; float* outf; float* ssn;
    DI void pre(const pg8::Unit&, int, int, float (&)[8]) const {}
    DI void operator()(const f32x4 (&acc)[2][2][4][2], const pg8::Unit& u, int wr, int wc, int fr, int fq, const float (&epre)[8]) const {
        const int row0 = u.pm * 256 + wr * 64 + fr, col0 = u.pn * 256 + wc * 32 + 4 * fq;
#pragma unroll
        for (int ai = 0; ai < 2; ++ai)
#pragma unroll
            for (int m = 0; m < 4; ++m) {
                const int row = row0 + ai * 128 + m * 16; float sq = 0.f;
#pragma unroll
                for (int bj = 0; bj < 2; ++bj)
#pragma unroll
                    for (int n = 0; n < 2; ++n) {
                        const size_t off = (size_t)row * DM + col0 + bj * 128 + n * 16; f32x4 r;
                        if (RES_F32) r = *(const f32x4*)(xres + off);
                        else { const u32x2 t = *(const u32x2*)(hb + off); r[0] = bflo(t[0]); r[1] = bfhi(t[0]); r[2] = bflo(t[1]); r[3] = bfhi(t[1]); }
                        const f32x4 v = r + acc[ai][bj][m][n];
                        sq += v[0] * v[0] + v[1] * v[1] + v[2] * v[2] + v[3] * v[3];
                        if (OUT_F32) *(f32x4*)(outf + off) = v;
                        else { u32x2 o; o[0] = pk2(v[0], v[1]); o[1] = pk2(v[2], v[3]); *(u32x2*)(hb + off) = o; }
                    }
                sq += __shfl_xor(sq, 16); sq += __shfl_xor(sq, 32);
                if (fq == 0) atomicAdd(ssn + row, sq);
            }
    }
};
struct EpiGU {
    static constexpr bool PERM = true, AFTER_DRAIN = false;
    bf16_t* act; const float* ss;
    DI void pre(const pg8::Unit& u, int wr, int fr, float (&e)[8]) const {
#pragma unroll
        for (int ai = 0; ai < 2; ++ai)
#pragma unroll
            for (int m = 0; m < 4; ++m) e[ai * 4 + m] = ss[u.pm * 256 + wr * 64 + fr + ai * 128 + m * 16];
    }
    DI void operator()(const f32x4 (&acc)[2][2][4][2], const pg8::Unit& u, int wr, int wc, int fr, int fq, const float (&epre)[8]) const {
        const int row0 = u.pm * 256 + wr * 64 + fr;
#pragma unroll
        for (int ai = 0; ai < 2; ++ai)
#pragma unroll
            for (int m = 0; m < 4; ++m) {
                const int row = row0 + ai * 128 + m * 16; const float rs = __builtin_amdgcn_rsqf(epre[ai * 4 + m] * (1.0f / 1024.0f) + 1e-6f);
                u32x4 o;
#pragma unroll
                for (int n = 0; n < 2; ++n) {
                    const f32x4 g = acc[ai][0][m][n] * rs, up = acc[ai][1][m][n] * rs; float a[4];
#pragma unroll
                    for (int j = 0; j < 4; ++j) a[j] = fsilu(g[j]) * up[j];
                    o[2 * n] = pk2(a[0], a[1]); o[2 * n + 1] = pk2(a[2], a[3]);
                }
                *(u32x4*)(act + (size_t)row * DFF + u.pn * 128 + wc * 32 + 8 * fq) = o;
            }
    }
};
struct EpiSsdIn {
    static constexpr bool PERM = true, AFTER_DRAIN = false;
    bf16_t* z; bf16_t* xbc; float* dt; const float* ss;
    DI void pre(const pg8::Unit& u, int wr, int fr, float (&e)[8]) const {
#pragma unroll
        for (int ai = 0; ai < 2; ++ai)
#pragma unroll
            for (int m = 0; m < 4; ++m) e[ai * 4 + m] = ss[u.pm * 256 + wr * 64 + fr + ai * 128 + m * 16];
    }
    DI void operator()(const f32x4 (&acc)[2][2][4][2], const pg8::Unit& u, int wr, int wc, int fr, int fq, const float (&epre)[8]) const {
        const int row0 = u.pm * 256 + wr * 64 + fr, col0 = u.pn * 256 + wc * 32 + 8 * fq;
#pragma unroll
        for (int ai = 0; ai < 2; ++ai)
#pragma unroll
            for (int m = 0; m < 4; ++m) {
                const int row = row0 + ai * 128 + m * 16; const float rs = __builtin_amdgcn_rsqf(epre[ai * 4 + m] * (1.0f / 1024.0f) + 1e-6f);
#pragma unroll
                for (int bj = 0; bj < 2; ++bj) {
                    const int c = col0 + bj * 128; const f32x4 v0 = acc[ai][bj][m][0] * rs, v1 = acc[ai][bj][m][1] * rs;
                    if (c < 6144) { u32x4 o; o[0] = pk2(v0[0], v0[1]); o[1] = pk2(v0[2], v0[3]); o[2] = pk2(v1[0], v1[1]); o[3] = pk2(v1[2], v1[3]);
                        if (c < DIN) *(u32x4*)(z + (size_t)row * DIN + c) = o; else *(u32x4*)(xbc + (size_t)row * XBCW + (c - DIN)) = o; }
                }
            }
    }
};

struct EpiFinal {
    static constexpr bool PERM = false, AFTER_DRAIN = true;
    const bf16_t* hb; float* outf; float* ssn; unsigned* cnt; const float* fw;
    DI void operator()(const f32x4 (&)[2][2][4][2], const pg8::Unit&, int, int, int, int, const float (&)[8]) const {}
    DI void pre(const pg8::Unit&, int, int, float (&)[8]) const {}
    DI void fused(f32x4 (&acc)[2][2][4][2], const pg8::Unit& u, int wr, int wc, int fr, int fq, PG8_LAS unsigned char*, int, int) const {
        const int row0 = u.pm * 256 + wr * 64 + fr, col0 = u.pn * 256 + wc * 32 + 4 * fq;
#pragma unroll
        for (int ai = 0; ai < 2; ++ai)
#pragma unroll
            for (int m = 0; m < 4; ++m) {
                const int row = row0 + ai * 128 + m * 16; float sq = 0.f;
#pragma unroll
                for (int bj = 0; bj < 2; ++bj)
#pragma unroll
                    for (int n = 0; n < 2; ++n) {
                        const size_t off = (size_t)row * DM + col0 + bj * 128 + n * 16;
                        const u32x2 t = *(const u32x2*)(hb + off); f32x4 r; r[0] = bflo(t[0]); r[1] = bfhi(t[0]); r[2] = bflo(t[1]); r[3] = bfhi(t[1]);
                        const f32x4 v = r + acc[ai][bj][m][n]; acc[ai][bj][m][n] = v;
                        sq += v[0] * v[0] + v[1] * v[1] + v[2] * v[2] + v[3] * v[3];
                    }
                sq += __shfl_xor(sq, 16); sq += __shfl_xor(sq, 32);
                if (fq == 0) atomicAdd(ssn + row, sq);
            }
        asm volatile("s_waitcnt vmcnt(0)" ::: "memory");
        __syncthreads();
        unsigned* c = cnt + 16 * u.pm;
        if (threadIdx.x == 0) {
            __builtin_amdgcn_fence(__ATOMIC_RELEASE, "agent"); asm volatile("s_waitcnt vmcnt(0)" ::: "memory");
            __hip_atomic_fetch_add(c, 1u, __ATOMIC_RELAXED, __HIP_MEMORY_SCOPE_AGENT);
            unsigned spins = 0;
            while (__hip_atomic_load(c, __ATOMIC_RELAXED, __HIP_MEMORY_SCOPE_AGENT) < 4u && ++spins < (1u << 22)) __builtin_amdgcn_s_sleep(2);
            __builtin_amdgcn_fence(__ATOMIC_ACQUIRE, "agent"); asm volatile("s_waitcnt vmcnt(0)" ::: "memory");
        }
        __syncthreads();
#pragma unroll
        for (int ai = 0; ai < 2; ++ai)
#pragma unroll
            for (int m = 0; m < 4; ++m) {
                const int row = row0 + ai * 128 + m * 16;
                const float rs = __builtin_amdgcn_rsqf(__hip_atomic_load(ssn + row, __ATOMIC_RELAXED, __HIP_MEMORY_SCOPE_AGENT) * (1.0f / 1024.0f) + 1e-6f);
#pragma unroll
                for (int bj = 0; bj < 2; ++bj)
#pragma unroll
                    for (int n = 0; n < 2; ++n) {
                        const int col = col0 + bj * 128 + n * 16; const f32x4 w = *(const f32x4*)(fw + col);
                        *(f32x4*)(outf + (size_t)row * DM + col) = acc[ai][bj][m][n] * rs * w;
                    }
            }
    }
};
constexpr int KST = 144, VST = 320, VST64 = 192;
constexpr int AT_K1 = 0, AT_K2 = 64 * KST, AT_V = 2 * 64 * KST, AT_STAGE = AT_V + 64 * VST;

DI void diff_tile(LAS unsigned char* lds, const bf16_t* proj, bf16_t* mixed, const float* subln, float lam, int b, int hd, int qt) {
    const int tid = otid(), w = __builtin_amdgcn_readfirstlane(tid >> 6), lane = tid & 63, qg = w & 3, mp = w >> 2, r = lane & 31, h = lane >> 5;
    const int q0 = qt * 128; const size_t rowb = (size_t)b * SEQ;
    bf16x8 qf[4];
    { const bf16_t* qp = proj + (rowb + q0 + 32 * qg + r) * AINW + hd * 128 + mp * 64 + 8 * h;
#pragma unroll
      for (int s = 0; s < 4; ++s) qf[s] = *(const bf16x8*)(qp + 16 * s); }
    f32x16 O[4];
#pragma unroll
    for (int i = 0; i < 4; ++i) O[i] = zero16();
    float mrun = 0.f, lrun = 0.f;
    const int nsteps = 2 * (qt + 1);
    const bf16_t* src[4]; int dst[4];
#pragma unroll
    for (int i = 0; i < 2; ++i) { const int cid = tid + 512 * i, row = cid >> 4, c16 = cid & 15;
        src[i] = proj + (rowb + row) * AINW + 512 + hd * 128 + c16 * 8; dst[i] = (c16 < 8 ? AT_K1 : AT_K2) + row * KST + (c16 & 7) * 16;
        src[2 + i] = proj + (rowb + row) * AINW + 1024 + hd * 128 + c16 * 8; dst[2 + i] = AT_V + row * VST + c16 * 16; }
    u32x4 pf[4];
#pragma unroll
    for (int i = 0; i < 4; ++i) pf[i] = *(const u32x4*)(src[i]);
#pragma unroll
    for (int i = 0; i < 4; ++i) *(LAS u32x4*)(lds + dst[i]) = pf[i];
    __syncthreads();
    const int i16 = lane & 15, tq = i16 >> 2, tp = i16 & 3, g16 = (lane >> 4) & 1;
    const int troff = (4 * h + tq) * VST + (16 * g16 + 4 * tp) * 2;
    for (int j = 0; j < nsteps; ++j) {
        const bool more = (j + 1 < nsteps);
        if (more) {
#pragma unroll
            for (int i = 0; i < 4; ++i) pf[i] = *(const u32x4*)(src[i] + (size_t)(j + 1) * 64 * AINW);
        }
        const LAS unsigned char* base = lds + (j & 1) * AT_STAGE;
        const LAS unsigned char* Kb = base + (mp ? AT_K2 : AT_K1);
        const LAS unsigned char* Vb = base + AT_V;
        f32x16 S[2];
        const float negm = -mrun;
#pragma unroll
        for (int kt = 0; kt < 2; ++kt) {
#pragma unroll
            for (int i = 0; i < 16; ++i) S[kt][i] = negm;
#pragma unroll
            for (int s = 0; s < 4; ++s) { const bf16x8 kf = *(const LAS bf16x8*)(Kb + (32 * kt + r) * KST + (16 * s + 8 * h) * 2); S[kt] = MFMA32(kf, qf[s], S[kt]); } }
        const int qidx = q0 + 32 * qg + r, kbase = 64 * j;
        if (kbase + 63 > q0 + 32 * qg) {
#pragma unroll
            for (int kt = 0; kt < 2; ++kt)
#pragma unroll
                for (int i = 0; i < 16; ++i) if (kbase + 32 * kt + crow(i, h) > qidx) S[kt][i] = -1e30f;
        }
        float mx = S[0][0];
#pragma unroll
        for (int kt = 0; kt < 2; ++kt)
#pragma unroll
            for (int i = 0; i < 16; ++i) mx = fmaxf(mx, S[kt][i]);
        mx = fmaxf(mx, __shfl_xor(mx, 32));
        if (j == 0 || __builtin_amdgcn_ballot_w64(mx > 8.0f) != 0ull) {
            const float d = (j == 0) ? mx : fmaxf(mx, 0.f);
            mrun += d;
            if (j != 0) { const float alpha = fexp2(-d); lrun *= alpha;
#pragma unroll
                for (int vt = 0; vt < 4; ++vt) O[vt] = O[vt] * alpha; }
#pragma unroll
            for (int kt = 0; kt < 2; ++kt)
#pragma unroll
                for (int i = 0; i < 16; ++i) S[kt][i] -= d;
        }
        float ls = 0.f;
#pragma unroll
        for (int kt = 0; kt < 2; ++kt)
#pragma unroll
            for (int i = 0; i < 16; ++i) { const float pv = fexp2(S[kt][i]); S[kt][i] = pv; ls += pv; }
        lrun += ls;
#pragma unroll
        for (int kt = 0; kt < 2; ++kt)
#pragma unroll
            for (int s2 = 0; s2 < 2; ++s2) {
                const bf16x8 pfr = pack8(S[kt], s2);
                const LAS unsigned char* vrow = Vb + (32 * kt + 16 * s2) * VST + troff;
#pragma unroll
                for (int vt = 0; vt < 4; ++vt) { const bf16x8 vf = tr2(vrow + vt * 64, vrow + 8 * VST + vt * 64); O[vt] = MFMA32(vf, pfr, O[vt]); }
            }
        if (more) {
            LAS unsigned char* nb = lds + ((j + 1) & 1) * AT_STAGE;
#pragma unroll
            for (int i = 0; i < 4; ++i) *(LAS u32x4*)(nb + dst[i]) = pf[i];
        }
        __syncthreads();
    }
    lrun += __shfl_xor(lrun, 32);
    const float inv = frcp(lrun);
    LAS float* ex = (LAS float*)lds;
    if (mp == 1) {
        const float sc = inv * lam;
#pragma unroll
        for (int vt = 0; vt < 4; ++vt)
#pragma unroll
            for (int i = 0; i < 16; ++i) ex[(qg * 128 + 32 * vt + crow(i, h)) * 32 + r] = O[vt][i] * sc;
    }
    __syncthreads();
    if (mp == 0) {
        float sq = 0.f;
#pragma unroll
        for (int vt = 0; vt < 4; ++vt)
#pragma unroll
            for (int i = 0; i < 16; ++i) { const float o = O[vt][i] * inv - ex[(qg * 128 + 32 * vt + crow(i, h)) * 32 + r]; O[vt][i] = o; sq += o * o; }
        sq += __shfl_xor(sq, 32);
        const float rn = __builtin_amdgcn_rsqf(sq * (1.0f / 128.0f) + 1e-5f) * 0.8f;
        bf16_t* op = mixed + (rowb + q0 + 32 * qg + r) * DM + hd * 128;
#pragma unroll
        for (int vt = 0; vt < 4; ++vt)
#pragma unroll
            for (int gq = 0; gq < 4; ++gq) { const int v0 = 32 * vt + 8 * gq + 4 * h; const f32x4 wv = *(const f32x4*)(subln + v0);
                u32x2 o; o[0] = pk2(O[vt][4 * gq] * rn * wv[0], O[vt][4 * gq + 1] * rn * wv[1]); o[1] = pk2(O[vt][4 * gq + 2] * rn * wv[2], O[vt][4 * gq + 3] * rn * wv[3]);
                *(u32x2*)(op + v0) = o; }
    }
    __syncthreads();
}

constexpr int SB_K = 0, SB_V = 64 * KST, SB_STAGE = 64 * KST + 64 * VST64;
DI void sb_block(LAS unsigned char* lds, const bf16_t* proj, bf16_t* mixed, int b, int hs, int qb) {
    const int tid = otid(), w = __builtin_amdgcn_readfirstlane(tid >> 6), lane = tid & 63, r = lane & 31, h = lane >> 5;
    const int q0 = qb * 256; const size_t rowb = (size_t)b * SEQ;
    const int qidx = q0 + 32 * w + r;
    bf16x8 qf[4];
    { const bf16_t* qp = proj + (rowb + qidx) * AINW + 1536 + hs * 64 + 8 * h;
#pragma unroll
      for (int s = 0; s < 4; ++s) qf[s] = *(const bf16x8*)(qp + 16 * s); }
    f32x16 O[2]; O[0] = zero16(); O[1] = zero16();
    float carry = 1.0f;
    const int jmax = 4 * qb + 3;
    const int srow = tid >> 3, sc8 = tid & 7;
    const bf16_t* srcK = proj + (rowb + srow) * AINW + 2048 + hs * 64 + sc8 * 8;
    const bf16_t* srcV = proj + (rowb + srow) * AINW + 2560 + hs * 64 + sc8 * 8;
    const int dstK = SB_K + srow * KST + sc8 * 16, dstV = SB_V + srow * VST64 + sc8 * 16;
    u32x4 pk_ = *(const u32x4*)(srcK + (size_t)jmax * 64 * AINW), pv_ = *(const u32x4*)(srcV + (size_t)jmax * 64 * AINW);
    *(LAS u32x4*)(lds + dstK) = pk_; *(LAS u32x4*)(lds + dstV) = pv_;
    __syncthreads();
    const int i16 = lane & 15, tq = i16 >> 2, tp = i16 & 3, g16 = (lane >> 4) & 1;
    const int troff = (4 * h + tq) * VST64 + (16 * g16 + 4 * tp) * 2;
    int it = 0;
    for (int j = jmax; j >= 0; --j, ++it) {
        const bool more = (j > 0);
        if (more) { pk_ = *(const u32x4*)(srcK + (size_t)(j - 1) * 64 * AINW); pv_ = *(const u32x4*)(srcV + (size_t)(j - 1) * 64 * AINW); }
        const LAS unsigned char* base = lds + (it & 1) * SB_STAGE;
        const int kbase = 64 * j;
        if (kbase < q0 + 32 * w + 32) {
#pragma unroll
            for (int kt = 1; kt >= 0; --kt) {
                f32x16 S = zero16();
#pragma unroll
                for (int s = 0; s < 4; ++s) { const bf16x8 kf = *(const LAS bf16x8*)(base + SB_K + (32 * kt + r) * KST + (16 * s + 8 * h) * 2); S = MFMA32(kf, qf[s], S); }
                float T[4], sfx[16];
#pragma unroll
                for (int gq = 0; gq < 4; ++gq) {
                    float run = 1.0f;
#pragma unroll
                    for (int jj = 3; jj >= 0; --jj) {
                        const int i = 4 * gq + jj; const bool valid = (kbase + 32 * kt + crow(i, h)) < qidx;
                        const float zz = fmaxf(S[i], -60.0f); const float e = fexp2(-LOG2E * zz); const float sg = frcp(1.0f + e);
                        const float keep = valid ? e * sg : 1.0f;
                        S[i] = valid ? sg : 0.0f; sfx[i] = run; run *= keep;
                    }
                    T[gq] = run;
                }
                float To[4];
#pragma unroll
                for (int gq = 0; gq < 4; ++gq) To[gq] = __shfl_xor(T[gq], 32);
                float E[4]; float acc_hi = 1.0f;
#pragma unroll
                for (int gq = 3; gq >= 0; --gq) {
                    const float above_same = acc_hi;
                    E[gq] = (h == 0) ? above_same * To[gq] : above_same;
                    acc_hi = acc_hi * T[gq] * To[gq];
                }
#pragma unroll
                for (int i = 0; i < 16; ++i) S[i] = S[i] * carry * E[i >> 2] * sfx[i];
                carry *= acc_hi;
#pragma unroll
                for (int s2 = 0; s2 < 2; ++s2) {
                    const bf16x8 pfr = pack8(S, s2);
                    const LAS unsigned char* vrow = base + SB_V + (32 * kt + 16 * s2) * VST64 + troff;
#pragma unroll
                    for (int vt = 0; vt < 2; ++vt) { const bf16x8 vf = tr2(vrow + vt * 64, vrow + 8 * VST64 + vt * 64); O[vt] = MFMA32(vf, pfr, O[vt]); }
                }
            }
        }
        if (more) { LAS unsigned char* nb = lds + ((it + 1) & 1) * SB_STAGE; *(LAS u32x4*)(nb + dstK) = pk_; *(LAS u32x4*)(nb + dstV) = pv_; }
        const int done = (kbase < q0 + 32 * w + 32) && (carry < 1e-12f);
        const bool wdone = (__builtin_amdgcn_ballot_w64(done != 0) == ~0ull);
        LAS int* flg = (LAS int*)(lds + 2 * SB_STAGE) + (it & 1) * 8;
        if (lane == 0) flg[w] = wdone ? 1 : 0;
        __syncthreads();
        int all = 1;
#pragma unroll
        for (int ww = 0; ww < 8; ++ww) all &= flg[ww];
        if (all) break;
    }
    bf16_t* op = mixed + (rowb + qidx) * DM + 512 + hs * 64;
#pragma unroll
    for (int vt = 0; vt < 2; ++vt)
#pragma unroll
        for (int gq = 0; gq < 4; ++gq) { const int v0 = 32 * vt + 8 * gq + 4 * h;
            u32x2 o; o[0] = pk2(O[vt][4 * gq], O[vt][4 * gq + 1]); o[1] = pk2(O[vt][4 * gq + 2], O[vt][4 * gq + 3]); *(u32x2*)(op + v0) = o; }
    __syncthreads();
}
DI void attn_phase(LAS unsigned char* lds, const Params& p) {
    const bf16_t* proj = (const bf16_t*)(p.ws + O_PROJ); bf16_t* mixed = (bf16_t*)(p.ws + O_MIXED);
    const float lam = *(const float*)(p.ws + O_LAM);
    for (int it0 = blockIdx.x; it0 < 256; it0 += gridDim.x) {
        const int it = (it0 & 7) * 32 + (it0 >> 3);
        const int b = it >> 7, hd = (it >> 5) & 3, pr = it & 31;
        diff_tile(lds, proj, mixed, p.in[7], lam, b, hd, 63 - pr);
        diff_tile(lds, proj, mixed, p.in[7], lam, b, hd, pr);
    }
    for (int it0 = blockIdx.x; it0 < 512; it0 += gridDim.x) {
        const int it = (it0 & 7) * 64 + (it0 >> 3);
        const int b = it >> 8, hs = (it >> 5) & 7, qb = it & 31;
        sb_block(lds, proj, mixed, b, hs, qb);
    }
}
constexpr int SXS = 528, SXS2 = 576, SBS = 272, SBS2 = 320;
constexpr int L_SX = 0, L_SB = 128 * SXS2, L_SC = L_SB + 128 * SBS, L_SDT = L_SC + 128 * SBS, L_SAC = L_SDT + 2048, L_SSQ = L_SAC + 2048;
static_assert(L_SSQ + 4096 <= LDS_BYTES, "lds");

DI void ssd_dt_acum(LAS unsigned char* lds, const float* DT, const float* dt_bias, const float* a_log, size_t t0, int g) {
    LAS float* sdt = (LAS float*)(lds + L_SDT); LAS float* sac = (LAS float*)(lds + L_SAC);
    const int tid = otid(), hh = tid >> 7, l = tid & 127, head = 4 * g + hh, w = tid >> 6, lane = tid & 63;
    const float raw = DT[(t0 + l) * 32 + head] + dt_bias[head];
    const float dt = fmaxf(raw, 0.f) + __logf(1.0f + __expf(-fabsf(raw)));
    sdt[hh * 128 + l] = dt; sac[hh * 128 + l] = -dt * __expf(a_log[head]);
    __syncthreads();
    if (w < 4) {
        const float v0 = sac[w * 128 + 2 * lane], v1 = sac[w * 128 + 2 * lane + 1]; float s = v0 + v1;
#pragma unroll
        for (int off = 1; off < 64; off <<= 1) { const float t = __shfl_up(s, off); if (lane >= off) s += t; }
        const float ex = s - (v0 + v1);
        sac[w * 128 + 2 * lane] = ex + v0; sac[w * 128 + 2 * lane + 1] = ex + v0 + v1;
    }
    __syncthreads();
}
template <int NT, class F> DI void conv_strip(const bf16_t* src, int nzero, const float* cw, const float* cb, int ch, F&& emit) {
    f32x4 wlo[4], whi[4];
#pragma unroll
    for (int k = 0; k < 4; ++k) { wlo[k] = *(const f32x4*)(cw + k * XBCW + ch); whi[k] = *(const f32x4*)(cw + k * XBCW + ch + 4); }
    const f32x4 blo = *(const f32x4*)(cb + ch), bhi = *(const f32x4*)(cb + ch + 4);
    u32x4 raw[NT + 3];
#pragma unroll
    for (int i = 0; i < NT + 3; ++i) { const int ii = (i < nzero) ? nzero : i; raw[i] = *(const u32x4*)(src + (ptrdiff_t)(ii - 3) * XBCW); if (i < nzero) raw[i] = (u32x4){0u, 0u, 0u, 0u}; }
#pragma unroll
    for (int t = 0; t < NT; ++t) {
        float o[8];
#pragma unroll
        for (int e = 0; e < 8; ++e) {
            float a = (e < 4) ? blo[e & 3] : bhi[e & 3];
#pragma unroll
            for (int k = 0; k < 4; ++k) { const unsigned d = raw[t + k][e >> 1]; const float xv = (e & 1) ? bfhi(d) : bflo(d); a += ((e < 4) ? wlo[k][e & 3] : whi[k][e & 3]) * xv; }
            o[e] = fsilu(a);
        }
        emit(t, o);
    }
}
DI u32x4 pack8f(const float* o) { u32x4 r; r[0] = pk2(o[0], o[1]); r[1] = pk2(o[2], o[3]); r[2] = pk2(o[4], o[5]); r[3] = pk2(o[6], o[7]); return r; }

template <bool XW, bool WITH_C> DI void ssd_stage(LAS unsigned char* lds, const bf16_t* xbc, const float* cw, const float* cb, size_t t0, int c, int g) {
    const int tid = otid();
    LAS float* sdt = (LAS float*)(lds + L_SDT); LAS float* sac = (LAS float*)(lds + L_SAC);
    {
        const int c8 = tid & 31, tg = tid >> 5, l0 = 8 * tg, ch = 256 * g + 8 * c8, hh = c8 >> 3;
        const int nzero = (c == 0) ? (3 - l0 > 0 ? 3 - l0 : 0) : 0;
        const float alast = sac[hh * 128 + 127];
        conv_strip<8>(xbc + (t0 + l0) * XBCW + ch, nzero, cw, cb, ch, [&](int t, float* o) {
            if (XW) { const float wgt = sdt[hh * 128 + l0 + t] * __expf(alast - sac[hh * 128 + l0 + t]);
#pragma unroll
                for (int e = 0; e < 8; ++e) o[e] *= wgt; }
            *(LAS u32x4*)(lds + L_SX + (l0 + t) * (XW ? SXS2 : SXS) + c8 * 16) = pack8f(o); });
    }
    {
        const int c8 = tid & 15, tg = tid >> 4, l0 = 4 * tg;
        const int nzero = (c == 0) ? (3 - l0 > 0 ? 3 - l0 : 0) : 0;
        const int chb = DIN + 128 * g + 8 * c8;
        conv_strip<4>(xbc + (t0 + l0) * XBCW + chb, nzero, cw, cb, chb, [&](int t, float* o) { *(LAS u32x4*)(lds + L_SB + (l0 + t) * (XW ? SBS2 : SBS) + c8 * 16) = pack8f(o); });
        if (WITH_C) { const int chc = DIN + 1024 + 128 * g + 8 * c8;
            conv_strip<4>(xbc + (t0 + l0) * XBCW + chc, nzero, cw, cb, chc, [&](int t, float* o) { *(LAS u32x4*)(lds + L_SC + (l0 + t) * SBS + c8 * 16) = pack8f(o); }); }
    }
}
DI bf16_t* st_ptr(unsigned char* ws, int b) { return (bf16_t*)(ws + (b ? O_ST1 : O_ST0)); }

DI void ssd_states_phase(LAS unsigned char* lds, const Params& p) {
    const int tid = otid(), w = __builtin_amdgcn_readfirstlane(tid >> 6), lane = tid & 63, r = lane & 31, h = lane >> 5, hh = w >> 1, ph = w & 1;
    const bf16_t* xbc = (const bf16_t*)(p.ws + O_XBC); const float* DT = (const float*)(p.ws + O_DT); float* cdec = (float*)(p.ws + O_CDEC);
    const int i16 = lane & 15, tq = i16 >> 2, tp = i16 & 3, g16 = (lane >> 4) & 1;
    for (int it = blockIdx.x; it < 1024; it += gridDim.x) {
        const int b = it >> 9, c = (it >> 3) & 63, g = it & 7; const size_t t0 = (size_t)b * SEQ + (size_t)c * 128;
        ssd_dt_acum(lds, DT, p.in[13], p.in[14], t0, g);
        ssd_stage<true, false>(lds, xbc, p.in[11], p.in[12], t0, c, g);
        __syncthreads();
        f32x16 acc[4];
#pragma unroll
        for (int i = 0; i < 4; ++i) acc[i] = zero16();
        const LAS unsigned char* xa = lds + L_SX + (8 * h + tq) * SXS2 + (64 * hh + 32 * ph + 16 * g16 + 4 * tp) * 2;
        const LAS unsigned char* ba = lds + L_SB + (8 * h + tq) * SBS2 + (16 * g16 + 4 * tp) * 2;
#pragma unroll
        for (int s = 0; s < 8; ++s) {
            const bf16x8 af = tr2(xa + 16 * s * SXS2, xa + (16 * s + 4) * SXS2);
#pragma unroll
            for (int nt = 0; nt < 4; ++nt) { const bf16x8 bfr = tr2(ba + 16 * s * SBS2 + nt * 64, ba + (16 * s + 4) * SBS2 + nt * 64); acc[nt] = MFMA32(af, bfr, acc[nt]); }
        }
        bf16_t* st = st_ptr(p.ws, b) + ((size_t)(c * 32 + 4 * g + hh) * 64 + 32 * ph) * 128;
#pragma unroll
        for (int nt = 0; nt < 4; ++nt)
#pragma unroll
            for (int i = 0; i < 16; ++i) st[(size_t)crow(i, h) * 128 + 32 * nt + r] = (bf16_t)(pk2(acc[nt][i], 0.f) & 0xffffu);
        if (tid < 4) cdec[(b * 64 + c) * 32 + 4 * g + tid] = __expf(((LAS float*)(lds + L_SAC))[tid * 128 + 127]);
        __syncthreads();
    }
}
DI void ssd_scan_phase(const Params& p, const bool dry) {
    const float* cdec = (const float*)(p.ws + O_CDEC);
    for (int e = blockIdx.x * 512 + threadIdx.x; e < 2 * 32 * 64 * 32; e += gridDim.x * 512) {
        const int b = e >> 16, rem = e & 65535, head = rem >> 11;
        bf16_t* st = st_ptr(p.ws, b) + (size_t)rem * 4;
        float carry[4] = {0.f, 0.f, 0.f, 0.f};
        for (int c0 = 0; c0 < 64; c0 += 8) {
            u32x2 v[8]; float dc[8];
#pragma unroll
            for (int u = 0; u < 8; ++u) { v[u] = *(const u32x2*)(st + (size_t)(c0 + u) * 262144); dc[u] = cdec[(b * 64 + c0 + u) * 32 + head]; }
#pragma unroll
            for (int u = 0; u < 8; ++u) {
                u32x2 o; o[0] = pk2(carry[0], carry[1]); o[1] = pk2(carry[2], carry[3]); if (!dry) *(u32x2*)(st + (size_t)(c0 + u) * 262144) = o;
                carry[0] = carry[0] * dc[u] + bflo(v[u][0]); carry[1] = carry[1] * dc[u] + bfhi(v[u][0]); carry[2] = carry[2] * dc[u] + bflo(v[u][1]); carry[3] = carry[3] * dc[u] + bfhi(v[u][1]);
            }
        }
    }
}
DI void ssd_out_phase(LAS unsigned char* lds, const Params& p, const bool dry) {
    const int tid = otid(), w = __builtin_amdgcn_readfirstlane(tid >> 6), lane = tid & 63, r = lane & 31, h = lane >> 5, hh = w >> 1, ph = w & 1;
    const bf16_t* xbc = (const bf16_t*)(p.ws + O_XBC); const float* DT = (const float*)(p.ws + O_DT); bf16_t* zy = (bf16_t*)p.out;
    LAS float* sdt = (LAS float*)(lds + L_SDT); LAS float* sac = (LAS float*)(lds + L_SAC); LAS float* ssq = (LAS float*)(lds + L_SSQ);
    const int i16 = lane & 15, tq = i16 >> 2, tp = i16 & 3, g16 = (lane >> 4) & 1;
    for (int it = blockIdx.x; it < 1024; it += gridDim.x) {
        const int b = it >> 9, c = (it >> 3) & 63, g = it & 7, head = 4 * g + hh; const size_t t0 = (size_t)b * SEQ + (size_t)c * 128;
        ssd_dt_acum(lds, DT, p.in[13], p.in[14], t0, g);
        ssd_stage<false, true>(lds, xbc, p.in[11], p.in[12], t0, c, g);
        bf16x8 pvf[8];
        { const bf16_t* pp = st_ptr(p.ws, b) + ((size_t)(c * 32 + head) * 64 + 32 * ph + r) * 128 + 8 * h;
#pragma unroll
          for (int s = 0; s < 8; ++s) pvf[s] = *(const bf16x8*)(pp + 16 * s); }
        __syncthreads();
        f32x16 Y[4];
        const LAS unsigned char* xa = lds + L_SX + (4 * h + tq) * SXS + (64 * hh + 32 * ph + 16 * g16 + 4 * tp) * 2;
#pragma unroll
        for (int lt = 0; lt < 4; ++lt) {
            __builtin_amdgcn_sched_barrier(0);
            f32x16 y = zero16();
#pragma unroll
            for (int s = 0; s < 8; ++s) { const bf16x8 cfs = *(const LAS bf16x8*)(lds + L_SC + (32 * lt + r) * SBS + (16 * s + 8 * h) * 2); y = MFMA32(pvf[s], cfs, y); }
            Y[lt] = y * __expf(sac[hh * 128 + 32 * lt + r]);
        }
#pragma unroll
        for (int lt = 0; lt < 4; ++lt) {
            __builtin_amdgcn_sched_barrier(0);
            bf16x8 cf[8];
#pragma unroll
            for (int s = 0; s < 8; ++s) cf[s] = *(const LAS bf16x8*)(lds + L_SC + (32 * lt + r) * SBS + (16 * s + 8 * h) * 2);
            const float al = sac[hh * 128 + 32 * lt + r];
#pragma unroll
            for (int mt = 0; mt < 4; ++mt) {
                if (mt <= lt) {
                    __builtin_amdgcn_sched_barrier(0);
                    f32x16 X = zero16();
#pragma unroll
                    for (int s = 0; s < 8; ++s) { const bf16x8 bfr = *(const LAS bf16x8*)(lds + L_SB + (32 * mt + r) * SBS + (16 * s + 8 * h) * 2); X = MFMA32(bfr, cf[s], X); }
#pragma unroll
                    for (int gq = 0; gq < 4; ++gq) {
                        const f32x4 am = *(const LAS f32x4*)(sac + hh * 128 + 32 * mt + 8 * gq + 4 * h), dm = *(const LAS f32x4*)(sdt + hh * 128 + 32 * mt + 8 * gq + 4 * h);
#pragma unroll
                        for (int jj = 0; jj < 4; ++jj) { const int mrow = 32 * mt + 8 * gq + 4 * h + jj; const bool ok = (32 * lt + r) >= mrow;
                            const float dec = ok ? __expf(fminf(al - am[jj], 0.f)) * dm[jj] : 0.f; X[4 * gq + jj] *= dec; }
                    }
#pragma unroll
                    for (int s2 = 0; s2 < 2; ++s2) { const bf16x8 xs = pack8(X, s2);
                        const LAS unsigned char* xr = xa + (32 * mt + 16 * s2) * SXS; const bf16x8 xf = tr2(xr, xr + 8 * SXS); Y[lt] = MFMA32(xf, xs, Y[lt]); }
                }
            }
        }
        __builtin_amdgcn_sched_barrier(0);
        const float Dh = p.in[15][head];
        float sq[4];
#pragma unroll
        for (int lt = 0; lt < 4; ++lt) {
            const int l = 32 * lt + r; sq[lt] = 0.f;
#pragma unroll
            for (int gq = 0; gq < 4; ++gq) {
                const int chl = 64 * hh + 32 * ph + 8 * gq + 4 * h;
                const u32x2 xv = *(const LAS u32x2*)(lds + L_SX + l * SXS + chl * 2);
                const u32x2 zv = *(const u32x2*)(zy + (t0 + l) * DIN + 256 * g + chl);
                const float xf4[4] = {bflo(xv[0]), bfhi(xv[0]), bflo(xv[1]), bfhi(xv[1])}, zf4[4] = {bflo(zv[0]), bfhi(zv[0]), bflo(zv[1]), bfhi(zv[1])};
#pragma unroll
                for (int jj = 0; jj < 4; ++jj) { const float yv = (Y[lt][4 * gq + jj] + Dh * xf4[jj]) * fsilu(zf4[jj]); Y[lt][4 * gq + jj] = yv; sq[lt] += yv * yv; }
            }
            sq[lt] += __shfl_xor(sq[lt], 32);
            if (h == 0) ssq[w * 128 + l] = sq[lt];
        }
        __syncthreads();
#pragma unroll
        for (int lt = 0; lt < 4; ++lt) {
            const int l = 32 * lt + r; float tot = 0.f;
#pragma unroll
            for (int ww = 0; ww < 8; ++ww) tot += ssq[ww * 128 + l];
            const float rn = __builtin_amdgcn_rsqf(tot * (1.0f / 256.0f) + 1e-5f);
#pragma unroll
            for (int gq = 0; gq < 4; ++gq) {
                const int chl = 64 * hh + 32 * ph + 8 * gq + 4 * h; const f32x4 gw = *(const f32x4*)(p.in[16] + 256 * g + chl);
                u32x2 o; o[0] = pk2(Y[lt][4 * gq] * rn * gw[0], Y[lt][4 * gq + 1] * rn * gw[1]); o[1] = pk2(Y[lt][4 * gq + 2] * rn * gw[2], Y[lt][4 * gq + 3] * rn * gw[3]);
                if (!dry) *(u32x2*)(zy + (t0 + l) * DIN + 256 * g + chl) = o;
            }
        }
        __syncthreads();
    }
}
DI void dt_proj(LAS unsigned char* lds, const Params& p) {
    const int tid = otid(), w = __builtin_amdgcn_readfirstlane(tid >> 6), lane = tid & 63, r = lane & 31, h = lane >> 5, rt = w & 1, kq = w >> 1;
    const bf16_t* hb = (const bf16_t*)(p.ws + O_HB); const bf16_t* wt = (const bf16_t*)(p.ws + W_SIN) + (size_t)6144 * DM;
    const float* ss = (const float*)(p.ws + O_SS) + 2 * MT; float* dt = (float*)(p.ws + O_DT);
    LAS float* part = (LAS float*)lds;
    for (int rb = blockIdx.x; rb < MT / 64; rb += gridDim.x) {
        const bf16_t* ap = hb + (size_t)(rb * 64 + rt * 32 + r) * DM + kq * 256 + 8 * h;
        const bf16_t* bp = wt + (size_t)r * DM + kq * 256 + 8 * h;
        bf16x8 af[16], bfr[16];
#pragma unroll
        for (int s = 0; s < 16; ++s) { af[s] = *(const bf16x8*)(ap + 16 * s); bfr[s] = *(const bf16x8*)(bp + 16 * s); }
        f32x16 acc = zero16();
#pragma unroll
        for (int s = 0; s < 16; ++s) acc = MFMA32(af[s], bfr[s], acc);
#pragma unroll
        for (int i = 0; i < 16; ++i) part[((kq * 2 + rt) * 32 + crow(i, h)) * 32 + r] = acc[i];
        __syncthreads();
#pragma unroll
        for (int q = 0; q < 4; ++q) {
            const int o = tid + 512 * q, row = o >> 5, col = o & 31;
            float v = 0.f;
#pragma unroll
            for (int k = 0; k < 4; ++k) v += part[((k * 2 + (row >> 5)) * 32 + (row & 31)) * 32 + col];
            const int grow = rb * 64 + row;
            dt[(size_t)grow * 32 + col] = v * __builtin_amdgcn_rsqf(ss[grow] * (1.0f / 1024.0f) + 1e-6f);
        }
        __syncthreads();
    }
}
template <class Epi> DI void run_gemm(LAS unsigned char* lds, const bf16_t* A, const bf16_t* Bt, int N, int K, const Epi& E) {
    pg8::Gemm g; g.A = A; g.Bt = Bt; g.M = MT; g.N = N; g.K = K;
    pg8::StaticOrder S; S.init(MT, N, (int)gridDim.x, (int)blockIdx.x);
    pg8::gemm_phase<Epi, pg8::StaticOrder, !Epi::AFTER_DRAIN, true>((PG8_LAS unsigned char*)lds, g, S, E);
}
#if defined(DRY_S3) || defined(DRY_S4)
#define DRYV (p.ws == nullptr)
#else
#define DRYV false
#endif
__global__ void __launch_bounds__(512, 2) fwd_megakernel(Params p) {
    extern __shared__ __attribute__((aligned(16))) unsigned char shm[];
    LAS unsigned char* lds = (LAS unsigned char*)shm;
    cg::grid_group grid = cg::this_grid();
    if (threadIdx.x < 4) ((LAS unsigned*)(lds + LDS_BYTES - 16))[threadIdx.x] = 0u;
    __syncthreads();
    const XcdBarrier xbar = xcd_barrier_post((unsigned*)(p.ws + O_BAR), (volatile LAS unsigned*)(lds + LDS_BYTES - 16));
#define GBAR() xcd_barrier(xbar)
    unsigned char* ws = p.ws;
    bf16_t* hb = (bf16_t*)(ws + O_HB); float* ss = (float*)(ws + O_SS);
    phase0(lds, p);
#ifdef DUP_P0
    GBAR(); phase0(lds, p);
#endif
    if (gridDim.x == 0x7fffffffu) grid.sync();
    GBAR();
    { EpiAttnIn E; E.O = (bf16_t*)(ws + O_PROJ); E.ss = ss; E.tab = (const f32x4*)(ws + O_ROPE); run_gemm(lds, hb, (const bf16_t*)(ws + W_AIN), AINW, DM, E); }
    GBAR();
    attn_phase(lds, p);
#ifdef DUP_ATTN
    GBAR(); attn_phase(lds, p);
#endif
    GBAR();
    { EpiRes<true, false> E; E.xres = p.in[0]; E.hb = hb; E.outf = nullptr; E.ssn = ss + MT; run_gemm(lds, (const bf16_t*)(ws + O_MIXED), (const bf16_t*)(ws + W_AOUT), DM, DM, E); }
    GBAR();
    { EpiGU E; E.act = (bf16_t*)(ws + O_ACT); E.ss = ss + MT; run_gemm(lds, hb, (const bf16_t*)(ws + W_GU0), 2 * DFF, DM, E); }
    GBAR();
    { EpiRes<false, false> E; E.xres = nullptr; E.hb = hb; E.outf = nullptr; E.ssn = ss + 2 * MT; run_gemm(lds, (const bf16_t*)(ws + O_ACT), (const bf16_t*)(ws + W_DN0), DM, DFF, E); }
    GBAR();
    { EpiSsdIn E; E.z = (bf16_t*)p.out; E.xbc = (bf16_t*)(ws + O_XBC); E.dt = (float*)(ws + O_DT); E.ss = ss + 2 * MT; dt_proj(lds, p); run_gemm(lds, hb, (const bf16_t*)(ws + W_SIN), 6144, DM, E); }
    GBAR();
    ssd_states_phase(lds, p);
#ifdef DUP_S2
    GBAR(); ssd_states_phase(lds, p);
#endif
    GBAR();
#ifdef DRY_S3
    ssd_scan_phase(p, p.ws != nullptr); GBAR();
#endif
    ssd_scan_phase(p, DRYV);
    GBAR();
#ifdef DRY_S4
    ssd_out_phase(lds, p, p.ws != nullptr); GBAR();
#endif
    ssd_out_phase(lds, p, DRYV);
    GBAR();
    { EpiRes<false, false> E; E.xres = nullptr; E.hb = hb; E.outf = nullptr; E.ssn = ss + 3 * MT; run_gemm(lds, (const bf16_t*)p.out, (const bf16_t*)(ws + W_SOUT), DM, DIN, E); }
    GBAR();
    { EpiGU E; E.act = (bf16_t*)(ws + O_ACT); E.ss = ss + 3 * MT; run_gemm(lds, hb, (const bf16_t*)(ws + W_GU1), 2 * DFF, DM, E); }
    GBAR();
    if (gridDim.x == 256) {
        EpiFinal E; E.hb = hb; E.outf = p.out; E.ssn = ss + 4 * MT; E.cnt = (unsigned*)(ws + O_BAR) + XCD_BAR_WORDS; E.fw = p.in[22];
        run_gemm(lds, (const bf16_t*)(ws + O_ACT), (const bf16_t*)(ws + W_DN1), DM, DFF, E);
    } else {
        { EpiRes<false, true> E; E.xres = nullptr; E.hb = hb; E.outf = p.out; E.ssn = ss + 4 * MT; run_gemm(lds, (const bf16_t*)(ws + O_ACT), (const bf16_t*)(ws + W_DN1), DM, DFF, E); }
        GBAR();
        const float* ss4 = ss + 4 * MT; const f32x4* fw = (const f32x4*)p.in[22]; f32x4* o4 = (f32x4*)p.out;
        for (int i = blockIdx.x * 512 + threadIdx.x; i < MT * (DM / 4); i += gridDim.x * 512) {
            const int row = i >> 8; const float rs = __builtin_amdgcn_rsqf(ss4[row] * (1.0f / 1024.0f) + 1e-6f);
            o4[i] = o4[i] * rs * fw[i & 255];
        }
    }
}

extern "C" void kernel_launch(void* const* d_in, const int* in_sizes, int n_in, void* d_out, int out_size, void* d_ws, size_t ws_size, hipStream_t stream) {
    static int grid_blocks = 0;
    if (!grid_blocks) {
        int dev = 0, cus = 0, per_cu = 0;
        hipGetDevice(&dev);
        hipDeviceGetAttribute(&cus, hipDeviceAttributeMultiprocessorCount, dev);
        if (hipFuncSetAttribute((const void*)fwd_megakernel, hipFuncAttributeMaxDynamicSharedMemorySize, LDS_BYTES) != hipSuccess) fprintf(stderr, "hipFuncSetAttribute failed\n");
        if (hipOccupancyMaxActiveBlocksPerMultiprocessor(&per_cu, (const void*)fwd_megakernel, 512, LDS_BYTES) != hipSuccess || per_cu < 1) { fprintf(stderr, "occupancy query: %d\n", per_cu); per_cu = 1; }
        (void)hipGetLastError();
        grid_blocks = cus * per_cu;
        if (ws_size < 268435456ull || n_in != 23) fprintf(stderr, "unexpected ws_size %zu / n_in %d\n", ws_size, n_in);
    }
    if (hipMemsetAsync((char*)d_ws + O_BAR, 0, 20480, stream) != hipSuccess) fprintf(stderr, "memset failed\n");
    Params p{};
    for (int i = 0; i < 23; ++i) p.in[i] = (const float*)d_in[i];
    p.out = (float*)d_out; p.ws = (unsigned char*)d_ws;
    void* args[] = {&p};
    hipError_t e = hipLaunchCooperativeKernel((const void*)fwd_megakernel, dim3(grid_blocks), dim3(512), args, LDS_BYTES, stream);
    if (e != hipSuccess) fprintf(stderr, "cooperative launch failed: %s (grid %d)\n", hipGetErrorString(e), grid_blocks);
}
#ifdef PHASE_TEST
__global__ void __launch_bounds__(512, 2) t_phase0(Params p) { extern __shared__ __attribute__((aligned(16))) unsigned char shm[]; phase0((LAS unsigned char*)shm, p); }
__global__ void __launch_bounds__(512, 2) t_attn_diff(Params p) { extern __shared__ __attribute__((aligned(16))) unsigned char shm[]; diff_tile((LAS unsigned char*)shm, (const bf16_t*)(p.ws + O_PROJ), (bf16_t*)(p.ws + O_MIXED), p.in[7], 0.3f, blockIdx.x & 1, blockIdx.y, blockIdx.z); }
__global__ void __launch_bounds__(512, 2) t_attn_sb(Params p) { extern __shared__ __attribute__((aligned(16))) unsigned char shm[]; sb_block((LAS unsigned char*)shm, (const bf16_t*)(p.ws + O_PROJ), (bf16_t*)(p.ws + O_MIXED), blockIdx.x & 1, blockIdx.y, blockIdx.z); }
__global__ void __launch_bounds__(512, 2) t_ssd_states(Params p) { extern __shared__ __attribute__((aligned(16))) unsigned char shm[]; ssd_states_phase((LAS unsigned char*)shm, p); }
__global__ void __launch_bounds__(512, 2) t_ssd_scan(Params p) { ssd_scan_phase(p, false); }
__global__ void __launch_bounds__(512, 2) t_ssd_out(Params p) { extern __shared__ __attribute__((aligned(16))) unsigned char shm[]; ssd_out_phase((LAS unsigned char*)shm, p, false); }
__global__ void __launch_bounds__(512, 2) t_gemm_ain(Params p) { extern __shared__ __attribute__((aligned(16))) unsigned char shm[]; EpiAttnIn E; E.O = (bf16_t*)(p.ws + O_PROJ); E.ss = (float*)(p.ws + O_SS); E.tab = (const f32x4*)(p.ws + O_ROPE); run_gemm((LAS unsigned char*)shm, (bf16_t*)(p.ws + O_HB), (const bf16_t*)(p.ws + W_AIN), AINW, DM, E); }
__global__ void __launch_bounds__(512, 2) t_gemm_res(Params p) { extern __shared__ __attribute__((aligned(16))) unsigned char shm[]; EpiRes<false, false> E; E.xres = nullptr; E.hb = (bf16_t*)(p.ws + O_HB); E.outf = nullptr; E.ssn = (float*)(p.ws + O_SS); run_gemm((LAS unsigned char*)shm, (bf16_t*)(p.ws + O_ACT), (const bf16_t*)(p.ws + W_DN0), DM, DFF, E); }
__global__ void __launch_bounds__(512, 2) t_gemm_gu(Params p) { extern __shared__ __attribute__((aligned(16))) unsigned char shm[]; EpiGU E; E.act = (bf16_t*)(p.ws + O_ACT); E.ss = (float*)(p.ws + O_SS); run_gemm((LAS unsigned char*)shm, (bf16_t*)(p.ws + O_HB), (const bf16_t*)(p.ws + W_GU0), 2 * DFF, DM, E); }
__global__ void __launch_bounds__(512, 2) t_gemm_ssdin(Params p) { extern __shared__ __attribute__((aligned(16))) unsigned char shm[]; EpiSsdIn E; E.z = (bf16_t*)p.out; E.xbc = (bf16_t*)(p.ws + O_XBC); E.dt = (float*)(p.ws + O_DT); E.ss = (float*)(p.ws + O_SS); run_gemm((LAS unsigned char*)shm, (bf16_t*)(p.ws + O_HB), (const bf16_t*)(p.ws + W_SIN), SINWP, DM, E); }
#endif
```

```cpp
#include <hip/hip_runtime.h>
#include <hip/hip_cooperative_groups.h>
#include <cstdio>
#include <cstdint>
namespace cg = cooperative_groups;
namespace pg8 {
#define PG8_LAS __attribute__((address_space(3)))
typedef unsigned short bf16_t;
typedef short bf16x8 __attribute__((ext_vector_type(8)));
typedef float f32x4 __attribute__((ext_vector_type(4)));
typedef unsigned u32x4 __attribute__((ext_vector_type(4)));
constexpr int BM = 256, BK = 64, HALF = 128, HTB = HALF * BK * 2  , STAGE_BYTES = 8 * HTB, NXCD = 8, WGM = 8;

__host__ __device__ __forceinline__ int lds_byte(int r, int c) { const int st = (r >> 4) * 2 + (c >> 5), rr = r & 15, cc = c & 31, ob = rr * 64 + cc * 2; return st * 1024 + (ob ^ (((ob >> 9) & 1) << 5)); }
__host__ __device__ __forceinline__ void stage_rc(int b, int& R, int& C) { const int st = b / 1024, sb = b % 1024, swz = sb ^ (((sb >> 9) & 1) << 5); R = (st >> 1) * 16 + swz / 64; C = (st & 1) * 32 + (swz % 64) / 2; }
__host__ __device__ __forceinline__ int perm32(int rho) { const int n = rho >> 4, i = rho & 15; return 8 * (i >> 2) + 4 * n + (i & 3); }

struct Unit { int pm, pn; };
struct Gemm { const bf16_t* A; const bf16_t* Bt; int M, N, K; };

struct StaticOrder {
    int nM, nN, nwg, G, c;
    __host__ __device__ void init(int M, int N, int G_, int c_) { nM = M / BM; nN = N / BM; nwg = nM * nN; G = G_; c = c_; }
    __host__ __device__ bool next(int i, Unit& u) const {
        const long L = (long)i * G + c; if (L >= nwg) return false;
        int wgid = (int)L; { const int q = nwg / NXCD, r = nwg % NXCD, xcd = wgid % NXCD, off = wgid / NXCD; wgid = (xcd < r ? xcd * (q + 1) : r * (q + 1) + (xcd - r) * q) + off; }
        const int nig = WGM * nN, gid = wgid / nig, fm = gid * WGM, gsz = (nM - fm) < WGM ? (nM - fm) : WGM;
        u.pm = fm + ((wgid % nig) % gsz); u.pn = (wgid % nig) / gsz; return true;
    }
    __device__ __forceinline__ void a_ready(const Unit&) const {}
    __device__ __forceinline__ void done(const Unit&) const {}
};

template <class Epi, class Sched, bool ALIGN_EPI = false, bool SP2 = false>
__device__ __forceinline__ void gemm_phase(PG8_LAS unsigned char* lds, const Gemm g, const Sched& S, const Epi& E) {
    int tid_ = threadIdx.x; asm volatile("" : "+v"(tid_)); const int tid = tid_, wid = __builtin_amdgcn_readfirstlane(tid >> 6), lane = tid & 63, wr = wid >> 2, wc = wid & 3, fr = lane & 15, fq = lane >> 4;
    const int K = g.K, nt = K / BK;
    unsigned voffA[2], voffB[2];
#pragma unroll
    for (int i = 0; i < 2; ++i) { int R, C; stage_rc(tid * 16 + i * 8192, R, C); const int Rb = Epi::PERM ? ((R & ~31) + perm32(R & 31)) : R;
        voffA[i] = (unsigned)(R * K + C) * 2u; voffB[i] = (unsigned)(Rb * K + C) * 2u; }
    const size_t kstep = (size_t)(BK * 2);
    const size_t hstep = (size_t)HALF * K * 2;
    const size_t tstep = 2 * hstep;
    const unsigned ldsw = (unsigned)wid * 1024u;
    const int aoff = lds_byte(wr * 64 + fr, fq * 8), boff = lds_byte(wc * 32 + fr, fq * 8);
#define PG8_SA(b, h) (((b) * 2 + (h)) * HTB)
#define PG8_SB(b, h) ((4 + (b) * 2 + (h)) * HTB)
#define PG8_STAGE(bufoff, gbase, voff) do { _Pragma("unroll") for (int _i = 0; _i < 2; ++_i) \
        __builtin_amdgcn_global_load_lds((const unsigned*)((const char*)(gbase) + (voff)[_i]), (PG8_LAS unsigned*)(lds + (bufoff) + ldsw + _i * 8192), 16, 0, 0); } while (0)
#define PG8_LDA(dst, b, h) do { _Pragma("unroll") for (int m = 0; m < 4; ++m) _Pragma("unroll") for (int k = 0; k < 2; ++k) dst[m][k] = *(const PG8_LAS bf16x8*)(lds + PG8_SA(b, h) + aoff + m * 2048 + k * 1024); } while (0)
#define PG8_LDB(dst, b, h) do { _Pragma("unroll") for (int n = 0; n < 2; ++n) _Pragma("unroll") for (int k = 0; k < 2; ++k) dst[n][k] = *(const PG8_LAS bf16x8*)(lds + PG8_SB(b, h) + boff + n * 2048 + k * 1024); } while (0)
#define PG8_MMA(ai, bj, At, Bt) do { __builtin_amdgcn_s_setprio(1); _Pragma("unroll") for (int m = 0; m < 4; ++m) _Pragma("unroll") for (int n = 0; n < 2; ++n) _Pragma("unroll") for (int k = 0; k < 2; ++k) \
        acc[ai][bj][m][n] = __builtin_amdgcn_mfma_f32_16x16x32_bf16(Bt[n][k], At[m][k], acc[ai][bj][m][n], 0, 0, 0); __builtin_amdgcn_s_setprio(0); } while (0)
#define PG8_WAIT_V(n) asm volatile("s_waitcnt vmcnt(" #n ")" ::: "memory")
#define PG8_WAIT_L(n) asm volatile("s_waitcnt lgkmcnt(" #n ")" ::: "memory")
#define PG8_BAR __builtin_amdgcn_s_barrier()
#define PG8_SCHED __builtin_amdgcn_sched_barrier(0)
    Unit cur, nxt; int ui = 0;
    if (!S.next(0, cur)) return;
    f32x4 acc[2][2][4][2];
#pragma unroll
    for (int a = 0; a < 2; ++a)
#pragma unroll
        for (int b = 0; b < 2; ++b)
#pragma unroll
            for (int m = 0; m < 4; ++m)
#pragma unroll
                for (int n = 0; n < 2; ++n) acc[a][b][m][n] = (f32x4){0.f, 0.f, 0.f, 0.f};
    bf16x8 At[4][2], B0[2][2], B1[2][2];
    float epre[8]; E.pre(cur, wr, fr, epre);
    const char* cA = (const char*)g.A + (size_t)cur.pm * tstep; const char* cB = (const char*)g.Bt + (size_t)cur.pn * tstep;
    S.a_ready(cur);
    if constexpr (SP2) {
        PG8_STAGE(PG8_SB(0, 0), cB, voffB); PG8_STAGE(PG8_SB(0, 1), cB + hstep, voffB); PG8_STAGE(PG8_SA(0, 0), cA, voffA); PG8_STAGE(PG8_SA(0, 1), cA + hstep, voffA);
        if (wr == 1) PG8_BAR;
        PG8_WAIT_V(2); PG8_BAR;
        PG8_STAGE(PG8_SB(1, 0), cB + kstep, voffB); PG8_STAGE(PG8_SA(1, 0), cA + kstep, voffA); PG8_STAGE(PG8_SB(1, 1), cB + hstep + kstep, voffB);
        PG8_WAIT_V(6); PG8_BAR;
    } else {
        PG8_STAGE(PG8_SB(0, 0), cB, voffB); PG8_STAGE(PG8_SA(0, 0), cA, voffA); PG8_STAGE(PG8_SB(0, 1), cB + hstep, voffB); PG8_STAGE(PG8_SA(0, 1), cA + hstep, voffA);
        if (wr == 1) PG8_BAR;
        PG8_WAIT_V(4); PG8_BAR;
        PG8_STAGE(PG8_SB(1, 0), cB + kstep, voffB); PG8_STAGE(PG8_SA(1, 0), cA + kstep, voffA); PG8_STAGE(PG8_SB(1, 1), cB + hstep + kstep, voffB);
        PG8_WAIT_V(6); PG8_BAR;
    }
    for (;;) {
        const bool has_next = S.next(ui + 1, nxt);
        const char* nA = has_next ? (const char*)g.A + (size_t)nxt.pm * tstep : cA; const char* nB = has_next ? (const char*)g.Bt + (size_t)nxt.pn * tstep : cB;
        for (int t = 0; t < nt; t += 2) {
            const bool last = (t == nt - 2);
            const char* a1 = cA + (size_t)(t + 1) * kstep;
            const char* a2 = last ? nA : cA + (size_t)(t + 2) * kstep; const char* b2 = last ? nB : cB + (size_t)(t + 2) * kstep;
            const char* a3 = a2 + kstep; const char* b3 = b2 + kstep;
            if (last && has_next) S.a_ready(nxt);
            if constexpr (SP2) {
            PG8_LDB(B0, 0, 0); PG8_LDB(B1, 0, 1); PG8_SCHED; PG8_LDA(At, 0, 0); PG8_STAGE(PG8_SA(1, 1), a1 + hstep, voffA);
            PG8_WAIT_V(8); PG8_WAIT_L(0); PG8_BAR; PG8_MMA(0, 0, At, B0); PG8_MMA(0, 1, At, B1); PG8_BAR; PG8_SCHED;
            PG8_LDA(At, 0, 1); PG8_STAGE(PG8_SB(0, 0), b2, voffB); PG8_STAGE(PG8_SB(0, 1), b2 + hstep, voffB); PG8_STAGE(PG8_SA(0, 0), a2, voffA);
            PG8_WAIT_V(8); PG8_WAIT_L(0); PG8_BAR; PG8_MMA(1, 0, At, B0); PG8_MMA(1, 1, At, B1); PG8_BAR; PG8_SCHED;
            PG8_LDB(B0, 1, 0); PG8_LDB(B1, 1, 1); PG8_SCHED; PG8_LDA(At, 1, 0); PG8_STAGE(PG8_SA(0, 1), a2 + hstep, voffA);
            PG8_WAIT_V(8); PG8_WAIT_L(0); PG8_BAR; PG8_MMA(0, 0, At, B0); PG8_MMA(0, 1, At, B1); PG8_BAR; PG8_SCHED;
            PG8_LDA(At, 1, 1); PG8_STAGE(PG8_SB(1, 0), b3, voffB); PG8_STAGE(PG8_SB(1, 1), b3 + hstep, voffB); PG8_STAGE(PG8_SA(1, 0), a3, voffA);
            PG8_WAIT_V(8); PG8_WAIT_L(0); PG8_BAR; PG8_MMA(1, 0, At, B0); PG8_MMA(1, 1, At, B1); PG8_BAR; PG8_SCHED;
            } else {
            PG8_LDB(B0, 0, 0); PG8_SCHED; PG8_LDA(At, 0, 0); PG8_STAGE(PG8_SA(1, 1), a1 + hstep, voffA);
            PG8_WAIT_L(8); PG8_BAR; PG8_WAIT_L(0); PG8_MMA(0, 0, At, B0); PG8_BAR; PG8_SCHED;
            PG8_LDB(B1, 0, 1); PG8_STAGE(PG8_SB(0, 0), b2, voffB);
            PG8_BAR; PG8_WAIT_L(0); PG8_MMA(0, 1, At, B1); PG8_BAR;
            PG8_LDA(At, 0, 1); PG8_STAGE(PG8_SA(0, 0), a2, voffA);
            PG8_BAR; PG8_WAIT_L(0); PG8_MMA(1, 0, At, B0); PG8_BAR; PG8_SCHED;
            PG8_STAGE(PG8_SB(0, 1), b2 + hstep, voffB);
            PG8_WAIT_V(6); PG8_BAR; PG8_MMA(1, 1, At, B1); PG8_BAR;
            PG8_LDB(B0, 1, 0); PG8_SCHED; PG8_LDA(At, 1, 0); PG8_STAGE(PG8_SA(0, 1), a2 + hstep, voffA);
            PG8_WAIT_L(8); PG8_BAR; PG8_WAIT_L(0); PG8_MMA(0, 0, At, B0); PG8_BAR; PG8_SCHED;
            PG8_LDB(B1, 1, 1); PG8_STAGE(PG8_SB(1, 0), b3, voffB);
            PG8_BAR; PG8_WAIT_L(0); PG8_MMA(0, 1, At, B1); PG8_BAR;
            PG8_LDA(At, 1, 1); PG8_STAGE(PG8_SA(1, 0), a3, voffA);
            PG8_BAR; PG8_WAIT_L(0); PG8_MMA(1, 0, At, B0); PG8_BAR; PG8_SCHED;
            PG8_STAGE(PG8_SB(1, 1), b3 + hstep, voffB);
            PG8_WAIT_V(6); PG8_BAR; PG8_MMA(1, 1, At, B1); PG8_BAR;
            }
        }
        if constexpr (ALIGN_EPI) { if (wr == 0) PG8_BAR; }
        if constexpr (!Epi::AFTER_DRAIN) { E(acc, cur, wr, wc, fr, fq, epre); S.done(cur); }
        if (!has_next) break;
        E.pre(nxt, wr, fr, epre);
#pragma unroll
        for (int a = 0; a < 2; ++a)
#pragma unroll
            for (int b = 0; b < 2; ++b)
#pragma unroll
                for (int m = 0; m < 4; ++m)
#pragma unroll
                    for (int n = 0; n < 2; ++n) acc[a][b][m][n] = (f32x4){0.f, 0.f, 0.f, 0.f};
        cur = nxt; cA = nA; cB = nB; ++ui;
        if constexpr (ALIGN_EPI) { if (wr == 1) PG8_BAR; }
    }
    PG8_WAIT_V(0);
    if constexpr (!ALIGN_EPI) { if (wr == 0) PG8_BAR; }
    PG8_BAR;
    if constexpr (Epi::AFTER_DRAIN) { E.fused(acc, cur, wr, wc, fr, fq, lds, wid, lane); S.done(cur); }
#undef PG8_SA
#undef PG8_SB
#undef PG8_STAGE
#undef PG8_LDA
#undef PG8_LDB
#undef PG8_MMA
#undef PG8_WAIT_V
#undef PG8_WAIT_L
#undef PG8_BAR
#undef PG8_SCHED
}
}
using pg8::bf16_t; using pg8::bf16x8; using pg8::f32x4;
typedef short s16x4 __attribute__((ext_vector_type(4)));
typedef float f32x16 __attribute__((ext_vector_type(16)));
typedef float f32x2 __attribute__((ext_vector_type(2)));
typedef __bf16 bf2_t __attribute__((ext_vector_type(2)));
typedef unsigned u32x2 __attribute__((ext_vector_type(2)));
typedef unsigned u32x4 __attribute__((ext_vector_type(4)));
#define LAS __attribute__((address_space(3)))
#define DI __device__ __forceinline__
#define MFMA32(a, b, c) __builtin_amdgcn_mfma_f32_32x32x16_bf16((a), (b), (c), 0, 0, 0)

DI int otid() { int t = threadIdx.x; asm volatile("" : "+v"(t)); return t; }
DI unsigned pk2(float a, float b) { f32x2 v = {a, b}; bf2_t r = __builtin_convertvector(v, bf2_t); return __builtin_bit_cast(unsigned, r); }
DI float bflo(unsigned u) { return __uint_as_float(u << 16); }
DI float bfhi(unsigned u) { return __uint_as_float(u & 0xffff0000u); }
DI float fexp2(float x) { return __builtin_amdgcn_exp2f(x); }
DI float frcp(float x) { return __builtin_amdgcn_rcpf(x); }
DI float fsilu(float x) { return x * frcp(1.0f + fexp2(-1.44269504089f * x)); }
DI int crow(int i, int h) { return (i & 3) + 8 * (i >> 2) + 4 * h; }
DI s16x4 trr(const LAS unsigned char* p) { return __builtin_amdgcn_ds_read_tr16_b64_v4i16((LAS s16x4*)p); }
DI bf16x8 tr2(const LAS unsigned char* p0, const LAS unsigned char* p1) { s16x4 a = trr(p0), b = trr(p1); return __builtin_shufflevector(a, b, 0, 1, 2, 3, 4, 5, 6, 7); }
DI bf16x8 pack8(const f32x16& x, int s) {
    u32x4 p; p[0] = pk2(x[8 * s], x[8 * s + 1]); p[1] = pk2(x[8 * s + 2], x[8 * s + 3]); p[2] = pk2(x[8 * s + 4], x[8 * s + 5]); p[3] = pk2(x[8 * s + 6], x[8 * s + 7]);
    return __builtin_bit_cast(bf16x8, p);
}
DI f32x16 zero16() { f32x16 z; for (int i = 0; i < 16; ++i) z[i] = 0.f; return z; }

constexpr int MT = 16384, SEQ = 8192, DM = 1024, DFF = 2816, AINW = 3072, SINW = 6176, SINWP = 6400, DIN = 2048, XBCW = 4096;
constexpr float LOG2E = 1.44269504089f;
constexpr int LDS_BYTES = 155648;
constexpr size_t W_AIN = 0, W_AOUT = W_AIN + (size_t)AINW * DM * 2, W_GU0 = W_AOUT + (size_t)DM * DM * 2, W_DN0 = W_GU0 + (size_t)2 * DFF * DM * 2,
                 W_SIN = W_DN0 + (size_t)DM * DFF * 2, W_SOUT = W_SIN + (size_t)SINWP * DM * 2, W_GU1 = W_SOUT + (size_t)DM * DIN * 2, W_DN1 = W_GU1 + (size_t)2 * DFF * DM * 2,
                 O_HB = W_DN1 + (size_t)DM * DFF * 2, O_SS = O_HB + (size_t)MT * DM * 2, O_ROPE = O_SS + (size_t)5 * MT * 4, O_DT = O_ROPE + (size_t)SEQ * 32 * 8,
                 O_CDEC = O_DT + (size_t)MT * 32 * 4, O_LAM = O_CDEC + 16384, O_BAR = O_LAM + 256, O_R = 98566144;
static_assert(O_BAR + 20480 <= O_R, "map");
constexpr size_t O_PROJ = O_R, O_MIXED = O_PROJ + (size_t)MT * AINW * 2, O_ACT = O_R, O_XBC = O_R, O_ST1 = O_XBC + (size_t)MT * XBCW * 2, O_ST0 = 0;
constexpr size_t ST_BATCH = (size_t)64 * 32 * 64 * 128;
static_assert(O_ST1 + ST_BATCH * 2 <= 268435456ull, "ws");
static_assert(ST_BATCH * 2 <= W_SOUT, "st0 overlay");
static_assert(O_MIXED + (size_t)MT * DM * 2 <= 268435456ull, "ws2");

struct Params { const float* in[23]; float* out; unsigned char* ws; };
#include <cstdlib>
#include <vector>

#define XB_TMO      128
#define XB_XCNT(j)  (256  + 64 * (j))
#define XB_XSUB(j)  (1280 + 64 * (j))
#define XB_XGEN(j)  (2304 + 64 * (j))
#define XB_TOP      3328
#define XB_TOPGEN   3392
#define XCD_BAR_WORDS 3456
#define XB_SPIN_CAP (1u << 18)

__device__ __forceinline__ unsigned xb_ld(unsigned* p)              { return __hip_atomic_load(p, __ATOMIC_RELAXED, __HIP_MEMORY_SCOPE_AGENT); }
__device__ __forceinline__ unsigned xb_add(unsigned* p, unsigned v) { return __hip_atomic_fetch_add(p, v, __ATOMIC_RELAXED, __HIP_MEMORY_SCOPE_AGENT); }
__device__ __forceinline__ unsigned xb_xcc_id() { return (unsigned)__builtin_amdgcn_s_getreg((3 << 11) | 20) & 0xFu; }
#define XB_SPIN(cond, bar) do { unsigned _sp = 0; while (cond) { __builtin_amdgcn_s_sleep(1); \
    if ((++_sp & 255u) == 0u) { if (xb_ld(&(bar)[XB_TMO])) break; if (_sp > XB_SPIN_CAP) { atomicAdd(&(bar)[XB_TMO], 1u); break; } } } } while (0)

struct XcdBarrier {
    unsigned* bar; unsigned x;
    volatile LAS unsigned* st;
};

__device__ __forceinline__ XcdBarrier xcd_barrier_post(unsigned* bar, volatile LAS unsigned* st) {
    XcdBarrier b; b.bar = bar; b.x = xb_xcc_id(); b.st = st;
    if (threadIdx.x == 0) (void)xb_add(&bar[XB_XCNT(b.x)], 1u);
    return b;
}
__device__ __forceinline__ void xcd_barrier_complete(unsigned* bar, unsigned x, unsigned& nloc, unsigned& nx) {
    const unsigned G = gridDim.x * gridDim.y * gridDim.z;
    unsigned sum, cnt, mine, sp = 0u;
    for (;;) {
        sum = 0u; cnt = 0u; mine = 0u;
#pragma unroll
        for (unsigned j = 0; j < 16; ++j) { const unsigned c = xb_ld(&bar[XB_XCNT(j)]); sum += c; cnt += (c > 0u) ? 1u : 0u; mine = (j == x) ? c : mine; }
        if (sum == G) break;
        __builtin_amdgcn_s_sleep(1);
        if ((++sp & 255u) == 0u) { if (xb_ld(&bar[XB_TMO])) break; if (sp > XB_SPIN_CAP) { atomicAdd(&bar[XB_TMO], 1u); break; } }
    }
    nloc = mine > 0u ? mine : 1u; nx = cnt > 0u ? cnt : 1u;
}

__device__ __forceinline__ void xcd_barrier(const XcdBarrier& b) {
    asm volatile("s_waitcnt vmcnt(0)" ::: "memory");
    __syncthreads();
    if (threadIdx.x == 0) {
        unsigned* bar = b.bar;
        __builtin_amdgcn_s_waitcnt(0);
        unsigned nloc = b.st[0], nx = b.st[1];
        if (nloc == 0u) { xcd_barrier_complete(bar, b.x, nloc, nx); b.st[0] = nloc; b.st[1] = nx; }
        const unsigned old = xb_add(&bar[XB_XSUB(b.x)], 1u);
        const unsigned gen = old / nloc;
        if (old + 1u == (gen + 1u) * nloc) {
            __builtin_amdgcn_fence(__ATOMIC_RELEASE, "agent");
            asm volatile("s_waitcnt vmcnt(0)" ::: "memory");
            const unsigned og = xb_add(&bar[XB_TOP], 1u);
            const unsigned tg = og / nx;
            if (og + 1u == (tg + 1u) * nx) xb_add(&bar[XB_TOPGEN], 1u);
            else XB_SPIN(xb_ld(&bar[XB_TOPGEN]) == tg, bar);
            __builtin_amdgcn_fence(__ATOMIC_ACQUIRE, "agent");
            xb_add(&bar[XB_XGEN(b.x)], 1u);
            asm volatile("s_waitcnt vmcnt(0)" ::: "memory");
        } else {
            XB_SPIN(xb_ld(&bar[XB_XGEN(b.x)]) == gen, bar);
            __builtin_amdgcn_fence(__ATOMIC_ACQUIRE, "agent");
            asm volatile("s_waitcnt vmcnt(0)" ::: "memory");
        }
    }
    __syncthreads();
}
DI void wmap(int mode, int c, int& src, float& scale, int& which) {
    src = c; scale = 1.f; which = 0;
    if (mode == 0) {
        if (c < 1024) { const int base = c & ~63, cc = c & 63, g = cc >> 3, e = cc & 7; src = base + (e < 4 ? 4 * g + e : 32 + 4 * g + (e - 4)); }
        if (c < 512) scale = 0.125f * LOG2E; else if (c >= 1536 && c < 2048) scale = 0.125f;
    } else if (mode == 2) { src = 128 * (c >> 8) + (c & 127); which = (c >> 7) & 1; }
    else if (mode == 3) { if (c >= SINW) src = -1; }
}
struct WJob { int mode, K, ldw, tix; const float* W0; const float* W1; const float* ks; bf16_t* dst; };
DI WJob wjob(const Params& p, int t) {
    unsigned char* ws = p.ws;
    const int cnt[8] = {48 * 4, 16 * 4, 88 * 4, 16 * 11, 100 * 4, 16 * 8, 88 * 4, 16 * 11};
    int j = 0, tt = t;
#pragma unroll
    for (int q = 0; q < 7; ++q) if (j == q && tt >= cnt[q]) { tt -= cnt[q]; j = q + 1; }
    WJob J; J.tix = tt; J.W1 = nullptr; J.ks = nullptr;
    switch (j) {
    case 0: J.mode = 0; J.W0 = p.in[2]; J.ks = p.in[1]; J.dst = (bf16_t*)(ws + W_AIN); J.K = DM; J.ldw = AINW; break;
    case 1: J.mode = 1; J.W0 = p.in[8]; J.dst = (bf16_t*)(ws + W_AOUT); J.K = DM; J.ldw = DM; break;
    case 2: J.mode = 2; J.W0 = p.in[19]; J.W1 = p.in[20]; J.ks = p.in[18]; J.dst = (bf16_t*)(ws + W_GU0); J.K = DM; J.ldw = DFF; break;
    case 3: J.mode = 1; J.W0 = p.in[21]; J.dst = (bf16_t*)(ws + W_DN0); J.K = DFF; J.ldw = DM; break;
    case 4: J.mode = 3; J.W0 = p.in[10]; J.ks = p.in[9]; J.dst = (bf16_t*)(ws + W_SIN); J.K = DM; J.ldw = SINW; break;
    case 5: J.mode = 1; J.W0 = p.in[17]; J.dst = (bf16_t*)(ws + W_SOUT); J.K = DIN; J.ldw = DM; break;
    case 6: J.mode = 2; J.W0 = p.in[19] + (size_t)DM * DFF; J.W1 = p.in[20] + (size_t)DM * DFF; J.ks = p.in[18] + DM; J.dst = (bf16_t*)(ws + W_GU1); J.K = DM; J.ldw = DFF; break;
    default: J.mode = 1; J.W0 = p.in[21] + (size_t)DFF * DM; J.dst = (bf16_t*)(ws + W_DN1); J.K = DFF; J.ldw = DM; break;
    }
    return J;
}
DI void wtile_load(const WJob& J, int tid, float (&v)[32], float& sc, int& srcok) {
    const int nk = J.K >> 8, c0 = (J.tix / nk) * 64, k0 = (J.tix % nk) * 256, cc = tid & 63; int src, which; wmap(J.mode, c0 + cc, src, sc, which);
    const float* W = (which ? J.W1 : J.W0) + (src >= 0 ? src : 0); srcok = (src >= 0);
#pragma unroll
    for (int i = 0; i < 32; ++i) { const int kk = (tid >> 6) + 8 * i; v[i] = W[(size_t)(k0 + kk) * J.ldw]; }
}
DI void wtile_store(LAS float* tile, const WJob& J, int tid, const float (&v)[32], float sc, int srcok) {
    const int nk = J.K >> 8, c0 = (J.tix / nk) * 64, k0 = (J.tix % nk) * 256, cc = tid & 63;
#pragma unroll
    for (int i = 0; i < 32; ++i) { const int kk = (tid >> 6) + 8 * i; float x = srcok ? v[i] * sc : 0.f; if (J.ks) x *= J.ks[k0 + kk]; tile[kk * 65 + cc] = x; }
    __syncthreads();
#pragma unroll
    for (int i = 0; i < 16; ++i) {
        const int idx = tid + 512 * i, c2 = idx >> 7, k2 = (idx & 127) * 2;
        *(unsigned*)(J.dst + (size_t)(c0 + c2) * J.K + k0 + k2) = pk2(tile[k2 * 65 + c2], tile[(k2 + 1) * 65 + c2]);
    }
    __syncthreads();
}
DI void wconv_jobs(LAS unsigned char* lds, const Params& p, int wi, int nb) {
    const int tid = otid(); const int total = 48 * 4 + 16 * 4 + 2 * (88 * 4 + 16 * 11) + 100 * 4 + 16 * 8;
    if (wi >= total) return;
    WJob J = wjob(p, wi); float v[32]; float sc; int ok;
    wtile_load(J, tid, v, sc, ok);
    for (int t = wi; t < total; t += nb) {
        const bool more = (t + nb < total);
        WJob Jn = J; float vn[32]; float scn = 0.f; int okn = 0;
        if (more) { Jn = wjob(p, t + nb); wtile_load(Jn, tid, vn, scn, okn); }
        wtile_store((LAS float*)lds, J, tid, v, sc, ok);
        if (more) { J = Jn; sc = scn; ok = okn;
#pragma unroll
            for (int i = 0; i < 32; ++i) v[i] = vn[i]; }
    }
}
DI void phase0(LAS unsigned char* lds, const Params& p) {
    const int tid = otid(), G = gridDim.x, bx = blockIdx.x;
    unsigned char* ws = p.ws;
    wconv_jobs(lds, p, bx, G);
    {
        const int wave = tid >> 6, lane = tid & 63; bf16_t* hb = (bf16_t*)(ws + O_HB); float* ss = (float*)(ws + O_SS);
        for (int row0 = (bx * 8 + wave) * 2; row0 < MT; row0 += G * 16) {
            f32x4 v[2][4];
#pragma unroll
            for (int q = 0; q < 2; ++q)
#pragma unroll
                for (int i = 0; i < 4; ++i) v[q][i] = *(const f32x4*)(p.in[0] + (size_t)(row0 + q) * DM + lane * 4 + 256 * i);
#pragma unroll
            for (int q = 0; q < 2; ++q) {
                float sq = 0.f;
#pragma unroll
                for (int i = 0; i < 4; ++i) { const f32x4 x = v[q][i]; sq += x[0] * x[0] + x[1] * x[1] + x[2] * x[2] + x[3] * x[3];
                    u32x2 o; o[0] = pk2(x[0], x[1]); o[1] = pk2(x[2], x[3]); *(u32x2*)(hb + (size_t)(row0 + q) * DM + lane * 4 + 256 * i) = o; }
#pragma unroll
                for (int o = 32; o >= 1; o >>= 1) sq += __shfl_xor(sq, o);
                if (lane == 0) ss[row0 + q] = sq;
            }
        }
        for (int i = bx * 512 + tid; i < 4 * MT; i += G * 512) ss[MT + i] = 0.f;
        f32x2* tab = (f32x2*)(ws + O_ROPE);
        for (int i = bx * 512 + tid; i < SEQ * 32; i += G * 512) {
            const int pos = i >> 5, f = i & 31; const float inv = fexp2(-(float)f * 0.41524101186092f); const float ang = (float)pos * inv;
            double t = (double)ang * 0.15915494309189535; t -= floor(t); const float tf = (float)t;
            f32x2 cs; cs[0] = __builtin_amdgcn_cosf(tf); cs[1] = __builtin_amdgcn_sinf(tf); tab[i] = cs;
        }
        if (bx == 0 && tid == 0) { float s1 = 0.f, s2 = 0.f; for (int i = 0; i < 64; ++i) { s1 += p.in[3][i] * p.in[4][i]; s2 += p.in[5][i] * p.in[6][i]; }
            *(float*)(ws + O_LAM) = fexp2(s1 * LOG2E) - fexp2(s2 * LOG2E) + 0.2f; }
    }
}

struct EpiAttnIn {
    static constexpr bool PERM = true, AFTER_DRAIN = false;
    bf16_t* O; const float* ss; const f32x4* tab;
    DI void pre(const pg8::Unit& u, int wr, int fr, float (&e)[8]) const {
#pragma unroll
        for (int ai = 0; ai < 2; ++ai)
#pragma unroll
            for (int m = 0; m < 4; ++m) e[ai * 4 + m] = ss[u.pm * 256 + wr * 64 + fr + ai * 128 + m * 16];
    }
    DI void operator()(const f32x4 (&acc)[2][2][4][2], const pg8::Unit& u, int wr, int wc, int fr, int fq, const float (&epre)[8]) const {
        const int row0 = u.pm * 256 + wr * 64 + fr, colt = u.pn * 256, col0 = colt + wc * 32 + 8 * fq;
        const int fb = 4 * (4 * (wc & 1) + fq);
#pragma unroll
        for (int ai = 0; ai < 2; ++ai)
#pragma unroll
            for (int m = 0; m < 4; ++m) {
                const int row = row0 + ai * 128 + m * 16; const float rs = __builtin_amdgcn_rsqf(epre[ai * 4 + m] * (1.0f / 1024.0f) + 1e-6f);
                f32x4 c01 = {1.f, 0.f, 1.f, 0.f}, c23 = {1.f, 0.f, 1.f, 0.f};
                if (colt < 1024) { const int pos = row & (SEQ - 1); c01 = tab[(pos * 32 + fb) >> 1]; c23 = tab[((pos * 32 + fb) >> 1) + 1]; }
#pragma unroll
                for (int bj = 0; bj < 2; ++bj) {
                    f32x4 v0 = acc[ai][bj][m][0] * rs, v1 = acc[ai][bj][m][1] * rs;
                    if (colt < 1024) {
                        const float cs[4] = {c01[0], c01[2], c23[0], c23[2]}, sn[4] = {c01[1], c01[3], c23[1], c23[3]};
#pragma unroll
                        for (int j = 0; j < 4; ++j) { const float t1 = v0[j], t2 = v1[j]; v0[j] = t1 * cs[j] - t2 * sn[j]; v1[j] = t2 * cs[j] + t1 * sn[j]; }
                    }
                    u32x4 o; o[0] = pk2(v0[0], v0[1]); o[1] = pk2(v0[2], v0[3]); o[2] = pk2(v1[0], v1[1]); o[3] = pk2(v1[2], v1[3]);
                    *(u32x4*)(O + (size_t)row * AINW + col0 + bj * 128) = o;
                }
            }
    }
};
template <bool RES_F32, bool OUT_F32> struct EpiRes {
    static constexpr bool PERM = true, AFTER_DRAIN = false;
    const float* xres; bf16_t* hb; float* outf; float* ssn;
    DI void pre(const pg8::Unit&, int, int, float (&)[8]) const {}
    DI void operator()(const f32x4 (&acc)[2][2][4][2], const pg8::Unit& u, int wr, int wc, int fr, int fq, const float (&epre)[8]) const {
        const int row0 = u.pm * 256 + wr * 64 + fr, col0 = u.pn * 256 + wc * 32 + 8 * fq;
#pragma unroll
        for (int ai = 0; ai < 2; ++ai)
#pragma unroll
            for (int m = 0; m < 4; ++m) {
                const int row = row0 + ai * 128 + m * 16; float sq = 0.f;
#pragma unroll
                for (int bj = 0; bj < 2; ++bj) {
                    const size_t off = (size_t)row * DM + col0 + bj * 128; f32x4 r0, r1;
                    if (RES_F32) { r0 = *(const f32x4*)(xres + off); r1 = *(const f32x4*)(xres + off + 4); }
                    else { const u32x4 t = *(const u32x4*)(hb + off); r0[0] = bflo(t[0]); r0[1] = bfhi(t[0]); r0[2] = bflo(t[1]); r0[3] = bfhi(t[1]); r1[0] = bflo(t[2]); r1[1] = bfhi(t[2]); r1[2] = bflo(t[3]); r1[3] = bfhi(t[3]); }
                    const f32x4 v0 = r0 + acc[ai][bj][m][0], v1 = r1 + acc[ai][bj][m][1];
                    sq += v0[0] * v0[0] + v0[1] * v0[1] + v0[2] * v0[2] + v0[3] * v0[3] + v1[0] * v1[0] + v1[1] * v1[1] + v1[2] * v1[2] + v1[3] * v1[3];
                    if (OUT_F32) { *(f32x4*)(outf + off) = v0; *(f32x4*)(outf + off + 4) = v1; }
                    else { u32x4 o; o[0] = pk2(v0[0], v0[1]); o[1] = pk2(v0[2], v0[3]); o[2] = pk2(v1[0], v1[1]); o[3] = pk2(v1[2], v1[3]); *(u32x4*)(hb + off) = o; }
                }
                sq += __shfl_xor(sq, 16); sq += __shfl_xor(sq, 32);
                if (fq == 0) atomicAdd(ssn + row, sq);
            }
    }
};
struct EpiGU {
    static constexpr bool PERM = true, AFTER_DRAIN = false;
    bf16_t* act; const float* ss;
    DI void pre(const pg8::Unit& u, int wr, int fr, float (&e)[8]) const {
#pragma unroll
        for (int ai = 0; ai < 2; ++ai)
#pragma unroll
            for (int m = 0; m < 4; ++m) e[ai * 4 + m] = ss[u.pm * 256 + wr * 64 + fr + ai * 128 + m * 16];
    }
    DI void operator()(const f32x4 (&acc)[2][2][4][2], const pg8::Unit& u, int wr, int wc, int fr, int fq, const float (&epre)[8]) const {
        const int row0 = u.pm * 256 + wr * 64 + fr;
#pragma unroll
        for (int ai = 0; ai < 2; ++ai)
#pragma unroll
            for (int m = 0; m < 4; ++m) {
                const int row = row0 + ai * 128 + m * 16; const float rs = __builtin_amdgcn_rsqf(epre[ai * 4 + m] * (1.0f / 1024.0f) + 1e-6f);
                u32x4 o;
#pragma unroll
                for (int n = 0; n < 2; ++n) {
                    const f32x4 g = acc[ai][0][m][n] * rs, up = acc[ai][1][m][n] * rs; float a[4];
#pragma unroll
                    for (int j = 0; j < 4; ++j) a[j] = fsilu(g[j]) * up[j];
                    o[2 * n] = pk2(a[0], a[1]); o[2 * n + 1] = pk2(a[2], a[3]);
                }
                *(u32x4*)(act + (size_t)row * DFF + u.pn * 128 + wc * 32 + 8 * fq) = o;
            }
    }
};
struct EpiSsdIn {
    static constexpr bool PERM = true, AFTER_DRAIN = false;
    bf16_t* z; bf16_t* xbc; float* dt; const float* ss;
    DI void pre(const pg8::Unit& u, int wr, int fr, float (&e)[8]) const {
#pragma unroll
        for (int ai = 0; ai < 2; ++ai)
#pragma unroll
            for (int m = 0; m < 4; ++m) e[ai * 4 + m] = ss[u.pm * 256 + wr * 64 + fr + ai * 128 + m * 16];
    }
    DI void operator()(const f32x4 (&acc)[2][2][4][2], const pg8::Unit& u, int wr, int wc, int fr, int fq, const float (&epre)[8]) const {
        const int row0 = u.pm * 256 + wr * 64 + fr, col0 = u.pn * 256 + wc * 32 + 8 * fq;
#pragma unroll
        for (int ai = 0; ai < 2; ++ai)
#pragma unroll
            for (int m = 0; m < 4; ++m) {
                const int row = row0 + ai * 128 + m * 16; const float rs = __builtin_amdgcn_rsqf(epre[ai * 4 + m] * (1.0f / 1024.0f) + 1e-6f);
#pragma unroll
                for (int bj = 0; bj < 2; ++bj) {
                    const int c = col0 + bj * 128; const f32x4 v0 = acc[ai][bj][m][0] * rs, v1 = acc[ai][bj][m][1] * rs;
                    if (c < 6144) { u32x4 o; o[0] = pk2(v0[0], v0[1]); o[1] = pk2(v0[2], v0[3]); o[2] = pk2(v1[0], v1[1]); o[3] = pk2(v1[2], v1[3]);
                        if (c < DIN) *(u32x4*)(z + (size_t)row * DIN + c) = o; else *(u32x4*)(xbc + (size_t)row * XBCW + (c - DIN)) = o; }
                }
            }
    }
};

struct EpiFinal {
    static constexpr bool PERM = true, AFTER_DRAIN = true;
    const bf16_t* hb; float* outf; float* ssn; unsigned* cnt; const float* fw;
    DI void operator()(const f32x4 (&)[2][2][4][2], const pg8::Unit&, int, int, int, int, const float (&)[8]) const {}
    DI void pre(const pg8::Unit&, int, int, float (&)[8]) const {}
    DI void fused(f32x4 (&acc)[2][2][4][2], const pg8::Unit& u, int wr, int wc, int fr, int fq, PG8_LAS unsigned char*, int, int) const {
        const int row0 = u.pm * 256 + wr * 64 + fr, col0 = u.pn * 256 + wc * 32 + 8 * fq;
#pragma unroll
        for (int ai = 0; ai < 2; ++ai)
#pragma unroll
            for (int m = 0; m < 4; ++m) {
                const int row = row0 + ai * 128 + m * 16; float sq = 0.f;
#pragma unroll
                for (int bj = 0; bj < 2; ++bj) {
                    const size_t off = (size_t)row * DM + col0 + bj * 128;
                    const u32x4 t = *(const u32x4*)(hb + off);
#pragma unroll
                    for (int n = 0; n < 2; ++n) {
                        f32x4 r; r[0] = bflo(t[2 * n]); r[1] = bfhi(t[2 * n]); r[2] = bflo(t[2 * n + 1]); r[3] = bfhi(t[2 * n + 1]);
                        const f32x4 v = r + acc[ai][bj][m][n]; acc[ai][bj][m][n] = v;
                        sq += v[0] * v[0] + v[1] * v[1] + v[2] * v[2] + v[3] * v[3];
                    }
                }
                sq += __shfl_xor(sq, 16); sq += __shfl_xor(sq, 32);
                if (fq == 0) atomicAdd(ssn + row, sq);
            }
        asm volatile("s_waitcnt vmcnt(0)" ::: "memory");
        __syncthreads();
        unsigned* c = cnt + 16 * u.pm;
        if (threadIdx.x == 0) {
            __builtin_amdgcn_fence(__ATOMIC_RELEASE, "agent"); asm volatile("s_waitcnt vmcnt(0)" ::: "memory");
            __hip_atomic_fetch_add(c, 1u, __ATOMIC_RELAXED, __HIP_MEMORY_SCOPE_AGENT);
            unsigned spins = 0;
            while (__hip_atomic_load(c, __ATOMIC_RELAXED, __HIP_MEMORY_SCOPE_AGENT) < 4u && ++spins < (1u << 22)) __builtin_amdgcn_s_sleep(2);
            __builtin_amdgcn_fence(__ATOMIC_ACQUIRE, "agent"); asm volatile("s_waitcnt vmcnt(0)" ::: "memory");
        }
        __syncthreads();
#pragma unroll
        for (int ai = 0; ai < 2; ++ai)
#pragma unroll
            for (int m = 0; m < 4; ++m) {
                const int row = row0 + ai * 128 + m * 16;
                const float rs = __builtin_amdgcn_rsqf(__hip_atomic_load(ssn + row, __ATOMIC_RELAXED, __HIP_MEMORY_SCOPE_AGENT) * (1.0f / 1024.0f) + 1e-6f);
#pragma unroll
                for (int bj = 0; bj < 2; ++bj)
#pragma unroll
                    for (int n = 0; n < 2; ++n) {
                        const int col = col0 + bj * 128 + n * 4; const f32x4 w = *(const f32x4*)(fw + col);
                        *(f32x4*)(outf + (size_t)row * DM + col) = acc[ai][bj][m][n] * rs * w;
                    }
            }
    }
};
constexpr int KST = 144, VST = 320, VST64 = 192;
constexpr int AT_K1 = 0, AT_K2 = 64 * KST, AT_V = 2 * 64 * KST, AT_STAGE = AT_V + 64 * VST;

DI void diff_tile(LAS unsigned char* lds, const bf16_t* proj, bf16_t* mixed, const float* subln, float lam, int b, int hd, int qt) {
    const int tid = otid(), w = __builtin_amdgcn_readfirstlane(tid >> 6), lane = tid & 63, qg = w & 3, mp = w >> 2, r = lane & 31, h = lane >> 5;
    const int q0 = qt * 128; const size_t rowb = (size_t)b * SEQ;
    bf16x8 qf[4];
    { const bf16_t* qp = proj + (rowb + q0 + 32 * qg + r) * AINW + hd * 128 + mp * 64 + 8 * h;
#pragma unroll
      for (int s = 0; s < 4; ++s) qf[s] = *(const bf16x8*)(qp + 16 * s); }
    f32x16 O[4];
#pragma unroll
    for (int i = 0; i < 4; ++i) O[i] = zero16();
    float mrun = 0.f, lrun = 0.f;
    const int nsteps = 2 * (qt + 1);
    const bf16_t* src[4]; int dst[4];
#pragma unroll
    for (int i = 0; i < 2; ++i) { const int cid = tid + 512 * i, row = cid >> 4, c16 = cid & 15;
        src[i] = proj + (rowb + row) * AINW + 512 + hd * 128 + c16 * 8; dst[i] = (c16 < 8 ? AT_K1 : AT_K2) + row * KST + (c16 & 7) * 16;
        src[2 + i] = proj + (rowb + row) * AINW + 1024 + hd * 128 + c16 * 8; dst[2 + i] = AT_V + row * VST + c16 * 16; }
    u32x4 pf[4];
#pragma unroll
    for (int i = 0; i < 4; ++i) pf[i] = *(const u32x4*)(src[i]);
#pragma unroll
    for (int i = 0; i < 4; ++i) *(LAS u32x4*)(lds + dst[i]) = pf[i];
    __syncthreads();
    const int i16 = lane & 15, tq = i16 >> 2, tp = i16 & 3, g16 = (lane >> 4) & 1;
    const int troff = (4 * h + tq) * VST + (16 * g16 + 4 * tp) * 2;
    for (int j = 0; j < nsteps; ++j) {
        const bool more = (j + 1 < nsteps);
        if (more) {
#pragma unroll
            for (int i = 0; i < 4; ++i) pf[i] = *(const u32x4*)(src[i] + (size_t)(j + 1) * 64 * AINW);
        }
        const LAS unsigned char* base = lds + (j & 1) * AT_STAGE;
        const LAS unsigned char* Kb = base + (mp ? AT_K2 : AT_K1);
        const LAS unsigned char* Vb = base + AT_V;
        f32x16 S[2];
        const float negm = -mrun;
#pragma unroll
        for (int kt = 0; kt < 2; ++kt) {
#pragma unroll
            for (int i = 0; i < 16; ++i) S[kt][i] = negm;
#pragma unroll
            for (int s = 0; s < 4; ++s) { const bf16x8 kf = *(const LAS bf16x8*)(Kb + (32 * kt + r) * KST + (16 * s + 8 * h) * 2); S[kt] = MFMA32(kf, qf[s], S[kt]); } }
        const int qidx = q0 + 32 * qg + r, kbase = 64 * j;
        if (kbase + 63 > q0 + 32 * qg) {
#pragma unroll
            for (int kt = 0; kt < 2; ++kt)
#pragma unroll
                for (int i = 0; i < 16; ++i) if (kbase + 32 * kt + crow(i, h) > qidx) S[kt][i] = -1e30f;
        }
        float mx = S[0][0];
#pragma unroll
        for (int kt = 0; kt < 2; ++kt)
#pragma unroll
            for (int i = 0; i < 16; ++i) mx = fmaxf(mx, S[kt][i]);
        mx = fmaxf(mx, __shfl_xor(mx, 32));
        if (j == 0 || __builtin_amdgcn_ballot_w64(mx > 8.0f) != 0ull) {
            const float d = (j == 0) ? mx : fmaxf(mx, 0.f);
            mrun += d;
            if (j != 0) { const float alpha = fexp2(-d); lrun *= alpha;
#pragma unroll
                for (int vt = 0; vt < 4; ++vt) O[vt] = O[vt] * alpha; }
#pragma unroll
            for (int kt = 0; kt < 2; ++kt)
#pragma unroll
                for (int i = 0; i < 16; ++i) S[kt][i] -= d;
        }
        float ls = 0.f;
#pragma unroll
        for (int kt = 0; kt < 2; ++kt)
#pragma unroll
            for (int i = 0; i < 16; ++i) { const float pv = fexp2(S[kt][i]); S[kt][i] = pv; ls += pv; }
        lrun += ls;
#pragma unroll
        for (int kt = 0; kt < 2; ++kt)
#pragma unroll
            for (int s2 = 0; s2 < 2; ++s2) {
                const bf16x8 pfr = pack8(S[kt], s2);
                const LAS unsigned char* vrow = Vb + (32 * kt + 16 * s2) * VST + troff;
#pragma unroll
                for (int vt = 0; vt < 4; ++vt) { const bf16x8 vf = tr2(vrow + vt * 64, vrow + 8 * VST + vt * 64); O[vt] = MFMA32(vf, pfr, O[vt]); }
            }
        if (more) {
            LAS unsigned char* nb = lds + ((j + 1) & 1) * AT_STAGE;
#pragma unroll
            for (int i = 0; i < 4; ++i) *(LAS u32x4*)(nb + dst[i]) = pf[i];
        }
        __syncthreads();
    }
    lrun += __shfl_xor(lrun, 32);
    const float inv = frcp(lrun);
    LAS float* ex = (LAS float*)lds;
    if (mp == 1) {
        const float sc = inv * lam;
#pragma unroll
        for (int vt = 0; vt < 4; ++vt)
#pragma unroll
            for (int i = 0; i < 16; ++i) ex[(qg * 128 + 32 * vt + crow(i, h)) * 32 + r] = O[vt][i] * sc;
    }
    __syncthreads();
    if (mp == 0) {
        float sq = 0.f;
#pragma unroll
        for (int vt = 0; vt < 4; ++vt)
#pragma unroll
            for (int i = 0; i < 16; ++i) { const float o = O[vt][i] * inv - ex[(qg * 128 + 32 * vt + crow(i, h)) * 32 + r]; O[vt][i] = o; sq += o * o; }
        sq += __shfl_xor(sq, 32);
        const float rn = __builtin_amdgcn_rsqf(sq * (1.0f / 128.0f) + 1e-5f) * 0.8f;
        bf16_t* op = mixed + (rowb + q0 + 32 * qg + r) * DM + hd * 128;
#pragma unroll
        for (int vt = 0; vt < 4; ++vt)
#pragma unroll
            for (int gq = 0; gq < 4; ++gq) { const int v0 = 32 * vt + 8 * gq + 4 * h; const f32x4 wv = *(const f32x4*)(subln + v0);
                u32x2 o; o[0] = pk2(O[vt][4 * gq] * rn * wv[0], O[vt][4 * gq + 1] * rn * wv[1]); o[1] = pk2(O[vt][4 * gq + 2] * rn * wv[2], O[vt][4 * gq + 3] * rn * wv[3]);
                *(u32x2*)(op + v0) = o; }
    }
    __syncthreads();
}

constexpr int SB_K = 0, SB_V = 64 * KST, SB_STAGE = 64 * KST + 64 * VST64;
DI void sb_block(LAS unsigned char* lds, const bf16_t* proj, bf16_t* mixed, int b, int hs, int qb) {
    const int tid = otid(), w = __builtin_amdgcn_readfirstlane(tid >> 6), lane = tid & 63, r = lane & 31, h = lane >> 5;
    const int q0 = qb * 256; const size_t rowb = (size_t)b * SEQ;
    const int qidx = q0 + 32 * w + r;
    bf16x8 qf[4];
    { const bf16_t* qp = proj + (rowb + qidx) * AINW + 1536 + hs * 64 + 8 * h;
#pragma unroll
      for (int s = 0; s < 4; ++s) qf[s] = *(const bf16x8*)(qp + 16 * s); }
    f32x16 O[2]; O[0] = zero16(); O[1] = zero16();
    float carry = 1.0f;
    const int jmax = 4 * qb + 3;
    const int srow = tid >> 3, sc8 = tid & 7;
    const bf16_t* srcK = proj + (rowb + srow) * AINW + 2048 + hs * 64 + sc8 * 8;
    const bf16_t* srcV = proj + (rowb + srow) * AINW + 2560 + hs * 64 + sc8 * 8;
    const int dstK = SB_K + srow * KST + sc8 * 16, dstV = SB_V + srow * VST64 + sc8 * 16;
    u32x4 pk_ = *(const u32x4*)(srcK + (size_t)jmax * 64 * AINW), pv_ = *(const u32x4*)(srcV + (size_t)jmax * 64 * AINW);
    *(LAS u32x4*)(lds + dstK) = pk_; *(LAS u32x4*)(lds + dstV) = pv_;
    __syncthreads();
    const int i16 = lane & 15, tq = i16 >> 2, tp = i16 & 3, g16 = (lane >> 4) & 1;
    const int troff = (4 * h + tq) * VST64 + (16 * g16 + 4 * tp) * 2;
    int it = 0;
    for (int j = jmax; j >= 0; --j, ++it) {
        const bool more = (j > 0);
        if (more) { pk_ = *(const u32x4*)(srcK + (size_t)(j - 1) * 64 * AINW); pv_ = *(const u32x4*)(srcV + (size_t)(j - 1) * 64 * AINW); }
        const LAS unsigned char* base = lds + (it & 1) * SB_STAGE;
        const int kbase = 64 * j;
        if (kbase < q0 + 32 * w + 32) {
#pragma unroll
            for (int kt = 1; kt >= 0; --kt) {
                f32x16 S = zero16();
#pragma unroll
                for (int s = 0; s < 4; ++s) { const bf16x8 kf = *(const LAS bf16x8*)(base + SB_K + (32 * kt + r) * KST + (16 * s + 8 * h) * 2); S = MFMA32(kf, qf[s], S); }
                float T[4], sfx[16];
#pragma unroll
                for (int gq = 0; gq < 4; ++gq) {
                    float run = 1.0f;
#pragma unroll
                    for (int jj = 3; jj >= 0; --jj) {
                        const int i = 4 * gq + jj; const bool valid = (kbase + 32 * kt + crow(i, h)) < qidx;
                        const float zz = fmaxf(S[i], -60.0f); const float e = fexp2(-LOG2E * zz); const float sg = frcp(1.0f + e);
                        const float keep = valid ? e * sg : 1.0f;
                        S[i] = valid ? sg : 0.0f; sfx[i] = run; run *= keep;
                    }
                    T[gq] = run;
                }
                float To[4];
#pragma unroll
                for (int gq = 0; gq < 4; ++gq) To[gq] = __shfl_xor(T[gq], 32);
                float E[4]; float acc_hi = 1.0f;
#pragma unroll
                for (int gq = 3; gq >= 0; --gq) {
                    const float above_same = acc_hi;
                    E[gq] = (h == 0) ? above_same * To[gq] : above_same;
                    acc_hi = acc_hi * T[gq] * To[gq];
                }
#pragma unroll
                for (int i = 0; i < 16; ++i) S[i] = S[i] * carry * E[i >> 2] * sfx[i];
                carry *= acc_hi;
#pragma unroll
                for (int s2 = 0; s2 < 2; ++s2) {
                    const bf16x8 pfr = pack8(S, s2);
                    const LAS unsigned char* vrow = base + SB_V + (32 * kt + 16 * s2) * VST64 + troff;
#pragma unroll
                    for (int vt = 0; vt < 2; ++vt) { const bf16x8 vf = tr2(vrow + vt * 64, vrow + 8 * VST64 + vt * 64); O[vt] = MFMA32(vf, pfr, O[vt]); }
                }
            }
        }
        if (more) { LAS unsigned char* nb = lds + ((it + 1) & 1) * SB_STAGE; *(LAS u32x4*)(nb + dstK) = pk_; *(LAS u32x4*)(nb + dstV) = pv_; }
        const int done = (kbase < q0 + 32 * w + 32) && (carry < 1e-12f);
        const bool wdone = (__builtin_amdgcn_ballot_w64(done != 0) == ~0ull);
        LAS int* flg = (LAS int*)(lds + 2 * SB_STAGE) + (it & 1) * 8;
        if (lane == 0) flg[w] = wdone ? 1 : 0;
        __syncthreads();
        int all = 1;
#pragma unroll
        for (int ww = 0; ww < 8; ++ww) all &= flg[ww];
        if (all) break;
    }
    bf16_t* op = mixed + (rowb + qidx) * DM + 512 + hs * 64;
#pragma unroll
    for (int vt = 0; vt < 2; ++vt)
#pragma unroll
        for (int gq = 0; gq < 4; ++gq) { const int v0 = 32 * vt + 8 * gq + 4 * h;
            u32x2 o; o[0] = pk2(O[vt][4 * gq], O[vt][4 * gq + 1]); o[1] = pk2(O[vt][4 * gq + 2], O[vt][4 * gq + 3]); *(u32x2*)(op + v0) = o; }
    __syncthreads();
}
DI void attn_phase(LAS unsigned char* lds, const Params& p) {
    const bf16_t* proj = (const bf16_t*)(p.ws + O_PROJ); bf16_t* mixed = (bf16_t*)(p.ws + O_MIXED);
    const float lam = *(const float*)(p.ws + O_LAM);
    for (int it0 = blockIdx.x; it0 < 256; it0 += gridDim.x) {
        const int it = (it0 & 7) * 32 + (it0 >> 3);
        const int b = it >> 7, hd = (it >> 5) & 3, pr = it & 31;
        diff_tile(lds, proj, mixed, p.in[7], lam, b, hd, 63 - pr);
        diff_tile(lds, proj, mixed, p.in[7], lam, b, hd, pr);
    }
    for (int it0 = blockIdx.x; it0 < 512; it0 += gridDim.x) {
        const int it = (it0 & 7) * 64 + (it0 >> 3);
        const int b = it >> 8, hs = (it >> 5) & 7, qb = it & 31;
        sb_block(lds, proj, mixed, b, hs, qb);
    }
}
constexpr int SXS = 528, SXS2 = 576, SBS = 272, SBS2 = 320;
constexpr int L_SX = 0, L_SB = 128 * SXS2, L_SC = L_SB + 128 * SBS, L_SDT = L_SC + 128 * SBS, L_SAC = L_SDT + 2048, L_SSQ = L_SAC + 2048;
static_assert(L_SSQ + 4096 <= LDS_BYTES, "lds");

DI void ssd_dt_acum(LAS unsigned char* lds, const float* DT, const float* dt_bias, const float* a_log, size_t t0, int g) {
    LAS float* sdt = (LAS float*)(lds + L_SDT); LAS float* sac = (LAS float*)(lds + L_SAC);
    const int tid = otid(), hh = tid >> 7, l = tid & 127, head = 4 * g + hh, w = tid >> 6, lane = tid & 63;
    const float raw = DT[(t0 + l) * 32 + head] + dt_bias[head];
    const float dt = fmaxf(raw, 0.f) + __logf(1.0f + __expf(-fabsf(raw)));
    sdt[hh * 128 + l] = dt; sac[hh * 128 + l] = -dt * __expf(a_log[head]);
    __syncthreads();
    if (w < 4) {
        const float v0 = sac[w * 128 + 2 * lane], v1 = sac[w * 128 + 2 * lane + 1]; float s = v0 + v1;
#pragma unroll
        for (int off = 1; off < 64; off <<= 1) { const float t = __shfl_up(s, off); if (lane >= off) s += t; }
        const float ex = s - (v0 + v1);
        sac[w * 128 + 2 * lane] = ex + v0; sac[w * 128 + 2 * lane + 1] = ex + v0 + v1;
    }
    __syncthreads();
}
template <int NT, class F> DI void conv_strip(const bf16_t* src, int nzero, const float* cw, const float* cb, int ch, F&& emit) {
    f32x4 wlo[4], whi[4];
#pragma unroll
    for (int k = 0; k < 4; ++k) { wlo[k] = *(const f32x4*)(cw + k * XBCW + ch); whi[k] = *(const f32x4*)(cw + k * XBCW + ch + 4); }
    const f32x4 blo = *(const f32x4*)(cb + ch), bhi = *(const f32x4*)(cb + ch + 4);
    u32x4 raw[NT + 3];
#pragma unroll
    for (int i = 0; i < NT + 3; ++i) { const int ii = (i < nzero) ? nzero : i; raw[i] = *(const u32x4*)(src + (ptrdiff_t)(ii - 3) * XBCW); if (i < nzero) raw[i] = (u32x4){0u, 0u, 0u, 0u}; }
#pragma unroll
    for (int t = 0; t < NT; ++t) {
        float o[8];
#pragma unroll
        for (int e = 0; e < 8; ++e) {
            float a = (e < 4) ? blo[e & 3] : bhi[e & 3];
#pragma unroll
            for (int k = 0; k < 4; ++k) { const unsigned d = raw[t + k][e >> 1]; const float xv = (e & 1) ? bfhi(d) : bflo(d); a += ((e < 4) ? wlo[k][e & 3] : whi[k][e & 3]) * xv; }
            o[e] = fsilu(a);
        }
        emit(t, o);
    }
}
DI u32x4 pack8f(const float* o) { u32x4 r; r[0] = pk2(o[0], o[1]); r[1] = pk2(o[2], o[3]); r[2] = pk2(o[4], o[5]); r[3] = pk2(o[6], o[7]); return r; }

template <bool XW, bool WITH_C> DI void ssd_stage(LAS unsigned char* lds, const bf16_t* xbc, const float* cw, const float* cb, size_t t0, int c, int g) {
    const int tid = otid();
    LAS float* sdt = (LAS float*)(lds + L_SDT); LAS float* sac = (LAS float*)(lds + L_SAC);
    {
        const int c8 = tid & 31, tg = tid >> 5, l0 = 8 * tg, ch = 256 * g + 8 * c8, hh = c8 >> 3;
        const int nzero = (c == 0) ? (3 - l0 > 0 ? 3 - l0 : 0) : 0;
        const float alast = sac[hh * 128 + 127];
        conv_strip<8>(xbc + (t0 + l0) * XBCW + ch, nzero, cw, cb, ch, [&](int t, float* o) {
            if (XW) { const float wgt = sdt[hh * 128 + l0 + t] * __expf(alast - sac[hh * 128 + l0 + t]);
#pragma unroll
                for (int e = 0; e < 8; ++e) o[e] *= wgt; }
            *(LAS u32x4*)(lds + L_SX + (l0 + t) * (XW ? SXS2 : SXS) + c8 * 16) = pack8f(o); });
    }
    {
        const int c8 = tid & 15, tg = tid >> 4, l0 = 4 * tg;
        const int nzero = (c == 0) ? (3 - l0 > 0 ? 3 - l0 : 0) : 0;
        const int chb = DIN + 128 * g + 8 * c8;
        conv_strip<4>(xbc + (t0 + l0) * XBCW + chb, nzero, cw, cb, chb, [&](int t, float* o) { *(LAS u32x4*)(lds + L_SB + (l0 + t) * (XW ? SBS2 : SBS) + c8 * 16) = pack8f(o); });
        if (WITH_C) { const int chc = DIN + 1024 + 128 * g + 8 * c8;
            conv_strip<4>(xbc + (t0 + l0) * XBCW + chc, nzero, cw, cb, chc, [&](int t, float* o) { *(LAS u32x4*)(lds + L_SC + (l0 + t) * SBS + c8 * 16) = pack8f(o); }); }
    }
}
DI bf16_t* st_ptr(unsigned char* ws, int b) { return (bf16_t*)(ws + (b ? O_ST1 : O_ST0)); }

DI void ssd_states_phase(LAS unsigned char* lds, const Params& p) {
    const int tid = otid(), w = __builtin_amdgcn_readfirstlane(tid >> 6), lane = tid & 63, r = lane & 31, h = lane >> 5, hh = w >> 1, ph = w & 1;
    const bf16_t* xbc = (const bf16_t*)(p.ws + O_XBC); const float* DT = (const float*)(p.ws + O_DT); float* cdec = (float*)(p.ws + O_CDEC);
    const int i16 = lane & 15, tq = i16 >> 2, tp = i16 & 3, g16 = (lane >> 4) & 1;
    for (int it = blockIdx.x; it < 1024; it += gridDim.x) {
        const int b = it >> 9, c = (it >> 3) & 63, g = it & 7; const size_t t0 = (size_t)b * SEQ + (size_t)c * 128;
        ssd_dt_acum(lds, DT, p.in[13], p.in[14], t0, g);
        ssd_stage<true, false>(lds, xbc, p.in[11], p.in[12], t0, c, g);
        __syncthreads();
        f32x16 acc[4];
#pragma unroll
        for (int i = 0; i < 4; ++i) acc[i] = zero16();
        const LAS unsigned char* xa = lds + L_SX + (8 * h + tq) * SXS2 + (64 * hh + 32 * ph + 16 * g16 + 4 * tp) * 2;
        const LAS unsigned char* ba = lds + L_SB + (8 * h + tq) * SBS2 + (16 * g16 + 4 * tp) * 2;
#pragma unroll
        for (int s = 0; s < 8; ++s) {
            const bf16x8 af = tr2(xa + 16 * s * SXS2, xa + (16 * s + 4) * SXS2);
#pragma unroll
            for (int nt = 0; nt < 4; ++nt) { const bf16x8 bfr = tr2(ba + 16 * s * SBS2 + nt * 64, ba + (16 * s + 4) * SBS2 + nt * 64); acc[nt] = MFMA32(af, bfr, acc[nt]); }
        }
        bf16_t* st = st_ptr(p.ws, b) + ((size_t)(c * 32 + 4 * g + hh) * 64 + 32 * ph) * 128;
#pragma unroll
        for (int nt = 0; nt < 4; ++nt)
#pragma unroll
            for (int i = 0; i < 16; ++i) st[(size_t)crow(i, h) * 128 + 32 * nt + r] = (bf16_t)(pk2(acc[nt][i], 0.f) & 0xffffu);
        if (tid < 4) cdec[(b * 64 + c) * 32 + 4 * g + tid] = __expf(((LAS float*)(lds + L_SAC))[tid * 128 + 127]);
        __syncthreads();
    }
}
DI void ssd_scan_phase(const Params& p, const bool dry) {
    const float* cdec = (const float*)(p.ws + O_CDEC);
    for (int e = blockIdx.x * 512 + threadIdx.x; e < 2 * 32 * 64 * 32; e += gridDim.x * 512) {
        const int b = e >> 16, rem = e & 65535, head = rem >> 11;
        bf16_t* st = st_ptr(p.ws, b) + (size_t)rem * 4;
        float carry[4] = {0.f, 0.f, 0.f, 0.f};
        for (int c0 = 0; c0 < 64; c0 += 8) {
            u32x2 v[8]; float dc[8];
#pragma unroll
            for (int u = 0; u < 8; ++u) { v[u] = *(const u32x2*)(st + (size_t)(c0 + u) * 262144); dc[u] = cdec[(b * 64 + c0 + u) * 32 + head]; }
#pragma unroll
            for (int u = 0; u < 8; ++u) {
                u32x2 o; o[0] = pk2(carry[0], carry[1]); o[1] = pk2(carry[2], carry[3]); if (!dry) *(u32x2*)(st + (size_t)(c0 + u) * 262144) = o;
                carry[0] = carry[0] * dc[u] + bflo(v[u][0]); carry[1] = carry[1] * dc[u] + bfhi(v[u][0]); carry[2] = carry[2] * dc[u] + bflo(v[u][1]); carry[3] = carry[3] * dc[u] + bfhi(v[u][1]);
            }
        }
    }
}
DI void ssd_out_phase(LAS unsigned char* lds, const Params& p, const bool dry) {
    const int tid = otid(), w = __builtin_amdgcn_readfirstlane(tid >> 6), lane = tid & 63, r = lane & 31, h = lane >> 5, hh = w >> 1, ph = w & 1;
    const bf16_t* xbc = (const bf16_t*)(p.ws + O_XBC); const float* DT = (const float*)(p.ws + O_DT); bf16_t* zy = (bf16_t*)p.out;
    LAS float* sdt = (LAS float*)(lds + L_SDT); LAS float* sac = (LAS float*)(lds + L_SAC); LAS float* ssq = (LAS float*)(lds + L_SSQ);
    const int i16 = lane & 15, tq = i16 >> 2, tp = i16 & 3, g16 = (lane >> 4) & 1;
    for (int it = blockIdx.x; it < 1024; it += gridDim.x) {
        const int b = it >> 9, c = (it >> 3) & 63, g = it & 7, head = 4 * g + hh; const size_t t0 = (size_t)b * SEQ + (size_t)c * 128;
        ssd_dt_acum(lds, DT, p.in[13], p.in[14], t0, g);
        ssd_stage<false, true>(lds, xbc, p.in[11], p.in[12], t0, c, g);
        bf16x8 pvf[8];
        { const bf16_t* pp = st_ptr(p.ws, b) + ((size_t)(c * 32 + head) * 64 + 32 * ph + r) * 128 + 8 * h;
#pragma unroll
          for (int s = 0; s < 8; ++s) pvf[s] = *(const bf16x8*)(pp + 16 * s); }
        __syncthreads();
        f32x16 Y[4];
        const LAS unsigned char* xa = lds + L_SX + (4 * h + tq) * SXS + (64 * hh + 32 * ph + 16 * g16 + 4 * tp) * 2;
#pragma unroll
        for (int lt = 0; lt < 4; ++lt) {
            __builtin_amdgcn_sched_barrier(0);
            f32x16 y = zero16();
#pragma unroll
            for (int s = 0; s < 8; ++s) { const bf16x8 cfs = *(const LAS bf16x8*)(lds + L_SC + (32 * lt + r) * SBS + (16 * s + 8 * h) * 2); y = MFMA32(pvf[s], cfs, y); }
            Y[lt] = y * __expf(sac[hh * 128 + 32 * lt + r]);
        }
#pragma unroll
        for (int lt = 0; lt < 4; ++lt) {
            __builtin_amdgcn_sched_barrier(0);
            bf16x8 cf[8];
#pragma unroll
            for (int s = 0; s < 8; ++s) cf[s] = *(const LAS bf16x8*)(lds + L_SC + (32 * lt + r) * SBS + (16 * s + 8 * h) * 2);
            const float al = sac[hh * 128 + 32 * lt + r];
#pragma unroll
            for (int mt = 0; mt < 4; ++mt) {
                if (mt <= lt) {
                    __builtin_amdgcn_sched_barrier(0);
                    f32x16 X = zero16();
#pragma unroll
                    for (int s = 0; s < 8; ++s) { const bf16x8 bfr = *(const LAS bf16x8*)(lds + L_SB + (32 * mt + r) * SBS + (16 * s + 8 * h) * 2); X = MFMA32(bfr, cf[s], X); }
#pragma unroll
                    for (int gq = 0; gq < 4; ++gq) {
                        const f32x4 am = *(const LAS f32x4*)(sac + hh * 128 + 32 * mt + 8 * gq + 4 * h), dm = *(const LAS f32x4*)(sdt + hh * 128 + 32 * mt + 8 * gq + 4 * h);
#pragma unroll
                        for (int jj = 0; jj < 4; ++jj) { const int mrow = 32 * mt + 8 * gq + 4 * h + jj; const bool ok = (32 * lt + r) >= mrow;
                            const float dec = ok ? __expf(fminf(al - am[jj], 0.f)) * dm[jj] : 0.f; X[4 * gq + jj] *= dec; }
                    }
#pragma unroll
                    for (int s2 = 0; s2 < 2; ++s2) { const bf16x8 xs = pack8(X, s2);
                        const LAS unsigned char* xr = xa + (32 * mt + 16 * s2) * SXS; const bf16x8 xf = tr2(xr, xr + 8 * SXS); Y[lt] = MFMA32(xf, xs, Y[lt]); }
                }
            }
        }
        __builtin_amdgcn_sched_barrier(0);
        const float Dh = p.in[15][head];
        float sq[4];
#pragma unroll
        for (int lt = 0; lt < 4; ++lt) {
            const int l = 32 * lt + r; sq[lt] = 0.f;
#pragma unroll
            for (int gq = 0; gq < 4; ++gq) {
                const int chl = 64 * hh + 32 * ph + 8 * gq + 4 * h;
                const u32x2 xv = *(const LAS u32x2*)(lds + L_SX + l * SXS + chl * 2);
                const u32x2 zv = *(const u32x2*)(zy + (t0 + l) * DIN + 256 * g + chl);
                const float xf4[4] = {bflo(xv[0]), bfhi(xv[0]), bflo(xv[1]), bfhi(xv[1])}, zf4[4] = {bflo(zv[0]), bfhi(zv[0]), bflo(zv[1]), bfhi(zv[1])};
#pragma unroll
                for (int jj = 0; jj < 4; ++jj) { const float yv = (Y[lt][4 * gq + jj] + Dh * xf4[jj]) * fsilu(zf4[jj]); Y[lt][4 * gq + jj] = yv; sq[lt] += yv * yv; }
            }
            sq[lt] += __shfl_xor(sq[lt], 32);
            if (h == 0) ssq[w * 128 + l] = sq[lt];
        }
        __syncthreads();
#pragma unroll
        for (int lt = 0; lt < 4; ++lt) {
            const int l = 32 * lt + r; float tot = 0.f;
#pragma unroll
            for (int ww = 0; ww < 8; ++ww) tot += ssq[ww * 128 + l];
            const float rn = __builtin_amdgcn_rsqf(tot * (1.0f / 256.0f) + 1e-5f);
#pragma unroll
            for (int gq = 0; gq < 4; ++gq) {
                const int chl = 64 * hh + 32 * ph + 8 * gq + 4 * h; const f32x4 gw = *(const f32x4*)(p.in[16] + 256 * g + chl);
                u32x2 o; o[0] = pk2(Y[lt][4 * gq] * rn * gw[0], Y[lt][4 * gq + 1] * rn * gw[1]); o[1] = pk2(Y[lt][4 * gq + 2] * rn * gw[2], Y[lt][4 * gq + 3] * rn * gw[3]);
                if (!dry) *(u32x2*)(zy + (t0 + l) * DIN + 256 * g + chl) = o;
            }
        }
        __syncthreads();
    }
}
DI void dt_proj(LAS unsigned char* lds, const Params& p) {
    const int tid = otid(), w = __builtin_amdgcn_readfirstlane(tid >> 6), lane = tid & 63, r = lane & 31, h = lane >> 5, rt = w & 1, kq = w >> 1;
    const bf16_t* hb = (const bf16_t*)(p.ws + O_HB); const bf16_t* wt = (const bf16_t*)(p.ws + W_SIN) + (size_t)6144 * DM;
    const float* ss = (const float*)(p.ws + O_SS) + 2 * MT; float* dt = (float*)(p.ws + O_DT);
    LAS float* part = (LAS float*)lds;
    for (int rb = blockIdx.x; rb < MT / 64; rb += gridDim.x) {
        const bf16_t* ap = hb + (size_t)(rb * 64 + rt * 32 + r) * DM + kq * 256 + 8 * h;
        const bf16_t* bp = wt + (size_t)r * DM + kq * 256 + 8 * h;
        bf16x8 af[16], bfr[16];
#pragma unroll
        for (int s = 0; s < 16; ++s) { af[s] = *(const bf16x8*)(ap + 16 * s); bfr[s] = *(const bf16x8*)(bp + 16 * s); }
        f32x16 acc = zero16();
#pragma unroll
        for (int s = 0; s < 16; ++s) acc = MFMA32(af[s], bfr[s], acc);
#pragma unroll
        for (int i = 0; i < 16; ++i) part[((kq * 2 + rt) * 32 + crow(i, h)) * 32 + r] = acc[i];
        __syncthreads();
#pragma unroll
        for (int q = 0; q < 4; ++q) {
            const int o = tid + 512 * q, row = o >> 5, col = o & 31;
            float v = 0.f;
#pragma unroll
            for (int k = 0; k < 4; ++k) v += part[((k * 2 + (row >> 5)) * 32 + (row & 31)) * 32 + col];
            const int grow = rb * 64 + row;
            dt[(size_t)grow * 32 + col] = v * __builtin_amdgcn_rsqf(ss[grow] * (1.0f / 1024.0f) + 1e-6f);
        }
        __syncthreads();
    }
}
template <class Epi> DI void run_gemm(LAS unsigned char* lds, const bf16_t* A, const bf16_t* Bt, int N, int K, const Epi& E) {
    pg8::Gemm g; g.A = A; g.Bt = Bt; g.M = MT; g.N = N; g.K = K;
    pg8::StaticOrder S; S.init(MT, N, (int)gridDim.x, (int)blockIdx.x);
    pg8::gemm_phase<Epi, pg8::StaticOrder, !Epi::AFTER_DRAIN, true>((PG8_LAS unsigned char*)lds, g, S, E);
}
#if defined(DRY_S3) || defined(DRY_S4)
#define DRYV (p.ws == nullptr)
#else
#define DRYV false
#endif
__global__ void __launch_bounds__(512, 2) fwd_megakernel(Params p) {
    extern __shared__ __attribute__((aligned(16))) unsigned char shm[];
    LAS unsigned char* lds = (LAS unsigned char*)shm;
    cg::grid_group grid = cg::this_grid();
    if (threadIdx.x < 4) ((LAS unsigned*)(lds + LDS_BYTES - 16))[threadIdx.x] = 0u;
    __syncthreads();
    const XcdBarrier xbar = xcd_barrier_post((unsigned*)(p.ws + O_BAR), (volatile LAS unsigned*)(lds + LDS_BYTES - 16));
#define GBAR() xcd_barrier(xbar)
    unsigned char* ws = p.ws;
    bf16_t* hb = (bf16_t*)(ws + O_HB); float* ss = (float*)(ws + O_SS);
    phase0(lds, p);
#ifdef DUP_P0
    GBAR(); phase0(lds, p);
#endif
    if (gridDim.x == 0x7fffffffu) grid.sync();
    GBAR();
    { EpiAttnIn E; E.O = (bf16_t*)(ws + O_PROJ); E.ss = ss; E.tab = (const f32x4*)(ws + O_ROPE); run_gemm(lds, hb, (const bf16_t*)(ws + W_AIN), AINW, DM, E); }
    GBAR();
    attn_phase(lds, p);
#ifdef DUP_ATTN
    GBAR(); attn_phase(lds, p);
#endif
    GBAR();
    { EpiRes<true, false> E; E.xres = p.in[0]; E.hb = hb; E.outf = nullptr; E.ssn = ss + MT; run_gemm(lds, (const bf16_t*)(ws + O_MIXED), (const bf16_t*)(ws + W_AOUT), DM, DM, E); }
    GBAR();
    { EpiGU E; E.act = (bf16_t*)(ws + O_ACT); E.ss = ss + MT; run_gemm(lds, hb, (const bf16_t*)(ws + W_GU0), 2 * DFF, DM, E); }
    GBAR();
    { EpiRes<false, false> E; E.xres = nullptr; E.hb = hb; E.outf = nullptr; E.ssn = ss + 2 * MT; run_gemm(lds, (const bf16_t*)(ws + O_ACT), (const bf16_t*)(ws + W_DN0), DM, DFF, E); }
    GBAR();
    { EpiSsdIn E; E.z = (bf16_t*)p.out; E.xbc = (bf16_t*)(ws + O_XBC); E.dt = (float*)(ws + O_DT); E.ss = ss + 2 * MT; dt_proj(lds, p); run_gemm(lds, hb, (const bf16_t*)(ws + W_SIN), 6144, DM, E); }
    GBAR();
    ssd_states_phase(lds, p);
#ifdef DUP_S2
    GBAR(); ssd_states_phase(lds, p);
#endif
    GBAR();
#ifdef DRY_S3
    ssd_scan_phase(p, p.ws != nullptr); GBAR();
#endif
    ssd_scan_phase(p, DRYV);
    GBAR();
#ifdef DRY_S4
    ssd_out_phase(lds, p, p.ws != nullptr); GBAR();
#endif
    ssd_out_phase(lds, p, DRYV);
    GBAR();
    { EpiRes<false, false> E; E.xres = nullptr; E.hb = hb; E.outf = nullptr; E.ssn = ss + 3 * MT; run_gemm(lds, (const bf16_t*)p.out, (const bf16_t*)(ws + W_SOUT), DM, DIN, E); }
    GBAR();
    { EpiGU E; E.act = (bf16_t*)(ws + O_ACT); E.ss = ss + 3 * MT; run_gemm(lds, hb, (const bf16_t*)(ws + W_GU1), 2 * DFF, DM, E); }
    GBAR();
    if (gridDim.x == 256) {
        EpiFinal E; E.hb = hb; E.outf = p.out; E.ssn = ss + 4 * MT; E.cnt = (unsigned*)(ws + O_BAR) + XCD_BAR_WORDS; E.fw = p.in[22];
        run_gemm(lds, (const bf16_t*)(ws + O_ACT), (const bf16_t*)(ws + W_DN1), DM, DFF, E);
    } else {
        { EpiRes<false, true> E; E.xres = nullptr; E.hb = hb; E.outf = p.out; E.ssn = ss + 4 * MT; run_gemm(lds, (const bf16_t*)(ws + O_ACT), (const bf16_t*)(ws + W_DN1), DM, DFF, E); }
        GBAR();
        const float* ss4 = ss + 4 * MT; const f32x4* fw = (const f32x4*)p.in[22]; f32x4* o4 = (f32x4*)p.out;
        for (int i = blockIdx.x * 512 + threadIdx.x; i < MT * (DM / 4); i += gridDim.x * 512) {
            const int row = i >> 8; const float rs = __builtin_amdgcn_rsqf(ss4[row] * (1.0f / 1024.0f) + 1e-6f);
            o4[i] = o4[i] * rs * fw[i & 255];
        }
    }
}

extern "C" void kernel_launch(void* const* d_in, const int* in_sizes, int n_in, void* d_out, int out_size, void* d_ws, size_t ws_size, hipStream_t stream) {
    static int grid_blocks = 0;
    if (!grid_blocks) {
        int dev = 0, cus = 0, per_cu = 0;
        hipGetDevice(&dev);
        hipDeviceGetAttribute(&cus, hipDeviceAttributeMultiprocessorCount, dev);
        if (hipFuncSetAttribute((const void*)fwd_megakernel, hipFuncAttributeMaxDynamicSharedMemorySize, LDS_BYTES) != hipSuccess) fprintf(stderr, "hipFuncSetAttribute failed\n");
        if (hipOccupancyMaxActiveBlocksPerMultiprocessor(&per_cu, (const void*)fwd_megakernel, 512, LDS_BYTES) != hipSuccess || per_cu < 1) { fprintf(stderr, "occupancy query: %d\n", per_cu); per_cu = 1; }
        (void)hipGetLastError();
        grid_blocks = cus * per_cu;
        if (ws_size < 268435456ull || n_in != 23) fprintf(stderr, "unexpected ws_size %zu / n_in %d\n", ws_size, n_in);
    }
    if (hipMemsetAsync((char*)d_ws + O_BAR, 0, 20480, stream) != hipSuccess) fprintf(stderr, "memset failed\n");
    Params p{};
    for (int i = 0; i < 23; ++i) p.in[i] = (const float*)d_in[i];
    p.out = (float*)d_out; p.ws = (unsigned char*)d_ws;
    void* args[] = {&p};
    hipError_t e = hipLaunchCooperativeKernel((const void*)fwd_megakernel, dim3(grid_blocks), dim3(512), args, LDS_BYTES, stream);
    if (e != hipSuccess) fprintf(stderr, "cooperative launch failed: %s (grid %d)\n", hipGetErrorString(e), grid_blocks);
}
#ifdef PHASE_TEST
__global__ void __launch_bounds__(512, 2) t_phase0(Params p) { extern __shared__ __attribute__((aligned(16))) unsigned char shm[]; phase0((LAS unsigned char*)shm, p); }
__global__ void __launch_bounds__(512, 2) t_attn_diff(Params p) { extern __shared__ __attribute__((aligned(16))) unsigned char shm[]; diff_tile((LAS unsigned char*)shm, (const bf16_t*)(p.ws + O_PROJ), (bf16_t*)(p.ws + O_MIXED), p.in[7], 0.3f, blockIdx.x & 1, blockIdx.y, blockIdx.z); }
__global__ void __launch_bounds__(512, 2) t_attn_sb(Params p) { extern __shared__ __attribute__((aligned(16))) unsigned char shm[]; sb_block((LAS unsigned char*)shm, (const bf16_t*)(p.ws + O_PROJ), (bf16_t*)(p.ws + O_MIXED), blockIdx.x & 1, blockIdx.y, blockIdx.z); }
__global__ void __launch_bounds__(512, 2) t_ssd_states(Params p) { extern __shared__ __attribute__((aligned(16))) unsigned char shm[]; ssd_states_phase((LAS unsigned char*)shm, p); }
__global__ void __launch_bounds__(512, 2) t_ssd_scan(Params p) { ssd_scan_phase(p, false); }
__global__ void __launch_bounds__(512, 2) t_ssd_out(Params p) { extern __shared__ __attribute__((aligned(16))) unsigned char shm[]; ssd_out_phase((LAS unsigned char*)shm, p, false); }
__global__ void __launch_bounds__(512, 2) t_gemm_ain(Params p) { extern __shared__ __attribute__((aligned(16))) unsigned char shm[]; EpiAttnIn E; E.O = (bf16_t*)(p.ws + O_PROJ); E.ss = (float*)(p.ws + O_SS); E.tab = (const f32x4*)(p.ws + O_ROPE); run_gemm((LAS unsigned char*)shm, (bf16_t*)(p.ws + O_HB), (const bf16_t*)(p.ws + W_AIN), AINW, DM, E); }
__global__ void __launch_bounds__(512, 2) t_gemm_res(Params p) { extern __shared__ __attribute__((aligned(16))) unsigned char shm[]; EpiRes<false, false> E; E.xres = nullptr; E.hb = (bf16_t*)(p.ws + O_HB); E.outf = nullptr; E.ssn = (float*)(p.ws + O_SS); run_gemm((LAS unsigned char*)shm, (bf16_t*)(p.ws + O_ACT), (const bf16_t*)(p.ws + W_DN0), DM, DFF, E); }
__global__ void __launch_bounds__(512, 2) t_gemm_gu(Params p) { extern __shared__ __attribute__((aligned(16))) unsigned char shm[]; EpiGU E; E.act = (bf16_t*)(p.ws + O_ACT); E.ss = (float*)(p.ws + O_SS); run_gemm((LAS unsigned char*)shm, (bf16_t*)(p.ws + O_HB), (const bf16_t*)(p.ws + W_GU0), 2 * DFF, DM, E); }
__global__ void __launch_bounds__(512, 2) t_gemm_ssdin(Params p) { extern __shared__ __attribute__((aligned(16))) unsigned char shm[]; EpiSsdIn E; E.z = (bf16_t*)p.out; E.xbc = (bf16_t*)(p.ws + O_XBC); E.dt = (float*)(p.ws + O_DT); E.ss = (float*)(p.ws + O_SS); run_gemm((LAS unsigned char*)shm, (bf16_t*)(p.ws + O_HB), (const bf16_t*)(p.ws + W_SIN), SINWP, DM, E); }
#endif
```

```cpp
#include <hip/hip_runtime.h>
#include <hip/hip_cooperative_groups.h>
#include <cstdio>
#include <cstdint>
namespace cg = cooperative_groups;
namespace pg8 {
#define PG8_LAS __attribute__((address_space(3)))
typedef unsigned short bf16_t;
typedef short bf16x8 __attribute__((ext_vector_type(8)));
typedef float f32x4 __attribute__((ext_vector_type(4)));
typedef unsigned u32x4 __attribute__((ext_vector_type(4)));
constexpr int BM = 256, BK = 64, HALF = 128, HTB = HALF * BK * 2  , STAGE_BYTES = 8 * HTB, NXCD = 8, WGM = 8;

__host__ __device__ __forceinline__ int lds_byte(int r, int c) { const int st = (r >> 4) * 2 + (c >> 5), rr = r & 15, cc = c & 31, ob = rr * 64 + cc * 2; return st * 1024 + (ob ^ (((ob >> 9) & 1) << 5)); }
__host__ __device__ __forceinline__ void stage_rc(int b, int& R, int& C) { const int st = b / 1024, sb = b % 1024, swz = sb ^ (((sb >> 9) & 1) << 5); R = (st >> 1) * 16 + swz / 64; C = (st & 1) * 32 + (swz % 64) / 2; }
__host__ __device__ __forceinline__ int perm32(int rho) { const int n = rho >> 4, i = rho & 15; return 8 * (i >> 2) + 4 * n + (i & 3); }

struct Unit { int pm, pn; };
struct Gemm { const bf16_t* A; const bf16_t* Bt; int M, N, K; };

struct StaticOrder {
    int nM, nN, nwg, G, c;
    __host__ __device__ void init(int M, int N, int G_, int c_) { nM = M / BM; nN = N / BM; nwg = nM * nN; G = G_; c = c_; }
    __host__ __device__ bool next(int i, Unit& u) const {
        const long L = (long)i * G + c; if (L >= nwg) return false;
        int wgid = (int)L; { const int q = nwg / NXCD, r = nwg % NXCD, xcd = wgid % NXCD, off = wgid / NXCD; wgid = (xcd < r ? xcd * (q + 1) : r * (q + 1) + (xcd - r) * q) + off; }
        const int nig = WGM * nN, gid = wgid / nig, fm = gid * WGM, gsz = (nM - fm) < WGM ? (nM - fm) : WGM;
        u.pm = fm + ((wgid % nig) % gsz); u.pn = (wgid % nig) / gsz; return true;
    }
    __device__ __forceinline__ void a_ready(const Unit&) const {}
    __device__ __forceinline__ void done(const Unit&) const {}
};

template <class Epi, class Sched, bool ALIGN_EPI = false, bool SP2 = false>
__device__ __forceinline__ void gemm_phase(PG8_LAS unsigned char* lds, const Gemm g, const Sched& S, const Epi& E) {
    int tid_ = threadIdx.x; asm volatile("" : "+v"(tid_)); const int tid = tid_, wid = __builtin_amdgcn_readfirstlane(tid >> 6), lane = tid & 63, wr = wid >> 2, wc = wid & 3, fr = lane & 15, fq = lane >> 4;
    const int K = g.K, nt = K / BK;
    unsigned voffA[2], voffB[2];
#pragma unroll
    for (int i = 0; i < 2; ++i) { int R, C; stage_rc(tid * 16 + i * 8192, R, C); const int Rb = Epi::PERM ? ((R & ~31) + perm32(R & 31)) : R;
        voffA[i] = (unsigned)(R * K + C) * 2u; voffB[i] = (unsigned)(Rb * K + C) * 2u; }
    const size_t kstep = (size_t)(BK * 2);
    const size_t hstep = (size_t)HALF * K * 2;
    const size_t tstep = 2 * hstep;
    const unsigned ldsw = (unsigned)wid * 1024u;
    const int aoff = lds_byte(wr * 64 + fr, fq * 8), boff = lds_byte(wc * 32 + fr, fq * 8);
#define PG8_SA(b, h) (((b) * 2 + (h)) * HTB)
#define PG8_SB(b, h) ((4 + (b) * 2 + (h)) * HTB)
#define PG8_STAGE(bufoff, gbase, voff) do { _Pragma("unroll") for (int _i = 0; _i < 2; ++_i) \
        __builtin_amdgcn_global_load_lds((const unsigned*)((const char*)(gbase) + (voff)[_i]), (PG8_LAS unsigned*)(lds + (bufoff) + ldsw + _i * 8192), 16, 0, 0); } while (0)
#define PG8_LDA(dst, b, h) do { _Pragma("unroll") for (int m = 0; m < 4; ++m) _Pragma("unroll") for (int k = 0; k < 2; ++k) dst[m][k] = *(const PG8_LAS bf16x8*)(lds + PG8_SA(b, h) + aoff + m * 2048 + k * 1024); } while (0)
#define PG8_LDB(dst, b, h) do { _Pragma("unroll") for (int n = 0; n < 2; ++n) _Pragma("unroll") for (int k = 0; k < 2; ++k) dst[n][k] = *(const PG8_LAS bf16x8*)(lds + PG8_SB(b, h) + boff + n * 2048 + k * 1024); } while (0)
#define PG8_MMA(ai, bj, At, Bt) do { __builtin_amdgcn_s_setprio(1); _Pragma("unroll") for (int m = 0; m < 4; ++m) _Pragma("unroll") for (int n = 0; n < 2; ++n) _Pragma("unroll") for (int k = 0; k < 2; ++k) \
        acc[ai][bj][m][n] = __builtin_amdgcn_mfma_f32_16x16x32_bf16(Bt[n][k], At[m][k], acc[ai][bj][m][n], 0, 0, 0); __builtin_amdgcn_s_setprio(0); } while (0)
#define PG8_WAIT_V(n) asm volatile("s_waitcnt vmcnt(" #n ")" ::: "memory")
#define PG8_WAIT_L(n) asm volatile("s_waitcnt lgkmcnt(" #n ")" ::: "memory")
#define PG8_BAR __builtin_amdgcn_s_barrier()
#define PG8_SCHED __builtin_amdgcn_sched_barrier(0)
    Unit cur, nxt; int ui = 0;
    if (!S.next(0, cur)) return;
    f32x4 acc[2][2][4][2];
#pragma unroll
    for (int a = 0; a < 2; ++a)
#pragma unroll
        for (int b = 0; b < 2; ++b)
#pragma unroll
            for (int m = 0; m < 4; ++m)
#pragma unroll
                for (int n = 0; n < 2; ++n) acc[a][b][m][n] = (f32x4){0.f, 0.f, 0.f, 0.f};
    bf16x8 At[4][2], B0[2][2], B1[2][2];
    float epre[8]; E.pre(cur, wr, fr, epre);
    const char* cA = (const char*)g.A + (size_t)cur.pm * tstep; const char* cB = (const char*)g.Bt + (size_t)cur.pn * tstep;
    S.a_ready(cur);
    if constexpr (SP2) {
        PG8_STAGE(PG8_SB(0, 0), cB, voffB); PG8_STAGE(PG8_SB(0, 1), cB + hstep, voffB); PG8_STAGE(PG8_SA(0, 0), cA, voffA); PG8_STAGE(PG8_SA(0, 1), cA + hstep, voffA);
        if (wr == 1) PG8_BAR;
        PG8_WAIT_V(2); PG8_BAR;
        PG8_STAGE(PG8_SB(1, 0), cB + kstep, voffB); PG8_STAGE(PG8_SA(1, 0), cA + kstep, voffA); PG8_STAGE(PG8_SB(1, 1), cB + hstep + kstep, voffB);
        PG8_WAIT_V(6); PG8_BAR;
    } else {
        PG8_STAGE(PG8_SB(0, 0), cB, voffB); PG8_STAGE(PG8_SA(0, 0), cA, voffA); PG8_STAGE(PG8_SB(0, 1), cB + hstep, voffB); PG8_STAGE(PG8_SA(0, 1), cA + hstep, voffA);
        if (wr == 1) PG8_BAR;
        PG8_WAIT_V(4); PG8_BAR;
        PG8_STAGE(PG8_SB(1, 0), cB + kstep, voffB); PG8_STAGE(PG8_SA(1, 0), cA + kstep, voffA); PG8_STAGE(PG8_SB(1, 1), cB + hstep + kstep, voffB);
        PG8_WAIT_V(6); PG8_BAR;
    }
    for (;;) {
        const bool has_next = S.next(ui + 1, nxt);
        const char* nA = has_next ? (const char*)g.A + (size_t)nxt.pm * tstep : cA; const char* nB = has_next ? (const char*)g.Bt + (size_t)nxt.pn * tstep : cB;
        for (int t = 0; t < nt; t += 2) {
            const bool last = (t == nt - 2);
            const char* a1 = cA + (size_t)(t + 1) * kstep;
            const char* a2 = last ? nA : cA + (size_t)(t + 2) * kstep; const char* b2 = last ? nB : cB + (size_t)(t + 2) * kstep;
            const char* a3 = a2 + kstep; const char* b3 = b2 + kstep;
            if (last && has_next) S.a_ready(nxt);
            if constexpr (SP2) {
            PG8_LDB(B0, 0, 0); PG8_LDB(B1, 0, 1); PG8_SCHED; PG8_LDA(At, 0, 0); PG8_STAGE(PG8_SA(1, 1), a1 + hstep, voffA);
            PG8_WAIT_V(8); PG8_WAIT_L(0); PG8_BAR; PG8_MMA(0, 0, At, B0); PG8_MMA(0, 1, At, B1); PG8_BAR; PG8_SCHED;
            PG8_LDA(At, 0, 1); PG8_STAGE(PG8_SB(0, 0), b2, voffB); PG8_STAGE(PG8_SB(0, 1), b2 + hstep, voffB); PG8_STAGE(PG8_SA(0, 0), a2, voffA);
            PG8_WAIT_V(8); PG8_WAIT_L(0); PG8_BAR; PG8_MMA(1, 0, At, B0); PG8_MMA(1, 1, At, B1); PG8_BAR; PG8_SCHED;
            PG8_LDB(B0, 1, 0); PG8_LDB(B1, 1, 1); PG8_SCHED; PG8_LDA(At, 1, 0); PG8_STAGE(PG8_SA(0, 1), a2 + hstep, voffA);
            PG8_WAIT_V(8); PG8_WAIT_L(0); PG8_BAR; PG8_MMA(0, 0, At, B0); PG8_MMA(0, 1, At, B1); PG8_BAR; PG8_SCHED;
            PG8_LDA(At, 1, 1); PG8_STAGE(PG8_SB(1, 0), b3, voffB); PG8_STAGE(PG8_SB(1, 1), b3 + hstep, voffB); PG8_STAGE(PG8_SA(1, 0), a3, voffA);
            PG8_WAIT_V(8); PG8_WAIT_L(0); PG8_BAR; PG8_MMA(1, 0, At, B0); PG8_MMA(1, 1, At, B1); PG8_BAR; PG8_SCHED;
            } else {
            PG8_LDB(B0, 0, 0); PG8_SCHED; PG8_LDA(At, 0, 0); PG8_STAGE(PG8_SA(1, 1), a1 + hstep, voffA);
            PG8_WAIT_L(8); PG8_BAR; PG8_WAIT_L(0); PG8_MMA(0, 0, At, B0); PG8_BAR; PG8_SCHED;
            PG8_LDB(B1, 0, 1); PG8_STAGE(PG8_SB(0, 0), b2, voffB);
            PG8_BAR; PG8_WAIT_L(0); PG8_MMA(0, 1, At, B1); PG8_BAR;
            PG8_LDA(At, 0, 1); PG8_STAGE(PG8_SA(0, 0), a2, voffA);
            PG8_BAR; PG8_WAIT_L(0); PG8_MMA(1, 0, At, B0); PG8_BAR; PG8_SCHED;
            PG8_STAGE(PG8_SB(0, 1), b2 + hstep, voffB);
            PG8_WAIT_V(6); PG8_BAR; PG8_MMA(1, 1, At, B1); PG8_BAR;
            PG8_LDB(B0, 1, 0); PG8_SCHED; PG8_LDA(At, 1, 0); PG8_STAGE(PG8_SA(0, 1), a2 + hstep, voffA);
            PG8_WAIT_L(8); PG8_BAR; PG8_WAIT_L(0); PG8_MMA(0, 0, At, B0); PG8_BAR; PG8_SCHED;
            PG8_LDB(B1, 1, 1); PG8_STAGE(PG8_SB(1, 0), b3, voffB);
            PG8_BAR; PG8_WAIT_L(0); PG8_MMA(0, 1, At, B1); PG8_BAR;
            PG8_LDA(At, 1, 1); PG8_STAGE(PG8_SA(1, 0), a3, voffA);
            PG8_BAR; PG8_WAIT_L(0); PG8_MMA(1, 0, At, B0); PG8_BAR; PG8_SCHED;
            PG8_STAGE(PG8_SB(1, 1), b3 + hstep, voffB);
            PG8_WAIT_V(6); PG8_BAR; PG8_MMA(1, 1, At, B1); PG8_BAR;
            }
        }
        if constexpr (ALIGN_EPI) { if (wr == 0) PG8_BAR; }
        if constexpr (!Epi::AFTER_DRAIN) { E(acc, cur, wr, wc, fr, fq, epre); S.done(cur); }
        if (!has_next) break;
        E.pre(nxt, wr, fr, epre);
#pragma unroll
        for (int a = 0; a < 2; ++a)
#pragma unroll
            for (int b = 0; b < 2; ++b)
#pragma unroll
                for (int m = 0; m < 4; ++m)
#pragma unroll
                    for (int n = 0; n < 2; ++n) acc[a][b][m][n] = (f32x4){0.f, 0.f, 0.f, 0.f};
        cur = nxt; cA = nA; cB = nB; ++ui;
        if constexpr (ALIGN_EPI) { if (wr == 1) PG8_BAR; }
    }
    PG8_WAIT_V(0);
    if constexpr (!ALIGN_EPI) { if (wr == 0) PG8_BAR; }
    PG8_BAR;
    if constexpr (Epi::AFTER_DRAIN) { E.fused(acc, cur, wr, wc, fr, fq, lds, wid, lane); S.done(cur); }
#undef PG8_SA
#undef PG8_SB
#undef PG8_STAGE
#undef PG8_LDA
#undef PG8_LDB
#undef PG8_MMA
#undef PG8_WAIT_V
#undef PG8_WAIT_L
#undef PG8_BAR
#undef PG8_SCHED
}
}
using pg8::bf16_t; using pg8::bf16x8; using pg8::f32x4;
typedef short s16x4 __attribute__((ext_vector_type(4)));
typedef float f32x16 __attribute__((ext_vector_type(16)));
typedef float f32x2 __attribute__((ext_vector_type(2)));
typedef __bf16 bf2_t __attribute__((ext_vector_type(2)));
typedef unsigned u32x2 __attribute__((ext_vector_type(2)));
typedef unsigned u32x4 __attribute__((ext_vector_type(4)));
#define LAS __attribute__((address_space(3)))
#define DI __device__ __forceinline__
#define MFMA32(a, b, c) __builtin_amdgcn_mfma_f32_32x32x16_bf16((a), (b), (c), 0, 0, 0)

DI int otid() { int t = threadIdx.x; asm volatile("" : "+v"(t)); return t; }
DI unsigned pk2(float a, float b) { f32x2 v = {a, b}; bf2_t r = __builtin_convertvector(v, bf2_t); return __builtin_bit_cast(unsigned, r); }
DI float bflo(unsigned u) { return __uint_as_float(u << 16); }
DI float bfhi(unsigned u) { return __uint_as_float(u & 0xffff0000u); }
DI float fexp2(float x) { return __builtin_amdgcn_exp2f(x); }
DI float frcp(float x) { return __builtin_amdgcn_rcpf(x); }
DI float fsilu(float x) { return x * frcp(1.0f + fexp2(-1.44269504089f * x)); }
DI int crow(int i, int h) { return (i & 3) + 8 * (i >> 2) + 4 * h; }
DI s16x4 trr(const LAS unsigned char* p) { return __builtin_amdgcn_ds_read_tr16_b64_v4i16((LAS s16x4*)p); }
DI bf16x8 tr2(const LAS unsigned char* p0, const LAS unsigned char* p1) { s16x4 a = trr(p0), b = trr(p1); return __builtin_shufflevector(a, b, 0, 1, 2, 3, 4, 5, 6, 7); }
DI bf16x8 pack8(const f32x16& x, int s) {
    u32x4 p; p[0] = pk2(x[8 * s], x[8 * s + 1]); p[1] = pk2(x[8 * s + 2], x[8 * s + 3]); p[2] = pk2(x[8 * s + 4], x[8 * s + 5]); p[3] = pk2(x[8 * s + 6], x[8 * s + 7]);
    return __builtin_bit_cast(bf16x8, p);
}
DI f32x16 zero16() { f32x16 z; for (int i = 0; i < 16; ++i) z[i] = 0.f; return z; }

constexpr int MT = 16384, SEQ = 8192, DM = 1024, DFF = 2816, AINW = 3072, SINW = 6176, SINWP = 6400, DIN = 2048, XBCW = 4096;
constexpr float LOG2E = 1.44269504089f;
constexpr int LDS_BYTES = 155648;
constexpr size_t W_AIN = 0, W_AOUT = W_AIN + (size_t)AINW * DM * 2, W_GU0 = W_AOUT + (size_t)DM * DM * 2, W_DN0 = W_GU0 + (size_t)2 * DFF * DM * 2,
                 W_SIN = W_DN0 + (size_t)DM * DFF * 2, W_SOUT = W_SIN + (size_t)SINWP * DM * 2, W_GU1 = W_SOUT + (size_t)DM * DIN * 2, W_DN1 = W_GU1 + (size_t)2 * DFF * DM * 2,
                 O_HB = W_DN1 + (size_t)DM * DFF * 2, O_SS = O_HB + (size_t)MT * DM * 2, O_ROPE = O_SS + (size_t)5 * MT * 4, O_DT = O_ROPE + (size_t)SEQ * 32 * 8,
                 O_CDEC = O_DT + (size_t)MT * 32 * 4, O_LAM = O_CDEC + 16384, O_BAR = O_LAM + 256, O_R = 98566144;
static_assert(O_BAR + 20480 <= O_R, "map");
constexpr size_t O_PROJ = O_R, O_MIXED = O_PROJ + (size_t)MT * AINW * 2, O_ACT = O_R, O_XBC = O_R, O_ST1 = O_XBC + (size_t)MT * XBCW * 2, O_ST0 = 0;
constexpr size_t ST_BATCH = (size_t)64 * 32 * 64 * 128;
static_assert(O_ST1 + ST_BATCH * 2 <= 268435456ull, "ws");
static_assert(ST_BATCH * 2 <= W_SOUT, "st0 overlay");
static_assert(O_MIXED + (size_t)MT * DM * 2 <= 268435456ull, "ws2");

struct Params { const float* in[23]; float* out; unsigned char* ws; };
#include <cstdlib>
#include <vector>

#define XB_TMO      128
#define XB_XCNT(j)  (256  + 64 * (j))
#define XB_XSUB(j)  (1280 + 64 * (j))
#define XB_XGEN(j)  (2304 + 64 * (j))
#define XB_TOP      3328
#define XB_TOPGEN   3392
#define XCD_BAR_WORDS 3456
#define XB_SPIN_CAP (1u << 18)

__device__ __forceinline__ unsigned xb_ld(unsigned* p)              { return __hip_atomic_load(p, __ATOMIC_RELAXED, __HIP_MEMORY_SCOPE_AGENT); }
__device__ __forceinline__ unsigned xb_add(unsigned* p, unsigned v) { return __hip_atomic_fetch_add(p, v, __ATOMIC_RELAXED, __HIP_MEMORY_SCOPE_AGENT); }
__device__ __forceinline__ unsigned xb_xcc_id() { return (unsigned)__builtin_amdgcn_s_getreg((3 << 11) | 20) & 0xFu; }
#define XB_SPIN(cond, bar) do { unsigned _sp = 0; while (cond) { \
    if ((++_sp & 255u) == 0u) { if (xb_ld(&(bar)[XB_TMO])) break; if (_sp > XB_SPIN_CAP) { atomicAdd(&(bar)[XB_TMO], 1u); break; } } } } while (0)

struct XcdBarrier {
    unsigned* bar; unsigned x;
    volatile LAS unsigned* st;
};

__device__ __forceinline__ XcdBarrier xcd_barrier_post(unsigned* bar, volatile LAS unsigned* st) {
    XcdBarrier b; b.bar = bar; b.x = xb_xcc_id(); b.st = st;
    if (threadIdx.x == 0) (void)xb_add(&bar[XB_XCNT(b.x)], 1u);
    return b;
}
__device__ __forceinline__ void xcd_barrier_complete(unsigned* bar, unsigned x, unsigned& nloc, unsigned& nx) {
    const unsigned G = gridDim.x * gridDim.y * gridDim.z;
    unsigned sum, cnt, mine, sp = 0u;
    for (;;) {
        sum = 0u; cnt = 0u; mine = 0u;
#pragma unroll
        for (unsigned j = 0; j < 16; ++j) { const unsigned c = xb_ld(&bar[XB_XCNT(j)]); sum += c; cnt += (c > 0u) ? 1u : 0u; mine = (j == x) ? c : mine; }
        if (sum == G) break;
        __builtin_amdgcn_s_sleep(1);
        if ((++sp & 255u) == 0u) { if (xb_ld(&bar[XB_TMO])) break; if (sp > XB_SPIN_CAP) { atomicAdd(&bar[XB_TMO], 1u); break; } }
    }
    nloc = mine > 0u ? mine : 1u; nx = cnt > 0u ? cnt : 1u;
}

__device__ __forceinline__ void xcd_barrier(const XcdBarrier& b) {
    asm volatile("s_waitcnt vmcnt(0)" ::: "memory");
    __syncthreads();
    if (threadIdx.x == 0) {
        unsigned* bar = b.bar;
        __builtin_amdgcn_s_waitcnt(0);
        unsigned nloc = b.st[0], nx = b.st[1];
        if (nloc == 0u) { xcd_barrier_complete(bar, b.x, nloc, nx); b.st[0] = nloc; b.st[1] = nx; }
        const unsigned old = xb_add(&bar[XB_XSUB(b.x)], 1u);
        const unsigned gen = old / nloc;
        if (old + 1u == (gen + 1u) * nloc) {
            __builtin_amdgcn_fence(__ATOMIC_RELEASE, "agent");
            asm volatile("s_waitcnt vmcnt(0)" ::: "memory");
            const unsigned og = xb_add(&bar[XB_TOP], 1u);
            const unsigned tg = og / nx;
            if (og + 1u == (tg + 1u) * nx) xb_add(&bar[XB_TOPGEN], 1u);
            else XB_SPIN(xb_ld(&bar[XB_TOPGEN]) == tg, bar);
            __builtin_amdgcn_fence(__ATOMIC_ACQUIRE, "agent");
            xb_add(&bar[XB_XGEN(b.x)], 1u);
            asm volatile("s_waitcnt vmcnt(0)" ::: "memory");
        } else {
            XB_SPIN(xb_ld(&bar[XB_XGEN(b.x)]) == gen, bar);
            __builtin_amdgcn_fence(__ATOMIC_ACQUIRE, "agent");
            asm volatile("s_waitcnt vmcnt(0)" ::: "memory");
        }
    }
    __syncthreads();
}
DI void wmap(int mode, int c, int& src, float& scale, int& which) {
    src = c; scale = 1.f; which = 0;
    if (mode == 0) {
        if (c < 1024) { const int base = c & ~63, cc = c & 63, g = cc >> 3, e = cc & 7; src = base + (e < 4 ? 4 * g + e : 32 + 4 * g + (e - 4)); }
        if (c < 512) scale = 0.125f * LOG2E; else if (c >= 1536 && c < 2048) scale = 0.125f;
    } else if (mode == 2) { src = 128 * (c >> 8) + (c & 127); which = (c >> 7) & 1; }
    else if (mode == 3) { if (c >= SINW) src = -1; }
}
struct WJob { int mode, K, ldw, tix; const float* W0; const float* W1; const float* ks; bf16_t* dst; };
DI WJob wjob(const Params& p, int t) {
    unsigned char* ws = p.ws;
    const int cnt[8] = {48 * 4, 16 * 4, 88 * 4, 16 * 11, 100 * 4, 16 * 8, 88 * 4, 16 * 11};
    int j = 0, tt = t;
#pragma unroll
    for (int q = 0; q < 7; ++q) if (j == q && tt >= cnt[q]) { tt -= cnt[q]; j = q + 1; }
    WJob J; J.tix = tt; J.W1 = nullptr; J.ks = nullptr;
    switch (j) {
    case 0: J.mode = 0; J.W0 = p.in[2]; J.ks = p.in[1]; J.dst = (bf16_t*)(ws + W_AIN); J.K = DM; J.ldw = AINW; break;
    case 1: J.mode = 1; J.W0 = p.in[8]; J.dst = (bf16_t*)(ws + W_AOUT); J.K = DM; J.ldw = DM; break;
    case 2: J.mode = 2; J.W0 = p.in[19]; J.W1 = p.in[20]; J.ks = p.in[18]; J.dst = (bf16_t*)(ws + W_GU0); J.K = DM; J.ldw = DFF; break;
    case 3: J.mode = 1; J.W0 = p.in[21]; J.dst = (bf16_t*)(ws + W_DN0); J.K = DFF; J.ldw = DM; break;
    case 4: J.mode = 3; J.W0 = p.in[10]; J.ks = p.in[9]; J.dst = (bf16_t*)(ws + W_SIN); J.K = DM; J.ldw = SINW; break;
    case 5: J.mode = 1; J.W0 = p.in[17]; J.dst = (bf16_t*)(ws + W_SOUT); J.K = DIN; J.ldw = DM; break;
    case 6: J.mode = 2; J.W0 = p.in[19] + (size_t)DM * DFF; J.W1 = p.in[20] + (size_t)DM * DFF; J.ks = p.in[18] + DM; J.dst = (bf16_t*)(ws + W_GU1); J.K = DM; J.ldw = DFF; break;
    default: J.mode = 1; J.W0 = p.in[21] + (size_t)DFF * DM; J.dst = (bf16_t*)(ws + W_DN1); J.K = DFF; J.ldw = DM; break;
    }
    return J;
}
DI void wtile_load(const WJob& J, int tid, float (&v)[32], float& sc, int& srcok) {
    const int nk = J.K >> 8, c0 = (J.tix / nk) * 64, k0 = (J.tix % nk) * 256, cc = tid & 63; int src, which; wmap(J.mode, c0 + cc, src, sc, which);
    const float* W = (which ? J.W1 : J.W0) + (src >= 0 ? src : 0); srcok = (src >= 0);
#pragma unroll
    for (int i = 0; i < 32; ++i) { const int kk = (tid >> 6) + 8 * i; v[i] = W[(size_t)(k0 + kk) * J.ldw]; }
}
DI void wtile_store(LAS float* tile, const WJob& J, int tid, const float (&v)[32], float sc, int srcok) {
    const int nk = J.K >> 8, c0 = (J.tix / nk) * 64, k0 = (J.tix % nk) * 256, cc = tid & 63;
#pragma unroll
    for (int i = 0; i < 32; ++i) { const int kk = (tid >> 6) + 8 * i; float x = srcok ? v[i] * sc : 0.f; if (J.ks) x *= J.ks[k0 + kk]; tile[kk * 65 + cc] = x; }
    __syncthreads();
#pragma unroll
    for (int i = 0; i < 16; ++i) {
        const int idx = tid + 512 * i, c2 = idx >> 7, k2 = (idx & 127) * 2;
        *(unsigned*)(J.dst + (size_t)(c0 + c2) * J.K + k0 + k2) = pk2(tile[k2 * 65 + c2], tile[(k2 + 1) * 65 + c2]);
    }
    __syncthreads();
}
DI void wconv_jobs(LAS unsigned char* lds, const Params& p, int wi, int nb) {
    const int tid = otid(); const int total = 48 * 4 + 16 * 4 + 2 * (88 * 4 + 16 * 11) + 100 * 4 + 16 * 8;
    if (wi >= total) return;
    WJob J = wjob(p, wi); float v[32]; float sc; int ok;
    wtile_load(J, tid, v, sc, ok);
    for (int t = wi; t < total; t += nb) {
        const bool more = (t + nb < total);
        WJob Jn = J; float vn[32]; float scn = 0.f; int okn = 0;
        if (more) { Jn = wjob(p, t + nb); wtile_load(Jn, tid, vn, scn, okn); }
        wtile_store((LAS float*)lds, J, tid, v, sc, ok);
        if (more) { J = Jn; sc = scn; ok = okn;
#pragma unroll
            for (int i = 0; i < 32; ++i) v[i] = vn[i]; }
    }
}
DI void phase0(LAS unsigned char* lds, const Params& p) {
    const int tid = otid(), G = gridDim.x, bx = blockIdx.x;
    unsigned char* ws = p.ws;
    wconv_jobs(lds, p, bx, G);
    {
        const int wave = tid >> 6, lane = tid & 63; bf16_t* hb = (bf16_t*)(ws + O_HB); float* ss = (float*)(ws + O_SS);
        for (int row0 = (bx * 8 + wave) * 2; row0 < MT; row0 += G * 16) {
            f32x4 v[2][4];
#pragma unroll
            for (int q = 0; q < 2; ++q)
#pragma unroll
                for (int i = 0; i < 4; ++i) v[q][i] = *(const f32x4*)(p.in[0] + (size_t)(row0 + q) * DM + lane * 4 + 256 * i);
#pragma unroll
            for (int q = 0; q < 2; ++q) {
                float sq = 0.f;
#pragma unroll
                for (int i = 0; i < 4; ++i) { const f32x4 x = v[q][i]; sq += x[0] * x[0] + x[1] * x[1] + x[2] * x[2] + x[3] * x[3];
                    u32x2 o; o[0] = pk2(x[0], x[1]); o[1] = pk2(x[2], x[3]); *(u32x2*)(hb + (size_t)(row0 + q) * DM + lane * 4 + 256 * i) = o; }
#pragma unroll
                for (int o = 32; o >= 1; o >>= 1) sq += __shfl_xor(sq, o);
                if (lane == 0) ss[row0 + q] = sq;
            }
        }
        for (int i = bx * 512 + tid; i < 4 * MT; i += G * 512) ss[MT + i] = 0.f;
        f32x2* tab = (f32x2*)(ws + O_ROPE);
        for (int i = bx * 512 + tid; i < SEQ * 32; i += G * 512) {
            const int pos = i >> 5, f = i & 31; const float inv = fexp2(-(float)f * 0.41524101186092f); const float ang = (float)pos * inv;
            double t = (double)ang * 0.15915494309189535; t -= floor(t); const float tf = (float)t;
            f32x2 cs; cs[0] = __builtin_amdgcn_cosf(tf); cs[1] = __builtin_amdgcn_sinf(tf); tab[i] = cs;
        }
        if (bx == 0 && tid == 0) { float s1 = 0.f, s2 = 0.f; for (int i = 0; i < 64; ++i) { s1 += p.in[3][i] * p.in[4][i]; s2 += p.in[5][i] * p.in[6][i]; }
            *(float*)(ws + O_LAM) = fexp2(s1 * LOG2E) - fexp2(s2 * LOG2E) + 0.2f; }
    }
}

struct EpiAttnIn {
    static constexpr bool PERM = true, AFTER_DRAIN = false;
    bf16_t* O; const float* ss; const f32x4* tab;
    DI void pre(const pg8::Unit& u, int wr, int fr, float (&e)[8]) const {
#pragma unroll
        for (int ai = 0; ai < 2; ++ai)
#pragma unroll
            for (int m = 0; m < 4; ++m) e[ai * 4 + m] = ss[u.pm * 256 + wr * 64 + fr + ai * 128 + m * 16];
    }
    DI void operator()(const f32x4 (&acc)[2][2][4][2], const pg8::Unit& u, int wr, int wc, int fr, int fq, const float (&epre)[8]) const {
        const int row0 = u.pm * 256 + wr * 64 + fr, colt = u.pn * 256, col0 = colt + wc * 32 + 8 * fq;
        const int fb = 4 * (4 * (wc & 1) + fq);
#pragma unroll
        for (int ai = 0; ai < 2; ++ai)
#pragma unroll
            for (int m = 0; m < 4; ++m) {
                const int row = row0 + ai * 128 + m * 16; const float rs = __builtin_amdgcn_rsqf(epre[ai * 4 + m] * (1.0f / 1024.0f) + 1e-6f);
                f32x4 c01 = {1.f, 0.f, 1.f, 0.f}, c23 = {1.f, 0.f, 1.f, 0.f};
                if (colt < 1024) { const int pos = row & (SEQ - 1); c01 = tab[(pos * 32 + fb) >> 1]; c23 = tab[((pos * 32 + fb) >> 1) + 1]; }
#pragma unroll
                for (int bj = 0; bj < 2; ++bj) {
                    f32x4 v0 = acc[ai][bj][m][0] * rs, v1 = acc[ai][bj][m][1] * rs;
                    if (colt < 1024) {
                        const float cs[4] = {c01[0], c01[2], c23[0], c23[2]}, sn[4] = {c01[1], c01[3], c23[1], c23[3]};
#pragma unroll
                        for (int j = 0; j < 4; ++j) { const float t1 = v0[j], t2 = v1[j]; v0[j] = t1 * cs[j] - t2 * sn[j]; v1[j] = t2 * cs[j] + t1 * sn[j]; }
                    }
                    u32x4 o; o[0] = pk2(v0[0], v0[1]); o[1] = pk2(v0[2], v0[3]); o[2] = pk2(v1[0], v1[1]); o[3] = pk2(v1[2], v1[3]);
                    *(u32x4*)(O + (size_t)row * AINW + col0 + bj * 128) = o;
                }
            }
    }
};
template <bool RES_F32, bool OUT_F32> struct EpiRes {
    static constexpr bool PERM = true, AFTER_DRAIN = false;
    const float* xres; bf16_t* hb; float* outf; float* ssn;
    DI void pre(const pg8::Unit&, int, int, float (&)[8]) const {}
    DI void operator()(const f32x4 (&acc)[2][2][4][2], const pg8::Unit& u, int wr, int wc, int fr, int fq, const float (&epre)[8]) const {
        const int row0 = u.pm * 256 + wr * 64 + fr, col0 = u.pn * 256 + wc * 32 + 8 * fq;
#pragma unroll
        for (int ai = 0; ai < 2; ++ai)
#pragma unroll
            for (int m = 0; m < 4; ++m) {
                const int row = row0 + ai * 128 + m * 16; float sq = 0.f;
#pragma unroll
                for (int bj = 0; bj < 2; ++bj) {
                    const size_t off = (size_t)row * DM + col0 + bj * 128; f32x4 r0, r1;
                    if (RES_F32) { r0 = *(const f32x4*)(xres + off); r1 = *(const f32x4*)(xres + off + 4); }
                    else { const u32x4 t = *(const u32x4*)(hb + off); r0[0] = bflo(t[0]); r0[1] = bfhi(t[0]); r0[2] = bflo(t[1]); r0[3] = bfhi(t[1]); r1[0] = bflo(t[2]); r1[1] = bfhi(t[2]); r1[2] = bflo(t[3]); r1[3] = bfhi(t[3]); }
                    const f32x4 v0 = r0 + acc[ai][bj][m][0], v1 = r1 + acc[ai][bj][m][1];
                    sq += v0[0] * v0[0] + v0[1] * v0[1] + v0[2] * v0[2] + v0[3] * v0[3] + v1[0] * v1[0] + v1[1] * v1[1] + v1[2] * v1[2] + v1[3] * v1[3];
                    if (OUT_F32) { *(f32x4*)(outf + off) = v0; *(f32x4*)(outf + off + 4) = v1; }
                    else { u32x4 o; o[0] = pk2(v0[0], v0[1]); o[1] = pk2(v0[2], v0[3]); o[2] = pk2(v1[0], v1[1]); o[3] = pk2(v1[2], v1[3]); *(u32x4*)(hb + off) = o; }
                }
                sq += __shfl_xor(sq, 16); sq += __shfl_xor(sq, 32);
                if (fq == 0) atomicAdd(ssn + row, sq);
            }
    }
};
struct EpiGU {
    static constexpr bool PERM = true, AFTER_DRAIN = false;
    bf16_t* act; const float* ss;
    DI void pre(const pg8::Unit& u, int wr, int fr, float (&e)[8]) const {
#pragma unroll
        for (int ai = 0; ai < 2; ++ai)
#pragma unroll
            for (int m = 0; m < 4; ++m) e[ai * 4 + m] = ss[u.pm * 256 + wr * 64 + fr + ai * 128 + m * 16];
    }
    DI void operator()(const f32x4 (&acc)[2][2][4][2], const pg8::Unit& u, int wr, int wc, int fr, int fq, const float (&epre)[8]) const {
        const int row0 = u.pm * 256 + wr * 64 + fr;
#pragma unroll
        for (int ai = 0; ai < 2; ++ai)
#pragma unroll
            for (int m = 0; m < 4; ++m) {
                const int row = row0 + ai * 128 + m * 16; const float rs = __builtin_amdgcn_rsqf(epre[ai * 4 + m] * (1.0f / 1024.0f) + 1e-6f);
                u32x4 o;
#pragma unroll
                for (int n = 0; n < 2; ++n) {
                    const f32x4 g = acc[ai][0][m][n] * rs, up = acc[ai][1][m][n] * rs; float a[4];
#pragma unroll
                    for (int j = 0; j < 4; ++j) a[j] = fsilu(g[j]) * up[j];
                    o[2 * n] = pk2(a[0], a[1]); o[2 * n + 1] = pk2(a[2], a[3]);
                }
                *(u32x4*)(act + (size_t)row * DFF + u.pn * 128 + wc * 32 + 8 * fq) = o;
            }
    }
};
struct EpiSsdIn {
    static constexpr bool PERM = true, AFTER_DRAIN = false;
    bf16_t* z; bf16_t* xbc; float* dt; const float* ss;
    DI void pre(const pg8::Unit& u, int wr, int fr, float (&e)[8]) const {
#pragma unroll
        for (int ai = 0; ai < 2; ++ai)
#pragma unroll
            for (int m = 0; m < 4; ++m) e[ai * 4 + m] = ss[u.pm * 256 + wr * 64 + fr + ai * 128 + m * 16];
    }
    DI void operator()(const f32x4 (&acc)[2][2][4][2], const pg8::Unit& u, int wr, int wc, int fr, int fq, const float (&epre)[8]) const {
        const int row0 = u.pm * 256 + wr * 64 + fr, col0 = u.pn * 256 + wc * 32 + 8 * fq;
#pragma unroll
        for (int ai = 0; ai < 2; ++ai)
#pragma unroll
            for (int m = 0; m < 4; ++m) {
                const int row = row0 + ai * 128 + m * 16; const float rs = __builtin_amdgcn_rsqf(epre[ai * 4 + m] * (1.0f / 1024.0f) + 1e-6f);
#pragma unroll
                for (int bj = 0; bj < 2; ++bj) {
                    const int c = col0 + bj * 128; const f32x4 v0 = acc[ai][bj][m][0] * rs, v1 = acc[ai][bj][m][1] * rs;
                    if (c < 6144) { u32x4 o; o[0] = pk2(v0[0], v0[1]); o[1] = pk2(v0[2], v0[3]); o[2] = pk2(v1[0], v1[1]); o[3] = pk2(v1[2], v1[3]);
                        if (c < DIN) *(u32x4*)(z + (size_t)row * DIN + c) = o; else *(u32x4*)(xbc + (size_t)row * XBCW + (c - DIN)) = o; }
                }
            }
    }
};

struct EpiFinal {
    static constexpr bool PERM = true, AFTER_DRAIN = true;
    const bf16_t* hb; float* outf; float* ssn; unsigned* cnt; const float* fw;
    DI void operator()(const f32x4 (&)[2][2][4][2], const pg8::Unit&, int, int, int, int, const float (&)[8]) const {}
    DI void pre(const pg8::Unit&, int, int, float (&)[8]) const {}
    DI void fused(f32x4 (&acc)[2][2][4][2], const pg8::Unit& u, int wr, int wc, int fr, int fq, PG8_LAS unsigned char*, int, int) const {
        const int row0 = u.pm * 256 + wr * 64 + fr, col0 = u.pn * 256 + wc * 32 + 8 * fq;
#pragma unroll
        for (int ai = 0; ai < 2; ++ai)
#pragma unroll
            for (int m = 0; m < 4; ++m) {
                const int row = row0 + ai * 128 + m * 16; float sq = 0.f;
#pragma unroll
                for (int bj = 0; bj < 2; ++bj) {
                    const size_t off = (size_t)row * DM + col0 + bj * 128;
                    const u32x4 t = *(const u32x4*)(hb + off);
#pragma unroll
                    for (int n = 0; n < 2; ++n) {
                        f32x4 r; r[0] = bflo(t[2 * n]); r[1] = bfhi(t[2 * n]); r[2] = bflo(t[2 * n + 1]); r[3] = bfhi(t[2 * n + 1]);
                        const f32x4 v = r + acc[ai][bj][m][n]; acc[ai][bj][m][n] = v;
                        sq += v[0] * v[0] + v[1] * v[1] + v[2] * v[2] + v[3] * v[3];
                    }
                }
                sq += __shfl_xor(sq, 16); sq += __shfl_xor(sq, 32);
                if (fq == 0) atomicAdd(ssn + row, sq);
            }
        asm volatile("s_waitcnt vmcnt(0)" ::: "memory");
        __syncthreads();
        unsigned* c = cnt + 16 * u.pm;
        if (threadIdx.x == 0) {
            __builtin_amdgcn_fence(__ATOMIC_RELEASE, "agent"); asm volatile("s_waitcnt vmcnt(0)" ::: "memory");
            __hip_atomic_fetch_add(c, 1u, __ATOMIC_RELAXED, __HIP_MEMORY_SCOPE_AGENT);
            unsigned spins = 0;
            while (__hip_atomic_load(c, __ATOMIC_RELAXED, __HIP_MEMORY_SCOPE_AGENT) < 4u && ++spins < (1u << 22)) __builtin_amdgcn_s_sleep(2);
            __builtin_amdgcn_fence(__ATOMIC_ACQUIRE, "agent"); asm volatile("s_waitcnt vmcnt(0)" ::: "memory");
        }
        __syncthreads();
#pragma unroll
        for (int ai = 0; ai < 2; ++ai)
#pragma unroll
            for (int m = 0; m < 4; ++m) {
                const int row = row0 + ai * 128 + m * 16;
                const float rs = __builtin_amdgcn_rsqf(__hip_atomic_load(ssn + row, __ATOMIC_RELAXED, __HIP_MEMORY_SCOPE_AGENT) * (1.0f / 1024.0f) + 1e-6f);
#pragma unroll
                for (int bj = 0; bj < 2; ++bj)
#pragma unroll
                    for (int n = 0; n < 2; ++n) {
                        const int col = col0 + bj * 128 + n * 4; const f32x4 w = *(const f32x4*)(fw + col);
                        *(f32x4*)(outf + (size_t)row * DM + col) = acc[ai][bj][m][n] * rs * w;
                    }
            }
    }
};
constexpr int KST = 144, VST = 320, VST64 = 192;
constexpr int AT_K1 = 0, AT_K2 = 64 * KST, AT_V = 2 * 64 * KST, AT_STAGE = AT_V + 64 * VST;

DI void diff_tile(LAS unsigned char* lds, const bf16_t* proj, bf16_t* mixed, const float* subln, float lam, int b, int hd, int qt) {
    const int tid = otid(), w = __builtin_amdgcn_readfirstlane(tid >> 6), lane = tid & 63, qg = w & 3, mp = w >> 2, r = lane & 31, h = lane >> 5;
    const int q0 = qt * 128; const size_t rowb = (size_t)b * SEQ;
    bf16x8 qf[4];
    { const bf16_t* qp = proj + (rowb + q0 + 32 * qg + r) * AINW + hd * 128 + mp * 64 + 8 * h;
#pragma unroll
      for (int s = 0; s < 4; ++s) qf[s] = *(const bf16x8*)(qp + 16 * s); }
    f32x16 O[4];
#pragma unroll
    for (int i = 0; i < 4; ++i) O[i] = zero16();
    float mrun = 0.f, lrun = 0.f;
    const int nsteps = 2 * (qt + 1);
    const bf16_t* src[4]; int dst[4];
#pragma unroll
    for (int i = 0; i < 2; ++i) { const int cid = tid + 512 * i, row = cid >> 4, c16 = cid & 15;
        src[i] = proj + (rowb + row) * AINW + 512 + hd * 128 + c16 * 8; dst[i] = (c16 < 8 ? AT_K1 : AT_K2) + row * KST + (c16 & 7) * 16;
        src[2 + i] = proj + (rowb + row) * AINW + 1024 + hd * 128 + c16 * 8; dst[2 + i] = AT_V + row * VST + c16 * 16; }
    u32x4 pf[4];
#pragma unroll
    for (int i = 0; i < 4; ++i) pf[i] = *(const u32x4*)(src[i]);
#pragma unroll
    for (int i = 0; i < 4; ++i) *(LAS u32x4*)(lds + dst[i]) = pf[i];
    __syncthreads();
    const int i16 = lane & 15, tq = i16 >> 2, tp = i16 & 3, g16 = (lane >> 4) & 1;
    const int troff = (4 * h + tq) * VST + (16 * g16 + 4 * tp) * 2;
    for (int j = 0; j < nsteps; ++j) {
        const bool more = (j + 1 < nsteps);
        if (more) {
#pragma unroll
            for (int i = 0; i < 4; ++i) pf[i] = *(const u32x4*)(src[i] + (size_t)(j + 1) * 64 * AINW);
        }
        const LAS unsigned char* base = lds + (j & 1) * AT_STAGE;
        const LAS unsigned char* Kb = base + (mp ? AT_K2 : AT_K1);
        const LAS unsigned char* Vb = base + AT_V;
        f32x16 S[2];
        const float negm = -mrun;
#pragma unroll
        for (int kt = 0; kt < 2; ++kt) {
#pragma unroll
            for (int i = 0; i < 16; ++i) S[kt][i] = negm;
#pragma unroll
            for (int s = 0; s < 4; ++s) { const bf16x8 kf = *(const LAS bf16x8*)(Kb + (32 * kt + r) * KST + (16 * s + 8 * h) * 2); S[kt] = MFMA32(kf, qf[s], S[kt]); } }
        const int qidx = q0 + 32 * qg + r, kbase = 64 * j;
        if (kbase + 63 > q0 + 32 * qg) {
#pragma unroll
            for (int kt = 0; kt < 2; ++kt)
#pragma unroll
                for (int i = 0; i < 16; ++i) if (kbase + 32 * kt + crow(i, h) > qidx) S[kt][i] = -1e30f;
        }
        float mx = S[0][0];
#pragma unroll
        for (int kt = 0; kt < 2; ++kt)
#pragma unroll
            for (int i = 0; i < 16; ++i) mx = fmaxf(mx, S[kt][i]);
        mx = fmaxf(mx, __shfl_xor(mx, 32));
        if (j == 0 || __builtin_amdgcn_ballot_w64(mx > 8.0f) != 0ull) {
            const float d = (j == 0) ? mx : fmaxf(mx, 0.f);
            mrun += d;
            if (j != 0) { const float alpha = fexp2(-d); lrun *= alpha;
#pragma unroll
                for (int vt = 0; vt < 4; ++vt) O[vt] = O[vt] * alpha; }
#pragma unroll
            for (int kt = 0; kt < 2; ++kt)
#pragma unroll
                for (int i = 0; i < 16; ++i) S[kt][i] -= d;
        }
        float ls = 0.f;
#pragma unroll
        for (int kt = 0; kt < 2; ++kt)
#pragma unroll
            for (int i = 0; i < 16; ++i) { const float pv = fexp2(S[kt][i]); S[kt][i] = pv; ls += pv; }
        lrun += ls;
#pragma unroll
        for (int kt = 0; kt < 2; ++kt)
#pragma unroll
            for (int s2 = 0; s2 < 2; ++s2) {
                const bf16x8 pfr = pack8(S[kt], s2);
                const LAS unsigned char* vrow = Vb + (32 * kt + 16 * s2) * VST + troff;
#pragma unroll
                for (int vt = 0; vt < 4; ++vt) { const bf16x8 vf = tr2(vrow + vt * 64, vrow + 8 * VST + vt * 64); O[vt] = MFMA32(vf, pfr, O[vt]); }
            }
        if (more) {
            LAS unsigned char* nb = lds + ((j + 1) & 1) * AT_STAGE;
#pragma unroll
            for (int i = 0; i < 4; ++i) *(LAS u32x4*)(nb + dst[i]) = pf[i];
        }
        __syncthreads();
    }
    lrun += __shfl_xor(lrun, 32);
    const float inv = frcp(lrun);
    LAS float* ex = (LAS float*)lds;
    if (mp == 1) {
        const float sc = inv * lam;
#pragma unroll
        for (int vt = 0; vt < 4; ++vt)
#pragma unroll
            for (int i = 0; i < 16; ++i) ex[(qg * 128 + 32 * vt + crow(i, h)) * 32 + r] = O[vt][i] * sc;
    }
    __syncthreads();
    if (mp == 0) {
        float sq = 0.f;
#pragma unroll
        for (int vt = 0; vt < 4; ++vt)
#pragma unroll
            for (int i = 0; i < 16; ++i) { const float o = O[vt][i] * inv - ex[(qg * 128 + 32 * vt + crow(i, h)) * 32 + r]; O[vt][i] = o; sq += o * o; }
        sq += __shfl_xor(sq, 32);
        const float rn = __builtin_amdgcn_rsqf(sq * (1.0f / 128.0f) + 1e-5f) * 0.8f;
        bf16_t* op = mixed + (rowb + q0 + 32 * qg + r) * DM + hd * 128;
#pragma unroll
        for (int vt = 0; vt < 4; ++vt)
#pragma unroll
            for (int gq = 0; gq < 4; ++gq) { const int v0 = 32 * vt + 8 * gq + 4 * h; const f32x4 wv = *(const f32x4*)(subln + v0);
                u32x2 o; o[0] = pk2(O[vt][4 * gq] * rn * wv[0], O[vt][4 * gq + 1] * rn * wv[1]); o[1] = pk2(O[vt][4 * gq + 2] * rn * wv[2], O[vt][4 * gq + 3] * rn * wv[3]);
                *(u32x2*)(op + v0) = o; }
    }
    __syncthreads();
}

constexpr int SB_K = 0, SB_V = 64 * KST, SB_STAGE = 64 * KST + 64 * VST64;
DI void sb_block(LAS unsigned char* lds, const bf16_t* proj, bf16_t* mixed, int b, int hs, int qb) {
    const int tid = otid(), w = __builtin_amdgcn_readfirstlane(tid >> 6), lane = tid & 63, r = lane & 31, h = lane >> 5;
    const int q0 = qb * 256; const size_t rowb = (size_t)b * SEQ;
    const int qidx = q0 + 32 * w + r;
    bf16x8 qf[4];
    { const bf16_t* qp = proj + (rowb + qidx) * AINW + 1536 + hs * 64 + 8 * h;
#pragma unroll
      for (int s = 0; s < 4; ++s) qf[s] = *(const bf16x8*)(qp + 16 * s); }
    f32x16 O[2]; O[0] = zero16(); O[1] = zero16();
    float carry = 1.0f;
    const int jmax = 4 * qb + 3;
    const int srow = tid >> 3, sc8 = tid & 7;
    const bf16_t* srcK = proj + (rowb + srow) * AINW + 2048 + hs * 64 + sc8 * 8;
    const bf16_t* srcV = proj + (rowb + srow) * AINW + 2560 + hs * 64 + sc8 * 8;
    const int dstK = SB_K + srow * KST + sc8 * 16, dstV = SB_V + srow * VST64 + sc8 * 16;
    u32x4 pk_ = *(const u32x4*)(srcK + (size_t)jmax * 64 * AINW), pv_ = *(const u32x4*)(srcV + (size_t)jmax * 64 * AINW);
    *(LAS u32x4*)(lds + dstK) = pk_; *(LAS u32x4*)(lds + dstV) = pv_;
    __syncthreads();
    const int i16 = lane & 15, tq = i16 >> 2, tp = i16 & 3, g16 = (lane >> 4) & 1;
    const int troff = (4 * h + tq) * VST64 + (16 * g16 + 4 * tp) * 2;
    int it = 0;
    for (int j = jmax; j >= 0; --j, ++it) {
        const bool more = (j > 0);
        if (more) { pk_ = *(const u32x4*)(srcK + (size_t)(j - 1) * 64 * AINW); pv_ = *(const u32x4*)(srcV + (size_t)(j - 1) * 64 * AINW); }
        const LAS unsigned char* base = lds + (it & 1) * SB_STAGE;
        const int kbase = 64 * j;
        if (kbase < q0 + 32 * w + 32) {
#pragma unroll
            for (int kt = 1; kt >= 0; --kt) {
                f32x16 S = zero16();
#pragma unroll
                for (int s = 0; s < 4; ++s) { const bf16x8 kf = *(const LAS bf16x8*)(base + SB_K + (32 * kt + r) * KST + (16 * s + 8 * h) * 2); S = MFMA32(kf, qf[s], S); }
                float T[4], sfx[16];
#pragma unroll
                for (int gq = 0; gq < 4; ++gq) {
                    float run = 1.0f;
#pragma unroll
                    for (int jj = 3; jj >= 0; --jj) {
                        const int i = 4 * gq + jj; const bool valid = (kbase + 32 * kt + crow(i, h)) < qidx;
                        const float zz = fmaxf(S[i], -60.0f); const float e = fexp2(-LOG2E * zz); const float sg = frcp(1.0f + e);
                        const float keep = valid ? e * sg : 1.0f;
                        S[i] = valid ? sg : 0.0f; sfx[i] = run; run *= keep;
                    }
                    T[gq] = run;
                }
                float To[4];
#pragma unroll
                for (int gq = 0; gq < 4; ++gq) To[gq] = __shfl_xor(T[gq], 32);
                float E[4]; float acc_hi = 1.0f;
#pragma unroll
                for (int gq = 3; gq >= 0; --gq) {
                    const float above_same = acc_hi;
                    E[gq] = (h == 0) ? above_same * To[gq] : above_same;
                    acc_hi = acc_hi * T[gq] * To[gq];
                }
#pragma unroll
                for (int i = 0; i < 16; ++i) S[i] = S[i] * carry * E[i >> 2] * sfx[i];
                carry *= acc_hi;
#pragma unroll
                for (int s2 = 0; s2 < 2; ++s2) {
                    const bf16x8 pfr = pack8(S, s2);
                    const LAS unsigned char* vrow = base + SB_V + (32 * kt + 16 * s2) * VST64 + troff;
#pragma unroll
                    for (int vt = 0; vt < 2; ++vt) { const bf16x8 vf = tr2(vrow + vt * 64, vrow + 8 * VST64 + vt * 64); O[vt] = MFMA32(vf, pfr, O[vt]); }
                }
            }
        }
        if (more) { LAS unsigned char* nb = lds + ((it + 1) & 1) * SB_STAGE; *(LAS u32x4*)(nb + dstK) = pk_; *(LAS u32x4*)(nb + dstV) = pv_; }
        const int done = (kbase < q0 + 32 * w + 32) && (carry < 1e-12f);
        const bool wdone = (__builtin_amdgcn_ballot_w64(done != 0) == ~0ull);
        LAS int* flg = (LAS int*)(lds + 2 * SB_STAGE) + (it & 1) * 8;
        if (lane == 0) flg[w] = wdone ? 1 : 0;
        __syncthreads();
        int all = 1;
#pragma unroll
        for (int ww = 0; ww < 8; ++ww) all &= flg[ww];
        if (all) break;
    }
    bf16_t* op = mixed + (rowb + qidx) * DM + 512 + hs * 64;
#pragma unroll
    for (int vt = 0; vt < 2; ++vt)
#pragma unroll
        for (int gq = 0; gq < 4; ++gq) { const int v0 = 32 * vt + 8 * gq + 4 * h;
            u32x2 o; o[0] = pk2(O[vt][4 * gq], O[vt][4 * gq + 1]); o[1] = pk2(O[vt][4 * gq + 2], O[vt][4 * gq + 3]); *(u32x2*)(op + v0) = o; }
    __syncthreads();
}
DI void attn_phase(LAS unsigned char* lds, const Params& p) {
    const bf16_t* proj = (const bf16_t*)(p.ws + O_PROJ); bf16_t* mixed = (bf16_t*)(p.ws + O_MIXED);
    const float lam = *(const float*)(p.ws + O_LAM);
    for (int it0 = blockIdx.x; it0 < 256; it0 += gridDim.x) {
        const int it = (it0 & 7) * 32 + (it0 >> 3);
        const int b = it >> 7, hd = (it >> 5) & 3, pr = it & 31;
        diff_tile(lds, proj, mixed, p.in[7], lam, b, hd, 63 - pr);
        diff_tile(lds, proj, mixed, p.in[7], lam, b, hd, pr);
    }
    for (int it0 = blockIdx.x; it0 < 512; it0 += gridDim.x) {
        const int it = (it0 & 7) * 64 + (it0 >> 3);
        const int b = it >> 8, hs = (it >> 5) & 7, qb = it & 31;
        sb_block(lds, proj, mixed, b, hs, qb);
    }
}
constexpr int SXS = 528, SXS2 = 576, SBS = 272, SBS2 = 320;
constexpr int L_SX = 0, L_SB = 128 * SXS2, L_SC = L_SB + 128 * SBS, L_SDT = L_SC + 128 * SBS, L_SAC = L_SDT + 2048, L_SSQ = L_SAC + 2048;
static_assert(L_SSQ + 4096 <= LDS_BYTES, "lds");

DI void ssd_dt_acum(LAS unsigned char* lds, const float* DT, const float* dt_bias, const float* a_log, size_t t0, int g) {
    LAS float* sdt = (LAS float*)(lds + L_SDT); LAS float* sac = (LAS float*)(lds + L_SAC);
    const int tid = otid(), hh = tid >> 7, l = tid & 127, head = 4 * g + hh, w = tid >> 6, lane = tid & 63;
    const float raw = DT[(t0 + l) * 32 + head] + dt_bias[head];
    const float dt = fmaxf(raw, 0.f) + __logf(1.0f + __expf(-fabsf(raw)));
    sdt[hh * 128 + l] = dt; sac[hh * 128 + l] = -dt * __expf(a_log[head]);
    __syncthreads();
    if (w < 4) {
        const float v0 = sac[w * 128 + 2 * lane], v1 = sac[w * 128 + 2 * lane + 1]; float s = v0 + v1;
#pragma unroll
        for (int off = 1; off < 64; off <<= 1) { const float t = __shfl_up(s, off); if (lane >= off) s += t; }
        const float ex = s - (v0 + v1);
        sac[w * 128 + 2 * lane] = ex + v0; sac[w * 128 + 2 * lane + 1] = ex + v0 + v1;
    }
    __syncthreads();
}
template <int NT, class F> DI void conv_strip(const bf16_t* src, int nzero, const float* cw, const float* cb, int ch, F&& emit) {
    f32x4 wlo[4], whi[4];
#pragma unroll
    for (int k = 0; k < 4; ++k) { wlo[k] = *(const f32x4*)(cw + k * XBCW + ch); whi[k] = *(const f32x4*)(cw + k * XBCW + ch + 4); }
    const f32x4 blo = *(const f32x4*)(cb + ch), bhi = *(const f32x4*)(cb + ch + 4);
    u32x4 raw[NT + 3];
#pragma unroll
    for (int i = 0; i < NT + 3; ++i) { const int ii = (i < nzero) ? nzero : i; raw[i] = *(const u32x4*)(src + (ptrdiff_t)(ii - 3) * XBCW); if (i < nzero) raw[i] = (u32x4){0u, 0u, 0u, 0u}; }
#pragma unroll
    for (int t = 0; t < NT; ++t) {
        float o[8];
#pragma unroll
        for (int e = 0; e < 8; ++e) {
            float a = (e < 4) ? blo[e & 3] : bhi[e & 3];
#pragma unroll
            for (int k = 0; k < 4; ++k) { const unsigned d = raw[t + k][e >> 1]; const float xv = (e & 1) ? bfhi(d) : bflo(d); a += ((e < 4) ? wlo[k][e & 3] : whi[k][e & 3]) * xv; }
            o[e] = fsilu(a);
        }
        emit(t, o);
    }
}
DI u32x4 pack8f(const float* o) { u32x4 r; r[0] = pk2(o[0], o[1]); r[1] = pk2(o[2], o[3]); r[2] = pk2(o[4], o[5]); r[3] = pk2(o[6], o[7]); return r; }

template <bool XW, bool WITH_C> DI void ssd_stage(LAS unsigned char* lds, const bf16_t* xbc, const float* cw, const float* cb, size_t t0, int c, int g) {
    const int tid = otid();
    LAS float* sdt = (LAS float*)(lds + L_SDT); LAS float* sac = (LAS float*)(lds + L_SAC);
    {
        const int c8 = tid & 31, tg = tid >> 5, l0 = 8 * tg, ch = 256 * g + 8 * c8, hh = c8 >> 3;
        const int nzero = (c == 0) ? (3 - l0 > 0 ? 3 - l0 : 0) : 0;
        const float alast = sac[hh * 128 + 127];
        conv_strip<8>(xbc + (t0 + l0) * XBCW + ch, nzero, cw, cb, ch, [&](int t, float* o) {
            if (XW) { const float wgt = sdt[hh * 128 + l0 + t] * __expf(alast - sac[hh * 128 + l0 + t]);
#pragma unroll
                for (int e = 0; e < 8; ++e) o[e] *= wgt; }
            *(LAS u32x4*)(lds + L_SX + (l0 + t) * (XW ? SXS2 : SXS) + c8 * 16) = pack8f(o); });
    }
    {
        const int c8 = tid & 15, tg = tid >> 4, l0 = 4 * tg;
        const int nzero = (c == 0) ? (3 - l0 > 0 ? 3 - l0 : 0) : 0;
        const int chb = DIN + 128 * g + 8 * c8;
        conv_strip<4>(xbc + (t0 + l0) * XBCW + chb, nzero, cw, cb, chb, [&](int t, float* o) { *(LAS u32x4*)(lds + L_SB + (l0 + t) * (XW ? SBS2 : SBS) + c8 * 16) = pack8f(o); });
        if (WITH_C) { const int chc = DIN + 1024 + 128 * g + 8 * c8;
            conv_strip<4>(xbc + (t0 + l0) * XBCW + chc, nzero, cw, cb, chc, [&](int t, float* o) { *(LAS u32x4*)(lds + L_SC + (l0 + t) * SBS + c8 * 16) = pack8f(o); }); }
    }
}
DI bf16_t* st_ptr(unsigned char* ws, int b) { return (bf16_t*)(ws + (b ? O_ST1 : O_ST0)); }

DI void ssd_states_phase(LAS unsigned char* lds, const Params& p) {
    const int tid = otid(), w = __builtin_amdgcn_readfirstlane(tid >> 6), lane = tid & 63, r = lane & 31, h = lane >> 5, hh = w >> 1, ph = w & 1;
    const bf16_t* xbc = (const bf16_t*)(p.ws + O_XBC); const float* DT = (const float*)(p.ws + O_DT); float* cdec = (float*)(p.ws + O_CDEC);
    const int i16 = lane & 15, tq = i16 >> 2, tp = i16 & 3, g16 = (lane >> 4) & 1;
    for (int it = blockIdx.x; it < 1024; it += gridDim.x) {
        const int b = it >> 9, c = (it >> 3) & 63, g = it & 7; const size_t t0 = (size_t)b * SEQ + (size_t)c * 128;
        ssd_dt_acum(lds, DT, p.in[13], p.in[14], t0, g);
        ssd_stage<true, false>(lds, xbc, p.in[11], p.in[12], t0, c, g);
        __syncthreads();
        f32x16 acc[4];
#pragma unroll
        for (int i = 0; i < 4; ++i) acc[i] = zero16();
        const LAS unsigned char* xa = lds + L_SX + (8 * h + tq) * SXS2 + (64 * hh + 32 * ph + 16 * g16 + 4 * tp) * 2;
        const LAS unsigned char* ba = lds + L_SB + (8 * h + tq) * SBS2 + (16 * g16 + 4 * tp) * 2;
#pragma unroll
        for (int s = 0; s < 8; ++s) {
            const bf16x8 af = tr2(xa + 16 * s * SXS2, xa + (16 * s + 4) * SXS2);
#pragma unroll
            for (int nt = 0; nt < 4; ++nt) { const bf16x8 bfr = tr2(ba + 16 * s * SBS2 + nt * 64, ba + (16 * s + 4) * SBS2 + nt * 64); acc[nt] = MFMA32(af, bfr, acc[nt]); }
        }
        bf16_t* st = st_ptr(p.ws, b) + ((size_t)(c * 32 + 4 * g + hh) * 64 + 32 * ph) * 128;
#pragma unroll
        for (int nt = 0; nt < 4; ++nt)
#pragma unroll
            for (int i = 0; i < 16; ++i) st[(size_t)crow(i, h) * 128 + 32 * nt + r] = (bf16_t)(pk2(acc[nt][i], 0.f) & 0xffffu);
        if (tid < 4) cdec[(b * 64 + c) * 32 + 4 * g + tid] = __expf(((LAS float*)(lds + L_SAC))[tid * 128 + 127]);
        __syncthreads();
    }
}
DI void ssd_scan_phase(const Params& p, const bool dry) {
    const float* cdec = (const float*)(p.ws + O_CDEC);
    for (int e = blockIdx.x * 512 + threadIdx.x; e < 2 * 32 * 64 * 32; e += gridDim.x * 512) {
        const int b = e >> 16, rem = e & 65535, head = rem >> 11;
        bf16_t* st = st_ptr(p.ws, b) + (size_t)rem * 4;
        float carry[4] = {0.f, 0.f, 0.f, 0.f};
        for (int c0 = 0; c0 < 64; c0 += 8) {
            u32x2 v[8]; float dc[8];
#pragma unroll
            for (int u = 0; u < 8; ++u) { v[u] = *(const u32x2*)(st + (size_t)(c0 + u) * 262144); dc[u] = cdec[(b * 64 + c0 + u) * 32 + head]; }
#pragma unroll
            for (int u = 0; u < 8; ++u) {
                u32x2 o; o[0] = pk2(carry[0], carry[1]); o[1] = pk2(carry[2], carry[3]); if (!dry) *(u32x2*)(st + (size_t)(c0 + u) * 262144) = o;
                carry[0] = carry[0] * dc[u] + bflo(v[u][0]); carry[1] = carry[1] * dc[u] + bfhi(v[u][0]); carry[2] = carry[2] * dc[u] + bflo(v[u][1]); carry[3] = carry[3] * dc[u] + bfhi(v[u][1]);
            }
        }
    }
}
DI void ssd_out_phase(LAS unsigned char* lds, const Params& p, const bool dry) {
    const int tid = otid(), w = __builtin_amdgcn_readfirstlane(tid >> 6), lane = tid & 63, r = lane & 31, h = lane >> 5, hh = w >> 1, ph = w & 1;
    const bf16_t* xbc = (const bf16_t*)(p.ws + O_XBC); const float* DT = (const float*)(p.ws + O_DT); bf16_t* zy = (bf16_t*)p.out;
    LAS float* sdt = (LAS float*)(lds + L_SDT); LAS float* sac = (LAS float*)(lds + L_SAC); LAS float* ssq = (LAS float*)(lds + L_SSQ);
    const int i16 = lane & 15, tq = i16 >> 2, tp = i16 & 3, g16 = (lane >> 4) & 1;
    for (int it = blockIdx.x; it < 1024; it += gridDim.x) {
        const int b = it >> 9, c = (it >> 3) & 63, g = it & 7, head = 4 * g + hh; const size_t t0 = (size_t)b * SEQ + (size_t)c * 128;
        ssd_dt_acum(lds, DT, p.in[13], p.in[14], t0, g);
        ssd_stage<false, true>(lds, xbc, p.in[11], p.in[12], t0, c, g);
        bf16x8 pvf[8];
        { const bf16_t* pp = st_ptr(p.ws, b) + ((size_t)(c * 32 + head) * 64 + 32 * ph + r) * 128 + 8 * h;
#pragma unroll
          for (int s = 0; s < 8; ++s) pvf[s] = *(const bf16x8*)(pp + 16 * s); }
        __syncthreads();
        f32x16 Y[4];
        const LAS unsigned char* xa = lds + L_SX + (4 * h + tq) * SXS + (64 * hh + 32 * ph + 16 * g16 + 4 * tp) * 2;
#pragma unroll
        for (int lt = 0; lt < 4; ++lt) {
            __builtin_amdgcn_sched_barrier(0);
            f32x16 y = zero16();
#pragma unroll
            for (int s = 0; s < 8; ++s) { const bf16x8 cfs = *(const LAS bf16x8*)(lds + L_SC + (32 * lt + r) * SBS + (16 * s + 8 * h) * 2); y = MFMA32(pvf[s], cfs, y); }
            Y[lt] = y * __expf(sac[hh * 128 + 32 * lt + r]);
        }
#pragma unroll
        for (int lt = 0; lt < 4; ++lt) {
            __builtin_amdgcn_sched_barrier(0);
            bf16x8 cf[8];
#pragma unroll
            for (int s = 0; s < 8; ++s) cf[s] = *(const LAS bf16x8*)(lds + L_SC + (32 * lt + r) * SBS + (16 * s + 8 * h) * 2);
            const float al = sac[hh * 128 + 32 * lt + r];
#pragma unroll
            for (int mt = 0; mt < 4; ++mt) {
                if (mt <= lt) {
                    __builtin_amdgcn_sched_barrier(0);
                    f32x16 X = zero16();
#pragma unroll
                    for (int s = 0; s < 8; ++s) { const bf16x8 bfr = *(const LAS bf16x8*)(lds + L_SB + (32 * mt + r) * SBS + (16 * s + 8 * h) * 2); X = MFMA32(bfr, cf[s], X); }
#pragma unroll
                    for (int gq = 0; gq < 4; ++gq) {
                        const f32x4 am = *(const LAS f32x4*)(sac + hh * 128 + 32 * mt + 8 * gq + 4 * h), dm = *(const LAS f32x4*)(sdt + hh * 128 + 32 * mt + 8 * gq + 4 * h);
#pragma unroll
                        for (int jj = 0; jj < 4; ++jj) { const int mrow = 32 * mt + 8 * gq + 4 * h + jj; const bool ok = (32 * lt + r) >= mrow;
                            const float dec = ok ? __expf(fminf(al - am[jj], 0.f)) * dm[jj] : 0.f; X[4 * gq + jj] *= dec; }
                    }
#pragma unroll
                    for (int s2 = 0; s2 < 2; ++s2) { const bf16x8 xs = pack8(X, s2);
                        const LAS unsigned char* xr = xa + (32 * mt + 16 * s2) * SXS; const bf16x8 xf = tr2(xr, xr + 8 * SXS); Y[lt] = MFMA32(xf, xs, Y[lt]); }
                }
            }
        }
        __builtin_amdgcn_sched_barrier(0);
        const float Dh = p.in[15][head];
        float sq[4];
#pragma unroll
        for (int lt = 0; lt < 4; ++lt) {
            const int l = 32 * lt + r; sq[lt] = 0.f;
#pragma unroll
            for (int gq = 0; gq < 4; ++gq) {
                const int chl = 64 * hh + 32 * ph + 8 * gq + 4 * h;
                const u32x2 xv = *(const LAS u32x2*)(lds + L_SX + l * SXS + chl * 2);
                const u32x2 zv = *(const u32x2*)(zy + (t0 + l) * DIN + 256 * g + chl);
                const float xf4[4] = {bflo(xv[0]), bfhi(xv[0]), bflo(xv[1]), bfhi(xv[1])}, zf4[4] = {bflo(zv[0]), bfhi(zv[0]), bflo(zv[1]), bfhi(zv[1])};
#pragma unroll
                for (int jj = 0; jj < 4; ++jj) { const float yv = (Y[lt][4 * gq + jj] + Dh * xf4[jj]) * fsilu(zf4[jj]); Y[lt][4 * gq + jj] = yv; sq[lt] += yv * yv; }
            }
            sq[lt] += __shfl_xor(sq[lt], 32);
            if (h == 0) ssq[w * 128 + l] = sq[lt];
        }
        __syncthreads();
#pragma unroll
        for (int lt = 0; lt < 4; ++lt) {
            const int l = 32 * lt + r; float tot = 0.f;
#pragma unroll
            for (int ww = 0; ww < 8; ++ww) tot += ssq[ww * 128 + l];
            const float rn = __builtin_amdgcn_rsqf(tot * (1.0f / 256.0f) + 1e-5f);
#pragma unroll
            for (int gq = 0; gq < 4; ++gq) {
                const int chl = 64 * hh + 32 * ph + 8 * gq + 4 * h; const f32x4 gw = *(const f32x4*)(p.in[16] + 256 * g + chl);
                u32x2 o; o[0] = pk2(Y[lt][4 * gq] * rn * gw[0], Y[lt][4 * gq + 1] * rn * gw[1]); o[1] = pk2(Y[lt][4 * gq + 2] * rn * gw[2], Y[lt][4 * gq + 3] * rn * gw[3]);
                if (!dry) *(u32x2*)(zy + (t0 + l) * DIN + 256 * g + chl) = o;
            }
        }
        __syncthreads();
    }
}
DI void dt_proj(LAS unsigned char* lds, const Params& p) {
    const int tid = otid(), w = __builtin_amdgcn_readfirstlane(tid >> 6), lane = tid & 63, r = lane & 31, h = lane >> 5, rt = w & 1, kq = w >> 1;
    const bf16_t* hb = (const bf16_t*)(p.ws + O_HB); const bf16_t* wt = (const bf16_t*)(p.ws + W_SIN) + (size_t)6144 * DM;
    const float* ss = (const float*)(p.ws + O_SS) + 2 * MT; float* dt = (float*)(p.ws + O_DT);
    LAS float* part = (LAS float*)lds;
    for (int rb = blockIdx.x; rb < MT / 64; rb += gridDim.x) {
        const bf16_t* ap = hb + (size_t)(rb * 64 + rt * 32 + r) * DM + kq * 256 + 8 * h;
        const bf16_t* bp = wt + (size_t)r * DM + kq * 256 + 8 * h;
        bf16x8 af[16], bfr[16];
#pragma unroll
        for (int s = 0; s < 16; ++s) { af[s] = *(const bf16x8*)(ap + 16 * s); bfr[s] = *(const bf16x8*)(bp + 16 * s); }
        f32x16 acc = zero16();
#pragma unroll
        for (int s = 0; s < 16; ++s) acc = MFMA32(af[s], bfr[s], acc);
#pragma unroll
        for (int i = 0; i < 16; ++i) part[((kq * 2 + rt) * 32 + crow(i, h)) * 32 + r] = acc[i];
        __syncthreads();
#pragma unroll
        for (int q = 0; q < 4; ++q) {
            const int o = tid + 512 * q, row = o >> 5, col = o & 31;
            float v = 0.f;
#pragma unroll
            for (int k = 0; k < 4; ++k) v += part[((k * 2 + (row >> 5)) * 32 + (row & 31)) * 32 + col];
            const int grow = rb * 64 + row;
            dt[(size_t)grow * 32 + col] = v * __builtin_amdgcn_rsqf(ss[grow] * (1.0f / 1024.0f) + 1e-6f);
        }
        __syncthreads();
    }
}
template <class Epi> DI void run_gemm(LAS unsigned char* lds, const bf16_t* A, const bf16_t* Bt, int N, int K, const Epi& E) {
    pg8::Gemm g; g.A = A; g.Bt = Bt; g.M = MT; g.N = N; g.K = K;
    pg8::StaticOrder S; S.init(MT, N, (int)gridDim.x, (int)blockIdx.x);
    pg8::gemm_phase<Epi, pg8::StaticOrder, !Epi::AFTER_DRAIN, true>((PG8_LAS unsigned char*)lds, g, S, E);
}
#if defined(DRY_S3) || defined(DRY_S4)
#define DRYV (p.ws == nullptr)
#else
#define DRYV false
#endif
__global__ void __launch_bounds__(512, 2) fwd_megakernel(Params p) {
    extern __shared__ __attribute__((aligned(16))) unsigned char shm[];
    LAS unsigned char* lds = (LAS unsigned char*)shm;
    cg::grid_group grid = cg::this_grid();
    if (threadIdx.x < 4) ((LAS unsigned*)(lds + LDS_BYTES - 16))[threadIdx.x] = 0u;
    __syncthreads();
    const XcdBarrier xbar = xcd_barrier_post((unsigned*)(p.ws + O_BAR), (volatile LAS unsigned*)(lds + LDS_BYTES - 16));
#define GBAR() xcd_barrier(xbar)
    unsigned char* ws = p.ws;
    bf16_t* hb = (bf16_t*)(ws + O_HB); float* ss = (float*)(ws + O_SS);
    phase0(lds, p);
#ifdef DUP_P0
    GBAR(); phase0(lds, p);
#endif
    if (gridDim.x == 0x7fffffffu) grid.sync();
    GBAR();
    { EpiAttnIn E; E.O = (bf16_t*)(ws + O_PROJ); E.ss = ss; E.tab = (const f32x4*)(ws + O_ROPE); run_gemm(lds, hb, (const bf16_t*)(ws + W_AIN), AINW, DM, E); }
    GBAR();
    attn_phase(lds, p);
#ifdef DUP_ATTN
    GBAR(); attn_phase(lds, p);
#endif
    GBAR();
    { EpiRes<true, false> E; E.xres = p.in[0]; E.hb = hb; E.outf = nullptr; E.ssn = ss + MT; run_gemm(lds, (const bf16_t*)(ws + O_MIXED), (const bf16_t*)(ws + W_AOUT), DM, DM, E); }
    GBAR();
    { EpiGU E; E.act = (bf16_t*)(ws + O_ACT); E.ss = ss + MT; run_gemm(lds, hb, (const bf16_t*)(ws + W_GU0), 2 * DFF, DM, E); }
    GBAR();
    { EpiRes<false, false> E; E.xres = nullptr; E.hb = hb; E.outf = nullptr; E.ssn = ss + 2 * MT; run_gemm(lds, (const bf16_t*)(ws + O_ACT), (const bf16_t*)(ws + W_DN0), DM, DFF, E); }
    GBAR();
    { EpiSsdIn E; E.z = (bf16_t*)p.out; E.xbc = (bf16_t*)(ws + O_XBC); E.dt = (float*)(ws + O_DT); E.ss = ss + 2 * MT; dt_proj(lds, p); run_gemm(lds, hb, (const bf16_t*)(ws + W_SIN), 6144, DM, E); }
    GBAR();
    ssd_states_phase(lds, p);
#ifdef DUP_S2
    GBAR(); ssd_states_phase(lds, p);
#endif
    GBAR();
#ifdef DRY_S3
    ssd_scan_phase(p, p.ws != nullptr); GBAR();
#endif
    ssd_scan_phase(p, DRYV);
    GBAR();
#ifdef DRY_S4
    ssd_out_phase(lds, p, p.ws != nullptr); GBAR();
#endif
    ssd_out_phase(lds, p, DRYV);
    GBAR();
    { EpiRes<false, false> E; E.xres = nullptr; E.hb = hb; E.outf = nullptr; E.ssn = ss + 3 * MT; run_gemm(lds, (const bf16_t*)p.out, (const bf16_t*)(ws + W_SOUT), DM, DIN, E); }
    GBAR();
    { EpiGU E; E.act = (bf16_t*)(ws + O_ACT); E.ss = ss + 3 * MT; run_gemm(lds, hb, (const bf16_t*)(ws + W_GU1), 2 * DFF, DM, E); }
    GBAR();
    if (gridDim.x == 256) {
        EpiFinal E; E.hb = hb; E.outf = p.out; E.ssn = ss + 4 * MT; E.cnt = (unsigned*)(ws + O_BAR) + XCD_BAR_WORDS; E.fw = p.in[22];
        run_gemm(lds, (const bf16_t*)(ws + O_ACT), (const bf16_t*)(ws + W_DN1), DM, DFF, E);
    } else {
        { EpiRes<false, true> E; E.xres = nullptr; E.hb = hb; E.outf = p.out; E.ssn = ss + 4 * MT; run_gemm(lds, (const bf16_t*)(ws + O_ACT), (const bf16_t*)(ws + W_DN1), DM, DFF, E); }
        GBAR();
        const float* ss4 = ss + 4 * MT; const f32x4* fw = (const f32x4*)p.in[22]; f32x4* o4 = (f32x4*)p.out;
        for (int i = blockIdx.x * 512 + threadIdx.x; i < MT * (DM / 4); i += gridDim.x * 512) {
            const int row = i >> 8; const float rs = __builtin_amdgcn_rsqf(ss4[row] * (1.0f / 1024.0f) + 1e-6f);
            o4[i] = o4[i] * rs * fw[i & 255];
        }
    }
}

extern "C" void kernel_launch(void* const* d_in, const int* in_sizes, int n_in, void* d_out, int out_size, void* d_ws, size_t ws_size, hipStream_t stream) {
    static int grid_blocks = 0;
    if (!grid_blocks) {
        int dev = 0, cus = 0, per_cu = 0;
        hipGetDevice(&dev);
        hipDeviceGetAttribute(&cus, hipDeviceAttributeMultiprocessorCount, dev);
        if (hipFuncSetAttribute((const void*)fwd_megakernel, hipFuncAttributeMaxDynamicSharedMemorySize, LDS_BYTES) != hipSuccess) fprintf(stderr, "hipFuncSetAttribute failed\n");
        if (hipOccupancyMaxActiveBlocksPerMultiprocessor(&per_cu, (const void*)fwd_megakernel, 512, LDS_BYTES) != hipSuccess || per_cu < 1) { fprintf(stderr, "occupancy query: %d\n", per_cu); per_cu = 1; }
        (void)hipGetLastError();
        grid_blocks = cus * per_cu;
        if (ws_size < 268435456ull || n_in != 23) fprintf(stderr, "unexpected ws_size %zu / n_in %d\n", ws_size, n_in);
    }
    if (hipMemsetAsync((char*)d_ws + O_BAR, 0, 20480, stream) != hipSuccess) fprintf(stderr, "memset failed\n");
    Params p{};
    for (int i = 0; i < 23; ++i) p.in[i] = (const float*)d_in[i];
    p.out = (float*)d_out; p.ws = (unsigned char*)d_ws;
    void* args[] = {&p};
    hipError_t e = hipLaunchCooperativeKernel((const void*)fwd_megakernel, dim3(grid_blocks), dim3(512), args, LDS_BYTES, stream);
    if (e != hipSuccess) fprintf(stderr, "cooperative launch failed: %s (grid %d)\n", hipGetErrorString(e), grid_blocks);
}
#ifdef PHASE_TEST
__global__ void __launch_bounds__(512, 2) t_phase0(Params p) { extern __shared__ __attribute__((aligned(16))) unsigned char shm[]; phase0((LAS unsigned char*)shm, p); }
__global__ void __launch_bounds__(512, 2) t_attn_diff(Params p) { extern __shared__ __attribute__((aligned(16))) unsigned char shm[]; diff_tile((LAS unsigned char*)shm, (const bf16_t*)(p.ws + O_PROJ), (bf16_t*)(p.ws + O_MIXED), p.in[7], 0.3f, blockIdx.x & 1, blockIdx.y, blockIdx.z); }
__global__ void __launch_bounds__(512, 2) t_attn_sb(Params p) { extern __shared__ __attribute__((aligned(16))) unsigned char shm[]; sb_block((LAS unsigned char*)shm, (const bf16_t*)(p.ws + O_PROJ), (bf16_t*)(p.ws + O_MIXED), blockIdx.x & 1, blockIdx.y, blockIdx.z); }
__global__ void __launch_bounds__(512, 2) t_ssd_states(Params p) { extern __shared__ __attribute__((aligned(16))) unsigned char shm[]; ssd_states_phase((LAS unsigned char*)shm, p); }
__global__ void __launch_bounds__(512, 2) t_ssd_scan(Params p) { ssd_scan_phase(p, false); }
__global__ void __launch_bounds__(512, 2) t_ssd_out(Params p) { extern __shared__ __attribute__((aligned(16))) unsigned char shm[]; ssd_out_phase((LAS unsigned char*)shm, p, false); }
__global__ void __launch_bounds__(512, 2) t_gemm_ain(Params p) { extern __shared__ __attribute__((aligned(16))) unsigned char shm[]; EpiAttnIn E; E.O = (bf16_t*)(p.ws + O_PROJ); E.ss = (float*)(p.ws + O_SS); E.tab = (const f32x4*)(p.ws + O_ROPE); run_gemm((LAS unsigned char*)shm, (bf16_t*)(p.ws + O_HB), (const bf16_t*)(p.ws + W_AIN), AINW, DM, E); }
__global__ void __launch_bounds__(512, 2) t_gemm_res(Params p) { extern __shared__ __attribute__((aligned(16))) unsigned char shm[]; EpiRes<false, false> E; E.xres = nullptr; E.hb = (bf16_t*)(p.ws + O_HB); E.outf = nullptr; E.ssn = (float*)(p.ws + O_SS); run_gemm((LAS unsigned char*)shm, (bf16_t*)(p.ws + O_ACT), (const bf16_t*)(p.ws + W_DN0), DM, DFF, E); }
__global__ void __launch_bounds__(512, 2) t_gemm_gu(Params p) { extern __shared__ __attribute__((aligned(16))) unsigned char shm[]; EpiGU E; E.act = (bf16_t*)(p.ws + O_ACT); E.ss = (float*)(p.ws + O_SS); run_gemm((LAS unsigned char*)shm, (bf16_t*)(p.ws + O_HB), (const bf16_t*)(p.ws + W_GU0), 2 * DFF, DM, E); }
__global__ void __launch_bounds__(512, 2) t_gemm_ssdin(Params p) { extern __shared__ __attribute__((aligned(16))) unsigned char shm[]; EpiSsdIn E; E.z = (bf16_t*)p.out; E.xbc = (bf16_t*)(p.ws + O_XBC); E.dt = (float*)(p.ws + O_DT); E.ss = (float*)(p.ws + O_SS); run_gemm((LAS unsigned char*)shm, (bf16_t*)(p.ws + O_HB), (const bf16_t*)(p.ws + W_SIN), SINWP, DM, E); }
#endif
```

```cpp
#include <hip/hip_runtime.h>
#include <hip/hip_cooperative_groups.h>
#include <cstdio>
#include <cstdint>
namespace cg = cooperative_groups;
namespace pg8 {
#define PG8_LAS __attribute__((address_space(3)))
typedef unsigned short bf16_t;
typedef short bf16x8 __attribute__((ext_vector_type(8)));
typedef float f32x4 __attribute__((ext_vector_type(4)));
typedef unsigned u32x4 __attribute__((ext_vector_type(4)));
constexpr int BM = 256, BK = 64, HALF = 128, HTB = HALF * BK * 2  , STAGE_BYTES = 8 * HTB, NXCD = 8, WGM = 8;

__host__ __device__ __forceinline__ int lds_byte(int r, int c) { const int st = (r >> 4) * 2 + (c >> 5), rr = r & 15, cc = c & 31, ob = rr * 64 + cc * 2; return st * 1024 + (ob ^ (((ob >> 9) & 1) << 5)); }
__host__ __device__ __forceinline__ void stage_rc(int b, int& R, int& C) { const int st = b / 1024, sb = b % 1024, swz = sb ^ (((sb >> 9) & 1) << 5); R = (st >> 1) * 16 + swz / 64; C = (st & 1) * 32 + (swz % 64) / 2; }
__host__ __device__ __forceinline__ int perm32(int rho) { const int n = rho >> 4, i = rho & 15; return 8 * (i >> 2) + 4 * n + (i & 3); }

struct Unit { int pm, pn; };
struct Gemm { const bf16_t* A; const bf16_t* Bt; int M, N, K; };

struct StaticOrder {
    int nM, nN, nwg, G, c;
    __host__ __device__ void init(int M, int N, int G_, int c_) { nM = M / BM; nN = N / BM; nwg = nM * nN; G = G_; c = c_; }
    __host__ __device__ bool next(int i, Unit& u) const {
        const long L = (long)i * G + c; if (L >= nwg) return false;
        int wgid = (int)L; { const int q = nwg / NXCD, r = nwg % NXCD, xcd = wgid % NXCD, off = wgid / NXCD; wgid = (xcd < r ? xcd * (q + 1) : r * (q + 1) + (xcd - r) * q) + off; }
        const int nig = WGM * nN, gid = wgid / nig, fm = gid * WGM, gsz = (nM - fm) < WGM ? (nM - fm) : WGM;
        u.pm = fm + ((wgid % nig) % gsz); u.pn = (wgid % nig) / gsz; return true;
    }
    __device__ __forceinline__ void a_ready(const Unit&) const {}
    __device__ __forceinline__ void done(const Unit&) const {}
};

template <class Epi, class Sched, bool ALIGN_EPI = false, bool SP2 = false>
__device__ __forceinline__ void gemm_phase(PG8_LAS unsigned char* lds, const Gemm g, const Sched& S, const Epi& E) {
    int tid_ = threadIdx.x; asm volatile("" : "+v"(tid_)); const int tid = tid_, wid = __builtin_amdgcn_readfirstlane(tid >> 6), lane = tid & 63, wr = wid >> 2, wc = wid & 3, fr = lane & 15, fq = lane >> 4;
    const int K = g.K, nt = K / BK;
    unsigned voffA[2], voffB[2];
#pragma unroll
    for (int i = 0; i < 2; ++i) { int R, C; stage_rc(tid * 16 + i * 8192, R, C); const int Rb = Epi::PERM ? ((R & ~31) + perm32(R & 31)) : R;
        voffA[i] = (unsigned)(R * K + C) * 2u; voffB[i] = (unsigned)(Rb * K + C) * 2u; }
    const size_t kstep = (size_t)(BK * 2);
    const size_t hstep = (size_t)HALF * K * 2;
    const size_t tstep = 2 * hstep;
    const unsigned ldsw = (unsigned)wid * 1024u;
    const int aoff = lds_byte(wr * 64 + fr, fq * 8), boff = lds_byte(wc * 32 + fr, fq * 8);
#define PG8_SA(b, h) (((b) * 2 + (h)) * HTB)
#define PG8_SB(b, h) ((4 + (b) * 2 + (h)) * HTB)
#define PG8_STAGE(bufoff, gbase, voff) do { _Pragma("unroll") for (int _i = 0; _i < 2; ++_i) \
        __builtin_amdgcn_global_load_lds((const unsigned*)((const char*)(gbase) + (voff)[_i]), (PG8_LAS unsigned*)(lds + (bufoff) + ldsw + _i * 8192), 16, 0, 0); } while (0)
#define PG8_LDA(dst, b, h) do { _Pragma("unroll") for (int m = 0; m < 4; ++m) _Pragma("unroll") for (int k = 0; k < 2; ++k) dst[m][k] = *(const PG8_LAS bf16x8*)(lds + PG8_SA(b, h) + aoff + m * 2048 + k * 1024); } while (0)
#define PG8_LDB(dst, b, h) do { _Pragma("unroll") for (int n = 0; n < 2; ++n) _Pragma("unroll") for (int k = 0; k < 2; ++k) dst[n][k] = *(const PG8_LAS bf16x8*)(lds + PG8_SB(b, h) + boff + n * 2048 + k * 1024); } while (0)
#define PG8_MMA(ai, bj, At, Bt) do { __builtin_amdgcn_s_setprio(1); _Pragma("unroll") for (int m = 0; m < 4; ++m) _Pragma("unroll") for (int n = 0; n < 2; ++n) _Pragma("unroll") for (int k = 0; k < 2; ++k) \
        acc[ai][bj][m][n] = __builtin_amdgcn_mfma_f32_16x16x32_bf16(Bt[n][k], At[m][k], acc[ai][bj][m][n], 0, 0, 0); __builtin_amdgcn_s_setprio(0); } while (0)
#define PG8_WAIT_V(n) asm volatile("s_waitcnt vmcnt(" #n ")" ::: "memory")
#define PG8_WAIT_L(n) asm volatile("s_waitcnt lgkmcnt(" #n ")" ::: "memory")
#define PG8_BAR __builtin_amdgcn_s_barrier()
#define PG8_SCHED __builtin_amdgcn_sched_barrier(0)
    Unit cur, nxt; int ui = 0;
    if (!S.next(0, cur)) return;
    f32x4 acc[2][2][4][2];
#pragma unroll
    for (int a = 0; a < 2; ++a)
#pragma unroll
        for (int b = 0; b < 2; ++b)
#pragma unroll
            for (int m = 0; m < 4; ++m)
#pragma unroll
                for (int n = 0; n < 2; ++n) acc[a][b][m][n] = (f32x4){0.f, 0.f, 0.f, 0.f};
    bf16x8 At[4][2], B0[2][2], B1[2][2];
    float epre[8]; E.pre(cur, wr, fr, epre);
    const char* cA = (const char*)g.A + (size_t)cur.pm * tstep; const char* cB = (const char*)g.Bt + (size_t)cur.pn * tstep;
    S.a_ready(cur);
    if constexpr (SP2) {
        PG8_STAGE(PG8_SB(0, 0), cB, voffB); PG8_STAGE(PG8_SB(0, 1), cB + hstep, voffB); PG8_STAGE(PG8_SA(0, 0), cA, voffA); PG8_STAGE(PG8_SA(0, 1), cA + hstep, voffA);
        if (wr == 1) PG8_BAR;
        PG8_WAIT_V(2); PG8_BAR;
        PG8_STAGE(PG8_SB(1, 0), cB + kstep, voffB); PG8_STAGE(PG8_SA(1, 0), cA + kstep, voffA); PG8_STAGE(PG8_SB(1, 1), cB + hstep + kstep, voffB);
        PG8_WAIT_V(6); PG8_BAR;
    } else {
        PG8_STAGE(PG8_SB(0, 0), cB, voffB); PG8_STAGE(PG8_SA(0, 0), cA, voffA); PG8_STAGE(PG8_SB(0, 1), cB + hstep, voffB); PG8_STAGE(PG8_SA(0, 1), cA + hstep, voffA);
        if (wr == 1) PG8_BAR;
        PG8_WAIT_V(4); PG8_BAR;
        PG8_STAGE(PG8_SB(1, 0), cB + kstep, voffB); PG8_STAGE(PG8_SA(1, 0), cA + kstep, voffA); PG8_STAGE(PG8_SB(1, 1), cB + hstep + kstep, voffB);
        PG8_WAIT_V(6); PG8_BAR;
    }
    for (;;) {
        const bool has_next = S.next(ui + 1, nxt);
        const char* nA = has_next ? (const char*)g.A + (size_t)nxt.pm * tstep : cA; const char* nB = has_next ? (const char*)g.Bt + (size_t)nxt.pn * tstep : cB;
        for (int t = 0; t < nt; t += 2) {
            const bool last = (t == nt - 2);
            const char* a1 = cA + (size_t)(t + 1) * kstep;
            const char* a2 = last ? nA : cA + (size_t)(t + 2) * kstep; const char* b2 = last ? nB : cB + (size_t)(t + 2) * kstep;
            const char* a3 = a2 + kstep; const char* b3 = b2 + kstep;
            if (last && has_next) S.a_ready(nxt);
            if constexpr (SP2) {
            PG8_LDB(B0, 0, 0); PG8_LDB(B1, 0, 1); PG8_SCHED; PG8_LDA(At, 0, 0); PG8_STAGE(PG8_SA(1, 1), a1 + hstep, voffA);
            PG8_WAIT_V(8); PG8_WAIT_L(0); PG8_BAR; PG8_MMA(0, 0, At, B0); PG8_MMA(0, 1, At, B1); PG8_BAR; PG8_SCHED;
            PG8_LDA(At, 0, 1); PG8_STAGE(PG8_SB(0, 0), b2, voffB); PG8_STAGE(PG8_SB(0, 1), b2 + hstep, voffB); PG8_STAGE(PG8_SA(0, 0), a2, voffA);
            PG8_WAIT_V(8); PG8_WAIT_L(0); PG8_BAR; PG8_MMA(1, 0, At, B0); PG8_MMA(1, 1, At, B1); PG8_BAR; PG8_SCHED;
            PG8_LDB(B0, 1, 0); PG8_LDB(B1, 1, 1); PG8_SCHED; PG8_LDA(At, 1, 0); PG8_STAGE(PG8_SA(0, 1), a2 + hstep, voffA);
            PG8_WAIT_V(8); PG8_WAIT_L(0); PG8_BAR; PG8_MMA(0, 0, At, B0); PG8_MMA(0, 1, At, B1); PG8_BAR; PG8_SCHED;
            PG8_LDA(At, 1, 1); PG8_STAGE(PG8_SB(1, 0), b3, voffB); PG8_STAGE(PG8_SB(1, 1), b3 + hstep, voffB); PG8_STAGE(PG8_SA(1, 0), a3, voffA);
            PG8_WAIT_V(8); PG8_WAIT_L(0); PG8_BAR; PG8_MMA(1, 0, At, B0); PG8_MMA(1, 1, At, B1); PG8_BAR; PG8_SCHED;
            } else {
            PG8_LDB(B0, 0, 0); PG8_SCHED; PG8_LDA(At, 0, 0); PG8_STAGE(PG8_SA(1, 1), a1 + hstep, voffA);
            PG8_WAIT_L(8); PG8_BAR; PG8_WAIT_L(0); PG8_MMA(0, 0, At, B0); PG8_BAR; PG8_SCHED;
            PG8_LDB(B1, 0, 1); PG8_STAGE(PG8_SB(0, 0), b2, voffB);
            PG8_BAR; PG8_WAIT_L(0); PG8_MMA(0, 1, At, B1); PG8_BAR;
            PG8_LDA(At, 0, 1); PG8_STAGE(PG8_SA(0, 0), a2, voffA);
            PG8_BAR; PG8_WAIT_L(0); PG8_MMA(1, 0, At, B0); PG8_BAR; PG8_SCHED;
            PG8_STAGE(PG8_SB(0, 1), b2 + hstep, voffB);
            PG8_WAIT_V(6); PG8_BAR; PG8_MMA(1, 1, At, B1); PG8_BAR;
            PG8_LDB(B0, 1, 0); PG8_SCHED; PG8_LDA(At, 1, 0); PG8_STAGE(PG8_SA(0, 1), a2 + hstep, voffA);
            PG8_WAIT_L(8); PG8_BAR; PG8_WAIT_L(0); PG8_MMA(0, 0, At, B0); PG8_BAR; PG8_SCHED;
            PG8_LDB(B1, 1, 1); PG8_STAGE(PG8_SB(1, 0), b3, voffB);
            PG8_BAR; PG8_WAIT_L(0); PG8_MMA(0, 1, At, B1); PG8_BAR;
            PG8_LDA(At, 1, 1); PG8_STAGE(PG8_SA(1, 0), a3, voffA);
            PG8_BAR; PG8_WAIT_L(0); PG8_MMA(1, 0, At, B0); PG8_BAR; PG8_SCHED;
            PG8_STAGE(PG8_SB(1, 1), b3 + hstep, voffB);
            PG8_WAIT_V(6); PG8_BAR; PG8_MMA(1, 1, At, B1); PG8_BAR;
            }
        }
        if constexpr (ALIGN_EPI) { if (wr == 0) PG8_BAR; }
        if constexpr (!Epi::AFTER_DRAIN) { E(acc, cur, wr, wc, fr, fq, epre); S.done(cur); }
        if (!has_next) break;
        E.pre(nxt, wr, fr, epre);
#pragma unroll
        for (int a = 0; a < 2; ++a)
#pragma unroll
            for (int b = 0; b < 2; ++b)
#pragma unroll
                for (int m = 0; m < 4; ++m)
#pragma unroll
                    for (int n = 0; n < 2; ++n) acc[a][b][m][n] = (f32x4){0.f, 0.f, 0.f, 0.f};
        cur = nxt; cA = nA; cB = nB; ++ui;
        if constexpr (ALIGN_EPI) { if (wr == 1) PG8_BAR; }
    }
    PG8_WAIT_V(0);
    if constexpr (!ALIGN_EPI) { if (wr == 0) PG8_BAR; }
    PG8_BAR;
    if constexpr (Epi::AFTER_DRAIN) { E.fused(acc, cur, wr, wc, fr, fq, lds, wid, lane); S.done(cur); }
#undef PG8_SA
#undef PG8_SB
#undef PG8_STAGE
#undef PG8_LDA
#undef PG8_LDB
#undef PG8_MMA
#undef PG8_WAIT_V
#undef PG8_WAIT_L
#undef PG8_BAR
#undef PG8_SCHED
}
}
using pg8::bf16_t; using pg8::bf16x8; using pg8::f32x4;
typedef short s16x4 __attribute__((ext_vector_type(4)));
typedef float f32x16 __attribute__((ext_vector_type(16)));
typedef float f32x2 __attribute__((ext_vector_type(2)));
typedef __bf16 bf2_t __attribute__((ext_vector_type(2)));
typedef unsigned u32x2 __attribute__((ext_vector_type(2)));
typedef unsigned u32x4 __attribute__((ext_vector_type(4)));
#define LAS __attribute__((address_space(3)))
#define DI __device__ __forceinline__
#define MFMA32(a, b, c) __builtin_amdgcn_mfma_f32_32x32x16_bf16((a), (b), (c), 0, 0, 0)

DI int otid() { int t = threadIdx.x; asm volatile("" : "+v"(t)); return t; }
DI unsigned pk2(float a, float b) { f32x2 v = {a, b}; bf2_t r = __builtin_convertvector(v, bf2_t); return __builtin_bit_cast(unsigned, r); }
DI float bflo(unsigned u) { return __uint_as_float(u << 16); }
DI float bfhi(unsigned u) { return __uint_as_float(u & 0xffff0000u); }
DI float fexp2(float x) { return __builtin_amdgcn_exp2f(x); }
DI float frcp(float x) { return __builtin_amdgcn_rcpf(x); }
DI float fsilu(float x) { return x * frcp(1.0f + fexp2(-1.44269504089f * x)); }
DI int crow(int i, int h) { return (i & 3) + 8 * (i >> 2) + 4 * h; }
DI s16x4 trr(const LAS unsigned char* p) { return __builtin_amdgcn_ds_read_tr16_b64_v4i16((LAS s16x4*)p); }
DI bf16x8 tr2(const LAS unsigned char* p0, const LAS unsigned char* p1) { s16x4 a = trr(p0), b = trr(p1); return __builtin_shufflevector(a, b, 0, 1, 2, 3, 4, 5, 6, 7); }
DI bf16x8 pack8(const f32x16& x, int s) {
    u32x4 p; p[0] = pk2(x[8 * s], x[8 * s + 1]); p[1] = pk2(x[8 * s + 2], x[8 * s + 3]); p[2] = pk2(x[8 * s + 4], x[8 * s + 5]); p[3] = pk2(x[8 * s + 6], x[8 * s + 7]);
    return __builtin_bit_cast(bf16x8, p);
}
DI f32x16 zero16() { f32x16 z; for (int i = 0; i < 16; ++i) z[i] = 0.f; return z; }

constexpr int MT = 16384, SEQ = 8192, DM = 1024, DFF = 2816, AINW = 3072, SINW = 6176, SINWP = 6400, DIN = 2048, XBCW = 4096;
constexpr float LOG2E = 1.44269504089f;
constexpr int LDS_BYTES = 155648;
constexpr size_t W_AIN = 0, W_AOUT = W_AIN + (size_t)AINW * DM * 2, W_GU0 = W_AOUT + (size_t)DM * DM * 2, W_DN0 = W_GU0 + (size_t)2 * DFF * DM * 2,
                 W_SIN = W_DN0 + (size_t)DM * DFF * 2, W_SOUT = W_SIN + (size_t)SINWP * DM * 2, W_GU1 = W_SOUT + (size_t)DM * DIN * 2, W_DN1 = W_GU1 + (size_t)2 * DFF * DM * 2,
                 O_HB = W_DN1 + (size_t)DM * DFF * 2, O_SS = O_HB + (size_t)MT * DM * 2, O_ROPE = O_SS + (size_t)5 * MT * 4, O_DT = O_ROPE + (size_t)SEQ * 32 * 8,
                 O_CDEC = O_DT + (size_t)MT * 32 * 4, O_LAM = O_CDEC + 16384, O_BAR = O_LAM + 256, O_R = 98566144;
static_assert(O_BAR + 20480 <= O_R, "map");
constexpr size_t O_PROJ = O_R, O_MIXED = O_PROJ + (size_t)MT * AINW * 2, O_ACT = O_R, O_XBC = O_R, O_ST1 = O_XBC + (size_t)MT * XBCW * 2, O_ST0 = 0;
constexpr size_t ST_BATCH = (size_t)64 * 32 * 64 * 128;
static_assert(O_ST1 + ST_BATCH * 2 <= 268435456ull, "ws");
static_assert(ST_BATCH * 2 <= W_SOUT, "st0 overlay");
static_assert(O_MIXED + (size_t)MT * DM * 2 <= 268435456ull, "ws2");

struct Params { const float* in[23]; float* out; unsigned char* ws; };
#include <cstdlib>
#include <vector>

#define XB_TMO      128
#define XB_XCNT(j)  (256  + 64 * (j))
#define XB_XSUB(j)  (1280 + 64 * (j))
#define XB_XGEN(j)  (2304 + 64 * (j))
#define XB_TOP      3328
#define XB_TOPGEN   3392
#define XCD_BAR_WORDS 3456
#define XB_SPIN_CAP (1u << 18)

__device__ __forceinline__ unsigned xb_ld(unsigned* p)              { return __hip_atomic_load(p, __ATOMIC_RELAXED, __HIP_MEMORY_SCOPE_AGENT); }
__device__ __forceinline__ unsigned xb_add(unsigned* p, unsigned v) { return __hip_atomic_fetch_add(p, v, __ATOMIC_RELAXED, __HIP_MEMORY_SCOPE_AGENT); }
__device__ __forceinline__ unsigned xb_xcc_id() { return (unsigned)__builtin_amdgcn_s_getreg((3 << 11) | 20) & 0xFu; }
#define XB_SPIN(cond, bar) do { unsigned _sp = 0; while (cond) { \
    if ((++_sp & 255u) == 0u) { if (xb_ld(&(bar)[XB_TMO])) break; if (_sp > XB_SPIN_CAP) { atomicAdd(&(bar)[XB_TMO], 1u); break; } } } } while (0)

struct XcdBarrier {
    unsigned* bar; unsigned x;
    volatile LAS unsigned* st;
};

__device__ __forceinline__ XcdBarrier xcd_barrier_post(unsigned* bar, volatile LAS unsigned* st) {
    XcdBarrier b; b.bar = bar; b.x = xb_xcc_id(); b.st = st;
    if (threadIdx.x == 0) (void)xb_add(&bar[XB_XCNT(b.x)], 1u);
    return b;
}
__device__ __forceinline__ void xcd_barrier_complete(unsigned* bar, unsigned x, unsigned& nloc, unsigned& nx) {
    const unsigned G = gridDim.x * gridDim.y * gridDim.z;
    unsigned sum, cnt, mine, sp = 0u;
    for (;;) {
        sum = 0u; cnt = 0u; mine = 0u;
#pragma unroll
        for (unsigned j = 0; j < 16; ++j) { const unsigned c = xb_ld(&bar[XB_XCNT(j)]); sum += c; cnt += (c > 0u) ? 1u : 0u; mine = (j == x) ? c : mine; }
        if (sum == G) break;
        __builtin_amdgcn_s_sleep(1);
        if ((++sp & 255u) == 0u) { if (xb_ld(&bar[XB_TMO])) break; if (sp > XB_SPIN_CAP) { atomicAdd(&bar[XB_TMO], 1u); break; } }
    }
    nloc = mine > 0u ? mine : 1u; nx = cnt > 0u ? cnt : 1u;
}

__device__ __forceinline__ void xcd_barrier(const XcdBarrier& b) {
    asm volatile("s_waitcnt vmcnt(0)" ::: "memory");
    __syncthreads();
    if (threadIdx.x == 0) {
        unsigned* bar = b.bar;
        __builtin_amdgcn_s_waitcnt(0);
        unsigned nloc = b.st[0], nx = b.st[1];
        if (nloc == 0u) { xcd_barrier_complete(bar, b.x, nloc, nx); b.st[0] = nloc; b.st[1] = nx; }
        const unsigned old = xb_add(&bar[XB_XSUB(b.x)], 1u);
        const unsigned gen = old / nloc;
        if (old + 1u == (gen + 1u) * nloc) {
            __builtin_amdgcn_fence(__ATOMIC_RELEASE, "agent");
            asm volatile("s_waitcnt vmcnt(0)" ::: "memory");
            const unsigned og = xb_add(&bar[XB_TOP], 1u);
            const unsigned tg = og / nx;
            if (og + 1u == (tg + 1u) * nx) xb_add(&bar[XB_TOPGEN], 1u);
            else XB_SPIN(xb_ld(&bar[XB_TOPGEN]) == tg, bar);
            __builtin_amdgcn_fence(__ATOMIC_ACQUIRE, "agent");
            asm volatile("s_waitcnt vmcnt(0)" ::: "memory");
        } else {
            XB_SPIN(xb_ld(&bar[XB_TOPGEN]) <= gen, bar);
            __builtin_amdgcn_fence(__ATOMIC_ACQUIRE, "agent");
            asm volatile("s_waitcnt vmcnt(0)" ::: "memory");
        }
    }
    __syncthreads();
}
DI void wmap(int mode, int c, int& src, float& scale, int& which) {
    src = c; scale = 1.f; which = 0;
    if (mode == 0) {
        if (c < 1024) { const int base = c & ~63, cc = c & 63, g = cc >> 3, e = cc & 7; src = base + (e < 4 ? 4 * g + e : 32 + 4 * g + (e - 4)); }
        if (c < 512) scale = 0.125f * LOG2E; else if (c >= 1536 && c < 2048) scale = 0.125f;
    } else if (mode == 2) { src = 128 * (c >> 8) + (c & 127); which = (c >> 7) & 1; }
    else if (mode == 3) { if (c >= SINW) src = -1; }
}
struct WJob { int mode, K, ldw, tix; const float* W0; const float* W1; const float* ks; bf16_t* dst; };
DI WJob wjob(const Params& p, int t) {
    unsigned char* ws = p.ws;
    const int cnt[8] = {48 * 4, 16 * 4, 88 * 4, 16 * 11, 100 * 4, 16 * 8, 88 * 4, 16 * 11};
    int j = 0, tt = t;
#pragma unroll
    for (int q = 0; q < 7; ++q) if (j == q && tt >= cnt[q]) { tt -= cnt[q]; j = q + 1; }
    WJob J; J.tix = tt; J.W1 = nullptr; J.ks = nullptr;
    switch (j) {
    case 0: J.mode = 0; J.W0 = p.in[2]; J.ks = p.in[1]; J.dst = (bf16_t*)(ws + W_AIN); J.K = DM; J.ldw = AINW; break;
    case 1: J.mode = 1; J.W0 = p.in[8]; J.dst = (bf16_t*)(ws + W_AOUT); J.K = DM; J.ldw = DM; break;
    case 2: J.mode = 2; J.W0 = p.in[19]; J.W1 = p.in[20]; J.ks = p.in[18]; J.dst = (bf16_t*)(ws + W_GU0); J.K = DM; J.ldw = DFF; break;
    case 3: J.mode = 1; J.W0 = p.in[21]; J.dst = (bf16_t*)(ws + W_DN0); J.K = DFF; J.ldw = DM; break;
    case 4: J.mode = 3; J.W0 = p.in[10]; J.ks = p.in[9]; J.dst = (bf16_t*)(ws + W_SIN); J.K = DM; J.ldw = SINW; break;
    case 5: J.mode = 1; J.W0 = p.in[17]; J.dst = (bf16_t*)(ws + W_SOUT); J.K = DIN; J.ldw = DM; break;
    case 6: J.mode = 2; J.W0 = p.in[19] + (size_t)DM * DFF; J.W1 = p.in[20] + (size_t)DM * DFF; J.ks = p.in[18] + DM; J.dst = (bf16_t*)(ws + W_GU1); J.K = DM; J.ldw = DFF; break;
    default: J.mode = 1; J.W0 = p.in[21] + (size_t)DFF * DM; J.dst = (bf16_t*)(ws + W_DN1); J.K = DFF; J.ldw = DM; break;
    }
    return J;
}
DI void wtile_load(const WJob& J, int tid, float (&v)[32], float& sc, int& srcok) {
    const int nk = J.K >> 8, c0 = (J.tix / nk) * 64, k0 = (J.tix % nk) * 256, cc = tid & 63; int src, which; wmap(J.mode, c0 + cc, src, sc, which);
    const float* W = (which ? J.W1 : J.W0) + (src >= 0 ? src : 0); srcok = (src >= 0);
#pragma unroll
    for (int i = 0; i < 32; ++i) { const int kk = (tid >> 6) + 8 * i; v[i] = W[(size_t)(k0 + kk) * J.ldw]; }
}
DI void wtile_store(LAS float* tile, const WJob& J, int tid, const float (&v)[32], float sc, int srcok) {
    const int nk = J.K >> 8, c0 = (J.tix / nk) * 64, k0 = (J.tix % nk) * 256, cc = tid & 63;
#pragma unroll
    for (int i = 0; i < 32; ++i) { const int kk = (tid >> 6) + 8 * i; float x = srcok ? v[i] * sc : 0.f; if (J.ks) x *= J.ks[k0 + kk]; tile[kk * 65 + cc] = x; }
    __syncthreads();
#pragma unroll
    for (int i = 0; i < 16; ++i) {
        const int idx = tid + 512 * i, c2 = idx >> 7, k2 = (idx & 127) * 2;
        *(unsigned*)(J.dst + (size_t)(c0 + c2) * J.K + k0 + k2) = pk2(tile[k2 * 65 + c2], tile[(k2 + 1) * 65 + c2]);
    }
    __syncthreads();
}
DI void wconv_jobs(LAS unsigned char* lds, const Params& p, int wi, int nb) {
    const int tid = otid(); const int total = 48 * 4 + 16 * 4 + 2 * (88 * 4 + 16 * 11) + 100 * 4 + 16 * 8;
    if (wi >= total) return;
    WJob J = wjob(p, wi); float v[32]; float sc; int ok;
    wtile_load(J, tid, v, sc, ok);
    for (int t = wi; t < total; t += nb) {
        const bool more = (t + nb < total);
        WJob Jn = J; float vn[32]; float scn = 0.f; int okn = 0;
        if (more) { Jn = wjob(p, t + nb); wtile_load(Jn, tid, vn, scn, okn); }
        wtile_store((LAS float*)lds, J, tid, v, sc, ok);
        if (more) { J = Jn; sc = scn; ok = okn;
#pragma unroll
            for (int i = 0; i < 32; ++i) v[i] = vn[i]; }
    }
}
DI void phase0(LAS unsigned char* lds, const Params& p) {
    const int tid = otid(), G = gridDim.x, bx = blockIdx.x;
    unsigned char* ws = p.ws;
    wconv_jobs(lds, p, bx, G);
    {
        const int wave = tid >> 6, lane = tid & 63; bf16_t* hb = (bf16_t*)(ws + O_HB); float* ss = (float*)(ws + O_SS);
        for (int row0 = (bx * 8 + wave) * 2; row0 < MT; row0 += G * 16) {
            f32x4 v[2][4];
#pragma unroll
            for (int q = 0; q < 2; ++q)
#pragma unroll
                for (int i = 0; i < 4; ++i) v[q][i] = *(const f32x4*)(p.in[0] + (size_t)(row0 + q) * DM + lane * 4 + 256 * i);
#pragma unroll
            for (int q = 0; q < 2; ++q) {
                float sq = 0.f;
#pragma unroll
                for (int i = 0; i < 4; ++i) { const f32x4 x = v[q][i]; sq += x[0] * x[0] + x[1] * x[1] + x[2] * x[2] + x[3] * x[3];
                    u32x2 o; o[0] = pk2(x[0], x[1]); o[1] = pk2(x[2], x[3]); *(u32x2*)(hb + (size_t)(row0 + q) * DM + lane * 4 + 256 * i) = o; }
#pragma unroll
                for (int o = 32; o >= 1; o >>= 1) sq += __shfl_xor(sq, o);
                if (lane == 0) ss[row0 + q] = sq;
            }
        }
        for (int i = bx * 512 + tid; i < 4 * MT; i += G * 512) ss[MT + i] = 0.f;
        f32x2* tab = (f32x2*)(ws + O_ROPE);
        for (int i = bx * 512 + tid; i < SEQ * 32; i += G * 512) {
            const int pos = i >> 5, f = i & 31; const float inv = fexp2(-(float)f * 0.41524101186092f); const float ang = (float)pos * inv;
            double t = (double)ang * 0.15915494309189535; t -= floor(t); const float tf = (float)t;
            f32x2 cs; cs[0] = __builtin_amdgcn_cosf(tf); cs[1] = __builtin_amdgcn_sinf(tf); tab[i] = cs;
        }
        if (bx == 0 && tid == 0) { float s1 = 0.f, s2 = 0.f; for (int i = 0; i < 64; ++i) { s1 += p.in[3][i] * p.in[4][i]; s2 += p.in[5][i] * p.in[6][i]; }
            *(float*)(ws + O_LAM) = fexp2(s1 * LOG2E) - fexp2(s2 * LOG2E) + 0.2f; }
    }
}

struct EpiAttnIn {
    static constexpr bool PERM = true, AFTER_DRAIN = false;
    bf16_t* O; const float* ss; const f32x4* tab;
    DI void pre(const pg8::Unit& u, int wr, int fr, float (&e)[8]) const {
#pragma unroll
        for (int ai = 0; ai < 2; ++ai)
#pragma unroll
            for (int m = 0; m < 4; ++m) e[ai * 4 + m] = ss[u.pm * 256 + wr * 64 + fr + ai * 128 + m * 16];
    }
    DI void operator()(const f32x4 (&acc)[2][2][4][2], const pg8::Unit& u, int wr, int wc, int fr, int fq, const float (&epre)[8]) const {
        const int row0 = u.pm * 256 + wr * 64 + fr, colt = u.pn * 256, col0 = colt + wc * 32 + 8 * fq;
        const int fb = 4 * (4 * (wc & 1) + fq);
#pragma unroll
        for (int ai = 0; ai < 2; ++ai)
#pragma unroll
            for (int m = 0; m < 4; ++m) {
                const int row = row0 + ai * 128 + m * 16; const float rs = __builtin_amdgcn_rsqf(epre[ai * 4 + m] * (1.0f / 1024.0f) + 1e-6f);
                f32x4 c01 = {1.f, 0.f, 1.f, 0.f}, c23 = {1.f, 0.f, 1.f, 0.f};
                if (colt < 1024) { const int pos = row & (SEQ - 1); c01 = tab[(pos * 32 + fb) >> 1]; c23 = tab[((pos * 32 + fb) >> 1) + 1]; }
#pragma unroll
                for (int bj = 0; bj < 2; ++bj) {
                    f32x4 v0 = acc[ai][bj][m][0] * rs, v1 = acc[ai][bj][m][1] * rs;
                    if (colt < 1024) {
                        const float cs[4] = {c01[0], c01[2], c23[0], c23[2]}, sn[4] = {c01[1], c01[3], c23[1], c23[3]};
#pragma unroll
                        for (int j = 0; j < 4; ++j) { const float t1 = v0[j], t2 = v1[j]; v0[j] = t1 * cs[j] - t2 * sn[j]; v1[j] = t2 * cs[j] + t1 * sn[j]; }
                    }
                    u32x4 o; o[0] = pk2(v0[0], v0[1]); o[1] = pk2(v0[2], v0[3]); o[2] = pk2(v1[0], v1[1]); o[3] = pk2(v1[2], v1[3]);
                    *(u32x4*)(O + (size_t)row * AINW + col0 + bj * 128) = o;
                }
            }
    }
};
template <bool RES_F32, bool OUT_F32> struct EpiRes {
    static constexpr bool PERM = true, AFTER_DRAIN = false;
    const float* xres; bf16_t* hb; float* outf; float* ssn;
    DI void pre(const pg8::Unit&, int, int, float (&)[8]) const {}
    DI void operator()(const f32x4 (&acc)[2][2][4][2], const pg8::Unit& u, int wr, int wc, int fr, int fq, const float (&epre)[8]) const {
        const int row0 = u.pm * 256 + wr * 64 + fr, col0 = u.pn * 256 + wc * 32 + 8 * fq;
#pragma unroll
        for (int ai = 0; ai < 2; ++ai)
#pragma unroll
            for (int m = 0; m < 4; ++m) {
                const int row = row0 + ai * 128 + m * 16; float sq = 0.f;
#pragma unroll
                for (int bj = 0; bj < 2; ++bj) {
                    const size_t off = (size_t)row * DM + col0 + bj * 128; f32x4 r0, r1;
                    if (RES_F32) { r0 = *(const f32x4*)(xres + off); r1 = *(const f32x4*)(xres + off + 4); }
                    else { const u32x4 t = *(const u32x4*)(hb + off); r0[0] = bflo(t[0]); r0[1] = bfhi(t[0]); r0[2] = bflo(t[1]); r0[3] = bfhi(t[1]); r1[0] = bflo(t[2]); r1[1] = bfhi(t[2]); r1[2] = bflo(t[3]); r1[3] = bfhi(t[3]); }
                    const f32x4 v0 = r0 + acc[ai][bj][m][0], v1 = r1 + acc[ai][bj][m][1];
                    sq += v0[0] * v0[0] + v0[1] * v0[1] + v0[2] * v0[2] + v0[3] * v0[3] + v1[0] * v1[0] + v1[1] * v1[1] + v1[2] * v1[2] + v1[3] * v1[3];
                    if (OUT_F32) { *(f32x4*)(outf + off) = v0; *(f32x4*)(outf + off + 4) = v1; }
                    else { u32x4 o; o[0] = pk2(v0[0], v0[1]); o[1] = pk2(v0[2], v0[3]); o[2] = pk2(v1[0], v1[1]); o[3] = pk2(v1[2], v1[3]); *(u32x4*)(hb + off) = o; }
                }
                sq += __shfl_xor(sq, 16); sq += __shfl_xor(sq, 32);
                if (fq == 0) atomicAdd(ssn + row, sq);
            }
    }
};
struct EpiGU {
    static constexpr bool PERM = true, AFTER_DRAIN = false;
    bf16_t* act; const float* ss;
    DI void pre(const pg8::Unit& u, int wr, int fr, float (&e)[8]) const {
#pragma unroll
        for (int ai = 0; ai < 2; ++ai)
#pragma unroll
            for (int m = 0; m < 4; ++m) e[ai * 4 + m] = ss[u.pm * 256 + wr * 64 + fr + ai * 128 + m * 16];
    }
    DI void operator()(const f32x4 (&acc)[2][2][4][2], const pg8::Unit& u, int wr, int wc, int fr, int fq, const float (&epre)[8]) const {
        const int row0 = u.pm * 256 + wr * 64 + fr;
#pragma unroll
        for (int ai = 0; ai < 2; ++ai)
#pragma unroll
            for (int m = 0; m < 4; ++m) {
                const int row = row0 + ai * 128 + m * 16; const float rs = __builtin_amdgcn_rsqf(epre[ai * 4 + m] * (1.0f / 1024.0f) + 1e-6f);
                u32x4 o;
#pragma unroll
                for (int n = 0; n < 2; ++n) {
                    const f32x4 g = acc[ai][0][m][n] * rs, up = acc[ai][1][m][n] * rs; float a[4];
#pragma unroll
                    for (int j = 0; j < 4; ++j) a[j] = fsilu(g[j]) * up[j];
                    o[2 * n] = pk2(a[0], a[1]); o[2 * n + 1] = pk2(a[2], a[3]);
                }
                *(u32x4*)(act + (size_t)row * DFF + u.pn * 128 + wc * 32 + 8 * fq) = o;
            }
    }
};
struct EpiSsdIn {
    static constexpr bool PERM = true, AFTER_DRAIN = false;
    bf16_t* z; bf16_t* xbc; float* dt; const float* ss;
    DI void pre(const pg8::Unit& u, int wr, int fr, float (&e)[8]) const {
#pragma unroll
        for (int ai = 0; ai < 2; ++ai)
#pragma unroll
            for (int m = 0; m < 4; ++m) e[ai * 4 + m] = ss[u.pm * 256 + wr * 64 + fr + ai * 128 + m * 16];
    }
    DI void operator()(const f32x4 (&acc)[2][2][4][2], const pg8::Unit& u, int wr, int wc, int fr, int fq, const float (&epre)[8]) const {
        const int row0 = u.pm * 256 + wr * 64 + fr, col0 = u.pn * 256 + wc * 32 + 8 * fq;
#pragma unroll
        for (int ai = 0; ai < 2; ++ai)
#pragma unroll
            for (int m = 0; m < 4; ++m) {
                const int row = row0 + ai * 128 + m * 16; const float rs = __builtin_amdgcn_rsqf(epre[ai * 4 + m] * (1.0f / 1024.0f) + 1e-6f);
#pragma unroll
                for (int bj = 0; bj < 2; ++bj) {
                    const int c = col0 + bj * 128; const f32x4 v0 = acc[ai][bj][m][0] * rs, v1 = acc[ai][bj][m][1] * rs;
                    if (c < 6144) { u32x4 o; o[0] = pk2(v0[0], v0[1]); o[1] = pk2(v0[2], v0[3]); o[2] = pk2(v1[0], v1[1]); o[3] = pk2(v1[2], v1[3]);
                        if (c < DIN) *(u32x4*)(z + (size_t)row * DIN + c) = o; else *(u32x4*)(xbc + (size_t)row * XBCW + (c - DIN)) = o; }
                }
            }
    }
};

struct EpiFinal {
    static constexpr bool PERM = true, AFTER_DRAIN = true;
    const bf16_t* hb; float* outf; float* ssn; unsigned* cnt; const float* fw;
    DI void operator()(const f32x4 (&)[2][2][4][2], const pg8::Unit&, int, int, int, int, const float (&)[8]) const {}
    DI void pre(const pg8::Unit&, int, int, float (&)[8]) const {}
    DI void fused(f32x4 (&acc)[2][2][4][2], const pg8::Unit& u, int wr, int wc, int fr, int fq, PG8_LAS unsigned char*, int, int) const {
        const int row0 = u.pm * 256 + wr * 64 + fr, col0 = u.pn * 256 + wc * 32 + 8 * fq;
#pragma unroll
        for (int ai = 0; ai < 2; ++ai)
#pragma unroll
            for (int m = 0; m < 4; ++m) {
                const int row = row0 + ai * 128 + m * 16; float sq = 0.f;
#pragma unroll
                for (int bj = 0; bj < 2; ++bj) {
                    const size_t off = (size_t)row * DM + col0 + bj * 128;
                    const u32x4 t = *(const u32x4*)(hb + off);
#pragma unroll
                    for (int n = 0; n < 2; ++n) {
                        f32x4 r; r[0] = bflo(t[2 * n]); r[1] = bfhi(t[2 * n]); r[2] = bflo(t[2 * n + 1]); r[3] = bfhi(t[2 * n + 1]);
                        const f32x4 v = r + acc[ai][bj][m][n]; acc[ai][bj][m][n] = v;
                        sq += v[0] * v[0] + v[1] * v[1] + v[2] * v[2] + v[3] * v[3];
                    }
                }
                sq += __shfl_xor(sq, 16); sq += __shfl_xor(sq, 32);
                if (fq == 0) atomicAdd(ssn + row, sq);
            }
        asm volatile("s_waitcnt vmcnt(0)" ::: "memory");
        __syncthreads();
        unsigned* c = cnt + 16 * u.pm;
        if (threadIdx.x == 0) {
            __builtin_amdgcn_fence(__ATOMIC_RELEASE, "agent"); asm volatile("s_waitcnt vmcnt(0)" ::: "memory");
            __hip_atomic_fetch_add(c, 1u, __ATOMIC_RELAXED, __HIP_MEMORY_SCOPE_AGENT);
            unsigned spins = 0;
            while (__hip_atomic_load(c, __ATOMIC_RELAXED, __HIP_MEMORY_SCOPE_AGENT) < 4u && ++spins < (1u << 22)) __builtin_amdgcn_s_sleep(2);
            __builtin_amdgcn_fence(__ATOMIC_ACQUIRE, "agent"); asm volatile("s_waitcnt vmcnt(0)" ::: "memory");
        }
        __syncthreads();
#pragma unroll
        for (int ai = 0; ai < 2; ++ai)
#pragma unroll
            for (int m = 0; m < 4; ++m) {
                const int row = row0 + ai * 128 + m * 16;
                const float rs = __builtin_amdgcn_rsqf(__hip_atomic_load(ssn + row, __ATOMIC_RELAXED, __HIP_MEMORY_SCOPE_AGENT) * (1.0f / 1024.0f) + 1e-6f);
#pragma unroll
                for (int bj = 0; bj < 2; ++bj)
#pragma unroll
                    for (int n = 0; n < 2; ++n) {
                        const int col = col0 + bj * 128 + n * 4; const f32x4 w = *(const f32x4*)(fw + col);
                        *(f32x4*)(outf + (size_t)row * DM + col) = acc[ai][bj][m][n] * rs * w;
                    }
            }
    }
};
constexpr int KST = 144, VST = 320, VST64 = 192;
constexpr int AT_K1 = 0, AT_K2 = 64 * KST, AT_V = 2 * 64 * KST, AT_STAGE = AT_V + 64 * VST;

DI void diff_tile(LAS unsigned char* lds, const bf16_t* proj, bf16_t* mixed, const float* subln, float lam, int b, int hd, int qt) {
    const int tid = otid(), w = __builtin_amdgcn_readfirstlane(tid >> 6), lane = tid & 63, qg = w & 3, mp = w >> 2, r = lane & 31, h = lane >> 5;
    const int q0 = qt * 128; const size_t rowb = (size_t)b * SEQ;
    bf16x8 qf[4];
    { const bf16_t* qp = proj + (rowb + q0 + 32 * qg + r) * AINW + hd * 128 + mp * 64 + 8 * h;
#pragma unroll
      for (int s = 0; s < 4; ++s) qf[s] = *(const bf16x8*)(qp + 16 * s); }
    f32x16 O[4];
#pragma unroll
    for (int i = 0; i < 4; ++i) O[i] = zero16();
    float mrun = 0.f, lrun = 0.f;
    const int nsteps = 2 * (qt + 1);
    const bf16_t* src[4]; int dst[4];
#pragma unroll
    for (int i = 0; i < 2; ++i) { const int cid = tid + 512 * i, row = cid >> 4, c16 = cid & 15;
        src[i] = proj + (rowb + row) * AINW + 512 + hd * 128 + c16 * 8; dst[i] = (c16 < 8 ? AT_K1 : AT_K2) + row * KST + (c16 & 7) * 16;
        src[2 + i] = proj + (rowb + row) * AINW + 1024 + hd * 128 + c16 * 8; dst[2 + i] = AT_V + row * VST + c16 * 16; }
    u32x4 pf[4];
#pragma unroll
    for (int i = 0; i < 4; ++i) pf[i] = *(const u32x4*)(src[i]);
#pragma unroll
    for (int i = 0; i < 4; ++i) *(LAS u32x4*)(lds + dst[i]) = pf[i];
    __syncthreads();
    const int i16 = lane & 15, tq = i16 >> 2, tp = i16 & 3, g16 = (lane >> 4) & 1;
    const int troff = (4 * h + tq) * VST + (16 * g16 + 4 * tp) * 2;
    for (int j = 0; j < nsteps; ++j) {
        const bool more = (j + 1 < nsteps);
        if (more) {
#pragma unroll
            for (int i = 0; i < 4; ++i) pf[i] = *(const u32x4*)(src[i] + (size_t)(j + 1) * 64 * AINW);
        }
        const LAS unsigned char* base = lds + (j & 1) * AT_STAGE;
        const LAS unsigned char* Kb = base + (mp ? AT_K2 : AT_K1);
        const LAS unsigned char* Vb = base + AT_V;
        f32x16 S[2];
        const float negm = -mrun;
#pragma unroll
        for (int kt = 0; kt < 2; ++kt) {
#pragma unroll
            for (int i = 0; i < 16; ++i) S[kt][i] = negm;
#pragma unroll
            for (int s = 0; s < 4; ++s) { const bf16x8 kf = *(const LAS bf16x8*)(Kb + (32 * kt + r) * KST + (16 * s + 8 * h) * 2); S[kt] = MFMA32(kf, qf[s], S[kt]); } }
        const int qidx = q0 + 32 * qg + r, kbase = 64 * j;
        if (kbase + 63 > q0 + 32 * qg) {
#pragma unroll
            for (int kt = 0; kt < 2; ++kt)
#pragma unroll
                for (int i = 0; i < 16; ++i) if (kbase + 32 * kt + crow(i, h) > qidx) S[kt][i] = -1e30f;
        }
        float mx = S[0][0];
#pragma unroll
        for (int kt = 0; kt < 2; ++kt)
#pragma unroll
            for (int i = 0; i < 16; ++i) mx = fmaxf(mx, S[kt][i]);
        mx = fmaxf(mx, __shfl_xor(mx, 32));
        if (j == 0 || __builtin_amdgcn_ballot_w64(mx > 8.0f) != 0ull) {
            const float d = (j == 0) ? mx : fmaxf(mx, 0.f);
            mrun += d;
            if (j != 0) { const float alpha = fexp2(-d); lrun *= alpha;
#pragma unroll
                for (int vt = 0; vt < 4; ++vt) O[vt] = O[vt] * alpha; }
#pragma unroll
            for (int kt = 0; kt < 2; ++kt)
#pragma unroll
                for (int i = 0; i < 16; ++i) S[kt][i] -= d;
        }
        float ls = 0.f;
#pragma unroll
        for (int kt = 0; kt < 2; ++kt)
#pragma unroll
            for (int i = 0; i < 16; ++i) { const float pv = fexp2(S[kt][i]); S[kt][i] = pv; ls += pv; }
        lrun += ls;
#pragma unroll
        for (int kt = 0; kt < 2; ++kt)
#pragma unroll
            for (int s2 = 0; s2 < 2; ++s2) {
                const bf16x8 pfr = pack8(S[kt], s2);
                const LAS unsigned char* vrow = Vb + (32 * kt + 16 * s2) * VST + troff;
#pragma unroll
                for (int vt = 0; vt < 4; ++vt) { const bf16x8 vf = tr2(vrow + vt * 64, vrow + 8 * VST + vt * 64); O[vt] = MFMA32(vf, pfr, O[vt]); }
            }
        if (more) {
            LAS unsigned char* nb = lds + ((j + 1) & 1) * AT_STAGE;
#pragma unroll
            for (int i = 0; i < 4; ++i) *(LAS u32x4*)(nb + dst[i]) = pf[i];
        }
        __syncthreads();
    }
    lrun += __shfl_xor(lrun, 32);
    const float inv = frcp(lrun);
    LAS float* ex = (LAS float*)lds;
    if (mp == 1) {
        const float sc = inv * lam;
#pragma unroll
        for (int vt = 0; vt < 4; ++vt)
#pragma unroll
            for (int i = 0; i < 16; ++i) ex[(qg * 128 + 32 * vt + crow(i, h)) * 32 + r] = O[vt][i] * sc;
    }
    __syncthreads();
    if (mp == 0) {
        float sq = 0.f;
#pragma unroll
        for (int vt = 0; vt < 4; ++vt)
#pragma unroll
            for (int i = 0; i < 16; ++i) { const float o = O[vt][i] * inv - ex[(qg * 128 + 32 * vt + crow(i, h)) * 32 + r]; O[vt][i] = o; sq += o * o; }
        sq += __shfl_xor(sq, 32);
        const float rn = __builtin_amdgcn_rsqf(sq * (1.0f / 128.0f) + 1e-5f) * 0.8f;
        bf16_t* op = mixed + (rowb + q0 + 32 * qg + r) * DM + hd * 128;
#pragma unroll
        for (int vt = 0; vt < 4; ++vt)
#pragma unroll
            for (int gq = 0; gq < 4; ++gq) { const int v0 = 32 * vt + 8 * gq + 4 * h; const f32x4 wv = *(const f32x4*)(subln + v0);
                u32x2 o; o[0] = pk2(O[vt][4 * gq] * rn * wv[0], O[vt][4 * gq + 1] * rn * wv[1]); o[1] = pk2(O[vt][4 * gq + 2] * rn * wv[2], O[vt][4 * gq + 3] * rn * wv[3]);
                *(u32x2*)(op + v0) = o; }
    }
    __syncthreads();
}

constexpr int SB_K = 0, SB_V = 64 * KST, SB_STAGE = 64 * KST + 64 * VST64;
DI void sb_block(LAS unsigned char* lds, const bf16_t* proj, bf16_t* mixed, int b, int hs, int qb) {
    const int tid = otid(), w = __builtin_amdgcn_readfirstlane(tid >> 6), lane = tid & 63, r = lane & 31, h = lane >> 5;
    const int q0 = qb * 256; const size_t rowb = (size_t)b * SEQ;
    const int qidx = q0 + 32 * w + r;
    bf16x8 qf[4];
    { const bf16_t* qp = proj + (rowb + qidx) * AINW + 1536 + hs * 64 + 8 * h;
#pragma unroll
      for (int s = 0; s < 4; ++s) qf[s] = *(const bf16x8*)(qp + 16 * s); }
    f32x16 O[2]; O[0] = zero16(); O[1] = zero16();
    float carry = 1.0f;
    const int jmax = 4 * qb + 3;
    const int srow = tid >> 3, sc8 = tid & 7;
    const bf16_t* srcK = proj + (rowb + srow) * AINW + 2048 + hs * 64 + sc8 * 8;
    const bf16_t* srcV = proj + (rowb + srow) * AINW + 2560 + hs * 64 + sc8 * 8;
    const int dstK = SB_K + srow * KST + sc8 * 16, dstV = SB_V + srow * VST64 + sc8 * 16;
    u32x4 pk_ = *(const u32x4*)(srcK + (size_t)jmax * 64 * AINW), pv_ = *(const u32x4*)(srcV + (size_t)jmax * 64 * AINW);
    *(LAS u32x4*)(lds + dstK) = pk_; *(LAS u32x4*)(lds + dstV) = pv_;
    __syncthreads();
    const int i16 = lane & 15, tq = i16 >> 2, tp = i16 & 3, g16 = (lane >> 4) & 1;
    const int troff = (4 * h + tq) * VST64 + (16 * g16 + 4 * tp) * 2;
    int it = 0;
    for (int j = jmax; j >= 0; --j, ++it) {
        const bool more = (j > 0);
        if (more) { pk_ = *(const u32x4*)(srcK + (size_t)(j - 1) * 64 * AINW); pv_ = *(const u32x4*)(srcV + (size_t)(j - 1) * 64 * AINW); }
        const LAS unsigned char* base = lds + (it & 1) * SB_STAGE;
        const int kbase = 64 * j;
        if (kbase < q0 + 32 * w + 32) {
#pragma unroll
            for (int kt = 1; kt >= 0; --kt) {
                f32x16 S = zero16();
#pragma unroll
                for (int s = 0; s < 4; ++s) { const bf16x8 kf = *(const LAS bf16x8*)(base + SB_K + (32 * kt + r) * KST + (16 * s + 8 * h) * 2); S = MFMA32(kf, qf[s], S); }
                float T[4], sfx[16];
#pragma unroll
                for (int gq = 0; gq < 4; ++gq) {
                    float run = 1.0f;
#pragma unroll
                    for (int jj = 3; jj >= 0; --jj) {
                        const int i = 4 * gq + jj; const bool valid = (kbase + 32 * kt + crow(i, h)) < qidx;
                        const float zz = fmaxf(S[i], -60.0f); const float e = fexp2(-LOG2E * zz); const float sg = frcp(1.0f + e);
                        const float keep = valid ? e * sg : 1.0f;
                        S[i] = valid ? sg : 0.0f; sfx[i] = run; run *= keep;
                    }
                    T[gq] = run;
                }
                float To[4];
#pragma unroll
                for (int gq = 0; gq < 4; ++gq) To[gq] = __shfl_xor(T[gq], 32);
                float E[4]; float acc_hi = 1.0f;
#pragma unroll
                for (int gq = 3; gq >= 0; --gq) {
                    const float above_same = acc_hi;
                    E[gq] = (h == 0) ? above_same * To[gq] : above_same;
                    acc_hi = acc_hi * T[gq] * To[gq];
                }
#pragma unroll
                for (int i = 0; i < 16; ++i) S[i] = S[i] * carry * E[i >> 2] * sfx[i];
                carry *= acc_hi;
#pragma unroll
                for (int s2 = 0; s2 < 2; ++s2) {
                    const bf16x8 pfr = pack8(S, s2);
                    const LAS unsigned char* vrow = base + SB_V + (32 * kt + 16 * s2) * VST64 + troff;
#pragma unroll
                    for (int vt = 0; vt < 2; ++vt) { const bf16x8 vf = tr2(vrow + vt * 64, vrow + 8 * VST64 + vt * 64); O[vt] = MFMA32(vf, pfr, O[vt]); }
                }
            }
        }
        if (more) { LAS unsigned char* nb = lds + ((it + 1) & 1) * SB_STAGE; *(LAS u32x4*)(nb + dstK) = pk_; *(LAS u32x4*)(nb + dstV) = pv_; }
        const int done = (kbase < q0 + 32 * w + 32) && (carry < 1e-12f);
        const bool wdone = (__builtin_amdgcn_ballot_w64(done != 0) == ~0ull);
        LAS int* flg = (LAS int*)(lds + 2 * SB_STAGE) + (it & 1) * 8;
        if (lane == 0) flg[w] = wdone ? 1 : 0;
        __syncthreads();
        int all = 1;
#pragma unroll
        for (int ww = 0; ww < 8; ++ww) all &= flg[ww];
        if (all) break;
    }
    bf16_t* op = mixed + (rowb + qidx) * DM + 512 + hs * 64;
#pragma unroll
    for (int vt = 0; vt < 2; ++vt)
#pragma unroll
        for (int gq = 0; gq < 4; ++gq) { const int v0 = 32 * vt + 8 * gq + 4 * h;
            u32x2 o; o[0] = pk2(O[vt][4 * gq], O[vt][4 * gq + 1]); o[1] = pk2(O[vt][4 * gq + 2], O[vt][4 * gq + 3]); *(u32x2*)(op + v0) = o; }
    __syncthreads();
}
DI void attn_phase(LAS unsigned char* lds, const Params& p) {
    const bf16_t* proj = (const bf16_t*)(p.ws + O_PROJ); bf16_t* mixed = (bf16_t*)(p.ws + O_MIXED);
    const float lam = *(const float*)(p.ws + O_LAM);
    for (int it0 = blockIdx.x; it0 < 256; it0 += gridDim.x) {
        const int it = (it0 & 7) * 32 + (it0 >> 3);
        const int b = it >> 7, hd = (it >> 5) & 3, pr = it & 31;
        diff_tile(lds, proj, mixed, p.in[7], lam, b, hd, 63 - pr);
        diff_tile(lds, proj, mixed, p.in[7], lam, b, hd, pr);
    }
    for (int it0 = blockIdx.x; it0 < 512; it0 += gridDim.x) {
        const int it = (it0 & 7) * 64 + (it0 >> 3);
        const int b = it >> 8, hs = (it >> 5) & 7, qb = it & 31;
        sb_block(lds, proj, mixed, b, hs, qb);
    }
}
constexpr int SXS = 528, SXS2 = 576, SBS = 272, SBS2 = 320;
constexpr int L_SX = 0, L_SB = 128 * SXS2, L_SC = L_SB + 128 * SBS, L_SDT = L_SC + 128 * SBS, L_SAC = L_SDT + 2048, L_SSQ = L_SAC + 2048;
static_assert(L_SSQ + 4096 <= LDS_BYTES, "lds");

DI void ssd_dt_acum(LAS unsigned char* lds, const float* DT, const float* dt_bias, const float* a_log, size_t t0, int g) {
    LAS float* sdt = (LAS float*)(lds + L_SDT); LAS float* sac = (LAS float*)(lds + L_SAC);
    const int tid = otid(), hh = tid >> 7, l = tid & 127, head = 4 * g + hh, w = tid >> 6, lane = tid & 63;
    const float raw = DT[(t0 + l) * 32 + head] + dt_bias[head];
    const float dt = fmaxf(raw, 0.f) + __logf(1.0f + __expf(-fabsf(raw)));
    sdt[hh * 128 + l] = dt; sac[hh * 128 + l] = -dt * __expf(a_log[head]);
    __syncthreads();
    if (w < 4) {
        const float v0 = sac[w * 128 + 2 * lane], v1 = sac[w * 128 + 2 * lane + 1]; float s = v0 + v1;
#pragma unroll
        for (int off = 1; off < 64; off <<= 1) { const float t = __shfl_up(s, off); if (lane >= off) s += t; }
        const float ex = s - (v0 + v1);
        sac[w * 128 + 2 * lane] = ex + v0; sac[w * 128 + 2 * lane + 1] = ex + v0 + v1;
    }
    __syncthreads();
}
template <int NT, class F> DI void conv_strip(const bf16_t* src, int nzero, const float* cw, const float* cb, int ch, F&& emit) {
    f32x4 wlo[4], whi[4];
#pragma unroll
    for (int k = 0; k < 4; ++k) { wlo[k] = *(const f32x4*)(cw + k * XBCW + ch); whi[k] = *(const f32x4*)(cw + k * XBCW + ch + 4); }
    const f32x4 blo = *(const f32x4*)(cb + ch), bhi = *(const f32x4*)(cb + ch + 4);
    u32x4 raw[NT + 3];
#pragma unroll
    for (int i = 0; i < NT + 3; ++i) { const int ii = (i < nzero) ? nzero : i; raw[i] = *(const u32x4*)(src + (ptrdiff_t)(ii - 3) * XBCW); if (i < nzero) raw[i] = (u32x4){0u, 0u, 0u, 0u}; }
#pragma unroll
    for (int t = 0; t < NT; ++t) {
        float o[8];
#pragma unroll
        for (int e = 0; e < 8; ++e) {
            float a = (e < 4) ? blo[e & 3] : bhi[e & 3];
#pragma unroll
            for (int k = 0; k < 4; ++k) { const unsigned d = raw[t + k][e >> 1]; const float xv = (e & 1) ? bfhi(d) : bflo(d); a += ((e < 4) ? wlo[k][e & 3] : whi[k][e & 3]) * xv; }
            o[e] = fsilu(a);
        }
        emit(t, o);
    }
}
DI u32x4 pack8f(const float* o) { u32x4 r; r[0] = pk2(o[0], o[1]); r[1] = pk2(o[2], o[3]); r[2] = pk2(o[4], o[5]); r[3] = pk2(o[6], o[7]); return r; }

template <bool XW, bool WITH_C> DI void ssd_stage(LAS unsigned char* lds, const bf16_t* xbc, const float* cw, const float* cb, size_t t0, int c, int g) {
    const int tid = otid();
    LAS float* sdt = (LAS float*)(lds + L_SDT); LAS float* sac = (LAS float*)(lds + L_SAC);
    {
        const int c8 = tid & 31, tg = tid >> 5, l0 = 8 * tg, ch = 256 * g + 8 * c8, hh = c8 >> 3;
        const int nzero = (c == 0) ? (3 - l0 > 0 ? 3 - l0 : 0) : 0;
        const float alast = sac[hh * 128 + 127];
        conv_strip<8>(xbc + (t0 + l0) * XBCW + ch, nzero, cw, cb, ch, [&](int t, float* o) {
            if (XW) { const float wgt = sdt[hh * 128 + l0 + t] * __expf(alast - sac[hh * 128 + l0 + t]);
#pragma unroll
                for (int e = 0; e < 8; ++e) o[e] *= wgt; }
            *(LAS u32x4*)(lds + L_SX + (l0 + t) * (XW ? SXS2 : SXS) + c8 * 16) = pack8f(o); });
    }
    {
        const int c8 = tid & 15, tg = tid >> 4, l0 = 4 * tg;
        const int nzero = (c == 0) ? (3 - l0 > 0 ? 3 - l0 : 0) : 0;
        const int chb = DIN + 128 * g + 8 * c8;
        conv_strip<4>(xbc + (t0 + l0) * XBCW + chb, nzero, cw, cb, chb, [&](int t, float* o) { *(LAS u32x4*)(lds + L_SB + (l0 + t) * (XW ? SBS2 : SBS) + c8 * 16) = pack8f(o); });
        if (WITH_C) { const int chc = DIN + 1024 + 128 * g + 8 * c8;
            conv_strip<4>(xbc + (t0 + l0) * XBCW + chc, nzero, cw, cb, chc, [&](int t, float* o) { *(LAS u32x4*)(lds + L_SC + (l0 + t) * SBS + c8 * 16) = pack8f(o); }); }
    }
}
DI bf16_t* st_ptr(unsigned char* ws, int b) { return (bf16_t*)(ws + (b ? O_ST1 : O_ST0)); }

DI void ssd_states_phase(LAS unsigned char* lds, const Params& p) {
    const int tid = otid(), w = __builtin_amdgcn_readfirstlane(tid >> 6), lane = tid & 63, r = lane & 31, h = lane >> 5, hh = w >> 1, ph = w & 1;
    const bf16_t* xbc = (const bf16_t*)(p.ws + O_XBC); const float* DT = (const float*)(p.ws + O_DT); float* cdec = (float*)(p.ws + O_CDEC);
    const int i16 = lane & 15, tq = i16 >> 2, tp = i16 & 3, g16 = (lane >> 4) & 1;
    for (int it = blockIdx.x; it < 1024; it += gridDim.x) {
        const int b = it >> 9, c = (it >> 3) & 63, g = it & 7; const size_t t0 = (size_t)b * SEQ + (size_t)c * 128;
        ssd_dt_acum(lds, DT, p.in[13], p.in[14], t0, g);
        ssd_stage<true, false>(lds, xbc, p.in[11], p.in[12], t0, c, g);
        __syncthreads();
        f32x16 acc[4];
#pragma unroll
        for (int i = 0; i < 4; ++i) acc[i] = zero16();
        const LAS unsigned char* xa = lds + L_SX + (8 * h + tq) * SXS2 + (64 * hh + 32 * ph + 16 * g16 + 4 * tp) * 2;
        const LAS unsigned char* ba = lds + L_SB + (8 * h + tq) * SBS2 + (16 * g16 + 4 * tp) * 2;
#pragma unroll
        for (int s = 0; s < 8; ++s) {
            const bf16x8 af = tr2(xa + 16 * s * SXS2, xa + (16 * s + 4) * SXS2);
#pragma unroll
            for (int nt = 0; nt < 4; ++nt) { const bf16x8 bfr = tr2(ba + 16 * s * SBS2 + nt * 64, ba + (16 * s + 4) * SBS2 + nt * 64); acc[nt] = MFMA32(af, bfr, acc[nt]); }
        }
        bf16_t* st = st_ptr(p.ws, b) + ((size_t)(c * 32 + 4 * g + hh) * 64 + 32 * ph) * 128;
#pragma unroll
        for (int nt = 0; nt < 4; ++nt)
#pragma unroll
            for (int i = 0; i < 16; ++i) st[(size_t)crow(i, h) * 128 + 32 * nt + r] = (bf16_t)(pk2(acc[nt][i], 0.f) & 0xffffu);
        if (tid < 4) cdec[(b * 64 + c) * 32 + 4 * g + tid] = __expf(((LAS float*)(lds + L_SAC))[tid * 128 + 127]);
        __syncthreads();
    }
}
DI void ssd_scan_phase(const Params& p, const bool dry) {
    const float* cdec = (const float*)(p.ws + O_CDEC);
    for (int e = blockIdx.x * 512 + threadIdx.x; e < 2 * 32 * 64 * 32; e += gridDim.x * 512) {
        const int b = e >> 16, rem = e & 65535, head = rem >> 11;
        bf16_t* st = st_ptr(p.ws, b) + (size_t)rem * 4;
        float carry[4] = {0.f, 0.f, 0.f, 0.f};
        for (int c0 = 0; c0 < 64; c0 += 8) {
            u32x2 v[8]; float dc[8];
#pragma unroll
            for (int u = 0; u < 8; ++u) { v[u] = *(const u32x2*)(st + (size_t)(c0 + u) * 262144); dc[u] = cdec[(b * 64 + c0 + u) * 32 + head]; }
#pragma unroll
            for (int u = 0; u < 8; ++u) {
                u32x2 o; o[0] = pk2(carry[0], carry[1]); o[1] = pk2(carry[2], carry[3]); if (!dry) *(u32x2*)(st + (size_t)(c0 + u) * 262144) = o;
                carry[0] = carry[0] * dc[u] + bflo(v[u][0]); carry[1] = carry[1] * dc[u] + bfhi(v[u][0]); carry[2] = carry[2] * dc[u] + bflo(v[u][1]); carry[3] = carry[3] * dc[u] + bfhi(v[u][1]);
            }
        }
    }
}
DI void ssd_out_phase(LAS unsigned char* lds, const Params& p, const bool dry) {
    const int tid = otid(), w = __builtin_amdgcn_readfirstlane(tid >> 6), lane = tid & 63, r = lane & 31, h = lane >> 5, hh = w >> 1, ph = w & 1;
    const bf16_t* xbc = (const bf16_t*)(p.ws + O_XBC); const float* DT = (const float*)(p.ws + O_DT); bf16_t* zy = (bf16_t*)p.out;
    LAS float* sdt = (LAS float*)(lds + L_SDT); LAS float* sac = (LAS float*)(lds + L_SAC); LAS float* ssq = (LAS float*)(lds + L_SSQ);
    const int i16 = lane & 15, tq = i16 >> 2, tp = i16 & 3, g16 = (lane >> 4) & 1;
    for (int it = blockIdx.x; it < 1024; it += gridDim.x) {
        const int b = it >> 9, c = (it >> 3) & 63, g = it & 7, head = 4 * g + hh; const size_t t0 = (size_t)b * SEQ + (size_t)c * 128;
        ssd_dt_acum(lds, DT, p.in[13], p.in[14], t0, g);
        ssd_stage<false, true>(lds, xbc, p.in[11], p.in[12], t0, c, g);
        bf16x8 pvf[8];
        { const bf16_t* pp = st_ptr(p.ws, b) + ((size_t)(c * 32 + head) * 64 + 32 * ph + r) * 128 + 8 * h;
#pragma unroll
          for (int s = 0; s < 8; ++s) pvf[s] = *(const bf16x8*)(pp + 16 * s); }
        __syncthreads();
        f32x16 Y[4];
        const LAS unsigned char* xa = lds + L_SX + (4 * h + tq) * SXS + (64 * hh + 32 * ph + 16 * g16 + 4 * tp) * 2;
#pragma unroll
        for (int lt = 0; lt < 4; ++lt) {
            __builtin_amdgcn_sched_barrier(0);
            f32x16 y = zero16();
#pragma unroll
            for (int s = 0; s < 8; ++s) { const bf16x8 cfs = *(const LAS bf16x8*)(lds + L_SC + (32 * lt + r) * SBS + (16 * s + 8 * h) * 2); y = MFMA32(pvf[s], cfs, y); }
            Y[lt] = y * __expf(sac[hh * 128 + 32 * lt + r]);
        }
#pragma unroll
        for (int lt = 0; lt < 4; ++lt) {
            __builtin_amdgcn_sched_barrier(0);
            bf16x8 cf[8];
#pragma unroll
            for (int s = 0; s < 8; ++s) cf[s] = *(const LAS bf16x8*)(lds + L_SC + (32 * lt + r) * SBS + (16 * s + 8 * h) * 2);
            const float al = sac[hh * 128 + 32 * lt + r];
#pragma unroll
            for (int mt = 0; mt < 4; ++mt) {
                if (mt <= lt) {
                    __builtin_amdgcn_sched_barrier(0);
                    f32x16 X = zero16();
#pragma unroll
                    for (int s = 0; s < 8; ++s) { const bf16x8 bfr = *(const LAS bf16x8*)(lds + L_SB + (32 * mt + r) * SBS + (16 * s + 8 * h) * 2); X = MFMA32(bfr, cf[s], X); }
#pragma unroll
                    for (int gq = 0; gq < 4; ++gq) {
                        const f32x4 am = *(const LAS f32x4*)(sac + hh * 128 + 32 * mt + 8 * gq + 4 * h), dm = *(const LAS f32x4*)(sdt + hh * 128 + 32 * mt + 8 * gq + 4 * h);
#pragma unroll
                        for (int jj = 0; jj < 4; ++jj) { const int mrow = 32 * mt + 8 * gq + 4 * h + jj; const bool ok = (32 * lt + r) >= mrow;
                            const float dec = ok ? __expf(fminf(al - am[jj], 0.f)) * dm[jj] : 0.f; X[4 * gq + jj] *= dec; }
                    }
#pragma unroll
                    for (int s2 = 0; s2 < 2; ++s2) { const bf16x8 xs = pack8(X, s2);
                        const LAS unsigned char* xr = xa + (32 * mt + 16 * s2) * SXS; const bf16x8 xf = tr2(xr, xr + 8 * SXS); Y[lt] = MFMA32(xf, xs, Y[lt]); }
                }
            }
        }
        __builtin_amdgcn_sched_barrier(0);
        const float Dh = p.in[15][head];
        float sq[4];
#pragma unroll
        for (int lt = 0; lt < 4; ++lt) {
            const int l = 32 * lt + r; sq[lt] = 0.f;
#pragma unroll
            for (int gq = 0; gq < 4; ++gq) {
                const int chl = 64 * hh + 32 * ph + 8 * gq + 4 * h;
                const u32x2 xv = *(const LAS u32x2*)(lds + L_SX + l * SXS + chl * 2);
                const u32x2 zv = *(const u32x2*)(zy + (t0 + l) * DIN + 256 * g + chl);
                const float xf4[4] = {bflo(xv[0]), bfhi(xv[0]), bflo(xv[1]), bfhi(xv[1])}, zf4[4] = {bflo(zv[0]), bfhi(zv[0]), bflo(zv[1]), bfhi(zv[1])};
#pragma unroll
                for (int jj = 0; jj < 4; ++jj) { const float yv = (Y[lt][4 * gq + jj] + Dh * xf4[jj]) * fsilu(zf4[jj]); Y[lt][4 * gq + jj] = yv; sq[lt] += yv * yv; }
            }
            sq[lt] += __shfl_xor(sq[lt], 32);
            if (h == 0) ssq[w * 128 + l] = sq[lt];
        }
        __syncthreads();
#pragma unroll
        for (int lt = 0; lt < 4; ++lt) {
            const int l = 32 * lt + r; float tot = 0.f;
#pragma unroll
            for (int ww = 0; ww < 8; ++ww) tot += ssq[ww * 128 + l];
            const float rn = __builtin_amdgcn_rsqf(tot * (1.0f / 256.0f) + 1e-5f);
#pragma unroll
            for (int gq = 0; gq < 4; ++gq) {
                const int chl = 64 * hh + 32 * ph + 8 * gq + 4 * h; const f32x4 gw = *(const f32x4*)(p.in[16] + 256 * g + chl);
                u32x2 o; o[0] = pk2(Y[lt][4 * gq] * rn * gw[0], Y[lt][4 * gq + 1] * rn * gw[1]); o[1] = pk2(Y[lt][4 * gq + 2] * rn * gw[2], Y[lt][4 * gq + 3] * rn * gw[3]);
                if (!dry) *(u32x2*)(zy + (t0 + l) * DIN + 256 * g + chl) = o;
            }
        }
        __syncthreads();
    }
}
DI void dt_proj(LAS unsigned char* lds, const Params& p) {
    const int tid = otid(), w = __builtin_amdgcn_readfirstlane(tid >> 6), lane = tid & 63, r = lane & 31, h = lane >> 5, rt = w & 1, kq = w >> 1;
    const bf16_t* hb = (const bf16_t*)(p.ws + O_HB); const bf16_t* wt = (const bf16_t*)(p.ws + W_SIN) + (size_t)6144 * DM;
    const float* ss = (const float*)(p.ws + O_SS) + 2 * MT; float* dt = (float*)(p.ws + O_DT);
    LAS float* part = (LAS float*)lds;
    for (int rb = blockIdx.x; rb < MT / 64; rb += gridDim.x) {
        const bf16_t* ap = hb + (size_t)(rb * 64 + rt * 32 + r) * DM + kq * 256 + 8 * h;
        const bf16_t* bp = wt + (size_t)r * DM + kq * 256 + 8 * h;
        bf16x8 af[16], bfr[16];
#pragma unroll
        for (int s = 0; s < 16; ++s) { af[s] = *(const bf16x8*)(ap + 16 * s); bfr[s] = *(const bf16x8*)(bp + 16 * s); }
        f32x16 acc = zero16();
#pragma unroll
        for (int s = 0; s < 16; ++s) acc = MFMA32(af[s], bfr[s], acc);
#pragma unroll
        for (int i = 0; i < 16; ++i) part[((kq * 2 + rt) * 32 + crow(i, h)) * 32 + r] = acc[i];
        __syncthreads();
#pragma unroll
        for (int q = 0; q < 4; ++q) {
            const int o = tid + 512 * q, row = o >> 5, col = o & 31;
            float v = 0.f;
#pragma unroll
            for (int k = 0; k < 4; ++k) v += part[((k * 2 + (row >> 5)) * 32 + (row & 31)) * 32 + col];
            const int grow = rb * 64 + row;
            dt[(size_t)grow * 32 + col] = v * __builtin_amdgcn_rsqf(ss[grow] * (1.0f / 1024.0f) + 1e-6f);
        }
        __syncthreads();
    }
}
template <class Epi> DI void run_gemm(LAS unsigned char* lds, const bf16_t* A, const bf16_t* Bt, int N, int K, const Epi& E) {
    pg8::Gemm g; g.A = A; g.Bt = Bt; g.M = MT; g.N = N; g.K = K;
    pg8::StaticOrder S; S.init(MT, N, (int)gridDim.x, (int)blockIdx.x);
    pg8::gemm_phase<Epi, pg8::StaticOrder, !Epi::AFTER_DRAIN, true>((PG8_LAS unsigned char*)lds, g, S, E);
}
#if defined(DRY_S3) || defined(DRY_S4)
#define DRYV (p.ws == nullptr)
#else
#define DRYV false
#endif
__global__ void __launch_bounds__(512, 2) fwd_megakernel(Params p) {
    extern __shared__ __attribute__((aligned(16))) unsigned char shm[];
    LAS unsigned char* lds = (LAS unsigned char*)shm;
    cg::grid_group grid = cg::this_grid();
    if (threadIdx.x < 4) ((LAS unsigned*)(lds + LDS_BYTES - 16))[threadIdx.x] = 0u;
    __syncthreads();
    const XcdBarrier xbar = xcd_barrier_post((unsigned*)(p.ws + O_BAR), (volatile LAS unsigned*)(lds + LDS_BYTES - 16));
#define GBAR() xcd_barrier(xbar)
    unsigned char* ws = p.ws;
    bf16_t* hb = (bf16_t*)(ws + O_HB); float* ss = (float*)(ws + O_SS);
    phase0(lds, p);
#ifdef DUP_P0
    GBAR(); phase0(lds, p);
#endif
    if (gridDim.x == 0x7fffffffu) grid.sync();
    GBAR();
    { EpiAttnIn E; E.O = (bf16_t*)(ws + O_PROJ); E.ss = ss; E.tab = (const f32x4*)(ws + O_ROPE); run_gemm(lds, hb, (const bf16_t*)(ws + W_AIN), AINW, DM, E); }
    GBAR();
    attn_phase(lds, p);
#ifdef DUP_ATTN
    GBAR(); attn_phase(lds, p);
#endif
    GBAR();
    { EpiRes<true, false> E; E.xres = p.in[0]; E.hb = hb; E.outf = nullptr; E.ssn = ss + MT; run_gemm(lds, (const bf16_t*)(ws + O_MIXED), (const bf16_t*)(ws + W_AOUT), DM, DM, E); }
    GBAR();
    { EpiGU E; E.act = (bf16_t*)(ws + O_ACT); E.ss = ss + MT; run_gemm(lds, hb, (const bf16_t*)(ws + W_GU0), 2 * DFF, DM, E); }
    GBAR();
    { EpiRes<false, false> E; E.xres = nullptr; E.hb = hb; E.outf = nullptr; E.ssn = ss + 2 * MT; run_gemm(lds, (const bf16_t*)(ws + O_ACT), (const bf16_t*)(ws + W_DN0), DM, DFF, E); }
    GBAR();
    { EpiSsdIn E; E.z = (bf16_t*)p.out; E.xbc = (bf16_t*)(ws + O_XBC); E.dt = (float*)(ws + O_DT); E.ss = ss + 2 * MT; dt_proj(lds, p); run_gemm(lds, hb, (const bf16_t*)(ws + W_SIN), 6144, DM, E); }
    GBAR();
    ssd_states_phase(lds, p);
#ifdef DUP_S2
    GBAR(); ssd_states_phase(lds, p);
#endif
    GBAR();
#ifdef DRY_S3
    ssd_scan_phase(p, p.ws != nullptr); GBAR();
#endif
    ssd_scan_phase(p, DRYV);
    GBAR();
#ifdef DRY_S4
    ssd_out_phase(lds, p, p.ws != nullptr); GBAR();
#endif
    ssd_out_phase(lds, p, DRYV);
    GBAR();
    { EpiRes<false, false> E; E.xres = nullptr; E.hb = hb; E.outf = nullptr; E.ssn = ss + 3 * MT; run_gemm(lds, (const bf16_t*)p.out, (const bf16_t*)(ws + W_SOUT), DM, DIN, E); }
    GBAR();
    { EpiGU E; E.act = (bf16_t*)(ws + O_ACT); E.ss = ss + 3 * MT; run_gemm(lds, hb, (const bf16_t*)(ws + W_GU1), 2 * DFF, DM, E); }
    GBAR();
    if (gridDim.x == 256) {
        EpiFinal E; E.hb = hb; E.outf = p.out; E.ssn = ss + 4 * MT; E.cnt = (unsigned*)(ws + O_BAR) + XCD_BAR_WORDS; E.fw = p.in[22];
        run_gemm(lds, (const bf16_t*)(ws + O_ACT), (const bf16_t*)(ws + W_DN1), DM, DFF, E);
    } else {
        { EpiRes<false, true> E; E.xres = nullptr; E.hb = hb; E.outf = p.out; E.ssn = ss + 4 * MT; run_gemm(lds, (const bf16_t*)(ws + O_ACT), (const bf16_t*)(ws + W_DN1), DM, DFF, E); }
        GBAR();
        const float* ss4 = ss + 4 * MT; const f32x4* fw = (const f32x4*)p.in[22]; f32x4* o4 = (f32x4*)p.out;
        for (int i = blockIdx.x * 512 + threadIdx.x; i < MT * (DM / 4); i += gridDim.x * 512) {
            const int row = i >> 8; const float rs = __builtin_amdgcn_rsqf(ss4[row] * (1.0f / 1024.0f) + 1e-6f);
            o4[i] = o4[i] * rs * fw[i & 255];
        }
    }
}

extern "C" void kernel_launch(void* const* d_in, const int* in_sizes, int n_in, void* d_out, int out_size, void* d_ws, size_t ws_size, hipStream_t stream) {
    static int grid_blocks = 0;
    if (!grid_blocks) {
        int dev = 0, cus = 0, per_cu = 0;
        hipGetDevice(&dev);
        hipDeviceGetAttribute(&cus, hipDeviceAttributeMultiprocessorCount, dev);
        if (hipFuncSetAttribute((const void*)fwd_megakernel, hipFuncAttributeMaxDynamicSharedMemorySize, LDS_BYTES) != hipSuccess) fprintf(stderr, "hipFuncSetAttribute failed\n");
        if (hipOccupancyMaxActiveBlocksPerMultiprocessor(&per_cu, (const void*)fwd_megakernel, 512, LDS_BYTES) != hipSuccess || per_cu < 1) { fprintf(stderr, "occupancy query: %d\n", per_cu); per_cu = 1; }
        (void)hipGetLastError();
        grid_blocks = cus * per_cu;
        if (ws_size < 268435456ull || n_in != 23) fprintf(stderr, "unexpected ws_size %zu / n_in %d\n", ws_size, n_in);
    }
    if (hipMemsetAsync((char*)d_ws + O_BAR, 0, 20480, stream) != hipSuccess) fprintf(stderr, "memset failed\n");
    Params p{};
    for (int i = 0; i < 23; ++i) p.in[i] = (const float*)d_in[i];
    p.out = (float*)d_out; p.ws = (unsigned char*)d_ws;
    void* args[] = {&p};
    hipError_t e = hipLaunchCooperativeKernel((const void*)fwd_megakernel, dim3(grid_blocks), dim3(512), args, LDS_BYTES, stream);
    if (e != hipSuccess) fprintf(stderr, "cooperative launch failed: %s (grid %d)\n", hipGetErrorString(e), grid_blocks);
}
#ifdef PHASE_TEST
__global__ void __launch_bounds__(512, 2) t_phase0(Params p) { extern __shared__ __attribute__((aligned(16))) unsigned char shm[]; phase0((LAS unsigned char*)shm, p); }
__global__ void __launch_bounds__(512, 2) t_attn_diff(Params p) { extern __shared__ __attribute__((aligned(16))) unsigned char shm[]; diff_tile((LAS unsigned char*)shm, (const bf16_t*)(p.ws + O_PROJ), (bf16_t*)(p.ws + O_MIXED), p.in[7], 0.3f, blockIdx.x & 1, blockIdx.y, blockIdx.z); }
__global__ void __launch_bounds__(512, 2) t_attn_sb(Params p) { extern __shared__ __attribute__((aligned(16))) unsigned char shm[]; sb_block((LAS unsigned char*)shm, (const bf16_t*)(p.ws + O_PROJ), (bf16_t*)(p.ws + O_MIXED), blockIdx.x & 1, blockIdx.y, blockIdx.z); }
__global__ void __launch_bounds__(512, 2) t_ssd_states(Params p) { extern __shared__ __attribute__((aligned(16))) unsigned char shm[]; ssd_states_phase((LAS unsigned char*)shm, p); }
__global__ void __launch_bounds__(512, 2) t_ssd_scan(Params p) { ssd_scan_phase(p, false); }
__global__ void __launch_bounds__(512, 2) t_ssd_out(Params p) { extern __shared__ __attribute__((aligned(16))) unsigned char shm[]; ssd_out_phase((LAS unsigned char*)shm, p, false); }
__global__ void __launch_bounds__(512, 2) t_gemm_ain(Params p) { extern __shared__ __attribute__((aligned(16))) unsigned char shm[]; EpiAttnIn E; E.O = (bf16_t*)(p.ws + O_PROJ); E.ss = (float*)(p.ws + O_SS); E.tab = (const f32x4*)(p.ws + O_ROPE); run_gemm((LAS unsigned char*)shm, (bf16_t*)(p.ws + O_HB), (const bf16_t*)(p.ws + W_AIN), AINW, DM, E); }
__global__ void __launch_bounds__(512, 2) t_gemm_res(Params p) { extern __shared__ __attribute__((aligned(16))) unsigned char shm[]; EpiRes<false, false> E; E.xres = nullptr; E.hb = (bf16_t*)(p.ws + O_HB); E.outf = nullptr; E.ssn = (float*)(p.ws + O_SS); run_gemm((LAS unsigned char*)shm, (bf16_t*)(p.ws + O_ACT), (const bf16_t*)(p.ws + W_DN0), DM, DFF, E); }
__global__ void __launch_bounds__(512, 2) t_gemm_gu(Params p) { extern __shared__ __attribute__((aligned(16))) unsigned char shm[]; EpiGU E; E.act = (bf16_t*)(p.ws + O_ACT); E.ss = (float*)(p.ws + O_SS); run_gemm((LAS unsigned char*)shm, (bf16_t*)(p.ws + O_HB), (const bf16_t*)(p.ws + W_GU0), 2 * DFF, DM, E); }
__global__ void __launch_bounds__(512, 2) t_gemm_ssdin(Params p) { extern __shared__ __attribute__((aligned(16))) unsigned char shm[]; EpiSsdIn E; E.z = (bf16_t*)p.out; E.xbc = (bf16_t*)(p.ws + O_XBC); E.dt = (float*)(p.ws + O_DT); E.ss = (float*)(p.ws + O_SS); run_gemm((LAS unsigned char*)shm, (bf16_t*)(p.ws + O_HB), (const bf16_t*)(p.ws + W_SIN), SINWP, DM, E); }
#endif
```

```cpp
#include <hip/hip_runtime.h>
#include <hip/hip_cooperative_groups.h>
#include <cstdio>
#include <cstdint>
namespace cg = cooperative_groups;
namespace pg8 {
#define PG8_LAS __attribute__((address_space(3)))
typedef unsigned short bf16_t;
typedef short bf16x8 __attribute__((ext_vector_type(8)));
typedef float f32x4 __attribute__((ext_vector_type(4)));
typedef unsigned u32x4 __attribute__((ext_vector_type(4)));
constexpr int BM = 256, BK = 64, HALF = 128, HTB = HALF * BK * 2  , STAGE_BYTES = 8 * HTB, NXCD = 8, WGM = 8;

__host__ __device__ __forceinline__ int lds_byte(int r, int c) { const int st = (r >> 4) * 2 + (c >> 5), rr = r & 15, cc = c & 31, ob = rr * 64 + cc * 2; return st * 1024 + (ob ^ (((ob >> 9) & 1) << 5)); }
__host__ __device__ __forceinline__ void stage_rc(int b, int& R, int& C) { const int st = b / 1024, sb = b % 1024, swz = sb ^ (((sb >> 9) & 1) << 5); R = (st >> 1) * 16 + swz / 64; C = (st & 1) * 32 + (swz % 64) / 2; }
__host__ __device__ __forceinline__ int perm32(int rho) { const int n = rho >> 4, i = rho & 15; return 8 * (i >> 2) + 4 * n + (i & 3); }

struct Unit { int pm, pn; };
struct Gemm { const bf16_t* A; const bf16_t* Bt; int M, N, K; };

struct StaticOrder {
    int nM, nN, nwg, G, c;
    __host__ __device__ void init(int M, int N, int G_, int c_) { nM = M / BM; nN = N / BM; nwg = nM * nN; G = G_; c = c_; }
    __host__ __device__ bool next(int i, Unit& u) const {
        const long L = (long)i * G + c; if (L >= nwg) return false;
        int wgid = (int)L; { const int q = nwg / NXCD, r = nwg % NXCD, xcd = wgid % NXCD, off = wgid / NXCD; wgid = (xcd < r ? xcd * (q + 1) : r * (q + 1) + (xcd - r) * q) + off; }
        const int nig = WGM * nN, gid = wgid / nig, fm = gid * WGM, gsz = (nM - fm) < WGM ? (nM - fm) : WGM;
        u.pm = fm + ((wgid % nig) % gsz); u.pn = (wgid % nig) / gsz; return true;
    }
    __device__ __forceinline__ void a_ready(const Unit&) const {}
    __device__ __forceinline__ void done(const Unit&) const {}
};

template <class Epi, class Sched, bool ALIGN_EPI = false, bool SP2 = false>
__device__ __forceinline__ void gemm_phase(PG8_LAS unsigned char* lds, const Gemm g, const Sched& S, const Epi& E) {
    int tid_ = threadIdx.x; asm volatile("" : "+v"(tid_)); const int tid = tid_, wid = __builtin_amdgcn_readfirstlane(tid >> 6), lane = tid & 63, wr = wid >> 2, wc = wid & 3, fr = lane & 15, fq = lane >> 4;
    const int K = g.K, nt = K / BK;
    unsigned voffA[2], voffB[2];
#pragma unroll
    for (int i = 0; i < 2; ++i) { int R, C; stage_rc(tid * 16 + i * 8192, R, C); const int Rb = Epi::PERM ? ((R & ~31) + perm32(R & 31)) : R;
        voffA[i] = (unsigned)(R * K + C) * 2u; voffB[i] = (unsigned)(Rb * K + C) * 2u; }
    const size_t kstep = (size_t)(BK * 2);
    const size_t hstep = (size_t)HALF * K * 2;
    const size_t tstep = 2 * hstep;
    const unsigned ldsw = (unsigned)wid * 1024u;
    const int aoff = lds_byte(wr * 64 + fr, fq * 8), boff = lds_byte(wc * 32 + fr, fq * 8);
#define PG8_SA(b, h) (((b) * 2 + (h)) * HTB)
#define PG8_SB(b, h) ((4 + (b) * 2 + (h)) * HTB)
#define PG8_STAGE(bufoff, gbase, voff) do { _Pragma("unroll") for (int _i = 0; _i < 2; ++_i) \
        __builtin_amdgcn_global_load_lds((const unsigned*)((const char*)(gbase) + (voff)[_i]), (PG8_LAS unsigned*)(lds + (bufoff) + ldsw + _i * 8192), 16, 0, 0); } while (0)
#define PG8_LDA(dst, b, h) do { _Pragma("unroll") for (int m = 0; m < 4; ++m) _Pragma("unroll") for (int k = 0; k < 2; ++k) dst[m][k] = *(const PG8_LAS bf16x8*)(lds + PG8_SA(b, h) + aoff + m * 2048 + k * 1024); } while (0)
#define PG8_LDB(dst, b, h) do { _Pragma("unroll") for (int n = 0; n < 2; ++n) _Pragma("unroll") for (int k = 0; k < 2; ++k) dst[n][k] = *(const PG8_LAS bf16x8*)(lds + PG8_SB(b, h) + boff + n * 2048 + k * 1024); } while (0)
#define PG8_MMA(ai, bj, At, Bt) do { __builtin_amdgcn_s_setprio(1); _Pragma("unroll") for (int m = 0; m < 4; ++m) _Pragma("unroll") for (int n = 0; n < 2; ++n) _Pragma("unroll") for (int k = 0; k < 2; ++k) \
        acc[ai][bj][m][n] = __builtin_amdgcn_mfma_f32_16x16x32_bf16(Bt[n][k], At[m][k], acc[ai][bj][m][n], 0, 0, 0); __builtin_amdgcn_s_setprio(0); } while (0)
#define PG8_WAIT_V(n) asm volatile("s_waitcnt vmcnt(" #n ")" ::: "memory")
#define PG8_WAIT_L(n) asm volatile("s_waitcnt lgkmcnt(" #n ")" ::: "memory")
#define PG8_BAR __builtin_amdgcn_s_barrier()
#define PG8_SCHED __builtin_amdgcn_sched_barrier(0)
    Unit cur, nxt; int ui = 0;
    if (!S.next(0, cur)) return;
    f32x4 acc[2][2][4][2];
#pragma unroll
    for (int a = 0; a < 2; ++a)
#pragma unroll
        for (int b = 0; b < 2; ++b)
#pragma unroll
            for (int m = 0; m < 4; ++m)
#pragma unroll
                for (int n = 0; n < 2; ++n) acc[a][b][m][n] = (f32x4){0.f, 0.f, 0.f, 0.f};
    bf16x8 At[4][2], B0[2][2], B1[2][2];
    float epre[8]; E.pre(cur, wr, fr, epre);
    const char* cA = (const char*)g.A + (size_t)cur.pm * tstep; const char* cB = (const char*)g.Bt + (size_t)cur.pn * tstep;
    S.a_ready(cur);
    if constexpr (SP2) {
        PG8_STAGE(PG8_SB(0, 0), cB, voffB); PG8_STAGE(PG8_SB(0, 1), cB + hstep, voffB); PG8_STAGE(PG8_SA(0, 0), cA, voffA); PG8_STAGE(PG8_SA(0, 1), cA + hstep, voffA);
        if (wr == 1) PG8_BAR;
        PG8_WAIT_V(2); PG8_BAR;
        PG8_STAGE(PG8_SB(1, 0), cB + kstep, voffB); PG8_STAGE(PG8_SA(1, 0), cA + kstep, voffA); PG8_STAGE(PG8_SB(1, 1), cB + hstep + kstep, voffB);
        PG8_WAIT_V(6); PG8_BAR;
    } else {
        PG8_STAGE(PG8_SB(0, 0), cB, voffB); PG8_STAGE(PG8_SA(0, 0), cA, voffA); PG8_STAGE(PG8_SB(0, 1), cB + hstep, voffB); PG8_STAGE(PG8_SA(0, 1), cA + hstep, voffA);
        if (wr == 1) PG8_BAR;
        PG8_WAIT_V(4); PG8_BAR;
        PG8_STAGE(PG8_SB(1, 0), cB + kstep, voffB); PG8_STAGE(PG8_SA(1, 0), cA + kstep, voffA); PG8_STAGE(PG8_SB(1, 1), cB + hstep + kstep, voffB);
        PG8_WAIT_V(6); PG8_BAR;
    }
    for (;;) {
        const bool has_next = S.next(ui + 1, nxt);
        const char* nA = has_next ? (const char*)g.A + (size_t)nxt.pm * tstep : cA; const char* nB = has_next ? (const char*)g.Bt + (size_t)nxt.pn * tstep : cB;
        for (int t = 0; t < nt; t += 2) {
            const bool last = (t == nt - 2);
            const char* a1 = cA + (size_t)(t + 1) * kstep;
            const char* a2 = last ? nA : cA + (size_t)(t + 2) * kstep; const char* b2 = last ? nB : cB + (size_t)(t + 2) * kstep;
            const char* a3 = a2 + kstep; const char* b3 = b2 + kstep;
            if (last && has_next) S.a_ready(nxt);
            if constexpr (SP2) {
            PG8_LDB(B0, 0, 0); PG8_LDB(B1, 0, 1); PG8_SCHED; PG8_LDA(At, 0, 0); PG8_STAGE(PG8_SA(1, 1), a1 + hstep, voffA);
            PG8_WAIT_V(8); PG8_WAIT_L(0); PG8_BAR; PG8_MMA(0, 0, At, B0); PG8_MMA(0, 1, At, B1); PG8_BAR; PG8_SCHED;
            PG8_LDA(At, 0, 1); PG8_STAGE(PG8_SB(0, 0), b2, voffB); PG8_STAGE(PG8_SB(0, 1), b2 + hstep, voffB); PG8_STAGE(PG8_SA(0, 0), a2, voffA);
            PG8_WAIT_V(8); PG8_WAIT_L(0); PG8_BAR; PG8_MMA(1, 0, At, B0); PG8_MMA(1, 1, At, B1); PG8_BAR; PG8_SCHED;
            PG8_LDB(B0, 1, 0); PG8_LDB(B1, 1, 1); PG8_SCHED; PG8_LDA(At, 1, 0); PG8_STAGE(PG8_SA(0, 1), a2 + hstep, voffA);
            PG8_WAIT_V(8); PG8_WAIT_L(0); PG8_BAR; PG8_MMA(0, 0, At, B0); PG8_MMA(0, 1, At, B1); PG8_BAR; PG8_SCHED;
            PG8_LDA(At, 1, 1); PG8_STAGE(PG8_SB(1, 0), b3, voffB); PG8_STAGE(PG8_SB(1, 1), b3 + hstep, voffB); PG8_STAGE(PG8_SA(1, 0), a3, voffA);
            PG8_WAIT_V(8); PG8_WAIT_L(0); PG8_BAR; PG8_MMA(1, 0, At, B0); PG8_MMA(1, 1, At, B1); PG8_BAR; PG8_SCHED;
            } else {
            PG8_LDB(B0, 0, 0); PG8_SCHED; PG8_LDA(At, 0, 0); PG8_STAGE(PG8_SA(1, 1), a1 + hstep, voffA);
            PG8_WAIT_L(8); PG8_BAR; PG8_WAIT_L(0); PG8_MMA(0, 0, At, B0); PG8_BAR; PG8_SCHED;
            PG8_LDB(B1, 0, 1); PG8_STAGE(PG8_SB(0, 0), b2, voffB);
            PG8_BAR; PG8_WAIT_L(0); PG8_MMA(0, 1, At, B1); PG8_BAR;
            PG8_LDA(At, 0, 1); PG8_STAGE(PG8_SA(0, 0), a2, voffA);
            PG8_BAR; PG8_WAIT_L(0); PG8_MMA(1, 0, At, B0); PG8_BAR; PG8_SCHED;
            PG8_STAGE(PG8_SB(0, 1), b2 + hstep, voffB);
            PG8_WAIT_V(6); PG8_BAR; PG8_MMA(1, 1, At, B1); PG8_BAR;
            PG8_LDB(B0, 1, 0); PG8_SCHED; PG8_LDA(At, 1, 0); PG8_STAGE(PG8_SA(0, 1), a2 + hstep, voffA);
            PG8_WAIT_L(8); PG8_BAR; PG8_WAIT_L(0); PG8_MMA(0, 0, At, B0); PG8_BAR; PG8_SCHED;
            PG8_LDB(B1, 1, 1); PG8_STAGE(PG8_SB(1, 0), b3, voffB);
            PG8_BAR; PG8_WAIT_L(0); PG8_MMA(0, 1, At, B1); PG8_BAR;
            PG8_LDA(At, 1, 1); PG8_STAGE(PG8_SA(1, 0), a3, voffA);
            PG8_BAR; PG8_WAIT_L(0); PG8_MMA(1, 0, At, B0); PG8_BAR; PG8_SCHED;
            PG8_STAGE(PG8_SB(1, 1), b3 + hstep, voffB);
            PG8_WAIT_V(6); PG8_BAR; PG8_MMA(1, 1, At, B1); PG8_BAR;
            }
        }
        if constexpr (ALIGN_EPI) { if (wr == 0) PG8_BAR; }
        if constexpr (!Epi::AFTER_DRAIN) { E(acc, cur, wr, wc, fr, fq, epre); S.done(cur); }
        if (!has_next) break;
        E.pre(nxt, wr, fr, epre);
#pragma unroll
        for (int a = 0; a < 2; ++a)
#pragma unroll
            for (int b = 0; b < 2; ++b)
#pragma unroll
                for (int m = 0; m < 4; ++m)
#pragma unroll
                    for (int n = 0; n < 2; ++n) acc[a][b][m][n] = (f32x4){0.f, 0.f, 0.f, 0.f};
        cur = nxt; cA = nA; cB = nB; ++ui;
        if constexpr (ALIGN_EPI) { if (wr == 1) PG8_BAR; }
    }
    PG8_WAIT_V(0);
    if constexpr (!ALIGN_EPI) { if (wr == 0) PG8_BAR; }
    PG8_BAR;
    if constexpr (Epi::AFTER_DRAIN) { E.fused(acc, cur, wr, wc, fr, fq, lds, wid, lane); S.done(cur); }
#undef PG8_SA
#undef PG8_SB
#undef PG8_STAGE
#undef PG8_LDA
#undef PG8_LDB
#undef PG8_MMA
#undef PG8_WAIT_V
#undef PG8_WAIT_L
#undef PG8_BAR
#undef PG8_SCHED
}
}
using pg8::bf16_t; using pg8::bf16x8; using pg8::f32x4;
typedef short s16x4 __attribute__((ext_vector_type(4)));
typedef float f32x16 __attribute__((ext_vector_type(16)));
typedef float f32x2 __attribute__((ext_vector_type(2)));
typedef __bf16 bf2_t __attribute__((ext_vector_type(2)));
typedef unsigned u32x2 __attribute__((ext_vector_type(2)));
typedef unsigned u32x4 __attribute__((ext_vector_type(4)));
#define LAS __attribute__((address_space(3)))
#define DI __device__ __forceinline__
#define MFMA32(a, b, c) __builtin_amdgcn_mfma_f32_32x32x16_bf16((a), (b), (c), 0, 0, 0)

DI int otid() { int t = threadIdx.x; asm volatile("" : "+v"(t)); return t; }
DI unsigned pk2(float a, float b) { f32x2 v = {a, b}; bf2_t r = __builtin_convertvector(v, bf2_t); return __builtin_bit_cast(unsigned, r); }
DI float bflo(unsigned u) { return __uint_as_float(u << 16); }
DI float bfhi(unsigned u) { return __uint_as_float(u & 0xffff0000u); }
DI float fexp2(float x) { return __builtin_amdgcn_exp2f(x); }
DI float frcp(float x) { return __builtin_amdgcn_rcpf(x); }
DI float fsilu(float x) { return x * frcp(1.0f + fexp2(-1.44269504089f * x)); }
DI int crow(int i, int h) { return (i & 3) + 8 * (i >> 2) + 4 * h; }
DI s16x4 trr(const LAS unsigned char* p) { return __builtin_amdgcn_ds_read_tr16_b64_v4i16((LAS s16x4*)p); }
DI bf16x8 tr2(const LAS unsigned char* p0, const LAS unsigned char* p1) { s16x4 a = trr(p0), b = trr(p1); return __builtin_shufflevector(a, b, 0, 1, 2, 3, 4, 5, 6, 7); }
DI bf16x8 pack8(const f32x16& x, int s) {
    u32x4 p; p[0] = pk2(x[8 * s], x[8 * s + 1]); p[1] = pk2(x[8 * s + 2], x[8 * s + 3]); p[2] = pk2(x[8 * s + 4], x[8 * s + 5]); p[3] = pk2(x[8 * s + 6], x[8 * s + 7]);
    return __builtin_bit_cast(bf16x8, p);
}
DI f32x16 zero16() { f32x16 z; for (int i = 0; i < 16; ++i) z[i] = 0.f; return z; }

constexpr int MT = 16384, SEQ = 8192, DM = 1024, DFF = 2816, AINW = 3072, SINW = 6176, SINWP = 6400, DIN = 2048, XBCW = 4096;
constexpr float LOG2E = 1.44269504089f;
constexpr int LDS_BYTES = 155648;
constexpr size_t W_AIN = 0, W_AOUT = W_AIN + (size_t)AINW * DM * 2, W_GU0 = W_AOUT + (size_t)DM * DM * 2, W_DN0 = W_GU0 + (size_t)2 * DFF * DM * 2,
                 W_SIN = W_DN0 + (size_t)DM * DFF * 2, W_SOUT = W_SIN + (size_t)SINWP * DM * 2, W_GU1 = W_SOUT + (size_t)DM * DIN * 2, W_DN1 = W_GU1 + (size_t)2 * DFF * DM * 2,
                 O_HB = W_DN1 + (size_t)DM * DFF * 2, O_SS = O_HB + (size_t)MT * DM * 2, O_ROPE = O_SS + (size_t)5 * MT * 4, O_DT = O_ROPE + (size_t)SEQ * 32 * 8,
                 O_CDEC = O_DT + (size_t)MT * 32 * 4, O_LAM = O_CDEC + 16384, O_BAR = O_LAM + 256, O_R = 98566144;
static_assert(O_BAR + 20480 <= O_R, "map");
constexpr size_t O_PROJ = O_R, O_MIXED = O_PROJ + (size_t)MT * AINW * 2, O_ACT = O_R, O_XBC = O_R, O_ST1 = O_XBC + (size_t)MT * XBCW * 2, O_ST0 = 0;
constexpr size_t ST_BATCH = (size_t)64 * 32 * 64 * 128;
static_assert(O_ST1 + ST_BATCH * 2 <= 268435456ull, "ws");
static_assert(ST_BATCH * 2 <= W_SOUT, "st0 overlay");
static_assert(O_MIXED + (size_t)MT * DM * 2 <= 268435456ull, "ws2");

struct Params { const float* in[23]; float* out; unsigned char* ws; };
#include <cstdlib>
#include <vector>

#define XB_TMO      128
#define XB_XCNT(j)  (256  + 64 * (j))
#define XB_XSUB(j)  (1280 + 64 * (j))
#define XB_XGEN(j)  (2304 + 64 * (j))
#define XB_TOP      3328
#define XB_TOPGEN   3392
#define XCD_BAR_WORDS 3456
#define XB_SPIN_CAP (1u << 18)

__device__ __forceinline__ unsigned xb_ld(unsigned* p)              { return __hip_atomic_load(p, __ATOMIC_RELAXED, __HIP_MEMORY_SCOPE_AGENT); }
__device__ __forceinline__ unsigned xb_add(unsigned* p, unsigned v) { return __hip_atomic_fetch_add(p, v, __ATOMIC_RELAXED, __HIP_MEMORY_SCOPE_AGENT); }
__device__ __forceinline__ unsigned xb_xcc_id() { return (unsigned)__builtin_amdgcn_s_getreg((3 << 11) | 20) & 0xFu; }
#define XB_SPIN(cond, bar) do { unsigned _sp = 0; while (cond) { \
    if ((++_sp & 255u) == 0u) { if (xb_ld(&(bar)[XB_TMO])) break; if (_sp > XB_SPIN_CAP) { atomicAdd(&(bar)[XB_TMO], 1u); break; } } } } while (0)

struct XcdBarrier {
    unsigned* bar; unsigned x;
    volatile LAS unsigned* st;
};

__device__ __forceinline__ XcdBarrier xcd_barrier_post(unsigned* bar, volatile LAS unsigned* st) {
    XcdBarrier b; b.bar = bar; b.x = xb_xcc_id(); b.st = st;
    if (threadIdx.x == 0) (void)xb_add(&bar[XB_XCNT(b.x)], 1u);
    return b;
}
__device__ __forceinline__ void xcd_barrier_complete(unsigned* bar, unsigned x, unsigned& nloc, unsigned& nx) {
    const unsigned G = gridDim.x * gridDim.y * gridDim.z;
    unsigned sum, cnt, mine, sp = 0u;
    for (;;) {
        sum = 0u; cnt = 0u; mine = 0u;
#pragma unroll
        for (unsigned j = 0; j < 16; ++j) { const unsigned c = xb_ld(&bar[XB_XCNT(j)]); sum += c; cnt += (c > 0u) ? 1u : 0u; mine = (j == x) ? c : mine; }
        if (sum == G) break;
        __builtin_amdgcn_s_sleep(1);
        if ((++sp & 255u) == 0u) { if (xb_ld(&bar[XB_TMO])) break; if (sp > XB_SPIN_CAP) { atomicAdd(&bar[XB_TMO], 1u); break; } }
    }
    nloc = mine > 0u ? mine : 1u; nx = cnt > 0u ? cnt : 1u;
}

__device__ __forceinline__ void xcd_barrier(const XcdBarrier& b) {
    asm volatile("s_waitcnt vmcnt(0)" ::: "memory");
    __syncthreads();
    if (threadIdx.x == 0) {
        unsigned* bar = b.bar;
        __builtin_amdgcn_s_waitcnt(0);
        unsigned nloc = b.st[0], nx = b.st[1];
        if (nloc == 0u) { xcd_barrier_complete(bar, b.x, nloc, nx); b.st[0] = nloc; b.st[1] = nx; }
        const unsigned old = xb_add(&bar[XB_XSUB(b.x)], 1u);
        const unsigned gen = old / nloc;
        if (old + 1u == (gen + 1u) * nloc) {
            __builtin_amdgcn_fence(__ATOMIC_RELEASE, "agent");
            asm volatile("s_waitcnt vmcnt(0)" ::: "memory");
            const unsigned og = xb_add(&bar[XB_TOP], 1u);
            const unsigned tg = og / nx;
            if (og + 1u == (tg + 1u) * nx) xb_add(&bar[XB_TOPGEN], 1u);
            else XB_SPIN(xb_ld(&bar[XB_TOPGEN]) == tg, bar);
            __builtin_amdgcn_fence(__ATOMIC_ACQUIRE, "agent");
            xb_add(&bar[XB_XGEN(b.x)], 1u);
            asm volatile("s_waitcnt vmcnt(0)" ::: "memory");
        } else {
            XB_SPIN(xb_ld(&bar[XB_XGEN(b.x)]) == gen, bar);
            __builtin_amdgcn_fence(__ATOMIC_ACQUIRE, "agent");
            asm volatile("s_waitcnt vmcnt(0)" ::: "memory");
        }
    }
    __syncthreads();
}
DI void wmap(int mode, int c, int& src, float& scale, int& which) {
    src = c; scale = 1.f; which = 0;
    if (mode == 0) {
        if (c < 1024) { const int base = c & ~63, cc = c & 63, g = cc >> 3, e = cc & 7; src = base + (e < 4 ? 4 * g + e : 32 + 4 * g + (e - 4)); }
        if (c < 512) scale = 0.125f * LOG2E; else if (c >= 1536 && c < 2048) scale = 0.125f;
    } else if (mode == 2) { src = 128 * (c >> 8) + (c & 127); which = (c >> 7) & 1; }
    else if (mode == 3) { if (c >= SINW) src = -1; }
}
struct WJob { int mode, K, ldw, tix; const float* W0; const float* W1; const float* ks; bf16_t* dst; };
DI WJob wjob(const Params& p, int t) {
    unsigned char* ws = p.ws;
    const int cnt[8] = {48 * 4, 16 * 4, 88 * 4, 16 * 11, 100 * 4, 16 * 8, 88 * 4, 16 * 11};
    int j = 0, tt = t;
#pragma unroll
    for (int q = 0; q < 7; ++q) if (j == q && tt >= cnt[q]) { tt -= cnt[q]; j = q + 1; }
    WJob J; J.tix = tt; J.W1 = nullptr; J.ks = nullptr;
    switch (j) {
    case 0: J.mode = 0; J.W0 = p.in[2]; J.ks = p.in[1]; J.dst = (bf16_t*)(ws + W_AIN); J.K = DM; J.ldw = AINW; break;
    case 1: J.mode = 1; J.W0 = p.in[8]; J.dst = (bf16_t*)(ws + W_AOUT); J.K = DM; J.ldw = DM; break;
    case 2: J.mode = 2; J.W0 = p.in[19]; J.W1 = p.in[20]; J.ks = p.in[18]; J.dst = (bf16_t*)(ws + W_GU0); J.K = DM; J.ldw = DFF; break;
    case 3: J.mode = 1; J.W0 = p.in[21]; J.dst = (bf16_t*)(ws + W_DN0); J.K = DFF; J.ldw = DM; break;
    case 4: J.mode = 3; J.W0 = p.in[10]; J.ks = p.in[9]; J.dst = (bf16_t*)(ws + W_SIN); J.K = DM; J.ldw = SINW; break;
    case 5: J.mode = 1; J.W0 = p.in[17]; J.dst = (bf16_t*)(ws + W_SOUT); J.K = DIN; J.ldw = DM; break;
    case 6: J.mode = 2; J.W0 = p.in[19] + (size_t)DM * DFF; J.W1 = p.in[20] + (size_t)DM * DFF; J.ks = p.in[18] + DM; J.dst = (bf16_t*)(ws + W_GU1); J.K = DM; J.ldw = DFF; break;
    default: J.mode = 1; J.W0 = p.in[21] + (size_t)DFF * DM; J.dst = (bf16_t*)(ws + W_DN1); J.K = DFF; J.ldw = DM; break;
    }
    return J;
}
DI void wtile_load(const WJob& J, int tid, float (&v)[32], float& sc, int& srcok) {
    const int nk = J.K >> 8, c0 = (J.tix / nk) * 64, k0 = (J.tix % nk) * 256, cc = tid & 63; int src, which; wmap(J.mode, c0 + cc, src, sc, which);
    const float* W = (which ? J.W1 : J.W0) + (src >= 0 ? src : 0); srcok = (src >= 0);
#pragma unroll
    for (int i = 0; i < 32; ++i) { const int kk = (tid >> 6) + 8 * i; v[i] = W[(size_t)(k0 + kk) * J.ldw]; }
}
DI void wtile_store(LAS float* tile, const WJob& J, int tid, const float (&v)[32], float sc, int srcok) {
    const int nk = J.K >> 8, c0 = (J.tix / nk) * 64, k0 = (J.tix % nk) * 256, cc = tid & 63;
#pragma unroll
    for (int i = 0; i < 32; ++i) { const int kk = (tid >> 6) + 8 * i; float x = srcok ? v[i] * sc : 0.f; if (J.ks) x *= J.ks[k0 + kk]; tile[kk * 65 + cc] = x; }
    __syncthreads();
#pragma unroll
    for (int i = 0; i < 16; ++i) {
        const int idx = tid + 512 * i, c2 = idx >> 7, k2 = (idx & 127) * 2;
        *(unsigned*)(J.dst + (size_t)(c0 + c2) * J.K + k0 + k2) = pk2(tile[k2 * 65 + c2], tile[(k2 + 1) * 65 + c2]);
    }
    __syncthreads();
}
DI void wconv_jobs(LAS unsigned char* lds, const Params& p, int wi, int nb) {
    const int tid = otid(); const int total = 48 * 4 + 16 * 4 + 2 * (88 * 4 + 16 * 11) + 100 * 4 + 16 * 8;
    if (wi >= total) return;
    WJob J = wjob(p, wi); float v[32]; float sc; int ok;
    wtile_load(J, tid, v, sc, ok);
    for (int t = wi; t < total; t += nb) {
        const bool more = (t + nb < total);
        WJob Jn = J; float vn[32]; float scn = 0.f; int okn = 0;
        if (more) { Jn = wjob(p, t + nb); wtile_load(Jn, tid, vn, scn, okn); }
        wtile_store((LAS float*)lds, J, tid, v, sc, ok);
        if (more) { J = Jn; sc = scn; ok = okn;
#pragma unroll
            for (int i = 0; i < 32; ++i) v[i] = vn[i]; }
    }
}
DI void phase0(LAS unsigned char* lds, const Params& p) {
    const int tid = otid(), G = gridDim.x, bx = blockIdx.x;
    unsigned char* ws = p.ws;
    wconv_jobs(lds, p, bx, G);
    {
        const int wave = tid >> 6, lane = tid & 63; bf16_t* hb = (bf16_t*)(ws + O_HB); float* ss = (float*)(ws + O_SS);
        for (int row0 = (bx * 8 + wave) * 2; row0 < MT; row0 += G * 16) {
            f32x4 v[2][4];
#pragma unroll
            for (int q = 0; q < 2; ++q)
#pragma unroll
                for (int i = 0; i < 4; ++i) v[q][i] = *(const f32x4*)(p.in[0] + (size_t)(row0 + q) * DM + lane * 4 + 256 * i);
#pragma unroll
            for (int q = 0; q < 2; ++q) {
                float sq = 0.f;
#pragma unroll
                for (int i = 0; i < 4; ++i) { const f32x4 x = v[q][i]; sq += x[0] * x[0] + x[1] * x[1] + x[2] * x[2] + x[3] * x[3];
                    u32x2 o; o[0] = pk2(x[0], x[1]); o[1] = pk2(x[2], x[3]); *(u32x2*)(hb + (size_t)(row0 + q) * DM + lane * 4 + 256 * i) = o; }
#pragma unroll
                for (int o = 32; o >= 1; o >>= 1) sq += __shfl_xor(sq, o);
                if (lane == 0) ss[row0 + q] = sq;
            }
        }
        for (int i = bx * 512 + tid; i < 4 * MT; i += G * 512) ss[MT + i] = 0.f;
        f32x2* tab = (f32x2*)(ws + O_ROPE);
        for (int i = bx * 512 + tid; i < SEQ * 32; i += G * 512) {
            const int pos = i >> 5, f = i & 31; const float inv = fexp2(-(float)f * 0.41524101186092f); const float ang = (float)pos * inv;
            double t = (double)ang * 0.15915494309189535; t -= floor(t); const float tf = (float)t;
            f32x2 cs; cs[0] = __builtin_amdgcn_cosf(tf); cs[1] = __builtin_amdgcn_sinf(tf); tab[i] = cs;
        }
        if (bx == 0 && tid == 0) { float s1 = 0.f, s2 = 0.f; for (int i = 0; i < 64; ++i) { s1 += p.in[3][i] * p.in[4][i]; s2 += p.in[5][i] * p.in[6][i]; }
            *(float*)(ws + O_LAM) = fexp2(s1 * LOG2E) - fexp2(s2 * LOG2E) + 0.2f; }
    }
}

struct EpiAttnIn {
    static constexpr bool PERM = true, AFTER_DRAIN = false;
    bf16_t* O; const float* ss; const f32x4* tab;
    DI void pre(const pg8::Unit& u, int wr, int fr, float (&e)[8]) const {
#pragma unroll
        for (int ai = 0; ai < 2; ++ai)
#pragma unroll
            for (int m = 0; m < 4; ++m) e[ai * 4 + m] = ss[u.pm * 256 + wr * 64 + fr + ai * 128 + m * 16];
    }
    DI void operator()(const f32x4 (&acc)[2][2][4][2], const pg8::Unit& u, int wr, int wc, int fr, int fq, const float (&epre)[8]) const {
        const int row0 = u.pm * 256 + wr * 64 + fr, colt = u.pn * 256, col0 = colt + wc * 32 + 8 * fq;
        const int fb = 4 * (4 * (wc & 1) + fq);
#pragma unroll
        for (int ai = 0; ai < 2; ++ai)
#pragma unroll
            for (int m = 0; m < 4; ++m) {
                const int row = row0 + ai * 128 + m * 16; const float rs = __builtin_amdgcn_rsqf(epre[ai * 4 + m] * (1.0f / 1024.0f) + 1e-6f);
                f32x4 c01 = {1.f, 0.f, 1.f, 0.f}, c23 = {1.f, 0.f, 1.f, 0.f};
                if (colt < 1024) { const int pos = row & (SEQ - 1); c01 = tab[(pos * 32 + fb) >> 1]; c23 = tab[((pos * 32 + fb) >> 1) + 1]; }
#pragma unroll
                for (int bj = 0; bj < 2; ++bj) {
                    f32x4 v0 = acc[ai][bj][m][0] * rs, v1 = acc[ai][bj][m][1] * rs;
                    if (colt < 1024) {
                        const float cs[4] = {c01[0], c01[2], c23[0], c23[2]}, sn[4] = {c01[1], c01[3], c23[1], c23[3]};
#pragma unroll
                        for (int j = 0; j < 4; ++j) { const float t1 = v0[j], t2 = v1[j]; v0[j] = t1 * cs[j] - t2 * sn[j]; v1[j] = t2 * cs[j] + t1 * sn[j]; }
                    }
                    u32x4 o; o[0] = pk2(v0[0], v0[1]); o[1] = pk2(v0[2], v0[3]); o[2] = pk2(v1[0], v1[1]); o[3] = pk2(v1[2], v1[3]);
                    *(u32x4*)(O + (size_t)row * AINW + col0 + bj * 128) = o;
                }
            }
    }
};
template <bool RES_F32, bool OUT_F32> struct EpiRes {
    static constexpr bool PERM = true, AFTER_DRAIN = false;
    const float* xres; bf16_t* hb; float* outf; float* ssn;
    DI void pre(const pg8::Unit&, int, int, float (&)[8]) const {}
    DI void operator()(const f32x4 (&acc)[2][2][4][2], const pg8::Unit& u, int wr, int wc, int fr, int fq, const float (&epre)[8]) const {
        const int row0 = u.pm * 256 + wr * 64 + fr, col0 = u.pn * 256 + wc * 32 + 8 * fq;
#pragma unroll
        for (int ai = 0; ai < 2; ++ai)
#pragma unroll
            for (int m = 0; m < 4; ++m) {
                const int row = row0 + ai * 128 + m * 16; float sq = 0.f;
#pragma unroll
                for (int bj = 0; bj < 2; ++bj) {
                    const size_t off = (size_t)row * DM + col0 + bj * 128; f32x4 r0, r1;
                    if (RES_F32) { r0 = *(const f32x4*)(xres + off); r1 = *(const f32x4*)(xres + off + 4); }
                    else { const u32x4 t = *(const u32x4*)(hb + off); r0[0] = bflo(t[0]); r0[1] = bfhi(t[0]); r0[2] = bflo(t[1]); r0[3] = bfhi(t[1]); r1[0] = bflo(t[2]); r1[1] = bfhi(t[2]); r1[2] = bflo(t[3]); r1[3] = bfhi(t[3]); }
                    const f32x4 v0 = r0 + acc[ai][bj][m][0], v1 = r1 + acc[ai][bj][m][1];
                    sq += v0[0] * v0[0] + v0[1] * v0[1] + v0[2] * v0[2] + v0[3] * v0[3] + v1[0] * v1[0] + v1[1] * v1[1] + v1[2] * v1[2] + v1[3] * v1[3];
                    if (OUT_F32) { *(f32x4*)(outf + off) = v0; *(f32x4*)(outf + off + 4) = v1; }
                    else { u32x4 o; o[0] = pk2(v0[0], v0[1]); o[1] = pk2(v0[2], v0[3]); o[2] = pk2(v1[0], v1[1]); o[3] = pk2(v1[2], v1[3]); *(u32x4*)(hb + off) = o; }
                }
                sq += __shfl_xor(sq, 16); sq += __shfl_xor(sq, 32);
                if (fq == 0) atomicAdd(ssn + row, sq);
            }
    }
};
struct EpiGU {
    static constexpr bool PERM = true, AFTER_DRAIN = false;
    bf16_t* act; const float* ss;
    DI void pre(const pg8::Unit& u, int wr, int fr, float (&e)[8]) const {
#pragma unroll
        for (int ai = 0; ai < 2; ++ai)
#pragma unroll
            for (int m = 0; m < 4; ++m) e[ai * 4 + m] = ss[u.pm * 256 + wr * 64 + fr + ai * 128 + m * 16];
    }
    DI void operator()(const f32x4 (&acc)[2][2][4][2], const pg8::Unit& u, int wr, int wc, int fr, int fq, const float (&epre)[8]) const {
        const int row0 = u.pm * 256 + wr * 64 + fr;
#pragma unroll
        for (int ai = 0; ai < 2; ++ai)
#pragma unroll
            for (int m = 0; m < 4; ++m) {
                const int row = row0 + ai * 128 + m * 16; const float rs = __builtin_amdgcn_rsqf(epre[ai * 4 + m] * (1.0f / 1024.0f) + 1e-6f);
                u32x4 o;
#pragma unroll
                for (int n = 0; n < 2; ++n) {
                    const f32x4 g = acc[ai][0][m][n] * rs, up = acc[ai][1][m][n] * rs; float a[4];
#pragma unroll
                    for (int j = 0; j < 4; ++j) a[j] = fsilu(g[j]) * up[j];
                    o[2 * n] = pk2(a[0], a[1]); o[2 * n + 1] = pk2(a[2], a[3]);
                }
                *(u32x4*)(act + (size_t)row * DFF + u.pn * 128 + wc * 32 + 8 * fq) = o;
            }
    }
};
struct EpiSsdIn {
    static constexpr bool PERM = true, AFTER_DRAIN = false;
    bf16_t* z; bf16_t* xbc; float* dt; const float* ss;
    DI void pre(const pg8::Unit& u, int wr, int fr, float (&e)[8]) const {
#pragma unroll
        for (int ai = 0; ai < 2; ++ai)
#pragma unroll
            for (int m = 0; m < 4; ++m) e[ai * 4 + m] = ss[u.pm * 256 + wr * 64 + fr + ai * 128 + m * 16];
    }
    DI void operator()(const f32x4 (&acc)[2][2][4][2], const pg8::Unit& u, int wr, int wc, int fr, int fq, const float (&epre)[8]) const {
        const int row0 = u.pm * 256 + wr * 64 + fr, col0 = u.pn * 256 + wc * 32 + 8 * fq;
#pragma unroll
        for (int ai = 0; ai < 2; ++ai)
#pragma unroll
            for (int m = 0; m < 4; ++m) {
                const int row = row0 + ai * 128 + m * 16; const float rs = __builtin_amdgcn_rsqf(epre[ai * 4 + m] * (1.0f / 1024.0f) + 1e-6f);
#pragma unroll
                for (int bj = 0; bj < 2; ++bj) {
                    const int c = col0 + bj * 128; const f32x4 v0 = acc[ai][bj][m][0] * rs, v1 = acc[ai][bj][m][1] * rs;
                    if (c < 6144) { u32x4 o; o[0] = pk2(v0[0], v0[1]); o[1] = pk2(v0[2], v0[3]); o[2] = pk2(v1[0], v1[1]); o[3] = pk2(v1[2], v1[3]);
                        if (c < DIN) *(u32x4*)(z + (size_t)row * DIN + c) = o; else *(u32x4*)(xbc + (size_t)row * XBCW + (c - DIN)) = o; }
                }
            }
    }
};

struct EpiFinal {
    static constexpr bool PERM = true, AFTER_DRAIN = true;
    const bf16_t* hb; float* outf; float* ssn; unsigned* cnt; const float* fw;
    DI void operator()(const f32x4 (&)[2][2][4][2], const pg8::Unit&, int, int, int, int, const float (&)[8]) const {}
    DI void pre(const pg8::Unit&, int, int, float (&)[8]) const {}
    DI void fused(f32x4 (&acc)[2][2][4][2], const pg8::Unit& u, int wr, int wc, int fr, int fq, PG8_LAS unsigned char*, int, int) const {
        const int row0 = u.pm * 256 + wr * 64 + fr, col0 = u.pn * 256 + wc * 32 + 8 * fq;
#pragma unroll
        for (int ai = 0; ai < 2; ++ai)
#pragma unroll
            for (int m = 0; m < 4; ++m) {
                const int row = row0 + ai * 128 + m * 16; float sq = 0.f;
#pragma unroll
                for (int bj = 0; bj < 2; ++bj) {
                    const size_t off = (size_t)row * DM + col0 + bj * 128;
                    const u32x4 t = *(const u32x4*)(hb + off);
#pragma unroll
                    for (int n = 0; n < 2; ++n) {
                        f32x4 r; r[0] = bflo(t[2 * n]); r[1] = bfhi(t[2 * n]); r[2] = bflo(t[2 * n + 1]); r[3] = bfhi(t[2 * n + 1]);
                        const f32x4 v = r + acc[ai][bj][m][n]; acc[ai][bj][m][n] = v;
                        sq += v[0] * v[0] + v[1] * v[1] + v[2] * v[2] + v[3] * v[3];
                    }
                }
                sq += __shfl_xor(sq, 16); sq += __shfl_xor(sq, 32);
                if (fq == 0) atomicAdd(ssn + row, sq);
            }
        asm volatile("s_waitcnt vmcnt(0)" ::: "memory");
        __syncthreads();
        unsigned* c = cnt + 16 * u.pm;
        if (threadIdx.x == 0) {
            __builtin_amdgcn_fence(__ATOMIC_RELEASE, "agent"); asm volatile("s_waitcnt vmcnt(0)" ::: "memory");
            __hip_atomic_fetch_add(c, 1u, __ATOMIC_RELAXED, __HIP_MEMORY_SCOPE_AGENT);
            unsigned spins = 0;
            while (__hip_atomic_load(c, __ATOMIC_RELAXED, __HIP_MEMORY_SCOPE_AGENT) < 4u && ++spins < (1u << 22)) __builtin_amdgcn_s_sleep(2);
            __builtin_amdgcn_fence(__ATOMIC_ACQUIRE, "agent"); asm volatile("s_waitcnt vmcnt(0)" ::: "memory");
        }
        __syncthreads();
#pragma unroll
        for (int ai = 0; ai < 2; ++ai)
#pragma unroll
            for (int m = 0; m < 4; ++m) {
                const int row = row0 + ai * 128 + m * 16;
                const float rs = __builtin_amdgcn_rsqf(__hip_atomic_load(ssn + row, __ATOMIC_RELAXED, __HIP_MEMORY_SCOPE_AGENT) * (1.0f / 1024.0f) + 1e-6f);
#pragma unroll
                for (int bj = 0; bj < 2; ++bj)
#pragma unroll
                    for (int n = 0; n < 2; ++n) {
                        const int col = col0 + bj * 128 + n * 4; const f32x4 w = *(const f32x4*)(fw + col);
                        *(f32x4*)(outf + (size_t)row * DM + col) = acc[ai][bj][m][n] * rs * w;
                    }
            }
    }
};
constexpr int KST = 144, VST = 320, VST64 = 192;
constexpr int AT_K1 = 0, AT_K2 = 64 * KST, AT_V = 2 * 64 * KST, AT_STAGE = AT_V + 64 * VST;

DI void diff_tile(LAS unsigned char* lds, const bf16_t* proj, bf16_t* mixed, const float* subln, float lam, int b, int hd, int qt) {
    const int tid = otid(), w = __builtin_amdgcn_readfirstlane(tid >> 6), lane = tid & 63, qg = w & 3, mp = w >> 2, r = lane & 31, h = lane >> 5;
    const int q0 = qt * 128; const size_t rowb = (size_t)b * SEQ;
    bf16x8 qf[4];
    { const bf16_t* qp = proj + (rowb + q0 + 32 * qg + r) * AINW + hd * 128 + mp * 64 + 8 * h;
#pragma unroll
      for (int s = 0; s < 4; ++s) qf[s] = *(const bf16x8*)(qp + 16 * s); }
    f32x16 O[4];
#pragma unroll
    for (int i = 0; i < 4; ++i) O[i] = zero16();
    float mrun = 0.f, lrun = 0.f;
    const int nsteps = 2 * (qt + 1);
    const bf16_t* src[4]; int dst[4];
#pragma unroll
    for (int i = 0; i < 2; ++i) { const int cid = tid + 512 * i, row = cid >> 4, c16 = cid & 15;
        src[i] = proj + (rowb + row) * AINW + 512 + hd * 128 + c16 * 8; dst[i] = (c16 < 8 ? AT_K1 : AT_K2) + row * KST + (c16 & 7) * 16;
        src[2 + i] = proj + (rowb + row) * AINW + 1024 + hd * 128 + c16 * 8; dst[2 + i] = AT_V + row * VST + c16 * 16; }
    u32x4 pf[4];
#pragma unroll
    for (int i = 0; i < 4; ++i) pf[i] = *(const u32x4*)(src[i]);
#pragma unroll
    for (int i = 0; i < 4; ++i) *(LAS u32x4*)(lds + dst[i]) = pf[i];
    __syncthreads();
    const int i16 = lane & 15, tq = i16 >> 2, tp = i16 & 3, g16 = (lane >> 4) & 1;
    const int troff = (4 * h + tq) * VST + (16 * g16 + 4 * tp) * 2;
    for (int j = 0; j < nsteps; ++j) {
        const bool more = (j + 1 < nsteps);
        if (more) {
#pragma unroll
            for (int i = 0; i < 4; ++i) pf[i] = *(const u32x4*)(src[i] + (size_t)(j + 1) * 64 * AINW);
        }
        const LAS unsigned char* base = lds + (j & 1) * AT_STAGE;
        const LAS unsigned char* Kb = base + (mp ? AT_K2 : AT_K1);
        const LAS unsigned char* Vb = base + AT_V;
        f32x16 S[2];
        const float negm = -mrun;
#pragma unroll
        for (int kt = 0; kt < 2; ++kt) {
#pragma unroll
            for (int i = 0; i < 16; ++i) S[kt][i] = negm;
#pragma unroll
            for (int s = 0; s < 4; ++s) { const bf16x8 kf = *(const LAS bf16x8*)(Kb + (32 * kt + r) * KST + (16 * s + 8 * h) * 2); S[kt] = MFMA32(kf, qf[s], S[kt]); } }
        const int qidx = q0 + 32 * qg + r, kbase = 64 * j;
        if (kbase + 63 > q0 + 32 * qg) {
#pragma unroll
            for (int kt = 0; kt < 2; ++kt)
#pragma unroll
                for (int i = 0; i < 16; ++i) if (kbase + 32 * kt + crow(i, h) > qidx) S[kt][i] = -1e30f;
        }
        float mx = S[0][0];
#pragma unroll
        for (int kt = 0; kt < 2; ++kt)
#pragma unroll
            for (int i = 0; i < 16; ++i) mx = fmaxf(mx, S[kt][i]);
        mx = fmaxf(mx, __shfl_xor(mx, 32));
        if (j == 0 || __builtin_amdgcn_ballot_w64(mx > 8.0f) != 0ull) {
            const float d = (j == 0) ? mx : fmaxf(mx, 0.f);
            mrun += d;
            if (j != 0) { const float alpha = fexp2(-d); lrun *= alpha;
#pragma unroll
                for (int vt = 0; vt < 4; ++vt) O[vt] = O[vt] * alpha; }
#pragma unroll
            for (int kt = 0; kt < 2; ++kt)
#pragma unroll
                for (int i = 0; i < 16; ++i) S[kt][i] -= d;
        }
        float ls = 0.f;
#pragma unroll
        for (int kt = 0; kt < 2; ++kt)
#pragma unroll
            for (int i = 0; i < 16; ++i) { const float pv = fexp2(S[kt][i]); S[kt][i] = pv; ls += pv; }
        lrun += ls;
#pragma unroll
        for (int kt = 0; kt < 2; ++kt)
#pragma unroll
            for (int s2 = 0; s2 < 2; ++s2) {
                const bf16x8 pfr = pack8(S[kt], s2);
                const LAS unsigned char* vrow = Vb + (32 * kt + 16 * s2) * VST + troff;
#pragma unroll
                for (int vt = 0; vt < 4; ++vt) { const bf16x8 vf = tr2(vrow + vt * 64, vrow + 8 * VST + vt * 64); O[vt] = MFMA32(vf, pfr, O[vt]); }
            }
        if (more) {
            LAS unsigned char* nb = lds + ((j + 1) & 1) * AT_STAGE;
#pragma unroll
            for (int i = 0; i < 4; ++i) *(LAS u32x4*)(nb + dst[i]) = pf[i];
        }
        __syncthreads();
    }
    lrun += __shfl_xor(lrun, 32);
    const float inv = frcp(lrun);
    LAS float* ex = (LAS float*)lds;
    if (mp == 1) {
        const float sc = inv * lam;
#pragma unroll
        for (int vt = 0; vt < 4; ++vt)
#pragma unroll
            for (int i = 0; i < 16; ++i) ex[(qg * 128 + 32 * vt + crow(i, h)) * 32 + r] = O[vt][i] * sc;
    }
    __syncthreads();
    if (mp == 0) {
        float sq = 0.f;
#pragma unroll
        for (int vt = 0; vt < 4; ++vt)
#pragma unroll
            for (int i = 0; i < 16; ++i) { const float o = O[vt][i] * inv - ex[(qg * 128 + 32 * vt + crow(i, h)) * 32 + r]; O[vt][i] = o; sq += o * o; }
        sq += __shfl_xor(sq, 32);
        const float rn = __builtin_amdgcn_rsqf(sq * (1.0f / 128.0f) + 1e-5f) * 0.8f;
        bf16_t* op = mixed + (rowb + q0 + 32 * qg + r) * DM + hd * 128;
#pragma unroll
        for (int vt = 0; vt < 4; ++vt)
#pragma unroll
            for (int gq = 0; gq < 4; ++gq) { const int v0 = 32 * vt + 8 * gq + 4 * h; const f32x4 wv = *(const f32x4*)(subln + v0);
                u32x2 o; o[0] = pk2(O[vt][4 * gq] * rn * wv[0], O[vt][4 * gq + 1] * rn * wv[1]); o[1] = pk2(O[vt][4 * gq + 2] * rn * wv[2], O[vt][4 * gq + 3] * rn * wv[3]);
                *(u32x2*)(op + v0) = o; }
    }
    __syncthreads();
}

constexpr int SB_K = 0, SB_V = 64 * KST, SB_STAGE = 64 * KST + 64 * VST64;
DI void sb_tile(const LAS unsigned char* base, int kbase, int qidx, const bf16x8 (&qf)[4], f32x16 (&O)[2], float& carry, int r, int h, int troff) {
#pragma unroll
    for (int kt = 1; kt >= 0; --kt) {
        f32x16 S = zero16();
#pragma unroll
        for (int s = 0; s < 4; ++s) { const bf16x8 kf = *(const LAS bf16x8*)(base + SB_K + (32 * kt + r) * KST + (16 * s + 8 * h) * 2); S = MFMA32(kf, qf[s], S); }
        float T[4], sfx[16];
#pragma unroll
        for (int gq = 0; gq < 4; ++gq) {
            float run = 1.0f;
#pragma unroll
            for (int jj = 3; jj >= 0; --jj) {
                const int i = 4 * gq + jj; const bool valid = (kbase + 32 * kt + crow(i, h)) < qidx;
                const float zz = fmaxf(S[i], -60.0f); const float e = fexp2(-LOG2E * zz); const float sg = frcp(1.0f + e);
                const float keep = valid ? e * sg : 1.0f;
                S[i] = valid ? sg : 0.0f; sfx[i] = run; run *= keep;
            }
            T[gq] = run;
        }
        float To[4];
#pragma unroll
        for (int gq = 0; gq < 4; ++gq) To[gq] = __shfl_xor(T[gq], 32);
        float E[4]; float acc_hi = 1.0f;
#pragma unroll
        for (int gq = 3; gq >= 0; --gq) { const float above_same = acc_hi; E[gq] = (h == 0) ? above_same * To[gq] : above_same; acc_hi = acc_hi * T[gq] * To[gq]; }
#pragma unroll
        for (int i = 0; i < 16; ++i) S[i] = S[i] * carry * E[i >> 2] * sfx[i];
        carry *= acc_hi;
#pragma unroll
        for (int s2 = 0; s2 < 2; ++s2) {
            const bf16x8 pfr = pack8(S, s2);
            const LAS unsigned char* vrow = base + SB_V + (32 * kt + 16 * s2) * VST64 + troff;
#pragma unroll
            for (int vt = 0; vt < 2; ++vt) { const bf16x8 vf = tr2(vrow + vt * 64, vrow + 8 * VST64 + vt * 64); O[vt] = MFMA32(vf, pfr, O[vt]); }
        }
    }
}
DI void sb_block(LAS unsigned char* lds, const bf16_t* proj, bf16_t* mixed, int b, int hs, int qb) {
    const int tid = otid(), w = __builtin_amdgcn_readfirstlane(tid >> 6), lane = tid & 63, r = lane & 31, h = lane >> 5;
    const int q0 = qb * 256; const size_t rowb = (size_t)b * SEQ;
    const int qidx = q0 + 32 * w + r;
    bf16x8 qf[4];
    { const bf16_t* qp = proj + (rowb + qidx) * AINW + 1536 + hs * 64 + 8 * h;
#pragma unroll
      for (int s = 0; s < 4; ++s) qf[s] = *(const bf16x8*)(qp + 16 * s); }
    f32x16 O[2]; O[0] = zero16(); O[1] = zero16();
    float carry = 1.0f;
    const int jmax = 4 * qb + 3;
    const int srow = tid >> 3, sc8 = tid & 7;
    const bf16_t* srcK = proj + (rowb + srow) * AINW + 2048 + hs * 64 + sc8 * 8;
    const bf16_t* srcV = proj + (rowb + srow) * AINW + 2560 + hs * 64 + sc8 * 8;
    const int dstK = SB_K + srow * KST + sc8 * 16, dstV = SB_V + srow * VST64 + sc8 * 16;
    constexpr int NPRE = 6;
    {
        u32x4 pk_[NPRE], pv_[NPRE];
#pragma unroll
        for (int s = 0; s < NPRE; ++s) { const int jj = (jmax - s) > 0 ? (jmax - s) : 0; pk_[s] = *(const u32x4*)(srcK + (size_t)jj * 64 * AINW); pv_[s] = *(const u32x4*)(srcV + (size_t)jj * 64 * AINW); }
#pragma unroll
        for (int s = 0; s < NPRE; ++s) { *(LAS u32x4*)(lds + s * SB_STAGE + dstK) = pk_[s]; *(LAS u32x4*)(lds + s * SB_STAGE + dstV) = pv_[s]; }
    }
    __syncthreads();
    const int i16 = lane & 15, tq = i16 >> 2, tp = i16 & 3, g16 = (lane >> 4) & 1;
    const int troff = (4 * h + tq) * VST64 + (16 * g16 + 4 * tp) * 2;
    bool wdone = false;
    int j = (q0 + 32 * w + 31) >> 6;
    for (; j >= 0 && j > jmax - NPRE; --j) {
        sb_tile(lds + (jmax - j) * SB_STAGE, 64 * j, qidx, qf, O, carry, r, h, troff);
        if (__builtin_amdgcn_ballot_w64(carry >= 1e-12f) == 0ull) { wdone = true; break; }
    }
    if (j < 0) wdone = true;
    for (int jj = jmax - NPRE, it = 0; ; --jj, ++it) {
        LAS int* flg = (LAS int*)(lds + NPRE * SB_STAGE) + (it & 1) * 8;
        if (lane == 0) flg[w] = wdone ? 1 : 0;
        __syncthreads();
        int all = 1;
#pragma unroll
        for (int ww = 0; ww < 8; ++ww) all &= flg[ww];
        if (all || jj < 0) break;
        const u32x4 a_ = *(const u32x4*)(srcK + (size_t)jj * 64 * AINW), b_ = *(const u32x4*)(srcV + (size_t)jj * 64 * AINW);
        *(LAS u32x4*)(lds + dstK) = a_; *(LAS u32x4*)(lds + dstV) = b_;
        __syncthreads();
        if (!wdone) { sb_tile(lds, 64 * jj, qidx, qf, O, carry, r, h, troff); if (__builtin_amdgcn_ballot_w64(carry >= 1e-12f) == 0ull || jj == 0) wdone = true; }
    }
    bf16_t* op = mixed + (rowb + qidx) * DM + 512 + hs * 64;
#pragma unroll
    for (int vt = 0; vt < 2; ++vt)
#pragma unroll
        for (int gq = 0; gq < 4; ++gq) { const int v0 = 32 * vt + 8 * gq + 4 * h;
            u32x2 o; o[0] = pk2(O[vt][4 * gq], O[vt][4 * gq + 1]); o[1] = pk2(O[vt][4 * gq + 2], O[vt][4 * gq + 3]); *(u32x2*)(op + v0) = o; }
    __syncthreads();
}
DI void attn_phase(LAS unsigned char* lds, const Params& p) {
    const bf16_t* proj = (const bf16_t*)(p.ws + O_PROJ); bf16_t* mixed = (bf16_t*)(p.ws + O_MIXED);
    const float lam = *(const float*)(p.ws + O_LAM);
    for (int it0 = blockIdx.x; it0 < 256; it0 += gridDim.x) {
        const int it = (it0 & 7) * 32 + (it0 >> 3);
        const int b = it >> 7, hd = (it >> 5) & 3, pr = it & 31;
        diff_tile(lds, proj, mixed, p.in[7], lam, b, hd, 63 - pr);
        diff_tile(lds, proj, mixed, p.in[7], lam, b, hd, pr);
    }
    for (int it0 = blockIdx.x; it0 < 512; it0 += gridDim.x) {
        const int it = (it0 & 7) * 64 + (it0 >> 3);
        const int b = it >> 8, hs = (it >> 5) & 7, qb = it & 31;
        sb_block(lds, proj, mixed, b, hs, qb);
    }
}
constexpr int SXS = 528, SXS2 = 576, SBS = 272, SBS2 = 320;
constexpr int L_SX = 0, L_SB = 128 * SXS2, L_SC = L_SB + 128 * SBS, L_SDT = L_SC + 128 * SBS, L_SAC = L_SDT + 2048, L_SSQ = L_SAC + 2048;
static_assert(L_SSQ + 4096 <= LDS_BYTES, "lds");

DI void ssd_dt_acum(LAS unsigned char* lds, const float* DT, const float* dt_bias, const float* a_log, size_t t0, int g) {
    LAS float* sdt = (LAS float*)(lds + L_SDT); LAS float* sac = (LAS float*)(lds + L_SAC);
    const int tid = otid(), hh = tid >> 7, l = tid & 127, head = 4 * g + hh, w = tid >> 6, lane = tid & 63;
    const float raw = DT[(t0 + l) * 32 + head] + dt_bias[head];
    const float dt = fmaxf(raw, 0.f) + __logf(1.0f + __expf(-fabsf(raw)));
    sdt[hh * 128 + l] = dt; sac[hh * 128 + l] = -dt * __expf(a_log[head]);
    __syncthreads();
    if (w < 4) {
        const float v0 = sac[w * 128 + 2 * lane], v1 = sac[w * 128 + 2 * lane + 1]; float s = v0 + v1;
#pragma unroll
        for (int off = 1; off < 64; off <<= 1) { const float t = __shfl_up(s, off); if (lane >= off) s += t; }
        const float ex = s - (v0 + v1);
        sac[w * 128 + 2 * lane] = ex + v0; sac[w * 128 + 2 * lane + 1] = ex + v0 + v1;
    }
    __syncthreads();
}
template <int NT, class F> DI void conv_strip(const bf16_t* src, int nzero, const float* cw, const float* cb, int ch, F&& emit) {
    f32x4 wlo[4], whi[4];
#pragma unroll
    for (int k = 0; k < 4; ++k) { wlo[k] = *(const f32x4*)(cw + k * XBCW + ch); whi[k] = *(const f32x4*)(cw + k * XBCW + ch + 4); }
    const f32x4 blo = *(const f32x4*)(cb + ch), bhi = *(const f32x4*)(cb + ch + 4);
    u32x4 raw[NT + 3];
#pragma unroll
    for (int i = 0; i < NT + 3; ++i) { const int ii = (i < nzero) ? nzero : i; raw[i] = *(const u32x4*)(src + (ptrdiff_t)(ii - 3) * XBCW); if (i < nzero) raw[i] = (u32x4){0u, 0u, 0u, 0u}; }
#pragma unroll
    for (int t = 0; t < NT; ++t) {
        float o[8];
#pragma unroll
        for (int e = 0; e < 8; ++e) {
            float a = (e < 4) ? blo[e & 3] : bhi[e & 3];
#pragma unroll
            for (int k = 0; k < 4; ++k) { const unsigned d = raw[t + k][e >> 1]; const float xv = (e & 1) ? bfhi(d) : bflo(d); a += ((e < 4) ? wlo[k][e & 3] : whi[k][e & 3]) * xv; }
            o[e] = fsilu(a);
        }
        emit(t, o);
    }
}
DI u32x4 pack8f(const float* o) { u32x4 r; r[0] = pk2(o[0], o[1]); r[1] = pk2(o[2], o[3]); r[2] = pk2(o[4], o[5]); r[3] = pk2(o[6], o[7]); return r; }

template <bool XW, bool WITH_C> DI void ssd_stage(LAS unsigned char* lds, const bf16_t* xbc, const float* cw, const float* cb, size_t t0, int c, int g) {
    const int tid = otid();
    LAS float* sdt = (LAS float*)(lds + L_SDT); LAS float* sac = (LAS float*)(lds + L_SAC);
    {
        const int c8 = tid & 31, tg = tid >> 5, l0 = 8 * tg, ch = 256 * g + 8 * c8, hh = c8 >> 3;
        const int nzero = (c == 0) ? (3 - l0 > 0 ? 3 - l0 : 0) : 0;
        const float alast = sac[hh * 128 + 127];
        conv_strip<8>(xbc + (t0 + l0) * XBCW + ch, nzero, cw, cb, ch, [&](int t, float* o) {
            if (XW) { const float wgt = sdt[hh * 128 + l0 + t] * __expf(alast - sac[hh * 128 + l0 + t]);
#pragma unroll
                for (int e = 0; e < 8; ++e) o[e] *= wgt; }
            *(LAS u32x4*)(lds + L_SX + (l0 + t) * (XW ? SXS2 : SXS) + c8 * 16) = pack8f(o); });
    }
    {
        const int c8 = tid & 15, tg = tid >> 4, l0 = 4 * tg;
        const int nzero = (c == 0) ? (3 - l0 > 0 ? 3 - l0 : 0) : 0;
        const int chb = DIN + 128 * g + 8 * c8;
        conv_strip<4>(xbc + (t0 + l0) * XBCW + chb, nzero, cw, cb, chb, [&](int t, float* o) { *(LAS u32x4*)(lds + L_SB + (l0 + t) * (XW ? SBS2 : SBS) + c8 * 16) = pack8f(o); });
        if (WITH_C) { const int chc = DIN + 1024 + 128 * g + 8 * c8;
            conv_strip<4>(xbc + (t0 + l0) * XBCW + chc, nzero, cw, cb, chc, [&](int t, float* o) { *(LAS u32x4*)(lds + L_SC + (l0 + t) * SBS + c8 * 16) = pack8f(o); }); }
    }
}
DI bf16_t* st_ptr(unsigned char* ws, int b) { return (bf16_t*)(ws + (b ? O_ST1 : O_ST0)); }

DI void ssd_states_phase(LAS unsigned char* lds, const Params& p) {
    const int tid = otid(), w = __builtin_amdgcn_readfirstlane(tid >> 6), lane = tid & 63, r = lane & 31, h = lane >> 5, hh = w >> 1, ph = w & 1;
    const bf16_t* xbc = (const bf16_t*)(p.ws + O_XBC); const float* DT = (const float*)(p.ws + O_DT); float* cdec = (float*)(p.ws + O_CDEC);
    const int i16 = lane & 15, tq = i16 >> 2, tp = i16 & 3, g16 = (lane >> 4) & 1;
    for (int it = blockIdx.x; it < 1024; it += gridDim.x) {
        const int b = it >> 9, c = (it >> 3) & 63, g = it & 7; const size_t t0 = (size_t)b * SEQ + (size_t)c * 128;
        ssd_dt_acum(lds, DT, p.in[13], p.in[14], t0, g);
        ssd_stage<true, false>(lds, xbc, p.in[11], p.in[12], t0, c, g);
        __syncthreads();
        f32x16 acc[4];
#pragma unroll
        for (int i = 0; i < 4; ++i) acc[i] = zero16();
        const LAS unsigned char* xa = lds + L_SX + (8 * h + tq) * SXS2 + (64 * hh + 32 * ph + 16 * g16 + 4 * tp) * 2;
        const LAS unsigned char* ba = lds + L_SB + (8 * h + tq) * SBS2 + (16 * g16 + 4 * tp) * 2;
#pragma unroll
        for (int s = 0; s < 8; ++s) {
            const bf16x8 af = tr2(xa + 16 * s * SXS2, xa + (16 * s + 4) * SXS2);
#pragma unroll
            for (int nt = 0; nt < 4; ++nt) { const bf16x8 bfr = tr2(ba + 16 * s * SBS2 + nt * 64, ba + (16 * s + 4) * SBS2 + nt * 64); acc[nt] = MFMA32(af, bfr, acc[nt]); }
        }
        bf16_t* st = st_ptr(p.ws, b) + ((size_t)(c * 32 + 4 * g + hh) * 64 + 32 * ph) * 128;
#pragma unroll
        for (int nt = 0; nt < 4; ++nt)
#pragma unroll
            for (int i = 0; i < 16; ++i) st[(size_t)crow(i, h) * 128 + 32 * nt + r] = (bf16_t)(pk2(acc[nt][i], 0.f) & 0xffffu);
        if (tid < 4) cdec[(b * 64 + c) * 32 + 4 * g + tid] = __expf(((LAS float*)(lds + L_SAC))[tid * 128 + 127]);
        __syncthreads();
    }
}
DI void ssd_scan_phase(const Params& p, const bool dry) {
    const float* cdec = (const float*)(p.ws + O_CDEC);
    for (int e = blockIdx.x * 512 + threadIdx.x; e < 2 * 32 * 64 * 32; e += gridDim.x * 512) {
        const int b = e >> 16, rem = e & 65535, head = rem >> 11;
        bf16_t* st = st_ptr(p.ws, b) + (size_t)rem * 4;
        float carry[4] = {0.f, 0.f, 0.f, 0.f};
        for (int c0 = 0; c0 < 64; c0 += 8) {
            u32x2 v[8]; float dc[8];
#pragma unroll
            for (int u = 0; u < 8; ++u) { v[u] = *(const u32x2*)(st + (size_t)(c0 + u) * 262144); dc[u] = cdec[(b * 64 + c0 + u) * 32 + head]; }
#pragma unroll
            for (int u = 0; u < 8; ++u) {
                u32x2 o; o[0] = pk2(carry[0], carry[1]); o[1] = pk2(carry[2], carry[3]); if (!dry) *(u32x2*)(st + (size_t)(c0 + u) * 262144) = o;
                carry[0] = carry[0] * dc[u] + bflo(v[u][0]); carry[1] = carry[1] * dc[u] + bfhi(v[u][0]); carry[2] = carry[2] * dc[u] + bflo(v[u][1]); carry[3] = carry[3] * dc[u] + bfhi(v[u][1]);
            }
        }
    }
}
DI void ssd_out_phase(LAS unsigned char* lds, const Params& p, const bool dry) {
    const int tid = otid(), w = __builtin_amdgcn_readfirstlane(tid >> 6), lane = tid & 63, r = lane & 31, h = lane >> 5, hh = w >> 1, ph = w & 1;
    const bf16_t* xbc = (const bf16_t*)(p.ws + O_XBC); const float* DT = (const float*)(p.ws + O_DT); bf16_t* zy = (bf16_t*)p.out;
    LAS float* sdt = (LAS float*)(lds + L_SDT); LAS float* sac = (LAS float*)(lds + L_SAC); LAS float* ssq = (LAS float*)(lds + L_SSQ);
    const int i16 = lane & 15, tq = i16 >> 2, tp = i16 & 3, g16 = (lane >> 4) & 1;
    for (int it = blockIdx.x; it < 1024; it += gridDim.x) {
        const int b = it >> 9, c = (it >> 3) & 63, g = it & 7, head = 4 * g + hh; const size_t t0 = (size_t)b * SEQ + (size_t)c * 128;
        ssd_dt_acum(lds, DT, p.in[13], p.in[14], t0, g);
        ssd_stage<false, true>(lds, xbc, p.in[11], p.in[12], t0, c, g);
        bf16x8 pvf[8];
        { const bf16_t* pp = st_ptr(p.ws, b) + ((size_t)(c * 32 + head) * 64 + 32 * ph + r) * 128 + 8 * h;
#pragma unroll
          for (int s = 0; s < 8; ++s) pvf[s] = *(const bf16x8*)(pp + 16 * s); }
        __syncthreads();
        f32x16 Y[4];
        const LAS unsigned char* xa = lds + L_SX + (4 * h + tq) * SXS + (64 * hh + 32 * ph + 16 * g16 + 4 * tp) * 2;
#pragma unroll
        for (int lt = 0; lt < 4; ++lt) {
            __builtin_amdgcn_sched_barrier(0);
            f32x16 y = zero16();
#pragma unroll
            for (int s = 0; s < 8; ++s) { const bf16x8 cfs = *(const LAS bf16x8*)(lds + L_SC + (32 * lt + r) * SBS + (16 * s + 8 * h) * 2); y = MFMA32(pvf[s], cfs, y); }
            Y[lt] = y * __expf(sac[hh * 128 + 32 * lt + r]);
        }
#pragma unroll
        for (int lt = 0; lt < 4; ++lt) {
            __builtin_amdgcn_sched_barrier(0);
            bf16x8 cf[8];
#pragma unroll
            for (int s = 0; s < 8; ++s) cf[s] = *(const LAS bf16x8*)(lds + L_SC + (32 * lt + r) * SBS + (16 * s + 8 * h) * 2);
            const float al = sac[hh * 128 + 32 * lt + r];
#pragma unroll
            for (int mt = 0; mt < 4; ++mt) {
                if (mt <= lt) {
                    __builtin_amdgcn_sched_barrier(0);
                    f32x16 X = zero16();
#pragma unroll
                    for (int s = 0; s < 8; ++s) { const bf16x8 bfr = *(const LAS bf16x8*)(lds + L_SB + (32 * mt + r) * SBS + (16 * s + 8 * h) * 2); X = MFMA32(bfr, cf[s], X); }
#pragma unroll
                    for (int gq = 0; gq < 4; ++gq) {
                        const f32x4 am = *(const LAS f32x4*)(sac + hh * 128 + 32 * mt + 8 * gq + 4 * h), dm = *(const LAS f32x4*)(sdt + hh * 128 + 32 * mt + 8 * gq + 4 * h);
#pragma unroll
                        for (int jj = 0; jj < 4; ++jj) { const int mrow = 32 * mt + 8 * gq + 4 * h + jj; const bool ok = (32 * lt + r) >= mrow;
                            const float dec = ok ? __expf(fminf(al - am[jj], 0.f)) * dm[jj] : 0.f; X[4 * gq + jj] *= dec; }
                    }
#pragma unroll
                    for (int s2 = 0; s2 < 2; ++s2) { const bf16x8 xs = pack8(X, s2);
                        const LAS unsigned char* xr = xa + (32 * mt + 16 * s2) * SXS; const bf16x8 xf = tr2(xr, xr + 8 * SXS); Y[lt] = MFMA32(xf, xs, Y[lt]); }
                }
            }
        }
        __builtin_amdgcn_sched_barrier(0);
        const float Dh = p.in[15][head];
        float sq[4];
#pragma unroll
        for (int lt = 0; lt < 4; ++lt) {
            const int l = 32 * lt + r; sq[lt] = 0.f;
#pragma unroll
            for (int gq = 0; gq < 4; ++gq) {
                const int chl = 64 * hh + 32 * ph + 8 * gq + 4 * h;
                const u32x2 xv = *(const LAS u32x2*)(lds + L_SX + l * SXS + chl * 2);
                const u32x2 zv = *(const u32x2*)(zy + (t0 + l) * DIN + 256 * g + chl);
                const float xf4[4] = {bflo(xv[0]), bfhi(xv[0]), bflo(xv[1]), bfhi(xv[1])}, zf4[4] = {bflo(zv[0]), bfhi(zv[0]), bflo(zv[1]), bfhi(zv[1])};
#pragma unroll
                for (int jj = 0; jj < 4; ++jj) { const float yv = (Y[lt][4 * gq + jj] + Dh * xf4[jj]) * fsilu(zf4[jj]); Y[lt][4 * gq + jj] = yv; sq[lt] += yv * yv; }
            }
            sq[lt] += __shfl_xor(sq[lt], 32);
            if (h == 0) ssq[w * 128 + l] = sq[lt];
        }
        __syncthreads();
#pragma unroll
        for (int lt = 0; lt < 4; ++lt) {
            const int l = 32 * lt + r; float tot = 0.f;
#pragma unroll
            for (int ww = 0; ww < 8; ++ww) tot += ssq[ww * 128 + l];
            const float rn = __builtin_amdgcn_rsqf(tot * (1.0f / 256.0f) + 1e-5f);
#pragma unroll
            for (int gq = 0; gq < 4; ++gq) {
                const int chl = 64 * hh + 32 * ph + 8 * gq + 4 * h; const f32x4 gw = *(const f32x4*)(p.in[16] + 256 * g + chl);
                u32x2 o; o[0] = pk2(Y[lt][4 * gq] * rn * gw[0], Y[lt][4 * gq + 1] * rn * gw[1]); o[1] = pk2(Y[lt][4 * gq + 2] * rn * gw[2], Y[lt][4 * gq + 3] * rn * gw[3]);
                if (!dry) *(u32x2*)(zy + (t0 + l) * DIN + 256 * g + chl) = o;
            }
        }
        __syncthreads();
    }
}
DI void dt_proj(LAS unsigned char* lds, const Params& p) {
    const int tid = otid(), w = __builtin_amdgcn_readfirstlane(tid >> 6), lane = tid & 63, r = lane & 31, h = lane >> 5, rt = w & 1, kq = w >> 1;
    const bf16_t* hb = (const bf16_t*)(p.ws + O_HB); const bf16_t* wt = (const bf16_t*)(p.ws + W_SIN) + (size_t)6144 * DM;
    const float* ss = (const float*)(p.ws + O_SS) + 2 * MT; float* dt = (float*)(p.ws + O_DT);
    LAS float* part = (LAS float*)lds;
    for (int rb = blockIdx.x; rb < MT / 64; rb += gridDim.x) {
        const bf16_t* ap = hb + (size_t)(rb * 64 + rt * 32 + r) * DM + kq * 256 + 8 * h;
        const bf16_t* bp = wt + (size_t)r * DM + kq * 256 + 8 * h;
        bf16x8 af[16], bfr[16];
#pragma unroll
        for (int s = 0; s < 16; ++s) { af[s] = *(const bf16x8*)(ap + 16 * s); bfr[s] = *(const bf16x8*)(bp + 16 * s); }
        f32x16 acc = zero16();
#pragma unroll
        for (int s = 0; s < 16; ++s) acc = MFMA32(af[s], bfr[s], acc);
#pragma unroll
        for (int i = 0; i < 16; ++i) part[((kq * 2 + rt) * 32 + crow(i, h)) * 32 + r] = acc[i];
        __syncthreads();
#pragma unroll
        for (int q = 0; q < 4; ++q) {
            const int o = tid + 512 * q, row = o >> 5, col = o & 31;
            float v = 0.f;
#pragma unroll
            for (int k = 0; k < 4; ++k) v += part[((k * 2 + (row >> 5)) * 32 + (row & 31)) * 32 + col];
            const int grow = rb * 64 + row;
            dt[(size_t)grow * 32 + col] = v * __builtin_amdgcn_rsqf(ss[grow] * (1.0f / 1024.0f) + 1e-6f);
        }
        __syncthreads();
    }
}
template <class Epi> DI void run_gemm(LAS unsigned char* lds, const bf16_t* A, const bf16_t* Bt, int N, int K, const Epi& E) {
    pg8::Gemm g; g.A = A; g.Bt = Bt; g.M = MT; g.N = N; g.K = K;
    pg8::StaticOrder S; S.init(MT, N, (int)gridDim.x, (int)blockIdx.x);
    pg8::gemm_phase<Epi, pg8::StaticOrder, !Epi::AFTER_DRAIN, true>((PG8_LAS unsigned char*)lds, g, S, E);
}
#if defined(DRY_S3) || defined(DRY_S4)
#define DRYV (p.ws == nullptr)
#else
#define DRYV false
#endif
__global__ void __launch_bounds__(512, 2) fwd_megakernel(Params p) {
    extern __shared__ __attribute__((aligned(16))) unsigned char shm[];
    LAS unsigned char* lds = (LAS unsigned char*)shm;
    cg::grid_group grid = cg::this_grid();
    if (threadIdx.x < 4) ((LAS unsigned*)(lds + LDS_BYTES - 16))[threadIdx.x] = 0u;
    __syncthreads();
    const XcdBarrier xbar = xcd_barrier_post((unsigned*)(p.ws + O_BAR), (volatile LAS unsigned*)(lds + LDS_BYTES - 16));
#define GBAR() xcd_barrier(xbar)
    unsigned char* ws = p.ws;
    bf16_t* hb = (bf16_t*)(ws + O_HB); float* ss = (float*)(ws + O_SS);
    phase0(lds, p);
#ifdef DUP_P0
    GBAR(); phase0(lds, p);
#endif
    if (gridDim.x == 0x7fffffffu) grid.sync();
    GBAR();
    { EpiAttnIn E; E.O = (bf16_t*)(ws + O_PROJ); E.ss = ss; E.tab = (const f32x4*)(ws + O_ROPE); run_gemm(lds, hb, (const bf16_t*)(ws + W_AIN), AINW, DM, E); }
    GBAR();
    attn_phase(lds, p);
#ifdef DUP_ATTN
    GBAR(); attn_phase(lds, p);
#endif
    GBAR();
    { EpiRes<true, false> E; E.xres = p.in[0]; E.hb = hb; E.outf = nullptr; E.ssn = ss + MT; run_gemm(lds, (const bf16_t*)(ws + O_MIXED), (const bf16_t*)(ws + W_AOUT), DM, DM, E); }
    GBAR();
    { EpiGU E; E.act = (bf16_t*)(ws + O_ACT); E.ss = ss + MT; run_gemm(lds, hb, (const bf16_t*)(ws + W_GU0), 2 * DFF, DM, E); }
    GBAR();
    { EpiRes<false, false> E; E.xres = nullptr; E.hb = hb; E.outf = nullptr; E.ssn = ss + 2 * MT; run_gemm(lds, (const bf16_t*)(ws + O_ACT), (const bf16_t*)(ws + W_DN0), DM, DFF, E); }
    GBAR();
    { EpiSsdIn E; E.z = (bf16_t*)p.out; E.xbc = (bf16_t*)(ws + O_XBC); E.dt = (float*)(ws + O_DT); E.ss = ss + 2 * MT; dt_proj(lds, p); run_gemm(lds, hb, (const bf16_t*)(ws + W_SIN), 6144, DM, E); }
    GBAR();
    ssd_states_phase(lds, p);
#ifdef DUP_S2
    GBAR(); ssd_states_phase(lds, p);
#endif
    GBAR();
#ifdef DRY_S3
    ssd_scan_phase(p, p.ws != nullptr); GBAR();
#endif
    ssd_scan_phase(p, DRYV);
    GBAR();
#ifdef DRY_S4
    ssd_out_phase(lds, p, p.ws != nullptr); GBAR();
#endif
    ssd_out_phase(lds, p, DRYV);
    GBAR();
    { EpiRes<false, false> E; E.xres = nullptr; E.hb = hb; E.outf = nullptr; E.ssn = ss + 3 * MT; run_gemm(lds, (const bf16_t*)p.out, (const bf16_t*)(ws + W_SOUT), DM, DIN, E); }
    GBAR();
    { EpiGU E; E.act = (bf16_t*)(ws + O_ACT); E.ss = ss + 3 * MT; run_gemm(lds, hb, (const bf16_t*)(ws + W_GU1), 2 * DFF, DM, E); }
    GBAR();
    if (gridDim.x == 256) {
        EpiFinal E; E.hb = hb; E.outf = p.out; E.ssn = ss + 4 * MT; E.cnt = (unsigned*)(ws + O_BAR) + XCD_BAR_WORDS; E.fw = p.in[22];
        run_gemm(lds, (const bf16_t*)(ws + O_ACT), (const bf16_t*)(ws + W_DN1), DM, DFF, E);
    } else {
        { EpiRes<false, true> E; E.xres = nullptr; E.hb = hb; E.outf = p.out; E.ssn = ss + 4 * MT; run_gemm(lds, (const bf16_t*)(ws + O_ACT), (const bf16_t*)(ws + W_DN1), DM, DFF, E); }
        GBAR();
        const float* ss4 = ss + 4 * MT; const f32x4* fw = (const f32x4*)p.in[22]; f32x4* o4 = (f32x4*)p.out;
        for (int i = blockIdx.x * 512 + threadIdx.x; i < MT * (DM / 4); i += gridDim.x * 512) {
            const int row = i >> 8; const float rs = __builtin_amdgcn_rsqf(ss4[row] * (1.0f / 1024.0f) + 1e-6f);
            o4[i] = o4[i] * rs * fw[i & 255];
        }
    }
}

extern "C" void kernel_launch(void* const* d_in, const int* in_sizes, int n_in, void* d_out, int out_size, void* d_ws, size_t ws_size, hipStream_t stream) {
    static int grid_blocks = 0;
    if (!grid_blocks) {
        int dev = 0, cus = 0, per_cu = 0;
        hipGetDevice(&dev);
        hipDeviceGetAttribute(&cus, hipDeviceAttributeMultiprocessorCount, dev);
        if (hipFuncSetAttribute((const void*)fwd_megakernel, hipFuncAttributeMaxDynamicSharedMemorySize, LDS_BYTES) != hipSuccess) fprintf(stderr, "hipFuncSetAttribute failed\n");
        if (hipOccupancyMaxActiveBlocksPerMultiprocessor(&per_cu, (const void*)fwd_megakernel, 512, LDS_BYTES) != hipSuccess || per_cu < 1) { fprintf(stderr, "occupancy query: %d\n", per_cu); per_cu = 1; }
        (void)hipGetLastError();
        grid_blocks = cus * per_cu;
        if (ws_size < 268435456ull || n_in != 23) fprintf(stderr, "unexpected ws_size %zu / n_in %d\n", ws_size, n_in);
    }
    if (hipMemsetAsync((char*)d_ws + O_BAR, 0, 20480, stream) != hipSuccess) fprintf(stderr, "memset failed\n");
    Params p{};
    for (int i = 0; i < 23; ++i) p.in[i] = (const float*)d_in[i];
    p.out = (float*)d_out; p.ws = (unsigned char*)d_ws;
    void* args[] = {&p};
    hipError_t e = hipLaunchCooperativeKernel((const void*)fwd_megakernel, dim3(grid_blocks), dim3(512), args, LDS_BYTES, stream);
    if (e != hipSuccess) fprintf(stderr, "cooperative launch failed: %s (grid %d)\n", hipGetErrorString(e), grid_blocks);
}
#ifdef PHASE_TEST
__global__ void __launch_bounds__(512, 2) t_phase0(Params p) { extern __shared__ __attribute__((aligned(16))) unsigned char shm[]; phase0((LAS unsigned char*)shm, p); }
__global__ void __launch_bounds__(512, 2) t_attn_diff(Params p) { extern __shared__ __attribute__((aligned(16))) unsigned char shm[]; diff_tile((LAS unsigned char*)shm, (const bf16_t*)(p.ws + O_PROJ), (bf16_t*)(p.ws + O_MIXED), p.in[7], 0.3f, blockIdx.x & 1, blockIdx.y, blockIdx.z); }
__global__ void __launch_bounds__(512, 2) t_attn_sb(Params p) { extern __shared__ __attribute__((aligned(16))) unsigned char shm[]; sb_block((LAS unsigned char*)shm, (const bf16_t*)(p.ws + O_PROJ), (bf16_t*)(p.ws + O_MIXED), blockIdx.x & 1, blockIdx.y, blockIdx.z); }
__global__ void __launch_bounds__(512, 2) t_ssd_states(Params p) { extern __shared__ __attribute__((aligned(16))) unsigned char shm[]; ssd_states_phase((LAS unsigned char*)shm, p); }
__global__ void __launch_bounds__(512, 2) t_ssd_scan(Params p) { ssd_scan_phase(p, false); }
__global__ void __launch_bounds__(512, 2) t_ssd_out(Params p) { extern __shared__ __attribute__((aligned(16))) unsigned char shm[]; ssd_out_phase((LAS unsigned char*)shm, p, false); }
__global__ void __launch_bounds__(512, 2) t_gemm_ain(Params p) { extern __shared__ __attribute__((aligned(16))) unsigned char shm[]; EpiAttnIn E; E.O = (bf16_t*)(p.ws + O_PROJ); E.ss = (float*)(p.ws + O_SS); E.tab = (const f32x4*)(p.ws + O_ROPE); run_gemm((LAS unsigned char*)shm, (bf16_t*)(p.ws + O_HB), (const bf16_t*)(p.ws + W_AIN), AINW, DM, E); }
__global__ void __launch_bounds__(512, 2) t_gemm_res(Params p) { extern __shared__ __attribute__((aligned(16))) unsigned char shm[]; EpiRes<false, false> E; E.xres = nullptr; E.hb = (bf16_t*)(p.ws + O_HB); E.outf = nullptr; E.ssn = (float*)(p.ws + O_SS); run_gemm((LAS unsigned char*)shm, (bf16_t*)(p.ws + O_ACT), (const bf16_t*)(p.ws + W_DN0), DM, DFF, E); }
__global__ void __launch_bounds__(512, 2) t_gemm_gu(Params p) { extern __shared__ __attribute__((aligned(16))) unsigned char shm[]; EpiGU E; E.act = (bf16_t*)(p.ws + O_ACT); E.ss = (float*)(p.ws + O_SS); run_gemm((LAS unsigned char*)shm, (bf16_t*)(p.ws + O_HB), (const bf16_t*)(p.ws + W_GU0), 2 * DFF, DM, E); }
__global__ void __launch_bounds__(512, 2) t_gemm_ssdin(Params p) { extern __shared__ __attribute__((aligned(16))) unsigned char shm[]; EpiSsdIn E; E.z = (bf16_t*)p.out; E.xbc = (bf16_t*)(p.ws + O_XBC); E.dt = (float*)(p.ws + O_DT); E.ss = (float*)(p.ws + O_SS); run_gemm((LAS unsigned char*)shm, (bf16_t*)(p.ws + O_HB), (const bf16_t*)(p.ws + W_SIN), SINWP, DM, E); }
#endif
```

```cpp
#include <hip/hip_runtime.h>
#include <hip/hip_cooperative_groups.h>
#include <cstdio>
#include <cstdint>
namespace cg = cooperative_groups;
namespace pg8 {
#define PG8_LAS __attribute__((address_space(3)))
typedef unsigned short bf16_t;
typedef short bf16x8 __attribute__((ext_vector_type(8)));
typedef float f32x4 __attribute__((ext_vector_type(4)));
typedef unsigned u32x4 __attribute__((ext_vector_type(4)));
constexpr int BM = 256, BK = 64, HALF = 128, HTB = HALF * BK * 2  , STAGE_BYTES = 8 * HTB, NXCD = 8, WGM = 8;

__host__ __device__ __forceinline__ int lds_byte(int r, int c) { const int st = (r >> 4) * 2 + (c >> 5), rr = r & 15, cc = c & 31, ob = rr * 64 + cc * 2; return st * 1024 + (ob ^ (((ob >> 9) & 1) << 5)); }
__host__ __device__ __forceinline__ void stage_rc(int b, int& R, int& C) { const int st = b / 1024, sb = b % 1024, swz = sb ^ (((sb >> 9) & 1) << 5); R = (st >> 1) * 16 + swz / 64; C = (st & 1) * 32 + (swz % 64) / 2; }
__host__ __device__ __forceinline__ int perm32(int rho) { const int n = rho >> 4, i = rho & 15; return 8 * (i >> 2) + 4 * n + (i & 3); }

struct Unit { int pm, pn; };
struct Gemm { const bf16_t* A; const bf16_t* Bt; int M, N, K; };

struct StaticOrder {
    int nM, nN, nwg, G, c;
    __host__ __device__ void init(int M, int N, int G_, int c_) { nM = M / BM; nN = N / BM; nwg = nM * nN; G = G_; c = c_; }
    __host__ __device__ bool next(int i, Unit& u) const {
        const long L = (long)i * G + c; if (L >= nwg) return false;
        int wgid = (int)L; { const int q = nwg / NXCD, r = nwg % NXCD, xcd = wgid % NXCD, off = wgid / NXCD; wgid = (xcd < r ? xcd * (q + 1) : r * (q + 1) + (xcd - r) * q) + off; }
        const int nig = WGM * nN, gid = wgid / nig, fm = gid * WGM, gsz = (nM - fm) < WGM ? (nM - fm) : WGM;
        u.pm = fm + ((wgid % nig) % gsz); u.pn = (wgid % nig) / gsz; return true;
    }
    __device__ __forceinline__ void a_ready(const Unit&) const {}
    __device__ __forceinline__ void done(const Unit&) const {}
};

template <class Epi, class Sched, bool ALIGN_EPI = false, bool SP2 = false>
__device__ __forceinline__ void gemm_phase(PG8_LAS unsigned char* lds, const Gemm g, const Sched& S, const Epi& E) {
    int tid_ = threadIdx.x; asm volatile("" : "+v"(tid_)); const int tid = tid_, wid = __builtin_amdgcn_readfirstlane(tid >> 6), lane = tid & 63, wr = wid >> 2, wc = wid & 3, fr = lane & 15, fq = lane >> 4;
    const int K = g.K, nt = K / BK;
    unsigned voffA[2], voffB[2];
#pragma unroll
    for (int i = 0; i < 2; ++i) { int R, C; stage_rc(tid * 16 + i * 8192, R, C); const int Rb = Epi::PERM ? ((R & ~31) + perm32(R & 31)) : R;
        voffA[i] = (unsigned)(R * K + C) * 2u; voffB[i] = (unsigned)(Rb * K + C) * 2u; }
    const size_t kstep = (size_t)(BK * 2);
    const size_t hstep = (size_t)HALF * K * 2;
    const size_t tstep = 2 * hstep;
    const unsigned ldsw = (unsigned)wid * 1024u;
    const int aoff = lds_byte(wr * 64 + fr, fq * 8), boff = lds_byte(wc * 32 + fr, fq * 8);
#define PG8_SA(b, h) (((b) * 2 + (h)) * HTB)
#define PG8_SB(b, h) ((4 + (b) * 2 + (h)) * HTB)
#define PG8_STAGE(bufoff, gbase, voff) do { _Pragma("unroll") for (int _i = 0; _i < 2; ++_i) \
        __builtin_amdgcn_global_load_lds((const unsigned*)((const char*)(gbase) + (voff)[_i]), (PG8_LAS unsigned*)(lds + (bufoff) + ldsw + _i * 8192), 16, 0, 0); } while (0)
#define PG8_LDA(dst, b, h) do { _Pragma("unroll") for (int m = 0; m < 4; ++m) _Pragma("unroll") for (int k = 0; k < 2; ++k) dst[m][k] = *(const PG8_LAS bf16x8*)(lds + PG8_SA(b, h) + aoff + m * 2048 + k * 1024); } while (0)
#define PG8_LDB(dst, b, h) do { _Pragma("unroll") for (int n = 0; n < 2; ++n) _Pragma("unroll") for (int k = 0; k < 2; ++k) dst[n][k] = *(const PG8_LAS bf16x8*)(lds + PG8_SB(b, h) + boff + n * 2048 + k * 1024); } while (0)
#define PG8_MMA(ai, bj, At, Bt) do { __builtin_amdgcn_s_setprio(1); _Pragma("unroll") for (int m = 0; m < 4; ++m) _Pragma("unroll") for (int n = 0; n < 2; ++n) _Pragma("unroll") for (int k = 0; k < 2; ++k) \
        acc[ai][bj][m][n] = __builtin_amdgcn_mfma_f32_16x16x32_bf16(Bt[n][k], At[m][k], acc[ai][bj][m][n], 0, 0, 0); __builtin_amdgcn_s_setprio(0); } while (0)
#define PG8_WAIT_V(n) asm volatile("s_waitcnt vmcnt(" #n ")" ::: "memory")
#define PG8_WAIT_L(n) asm volatile("s_waitcnt lgkmcnt(" #n ")" ::: "memory")
#define PG8_BAR __builtin_amdgcn_s_barrier()
#define PG8_SCHED __builtin_amdgcn_sched_barrier(0)
    Unit cur, nxt; int ui = 0;
    if (!S.next(0, cur)) return;
    f32x4 acc[2][2][4][2];
#pragma unroll
    for (int a = 0; a < 2; ++a)
#pragma unroll
        for (int b = 0; b < 2; ++b)
#pragma unroll
            for (int m = 0; m < 4; ++m)
#pragma unroll
                for (int n = 0; n < 2; ++n) acc[a][b][m][n] = (f32x4){0.f, 0.f, 0.f, 0.f};
    bf16x8 At[4][2], B0[2][2], B1[2][2];
    float epre[8]; E.pre(cur, wr, fr, epre);
    const char* cA = (const char*)g.A + (size_t)cur.pm * tstep; const char* cB = (const char*)g.Bt + (size_t)cur.pn * tstep;
    S.a_ready(cur);
    if constexpr (SP2) {
        PG8_STAGE(PG8_SB(0, 0), cB, voffB); PG8_STAGE(PG8_SB(0, 1), cB + hstep, voffB); PG8_STAGE(PG8_SA(0, 0), cA, voffA); PG8_STAGE(PG8_SA(0, 1), cA + hstep, voffA);
        if (wr == 1) PG8_BAR;
        PG8_WAIT_V(2); PG8_BAR;
        PG8_STAGE(PG8_SB(1, 0), cB + kstep, voffB); PG8_STAGE(PG8_SA(1, 0), cA + kstep, voffA); PG8_STAGE(PG8_SB(1, 1), cB + hstep + kstep, voffB);
        PG8_WAIT_V(6); PG8_BAR;
    } else {
        PG8_STAGE(PG8_SB(0, 0), cB, voffB); PG8_STAGE(PG8_SA(0, 0), cA, voffA); PG8_STAGE(PG8_SB(0, 1), cB + hstep, voffB); PG8_STAGE(PG8_SA(0, 1), cA + hstep, voffA);
        if (wr == 1) PG8_BAR;
        PG8_WAIT_V(4); PG8_BAR;
        PG8_STAGE(PG8_SB(1, 0), cB + kstep, voffB); PG8_STAGE(PG8_SA(1, 0), cA + kstep, voffA); PG8_STAGE(PG8_SB(1, 1), cB + hstep + kstep, voffB);
        PG8_WAIT_V(6); PG8_BAR;
    }
    for (;;) {
        const bool has_next = S.next(ui + 1, nxt);
        const char* nA = has_next ? (const char*)g.A + (size_t)nxt.pm * tstep : cA; const char* nB = has_next ? (const char*)g.Bt + (size_t)nxt.pn * tstep : cB;
        for (int t = 0; t < nt; t += 2) {
            const bool last = (t == nt - 2);
            const char* a1 = cA + (size_t)(t + 1) * kstep;
            const char* a2 = last ? nA : cA + (size_t)(t + 2) * kstep; const char* b2 = last ? nB : cB + (size_t)(t + 2) * kstep;
            const char* a3 = a2 + kstep; const char* b3 = b2 + kstep;
            if (last && has_next) S.a_ready(nxt);
            if constexpr (SP2) {
            PG8_LDB(B0, 0, 0); PG8_LDB(B1, 0, 1); PG8_SCHED; PG8_LDA(At, 0, 0); PG8_STAGE(PG8_SA(1, 1), a1 + hstep, voffA);
            PG8_WAIT_V(8); PG8_WAIT_L(0); PG8_BAR; PG8_MMA(0, 0, At, B0); PG8_MMA(0, 1, At, B1); PG8_BAR; PG8_SCHED;
            PG8_LDA(At, 0, 1); PG8_STAGE(PG8_SB(0, 0), b2, voffB); PG8_STAGE(PG8_SB(0, 1), b2 + hstep, voffB); PG8_STAGE(PG8_SA(0, 0), a2, voffA);
            PG8_WAIT_V(8); PG8_WAIT_L(0); PG8_BAR; PG8_MMA(1, 0, At, B0); PG8_MMA(1, 1, At, B1); PG8_BAR; PG8_SCHED;
            PG8_LDB(B0, 1, 0); PG8_LDB(B1, 1, 1); PG8_SCHED; PG8_LDA(At, 1, 0); PG8_STAGE(PG8_SA(0, 1), a2 + hstep, voffA);
            PG8_WAIT_V(8); PG8_WAIT_L(0); PG8_BAR; PG8_MMA(0, 0, At, B0); PG8_MMA(0, 1, At, B1); PG8_BAR; PG8_SCHED;
            PG8_LDA(At, 1, 1); PG8_STAGE(PG8_SB(1, 0), b3, voffB); PG8_STAGE(PG8_SB(1, 1), b3 + hstep, voffB); PG8_STAGE(PG8_SA(1, 0), a3, voffA);
            PG8_WAIT_V(8); PG8_WAIT_L(0); PG8_BAR; PG8_MMA(1, 0, At, B0); PG8_MMA(1, 1, At, B1); PG8_BAR; PG8_SCHED;
            } else {
            PG8_LDB(B0, 0, 0); PG8_SCHED; PG8_LDA(At, 0, 0); PG8_STAGE(PG8_SA(1, 1), a1 + hstep, voffA);
            PG8_WAIT_L(8); PG8_BAR; PG8_WAIT_L(0); PG8_MMA(0, 0, At, B0); PG8_BAR; PG8_SCHED;
            PG8_LDB(B1, 0, 1); PG8_STAGE(PG8_SB(0, 0), b2, voffB);
            PG8_BAR; PG8_WAIT_L(0); PG8_MMA(0, 1, At, B1); PG8_BAR;
            PG8_LDA(At, 0, 1); PG8_STAGE(PG8_SA(0, 0), a2, voffA);
            PG8_BAR; PG8_WAIT_L(0); PG8_MMA(1, 0, At, B0); PG8_BAR; PG8_SCHED;
            PG8_STAGE(PG8_SB(0, 1), b2 + hstep, voffB);
            PG8_WAIT_V(6); PG8_BAR; PG8_MMA(1, 1, At, B1); PG8_BAR;
            PG8_LDB(B0, 1, 0); PG8_SCHED; PG8_LDA(At, 1, 0); PG8_STAGE(PG8_SA(0, 1), a2 + hstep, voffA);
            PG8_WAIT_L(8); PG8_BAR; PG8_WAIT_L(0); PG8_MMA(0, 0, At, B0); PG8_BAR; PG8_SCHED;
            PG8_LDB(B1, 1, 1); PG8_STAGE(PG8_SB(1, 0), b3, voffB);
            PG8_BAR; PG8_WAIT_L(0); PG8_MMA(0, 1, At, B1); PG8_BAR;
            PG8_LDA(At, 1, 1); PG8_STAGE(PG8_SA(1, 0), a3, voffA);
            PG8_BAR; PG8_WAIT_L(0); PG8_MMA(1, 0, At, B0); PG8_BAR; PG8_SCHED;
            PG8_STAGE(PG8_SB(1, 1), b3 + hstep, voffB);
            PG8_WAIT_V(6); PG8_BAR; PG8_MMA(1, 1, At, B1); PG8_BAR;
            }
        }
        if constexpr (ALIGN_EPI) { if (wr == 0) PG8_BAR; }
        if constexpr (!Epi::AFTER_DRAIN) { E(acc, cur, wr, wc, fr, fq, epre); S.done(cur); }
        if (!has_next) break;
        E.pre(nxt, wr, fr, epre);
#pragma unroll
        for (int a = 0; a < 2; ++a)
#pragma unroll
            for (int b = 0; b < 2; ++b)
#pragma unroll
                for (int m = 0; m < 4; ++m)
#pragma unroll
                    for (int n = 0; n < 2; ++n) acc[a][b][m][n] = (f32x4){0.f, 0.f, 0.f, 0.f};
        cur = nxt; cA = nA; cB = nB; ++ui;
        if constexpr (ALIGN_EPI) { if (wr == 1) PG8_BAR; }
    }
    PG8_WAIT_V(0);
    if constexpr (!ALIGN_EPI) { if (wr == 0) PG8_BAR; }
    PG8_BAR;
    if constexpr (Epi::AFTER_DRAIN) { E.fused(acc, cur, wr, wc, fr, fq, lds, wid, lane); S.done(cur); }
#undef PG8_SA
#undef PG8_SB
#undef PG8_STAGE
#undef PG8_LDA
#undef PG8_LDB
#undef PG8_MMA
#undef PG8_WAIT_V
#undef PG8_WAIT_L
#undef PG8_BAR
#undef PG8_SCHED
}
}
using pg8::bf16_t; using pg8::bf16x8; using pg8::f32x4;
typedef short s16x4 __attribute__((ext_vector_type(4)));
typedef float f32x16 __attribute__((ext_vector_type(16)));
typedef float f32x2 __attribute__((ext_vector_type(2)));
typedef __bf16 bf2_t __attribute__((ext_vector_type(2)));
typedef unsigned u32x2 __attribute__((ext_vector_type(2)));
typedef unsigned u32x4 __attribute__((ext_vector_type(4)));
#define LAS __attribute__((address_space(3)))
#define DI __device__ __forceinline__
#define MFMA32(a, b, c) __builtin_amdgcn_mfma_f32_32x32x16_bf16((a), (b), (c), 0, 0, 0)

DI int otid() { int t = threadIdx.x; asm volatile("" : "+v"(t)); return t; }
DI unsigned pk2(float a, float b) { f32x2 v = {a, b}; bf2_t r = __builtin_convertvector(v, bf2_t); return __builtin_bit_cast(unsigned, r); }
DI float bflo(unsigned u) { return __uint_as_float(u << 16); }
DI float bfhi(unsigned u) { return __uint_as_float(u & 0xffff0000u); }
DI float fexp2(float x) { return __builtin_amdgcn_exp2f(x); }
DI float frcp(float x) { return __builtin_amdgcn_rcpf(x); }
DI float fsilu(float x) { return x * frcp(1.0f + fexp2(-1.44269504089f * x)); }
DI int crow(int i, int h) { return (i & 3) + 8 * (i >> 2) + 4 * h; }
DI s16x4 trr(const LAS unsigned char* p) { return __builtin_amdgcn_ds_read_tr16_b64_v4i16((LAS s16x4*)p); }
DI bf16x8 tr2(const LAS unsigned char* p0, const LAS unsigned char* p1) { s16x4 a = trr(p0), b = trr(p1); return __builtin_shufflevector(a, b, 0, 1, 2, 3, 4, 5, 6, 7); }
DI bf16x8 pack8(const f32x16& x, int s) {
    u32x4 p; p[0] = pk2(x[8 * s], x[8 * s + 1]); p[1] = pk2(x[8 * s + 2], x[8 * s + 3]); p[2] = pk2(x[8 * s + 4], x[8 * s + 5]); p[3] = pk2(x[8 * s + 6], x[8 * s + 7]);
    return __builtin_bit_cast(bf16x8, p);
}
DI f32x16 zero16() { f32x16 z; for (int i = 0; i < 16; ++i) z[i] = 0.f; return z; }

constexpr int MT = 16384, SEQ = 8192, DM = 1024, DFF = 2816, AINW = 3072, SINW = 6176, SINWP = 6400, DIN = 2048, XBCW = 4096;
constexpr float LOG2E = 1.44269504089f;
constexpr int LDS_BYTES = 155648;
constexpr size_t W_AIN = 0, W_AOUT = W_AIN + (size_t)AINW * DM * 2, W_GU0 = W_AOUT + (size_t)DM * DM * 2, W_DN0 = W_GU0 + (size_t)2 * DFF * DM * 2,
                 W_SIN = W_DN0 + (size_t)DM * DFF * 2, W_SOUT = W_SIN + (size_t)SINWP * DM * 2, W_GU1 = W_SOUT + (size_t)DM * DIN * 2, W_DN1 = W_GU1 + (size_t)2 * DFF * DM * 2,
                 O_HB = W_DN1 + (size_t)DM * DFF * 2, O_SS = O_HB + (size_t)MT * DM * 2, O_ROPE = O_SS + (size_t)5 * MT * 4, O_DT = O_ROPE + (size_t)SEQ * 32 * 8,
                 O_CDEC = O_DT + (size_t)MT * 32 * 4, O_LAM = O_CDEC + 16384, O_BAR = O_LAM + 256, O_R = 98566144;
static_assert(O_BAR + 20480 <= O_R, "map");
constexpr size_t O_PROJ = O_R, O_MIXED = O_PROJ + (size_t)MT * AINW * 2, O_ACT = O_R, O_XBC = O_R, O_ST1 = O_XBC + (size_t)MT * XBCW * 2, O_ST0 = 0;
constexpr size_t ST_BATCH = (size_t)64 * 32 * 64 * 128;
static_assert(O_ST1 + ST_BATCH * 2 <= 268435456ull, "ws");
static_assert(ST_BATCH * 2 <= W_SOUT, "st0 overlay");
static_assert(O_MIXED + (size_t)MT * DM * 2 <= 268435456ull, "ws2");

struct Params { const float* in[23]; float* out; unsigned char* ws; };
#include <cstdlib>
#include <vector>

#define XB_TMO      128
#define XB_XCNT(j)  (256  + 64 * (j))
#define XB_XSUB(j)  (1280 + 64 * (j))
#define XB_XGEN(j)  (2304 + 64 * (j))
#define XB_TOP      3328
#define XB_TOPGEN   3392
#define XCD_BAR_WORDS 3456
#define XB_SPIN_CAP (1u << 18)

__device__ __forceinline__ unsigned xb_ld(unsigned* p)              { return __hip_atomic_load(p, __ATOMIC_RELAXED, __HIP_MEMORY_SCOPE_AGENT); }
__device__ __forceinline__ unsigned xb_add(unsigned* p, unsigned v) { return __hip_atomic_fetch_add(p, v, __ATOMIC_RELAXED, __HIP_MEMORY_SCOPE_AGENT); }
__device__ __forceinline__ unsigned xb_xcc_id() { return (unsigned)__builtin_amdgcn_s_getreg((3 << 11) | 20) & 0xFu; }
#define XB_SPIN(cond, bar) do { unsigned _sp = 0; while (cond) { \
    if ((++_sp & 255u) == 0u) { if (xb_ld(&(bar)[XB_TMO])) break; if (_sp > XB_SPIN_CAP) { atomicAdd(&(bar)[XB_TMO], 1u); break; } } } } while (0)

struct XcdBarrier {
    unsigned* bar; unsigned x;
    volatile LAS unsigned* st;
};

__device__ __forceinline__ XcdBarrier xcd_barrier_post(unsigned* bar, volatile LAS unsigned* st) {
    XcdBarrier b; b.bar = bar; b.x = xb_xcc_id(); b.st = st;
    if (threadIdx.x == 0) (void)xb_add(&bar[XB_XCNT(b.x)], 1u);
    return b;
}
__device__ __forceinline__ void xcd_barrier_complete(unsigned* bar, unsigned x, unsigned& nloc, unsigned& nx) {
    const unsigned G = gridDim.x * gridDim.y * gridDim.z;
    unsigned sum, cnt, mine, sp = 0u;
    for (;;) {
        sum = 0u; cnt = 0u; mine = 0u;
#pragma unroll
        for (unsigned j = 0; j < 16; ++j) { const unsigned c = xb_ld(&bar[XB_XCNT(j)]); sum += c; cnt += (c > 0u) ? 1u : 0u; mine = (j == x) ? c : mine; }
        if (sum == G) break;
        __builtin_amdgcn_s_sleep(1);
        if ((++sp & 255u) == 0u) { if (xb_ld(&bar[XB_TMO])) break; if (sp > XB_SPIN_CAP) { atomicAdd(&bar[XB_TMO], 1u); break; } }
    }
    nloc = mine > 0u ? mine : 1u; nx = cnt > 0u ? cnt : 1u;
}

__device__ __forceinline__ void xcd_barrier(const XcdBarrier& b) {
    asm volatile("s_waitcnt vmcnt(0)" ::: "memory");
    __syncthreads();
    if (threadIdx.x == 0) {
        unsigned* bar = b.bar;
        __builtin_amdgcn_s_waitcnt(0);
        unsigned nloc = b.st[0], nx = b.st[1];
        if (nloc == 0u) { xcd_barrier_complete(bar, b.x, nloc, nx); b.st[0] = nloc; b.st[1] = nx; }
        const unsigned old = xb_add(&bar[XB_XSUB(b.x)], 1u);
        const unsigned gen = old / nloc;
        if (old + 1u == (gen + 1u) * nloc) {
            __builtin_amdgcn_fence(__ATOMIC_RELEASE, "agent");
            asm volatile("s_waitcnt vmcnt(0)" ::: "memory");
            const unsigned og = xb_add(&bar[XB_TOP], 1u);
            const unsigned tg = og / nx;
            if (og + 1u != (tg + 1u) * nx) XB_SPIN(xb_ld(&bar[XB_TOP]) < (tg + 1u) * nx, bar);
            __builtin_amdgcn_fence(__ATOMIC_ACQUIRE, "agent");
            asm volatile("s_waitcnt vmcnt(0)" ::: "memory");
        } else {
            XB_SPIN(xb_ld(&bar[XB_TOP]) < (gen + 1u) * nx, bar);
            __builtin_amdgcn_fence(__ATOMIC_ACQUIRE, "agent");
            asm volatile("s_waitcnt vmcnt(0)" ::: "memory");
        }
    }
    __syncthreads();
}
DI void wmap(int mode, int c, int& src, float& scale, int& which) {
    src = c; scale = 1.f; which = 0;
    if (mode == 0) {
        if (c < 1024) { const int base = c & ~63, cc = c & 63, g = cc >> 3, e = cc & 7; src = base + (e < 4 ? 4 * g + e : 32 + 4 * g + (e - 4)); }
        if (c < 512) scale = 0.125f * LOG2E; else if (c >= 1536 && c < 2048) scale = 0.125f;
    } else if (mode == 2) { src = 128 * (c >> 8) + (c & 127); which = (c >> 7) & 1; }
    else if (mode == 3) { if (c >= SINW) src = -1; }
}
struct WJob { int mode, K, ldw, tix; const float* W0; const float* W1; const float* ks; bf16_t* dst; };
DI WJob wjob(const Params& p, int t) {
    unsigned char* ws = p.ws;
    const int cnt[8] = {48 * 4, 16 * 4, 88 * 4, 16 * 11, 100 * 4, 16 * 8, 88 * 4, 16 * 11};
    int j = 0, tt = t;
#pragma unroll
    for (int q = 0; q < 7; ++q) if (j == q && tt >= cnt[q]) { tt -= cnt[q]; j = q + 1; }
    WJob J; J.tix = tt; J.W1 = nullptr; J.ks = nullptr;
    switch (j) {
    case 0: J.mode = 0; J.W0 = p.in[2]; J.ks = p.in[1]; J.dst = (bf16_t*)(ws + W_AIN); J.K = DM; J.ldw = AINW; break;
    case 1: J.mode = 1; J.W0 = p.in[8]; J.dst = (bf16_t*)(ws + W_AOUT); J.K = DM; J.ldw = DM; break;
    case 2: J.mode = 2; J.W0 = p.in[19]; J.W1 = p.in[20]; J.ks = p.in[18]; J.dst = (bf16_t*)(ws + W_GU0); J.K = DM; J.ldw = DFF; break;
    case 3: J.mode = 1; J.W0 = p.in[21]; J.dst = (bf16_t*)(ws + W_DN0); J.K = DFF; J.ldw = DM; break;
    case 4: J.mode = 3; J.W0 = p.in[10]; J.ks = p.in[9]; J.dst = (bf16_t*)(ws + W_SIN); J.K = DM; J.ldw = SINW; break;
    case 5: J.mode = 1; J.W0 = p.in[17]; J.dst = (bf16_t*)(ws + W_SOUT); J.K = DIN; J.ldw = DM; break;
    case 6: J.mode = 2; J.W0 = p.in[19] + (size_t)DM * DFF; J.W1 = p.in[20] + (size_t)DM * DFF; J.ks = p.in[18] + DM; J.dst = (bf16_t*)(ws + W_GU1); J.K = DM; J.ldw = DFF; break;
    default: J.mode = 1; J.W0 = p.in[21] + (size_t)DFF * DM; J.dst = (bf16_t*)(ws + W_DN1); J.K = DFF; J.ldw = DM; break;
    }
    return J;
}
DI void wtile_load(const WJob& J, int tid, float (&v)[32], float& sc, int& srcok) {
    const int nk = J.K >> 8, c0 = (J.tix / nk) * 64, k0 = (J.tix % nk) * 256, cc = tid & 63; int src, which; wmap(J.mode, c0 + cc, src, sc, which);
    const float* W = (which ? J.W1 : J.W0) + (src >= 0 ? src : 0); srcok = (src >= 0);
#pragma unroll
    for (int i = 0; i < 32; ++i) { const int kk = (tid >> 6) + 8 * i; v[i] = W[(size_t)(k0 + kk) * J.ldw]; }
}
DI void wtile_store(LAS float* tile, const WJob& J, int tid, const float (&v)[32], float sc, int srcok) {
    const int nk = J.K >> 8, c0 = (J.tix / nk) * 64, k0 = (J.tix % nk) * 256, cc = tid & 63;
#pragma unroll
    for (int i = 0; i < 32; ++i) { const int kk = (tid >> 6) + 8 * i; float x = srcok ? v[i] * sc : 0.f; if (J.ks) x *= J.ks[k0 + kk]; tile[kk * 65 + cc] = x; }
    __syncthreads();
#pragma unroll
    for (int i = 0; i < 16; ++i) {
        const int idx = tid + 512 * i, c2 = idx >> 7, k2 = (idx & 127) * 2;
        *(unsigned*)(J.dst + (size_t)(c0 + c2) * J.K + k0 + k2) = pk2(tile[k2 * 65 + c2], tile[(k2 + 1) * 65 + c2]);
    }
    __syncthreads();
}
DI void wconv_jobs(LAS unsigned char* lds, const Params& p, int wi, int nb) {
    const int tid = otid(); const int total = 48 * 4 + 16 * 4 + 2 * (88 * 4 + 16 * 11) + 100 * 4 + 16 * 8;
    if (wi >= total) return;
    WJob J = wjob(p, wi); float v[32]; float sc; int ok;
    wtile_load(J, tid, v, sc, ok);
    for (int t = wi; t < total; t += nb) {
        const bool more = (t + nb < total);
        WJob Jn = J; float vn[32]; float scn = 0.f; int okn = 0;
        if (more) { Jn = wjob(p, t + nb); wtile_load(Jn, tid, vn, scn, okn); }
        wtile_store((LAS float*)lds, J, tid, v, sc, ok);
        if (more) { J = Jn; sc = scn; ok = okn;
#pragma unroll
            for (int i = 0; i < 32; ++i) v[i] = vn[i]; }
    }
}
DI void phase0(LAS unsigned char* lds, const Params& p) {
    const int tid = otid(), G = gridDim.x, bx = blockIdx.x;
    unsigned char* ws = p.ws;
    wconv_jobs(lds, p, bx, G);
    {
        const int wave = tid >> 6, lane = tid & 63; bf16_t* hb = (bf16_t*)(ws + O_HB); float* ss = (float*)(ws + O_SS);
        for (int row0 = (bx * 8 + wave) * 2; row0 < MT; row0 += G * 16) {
            f32x4 v[2][4];
#pragma unroll
            for (int q = 0; q < 2; ++q)
#pragma unroll
                for (int i = 0; i < 4; ++i) v[q][i] = *(const f32x4*)(p.in[0] + (size_t)(row0 + q) * DM + lane * 4 + 256 * i);
#pragma unroll
            for (int q = 0; q < 2; ++q) {
                float sq = 0.f;
#pragma unroll
                for (int i = 0; i < 4; ++i) { const f32x4 x = v[q][i]; sq += x[0] * x[0] + x[1] * x[1] + x[2] * x[2] + x[3] * x[3];
                    u32x2 o; o[0] = pk2(x[0], x[1]); o[1] = pk2(x[2], x[3]); *(u32x2*)(hb + (size_t)(row0 + q) * DM + lane * 4 + 256 * i) = o; }
#pragma unroll
                for (int o = 32; o >= 1; o >>= 1) sq += __shfl_xor(sq, o);
                if (lane == 0) ss[row0 + q] = sq;
            }
        }
        for (int i = bx * 512 + tid; i < 4 * MT; i += G * 512) ss[MT + i] = 0.f;
        f32x2* tab = (f32x2*)(ws + O_ROPE);
        for (int i = bx * 512 + tid; i < SEQ * 32; i += G * 512) {
            const int pos = i >> 5, f = i & 31; const float inv = fexp2(-(float)f * 0.41524101186092f); const float ang = (float)pos * inv;
            double t = (double)ang * 0.15915494309189535; t -= floor(t); const float tf = (float)t;
            f32x2 cs; cs[0] = __builtin_amdgcn_cosf(tf); cs[1] = __builtin_amdgcn_sinf(tf); tab[i] = cs;
        }
        if (bx == 0 && tid == 0) { float s1 = 0.f, s2 = 0.f; for (int i = 0; i < 64; ++i) { s1 += p.in[3][i] * p.in[4][i]; s2 += p.in[5][i] * p.in[6][i]; }
            *(float*)(ws + O_LAM) = fexp2(s1 * LOG2E) - fexp2(s2 * LOG2E) + 0.2f; }
    }
}

struct EpiAttnIn {
    static constexpr bool PERM = true, AFTER_DRAIN = false;
    bf16_t* O; const float* ss; const f32x4* tab;
    DI void pre(const pg8::Unit& u, int wr, int fr, float (&e)[8]) const {
#pragma unroll
        for (int ai = 0; ai < 2; ++ai)
#pragma unroll
            for (int m = 0; m < 4; ++m) e[ai * 4 + m] = ss[u.pm * 256 + wr * 64 + fr + ai * 128 + m * 16];
    }
    DI void operator()(const f32x4 (&acc)[2][2][4][2], const pg8::Unit& u, int wr, int wc, int fr, int fq, const float (&epre)[8]) const {
        const int row0 = u.pm * 256 + wr * 64 + fr, colt = u.pn * 256, col0 = colt + wc * 32 + 8 * fq;
        const int fb = 4 * (4 * (wc & 1) + fq);
#pragma unroll
        for (int ai = 0; ai < 2; ++ai)
#pragma unroll
            for (int m = 0; m < 4; ++m) {
                const int row = row0 + ai * 128 + m * 16; const float rs = __builtin_amdgcn_rsqf(epre[ai * 4 + m] * (1.0f / 1024.0f) + 1e-6f);
                f32x4 c01 = {1.f, 0.f, 1.f, 0.f}, c23 = {1.f, 0.f, 1.f, 0.f};
                if (colt < 1024) { const int pos = row & (SEQ - 1); c01 = tab[(pos * 32 + fb) >> 1]; c23 = tab[((pos * 32 + fb) >> 1) + 1]; }
#pragma unroll
                for (int bj = 0; bj < 2; ++bj) {
                    f32x4 v0 = acc[ai][bj][m][0] * rs, v1 = acc[ai][bj][m][1] * rs;
                    if (colt < 1024) {
                        const float cs[4] = {c01[0], c01[2], c23[0], c23[2]}, sn[4] = {c01[1], c01[3], c23[1], c23[3]};
#pragma unroll
                        for (int j = 0; j < 4; ++j) { const float t1 = v0[j], t2 = v1[j]; v0[j] = t1 * cs[j] - t2 * sn[j]; v1[j] = t2 * cs[j] + t1 * sn[j]; }
                    }
                    u32x4 o; o[0] = pk2(v0[0], v0[1]); o[1] = pk2(v0[2], v0[3]); o[2] = pk2(v1[0], v1[1]); o[3] = pk2(v1[2], v1[3]);
                    *(u32x4*)(O + (size_t)row * AINW + col0 + bj * 128) = o;
                }
            }
    }
};
template <bool RES_F32, bool OUT_F32> struct EpiRes {
    static constexpr bool PERM = true, AFTER_DRAIN = false;
    const float* xres; bf16_t* hb; float* outf; float* ssn;
    DI void pre(const pg8::Unit&, int, int, float (&)[8]) const {}
    DI void operator()(const f32x4 (&acc)[2][2][4][2], const pg8::Unit& u, int wr, int wc, int fr, int fq, const float (&epre)[8]) const {
        const int row0 = u.pm * 256 + wr * 64 + fr, col0 = u.pn * 256 + wc * 32 + 8 * fq;
#pragma unroll
        for (int ai = 0; ai < 2; ++ai)
#pragma unroll
            for (int m = 0; m < 4; ++m) {
                const int row = row0 + ai * 128 + m * 16; float sq = 0.f;
#pragma unroll
                for (int bj = 0; bj < 2; ++bj) {
                    const size_t off = (size_t)row * DM + col0 + bj * 128; f32x4 r0, r1;
                    if (RES_F32) { r0 = *(const f32x4*)(xres + off); r1 = *(const f32x4*)(xres + off + 4); }
                    else { const u32x4 t = *(const u32x4*)(hb + off); r0[0] = bflo(t[0]); r0[1] = bfhi(t[0]); r0[2] = bflo(t[1]); r0[3] = bfhi(t[1]); r1[0] = bflo(t[2]); r1[1] = bfhi(t[2]); r1[2] = bflo(t[3]); r1[3] = bfhi(t[3]); }
                    const f32x4 v0 = r0 + acc[ai][bj][m][0], v1 = r1 + acc[ai][bj][m][1];
                    sq += v0[0] * v0[0] + v0[1] * v0[1] + v0[2] * v0[2] + v0[3] * v0[3] + v1[0] * v1[0] + v1[1] * v1[1] + v1[2] * v1[2] + v1[3] * v1[3];
                    if (OUT_F32) { *(f32x4*)(outf + off) = v0; *(f32x4*)(outf + off + 4) = v1; }
                    else { u32x4 o; o[0] = pk2(v0[0], v0[1]); o[1] = pk2(v0[2], v0[3]); o[2] = pk2(v1[0], v1[1]); o[3] = pk2(v1[2], v1[3]); *(u32x4*)(hb + off) = o; }
                }
                sq += __shfl_xor(sq, 16); sq += __shfl_xor(sq, 32);
                if (fq == 0) atomicAdd(ssn + row, sq);
            }
    }
};
struct EpiGU {
    static constexpr bool PERM = true, AFTER_DRAIN = false;
    bf16_t* act; const float* ss;
    DI void pre(const pg8::Unit& u, int wr, int fr, float (&e)[8]) const {
#pragma unroll
        for (int ai = 0; ai < 2; ++ai)
#pragma unroll
            for (int m = 0; m < 4; ++m) e[ai * 4 + m] = ss[u.pm * 256 + wr * 64 + fr + ai * 128 + m * 16];
    }
    DI void operator()(const f32x4 (&acc)[2][2][4][2], const pg8::Unit& u, int wr, int wc, int fr, int fq, const float (&epre)[8]) const {
        const int row0 = u.pm * 256 + wr * 64 + fr;
#pragma unroll
        for (int ai = 0; ai < 2; ++ai)
#pragma unroll
            for (int m = 0; m < 4; ++m) {
                const int row = row0 + ai * 128 + m * 16; const float rs = __builtin_amdgcn_rsqf(epre[ai * 4 + m] * (1.0f / 1024.0f) + 1e-6f);
                u32x4 o;
#pragma unroll
                for (int n = 0; n < 2; ++n) {
                    const f32x4 g = acc[ai][0][m][n] * rs, up = acc[ai][1][m][n] * rs; float a[4];
#pragma unroll
                    for (int j = 0; j < 4; ++j) a[j] = fsilu(g[j]) * up[j];
                    o[2 * n] = pk2(a[0], a[1]); o[2 * n + 1] = pk2(a[2], a[3]);
                }
                *(u32x4*)(act + (size_t)row * DFF + u.pn * 128 + wc * 32 + 8 * fq) = o;
            }
    }
};
struct EpiSsdIn {
    static constexpr bool PERM = true, AFTER_DRAIN = false;
    bf16_t* z; bf16_t* xbc; float* dt; const float* ss;
    DI void pre(const pg8::Unit& u, int wr, int fr, float (&e)[8]) const {
#pragma unroll
        for (int ai = 0; ai < 2; ++ai)
#pragma unroll
            for (int m = 0; m < 4; ++m) e[ai * 4 + m] = ss[u.pm * 256 + wr * 64 + fr + ai * 128 + m * 16];
    }
    DI void operator()(const f32x4 (&acc)[2][2][4][2], const pg8::Unit& u, int wr, int wc, int fr, int fq, const float (&epre)[8]) const {
        const int row0 = u.pm * 256 + wr * 64 + fr, col0 = u.pn * 256 + wc * 32 + 8 * fq;
#pragma unroll
        for (int ai = 0; ai < 2; ++ai)
#pragma unroll
            for (int m = 0; m < 4; ++m) {
                const int row = row0 + ai * 128 + m * 16; const float rs = __builtin_amdgcn_rsqf(epre[ai * 4 + m] * (1.0f / 1024.0f) + 1e-6f);
#pragma unroll
                for (int bj = 0; bj < 2; ++bj) {
                    const int c = col0 + bj * 128; const f32x4 v0 = acc[ai][bj][m][0] * rs, v1 = acc[ai][bj][m][1] * rs;
                    if (c < 6144) { u32x4 o; o[0] = pk2(v0[0], v0[1]); o[1] = pk2(v0[2], v0[3]); o[2] = pk2(v1[0], v1[1]); o[3] = pk2(v1[2], v1[3]);
                        if (c < DIN) *(u32x4*)(z + (size_t)row * DIN + c) = o; else *(u32x4*)(xbc + (size_t)row * XBCW + (c - DIN)) = o; }
                }
            }
    }
};

struct EpiFinal {
    static constexpr bool PERM = true, AFTER_DRAIN = true;
    const bf16_t* hb; float* outf; float* ssn; unsigned* cnt; const float* fw;
    DI void operator()(const f32x4 (&)[2][2][4][2], const pg8::Unit&, int, int, int, int, const float (&)[8]) const {}
    DI void pre(const pg8::Unit&, int, int, float (&)[8]) const {}
    DI void fused(f32x4 (&acc)[2][2][4][2], const pg8::Unit& u, int wr, int wc, int fr, int fq, PG8_LAS unsigned char*, int, int) const {
        const int row0 = u.pm * 256 + wr * 64 + fr, col0 = u.pn * 256 + wc * 32 + 8 * fq;
#pragma unroll
        for (int ai = 0; ai < 2; ++ai)
#pragma unroll
            for (int m = 0; m < 4; ++m) {
                const int row = row0 + ai * 128 + m * 16; float sq = 0.f;
#pragma unroll
                for (int bj = 0; bj < 2; ++bj) {
                    const size_t off = (size_t)row * DM + col0 + bj * 128;
                    const u32x4 t = *(const u32x4*)(hb + off);
#pragma unroll
                    for (int n = 0; n < 2; ++n) {
                        f32x4 r; r[0] = bflo(t[2 * n]); r[1] = bfhi(t[2 * n]); r[2] = bflo(t[2 * n + 1]); r[3] = bfhi(t[2 * n + 1]);
                        const f32x4 v = r + acc[ai][bj][m][n]; acc[ai][bj][m][n] = v;
                        sq += v[0] * v[0] + v[1] * v[1] + v[2] * v[2] + v[3] * v[3];
                    }
                }
                sq += __shfl_xor(sq, 16); sq += __shfl_xor(sq, 32);
                if (fq == 0) atomicAdd(ssn + row, sq);
            }
        asm volatile("s_waitcnt vmcnt(0)" ::: "memory");
        __syncthreads();
        unsigned* c = cnt + 16 * u.pm;
        if (threadIdx.x == 0) {
            __builtin_amdgcn_fence(__ATOMIC_RELEASE, "agent"); asm volatile("s_waitcnt vmcnt(0)" ::: "memory");
            __hip_atomic_fetch_add(c, 1u, __ATOMIC_RELAXED, __HIP_MEMORY_SCOPE_AGENT);
            unsigned spins = 0;
            while (__hip_atomic_load(c, __ATOMIC_RELAXED, __HIP_MEMORY_SCOPE_AGENT) < 4u && ++spins < (1u << 22)) __builtin_amdgcn_s_sleep(2);
            __builtin_amdgcn_fence(__ATOMIC_ACQUIRE, "agent"); asm volatile("s_waitcnt vmcnt(0)" ::: "memory");
        }
        __syncthreads();
#pragma unroll
        for (int ai = 0; ai < 2; ++ai)
#pragma unroll
            for (int m = 0; m < 4; ++m) {
                const int row = row0 + ai * 128 + m * 16;
                const float rs = __builtin_amdgcn_rsqf(__hip_atomic_load(ssn + row, __ATOMIC_RELAXED, __HIP_MEMORY_SCOPE_AGENT) * (1.0f / 1024.0f) + 1e-6f);
#pragma unroll
                for (int bj = 0; bj < 2; ++bj)
#pragma unroll
                    for (int n = 0; n < 2; ++n) {
                        const int col = col0 + bj * 128 + n * 4; const f32x4 w = *(const f32x4*)(fw + col);
                        *(f32x4*)(outf + (size_t)row * DM + col) = acc[ai][bj][m][n] * rs * w;
                    }
            }
    }
};
constexpr int KST = 144, VST = 320, VST64 = 192;
constexpr int AT_K1 = 0, AT_K2 = 64 * KST, AT_V = 2 * 64 * KST, AT_STAGE = AT_V + 64 * VST;

DI void diff_tile(LAS unsigned char* lds, const bf16_t* proj, bf16_t* mixed, const float* subln, float lam, int b, int hd, int qt) {
    const int tid = otid(), w = __builtin_amdgcn_readfirstlane(tid >> 6), lane = tid & 63, qg = w & 3, mp = w >> 2, r = lane & 31, h = lane >> 5;
    const int q0 = qt * 128; const size_t rowb = (size_t)b * SEQ;
    bf16x8 qf[4];
    { const bf16_t* qp = proj + (rowb + q0 + 32 * qg + r) * AINW + hd * 128 + mp * 64 + 8 * h;
#pragma unroll
      for (int s = 0; s < 4; ++s) qf[s] = *(const bf16x8*)(qp + 16 * s); }
    f32x16 O[4];
#pragma unroll
    for (int i = 0; i < 4; ++i) O[i] = zero16();
    float mrun = 0.f, lrun = 0.f;
    const int nsteps = 2 * (qt + 1);
    const bf16_t* src[4]; int dst[4];
#pragma unroll
    for (int i = 0; i < 2; ++i) { const int cid = tid + 512 * i, row = cid >> 4, c16 = cid & 15;
        src[i] = proj + (rowb + row) * AINW + 512 + hd * 128 + c16 * 8; dst[i] = (c16 < 8 ? AT_K1 : AT_K2) + row * KST + (c16 & 7) * 16;
        src[2 + i] = proj + (rowb + row) * AINW + 1024 + hd * 128 + c16 * 8; dst[2 + i] = AT_V + row * VST + c16 * 16; }
    u32x4 pf[4];
#pragma unroll
    for (int i = 0; i < 4; ++i) pf[i] = *(const u32x4*)(src[i]);
#pragma unroll
    for (int i = 0; i < 4; ++i) *(LAS u32x4*)(lds + dst[i]) = pf[i];
    __syncthreads();
    const int i16 = lane & 15, tq = i16 >> 2, tp = i16 & 3, g16 = (lane >> 4) & 1;
    const int troff = (4 * h + tq) * VST + (16 * g16 + 4 * tp) * 2;
    for (int j = 0; j < nsteps; ++j) {
        const bool more = (j + 1 < nsteps);
        if (more) {
#pragma unroll
            for (int i = 0; i < 4; ++i) pf[i] = *(const u32x4*)(src[i] + (size_t)(j + 1) * 64 * AINW);
        }
        const LAS unsigned char* base = lds + (j & 1) * AT_STAGE;
        const LAS unsigned char* Kb = base + (mp ? AT_K2 : AT_K1);
        const LAS unsigned char* Vb = base + AT_V;
        f32x16 S[2];
        const float negm = -mrun;
#pragma unroll
        for (int kt = 0; kt < 2; ++kt) {
#pragma unroll
            for (int i = 0; i < 16; ++i) S[kt][i] = negm;
#pragma unroll
            for (int s = 0; s < 4; ++s) { const bf16x8 kf = *(const LAS bf16x8*)(Kb + (32 * kt + r) * KST + (16 * s + 8 * h) * 2); S[kt] = MFMA32(kf, qf[s], S[kt]); } }
        const int qidx = q0 + 32 * qg + r, kbase = 64 * j;
        if (kbase + 63 > q0 + 32 * qg) {
#pragma unroll
            for (int kt = 0; kt < 2; ++kt)
#pragma unroll
                for (int i = 0; i < 16; ++i) if (kbase + 32 * kt + crow(i, h) > qidx) S[kt][i] = -1e30f;
        }
        float mx = S[0][0];
#pragma unroll
        for (int kt = 0; kt < 2; ++kt)
#pragma unroll
            for (int i = 0; i < 16; ++i) mx = fmaxf(mx, S[kt][i]);
        mx = fmaxf(mx, __shfl_xor(mx, 32));
        if (j == 0 || __builtin_amdgcn_ballot_w64(mx > 8.0f) != 0ull) {
            const float d = (j == 0) ? mx : fmaxf(mx, 0.f);
            mrun += d;
            if (j != 0) { const float alpha = fexp2(-d); lrun *= alpha;
#pragma unroll
                for (int vt = 0; vt < 4; ++vt) O[vt] = O[vt] * alpha; }
#pragma unroll
            for (int kt = 0; kt < 2; ++kt)
#pragma unroll
                for (int i = 0; i < 16; ++i) S[kt][i] -= d;
        }
        float ls = 0.f;
#pragma unroll
        for (int kt = 0; kt < 2; ++kt)
#pragma unroll
            for (int i = 0; i < 16; ++i) { const float pv = fexp2(S[kt][i]); S[kt][i] = pv; ls += pv; }
        lrun += ls;
#pragma unroll
        for (int kt = 0; kt < 2; ++kt)
#pragma unroll
            for (int s2 = 0; s2 < 2; ++s2) {
                const bf16x8 pfr = pack8(S[kt], s2);
                const LAS unsigned char* vrow = Vb + (32 * kt + 16 * s2) * VST + troff;
#pragma unroll
                for (int vt = 0; vt < 4; ++vt) { const bf16x8 vf = tr2(vrow + vt * 64, vrow + 8 * VST + vt * 64); O[vt] = MFMA32(vf, pfr, O[vt]); }
            }
        if (more) {
            LAS unsigned char* nb = lds + ((j + 1) & 1) * AT_STAGE;
#pragma unroll
            for (int i = 0; i < 4; ++i) *(LAS u32x4*)(nb + dst[i]) = pf[i];
        }
        __syncthreads();
    }
    lrun += __shfl_xor(lrun, 32);
    const float inv = frcp(lrun);
    LAS float* ex = (LAS float*)lds;
    if (mp == 1) {
        const float sc = inv * lam;
#pragma unroll
        for (int vt = 0; vt < 4; ++vt)
#pragma unroll
            for (int i = 0; i < 16; ++i) ex[(qg * 128 + 32 * vt + crow(i, h)) * 32 + r] = O[vt][i] * sc;
    }
    __syncthreads();
    if (mp == 0) {
        float sq = 0.f;
#pragma unroll
        for (int vt = 0; vt < 4; ++vt)
#pragma unroll
            for (int i = 0; i < 16; ++i) { const float o = O[vt][i] * inv - ex[(qg * 128 + 32 * vt + crow(i, h)) * 32 + r]; O[vt][i] = o; sq += o * o; }
        sq += __shfl_xor(sq, 32);
        const float rn = __builtin_amdgcn_rsqf(sq * (1.0f / 128.0f) + 1e-5f) * 0.8f;
        bf16_t* op = mixed + (rowb + q0 + 32 * qg + r) * DM + hd * 128;
#pragma unroll
        for (int vt = 0; vt < 4; ++vt)
#pragma unroll
            for (int gq = 0; gq < 4; ++gq) { const int v0 = 32 * vt + 8 * gq + 4 * h; const f32x4 wv = *(const f32x4*)(subln + v0);
                u32x2 o; o[0] = pk2(O[vt][4 * gq] * rn * wv[0], O[vt][4 * gq + 1] * rn * wv[1]); o[1] = pk2(O[vt][4 * gq + 2] * rn * wv[2], O[vt][4 * gq + 3] * rn * wv[3]);
                *(u32x2*)(op + v0) = o; }
    }
    __syncthreads();
}

constexpr int SB_K = 0, SB_V = 64 * KST, SB_STAGE = 64 * KST + 64 * VST64;
DI void sb_tile(const LAS unsigned char* base, int kbase, int qidx, const bf16x8 (&qf)[4], f32x16 (&O)[2], float& carry, int r, int h, int troff) {
#pragma unroll
    for (int kt = 1; kt >= 0; --kt) {
        f32x16 S = zero16();
#pragma unroll
        for (int s = 0; s < 4; ++s) { const bf16x8 kf = *(const LAS bf16x8*)(base + SB_K + (32 * kt + r) * KST + (16 * s + 8 * h) * 2); S = MFMA32(kf, qf[s], S); }
        float T[4], sfx[16];
#pragma unroll
        for (int gq = 0; gq < 4; ++gq) {
            float run = 1.0f;
#pragma unroll
            for (int jj = 3; jj >= 0; --jj) {
                const int i = 4 * gq + jj; const bool valid = (kbase + 32 * kt + crow(i, h)) < qidx;
                const float zz = fmaxf(S[i], -60.0f); const float e = fexp2(-LOG2E * zz); const float sg = frcp(1.0f + e);
                const float keep = valid ? e * sg : 1.0f;
                S[i] = valid ? sg : 0.0f; sfx[i] = run; run *= keep;
            }
            T[gq] = run;
        }
        float To[4];
#pragma unroll
        for (int gq = 0; gq < 4; ++gq) To[gq] = __shfl_xor(T[gq], 32);
        float E[4]; float acc_hi = 1.0f;
#pragma unroll
        for (int gq = 3; gq >= 0; --gq) { const float above_same = acc_hi; E[gq] = (h == 0) ? above_same * To[gq] : above_same; acc_hi = acc_hi * T[gq] * To[gq]; }
#pragma unroll
        for (int i = 0; i < 16; ++i) S[i] = S[i] * carry * E[i >> 2] * sfx[i];
        carry *= acc_hi;
#pragma unroll
        for (int s2 = 0; s2 < 2; ++s2) {
            const bf16x8 pfr = pack8(S, s2);
            const LAS unsigned char* vrow = base + SB_V + (32 * kt + 16 * s2) * VST64 + troff;
#pragma unroll
            for (int vt = 0; vt < 2; ++vt) { const bf16x8 vf = tr2(vrow + vt * 64, vrow + 8 * VST64 + vt * 64); O[vt] = MFMA32(vf, pfr, O[vt]); }
        }
    }
}
DI void sb_block(LAS unsigned char* lds, const bf16_t* proj, bf16_t* mixed, int b, int hs, int qb) {
    const int tid = otid(), w = __builtin_amdgcn_readfirstlane(tid >> 6), lane = tid & 63, r = lane & 31, h = lane >> 5;
    const int q0 = qb * 256; const size_t rowb = (size_t)b * SEQ;
    const int qidx = q0 + 32 * w + r;
    bf16x8 qf[4];
    { const bf16_t* qp = proj + (rowb + qidx) * AINW + 1536 + hs * 64 + 8 * h;
#pragma unroll
      for (int s = 0; s < 4; ++s) qf[s] = *(const bf16x8*)(qp + 16 * s); }
    f32x16 O[2]; O[0] = zero16(); O[1] = zero16();
    float carry = 1.0f;
    const int jmax = 4 * qb + 3;
    const int srow = tid >> 3, sc8 = tid & 7;
    const bf16_t* srcK = proj + (rowb + srow) * AINW + 2048 + hs * 64 + sc8 * 8;
    const bf16_t* srcV = proj + (rowb + srow) * AINW + 2560 + hs * 64 + sc8 * 8;
    const int dstK = SB_K + srow * KST + sc8 * 16, dstV = SB_V + srow * VST64 + sc8 * 16;
    constexpr int NPRE = 6;
    {
        u32x4 pk_[NPRE], pv_[NPRE];
#pragma unroll
        for (int s = 0; s < NPRE; ++s) { const int jj = (jmax - s) > 0 ? (jmax - s) : 0; pk_[s] = *(const u32x4*)(srcK + (size_t)jj * 64 * AINW); pv_[s] = *(const u32x4*)(srcV + (size_t)jj * 64 * AINW); }
#pragma unroll
        for (int s = 0; s < NPRE; ++s) { *(LAS u32x4*)(lds + s * SB_STAGE + dstK) = pk_[s]; *(LAS u32x4*)(lds + s * SB_STAGE + dstV) = pv_[s]; }
    }
    __syncthreads();
    const int i16 = lane & 15, tq = i16 >> 2, tp = i16 & 3, g16 = (lane >> 4) & 1;
    const int troff = (4 * h + tq) * VST64 + (16 * g16 + 4 * tp) * 2;
    bool wdone = false;
    int j = (q0 + 32 * w + 31) >> 6;
    for (; j >= 0 && j > jmax - NPRE; --j) {
        sb_tile(lds + (jmax - j) * SB_STAGE, 64 * j, qidx, qf, O, carry, r, h, troff);
        if (__builtin_amdgcn_ballot_w64(carry >= 1e-12f) == 0ull) { wdone = true; break; }
    }
    if (j < 0) wdone = true;
    for (int jj = jmax - NPRE, it = 0; ; --jj, ++it) {
        LAS int* flg = (LAS int*)(lds + NPRE * SB_STAGE) + (it & 1) * 8;
        if (lane == 0) flg[w] = wdone ? 1 : 0;
        __syncthreads();
        int all = 1;
#pragma unroll
        for (int ww = 0; ww < 8; ++ww) all &= flg[ww];
        if (all || jj < 0) break;
        const u32x4 a_ = *(const u32x4*)(srcK + (size_t)jj * 64 * AINW), b_ = *(const u32x4*)(srcV + (size_t)jj * 64 * AINW);
        *(LAS u32x4*)(lds + dstK) = a_; *(LAS u32x4*)(lds + dstV) = b_;
        __syncthreads();
        if (!wdone) { sb_tile(lds, 64 * jj, qidx, qf, O, carry, r, h, troff); if (__builtin_amdgcn_ballot_w64(carry >= 1e-12f) == 0ull || jj == 0) wdone = true; }
    }
    bf16_t* op = mixed + (rowb + qidx) * DM + 512 + hs * 64;
#pragma unroll
    for (int vt = 0; vt < 2; ++vt)
#pragma unroll
        for (int gq = 0; gq < 4; ++gq) { const int v0 = 32 * vt + 8 * gq + 4 * h;
            u32x2 o; o[0] = pk2(O[vt][4 * gq], O[vt][4 * gq + 1]); o[1] = pk2(O[vt][4 * gq + 2], O[vt][4 * gq + 3]); *(u32x2*)(op + v0) = o; }
    __syncthreads();
}
DI void attn_phase(LAS unsigned char* lds, const Params& p) {
    const bf16_t* proj = (const bf16_t*)(p.ws + O_PROJ); bf16_t* mixed = (bf16_t*)(p.ws + O_MIXED);
    const float lam = *(const float*)(p.ws + O_LAM);
    for (int it0 = blockIdx.x; it0 < 256; it0 += gridDim.x) {
        const int it = (it0 & 7) * 32 + (it0 >> 3);
        const int b = it >> 7, hd = (it >> 5) & 3, pr = it & 31;
        diff_tile(lds, proj, mixed, p.in[7], lam, b, hd, 63 - pr);
        diff_tile(lds, proj, mixed, p.in[7], lam, b, hd, pr);
    }
    for (int it0 = blockIdx.x; it0 < 512; it0 += gridDim.x) {
        const int it = (it0 & 7) * 64 + (it0 >> 3);
        const int b = it >> 8, hs = (it >> 5) & 7, qb = it & 31;
        sb_block(lds, proj, mixed, b, hs, qb);
    }
}
constexpr int SXS = 528, SXS2 = 576, SBS = 272, SBS2 = 320;
constexpr int L_SX = 0, L_SB = 128 * SXS2, L_SC = L_SB + 128 * SBS, L_SDT = L_SC + 128 * SBS, L_SAC = L_SDT + 2048, L_SSQ = L_SAC + 2048;
static_assert(L_SSQ + 4096 <= LDS_BYTES, "lds");

DI void ssd_dt_acum(LAS unsigned char* lds, const float* DT, const float* dt_bias, const float* a_log, size_t t0, int g) {
    LAS float* sdt = (LAS float*)(lds + L_SDT); LAS float* sac = (LAS float*)(lds + L_SAC);
    const int tid = otid(), hh = tid >> 7, l = tid & 127, head = 4 * g + hh, w = tid >> 6, lane = tid & 63;
    const float raw = DT[(t0 + l) * 32 + head] + dt_bias[head];
    const float dt = fmaxf(raw, 0.f) + __logf(1.0f + __expf(-fabsf(raw)));
    sdt[hh * 128 + l] = dt; sac[hh * 128 + l] = -dt * __expf(a_log[head]);
    __syncthreads();
    if (w < 4) {
        const float v0 = sac[w * 128 + 2 * lane], v1 = sac[w * 128 + 2 * lane + 1]; float s = v0 + v1;
#pragma unroll
        for (int off = 1; off < 64; off <<= 1) { const float t = __shfl_up(s, off); if (lane >= off) s += t; }
        const float ex = s - (v0 + v1);
        sac[w * 128 + 2 * lane] = ex + v0; sac[w * 128 + 2 * lane + 1] = ex + v0 + v1;
    }
    __syncthreads();
}
template <int NT, class F> DI void conv_strip(const bf16_t* src, int nzero, const float* cw, const float* cb, int ch, F&& emit) {
    f32x4 wlo[4], whi[4];
#pragma unroll
    for (int k = 0; k < 4; ++k) { wlo[k] = *(const f32x4*)(cw + k * XBCW + ch); whi[k] = *(const f32x4*)(cw + k * XBCW + ch + 4); }
    const f32x4 blo = *(const f32x4*)(cb + ch), bhi = *(const f32x4*)(cb + ch + 4);
    u32x4 raw[NT + 3];
#pragma unroll
    for (int i = 0; i < NT + 3; ++i) { const int ii = (i < nzero) ? nzero : i; raw[i] = *(const u32x4*)(src + (ptrdiff_t)(ii - 3) * XBCW); if (i < nzero) raw[i] = (u32x4){0u, 0u, 0u, 0u}; }
#pragma unroll
    for (int t = 0; t < NT; ++t) {
        float o[8];
#pragma unroll
        for (int e = 0; e < 8; ++e) {
            float a = (e < 4) ? blo[e & 3] : bhi[e & 3];
#pragma unroll
            for (int k = 0; k < 4; ++k) { const unsigned d = raw[t + k][e >> 1]; const float xv = (e & 1) ? bfhi(d) : bflo(d); a += ((e < 4) ? wlo[k][e & 3] : whi[k][e & 3]) * xv; }
            o[e] = fsilu(a);
        }
        emit(t, o);
    }
}
DI u32x4 pack8f(const float* o) { u32x4 r; r[0] = pk2(o[0], o[1]); r[1] = pk2(o[2], o[3]); r[2] = pk2(o[4], o[5]); r[3] = pk2(o[6], o[7]); return r; }

template <bool XW, bool WITH_C> DI void ssd_stage(LAS unsigned char* lds, const bf16_t* xbc, const float* cw, const float* cb, size_t t0, int c, int g) {
    const int tid = otid();
    LAS float* sdt = (LAS float*)(lds + L_SDT); LAS float* sac = (LAS float*)(lds + L_SAC);
    {
        const int c8 = tid & 31, tg = tid >> 5, l0 = 8 * tg, ch = 256 * g + 8 * c8, hh = c8 >> 3;
        const int nzero = (c == 0) ? (3 - l0 > 0 ? 3 - l0 : 0) : 0;
        const float alast = sac[hh * 128 + 127];
        conv_strip<8>(xbc + (t0 + l0) * XBCW + ch, nzero, cw, cb, ch, [&](int t, float* o) {
            if (XW) { const float wgt = sdt[hh * 128 + l0 + t] * __expf(alast - sac[hh * 128 + l0 + t]);
#pragma unroll
                for (int e = 0; e < 8; ++e) o[e] *= wgt; }
            *(LAS u32x4*)(lds + L_SX + (l0 + t) * (XW ? SXS2 : SXS) + c8 * 16) = pack8f(o); });
    }
    {
        const int c8 = tid & 15, tg = tid >> 4, l0 = 4 * tg;
        const int nzero = (c == 0) ? (3 - l0 > 0 ? 3 - l0 : 0) : 0;
        const int chb = DIN + 128 * g + 8 * c8;
        conv_strip<4>(xbc + (t0 + l0) * XBCW + chb, nzero, cw, cb, chb, [&](int t, float* o) { *(LAS u32x4*)(lds + L_SB + (l0 + t) * (XW ? SBS2 : SBS) + c8 * 16) = pack8f(o); });
        if (WITH_C) { const int chc = DIN + 1024 + 128 * g + 8 * c8;
            conv_strip<4>(xbc + (t0 + l0) * XBCW + chc, nzero, cw, cb, chc, [&](int t, float* o) { *(LAS u32x4*)(lds + L_SC + (l0 + t) * SBS + c8 * 16) = pack8f(o); }); }
    }
}
DI bf16_t* st_ptr(unsigned char* ws, int b) { return (bf16_t*)(ws + (b ? O_ST1 : O_ST0)); }

DI void ssd_states_phase(LAS unsigned char* lds, const Params& p) {
    const int tid = otid(), w = __builtin_amdgcn_readfirstlane(tid >> 6), lane = tid & 63, r = lane & 31, h = lane >> 5, hh = w >> 1, ph = w & 1;
    const bf16_t* xbc = (const bf16_t*)(p.ws + O_XBC); const float* DT = (const float*)(p.ws + O_DT); float* cdec = (float*)(p.ws + O_CDEC);
    const int i16 = lane & 15, tq = i16 >> 2, tp = i16 & 3, g16 = (lane >> 4) & 1;
    for (int it = blockIdx.x; it < 1024; it += gridDim.x) {
        const int b = it >> 9, c = (it >> 3) & 63, g = it & 7; const size_t t0 = (size_t)b * SEQ + (size_t)c * 128;
        ssd_dt_acum(lds, DT, p.in[13], p.in[14], t0, g);
        ssd_stage<true, false>(lds, xbc, p.in[11], p.in[12], t0, c, g);
        __syncthreads();
        f32x16 acc[4];
#pragma unroll
        for (int i = 0; i < 4; ++i) acc[i] = zero16();
        const LAS unsigned char* xa = lds + L_SX + (8 * h + tq) * SXS2 + (64 * hh + 32 * ph + 16 * g16 + 4 * tp) * 2;
        const LAS unsigned char* ba = lds + L_SB + (8 * h + tq) * SBS2 + (16 * g16 + 4 * tp) * 2;
#pragma unroll
        for (int s = 0; s < 8; ++s) {
            const bf16x8 af = tr2(xa + 16 * s * SXS2, xa + (16 * s + 4) * SXS2);
#pragma unroll
            for (int nt = 0; nt < 4; ++nt) { const bf16x8 bfr = tr2(ba + 16 * s * SBS2 + nt * 64, ba + (16 * s + 4) * SBS2 + nt * 64); acc[nt] = MFMA32(af, bfr, acc[nt]); }
        }
        bf16_t* st = st_ptr(p.ws, b) + ((size_t)(c * 32 + 4 * g + hh) * 64 + 32 * ph) * 128;
#pragma unroll
        for (int nt = 0; nt < 4; ++nt)
#pragma unroll
            for (int i = 0; i < 16; ++i) st[(size_t)crow(i, h) * 128 + 32 * nt + r] = (bf16_t)(pk2(acc[nt][i], 0.f) & 0xffffu);
        if (tid < 4) cdec[(b * 64 + c) * 32 + 4 * g + tid] = __expf(((LAS float*)(lds + L_SAC))[tid * 128 + 127]);
        __syncthreads();
    }
}
DI void ssd_scan_phase(const Params& p, const bool dry) {
    const float* cdec = (const float*)(p.ws + O_CDEC);
    for (int e = blockIdx.x * 512 + threadIdx.x; e < 2 * 32 * 64 * 32; e += gridDim.x * 512) {
        const int b = e >> 16, rem = e & 65535, head = rem >> 11;
        bf16_t* st = st_ptr(p.ws, b) + (size_t)rem * 4;
        float carry[4] = {0.f, 0.f, 0.f, 0.f};
        for (int c0 = 0; c0 < 64; c0 += 8) {
            u32x2 v[8]; float dc[8];
#pragma unroll
            for (int u = 0; u < 8; ++u) { v[u] = *(const u32x2*)(st + (size_t)(c0 + u) * 262144); dc[u] = cdec[(b * 64 + c0 + u) * 32 + head]; }
#pragma unroll
            for (int u = 0; u < 8; ++u) {
                u32x2 o; o[0] = pk2(carry[0], carry[1]); o[1] = pk2(carry[2], carry[3]); if (!dry) *(u32x2*)(st + (size_t)(c0 + u) * 262144) = o;
                carry[0] = carry[0] * dc[u] + bflo(v[u][0]); carry[1] = carry[1] * dc[u] + bfhi(v[u][0]); carry[2] = carry[2] * dc[u] + bflo(v[u][1]); carry[3] = carry[3] * dc[u] + bfhi(v[u][1]);
            }
        }
    }
}
DI void ssd_out_phase(LAS unsigned char* lds, const Params& p, const bool dry) {
    const int tid = otid(), w = __builtin_amdgcn_readfirstlane(tid >> 6), lane = tid & 63, r = lane & 31, h = lane >> 5, hh = w >> 1, ph = w & 1;
    const bf16_t* xbc = (const bf16_t*)(p.ws + O_XBC); const float* DT = (const float*)(p.ws + O_DT); bf16_t* zy = (bf16_t*)p.out;
    LAS float* sdt = (LAS float*)(lds + L_SDT); LAS float* sac = (LAS float*)(lds + L_SAC); LAS float* ssq = (LAS float*)(lds + L_SSQ);
    const int i16 = lane & 15, tq = i16 >> 2, tp = i16 & 3, g16 = (lane >> 4) & 1;
    for (int it = blockIdx.x; it < 1024; it += gridDim.x) {
        const int b = it >> 9, c = (it >> 3) & 63, g = it & 7, head = 4 * g + hh; const size_t t0 = (size_t)b * SEQ + (size_t)c * 128;
        ssd_dt_acum(lds, DT, p.in[13], p.in[14], t0, g);
        ssd_stage<false, true>(lds, xbc, p.in[11], p.in[12], t0, c, g);
        bf16x8 pvf[8];
        { const bf16_t* pp = st_ptr(p.ws, b) + ((size_t)(c * 32 + head) * 64 + 32 * ph + r) * 128 + 8 * h;
#pragma unroll
          for (int s = 0; s < 8; ++s) pvf[s] = *(const bf16x8*)(pp + 16 * s); }
        __syncthreads();
        f32x16 Y[4];
        const LAS unsigned char* xa = lds + L_SX + (4 * h + tq) * SXS + (64 * hh + 32 * ph + 16 * g16 + 4 * tp) * 2;
#pragma unroll
        for (int lt = 0; lt < 4; ++lt) {
            __builtin_amdgcn_sched_barrier(0);
            f32x16 y = zero16();
#pragma unroll
            for (int s = 0; s < 8; ++s) { const bf16x8 cfs = *(const LAS bf16x8*)(lds + L_SC + (32 * lt + r) * SBS + (16 * s + 8 * h) * 2); y = MFMA32(pvf[s], cfs, y); }
            Y[lt] = y * __expf(sac[hh * 128 + 32 * lt + r]);
        }
#pragma unroll
        for (int lt = 0; lt < 4; ++lt) {
            __builtin_amdgcn_sched_barrier(0);
            bf16x8 cf[8];
#pragma unroll
            for (int s = 0; s < 8; ++s) cf[s] = *(const LAS bf16x8*)(lds + L_SC + (32 * lt + r) * SBS + (16 * s + 8 * h) * 2);
            const float al = sac[hh * 128 + 32 * lt + r];
#pragma unroll
            for (int mt = 0; mt < 4; ++mt) {
                if (mt <= lt) {
                    __builtin_amdgcn_sched_barrier(0);
                    f32x16 X = zero16();
#pragma unroll
                    for (int s = 0; s < 8; ++s) { const bf16x8 bfr = *(const LAS bf16x8*)(lds + L_SB + (32 * mt + r) * SBS + (16 * s + 8 * h) * 2); X = MFMA32(bfr, cf[s], X); }
#pragma unroll
                    for (int gq = 0; gq < 4; ++gq) {
                        const f32x4 am = *(const LAS f32x4*)(sac + hh * 128 + 32 * mt + 8 * gq + 4 * h), dm = *(const LAS f32x4*)(sdt + hh * 128 + 32 * mt + 8 * gq + 4 * h);
#pragma unroll
                        for (int jj = 0; jj < 4; ++jj) { const int mrow = 32 * mt + 8 * gq + 4 * h + jj; const bool ok = (32 * lt + r) >= mrow;
                            const float dec = ok ? __expf(fminf(al - am[jj], 0.f)) * dm[jj] : 0.f; X[4 * gq + jj] *= dec; }
                    }
#pragma unroll
                    for (int s2 = 0; s2 < 2; ++s2) { const bf16x8 xs = pack8(X, s2);
                        const LAS unsigned char* xr = xa + (32 * mt + 16 * s2) * SXS; const bf16x8 xf = tr2(xr, xr + 8 * SXS); Y[lt] = MFMA32(xf, xs, Y[lt]); }
                }
            }
        }
        __builtin_amdgcn_sched_barrier(0);
        const float Dh = p.in[15][head];
        float sq[4];
#pragma unroll
        for (int lt = 0; lt < 4; ++lt) {
            const int l = 32 * lt + r; sq[lt] = 0.f;
#pragma unroll
            for (int gq = 0; gq < 4; ++gq) {
                const int chl = 64 * hh + 32 * ph + 8 * gq + 4 * h;
                const u32x2 xv = *(const LAS u32x2*)(lds + L_SX + l * SXS + chl * 2);
                const u32x2 zv = *(const u32x2*)(zy + (t0 + l) * DIN + 256 * g + chl);
                const float xf4[4] = {bflo(xv[0]), bfhi(xv[0]), bflo(xv[1]), bfhi(xv[1])}, zf4[4] = {bflo(zv[0]), bfhi(zv[0]), bflo(zv[1]), bfhi(zv[1])};
#pragma unroll
                for (int jj = 0; jj < 4; ++jj) { const float yv = (Y[lt][4 * gq + jj] + Dh * xf4[jj]) * fsilu(zf4[jj]); Y[lt][4 * gq + jj] = yv; sq[lt] += yv * yv; }
            }
            sq[lt] += __shfl_xor(sq[lt], 32);
            if (h == 0) ssq[w * 128 + l] = sq[lt];
        }
        __syncthreads();
#pragma unroll
        for (int lt = 0; lt < 4; ++lt) {
            const int l = 32 * lt + r; float tot = 0.f;
#pragma unroll
            for (int ww = 0; ww < 8; ++ww) tot += ssq[ww * 128 + l];
            const float rn = __builtin_amdgcn_rsqf(tot * (1.0f / 256.0f) + 1e-5f);
#pragma unroll
            for (int gq = 0; gq < 4; ++gq) {
                const int chl = 64 * hh + 32 * ph + 8 * gq + 4 * h; const f32x4 gw = *(const f32x4*)(p.in[16] + 256 * g + chl);
                u32x2 o; o[0] = pk2(Y[lt][4 * gq] * rn * gw[0], Y[lt][4 * gq + 1] * rn * gw[1]); o[1] = pk2(Y[lt][4 * gq + 2] * rn * gw[2], Y[lt][4 * gq + 3] * rn * gw[3]);
                if (!dry) *(u32x2*)(zy + (t0 + l) * DIN + 256 * g + chl) = o;
            }
        }
        __syncthreads();
    }
}
DI void dt_proj(LAS unsigned char* lds, const Params& p) {
    const int tid = otid(), w = __builtin_amdgcn_readfirstlane(tid >> 6), lane = tid & 63, r = lane & 31, h = lane >> 5, rt = w & 1, kq = w >> 1;
    const bf16_t* hb = (const bf16_t*)(p.ws + O_HB); const bf16_t* wt = (const bf16_t*)(p.ws + W_SIN) + (size_t)6144 * DM;
    const float* ss = (const float*)(p.ws + O_SS) + 2 * MT; float* dt = (float*)(p.ws + O_DT);
    LAS float* part = (LAS float*)lds;
    for (int rb = blockIdx.x; rb < MT / 64; rb += gridDim.x) {
        const bf16_t* ap = hb + (size_t)(rb * 64 + rt * 32 + r) * DM + kq * 256 + 8 * h;
        const bf16_t* bp = wt + (size_t)r * DM + kq * 256 + 8 * h;
        bf16x8 af[16], bfr[16];
#pragma unroll
        for (int s = 0; s < 16; ++s) { af[s] = *(const bf16x8*)(ap + 16 * s); bfr[s] = *(const bf16x8*)(bp + 16 * s); }
        f32x16 acc = zero16();
#pragma unroll
        for (int s = 0; s < 16; ++s) acc = MFMA32(af[s], bfr[s], acc);
#pragma unroll
        for (int i = 0; i < 16; ++i) part[((kq * 2 + rt) * 32 + crow(i, h)) * 32 + r] = acc[i];
        __syncthreads();
#pragma unroll
        for (int q = 0; q < 4; ++q) {
            const int o = tid + 512 * q, row = o >> 5, col = o & 31;
            float v = 0.f;
#pragma unroll
            for (int k = 0; k < 4; ++k) v += part[((k * 2 + (row >> 5)) * 32 + (row & 31)) * 32 + col];
            const int grow = rb * 64 + row;
            dt[(size_t)grow * 32 + col] = v * __builtin_amdgcn_rsqf(ss[grow] * (1.0f / 1024.0f) + 1e-6f);
        }
        __syncthreads();
    }
}
template <class Epi> DI void run_gemm(LAS unsigned char* lds, const bf16_t* A, const bf16_t* Bt, int N, int K, const Epi& E) {
    pg8::Gemm g; g.A = A; g.Bt = Bt; g.M = MT; g.N = N; g.K = K;
    pg8::StaticOrder S; S.init(MT, N, (int)gridDim.x, (int)blockIdx.x);
    pg8::gemm_phase<Epi, pg8::StaticOrder, !Epi::AFTER_DRAIN, true>((PG8_LAS unsigned char*)lds, g, S, E);
}
#if defined(DRY_S3) || defined(DRY_S4)
#define DRYV (p.ws == nullptr)
#else
#define DRYV false
#endif
__global__ void __launch_bounds__(512, 2) fwd_megakernel(Params p) {
    extern __shared__ __attribute__((aligned(16))) unsigned char shm[];
    LAS unsigned char* lds = (LAS unsigned char*)shm;
    cg::grid_group grid = cg::this_grid();
    if (threadIdx.x < 4) ((LAS unsigned*)(lds + LDS_BYTES - 16))[threadIdx.x] = 0u;
    __syncthreads();
    const XcdBarrier xbar = xcd_barrier_post((unsigned*)(p.ws + O_BAR), (volatile LAS unsigned*)(lds + LDS_BYTES - 16));
#define GBAR() xcd_barrier(xbar)
    unsigned char* ws = p.ws;
    bf16_t* hb = (bf16_t*)(ws + O_HB); float* ss = (float*)(ws + O_SS);
    phase0(lds, p);
#ifdef DUP_P0
    GBAR(); phase0(lds, p);
#endif
    if (gridDim.x == 0x7fffffffu) grid.sync();
    GBAR();
    { EpiAttnIn E; E.O = (bf16_t*)(ws + O_PROJ); E.ss = ss; E.tab = (const f32x4*)(ws + O_ROPE); run_gemm(lds, hb, (const bf16_t*)(ws + W_AIN), AINW, DM, E); }
    GBAR();
    attn_phase(lds, p);
#ifdef DUP_ATTN
    GBAR(); attn_phase(lds, p);
#endif
    GBAR();
    { EpiRes<true, false> E; E.xres = p.in[0]; E.hb = hb; E.outf = nullptr; E.ssn = ss + MT; run_gemm(lds, (const bf16_t*)(ws + O_MIXED), (const bf16_t*)(ws + W_AOUT), DM, DM, E); }
    GBAR();
    { EpiGU E; E.act = (bf16_t*)(ws + O_ACT); E.ss = ss + MT; run_gemm(lds, hb, (const bf16_t*)(ws + W_GU0), 2 * DFF, DM, E); }
    GBAR();
    { EpiRes<false, false> E; E.xres = nullptr; E.hb = hb; E.outf = nullptr; E.ssn = ss + 2 * MT; run_gemm(lds, (const bf16_t*)(ws + O_ACT), (const bf16_t*)(ws + W_DN0), DM, DFF, E); }
    GBAR();
    { EpiSsdIn E; E.z = (bf16_t*)p.out; E.xbc = (bf16_t*)(ws + O_XBC); E.dt = (float*)(ws + O_DT); E.ss = ss + 2 * MT; dt_proj(lds, p); run_gemm(lds, hb, (const bf16_t*)(ws + W_SIN), 6144, DM, E); }
    GBAR();
    ssd_states_phase(lds, p);
#ifdef DUP_S2
    GBAR(); ssd_states_phase(lds, p);
#endif
    GBAR();
#ifdef DRY_S3
    ssd_scan_phase(p, p.ws != nullptr); GBAR();
#endif
    ssd_scan_phase(p, DRYV);
    GBAR();
#ifdef DRY_S4
    ssd_out_phase(lds, p, p.ws != nullptr); GBAR();
#endif
    ssd_out_phase(lds, p, DRYV);
    GBAR();
    { EpiRes<false, false> E; E.xres = nullptr; E.hb = hb; E.outf = nullptr; E.ssn = ss + 3 * MT; run_gemm(lds, (const bf16_t*)p.out, (const bf16_t*)(ws + W_SOUT), DM, DIN, E); }
    GBAR();
    { EpiGU E; E.act = (bf16_t*)(ws + O_ACT); E.ss = ss + 3 * MT; run_gemm(lds, hb, (const bf16_t*)(ws + W_GU1), 2 * DFF, DM, E); }
    GBAR();
    if (gridDim.x == 256) {
        EpiFinal E; E.hb = hb; E.outf = p.out; E.ssn = ss + 4 * MT; E.cnt = (unsigned*)(ws + O_BAR) + XCD_BAR_WORDS; E.fw = p.in[22];
        run_gemm(lds, (const bf16_t*)(ws + O_ACT), (const bf16_t*)(ws + W_DN1), DM, DFF, E);
    } else {
        { EpiRes<false, true> E; E.xres = nullptr; E.hb = hb; E.outf = p.out; E.ssn = ss + 4 * MT; run_gemm(lds, (const bf16_t*)(ws + O_ACT), (const bf16_t*)(ws + W_DN1), DM, DFF, E); }
        GBAR();
        const float* ss4 = ss + 4 * MT; const f32x4* fw = (const f32x4*)p.in[22]; f32x4* o4 = (f32x4*)p.out;
        for (int i = blockIdx.x * 512 + threadIdx.x; i < MT * (DM / 4); i += gridDim.x * 512) {
            const int row = i >> 8; const float rs = __builtin_amdgcn_rsqf(ss4[row] * (1.0f / 1024.0f) + 1e-6f);
            o4[i] = o4[i] * rs * fw[i & 255];
        }
    }
}

extern "C" void kernel_launch(void* const* d_in, const int* in_sizes, int n_in, void* d_out, int out_size, void* d_ws, size_t ws_size, hipStream_t stream) {
    static int grid_blocks = 0;
    if (!grid_blocks) {
        int dev = 0, cus = 0, per_cu = 0;
        hipGetDevice(&dev);
        hipDeviceGetAttribute(&cus, hipDeviceAttributeMultiprocessorCount, dev);
        if (hipFuncSetAttribute((const void*)fwd_megakernel, hipFuncAttributeMaxDynamicSharedMemorySize, LDS_BYTES) != hipSuccess) fprintf(stderr, "hipFuncSetAttribute failed\n");
        if (hipOccupancyMaxActiveBlocksPerMultiprocessor(&per_cu, (const void*)fwd_megakernel, 512, LDS_BYTES) != hipSuccess || per_cu < 1) { fprintf(stderr, "occupancy query: %d\n", per_cu); per_cu = 1; }
        (void)hipGetLastError();
        grid_blocks = cus * per_cu;
        if (ws_size < 268435456ull || n_in != 23) fprintf(stderr, "unexpected ws_size %zu / n_in %d\n", ws_size, n_in);
    }
    if (hipMemsetAsync((char*)d_ws + O_BAR, 0, 20480, stream) != hipSuccess) fprintf(stderr, "memset failed\n");
    Params p{};
    for (int i = 0; i < 23; ++i) p.in[i] = (const float*)d_in[i];
    p.out = (float*)d_out; p.ws = (unsigned char*)d_ws;
    void* args[] = {&p};
    hipError_t e = hipLaunchCooperativeKernel((const void*)fwd_megakernel, dim3(grid_blocks), dim3(512), args, LDS_BYTES, stream);
    if (e != hipSuccess) fprintf(stderr, "cooperative launch failed: %s (grid %d)\n", hipGetErrorString(e), grid_blocks);
}
#ifdef PHASE_TEST
__global__ void __launch_bounds__(512, 2) t_phase0(Params p) { extern __shared__ __attribute__((aligned(16))) unsigned char shm[]; phase0((LAS unsigned char*)shm, p); }
__global__ void __launch_bounds__(512, 2) t_attn_diff(Params p) { extern __shared__ __attribute__((aligned(16))) unsigned char shm[]; diff_tile((LAS unsigned char*)shm, (const bf16_t*)(p.ws + O_PROJ), (bf16_t*)(p.ws + O_MIXED), p.in[7], 0.3f, blockIdx.x & 1, blockIdx.y, blockIdx.z); }
__global__ void __launch_bounds__(512, 2) t_attn_sb(Params p) { extern __shared__ __attribute__((aligned(16))) unsigned char shm[]; sb_block((LAS unsigned char*)shm, (const bf16_t*)(p.ws + O_PROJ), (bf16_t*)(p.ws + O_MIXED), blockIdx.x & 1, blockIdx.y, blockIdx.z); }
__global__ void __launch_bounds__(512, 2) t_ssd_states(Params p) { extern __shared__ __attribute__((aligned(16))) unsigned char shm[]; ssd_states_phase((LAS unsigned char*)shm, p); }
__global__ void __launch_bounds__(512, 2) t_ssd_scan(Params p) { ssd_scan_phase(p, false); }
__global__ void __launch_bounds__(512, 2) t_ssd_out(Params p) { extern __shared__ __attribute__((aligned(16))) unsigned char shm[]; ssd_out_phase((LAS unsigned char*)shm, p, false); }
__global__ void __launch_bounds__(512, 2) t_gemm_ain(Params p) { extern __shared__ __attribute__((aligned(16))) unsigned char shm[]; EpiAttnIn E; E.O = (bf16_t*)(p.ws + O_PROJ); E.ss = (float*)(p.ws + O_SS); E.tab = (const f32x4*)(p.ws + O_ROPE); run_gemm((LAS unsigned char*)shm, (bf16_t*)(p.ws + O_HB), (const bf16_t*)(p.ws + W_AIN), AINW, DM, E); }
__global__ void __launch_bounds__(512, 2) t_gemm_res(Params p) { extern __shared__ __attribute__((aligned(16))) unsigned char shm[]; EpiRes<false, false> E; E.xres = nullptr; E.hb = (bf16_t*)(p.ws + O_HB); E.outf = nullptr; E.ssn = (float*)(p.ws + O_SS); run_gemm((LAS unsigned char*)shm, (bf16_t*)(p.ws + O_ACT), (const bf16_t*)(p.ws + W_DN0), DM, DFF, E); }
__global__ void __launch_bounds__(512, 2) t_gemm_gu(Params p) { extern __shared__ __attribute__((aligned(16))) unsigned char shm[]; EpiGU E; E.act = (bf16_t*)(p.ws + O_ACT); E.ss = (float*)(p.ws + O_SS); run_gemm((LAS unsigned char*)shm, (bf16_t*)(p.ws + O_HB), (const bf16_t*)(p.ws + W_GU0), 2 * DFF, DM, E); }
__global__ void __launch_bounds__(512, 2) t_gemm_ssdin(Params p) { extern __shared__ __attribute__((aligned(16))) unsigned char shm[]; EpiSsdIn E; E.z = (bf16_t*)p.out; E.xbc = (bf16_t*)(p.ws + O_XBC); E.dt = (float*)(p.ws + O_DT); E.ss = (float*)(p.ws + O_SS); run_gemm((LAS unsigned char*)shm, (bf16_t*)(p.ws + O_HB), (const bf16_t*)(p.ws + W_SIN), SINWP, DM, E); }
#endif
```

```cpp
#include <hip/hip_runtime.h>
#include <hip/hip_cooperative_groups.h>
#include <cstdio>
#include <cstdint>
namespace cg = cooperative_groups;
namespace pg8 {
#define PG8_LAS __attribute__((address_space(3)))
typedef unsigned short bf16_t;
typedef short bf16x8 __attribute__((ext_vector_type(8)));
typedef float f32x4 __attribute__((ext_vector_type(4)));
typedef unsigned u32x4 __attribute__((ext_vector_type(4)));
constexpr int BM = 256, BK = 64, HALF = 128, HTB = HALF * BK * 2  , STAGE_BYTES = 8 * HTB, NXCD = 8, WGM = 8;

__host__ __device__ __forceinline__ int lds_byte(int r, int c) { const int st = (r >> 4) * 2 + (c >> 5), rr = r & 15, cc = c & 31, ob = rr * 64 + cc * 2; return st * 1024 + (ob ^ (((ob >> 9) & 1) << 5)); }
__host__ __device__ __forceinline__ void stage_rc(int b, int& R, int& C) { const int st = b / 1024, sb = b % 1024, swz = sb ^ (((sb >> 9) & 1) << 5); R = (st >> 1) * 16 + swz / 64; C = (st & 1) * 32 + (swz % 64) / 2; }
__host__ __device__ __forceinline__ int perm32(int rho) { const int n = rho >> 4, i = rho & 15; return 8 * (i >> 2) + 4 * n + (i & 3); }

struct Unit { int pm, pn; };
struct Gemm { const bf16_t* A; const bf16_t* Bt; int M, N, K; };

struct StaticOrder {
    int nM, nN, nwg, G, c;
    __host__ __device__ void init(int M, int N, int G_, int c_) { nM = M / BM; nN = N / BM; nwg = nM * nN; G = G_; c = c_; }
    __host__ __device__ bool next(int i, Unit& u) const {
        const long L = (long)i * G + c; if (L >= nwg) return false;
        int wgid = (int)L; { const int q = nwg / NXCD, r = nwg % NXCD, xcd = wgid % NXCD, off = wgid / NXCD; wgid = (xcd < r ? xcd * (q + 1) : r * (q + 1) + (xcd - r) * q) + off; }
        const int nig = WGM * nN, gid = wgid / nig, fm = gid * WGM, gsz = (nM - fm) < WGM ? (nM - fm) : WGM;
        u.pm = fm + ((wgid % nig) % gsz); u.pn = (wgid % nig) / gsz; return true;
    }
    __device__ __forceinline__ void a_ready(const Unit&) const {}
    __device__ __forceinline__ void done(const Unit&) const {}
};

template <class Epi, class Sched, bool ALIGN_EPI = false, bool SP2 = false>
__device__ __forceinline__ void gemm_phase(PG8_LAS unsigned char* lds, const Gemm g, const Sched& S, const Epi& E) {
    int tid_ = threadIdx.x; asm volatile("" : "+v"(tid_)); const int tid = tid_, wid = __builtin_amdgcn_readfirstlane(tid >> 6), lane = tid & 63, wr = wid >> 2, wc = wid & 3, fr = lane & 15, fq = lane >> 4;
    const int K = g.K, nt = K / BK;
    unsigned voffA[2], voffB[2];
#pragma unroll
    for (int i = 0; i < 2; ++i) { int R, C; stage_rc(tid * 16 + i * 8192, R, C); const int Rb = Epi::PERM ? ((R & ~31) + perm32(R & 31)) : R;
        voffA[i] = (unsigned)(R * K + C) * 2u; voffB[i] = (unsigned)(Rb * K + C) * 2u; }
    const size_t kstep = (size_t)(BK * 2);
    const size_t hstep = (size_t)HALF * K * 2;
    const size_t tstep = 2 * hstep;
    const unsigned ldsw = (unsigned)wid * 1024u;
    const int aoff = lds_byte(wr * 64 + fr, fq * 8), boff = lds_byte(wc * 32 + fr, fq * 8);
#define PG8_SA(b, h) (((b) * 2 + (h)) * HTB)
#define PG8_SB(b, h) ((4 + (b) * 2 + (h)) * HTB)
#define PG8_STAGE(bufoff, gbase, voff) do { _Pragma("unroll") for (int _i = 0; _i < 2; ++_i) \
        __builtin_amdgcn_global_load_lds((const unsigned*)((const char*)(gbase) + (voff)[_i]), (PG8_LAS unsigned*)(lds + (bufoff) + ldsw + _i * 8192), 16, 0, 0); } while (0)
#define PG8_LDA(dst, b, h) do { _Pragma("unroll") for (int m = 0; m < 4; ++m) _Pragma("unroll") for (int k = 0; k < 2; ++k) dst[m][k] = *(const PG8_LAS bf16x8*)(lds + PG8_SA(b, h) + aoff + m * 2048 + k * 1024); } while (0)
#define PG8_LDB(dst, b, h) do { _Pragma("unroll") for (int n = 0; n < 2; ++n) _Pragma("unroll") for (int k = 0; k < 2; ++k) dst[n][k] = *(const PG8_LAS bf16x8*)(lds + PG8_SB(b, h) + boff + n * 2048 + k * 1024); } while (0)
#define PG8_MMA(ai, bj, At, Bt) do { __builtin_amdgcn_s_setprio(1); _Pragma("unroll") for (int m = 0; m < 4; ++m) _Pragma("unroll") for (int n = 0; n < 2; ++n) _Pragma("unroll") for (int k = 0; k < 2; ++k) \
        acc[ai][bj][m][n] = __builtin_amdgcn_mfma_f32_16x16x32_bf16(Bt[n][k], At[m][k], acc[ai][bj][m][n], 0, 0, 0); __builtin_amdgcn_s_setprio(0); } while (0)
#define PG8_WAIT_V(n) asm volatile("s_waitcnt vmcnt(" #n ")" ::: "memory")
#define PG8_WAIT_L(n) asm volatile("s_waitcnt lgkmcnt(" #n ")" ::: "memory")
#define PG8_BAR __builtin_amdgcn_s_barrier()
#define PG8_SCHED __builtin_amdgcn_sched_barrier(0)
    Unit cur, nxt; int ui = 0;
    if (!S.next(0, cur)) return;
    f32x4 acc[2][2][4][2];
#pragma unroll
    for (int a = 0; a < 2; ++a)
#pragma unroll
        for (int b = 0; b < 2; ++b)
#pragma unroll
            for (int m = 0; m < 4; ++m)
#pragma unroll
                for (int n = 0; n < 2; ++n) acc[a][b][m][n] = (f32x4){0.f, 0.f, 0.f, 0.f};
    bf16x8 At[4][2], B0[2][2], B1[2][2];
    float epre[8]; E.pre(cur, wr, fr, epre);
    const char* cA = (const char*)g.A + (size_t)cur.pm * tstep; const char* cB = (const char*)g.Bt + (size_t)cur.pn * tstep;
    S.a_ready(cur);
    if constexpr (SP2) {
        PG8_STAGE(PG8_SB(0, 0), cB, voffB); PG8_STAGE(PG8_SB(0, 1), cB + hstep, voffB); PG8_STAGE(PG8_SA(0, 0), cA, voffA); PG8_STAGE(PG8_SA(0, 1), cA + hstep, voffA);
        if (wr == 1) PG8_BAR;
        PG8_WAIT_V(2); PG8_BAR;
        PG8_STAGE(PG8_SB(1, 0), cB + kstep, voffB); PG8_STAGE(PG8_SA(1, 0), cA + kstep, voffA); PG8_STAGE(PG8_SB(1, 1), cB + hstep + kstep, voffB);
        PG8_WAIT_V(6); PG8_BAR;
    } else {
        PG8_STAGE(PG8_SB(0, 0), cB, voffB); PG8_STAGE(PG8_SA(0, 0), cA, voffA); PG8_STAGE(PG8_SB(0, 1), cB + hstep, voffB); PG8_STAGE(PG8_SA(0, 1), cA + hstep, voffA);
        if (wr == 1) PG8_BAR;
        PG8_WAIT_V(4); PG8_BAR;
        PG8_STAGE(PG8_SB(1, 0), cB + kstep, voffB); PG8_STAGE(PG8_SA(1, 0), cA + kstep, voffA); PG8_STAGE(PG8_SB(1, 1), cB + hstep + kstep, voffB);
        PG8_WAIT_V(6); PG8_BAR;
    }
    for (;;) {
        const bool has_next = S.next(ui + 1, nxt);
        const char* nA = has_next ? (const char*)g.A + (size_t)nxt.pm * tstep : cA; const char* nB = has_next ? (const char*)g.Bt + (size_t)nxt.pn * tstep : cB;
        for (int t = 0; t < nt; t += 2) {
            const bool last = (t == nt - 2);
            const char* a1 = cA + (size_t)(t + 1) * kstep;
            const char* a2 = last ? nA : cA + (size_t)(t + 2) * kstep; const char* b2 = last ? nB : cB + (size_t)(t + 2) * kstep;
            const char* a3 = a2 + kstep; const char* b3 = b2 + kstep;
            if (last && has_next) S.a_ready(nxt);
            if constexpr (SP2) {
            PG8_LDB(B0, 0, 0); PG8_LDB(B1, 0, 1); PG8_SCHED; PG8_LDA(At, 0, 0); PG8_STAGE(PG8_SA(1, 1), a1 + hstep, voffA);
            PG8_WAIT_V(8); PG8_WAIT_L(0); PG8_BAR; PG8_MMA(0, 0, At, B0); PG8_MMA(0, 1, At, B1); PG8_BAR; PG8_SCHED;
            PG8_LDA(At, 0, 1); PG8_STAGE(PG8_SB(0, 0), b2, voffB); PG8_STAGE(PG8_SB(0, 1), b2 + hstep, voffB); PG8_STAGE(PG8_SA(0, 0), a2, voffA);
            PG8_WAIT_V(8); PG8_WAIT_L(0); PG8_BAR; PG8_MMA(1, 0, At, B0); PG8_MMA(1, 1, At, B1); PG8_BAR; PG8_SCHED;
            PG8_LDB(B0, 1, 0); PG8_LDB(B1, 1, 1); PG8_SCHED; PG8_LDA(At, 1, 0); PG8_STAGE(PG8_SA(0, 1), a2 + hstep, voffA);
            PG8_WAIT_V(8); PG8_WAIT_L(0); PG8_BAR; PG8_MMA(0, 0, At, B0); PG8_MMA(0, 1, At, B1); PG8_BAR; PG8_SCHED;
            PG8_LDA(At, 1, 1); PG8_STAGE(PG8_SB(1, 0), b3, voffB); PG8_STAGE(PG8_SB(1, 1), b3 + hstep, voffB); PG8_STAGE(PG8_SA(1, 0), a3, voffA);
            PG8_WAIT_V(8); PG8_WAIT_L(0); PG8_BAR; PG8_MMA(1, 0, At, B0); PG8_MMA(1, 1, At, B1); PG8_BAR; PG8_SCHED;
            } else {
            PG8_LDB(B0, 0, 0); PG8_SCHED; PG8_LDA(At, 0, 0); PG8_STAGE(PG8_SA(1, 1), a1 + hstep, voffA);
            PG8_WAIT_L(8); PG8_BAR; PG8_WAIT_L(0); PG8_MMA(0, 0, At, B0); PG8_BAR; PG8_SCHED;
            PG8_LDB(B1, 0, 1); PG8_STAGE(PG8_SB(0, 0), b2, voffB);
            PG8_BAR; PG8_WAIT_L(0); PG8_MMA(0, 1, At, B1); PG8_BAR;
            PG8_LDA(At, 0, 1); PG8_STAGE(PG8_SA(0, 0), a2, voffA);
            PG8_BAR; PG8_WAIT_L(0); PG8_MMA(1, 0, At, B0); PG8_BAR; PG8_SCHED;
            PG8_STAGE(PG8_SB(0, 1), b2 + hstep, voffB);
            PG8_WAIT_V(6); PG8_BAR; PG8_MMA(1, 1, At, B1); PG8_BAR;
            PG8_LDB(B0, 1, 0); PG8_SCHED; PG8_LDA(At, 1, 0); PG8_STAGE(PG8_SA(0, 1), a2 + hstep, voffA);
            PG8_WAIT_L(8); PG8_BAR; PG8_WAIT_L(0); PG8_MMA(0, 0, At, B0); PG8_BAR; PG8_SCHED;
            PG8_LDB(B1, 1, 1); PG8_STAGE(PG8_SB(1, 0), b3, voffB);
            PG8_BAR; PG8_WAIT_L(0); PG8_MMA(0, 1, At, B1); PG8_BAR;
            PG8_LDA(At, 1, 1); PG8_STAGE(PG8_SA(1, 0), a3, voffA);
            PG8_BAR; PG8_WAIT_L(0); PG8_MMA(1, 0, At, B0); PG8_BAR; PG8_SCHED;
            PG8_STAGE(PG8_SB(1, 1), b3 + hstep, voffB);
            PG8_WAIT_V(6); PG8_BAR; PG8_MMA(1, 1, At, B1); PG8_BAR;
            }
        }
        if constexpr (ALIGN_EPI) { if (wr == 0) PG8_BAR; }
        if constexpr (!Epi::AFTER_DRAIN) { E(acc, cur, wr, wc, fr, fq, epre); S.done(cur); }
        if (!has_next) break;
        E.pre(nxt, wr, fr, epre);
#pragma unroll
        for (int a = 0; a < 2; ++a)
#pragma unroll
            for (int b = 0; b < 2; ++b)
#pragma unroll
                for (int m = 0; m < 4; ++m)
#pragma unroll
                    for (int n = 0; n < 2; ++n) acc[a][b][m][n] = (f32x4){0.f, 0.f, 0.f, 0.f};
        cur = nxt; cA = nA; cB = nB; ++ui;
        if constexpr (ALIGN_EPI) { if (wr == 1) PG8_BAR; }
    }
    PG8_WAIT_V(0);
    if constexpr (!ALIGN_EPI) { if (wr == 0) PG8_BAR; }
    PG8_BAR;
    if constexpr (Epi::AFTER_DRAIN) { E.fused(acc, cur, wr, wc, fr, fq, lds, wid, lane); S.done(cur); }
#undef PG8_SA
#undef PG8_SB
#undef PG8_STAGE
#undef PG8_LDA
#undef PG8_LDB
#undef PG8_MMA
#undef PG8_WAIT_V
#undef PG8_WAIT_L
#undef PG8_BAR
#undef PG8_SCHED
}
}
using pg8::bf16_t; using pg8::bf16x8; using pg8::f32x4;
typedef short s16x4 __attribute__((ext_vector_type(4)));
typedef float f32x16 __attribute__((ext_vector_type(16)));
typedef float f32x2 __attribute__((ext_vector_type(2)));
typedef __bf16 bf2_t __attribute__((ext_vector_type(2)));
typedef unsigned u32x2 __attribute__((ext_vector_type(2)));
typedef unsigned u32x4 __attribute__((ext_vector_type(4)));
#define LAS __attribute__((address_space(3)))
#define DI __device__ __forceinline__
#define MFMA32(a, b, c) __builtin_amdgcn_mfma_f32_32x32x16_bf16((a), (b), (c), 0, 0, 0)

DI int otid() { int t = threadIdx.x; asm volatile("" : "+v"(t)); return t; }
DI unsigned pk2(float a, float b) { f32x2 v = {a, b}; bf2_t r = __builtin_convertvector(v, bf2_t); return __builtin_bit_cast(unsigned, r); }
DI float bflo(unsigned u) { return __uint_as_float(u << 16); }
DI float bfhi(unsigned u) { return __uint_as_float(u & 0xffff0000u); }
DI float fexp2(float x) { return __builtin_amdgcn_exp2f(x); }
DI float frcp(float x) { return __builtin_amdgcn_rcpf(x); }
DI float fsilu(float x) { return x * frcp(1.0f + fexp2(-1.44269504089f * x)); }
DI int crow(int i, int h) { return (i & 3) + 8 * (i >> 2) + 4 * h; }
DI s16x4 trr(const LAS unsigned char* p) { return __builtin_amdgcn_ds_read_tr16_b64_v4i16((LAS s16x4*)p); }
DI bf16x8 tr2(const LAS unsigned char* p0, const LAS unsigned char* p1) { s16x4 a = trr(p0), b = trr(p1); return __builtin_shufflevector(a, b, 0, 1, 2, 3, 4, 5, 6, 7); }
DI bf16x8 pack8(const f32x16& x, int s) {
    u32x4 p; p[0] = pk2(x[8 * s], x[8 * s + 1]); p[1] = pk2(x[8 * s + 2], x[8 * s + 3]); p[2] = pk2(x[8 * s + 4], x[8 * s + 5]); p[3] = pk2(x[8 * s + 6], x[8 * s + 7]);
    return __builtin_bit_cast(bf16x8, p);
}
DI f32x16 zero16() { f32x16 z; for (int i = 0; i < 16; ++i) z[i] = 0.f; return z; }

constexpr int MT = 16384, SEQ = 8192, DM = 1024, DFF = 2816, AINW = 3072, SINW = 6176, SINWP = 6400, DIN = 2048, XBCW = 4096;
constexpr float LOG2E = 1.44269504089f;
constexpr int LDS_BYTES = 155648;
constexpr size_t W_AIN = 0, W_AOUT = W_AIN + (size_t)AINW * DM * 2, W_GU0 = W_AOUT + (size_t)DM * DM * 2, W_DN0 = W_GU0 + (size_t)2 * DFF * DM * 2,
                 W_SIN = W_DN0 + (size_t)DM * DFF * 2, W_SOUT = W_SIN + (size_t)SINWP * DM * 2, W_GU1 = W_SOUT + (size_t)DM * DIN * 2, W_DN1 = W_GU1 + (size_t)2 * DFF * DM * 2,
                 O_HB = W_DN1 + (size_t)DM * DFF * 2, O_SS = O_HB + (size_t)MT * DM * 2, O_ROPE = O_SS + (size_t)5 * MT * 4, O_DT = O_ROPE + (size_t)SEQ * 32 * 8,
                 O_CDEC = O_DT + (size_t)MT * 32 * 4, O_LAM = O_CDEC + 16384, O_BAR = O_LAM + 256, O_R = 98566144;
static_assert(O_BAR + 20480 <= O_R, "map");
constexpr size_t O_PROJ = O_R, O_MIXED = O_PROJ + (size_t)MT * AINW * 2, O_ACT = O_R, O_XBC = O_R, O_ST1 = O_XBC + (size_t)MT * XBCW * 2, O_ST0 = 0;
constexpr size_t ST_BATCH = (size_t)64 * 32 * 64 * 128;
static_assert(O_ST1 + ST_BATCH * 2 <= 268435456ull, "ws");
static_assert(ST_BATCH * 2 <= W_SOUT, "st0 overlay");
static_assert(O_MIXED + (size_t)MT * DM * 2 <= 268435456ull, "ws2");

struct Params { const float* in[23]; float* out; unsigned char* ws; };
#include <cstdlib>
#include <vector>

#define XB_TMO      128
#define XB_XCNT(j)  (256  + 64 * (j))
#define XB_XSUB(j)  (1280 + 64 * (j))
#define XB_XGEN(j)  (2304 + 64 * (j))
#define XB_TOP      3328
#define XB_TOPGEN   3392
#define XCD_BAR_WORDS 3456
#define XB_SPIN_CAP (1u << 18)

__device__ __forceinline__ unsigned xb_ld(unsigned* p)              { return __hip_atomic_load(p, __ATOMIC_RELAXED, __HIP_MEMORY_SCOPE_AGENT); }
__device__ __forceinline__ unsigned xb_add(unsigned* p, unsigned v) { return __hip_atomic_fetch_add(p, v, __ATOMIC_RELAXED, __HIP_MEMORY_SCOPE_AGENT); }
__device__ __forceinline__ unsigned xb_xcc_id() { return (unsigned)__builtin_amdgcn_s_getreg((3 << 11) | 20) & 0xFu; }
#define XB_SPIN(cond, bar) do { unsigned _sp = 0; while (cond) { \
    if ((++_sp & 255u) == 0u) { if (xb_ld(&(bar)[XB_TMO])) break; if (_sp > XB_SPIN_CAP) { atomicAdd(&(bar)[XB_TMO], 1u); break; } } } } while (0)

struct XcdBarrier {
    unsigned* bar; unsigned x;
    volatile LAS unsigned* st;
};

__device__ __forceinline__ XcdBarrier xcd_barrier_post(unsigned* bar, volatile LAS unsigned* st) {
    XcdBarrier b; b.bar = bar; b.x = xb_xcc_id(); b.st = st;
    if (threadIdx.x == 0) (void)xb_add(&bar[XB_XCNT(b.x)], 1u);
    return b;
}
__device__ __forceinline__ void xcd_barrier_complete(unsigned* bar, unsigned x, unsigned& nloc, unsigned& nx) {
    const unsigned G = gridDim.x * gridDim.y * gridDim.z;
    unsigned sum, cnt, mine, sp = 0u;
    for (;;) {
        sum = 0u; cnt = 0u; mine = 0u;
#pragma unroll
        for (unsigned j = 0; j < 16; ++j) { const unsigned c = xb_ld(&bar[XB_XCNT(j)]); sum += c; cnt += (c > 0u) ? 1u : 0u; mine = (j == x) ? c : mine; }
        if (sum == G) break;
        __builtin_amdgcn_s_sleep(1);
        if ((++sp & 255u) == 0u) { if (xb_ld(&bar[XB_TMO])) break; if (sp > XB_SPIN_CAP) { atomicAdd(&bar[XB_TMO], 1u); break; } }
    }
    nloc = mine > 0u ? mine : 1u; nx = cnt > 0u ? cnt : 1u;
}

__device__ __forceinline__ void xcd_barrier(const XcdBarrier& b) {
    asm volatile("s_waitcnt vmcnt(0)" ::: "memory");
    __syncthreads();
    if (threadIdx.x == 0) {
        unsigned* bar = b.bar;
        __builtin_amdgcn_s_waitcnt(0);
        unsigned nloc = b.st[0], nx = b.st[1];
        if (nloc == 0u) { xcd_barrier_complete(bar, b.x, nloc, nx); b.st[0] = nloc; b.st[1] = nx; }
        const unsigned old = xb_add(&bar[XB_XSUB(b.x)], 1u);
        const unsigned gen = old / nloc;
        if (old + 1u == (gen + 1u) * nloc) {
            __builtin_amdgcn_fence(__ATOMIC_RELEASE, "agent");
            asm volatile("s_waitcnt vmcnt(0)" ::: "memory");
            const unsigned og = xb_add(&bar[XB_TOP], 1u);
            const unsigned tg = og / nx;
            if (og + 1u != (tg + 1u) * nx) XB_SPIN(xb_ld(&bar[XB_TOP]) < (tg + 1u) * nx, bar);
            __builtin_amdgcn_fence(__ATOMIC_ACQUIRE, "agent");
            asm volatile("s_waitcnt vmcnt(0)" ::: "memory");
        } else {
            XB_SPIN(xb_ld(&bar[XB_TOP]) < (gen + 1u) * nx, bar);
            __builtin_amdgcn_fence(__ATOMIC_ACQUIRE, "agent");
            asm volatile("s_waitcnt vmcnt(0)" ::: "memory");
        }
    }
    __syncthreads();
}
DI void wmap(int mode, int c, int& src, float& scale, int& which) {
    src = c; scale = 1.f; which = 0;
    if (mode == 0) {
        if (c < 1024) { const int base = c & ~63, cc = c & 63, g = cc >> 3, e = cc & 7; src = base + (e < 4 ? 4 * g + e : 32 + 4 * g + (e - 4)); }
        if (c < 512) scale = 0.125f * LOG2E; else if (c >= 1536 && c < 2048) scale = 0.125f;
    } else if (mode == 2) { src = 128 * (c >> 8) + (c & 127); which = (c >> 7) & 1; }
    else if (mode == 3) { if (c >= SINW) src = -1; }
}
struct WJob { int mode, K, ldw, tix; const float* W0; const float* W1; const float* ks; bf16_t* dst; };
DI WJob wjob(const Params& p, int t) {
    unsigned char* ws = p.ws;
    const int cnt[8] = {48 * 4, 16 * 4, 88 * 4, 16 * 11, 100 * 4, 16 * 8, 88 * 4, 16 * 11};
    int j = 0, tt = t;
#pragma unroll
    for (int q = 0; q < 7; ++q) if (j == q && tt >= cnt[q]) { tt -= cnt[q]; j = q + 1; }
    WJob J; J.tix = tt; J.W1 = nullptr; J.ks = nullptr;
    switch (j) {
    case 0: J.mode = 0; J.W0 = p.in[2]; J.ks = p.in[1]; J.dst = (bf16_t*)(ws + W_AIN); J.K = DM; J.ldw = AINW; break;
    case 1: J.mode = 1; J.W0 = p.in[8]; J.dst = (bf16_t*)(ws + W_AOUT); J.K = DM; J.ldw = DM; break;
    case 2: J.mode = 2; J.W0 = p.in[19]; J.W1 = p.in[20]; J.ks = p.in[18]; J.dst = (bf16_t*)(ws + W_GU0); J.K = DM; J.ldw = DFF; break;
    case 3: J.mode = 1; J.W0 = p.in[21]; J.dst = (bf16_t*)(ws + W_DN0); J.K = DFF; J.ldw = DM; break;
    case 4: J.mode = 3; J.W0 = p.in[10]; J.ks = p.in[9]; J.dst = (bf16_t*)(ws + W_SIN); J.K = DM; J.ldw = SINW; break;
    case 5: J.mode = 1; J.W0 = p.in[17]; J.dst = (bf16_t*)(ws + W_SOUT); J.K = DIN; J.ldw = DM; break;
    case 6: J.mode = 2; J.W0 = p.in[19] + (size_t)DM * DFF; J.W1 = p.in[20] + (size_t)DM * DFF; J.ks = p.in[18] + DM; J.dst = (bf16_t*)(ws + W_GU1); J.K = DM; J.ldw = DFF; break;
    default: J.mode = 1; J.W0 = p.in[21] + (size_t)DFF * DM; J.dst = (bf16_t*)(ws + W_DN1); J.K = DFF; J.ldw = DM; break;
    }
    return J;
}
DI void wtile_load(const WJob& J, int tid, float (&v)[32], float& sc, int& srcok) {
    const int nk = J.K >> 8, c0 = (J.tix / nk) * 64, k0 = (J.tix % nk) * 256, cc = tid & 63; int src, which; wmap(J.mode, c0 + cc, src, sc, which);
    const float* W = (which ? J.W1 : J.W0) + (src >= 0 ? src : 0); srcok = (src >= 0);
#pragma unroll
    for (int i = 0; i < 32; ++i) { const int kk = (tid >> 6) + 8 * i; v[i] = __builtin_nontemporal_load(W + (size_t)(k0 + kk) * J.ldw); }
}
DI void wtile_store(LAS float* tile, const WJob& J, int tid, const float (&v)[32], float sc, int srcok) {
    const int nk = J.K >> 8, c0 = (J.tix / nk) * 64, k0 = (J.tix % nk) * 256, cc = tid & 63;
#pragma unroll
    for (int i = 0; i < 32; ++i) { const int kk = (tid >> 6) + 8 * i; float x = srcok ? v[i] * sc : 0.f; if (J.ks) x *= J.ks[k0 + kk]; tile[kk * 65 + cc] = x; }
    __syncthreads();
#pragma unroll
    for (int i = 0; i < 16; ++i) {
        const int idx = tid + 512 * i, c2 = idx >> 7, k2 = (idx & 127) * 2;
        *(unsigned*)(J.dst + (size_t)(c0 + c2) * J.K + k0 + k2) = pk2(tile[k2 * 65 + c2], tile[(k2 + 1) * 65 + c2]);
    }
    __syncthreads();
}
DI void wconv_jobs(LAS unsigned char* lds, const Params& p, int wi, int nb) {
    const int tid = otid(); const int total = 48 * 4 + 16 * 4 + 2 * (88 * 4 + 16 * 11) + 100 * 4 + 16 * 8;
    if (wi >= total) return;
    WJob J = wjob(p, wi); float v[32]; float sc; int ok;
    wtile_load(J, tid, v, sc, ok);
    for (int t = wi; t < total; t += nb) {
        const bool more = (t + nb < total);
        WJob Jn = J; float vn[32]; float scn = 0.f; int okn = 0;
        if (more) { Jn = wjob(p, t + nb); wtile_load(Jn, tid, vn, scn, okn); }
        wtile_store((LAS float*)lds, J, tid, v, sc, ok);
        if (more) { J = Jn; sc = scn; ok = okn;
#pragma unroll
            for (int i = 0; i < 32; ++i) v[i] = vn[i]; }
    }
}
DI void phase0(LAS unsigned char* lds, const Params& p) {
    const int tid = otid(), G = gridDim.x, bx = blockIdx.x;
    unsigned char* ws = p.ws;
    wconv_jobs(lds, p, bx, G);
    {
        const int wave = tid >> 6, lane = tid & 63; bf16_t* hb = (bf16_t*)(ws + O_HB); float* ss = (float*)(ws + O_SS);
        for (int row0 = (bx * 8 + wave) * 2; row0 < MT; row0 += G * 16) {
            f32x4 v[2][4];
#pragma unroll
            for (int q = 0; q < 2; ++q)
#pragma unroll
                for (int i = 0; i < 4; ++i) v[q][i] = __builtin_nontemporal_load((const f32x4*)(p.in[0] + (size_t)(row0 + q) * DM + lane * 4 + 256 * i));
#pragma unroll
            for (int q = 0; q < 2; ++q) {
                float sq = 0.f;
#pragma unroll
                for (int i = 0; i < 4; ++i) { const f32x4 x = v[q][i]; sq += x[0] * x[0] + x[1] * x[1] + x[2] * x[2] + x[3] * x[3];
                    u32x2 o; o[0] = pk2(x[0], x[1]); o[1] = pk2(x[2], x[3]); *(u32x2*)(hb + (size_t)(row0 + q) * DM + lane * 4 + 256 * i) = o; }
#pragma unroll
                for (int o = 32; o >= 1; o >>= 1) sq += __shfl_xor(sq, o);
                if (lane == 0) ss[row0 + q] = sq;
            }
        }
        for (int i = bx * 512 + tid; i < 4 * MT; i += G * 512) ss[MT + i] = 0.f;
        f32x2* tab = (f32x2*)(ws + O_ROPE);
        for (int i = bx * 512 + tid; i < SEQ * 32; i += G * 512) {
            const int pos = i >> 5, f = i & 31; const float inv = fexp2(-(float)f * 0.41524101186092f); const float ang = (float)pos * inv;
            double t = (double)ang * 0.15915494309189535; t -= floor(t); const float tf = (float)t;
            f32x2 cs; cs[0] = __builtin_amdgcn_cosf(tf); cs[1] = __builtin_amdgcn_sinf(tf); tab[i] = cs;
        }
        if (bx == 0 && tid == 0) { float s1 = 0.f, s2 = 0.f; for (int i = 0; i < 64; ++i) { s1 += p.in[3][i] * p.in[4][i]; s2 += p.in[5][i] * p.in[6][i]; }
            *(float*)(ws + O_LAM) = fexp2(s1 * LOG2E) - fexp2(s2 * LOG2E) + 0.2f; }
    }
}

struct EpiAttnIn {
    static constexpr bool PERM = true, AFTER_DRAIN = false;
    bf16_t* O; const float* ss; const f32x4* tab;
    DI void pre(const pg8::Unit& u, int wr, int fr, float (&e)[8]) const {
#pragma unroll
        for (int ai = 0; ai < 2; ++ai)
#pragma unroll
            for (int m = 0; m < 4; ++m) e[ai * 4 + m] = ss[u.pm * 256 + wr * 64 + fr + ai * 128 + m * 16];
    }
    DI void operator()(const f32x4 (&acc)[2][2][4][2], const pg8::Unit& u, int wr, int wc, int fr, int fq, const float (&epre)[8]) const {
        const int row0 = u.pm * 256 + wr * 64 + fr, colt = u.pn * 256, col0 = colt + wc * 32 + 8 * fq;
        const int fb = 4 * (4 * (wc & 1) + fq);
#pragma unroll
        for (int ai = 0; ai < 2; ++ai)
#pragma unroll
            for (int m = 0; m < 4; ++m) {
                const int row = row0 + ai * 128 + m * 16; const float rs = __builtin_amdgcn_rsqf(epre[ai * 4 + m] * (1.0f / 1024.0f) + 1e-6f);
                f32x4 c01 = {1.f, 0.f, 1.f, 0.f}, c23 = {1.f, 0.f, 1.f, 0.f};
                if (colt < 1024) { const int pos = row & (SEQ - 1); c01 = tab[(pos * 32 + fb) >> 1]; c23 = tab[((pos * 32 + fb) >> 1) + 1]; }
#pragma unroll
                for (int bj = 0; bj < 2; ++bj) {
                    f32x4 v0 = acc[ai][bj][m][0] * rs, v1 = acc[ai][bj][m][1] * rs;
                    if (colt < 1024) {
                        const float cs[4] = {c01[0], c01[2], c23[0], c23[2]}, sn[4] = {c01[1], c01[3], c23[1], c23[3]};
#pragma unroll
                        for (int j = 0; j < 4; ++j) { const float t1 = v0[j], t2 = v1[j]; v0[j] = t1 * cs[j] - t2 * sn[j]; v1[j] = t2 * cs[j] + t1 * sn[j]; }
                    }
                    u32x4 o; o[0] = pk2(v0[0], v0[1]); o[1] = pk2(v0[2], v0[3]); o[2] = pk2(v1[0], v1[1]); o[3] = pk2(v1[2], v1[3]);
                    *(u32x4*)(O + (size_t)row * AINW + col0 + bj * 128) = o;
                }
            }
    }
};
template <bool RES_F32, bool OUT_F32> struct EpiRes {
    static constexpr bool PERM = true, AFTER_DRAIN = false;
    const float* xres; bf16_t* hb; float* outf; float* ssn;
    DI void pre(const pg8::Unit&, int, int, float (&)[8]) const {}
    DI void operator()(const f32x4 (&acc)[2][2][4][2], const pg8::Unit& u, int wr, int wc, int fr, int fq, const float (&epre)[8]) const {
        const int row0 = u.pm * 256 + wr * 64 + fr, col0 = u.pn * 256 + wc * 32 + 8 * fq;
#pragma unroll
        for (int ai = 0; ai < 2; ++ai)
#pragma unroll
            for (int m = 0; m < 4; ++m) {
                const int row = row0 + ai * 128 + m * 16; float sq = 0.f;
#pragma unroll
                for (int bj = 0; bj < 2; ++bj) {
                    const size_t off = (size_t)row * DM + col0 + bj * 128; f32x4 r0, r1;
                    if (RES_F32) { r0 = *(const f32x4*)(xres + off); r1 = *(const f32x4*)(xres + off + 4); }
                    else { const u32x4 t = *(const u32x4*)(hb + off); r0[0] = bflo(t[0]); r0[1] = bfhi(t[0]); r0[2] = bflo(t[1]); r0[3] = bfhi(t[1]); r1[0] = bflo(t[2]); r1[1] = bfhi(t[2]); r1[2] = bflo(t[3]); r1[3] = bfhi(t[3]); }
                    const f32x4 v0 = r0 + acc[ai][bj][m][0], v1 = r1 + acc[ai][bj][m][1];
                    sq += v0[0] * v0[0] + v0[1] * v0[1] + v0[2] * v0[2] + v0[3] * v0[3] + v1[0] * v1[0] + v1[1] * v1[1] + v1[2] * v1[2] + v1[3] * v1[3];
                    if (OUT_F32) { *(f32x4*)(outf + off) = v0; *(f32x4*)(outf + off + 4) = v1; }
                    else { u32x4 o; o[0] = pk2(v0[0], v0[1]); o[1] = pk2(v0[2], v0[3]); o[2] = pk2(v1[0], v1[1]); o[3] = pk2(v1[2], v1[3]); *(u32x4*)(hb + off) = o; }
                }
                sq += __shfl_xor(sq, 16); sq += __shfl_xor(sq, 32);
                if (fq == 0) atomicAdd(ssn + row, sq);
            }
    }
};
struct EpiGU {
    static constexpr bool PERM = true, AFTER_DRAIN = false;
    bf16_t* act; const float* ss;
    DI void pre(const pg8::Unit& u, int wr, int fr, float (&e)[8]) const {
#pragma unroll
        for (int ai = 0; ai < 2; ++ai)
#pragma unroll
            for (int m = 0; m < 4; ++m) e[ai * 4 + m] = ss[u.pm * 256 + wr * 64 + fr + ai * 128 + m * 16];
    }
    DI void operator()(const f32x4 (&acc)[2][2][4][2], const pg8::Unit& u, int wr, int wc, int fr, int fq, const float (&epre)[8]) const {
        const int row0 = u.pm * 256 + wr * 64 + fr;
#pragma unroll
        for (int ai = 0; ai < 2; ++ai)
#pragma unroll
            for (int m = 0; m < 4; ++m) {
                const int row = row0 + ai * 128 + m * 16; const float rs = __builtin_amdgcn_rsqf(epre[ai * 4 + m] * (1.0f / 1024.0f) + 1e-6f);
                u32x4 o;
#pragma unroll
                for (int n = 0; n < 2; ++n) {
                    const f32x4 g = acc[ai][0][m][n] * rs, up = acc[ai][1][m][n] * rs; float a[4];
#pragma unroll
                    for (int j = 0; j < 4; ++j) a[j] = fsilu(g[j]) * up[j];
                    o[2 * n] = pk2(a[0], a[1]); o[2 * n + 1] = pk2(a[2], a[3]);
                }
                *(u32x4*)(act + (size_t)row * DFF + u.pn * 128 + wc * 32 + 8 * fq) = o;
            }
    }
};
struct EpiSsdIn {
    static constexpr bool PERM = true, AFTER_DRAIN = false;
    bf16_t* z; bf16_t* xbc; float* dt; const float* ss;
    DI void pre(const pg8::Unit& u, int wr, int fr, float (&e)[8]) const {
#pragma unroll
        for (int ai = 0; ai < 2; ++ai)
#pragma unroll
            for (int m = 0; m < 4; ++m) e[ai * 4 + m] = ss[u.pm * 256 + wr * 64 + fr + ai * 128 + m * 16];
    }
    DI void operator()(const f32x4 (&acc)[2][2][4][2], const pg8::Unit& u, int wr, int wc, int fr, int fq, const float (&epre)[8]) const {
        const int row0 = u.pm * 256 + wr * 64 + fr, col0 = u.pn * 256 + wc * 32 + 8 * fq;
#pragma unroll
        for (int ai = 0; ai < 2; ++ai)
#pragma unroll
            for (int m = 0; m < 4; ++m) {
                const int row = row0 + ai * 128 + m * 16; const float rs = __builtin_amdgcn_rsqf(epre[ai * 4 + m] * (1.0f / 1024.0f) + 1e-6f);
#pragma unroll
                for (int bj = 0; bj < 2; ++bj) {
                    const int c = col0 + bj * 128; const f32x4 v0 = acc[ai][bj][m][0] * rs, v1 = acc[ai][bj][m][1] * rs;
                    if (c < 6144) { u32x4 o; o[0] = pk2(v0[0], v0[1]); o[1] = pk2(v0[2], v0[3]); o[2] = pk2(v1[0], v1[1]); o[3] = pk2(v1[2], v1[3]);
                        if (c < DIN) *(u32x4*)(z + (size_t)row * DIN + c) = o; else *(u32x4*)(xbc + (size_t)row * XBCW + (c - DIN)) = o; }
                }
            }
    }
};

struct EpiFinal {
    static constexpr bool PERM = true, AFTER_DRAIN = true;
    const bf16_t* hb; float* outf; float* ssn; unsigned* cnt; const float* fw;
    DI void operator()(const f32x4 (&)[2][2][4][2], const pg8::Unit&, int, int, int, int, const float (&)[8]) const {}
    DI void pre(const pg8::Unit&, int, int, float (&)[8]) const {}
    DI void fused(f32x4 (&acc)[2][2][4][2], const pg8::Unit& u, int wr, int wc, int fr, int fq, PG8_LAS unsigned char*, int, int) const {
        const int row0 = u.pm * 256 + wr * 64 + fr, col0 = u.pn * 256 + wc * 32 + 8 * fq;
#pragma unroll
        for (int ai = 0; ai < 2; ++ai)
#pragma unroll
            for (int m = 0; m < 4; ++m) {
                const int row = row0 + ai * 128 + m * 16; float sq = 0.f;
#pragma unroll
                for (int bj = 0; bj < 2; ++bj) {
                    const size_t off = (size_t)row * DM + col0 + bj * 128;
                    const u32x4 t = *(const u32x4*)(hb + off);
#pragma unroll
                    for (int n = 0; n < 2; ++n) {
                        f32x4 r; r[0] = bflo(t[2 * n]); r[1] = bfhi(t[2 * n]); r[2] = bflo(t[2 * n + 1]); r[3] = bfhi(t[2 * n + 1]);
                        const f32x4 v = r + acc[ai][bj][m][n]; acc[ai][bj][m][n] = v;
                        sq += v[0] * v[0] + v[1] * v[1] + v[2] * v[2] + v[3] * v[3];
                    }
                }
                sq += __shfl_xor(sq, 16); sq += __shfl_xor(sq, 32);
                if (fq == 0) atomicAdd(ssn + row, sq);
            }
        asm volatile("s_waitcnt vmcnt(0)" ::: "memory");
        __syncthreads();
        unsigned* c = cnt + 16 * u.pm;
        if (threadIdx.x == 0) {
            __builtin_amdgcn_fence(__ATOMIC_RELEASE, "agent"); asm volatile("s_waitcnt vmcnt(0)" ::: "memory");
            __hip_atomic_fetch_add(c, 1u, __ATOMIC_RELAXED, __HIP_MEMORY_SCOPE_AGENT);
            unsigned spins = 0;
            while (__hip_atomic_load(c, __ATOMIC_RELAXED, __HIP_MEMORY_SCOPE_AGENT) < 4u && ++spins < (1u << 22)) __builtin_amdgcn_s_sleep(2);
            __builtin_amdgcn_fence(__ATOMIC_ACQUIRE, "agent"); asm volatile("s_waitcnt vmcnt(0)" ::: "memory");
        }
        __syncthreads();
#pragma unroll
        for (int ai = 0; ai < 2; ++ai)
#pragma unroll
            for (int m = 0; m < 4; ++m) {
                const int row = row0 + ai * 128 + m * 16;
                const float rs = __builtin_amdgcn_rsqf(__hip_atomic_load(ssn + row, __ATOMIC_RELAXED, __HIP_MEMORY_SCOPE_AGENT) * (1.0f / 1024.0f) + 1e-6f);
#pragma unroll
                for (int bj = 0; bj < 2; ++bj)
#pragma unroll
                    for (int n = 0; n < 2; ++n) {
                        const int col = col0 + bj * 128 + n * 4; const f32x4 w = *(const f32x4*)(fw + col);
                        *(f32x4*)(outf + (size_t)row * DM + col) = acc[ai][bj][m][n] * rs * w;
                    }
            }
    }
};
constexpr int KST = 144, VST = 320, VST64 = 192;
constexpr int AT_K1 = 0, AT_K2 = 64 * KST, AT_V = 2 * 64 * KST, AT_STAGE = AT_V + 64 * VST;

DI void diff_tile(LAS unsigned char* lds, const bf16_t* proj, bf16_t* mixed, const float* subln, float lam, int b, int hd, int qt) {
    const int tid = otid(), w = __builtin_amdgcn_readfirstlane(tid >> 6), lane = tid & 63, qg = w & 3, mp = w >> 2, r = lane & 31, h = lane >> 5;
    const int q0 = qt * 128; const size_t rowb = (size_t)b * SEQ;
    bf16x8 qf[4];
    { const bf16_t* qp = proj + (rowb + q0 + 32 * qg + r) * AINW + hd * 128 + mp * 64 + 8 * h;
#pragma unroll
      for (int s = 0; s < 4; ++s) qf[s] = *(const bf16x8*)(qp + 16 * s); }
    f32x16 O[4];
#pragma unroll
    for (int i = 0; i < 4; ++i) O[i] = zero16();
    float mrun = 0.f, lrun = 0.f;
    const int nsteps = 2 * (qt + 1);
    const bf16_t* src[4]; int dst[4];
#pragma unroll
    for (int i = 0; i < 2; ++i) { const int cid = tid + 512 * i, row = cid >> 4, c16 = cid & 15;
        src[i] = proj + (rowb + row) * AINW + 512 + hd * 128 + c16 * 8; dst[i] = (c16 < 8 ? AT_K1 : AT_K2) + row * KST + (c16 & 7) * 16;
        src[2 + i] = proj + (rowb + row) * AINW + 1024 + hd * 128 + c16 * 8; dst[2 + i] = AT_V + row * VST + c16 * 16; }
    u32x4 pf[4];
#pragma unroll
    for (int i = 0; i < 4; ++i) pf[i] = *(const u32x4*)(src[i]);
#pragma unroll
    for (int i = 0; i < 4; ++i) *(LAS u32x4*)(lds + dst[i]) = pf[i];
    __syncthreads();
    const int i16 = lane & 15, tq = i16 >> 2, tp = i16 & 3, g16 = (lane >> 4) & 1;
    const int troff = (4 * h + tq) * VST + (16 * g16 + 4 * tp) * 2;
    for (int j = 0; j < nsteps; ++j) {
        const bool more = (j + 1 < nsteps);
        if (more) {
#pragma unroll
            for (int i = 0; i < 4; ++i) pf[i] = *(const u32x4*)(src[i] + (size_t)(j + 1) * 64 * AINW);
        }
        const LAS unsigned char* base = lds + (j & 1) * AT_STAGE;
        const LAS unsigned char* Kb = base + (mp ? AT_K2 : AT_K1);
        const LAS unsigned char* Vb = base + AT_V;
        f32x16 S[2];
        const float negm = -mrun;
#pragma unroll
        for (int kt = 0; kt < 2; ++kt) {
#pragma unroll
            for (int i = 0; i < 16; ++i) S[kt][i] = negm;
#pragma unroll
            for (int s = 0; s < 4; ++s) { const bf16x8 kf = *(const LAS bf16x8*)(Kb + (32 * kt + r) * KST + (16 * s + 8 * h) * 2); S[kt] = MFMA32(kf, qf[s], S[kt]); } }
        const int qidx = q0 + 32 * qg + r, kbase = 64 * j;
        if (kbase + 63 > q0 + 32 * qg) {
#pragma unroll
            for (int kt = 0; kt < 2; ++kt)
#pragma unroll
                for (int i = 0; i < 16; ++i) if (kbase + 32 * kt + crow(i, h) > qidx) S[kt][i] = -1e30f;
        }
        float mx = S[0][0];
#pragma unroll
        for (int kt = 0; kt < 2; ++kt)
#pragma unroll
            for (int i = 0; i < 16; ++i) mx = fmaxf(mx, S[kt][i]);
        mx = fmaxf(mx, __shfl_xor(mx, 32));
        if (j == 0 || __builtin_amdgcn_ballot_w64(mx > 8.0f) != 0ull) {
            const float d = (j == 0) ? mx : fmaxf(mx, 0.f);
            mrun += d;
            if (j != 0) { const float alpha = fexp2(-d); lrun *= alpha;
#pragma unroll
                for (int vt = 0; vt < 4; ++vt) O[vt] = O[vt] * alpha; }
#pragma unroll
            for (int kt = 0; kt < 2; ++kt)
#pragma unroll
                for (int i = 0; i < 16; ++i) S[kt][i] -= d;
        }
        float ls = 0.f;
#pragma unroll
        for (int kt = 0; kt < 2; ++kt)
#pragma unroll
            for (int i = 0; i < 16; ++i) { const float pv = fexp2(S[kt][i]); S[kt][i] = pv; ls += pv; }
        lrun += ls;
#pragma unroll
        for (int kt = 0; kt < 2; ++kt)
#pragma unroll
            for (int s2 = 0; s2 < 2; ++s2) {
                const bf16x8 pfr = pack8(S[kt], s2);
                const LAS unsigned char* vrow = Vb + (32 * kt + 16 * s2) * VST + troff;
#pragma unroll
                for (int vt = 0; vt < 4; ++vt) { const bf16x8 vf = tr2(vrow + vt * 64, vrow + 8 * VST + vt * 64); O[vt] = MFMA32(vf, pfr, O[vt]); }
            }
        if (more) {
            LAS unsigned char* nb = lds + ((j + 1) & 1) * AT_STAGE;
#pragma unroll
            for (int i = 0; i < 4; ++i) *(LAS u32x4*)(nb + dst[i]) = pf[i];
        }
        __syncthreads();
    }
    lrun += __shfl_xor(lrun, 32);
    const float inv = frcp(lrun);
    LAS float* ex = (LAS float*)lds;
    if (mp == 1) {
        const float sc = inv * lam;
#pragma unroll
        for (int vt = 0; vt < 4; ++vt)
#pragma unroll
            for (int i = 0; i < 16; ++i) ex[(qg * 128 + 32 * vt + crow(i, h)) * 32 + r] = O[vt][i] * sc;
    }
    __syncthreads();
    if (mp == 0) {
        float sq = 0.f;
#pragma unroll
        for (int vt = 0; vt < 4; ++vt)
#pragma unroll
            for (int i = 0; i < 16; ++i) { const float o = O[vt][i] * inv - ex[(qg * 128 + 32 * vt + crow(i, h)) * 32 + r]; O[vt][i] = o; sq += o * o; }
        sq += __shfl_xor(sq, 32);
        const float rn = __builtin_amdgcn_rsqf(sq * (1.0f / 128.0f) + 1e-5f) * 0.8f;
        bf16_t* op = mixed + (rowb + q0 + 32 * qg + r) * DM + hd * 128;
#pragma unroll
        for (int vt = 0; vt < 4; ++vt)
#pragma unroll
            for (int gq = 0; gq < 4; ++gq) { const int v0 = 32 * vt + 8 * gq + 4 * h; const f32x4 wv = *(const f32x4*)(subln + v0);
                u32x2 o; o[0] = pk2(O[vt][4 * gq] * rn * wv[0], O[vt][4 * gq + 1] * rn * wv[1]); o[1] = pk2(O[vt][4 * gq + 2] * rn * wv[2], O[vt][4 * gq + 3] * rn * wv[3]);
                *(u32x2*)(op + v0) = o; }
    }
    __syncthreads();
}

constexpr int SB_K = 0, SB_V = 64 * KST, SB_STAGE = 64 * KST + 64 * VST64;
DI void sb_tile(const LAS unsigned char* base, int kbase, int qidx, const bf16x8 (&qf)[4], f32x16 (&O)[2], float& carry, int r, int h, int troff) {
#pragma unroll
    for (int kt = 1; kt >= 0; --kt) {
        f32x16 S = zero16();
#pragma unroll
        for (int s = 0; s < 4; ++s) { const bf16x8 kf = *(const LAS bf16x8*)(base + SB_K + (32 * kt + r) * KST + (16 * s + 8 * h) * 2); S = MFMA32(kf, qf[s], S); }
        float T[4], sfx[16];
#pragma unroll
        for (int gq = 0; gq < 4; ++gq) {
            float run = 1.0f;
#pragma unroll
            for (int jj = 3; jj >= 0; --jj) {
                const int i = 4 * gq + jj; const bool valid = (kbase + 32 * kt + crow(i, h)) < qidx;
                const float zz = fmaxf(S[i], -60.0f); const float e = fexp2(-LOG2E * zz); const float sg = frcp(1.0f + e);
                const float keep = valid ? e * sg : 1.0f;
                S[i] = valid ? sg : 0.0f; sfx[i] = run; run *= keep;
            }
            T[gq] = run;
        }
        float To[4];
#pragma unroll
        for (int gq = 0; gq < 4; ++gq) To[gq] = __shfl_xor(T[gq], 32);
        float E[4]; float acc_hi = 1.0f;
#pragma unroll
        for (int gq = 3; gq >= 0; --gq) { const float above_same = acc_hi; E[gq] = (h == 0) ? above_same * To[gq] : above_same; acc_hi = acc_hi * T[gq] * To[gq]; }
#pragma unroll
        for (int i = 0; i < 16; ++i) S[i] = S[i] * carry * E[i >> 2] * sfx[i];
        carry *= acc_hi;
#pragma unroll
        for (int s2 = 0; s2 < 2; ++s2) {
            const bf16x8 pfr = pack8(S, s2);
            const LAS unsigned char* vrow = base + SB_V + (32 * kt + 16 * s2) * VST64 + troff;
#pragma unroll
            for (int vt = 0; vt < 2; ++vt) { const bf16x8 vf = tr2(vrow + vt * 64, vrow + 8 * VST64 + vt * 64); O[vt] = MFMA32(vf, pfr, O[vt]); }
        }
    }
}
DI void sb_block(LAS unsigned char* lds, const bf16_t* proj, bf16_t* mixed, int b, int hs, int qb) {
    const int tid = otid(), w = __builtin_amdgcn_readfirstlane(tid >> 6), lane = tid & 63, r = lane & 31, h = lane >> 5;
    const int q0 = qb * 256; const size_t rowb = (size_t)b * SEQ;
    const int qidx = q0 + 32 * w + r;
    bf16x8 qf[4];
    { const bf16_t* qp = proj + (rowb + qidx) * AINW + 1536 + hs * 64 + 8 * h;
#pragma unroll
      for (int s = 0; s < 4; ++s) qf[s] = *(const bf16x8*)(qp + 16 * s); }
    f32x16 O[2]; O[0] = zero16(); O[1] = zero16();
    float carry = 1.0f;
    const int jmax = 4 * qb + 3;
    const int srow = tid >> 3, sc8 = tid & 7;
    const bf16_t* srcK = proj + (rowb + srow) * AINW + 2048 + hs * 64 + sc8 * 8;
    const bf16_t* srcV = proj + (rowb + srow) * AINW + 2560 + hs * 64 + sc8 * 8;
    const int dstK = SB_K + srow * KST + sc8 * 16, dstV = SB_V + srow * VST64 + sc8 * 16;
    constexpr int NPRE = 6;
    {
        u32x4 pk_[NPRE], pv_[NPRE];
#pragma unroll
        for (int s = 0; s < NPRE; ++s) { const int jj = (jmax - s) > 0 ? (jmax - s) : 0; pk_[s] = *(const u32x4*)(srcK + (size_t)jj * 64 * AINW); pv_[s] = *(const u32x4*)(srcV + (size_t)jj * 64 * AINW); }
#pragma unroll
        for (int s = 0; s < NPRE; ++s) { *(LAS u32x4*)(lds + s * SB_STAGE + dstK) = pk_[s]; *(LAS u32x4*)(lds + s * SB_STAGE + dstV) = pv_[s]; }
    }
    __syncthreads();
    const int i16 = lane & 15, tq = i16 >> 2, tp = i16 & 3, g16 = (lane >> 4) & 1;
    const int troff = (4 * h + tq) * VST64 + (16 * g16 + 4 * tp) * 2;
    bool wdone = false;
    int j = (q0 + 32 * w + 31) >> 6;
    for (; j >= 0 && j > jmax - NPRE; --j) {
        sb_tile(lds + (jmax - j) * SB_STAGE, 64 * j, qidx, qf, O, carry, r, h, troff);
        if (__builtin_amdgcn_ballot_w64(carry >= 1e-12f) == 0ull) { wdone = true; break; }
    }
    if (j < 0) wdone = true;
    for (int jj = jmax - NPRE, it = 0; ; --jj, ++it) {
        LAS int* flg = (LAS int*)(lds + NPRE * SB_STAGE) + (it & 1) * 8;
        if (lane == 0) flg[w] = wdone ? 1 : 0;
        __syncthreads();
        int all = 1;
#pragma unroll
        for (int ww = 0; ww < 8; ++ww) all &= flg[ww];
        if (all || jj < 0) break;
        const u32x4 a_ = *(const u32x4*)(srcK + (size_t)jj * 64 * AINW), b_ = *(const u32x4*)(srcV + (size_t)jj * 64 * AINW);
        *(LAS u32x4*)(lds + dstK) = a_; *(LAS u32x4*)(lds + dstV) = b_;
        __syncthreads();
        if (!wdone) { sb_tile(lds, 64 * jj, qidx, qf, O, carry, r, h, troff); if (__builtin_amdgcn_ballot_w64(carry >= 1e-12f) == 0ull || jj == 0) wdone = true; }
    }
    bf16_t* op = mixed + (rowb + qidx) * DM + 512 + hs * 64;
#pragma unroll
    for (int vt = 0; vt < 2; ++vt)
#pragma unroll
        for (int gq = 0; gq < 4; ++gq) { const int v0 = 32 * vt + 8 * gq + 4 * h;
            u32x2 o; o[0] = pk2(O[vt][4 * gq], O[vt][4 * gq + 1]); o[1] = pk2(O[vt][4 * gq + 2], O[vt][4 * gq + 3]); *(u32x2*)(op + v0) = o; }
    __syncthreads();
}
DI void attn_phase(LAS unsigned char* lds, const Params& p) {
    const bf16_t* proj = (const bf16_t*)(p.ws + O_PROJ); bf16_t* mixed = (bf16_t*)(p.ws + O_MIXED);
    const float lam = *(const float*)(p.ws + O_LAM);
    for (int it0 = blockIdx.x; it0 < 256; it0 += gridDim.x) {
        const int it = (it0 & 7) * 32 + (it0 >> 3);
        const int b = it >> 7, hd = (it >> 5) & 3, pr = it & 31;
        diff_tile(lds, proj, mixed, p.in[7], lam, b, hd, 63 - pr);
        diff_tile(lds, proj, mixed, p.in[7], lam, b, hd, pr);
    }
    for (int it0 = blockIdx.x; it0 < 512; it0 += gridDim.x) {
        const int it = (it0 & 7) * 64 + (it0 >> 3);
        const int b = it >> 8, hs = (it >> 5) & 7, qb = it & 31;
        sb_block(lds, proj, mixed, b, hs, qb);
    }
}
constexpr int SXS = 528, SXS2 = 576, SBS = 272, SBS2 = 320;
constexpr int L_SX = 0, L_SB = 128 * SXS2, L_SC = L_SB + 128 * SBS, L_SDT = L_SC + 128 * SBS, L_SAC = L_SDT + 2048, L_SSQ = L_SAC + 2048;
static_assert(L_SSQ + 4096 <= LDS_BYTES, "lds");

DI void ssd_dt_acum(LAS unsigned char* lds, const float* DT, const float* dt_bias, const float* a_log, size_t t0, int g) {
    LAS float* sdt = (LAS float*)(lds + L_SDT); LAS float* sac = (LAS float*)(lds + L_SAC);
    const int tid = otid(), hh = tid >> 7, l = tid & 127, head = 4 * g + hh, w = tid >> 6, lane = tid & 63;
    const float raw = DT[(t0 + l) * 32 + head] + dt_bias[head];
    const float dt = fmaxf(raw, 0.f) + __logf(1.0f + __expf(-fabsf(raw)));
    sdt[hh * 128 + l] = dt; sac[hh * 128 + l] = -dt * __expf(a_log[head]);
    __syncthreads();
    if (w < 4) {
        const float v0 = sac[w * 128 + 2 * lane], v1 = sac[w * 128 + 2 * lane + 1]; float s = v0 + v1;
#pragma unroll
        for (int off = 1; off < 64; off <<= 1) { const float t = __shfl_up(s, off); if (lane >= off) s += t; }
        const float ex = s - (v0 + v1);
        sac[w * 128 + 2 * lane] = ex + v0; sac[w * 128 + 2 * lane + 1] = ex + v0 + v1;
    }
    __syncthreads();
}
template <int NT, class F> DI void conv_strip(const bf16_t* src, int nzero, const float* cw, const float* cb, int ch, F&& emit) {
    f32x4 wlo[4], whi[4];
#pragma unroll
    for (int k = 0; k < 4; ++k) { wlo[k] = *(const f32x4*)(cw + k * XBCW + ch); whi[k] = *(const f32x4*)(cw + k * XBCW + ch + 4); }
    const f32x4 blo = *(const f32x4*)(cb + ch), bhi = *(const f32x4*)(cb + ch + 4);
    u32x4 raw[NT + 3];
#pragma unroll
    for (int i = 0; i < NT + 3; ++i) { const int ii = (i < nzero) ? nzero : i; raw[i] = *(const u32x4*)(src + (ptrdiff_t)(ii - 3) * XBCW); if (i < nzero) raw[i] = (u32x4){0u, 0u, 0u, 0u}; }
#pragma unroll
    for (int t = 0; t < NT; ++t) {
        float o[8];
#pragma unroll
        for (int e = 0; e < 8; ++e) {
            float a = (e < 4) ? blo[e & 3] : bhi[e & 3];
#pragma unroll
            for (int k = 0; k < 4; ++k) { const unsigned d = raw[t + k][e >> 1]; const float xv = (e & 1) ? bfhi(d) : bflo(d); a += ((e < 4) ? wlo[k][e & 3] : whi[k][e & 3]) * xv; }
            o[e] = fsilu(a);
        }
        emit(t, o);
    }
}
DI u32x4 pack8f(const float* o) { u32x4 r; r[0] = pk2(o[0], o[1]); r[1] = pk2(o[2], o[3]); r[2] = pk2(o[4], o[5]); r[3] = pk2(o[6], o[7]); return r; }

template <bool XW, bool WITH_C> DI void ssd_stage(LAS unsigned char* lds, const bf16_t* xbc, const float* cw, const float* cb, size_t t0, int c, int g) {
    const int tid = otid();
    LAS float* sdt = (LAS float*)(lds + L_SDT); LAS float* sac = (LAS float*)(lds + L_SAC);
    {
        const int c8 = tid & 31, tg = tid >> 5, l0 = 8 * tg, ch = 256 * g + 8 * c8, hh = c8 >> 3;
        const int nzero = (c == 0) ? (3 - l0 > 0 ? 3 - l0 : 0) : 0;
        const float alast = sac[hh * 128 + 127];
        conv_strip<8>(xbc + (t0 + l0) * XBCW + ch, nzero, cw, cb, ch, [&](int t, float* o) {
            if (XW) { const float wgt = sdt[hh * 128 + l0 + t] * __expf(alast - sac[hh * 128 + l0 + t]);
#pragma unroll
                for (int e = 0; e < 8; ++e) o[e] *= wgt; }
            *(LAS u32x4*)(lds + L_SX + (l0 + t) * (XW ? SXS2 : SXS) + c8 * 16) = pack8f(o); });
    }
    {
        const int c8 = tid & 15, tg = tid >> 4, l0 = 4 * tg;
        const int nzero = (c == 0) ? (3 - l0 > 0 ? 3 - l0 : 0) : 0;
        const int chb = DIN + 128 * g + 8 * c8;
        conv_strip<4>(xbc + (t0 + l0) * XBCW + chb, nzero, cw, cb, chb, [&](int t, float* o) { *(LAS u32x4*)(lds + L_SB + (l0 + t) * (XW ? SBS2 : SBS) + c8 * 16) = pack8f(o); });
        if (WITH_C) { const int chc = DIN + 1024 + 128 * g + 8 * c8;
            conv_strip<4>(xbc + (t0 + l0) * XBCW + chc, nzero, cw, cb, chc, [&](int t, float* o) { *(LAS u32x4*)(lds + L_SC + (l0 + t) * SBS + c8 * 16) = pack8f(o); }); }
    }
}
DI bf16_t* st_ptr(unsigned char* ws, int b) { return (bf16_t*)(ws + (b ? O_ST1 : O_ST0)); }

DI void ssd_states_phase(LAS unsigned char* lds, const Params& p) {
    const int tid = otid(), w = __builtin_amdgcn_readfirstlane(tid >> 6), lane = tid & 63, r = lane & 31, h = lane >> 5, hh = w >> 1, ph = w & 1;
    const bf16_t* xbc = (const bf16_t*)(p.ws + O_XBC); const float* DT = (const float*)(p.ws + O_DT); float* cdec = (float*)(p.ws + O_CDEC);
    const int i16 = lane & 15, tq = i16 >> 2, tp = i16 & 3, g16 = (lane >> 4) & 1;
    for (int it = blockIdx.x; it < 1024; it += gridDim.x) {
        const int b = it >> 9, c = (it >> 3) & 63, g = it & 7; const size_t t0 = (size_t)b * SEQ + (size_t)c * 128;
        ssd_dt_acum(lds, DT, p.in[13], p.in[14], t0, g);
        ssd_stage<true, false>(lds, xbc, p.in[11], p.in[12], t0, c, g);
        __syncthreads();
        f32x16 acc[4];
#pragma unroll
        for (int i = 0; i < 4; ++i) acc[i] = zero16();
        const LAS unsigned char* xa = lds + L_SX + (8 * h + tq) * SXS2 + (64 * hh + 32 * ph + 16 * g16 + 4 * tp) * 2;
        const LAS unsigned char* ba = lds + L_SB + (8 * h + tq) * SBS2 + (16 * g16 + 4 * tp) * 2;
#pragma unroll
        for (int s = 0; s < 8; ++s) {
            const bf16x8 af = tr2(xa + 16 * s * SXS2, xa + (16 * s + 4) * SXS2);
#pragma unroll
            for (int nt = 0; nt < 4; ++nt) { const bf16x8 bfr = tr2(ba + 16 * s * SBS2 + nt * 64, ba + (16 * s + 4) * SBS2 + nt * 64); acc[nt] = MFMA32(af, bfr, acc[nt]); }
        }
        bf16_t* st = st_ptr(p.ws, b) + ((size_t)(c * 32 + 4 * g + hh) * 64 + 32 * ph) * 128;
#pragma unroll
        for (int nt = 0; nt < 4; ++nt)
#pragma unroll
            for (int i = 0; i < 16; ++i) st[(size_t)crow(i, h) * 128 + 32 * nt + r] = (bf16_t)(pk2(acc[nt][i], 0.f) & 0xffffu);
        if (tid < 4) cdec[(b * 64 + c) * 32 + 4 * g + tid] = __expf(((LAS float*)(lds + L_SAC))[tid * 128 + 127]);
        __syncthreads();
    }
}
DI void ssd_scan_phase(const Params& p, const bool dry) {
    const float* cdec = (const float*)(p.ws + O_CDEC);
    for (int e = blockIdx.x * 512 + threadIdx.x; e < 2 * 32 * 64 * 32; e += gridDim.x * 512) {
        const int b = e >> 16, rem = e & 65535, head = rem >> 11;
        bf16_t* st = st_ptr(p.ws, b) + (size_t)rem * 4;
        float carry[4] = {0.f, 0.f, 0.f, 0.f};
        for (int c0 = 0; c0 < 64; c0 += 8) {
            u32x2 v[8]; float dc[8];
#pragma unroll
            for (int u = 0; u < 8; ++u) { v[u] = *(const u32x2*)(st + (size_t)(c0 + u) * 262144); dc[u] = cdec[(b * 64 + c0 + u) * 32 + head]; }
#pragma unroll
            for (int u = 0; u < 8; ++u) {
                u32x2 o; o[0] = pk2(carry[0], carry[1]); o[1] = pk2(carry[2], carry[3]); if (!dry) *(u32x2*)(st + (size_t)(c0 + u) * 262144) = o;
                carry[0] = carry[0] * dc[u] + bflo(v[u][0]); carry[1] = carry[1] * dc[u] + bfhi(v[u][0]); carry[2] = carry[2] * dc[u] + bflo(v[u][1]); carry[3] = carry[3] * dc[u] + bfhi(v[u][1]);
            }
        }
    }
}
DI void ssd_out_phase(LAS unsigned char* lds, const Params& p, const bool dry) {
    const int tid = otid(), w = __builtin_amdgcn_readfirstlane(tid >> 6), lane = tid & 63, r = lane & 31, h = lane >> 5, hh = w >> 1, ph = w & 1;
    const bf16_t* xbc = (const bf16_t*)(p.ws + O_XBC); const float* DT = (const float*)(p.ws + O_DT); bf16_t* zy = (bf16_t*)p.out;
    LAS float* sdt = (LAS float*)(lds + L_SDT); LAS float* sac = (LAS float*)(lds + L_SAC); LAS float* ssq = (LAS float*)(lds + L_SSQ);
    const int i16 = lane & 15, tq = i16 >> 2, tp = i16 & 3, g16 = (lane >> 4) & 1;
    for (int it = blockIdx.x; it < 1024; it += gridDim.x) {
        const int b = it >> 9, c = (it >> 3) & 63, g = it & 7, head = 4 * g + hh; const size_t t0 = (size_t)b * SEQ + (size_t)c * 128;
        ssd_dt_acum(lds, DT, p.in[13], p.in[14], t0, g);
        ssd_stage<false, true>(lds, xbc, p.in[11], p.in[12], t0, c, g);
        bf16x8 pvf[8];
        { const bf16_t* pp = st_ptr(p.ws, b) + ((size_t)(c * 32 + head) * 64 + 32 * ph + r) * 128 + 8 * h;
#pragma unroll
          for (int s = 0; s < 8; ++s) pvf[s] = *(const bf16x8*)(pp + 16 * s); }
        __syncthreads();
        f32x16 Y[4];
        const LAS unsigned char* xa = lds + L_SX + (4 * h + tq) * SXS + (64 * hh + 32 * ph + 16 * g16 + 4 * tp) * 2;
#pragma unroll
        for (int lt = 0; lt < 4; ++lt) {
            __builtin_amdgcn_sched_barrier(0);
            f32x16 y = zero16();
#pragma unroll
            for (int s = 0; s < 8; ++s) { const bf16x8 cfs = *(const LAS bf16x8*)(lds + L_SC + (32 * lt + r) * SBS + (16 * s + 8 * h) * 2); y = MFMA32(pvf[s], cfs, y); }
            Y[lt] = y * __expf(sac[hh * 128 + 32 * lt + r]);
        }
#pragma unroll
        for (int lt = 0; lt < 4; ++lt) {
            __builtin_amdgcn_sched_barrier(0);
            bf16x8 cf[8];
#pragma unroll
            for (int s = 0; s < 8; ++s) cf[s] = *(const LAS bf16x8*)(lds + L_SC + (32 * lt + r) * SBS + (16 * s + 8 * h) * 2);
            const float al = sac[hh * 128 + 32 * lt + r];
#pragma unroll
            for (int mt = 0; mt < 4; ++mt) {
                if (mt <= lt) {
                    __builtin_amdgcn_sched_barrier(0);
                    f32x16 X = zero16();
#pragma unroll
                    for (int s = 0; s < 8; ++s) { const bf16x8 bfr = *(const LAS bf16x8*)(lds + L_SB + (32 * mt + r) * SBS + (16 * s + 8 * h) * 2); X = MFMA32(bfr, cf[s], X); }
#pragma unroll
                    for (int gq = 0; gq < 4; ++gq) {
                        const f32x4 am = *(const LAS f32x4*)(sac + hh * 128 + 32 * mt + 8 * gq + 4 * h), dm = *(const LAS f32x4*)(sdt + hh * 128 + 32 * mt + 8 * gq + 4 * h);
#pragma unroll
                        for (int jj = 0; jj < 4; ++jj) { const int mrow = 32 * mt + 8 * gq + 4 * h + jj; const bool ok = (32 * lt + r) >= mrow;
                            const float dec = ok ? __expf(fminf(al - am[jj], 0.f)) * dm[jj] : 0.f; X[4 * gq + jj] *= dec; }
                    }
#pragma unroll
                    for (int s2 = 0; s2 < 2; ++s2) { const bf16x8 xs = pack8(X, s2);
                        const LAS unsigned char* xr = xa + (32 * mt + 16 * s2) * SXS; const bf16x8 xf = tr2(xr, xr + 8 * SXS); Y[lt] = MFMA32(xf, xs, Y[lt]); }
                }
            }
        }
        __builtin_amdgcn_sched_barrier(0);
        const float Dh = p.in[15][head];
        float sq[4];
#pragma unroll
        for (int lt = 0; lt < 4; ++lt) {
            const int l = 32 * lt + r; sq[lt] = 0.f;
#pragma unroll
            for (int gq = 0; gq < 4; ++gq) {
                const int chl = 64 * hh + 32 * ph + 8 * gq + 4 * h;
                const u32x2 xv = *(const LAS u32x2*)(lds + L_SX + l * SXS + chl * 2);
                const u32x2 zv = *(const u32x2*)(zy + (t0 + l) * DIN + 256 * g + chl);
                const float xf4[4] = {bflo(xv[0]), bfhi(xv[0]), bflo(xv[1]), bfhi(xv[1])}, zf4[4] = {bflo(zv[0]), bfhi(zv[0]), bflo(zv[1]), bfhi(zv[1])};
#pragma unroll
                for (int jj = 0; jj < 4; ++jj) { const float yv = (Y[lt][4 * gq + jj] + Dh * xf4[jj]) * fsilu(zf4[jj]); Y[lt][4 * gq + jj] = yv; sq[lt] += yv * yv; }
            }
            sq[lt] += __shfl_xor(sq[lt], 32);
            if (h == 0) ssq[w * 128 + l] = sq[lt];
        }
        __syncthreads();
#pragma unroll
        for (int lt = 0; lt < 4; ++lt) {
            const int l = 32 * lt + r; float tot = 0.f;
#pragma unroll
            for (int ww = 0; ww < 8; ++ww) tot += ssq[ww * 128 + l];
            const float rn = __builtin_amdgcn_rsqf(tot * (1.0f / 256.0f) + 1e-5f);
#pragma unroll
            for (int gq = 0; gq < 4; ++gq) {
                const int chl = 64 * hh + 32 * ph + 8 * gq + 4 * h; const f32x4 gw = *(const f32x4*)(p.in[16] + 256 * g + chl);
                u32x2 o; o[0] = pk2(Y[lt][4 * gq] * rn * gw[0], Y[lt][4 * gq + 1] * rn * gw[1]); o[1] = pk2(Y[lt][4 * gq + 2] * rn * gw[2], Y[lt][4 * gq + 3] * rn * gw[3]);
                if (!dry) *(u32x2*)(zy + (t0 + l) * DIN + 256 * g + chl) = o;
            }
        }
        __syncthreads();
    }
}
DI void dt_proj(LAS unsigned char* lds, const Params& p) {
    const int tid = otid(), w = __builtin_amdgcn_readfirstlane(tid >> 6), lane = tid & 63, r = lane & 31, h = lane >> 5, rt = w & 1, kq = w >> 1;
    const bf16_t* hb = (const bf16_t*)(p.ws + O_HB); const bf16_t* wt = (const bf16_t*)(p.ws + W_SIN) + (size_t)6144 * DM;
    const float* ss = (const float*)(p.ws + O_SS) + 2 * MT; float* dt = (float*)(p.ws + O_DT);
    LAS float* part = (LAS float*)lds;
    for (int rb = blockIdx.x; rb < MT / 64; rb += gridDim.x) {
        const bf16_t* ap = hb + (size_t)(rb * 64 + rt * 32 + r) * DM + kq * 256 + 8 * h;
        const bf16_t* bp = wt + (size_t)r * DM + kq * 256 + 8 * h;
        bf16x8 af[16], bfr[16];
#pragma unroll
        for (int s = 0; s < 16; ++s) { af[s] = *(const bf16x8*)(ap + 16 * s); bfr[s] = *(const bf16x8*)(bp + 16 * s); }
        f32x16 acc = zero16();
#pragma unroll
        for (int s = 0; s < 16; ++s) acc = MFMA32(af[s], bfr[s], acc);
#pragma unroll
        for (int i = 0; i < 16; ++i) part[((kq * 2 + rt) * 32 + crow(i, h)) * 32 + r] = acc[i];
        __syncthreads();
#pragma unroll
        for (int q = 0; q < 4; ++q) {
            const int o = tid + 512 * q, row = o >> 5, col = o & 31;
            float v = 0.f;
#pragma unroll
            for (int k = 0; k < 4; ++k) v += part[((k * 2 + (row >> 5)) * 32 + (row & 31)) * 32 + col];
            const int grow = rb * 64 + row;
            dt[(size_t)grow * 32 + col] = v * __builtin_amdgcn_rsqf(ss[grow] * (1.0f / 1024.0f) + 1e-6f);
        }
        __syncthreads();
    }
}
template <class Epi> DI void run_gemm(LAS unsigned char* lds, const bf16_t* A, const bf16_t* Bt, int N, int K, const Epi& E) {
    pg8::Gemm g; g.A = A; g.Bt = Bt; g.M = MT; g.N = N; g.K = K;
    pg8::StaticOrder S; S.init(MT, N, (int)gridDim.x, (int)blockIdx.x);
    pg8::gemm_phase<Epi, pg8::StaticOrder, !Epi::AFTER_DRAIN, true>((PG8_LAS unsigned char*)lds, g, S, E);
}
#if defined(DRY_S3) || defined(DRY_S4)
#define DRYV (p.ws == nullptr)
#else
#define DRYV false
#endif
__global__ void __launch_bounds__(512, 2) fwd_megakernel(Params p) {
    extern __shared__ __attribute__((aligned(16))) unsigned char shm[];
    LAS unsigned char* lds = (LAS unsigned char*)shm;
    cg::grid_group grid = cg::this_grid();
    if (threadIdx.x < 4) ((LAS unsigned*)(lds + LDS_BYTES - 16))[threadIdx.x] = 0u;
    __syncthreads();
    const XcdBarrier xbar = xcd_barrier_post((unsigned*)(p.ws + O_BAR), (volatile LAS unsigned*)(lds + LDS_BYTES - 16));
#define GBAR() xcd_barrier(xbar)
    unsigned char* ws = p.ws;
    bf16_t* hb = (bf16_t*)(ws + O_HB); float* ss = (float*)(ws + O_SS);
    phase0(lds, p);
#ifdef DUP_P0
    GBAR(); phase0(lds, p);
#endif
    if (gridDim.x == 0x7fffffffu) grid.sync();
    GBAR();
    { EpiAttnIn E; E.O = (bf16_t*)(ws + O_PROJ); E.ss = ss; E.tab = (const f32x4*)(ws + O_ROPE); run_gemm(lds, hb, (const bf16_t*)(ws + W_AIN), AINW, DM, E); }
    GBAR();
    attn_phase(lds, p);
#ifdef DUP_ATTN
    GBAR(); attn_phase(lds, p);
#endif
    GBAR();
    { EpiRes<true, false> E; E.xres = p.in[0]; E.hb = hb; E.outf = nullptr; E.ssn = ss + MT; run_gemm(lds, (const bf16_t*)(ws + O_MIXED), (const bf16_t*)(ws + W_AOUT), DM, DM, E); }
    GBAR();
    { EpiGU E; E.act = (bf16_t*)(ws + O_ACT); E.ss = ss + MT; run_gemm(lds, hb, (const bf16_t*)(ws + W_GU0), 2 * DFF, DM, E); }
    GBAR();
    { EpiRes<false, false> E; E.xres = nullptr; E.hb = hb; E.outf = nullptr; E.ssn = ss + 2 * MT; run_gemm(lds, (const bf16_t*)(ws + O_ACT), (const bf16_t*)(ws + W_DN0), DM, DFF, E); }
    GBAR();
    { EpiSsdIn E; E.z = (bf16_t*)p.out; E.xbc = (bf16_t*)(ws + O_XBC); E.dt = (float*)(ws + O_DT); E.ss = ss + 2 * MT; dt_proj(lds, p); run_gemm(lds, hb, (const bf16_t*)(ws + W_SIN), 6144, DM, E); }
    GBAR();
    ssd_states_phase(lds, p);
#ifdef DUP_S2
    GBAR(); ssd_states_phase(lds, p);
#endif
    GBAR();
#ifdef DRY_S3
    ssd_scan_phase(p, p.ws != nullptr); GBAR();
#endif
    ssd_scan_phase(p, DRYV);
    GBAR();
#ifdef DRY_S4
    ssd_out_phase(lds, p, p.ws != nullptr); GBAR();
#endif
    ssd_out_phase(lds, p, DRYV);
    GBAR();
    { EpiRes<false, false> E; E.xres = nullptr; E.hb = hb; E.outf = nullptr; E.ssn = ss + 3 * MT; run_gemm(lds, (const bf16_t*)p.out, (const bf16_t*)(ws + W_SOUT), DM, DIN, E); }
    GBAR();
    { EpiGU E; E.act = (bf16_t*)(ws + O_ACT); E.ss = ss + 3 * MT; run_gemm(lds, hb, (const bf16_t*)(ws + W_GU1), 2 * DFF, DM, E); }
    GBAR();
    if (gridDim.x == 256) {
        EpiFinal E; E.hb = hb; E.outf = p.out; E.ssn = ss + 4 * MT; E.cnt = (unsigned*)(ws + O_BAR) + XCD_BAR_WORDS; E.fw = p.in[22];
        run_gemm(lds, (const bf16_t*)(ws + O_ACT), (const bf16_t*)(ws + W_DN1), DM, DFF, E);
    } else {
        { EpiRes<false, true> E; E.xres = nullptr; E.hb = hb; E.outf = p.out; E.ssn = ss + 4 * MT; run_gemm(lds, (const bf16_t*)(ws + O_ACT), (const bf16_t*)(ws + W_DN1), DM, DFF, E); }
        GBAR();
        const float* ss4 = ss + 4 * MT; const f32x4* fw = (const f32x4*)p.in[22]; f32x4* o4 = (f32x4*)p.out;
        for (int i = blockIdx.x * 512 + threadIdx.x; i < MT * (DM / 4); i += gridDim.x * 512) {
            const int row = i >> 8; const float rs = __builtin_amdgcn_rsqf(ss4[row] * (1.0f / 1024.0f) + 1e-6f);
            o4[i] = o4[i] * rs * fw[i & 255];
        }
    }
}

extern "C" void kernel_launch(void* const* d_in, const int* in_sizes, int n_in, void* d_out, int out_size, void* d_ws, size_t ws_size, hipStream_t stream) {
    static int grid_blocks = 0;
    if (!grid_blocks) {
        int dev = 0, cus = 0, per_cu = 0;
        hipGetDevice(&dev);
        hipDeviceGetAttribute(&cus, hipDeviceAttributeMultiprocessorCount, dev);
        if (hipFuncSetAttribute((const void*)fwd_megakernel, hipFuncAttributeMaxDynamicSharedMemorySize, LDS_BYTES) != hipSuccess) fprintf(stderr, "hipFuncSetAttribute failed\n");
        if (hipOccupancyMaxActiveBlocksPerMultiprocessor(&per_cu, (const void*)fwd_megakernel, 512, LDS_BYTES) != hipSuccess || per_cu < 1) { fprintf(stderr, "occupancy query: %d\n", per_cu); per_cu = 1; }
        (void)hipGetLastError();
        grid_blocks = cus * per_cu;
        if (ws_size < 268435456ull || n_in != 23) fprintf(stderr, "unexpected ws_size %zu / n_in %d\n", ws_size, n_in);
    }
    if (hipMemsetAsync((char*)d_ws + O_BAR, 0, 20480, stream) != hipSuccess) fprintf(stderr, "memset failed\n");
    Params p{};
    for (int i = 0; i < 23; ++i) p.in[i] = (const float*)d_in[i];
    p.out = (float*)d_out; p.ws = (unsigned char*)d_ws;
    void* args[] = {&p};
    hipError_t e = hipLaunchCooperativeKernel((const void*)fwd_megakernel, dim3(grid_blocks), dim3(512), args, LDS_BYTES, stream);
    if (e != hipSuccess) fprintf(stderr, "cooperative launch failed: %s (grid %d)\n", hipGetErrorString(e), grid_blocks);
}
#ifdef PHASE_TEST
__global__ void __launch_bounds__(512, 2) t_phase0(Params p) { extern __shared__ __attribute__((aligned(16))) unsigned char shm[]; phase0((LAS unsigned char*)shm, p); }
__global__ void __launch_bounds__(512, 2) t_attn_diff(Params p) { extern __shared__ __attribute__((aligned(16))) unsigned char shm[]; diff_tile((LAS unsigned char*)shm, (const bf16_t*)(p.ws + O_PROJ), (bf16_t*)(p.ws + O_MIXED), p.in[7], 0.3f, blockIdx.x & 1, blockIdx.y, blockIdx.z); }
__global__ void __launch_bounds__(512, 2) t_attn_sb(Params p) { extern __shared__ __attribute__((aligned(16))) unsigned char shm[]; sb_block((LAS unsigned char*)shm, (const bf16_t*)(p.ws + O_PROJ), (bf16_t*)(p.ws + O_MIXED), blockIdx.x & 1, blockIdx.y, blockIdx.z); }
__global__ void __launch_bounds__(512, 2) t_ssd_states(Params p) { extern __shared__ __attribute__((aligned(16))) unsigned char shm[]; ssd_states_phase((LAS unsigned char*)shm, p); }
__global__ void __launch_bounds__(512, 2) t_ssd_scan(Params p) { ssd_scan_phase(p, false); }
__global__ void __launch_bounds__(512, 2) t_ssd_out(Params p) { extern __shared__ __attribute__((aligned(16))) unsigned char shm[]; ssd_out_phase((LAS unsigned char*)shm, p, false); }
__global__ void __launch_bounds__(512, 2) t_gemm_ain(Params p) { extern __shared__ __attribute__((aligned(16))) unsigned char shm[]; EpiAttnIn E; E.O = (bf16_t*)(p.ws + O_PROJ); E.ss = (float*)(p.ws + O_SS); E.tab = (const f32x4*)(p.ws + O_ROPE); run_gemm((LAS unsigned char*)shm, (bf16_t*)(p.ws + O_HB), (const bf16_t*)(p.ws + W_AIN), AINW, DM, E); }
__global__ void __launch_bounds__(512, 2) t_gemm_res(Params p) { extern __shared__ __attribute__((aligned(16))) unsigned char shm[]; EpiRes<false, false> E; E.xres = nullptr; E.hb = (bf16_t*)(p.ws + O_HB); E.outf = nullptr; E.ssn = (float*)(p.ws + O_SS); run_gemm((LAS unsigned char*)shm, (bf16_t*)(p.ws + O_ACT), (const bf16_t*)(p.ws + W_DN0), DM, DFF, E); }
__global__ void __launch_bounds__(512, 2) t_gemm_gu(Params p) { extern __shared__ __attribute__((aligned(16))) unsigned char shm[]; EpiGU E; E.act = (bf16_t*)(p.ws + O_ACT); E.ss = (float*)(p.ws + O_SS); run_gemm((LAS unsigned char*)shm, (bf16_t*)(p.ws + O_HB), (const bf16_t*)(p.ws + W_GU0), 2 * DFF, DM, E); }
__global__ void __launch_bounds__(512, 2) t_gemm_ssdin(Params p) { extern __shared__ __attribute__((aligned(16))) unsigned char shm[]; EpiSsdIn E; E.z = (bf16_t*)p.out; E.xbc = (bf16_t*)(p.ws + O_XBC); E.dt = (float*)(p.ws + O_DT); E.ss = (float*)(p.ws + O_SS); run_gemm((LAS unsigned char*)shm, (bf16_t*)(p.ws + O_HB), (const bf16_t*)(p.ws + W_SIN), SINWP, DM, E); }
#endif
```

```cpp
#include <hip/hip_runtime.h>
#include <hip/hip_cooperative_groups.h>
#include <cstdio>
#include <cstdint>
namespace cg = cooperative_groups;
namespace pg8 {
#define PG8_LAS __attribute__((address_space(3)))
typedef unsigned short bf16_t;
typedef short bf16x8 __attribute__((ext_vector_type(8)));
typedef float f32x4 __attribute__((ext_vector_type(4)));
typedef unsigned u32x4 __attribute__((ext_vector_type(4)));
constexpr int BM = 256, BK = 64, HALF = 128, HTB = HALF * BK * 2  , STAGE_BYTES = 8 * HTB, NXCD = 8, WGM = 8;

__host__ __device__ __forceinline__ int lds_byte(int r, int c) { const int st = (r >> 4) * 2 + (c >> 5), rr = r & 15, cc = c & 31, ob = rr * 64 + cc * 2; return st * 1024 + (ob ^ (((ob >> 9) & 1) << 5)); }
__host__ __device__ __forceinline__ void stage_rc(int b, int& R, int& C) { const int st = b / 1024, sb = b % 1024, swz = sb ^ (((sb >> 9) & 1) << 5); R = (st >> 1) * 16 + swz / 64; C = (st & 1) * 32 + (swz % 64) / 2; }
__host__ __device__ __forceinline__ int perm32(int rho) { const int n = rho >> 4, i = rho & 15; return 8 * (i >> 2) + 4 * n + (i & 3); }

struct Unit { int pm, pn; };
struct Gemm { const bf16_t* A; const bf16_t* Bt; int M, N, K; };

struct StaticOrder {
    int nM, nN, nwg, G, c;
    __host__ __device__ void init(int M, int N, int G_, int c_) { nM = M / BM; nN = N / BM; nwg = nM * nN; G = G_; c = c_; }
    __host__ __device__ bool next(int i, Unit& u) const {
        const long L = (long)i * G + c; if (L >= nwg) return false;
        int wgid = (int)L; { const int q = nwg / NXCD, r = nwg % NXCD, xcd = wgid % NXCD, off = wgid / NXCD; wgid = (xcd < r ? xcd * (q + 1) : r * (q + 1) + (xcd - r) * q) + off; }
        const int nig = WGM * nN, gid = wgid / nig, fm = gid * WGM, gsz = (nM - fm) < WGM ? (nM - fm) : WGM;
        u.pm = fm + ((wgid % nig) % gsz); u.pn = (wgid % nig) / gsz; return true;
    }
    __device__ __forceinline__ void a_ready(const Unit&) const {}
    __device__ __forceinline__ void done(const Unit&) const {}
};

template <class Epi, class Sched, bool ALIGN_EPI = false, bool SP2 = false>
__device__ __forceinline__ void gemm_phase(PG8_LAS unsigned char* lds, const Gemm g, const Sched& S, const Epi& E) {
    int tid_ = threadIdx.x; asm volatile("" : "+v"(tid_)); const int tid = tid_, wid = __builtin_amdgcn_readfirstlane(tid >> 6), lane = tid & 63, wr = wid >> 2, wc = wid & 3, fr = lane & 15, fq = lane >> 4;
    const int K = g.K, nt = K / BK;
    unsigned voffA[2], voffB[2];
#pragma unroll
    for (int i = 0; i < 2; ++i) { int R, C; stage_rc(tid * 16 + i * 8192, R, C); const int Rb = Epi::PERM ? ((R & ~31) + perm32(R & 31)) : R;
        voffA[i] = (unsigned)(R * K + C) * 2u; voffB[i] = (unsigned)(Rb * K + C) * 2u; }
    const size_t kstep = (size_t)(BK * 2);
    const size_t hstep = (size_t)HALF * K * 2;
    const size_t tstep = 2 * hstep;
    const unsigned ldsw = (unsigned)wid * 1024u;
    const int aoff = lds_byte(wr * 64 + fr, fq * 8), boff = lds_byte(wc * 32 + fr, fq * 8);
#define PG8_SA(b, h) (((b) * 2 + (h)) * HTB)
#define PG8_SB(b, h) ((4 + (b) * 2 + (h)) * HTB)
#define PG8_STAGE(bufoff, gbase, voff) do { _Pragma("unroll") for (int _i = 0; _i < 2; ++_i) \
        __builtin_amdgcn_global_load_lds((const unsigned*)((const char*)(gbase) + (voff)[_i]), (PG8_LAS unsigned*)(lds + (bufoff) + ldsw + _i * 8192), 16, 0, 0); } while (0)
#define PG8_LDA(dst, b, h) do { _Pragma("unroll") for (int m = 0; m < 4; ++m) _Pragma("unroll") for (int k = 0; k < 2; ++k) dst[m][k] = *(const PG8_LAS bf16x8*)(lds + PG8_SA(b, h) + aoff + m * 2048 + k * 1024); } while (0)
#define PG8_LDB(dst, b, h) do { _Pragma("unroll") for (int n = 0; n < 2; ++n) _Pragma("unroll") for (int k = 0; k < 2; ++k) dst[n][k] = *(const PG8_LAS bf16x8*)(lds + PG8_SB(b, h) + boff + n * 2048 + k * 1024); } while (0)
#define PG8_MMA(ai, bj, At, Bt) do { __builtin_amdgcn_s_setprio(1); _Pragma("unroll") for (int m = 0; m < 4; ++m) _Pragma("unroll") for (int n = 0; n < 2; ++n) _Pragma("unroll") for (int k = 0; k < 2; ++k) \
        acc[ai][bj][m][n] = __builtin_amdgcn_mfma_f32_16x16x32_bf16(Bt[n][k], At[m][k], acc[ai][bj][m][n], 0, 0, 0); __builtin_amdgcn_s_setprio(0); } while (0)
#define PG8_WAIT_V(n) asm volatile("s_waitcnt vmcnt(" #n ")" ::: "memory")
#define PG8_WAIT_L(n) asm volatile("s_waitcnt lgkmcnt(" #n ")" ::: "memory")
#define PG8_BAR __builtin_amdgcn_s_barrier()
#define PG8_SCHED __builtin_amdgcn_sched_barrier(0)
    Unit cur, nxt; int ui = 0;
    if (!S.next(0, cur)) return;
    f32x4 acc[2][2][4][2];
#pragma unroll
    for (int a = 0; a < 2; ++a)
#pragma unroll
        for (int b = 0; b < 2; ++b)
#pragma unroll
            for (int m = 0; m < 4; ++m)
#pragma unroll
                for (int n = 0; n < 2; ++n) acc[a][b][m][n] = (f32x4){0.f, 0.f, 0.f, 0.f};
    bf16x8 At[4][2], B0[2][2], B1[2][2];
    float epre[8]; E.pre(cur, wr, fr, epre);
    const char* cA = (const char*)g.A + (size_t)cur.pm * tstep; const char* cB = (const char*)g.Bt + (size_t)cur.pn * tstep;
    S.a_ready(cur);
    if constexpr (SP2) {
        PG8_STAGE(PG8_SB(0, 0), cB, voffB); PG8_STAGE(PG8_SB(0, 1), cB + hstep, voffB); PG8_STAGE(PG8_SA(0, 0), cA, voffA); PG8_STAGE(PG8_SA(0, 1), cA + hstep, voffA);
        if (wr == 1) PG8_BAR;
        PG8_WAIT_V(2); PG8_BAR;
        PG8_STAGE(PG8_SB(1, 0), cB + kstep, voffB); PG8_STAGE(PG8_SA(1, 0), cA + kstep, voffA); PG8_STAGE(PG8_SB(1, 1), cB + hstep + kstep, voffB);
        PG8_WAIT_V(6); PG8_BAR;
    } else {
        PG8_STAGE(PG8_SB(0, 0), cB, voffB); PG8_STAGE(PG8_SA(0, 0), cA, voffA); PG8_STAGE(PG8_SB(0, 1), cB + hstep, voffB); PG8_STAGE(PG8_SA(0, 1), cA + hstep, voffA);
        if (wr == 1) PG8_BAR;
        PG8_WAIT_V(4); PG8_BAR;
        PG8_STAGE(PG8_SB(1, 0), cB + kstep, voffB); PG8_STAGE(PG8_SA(1, 0), cA + kstep, voffA); PG8_STAGE(PG8_SB(1, 1), cB + hstep + kstep, voffB);
        PG8_WAIT_V(6); PG8_BAR;
    }
    for (;;) {
        const bool has_next = S.next(ui + 1, nxt);
        const char* nA = has_next ? (const char*)g.A + (size_t)nxt.pm * tstep : cA; const char* nB = has_next ? (const char*)g.Bt + (size_t)nxt.pn * tstep : cB;
        for (int t = 0; t < nt; t += 2) {
            const bool last = (t == nt - 2);
            const char* a1 = cA + (size_t)(t + 1) * kstep;
            const char* a2 = last ? nA : cA + (size_t)(t + 2) * kstep; const char* b2 = last ? nB : cB + (size_t)(t + 2) * kstep;
            const char* a3 = a2 + kstep; const char* b3 = b2 + kstep;
            if (last && has_next) S.a_ready(nxt);
            if constexpr (SP2) {
            PG8_LDB(B0, 0, 0); PG8_LDB(B1, 0, 1); PG8_SCHED; PG8_LDA(At, 0, 0); PG8_STAGE(PG8_SA(1, 1), a1 + hstep, voffA);
            PG8_WAIT_V(8); PG8_WAIT_L(0); PG8_BAR; PG8_MMA(0, 0, At, B0); PG8_MMA(0, 1, At, B1); PG8_BAR; PG8_SCHED;
            PG8_LDA(At, 0, 1); PG8_STAGE(PG8_SB(0, 0), b2, voffB); PG8_STAGE(PG8_SB(0, 1), b2 + hstep, voffB); PG8_STAGE(PG8_SA(0, 0), a2, voffA);
            PG8_WAIT_V(8); PG8_WAIT_L(0); PG8_BAR; PG8_MMA(1, 0, At, B0); PG8_MMA(1, 1, At, B1); PG8_BAR; PG8_SCHED;
            PG8_LDB(B0, 1, 0); PG8_LDB(B1, 1, 1); PG8_SCHED; PG8_LDA(At, 1, 0); PG8_STAGE(PG8_SA(0, 1), a2 + hstep, voffA);
            PG8_WAIT_V(8); PG8_WAIT_L(0); PG8_BAR; PG8_MMA(0, 0, At, B0); PG8_MMA(0, 1, At, B1); PG8_BAR; PG8_SCHED;
            PG8_LDA(At, 1, 1); PG8_STAGE(PG8_SB(1, 0), b3, voffB); PG8_STAGE(PG8_SB(1, 1), b3 + hstep, voffB); PG8_STAGE(PG8_SA(1, 0), a3, voffA);
            PG8_WAIT_V(8); PG8_WAIT_L(0); PG8_BAR; PG8_MMA(1, 0, At, B0); PG8_MMA(1, 1, At, B1); PG8_BAR; PG8_SCHED;
            } else {
            PG8_LDB(B0, 0, 0); PG8_SCHED; PG8_LDA(At, 0, 0); PG8_STAGE(PG8_SA(1, 1), a1 + hstep, voffA);
            PG8_WAIT_L(8); PG8_BAR; PG8_WAIT_L(0); PG8_MMA(0, 0, At, B0); PG8_BAR; PG8_SCHED;
            PG8_LDB(B1, 0, 1); PG8_STAGE(PG8_SB(0, 0), b2, voffB);
            PG8_BAR; PG8_WAIT_L(0); PG8_MMA(0, 1, At, B1); PG8_BAR;
            PG8_LDA(At, 0, 1); PG8_STAGE(PG8_SA(0, 0), a2, voffA);
            PG8_BAR; PG8_WAIT_L(0); PG8_MMA(1, 0, At, B0); PG8_BAR; PG8_SCHED;
            PG8_STAGE(PG8_SB(0, 1), b2 + hstep, voffB);
            PG8_WAIT_V(6); PG8_BAR; PG8_MMA(1, 1, At, B1); PG8_BAR;
            PG8_LDB(B0, 1, 0); PG8_SCHED; PG8_LDA(At, 1, 0); PG8_STAGE(PG8_SA(0, 1), a2 + hstep, voffA);
            PG8_WAIT_L(8); PG8_BAR; PG8_WAIT_L(0); PG8_MMA(0, 0, At, B0); PG8_BAR; PG8_SCHED;
            PG8_LDB(B1, 1, 1); PG8_STAGE(PG8_SB(1, 0), b3, voffB);
            PG8_BAR; PG8_WAIT_L(0); PG8_MMA(0, 1, At, B1); PG8_BAR;
            PG8_LDA(At, 1, 1); PG8_STAGE(PG8_SA(1, 0), a3, voffA);
            PG8_BAR; PG8_WAIT_L(0); PG8_MMA(1, 0, At, B0); PG8_BAR; PG8_SCHED;
            PG8_STAGE(PG8_SB(1, 1), b3 + hstep, voffB);
            PG8_WAIT_V(6); PG8_BAR; PG8_MMA(1, 1, At, B1); PG8_BAR;
            }
        }
        if constexpr (ALIGN_EPI) { if (wr == 0) PG8_BAR; }
        if constexpr (!Epi::AFTER_DRAIN) { E(acc, cur, wr, wc, fr, fq, epre); S.done(cur); }
        if (!has_next) break;
        E.pre(nxt, wr, fr, epre);
#pragma unroll
        for (int a = 0; a < 2; ++a)
#pragma unroll
            for (int b = 0; b < 2; ++b)
#pragma unroll
                for (int m = 0; m < 4; ++m)
#pragma unroll
                    for (int n = 0; n < 2; ++n) acc[a][b][m][n] = (f32x4){0.f, 0.f, 0.f, 0.f};
        cur = nxt; cA = nA; cB = nB; ++ui;
        if constexpr (ALIGN_EPI) { if (wr == 1) PG8_BAR; }
    }
    PG8_WAIT_V(0);
    if constexpr (!ALIGN_EPI) { if (wr == 0) PG8_BAR; }
    PG8_BAR;
    if constexpr (Epi::AFTER_DRAIN) { E.fused(acc, cur, wr, wc, fr, fq, lds, wid, lane); S.done(cur); }
#undef PG8_SA
#undef PG8_SB
#undef PG8_STAGE
#undef PG8_LDA
#undef PG8_LDB
#undef PG8_MMA
#undef PG8_WAIT_V
#undef PG8_WAIT_L
#undef PG8_BAR
#undef PG8_SCHED
}
}
using pg8::bf16_t; using pg8::bf16x8; using pg8::f32x4;
typedef short s16x4 __attribute__((ext_vector_type(4)));
typedef float f32x16 __attribute__((ext_vector_type(16)));
typedef float f32x2 __attribute__((ext_vector_type(2)));
typedef __bf16 bf2_t __attribute__((ext_vector_type(2)));
typedef unsigned u32x2 __attribute__((ext_vector_type(2)));
typedef unsigned u32x4 __attribute__((ext_vector_type(4)));
#define LAS __attribute__((address_space(3)))
#define DI __device__ __forceinline__
#define MFMA32(a, b, c) __builtin_amdgcn_mfma_f32_32x32x16_bf16((a), (b), (c), 0, 0, 0)

DI int otid() { int t = threadIdx.x; asm volatile("" : "+v"(t)); return t; }
DI unsigned pk2(float a, float b) { f32x2 v = {a, b}; bf2_t r = __builtin_convertvector(v, bf2_t); return __builtin_bit_cast(unsigned, r); }
DI float bflo(unsigned u) { return __uint_as_float(u << 16); }
DI float bfhi(unsigned u) { return __uint_as_float(u & 0xffff0000u); }
DI float fexp2(float x) { return __builtin_amdgcn_exp2f(x); }
DI float frcp(float x) { return __builtin_amdgcn_rcpf(x); }
DI float fsilu(float x) { return x * frcp(1.0f + fexp2(-1.44269504089f * x)); }
DI int crow(int i, int h) { return (i & 3) + 8 * (i >> 2) + 4 * h; }
DI s16x4 trr(const LAS unsigned char* p) { return __builtin_amdgcn_ds_read_tr16_b64_v4i16((LAS s16x4*)p); }
DI bf16x8 tr2(const LAS unsigned char* p0, const LAS unsigned char* p1) { s16x4 a = trr(p0), b = trr(p1); return __builtin_shufflevector(a, b, 0, 1, 2, 3, 4, 5, 6, 7); }
DI bf16x8 pack8(const f32x16& x, int s) {
    u32x4 p; p[0] = pk2(x[8 * s], x[8 * s + 1]); p[1] = pk2(x[8 * s + 2], x[8 * s + 3]); p[2] = pk2(x[8 * s + 4], x[8 * s + 5]); p[3] = pk2(x[8 * s + 6], x[8 * s + 7]);
    return __builtin_bit_cast(bf16x8, p);
}
DI f32x16 zero16() { f32x16 z; for (int i = 0; i < 16; ++i) z[i] = 0.f; return z; }

constexpr int MT = 16384, SEQ = 8192, DM = 1024, DFF = 2816, AINW = 3072, SINW = 6176, SINWP = 6400, DIN = 2048, XBCW = 4096;
constexpr float LOG2E = 1.44269504089f;
constexpr int LDS_BYTES = 155648;
constexpr size_t W_AIN = 0, W_AOUT = W_AIN + (size_t)AINW * DM * 2, W_GU0 = W_AOUT + (size_t)DM * DM * 2, W_DN0 = W_GU0 + (size_t)2 * DFF * DM * 2,
                 W_SIN = W_DN0 + (size_t)DM * DFF * 2, W_SOUT = W_SIN + (size_t)SINWP * DM * 2, W_GU1 = W_SOUT + (size_t)DM * DIN * 2, W_DN1 = W_GU1 + (size_t)2 * DFF * DM * 2,
                 O_HB = W_DN1 + (size_t)DM * DFF * 2, O_SS = O_HB + (size_t)MT * DM * 2, O_ROPE = O_SS + (size_t)5 * MT * 4, O_DT = O_ROPE + (size_t)SEQ * 32 * 8,
                 O_CDEC = O_DT + (size_t)MT * 32 * 4, O_LAM = O_CDEC + 16384, O_BAR = O_LAM + 256, O_R = 98566144;
static_assert(O_BAR + 20480 <= O_R, "map");
constexpr size_t O_PROJ = O_R, O_MIXED = O_PROJ + (size_t)MT * AINW * 2, O_ACT = O_R, O_XBC = O_R, O_ST1 = O_XBC + (size_t)MT * XBCW * 2, O_ST0 = 0;
constexpr size_t ST_BATCH = (size_t)64 * 32 * 64 * 128;
static_assert(O_ST1 + ST_BATCH * 2 <= 268435456ull, "ws");
static_assert(ST_BATCH * 2 <= W_SOUT, "st0 overlay");
static_assert(O_MIXED + (size_t)MT * DM * 2 <= 268435456ull, "ws2");

struct Params { const float* in[23]; float* out; unsigned char* ws; };
#include <cstdlib>
#include <vector>

#define XB_TMO      128
#define XB_XCNT(j)  (256  + 64 * (j))
#define XB_XSUB(j)  (1280 + 64 * (j))
#define XB_XGEN(j)  (2304 + 64 * (j))
#define XB_TOP      3328
#define XB_TOPGEN   3392
#define XCD_BAR_WORDS 3456
#define XB_SPIN_CAP (1u << 18)

__device__ __forceinline__ unsigned xb_ld(unsigned* p)              { return __hip_atomic_load(p, __ATOMIC_RELAXED, __HIP_MEMORY_SCOPE_AGENT); }
__device__ __forceinline__ unsigned xb_add(unsigned* p, unsigned v) { return __hip_atomic_fetch_add(p, v, __ATOMIC_RELAXED, __HIP_MEMORY_SCOPE_AGENT); }
__device__ __forceinline__ unsigned xb_xcc_id() { return (unsigned)__builtin_amdgcn_s_getreg((3 << 11) | 20) & 0xFu; }
#define XB_SPIN(cond, bar) do { unsigned _sp = 0; while (cond) { \
    if ((++_sp & 255u) == 0u) { if (xb_ld(&(bar)[XB_TMO])) break; if (_sp > XB_SPIN_CAP) { atomicAdd(&(bar)[XB_TMO], 1u); break; } } } } while (0)

struct XcdBarrier {
    unsigned* bar; unsigned x;
    volatile LAS unsigned* st;
};

__device__ __forceinline__ XcdBarrier xcd_barrier_post(unsigned* bar, volatile LAS unsigned* st) {
    XcdBarrier b; b.bar = bar; b.x = xb_xcc_id(); b.st = st;
    if (threadIdx.x == 0) (void)xb_add(&bar[XB_XCNT(b.x)], 1u);
    return b;
}
__device__ __forceinline__ void xcd_barrier_complete(unsigned* bar, unsigned x, unsigned& nloc, unsigned& nx) {
    const unsigned G = gridDim.x * gridDim.y * gridDim.z;
    unsigned sum, cnt, mine, sp = 0u;
    for (;;) {
        sum = 0u; cnt = 0u; mine = 0u;
#pragma unroll
        for (unsigned j = 0; j < 16; ++j) { const unsigned c = xb_ld(&bar[XB_XCNT(j)]); sum += c; cnt += (c > 0u) ? 1u : 0u; mine = (j == x) ? c : mine; }
        if (sum == G) break;
        __builtin_amdgcn_s_sleep(1);
        if ((++sp & 255u) == 0u) { if (xb_ld(&bar[XB_TMO])) break; if (sp > XB_SPIN_CAP) { atomicAdd(&bar[XB_TMO], 1u); break; } }
    }
    nloc = mine > 0u ? mine : 1u; nx = cnt > 0u ? cnt : 1u;
}

__device__ __forceinline__ void xcd_barrier(const XcdBarrier& b) {
    asm volatile("s_waitcnt vmcnt(0)" ::: "memory");
    __syncthreads();
    if (threadIdx.x == 0) {
        unsigned* bar = b.bar;
        __builtin_amdgcn_s_waitcnt(0);
        unsigned nloc = b.st[0], nx = b.st[1];
        if (nloc == 0u) { xcd_barrier_complete(bar, b.x, nloc, nx); b.st[0] = nloc; b.st[1] = nx; }
        const unsigned old = xb_add(&bar[XB_XSUB(b.x)], 1u);
        const unsigned gen = old / nloc;
        if (old + 1u == (gen + 1u) * nloc) {
            __builtin_amdgcn_fence(__ATOMIC_RELEASE, "agent");
            asm volatile("s_waitcnt vmcnt(0)" ::: "memory");
            const unsigned og = xb_add(&bar[XB_TOP], 1u);
            const unsigned tg = og / nx;
            if (og + 1u != (tg + 1u) * nx) XB_SPIN(xb_ld(&bar[XB_TOP]) < (tg + 1u) * nx, bar);
            __builtin_amdgcn_fence(__ATOMIC_ACQUIRE, "agent");
            asm volatile("s_waitcnt vmcnt(0)" ::: "memory");
        } else {
            XB_SPIN(xb_ld(&bar[XB_TOP]) < (gen + 1u) * nx, bar);
            __builtin_amdgcn_fence(__ATOMIC_ACQUIRE, "agent");
            asm volatile("s_waitcnt vmcnt(0)" ::: "memory");
        }
    }
    __syncthreads();
}
DI void wmap(int mode, int c, int& src, float& scale, int& which) {
    src = c; scale = 1.f; which = 0;
    if (mode == 0) {
        if (c < 1024) { const int base = c & ~63, cc = c & 63, g = cc >> 3, e = cc & 7; src = base + (e < 4 ? 4 * g + e : 32 + 4 * g + (e - 4)); }
        if (c < 512) scale = 0.125f * LOG2E; else if (c >= 1536 && c < 2048) scale = 0.125f;
    } else if (mode == 2) { src = 128 * (c >> 8) + (c & 127); which = (c >> 7) & 1; }
    else if (mode == 3) { if (c >= SINW) src = -1; }
}
struct WJob { int mode, K, ldw, tix; const float* W0; const float* W1; const float* ks; bf16_t* dst; };
DI WJob wjob(const Params& p, int t) {
    unsigned char* ws = p.ws;
    const int cnt[8] = {48 * 4, 16 * 4, 88 * 4, 16 * 11, 100 * 4, 16 * 8, 88 * 4, 16 * 11};
    int j = 0, tt = t;
#pragma unroll
    for (int q = 0; q < 7; ++q) if (j == q && tt >= cnt[q]) { tt -= cnt[q]; j = q + 1; }
    WJob J; J.tix = tt; J.W1 = nullptr; J.ks = nullptr;
    switch (j) {
    case 0: J.mode = 0; J.W0 = p.in[2]; J.ks = p.in[1]; J.dst = (bf16_t*)(ws + W_AIN); J.K = DM; J.ldw = AINW; break;
    case 1: J.mode = 1; J.W0 = p.in[8]; J.dst = (bf16_t*)(ws + W_AOUT); J.K = DM; J.ldw = DM; break;
    case 2: J.mode = 2; J.W0 = p.in[19]; J.W1 = p.in[20]; J.ks = p.in[18]; J.dst = (bf16_t*)(ws + W_GU0); J.K = DM; J.ldw = DFF; break;
    case 3: J.mode = 1; J.W0 = p.in[21]; J.dst = (bf16_t*)(ws + W_DN0); J.K = DFF; J.ldw = DM; break;
    case 4: J.mode = 3; J.W0 = p.in[10]; J.ks = p.in[9]; J.dst = (bf16_t*)(ws + W_SIN); J.K = DM; J.ldw = SINW; break;
    case 5: J.mode = 1; J.W0 = p.in[17]; J.dst = (bf16_t*)(ws + W_SOUT); J.K = DIN; J.ldw = DM; break;
    case 6: J.mode = 2; J.W0 = p.in[19] + (size_t)DM * DFF; J.W1 = p.in[20] + (size_t)DM * DFF; J.ks = p.in[18] + DM; J.dst = (bf16_t*)(ws + W_GU1); J.K = DM; J.ldw = DFF; break;
    default: J.mode = 1; J.W0 = p.in[21] + (size_t)DFF * DM; J.dst = (bf16_t*)(ws + W_DN1); J.K = DFF; J.ldw = DM; break;
    }
    return J;
}
DI void wtile_load(const WJob& J, int tid, float (&v)[32], float& sc, int& srcok) {
    const int nk = J.K >> 8, c0 = (J.tix / nk) * 64, k0 = (J.tix % nk) * 256, cc = tid & 63; int src, which; wmap(J.mode, c0 + cc, src, sc, which);
    const float* W = (which ? J.W1 : J.W0) + (src >= 0 ? src : 0); srcok = (src >= 0);
#pragma unroll
    for (int i = 0; i < 32; ++i) { const int kk = (tid >> 6) + 8 * i; v[i] = __builtin_nontemporal_load(W + (size_t)(k0 + kk) * J.ldw); }
}
DI void wtile_store(LAS float* tile, const WJob& J, int tid, const float (&v)[32], float sc, int srcok) {
    const int nk = J.K >> 8, c0 = (J.tix / nk) * 64, k0 = (J.tix % nk) * 256, cc = tid & 63;
#pragma unroll
    for (int i = 0; i < 32; ++i) { const int kk = (tid >> 6) + 8 * i; float x = srcok ? v[i] * sc : 0.f; if (J.ks) x *= J.ks[k0 + kk]; tile[kk * 65 + cc] = x; }
    __syncthreads();
#pragma unroll
    for (int i = 0; i < 16; ++i) {
        const int idx = tid + 512 * i, c2 = idx >> 7, k2 = (idx & 127) * 2;
        *(unsigned*)(J.dst + (size_t)(c0 + c2) * J.K + k0 + k2) = pk2(tile[k2 * 65 + c2], tile[(k2 + 1) * 65 + c2]);
    }
    __syncthreads();
}
DI void wconv_jobs(LAS unsigned char* lds, const Params& p, int wi, int nb) {
    const int tid = otid(); const int total = 48 * 4 + 16 * 4 + 2 * (88 * 4 + 16 * 11) + 100 * 4 + 16 * 8;
    if (wi >= total) return;
    WJob J = wjob(p, wi); float v[32]; float sc; int ok;
    wtile_load(J, tid, v, sc, ok);
    for (int t = wi; t < total; t += nb) {
        const bool more = (t + nb < total);
        WJob Jn = J; float vn[32]; float scn = 0.f; int okn = 0;
        if (more) { Jn = wjob(p, t + nb); wtile_load(Jn, tid, vn, scn, okn); }
        wtile_store((LAS float*)lds, J, tid, v, sc, ok);
        if (more) { J = Jn; sc = scn; ok = okn;
#pragma unroll
            for (int i = 0; i < 32; ++i) v[i] = vn[i]; }
    }
}
DI void phase0(LAS unsigned char* lds, const Params& p) {
    const int tid = otid(), G = gridDim.x, bx = blockIdx.x;
    unsigned char* ws = p.ws;
    wconv_jobs(lds, p, bx, G);
    {
        const int wave = tid >> 6, lane = tid & 63; bf16_t* hb = (bf16_t*)(ws + O_HB); float* ss = (float*)(ws + O_SS);
        for (int row0 = (bx * 8 + wave) * 2; row0 < MT; row0 += G * 16) {
            f32x4 v[2][4];
#pragma unroll
            for (int q = 0; q < 2; ++q)
#pragma unroll
                for (int i = 0; i < 4; ++i) v[q][i] = __builtin_nontemporal_load((const f32x4*)(p.in[0] + (size_t)(row0 + q) * DM + lane * 4 + 256 * i));
#pragma unroll
            for (int q = 0; q < 2; ++q) {
                float sq = 0.f;
#pragma unroll
                for (int i = 0; i < 4; ++i) { const f32x4 x = v[q][i]; sq += x[0] * x[0] + x[1] * x[1] + x[2] * x[2] + x[3] * x[3];
                    u32x2 o; o[0] = pk2(x[0], x[1]); o[1] = pk2(x[2], x[3]); *(u32x2*)(hb + (size_t)(row0 + q) * DM + lane * 4 + 256 * i) = o; }
#pragma unroll
                for (int o = 32; o >= 1; o >>= 1) sq += __shfl_xor(sq, o);
                if (lane == 0) ss[row0 + q] = sq;
            }
        }
        for (int i = bx * 512 + tid; i < 4 * MT; i += G * 512) ss[MT + i] = 0.f;
        f32x2* tab = (f32x2*)(ws + O_ROPE);
        for (int i = bx * 512 + tid; i < SEQ * 32; i += G * 512) {
            const int pos = i >> 5, f = i & 31; const float inv = fexp2(-(float)f * 0.41524101186092f); const float ang = (float)pos * inv;
            double t = (double)ang * 0.15915494309189535; t -= floor(t); const float tf = (float)t;
            f32x2 cs; cs[0] = __builtin_amdgcn_cosf(tf); cs[1] = __builtin_amdgcn_sinf(tf); tab[i] = cs;
        }
        if (bx == 0 && tid == 0) { float s1 = 0.f, s2 = 0.f; for (int i = 0; i < 64; ++i) { s1 += p.in[3][i] * p.in[4][i]; s2 += p.in[5][i] * p.in[6][i]; }
            *(float*)(ws + O_LAM) = fexp2(s1 * LOG2E) - fexp2(s2 * LOG2E) + 0.2f; }
    }
}

struct EpiAttnIn {
    static constexpr bool PERM = true, AFTER_DRAIN = false;
    bf16_t* O; const float* ss; const f32x4* tab;
    DI void pre(const pg8::Unit& u, int wr, int fr, float (&e)[8]) const {
#pragma unroll
        for (int ai = 0; ai < 2; ++ai)
#pragma unroll
            for (int m = 0; m < 4; ++m) e[ai * 4 + m] = ss[u.pm * 256 + wr * 64 + fr + ai * 128 + m * 16];
    }
    DI void operator()(const f32x4 (&acc)[2][2][4][2], const pg8::Unit& u, int wr, int wc, int fr, int fq, const float (&epre)[8]) const {
        const int row0 = u.pm * 256 + wr * 64 + fr, colt = u.pn * 256, col0 = colt + wc * 32 + 8 * fq;
        const int fb = 4 * (4 * (wc & 1) + fq);
#pragma unroll
        for (int ai = 0; ai < 2; ++ai)
#pragma unroll
            for (int m = 0; m < 4; ++m) {
                const int row = row0 + ai * 128 + m * 16; const float rs = __builtin_amdgcn_rsqf(epre[ai * 4 + m] * (1.0f / 1024.0f) + 1e-6f);
                f32x4 c01 = {1.f, 0.f, 1.f, 0.f}, c23 = {1.f, 0.f, 1.f, 0.f};
                if (colt < 1024) { const int pos = row & (SEQ - 1); c01 = tab[(pos * 32 + fb) >> 1]; c23 = tab[((pos * 32 + fb) >> 1) + 1]; }
#pragma unroll
                for (int bj = 0; bj < 2; ++bj) {
                    f32x4 v0 = acc[ai][bj][m][0] * rs, v1 = acc[ai][bj][m][1] * rs;
                    if (colt < 1024) {
                        const float cs[4] = {c01[0], c01[2], c23[0], c23[2]}, sn[4] = {c01[1], c01[3], c23[1], c23[3]};
#pragma unroll
                        for (int j = 0; j < 4; ++j) { const float t1 = v0[j], t2 = v1[j]; v0[j] = t1 * cs[j] - t2 * sn[j]; v1[j] = t2 * cs[j] + t1 * sn[j]; }
                    }
                    u32x4 o; o[0] = pk2(v0[0], v0[1]); o[1] = pk2(v0[2], v0[3]); o[2] = pk2(v1[0], v1[1]); o[3] = pk2(v1[2], v1[3]);
                    *(u32x4*)(O + (size_t)row * AINW + col0 + bj * 128) = o;
                }
            }
    }
};
template <bool RES_F32, bool OUT_F32> struct EpiRes {
    static constexpr bool PERM = true, AFTER_DRAIN = false;
    const float* xres; bf16_t* hb; float* outf; float* ssn;
    DI void pre(const pg8::Unit&, int, int, float (&)[8]) const {}
    DI void operator()(const f32x4 (&acc)[2][2][4][2], const pg8::Unit& u, int wr, int wc, int fr, int fq, const float (&epre)[8]) const {
        const int row0 = u.pm * 256 + wr * 64 + fr, col0 = u.pn * 256 + wc * 32 + 8 * fq;
#pragma unroll
        for (int ai = 0; ai < 2; ++ai)
#pragma unroll
            for (int m = 0; m < 4; ++m) {
                const int row = row0 + ai * 128 + m * 16; float sq = 0.f;
#pragma unroll
                for (int bj = 0; bj < 2; ++bj) {
                    const size_t off = (size_t)row * DM + col0 + bj * 128; f32x4 r0, r1;
                    if (RES_F32) { r0 = *(const f32x4*)(xres + off); r1 = *(const f32x4*)(xres + off + 4); }
                    else { const u32x4 t = *(const u32x4*)(hb + off); r0[0] = bflo(t[0]); r0[1] = bfhi(t[0]); r0[2] = bflo(t[1]); r0[3] = bfhi(t[1]); r1[0] = bflo(t[2]); r1[1] = bfhi(t[2]); r1[2] = bflo(t[3]); r1[3] = bfhi(t[3]); }
                    const f32x4 v0 = r0 + acc[ai][bj][m][0], v1 = r1 + acc[ai][bj][m][1];
                    sq += v0[0] * v0[0] + v0[1] * v0[1] + v0[2] * v0[2] + v0[3] * v0[3] + v1[0] * v1[0] + v1[1] * v1[1] + v1[2] * v1[2] + v1[3] * v1[3];
                    if (OUT_F32) { *(f32x4*)(outf + off) = v0; *(f32x4*)(outf + off + 4) = v1; }
                    else { u32x4 o; o[0] = pk2(v0[0], v0[1]); o[1] = pk2(v0[2], v0[3]); o[2] = pk2(v1[0], v1[1]); o[3] = pk2(v1[2], v1[3]); *(u32x4*)(hb + off) = o; }
                }
                sq += __shfl_xor(sq, 16); sq += __shfl_xor(sq, 32);
                if (fq == 0) atomicAdd(ssn + row, sq);
            }
    }
};
struct EpiGU {
    static constexpr bool PERM = true, AFTER_DRAIN = false;
    bf16_t* act; const float* ss;
    DI void pre(const pg8::Unit& u, int wr, int fr, float (&e)[8]) const {
#pragma unroll
        for (int ai = 0; ai < 2; ++ai)
#pragma unroll
            for (int m = 0; m < 4; ++m) e[ai * 4 + m] = ss[u.pm * 256 + wr * 64 + fr + ai * 128 + m * 16];
    }
    DI void operator()(const f32x4 (&acc)[2][2][4][2], const pg8::Unit& u, int wr, int wc, int fr, int fq, const float (&epre)[8]) const {
        const int row0 = u.pm * 256 + wr * 64 + fr;
#pragma unroll
        for (int ai = 0; ai < 2; ++ai)
#pragma unroll
            for (int m = 0; m < 4; ++m) {
                const int row = row0 + ai * 128 + m * 16; const float rs = __builtin_amdgcn_rsqf(epre[ai * 4 + m] * (1.0f / 1024.0f) + 1e-6f);
                u32x4 o;
#pragma unroll
                for (int n = 0; n < 2; ++n) {
                    const f32x4 g = acc[ai][0][m][n] * rs, up = acc[ai][1][m][n] * rs; float a[4];
#pragma unroll
                    for (int j = 0; j < 4; ++j) a[j] = fsilu(g[j]) * up[j];
                    o[2 * n] = pk2(a[0], a[1]); o[2 * n + 1] = pk2(a[2], a[3]);
                }
                *(u32x4*)(act + (size_t)row * DFF + u.pn * 128 + wc * 32 + 8 * fq) = o;
            }
    }
};
struct EpiSsdIn {
    static constexpr bool PERM = true, AFTER_DRAIN = false;
    bf16_t* z; bf16_t* xbc; float* dt; const float* ss;
    DI void pre(const pg8::Unit& u, int wr, int fr, float (&e)[8]) const {
#pragma unroll
        for (int ai = 0; ai < 2; ++ai)
#pragma unroll
            for (int m = 0; m < 4; ++m) e[ai * 4 + m] = ss[u.pm * 256 + wr * 64 + fr + ai * 128 + m * 16];
    }
    DI void operator()(const f32x4 (&acc)[2][2][4][2], const pg8::Unit& u, int wr, int wc, int fr, int fq, const float (&epre)[8]) const {
        const int row0 = u.pm * 256 + wr * 64 + fr, col0 = u.pn * 256 + wc * 32 + 8 * fq;
#pragma unroll
        for (int ai = 0; ai < 2; ++ai)
#pragma unroll
            for (int m = 0; m < 4; ++m) {
                const int row = row0 + ai * 128 + m * 16; const float rs = __builtin_amdgcn_rsqf(epre[ai * 4 + m] * (1.0f / 1024.0f) + 1e-6f);
#pragma unroll
                for (int bj = 0; bj < 2; ++bj) {
                    const int c = col0 + bj * 128; const f32x4 v0 = acc[ai][bj][m][0] * rs, v1 = acc[ai][bj][m][1] * rs;
                    if (c < 6144) { u32x4 o; o[0] = pk2(v0[0], v0[1]); o[1] = pk2(v0[2], v0[3]); o[2] = pk2(v1[0], v1[1]); o[3] = pk2(v1[2], v1[3]);
                        if (c < DIN) *(u32x4*)(z + (size_t)row * DIN + c) = o; else *(u32x4*)(xbc + (size_t)row * XBCW + (c - DIN)) = o; }
                }
            }
    }
};

struct EpiFinal {
    static constexpr bool PERM = true, AFTER_DRAIN = true;
    const bf16_t* hb; float* outf; float* ssn; unsigned* cnt; const float* fw;
    DI void operator()(const f32x4 (&)[2][2][4][2], const pg8::Unit&, int, int, int, int, const float (&)[8]) const {}
    DI void pre(const pg8::Unit&, int, int, float (&)[8]) const {}
    DI void fused(f32x4 (&acc)[2][2][4][2], const pg8::Unit& u, int wr, int wc, int fr, int fq, PG8_LAS unsigned char*, int, int) const {
        const int row0 = u.pm * 256 + wr * 64 + fr, col0 = u.pn * 256 + wc * 32 + 8 * fq;
#pragma unroll
        for (int ai = 0; ai < 2; ++ai)
#pragma unroll
            for (int m = 0; m < 4; ++m) {
                const int row = row0 + ai * 128 + m * 16; float sq = 0.f;
#pragma unroll
                for (int bj = 0; bj < 2; ++bj) {
                    const size_t off = (size_t)row * DM + col0 + bj * 128;
                    const u32x4 t = *(const u32x4*)(hb + off);
#pragma unroll
                    for (int n = 0; n < 2; ++n) {
                        f32x4 r; r[0] = bflo(t[2 * n]); r[1] = bfhi(t[2 * n]); r[2] = bflo(t[2 * n + 1]); r[3] = bfhi(t[2 * n + 1]);
                        const f32x4 v = r + acc[ai][bj][m][n]; acc[ai][bj][m][n] = v;
                        sq += v[0] * v[0] + v[1] * v[1] + v[2] * v[2] + v[3] * v[3];
                    }
                }
                sq += __shfl_xor(sq, 16); sq += __shfl_xor(sq, 32);
                if (fq == 0) atomicAdd(ssn + row, sq);
            }
        asm volatile("s_waitcnt vmcnt(0)" ::: "memory");
        __syncthreads();
        unsigned* c = cnt + 16 * u.pm;
        if (threadIdx.x == 0) {
            __builtin_amdgcn_fence(__ATOMIC_RELEASE, "agent"); asm volatile("s_waitcnt vmcnt(0)" ::: "memory");
            __hip_atomic_fetch_add(c, 1u, __ATOMIC_RELAXED, __HIP_MEMORY_SCOPE_AGENT);
            unsigned spins = 0;
            while (__hip_atomic_load(c, __ATOMIC_RELAXED, __HIP_MEMORY_SCOPE_AGENT) < 4u && ++spins < (1u << 22)) __builtin_amdgcn_s_sleep(2);
            __builtin_amdgcn_fence(__ATOMIC_ACQUIRE, "agent"); asm volatile("s_waitcnt vmcnt(0)" ::: "memory");
        }
        __syncthreads();
#pragma unroll
        for (int ai = 0; ai < 2; ++ai)
#pragma unroll
            for (int m = 0; m < 4; ++m) {
                const int row = row0 + ai * 128 + m * 16;
                const float rs = __builtin_amdgcn_rsqf(__hip_atomic_load(ssn + row, __ATOMIC_RELAXED, __HIP_MEMORY_SCOPE_AGENT) * (1.0f / 1024.0f) + 1e-6f);
#pragma unroll
                for (int bj = 0; bj < 2; ++bj)
#pragma unroll
                    for (int n = 0; n < 2; ++n) {
                        const int col = col0 + bj * 128 + n * 4; const f32x4 w = *(const f32x4*)(fw + col);
                        *(f32x4*)(outf + (size_t)row * DM + col) = acc[ai][bj][m][n] * rs * w;
                    }
            }
    }
};
constexpr int KST = 144, VST = 320, VST64 = 192;
constexpr int AT_K1 = 0, AT_K2 = 64 * KST, AT_V = 2 * 64 * KST, AT_STAGE = AT_V + 64 * VST;

DI void diff_tile(LAS unsigned char* lds, const bf16_t* proj, bf16_t* mixed, const float* subln, float lam, int b, int hd, int qt) {
    const int tid = otid(), w = __builtin_amdgcn_readfirstlane(tid >> 6), lane = tid & 63, qg = w & 3, mp = w >> 2, r = lane & 31, h = lane >> 5;
    const int q0 = qt * 128; const size_t rowb = (size_t)b * SEQ;
    bf16x8 qf[4];
    { const bf16_t* qp = proj + (rowb + q0 + 32 * qg + r) * AINW + hd * 128 + mp * 64 + 8 * h;
#pragma unroll
      for (int s = 0; s < 4; ++s) qf[s] = *(const bf16x8*)(qp + 16 * s); }
    f32x16 O[4];
#pragma unroll
    for (int i = 0; i < 4; ++i) O[i] = zero16();
    float mrun = 0.f, lrun = 0.f;
    const int nsteps = 2 * (qt + 1);
    const bf16_t* src[4]; int dst[4];
#pragma unroll
    for (int i = 0; i < 2; ++i) { const int cid = tid + 512 * i, row = cid >> 4, c16 = cid & 15;
        src[i] = proj + (rowb + row) * AINW + 512 + hd * 128 + c16 * 8; dst[i] = (c16 < 8 ? AT_K1 : AT_K2) + row * KST + (c16 & 7) * 16;
        src[2 + i] = proj + (rowb + row) * AINW + 1024 + hd * 128 + c16 * 8; dst[2 + i] = AT_V + row * VST + c16 * 16; }
    u32x4 pf[4];
#pragma unroll
    for (int i = 0; i < 4; ++i) pf[i] = *(const u32x4*)(src[i]);
#pragma unroll
    for (int i = 0; i < 4; ++i) *(LAS u32x4*)(lds + dst[i]) = pf[i];
    __syncthreads();
    const int i16 = lane & 15, tq = i16 >> 2, tp = i16 & 3, g16 = (lane >> 4) & 1;
    const int troff = (4 * h + tq) * VST + (16 * g16 + 4 * tp) * 2;
    for (int j = 0; j < nsteps; ++j) {
        const bool more = (j + 1 < nsteps);
        if (more) {
#pragma unroll
            for (int i = 0; i < 4; ++i) pf[i] = *(const u32x4*)(src[i] + (size_t)(j + 1) * 64 * AINW);
        }
        const LAS unsigned char* base = lds + (j & 1) * AT_STAGE;
        const LAS unsigned char* Kb = base + (mp ? AT_K2 : AT_K1);
        const LAS unsigned char* Vb = base + AT_V;
        f32x16 S[2];
        const float negm = -mrun;
#pragma unroll
        for (int kt = 0; kt < 2; ++kt) {
#pragma unroll
            for (int i = 0; i < 16; ++i) S[kt][i] = negm;
#pragma unroll
            for (int s = 0; s < 4; ++s) { const bf16x8 kf = *(const LAS bf16x8*)(Kb + (32 * kt + r) * KST + (16 * s + 8 * h) * 2); S[kt] = MFMA32(kf, qf[s], S[kt]); } }
        const int qidx = q0 + 32 * qg + r, kbase = 64 * j;
        if (kbase + 63 > q0 + 32 * qg) {
#pragma unroll
            for (int kt = 0; kt < 2; ++kt)
#pragma unroll
                for (int i = 0; i < 16; ++i) if (kbase + 32 * kt + crow(i, h) > qidx) S[kt][i] = -1e30f;
        }
        float mx = S[0][0];
#pragma unroll
        for (int kt = 0; kt < 2; ++kt)
#pragma unroll
            for (int i = 0; i < 16; ++i) mx = fmaxf(mx, S[kt][i]);
        mx = fmaxf(mx, __shfl_xor(mx, 32));
        if (j == 0 || __builtin_amdgcn_ballot_w64(mx > 8.0f) != 0ull) {
            const float d = (j == 0) ? mx : fmaxf(mx, 0.f);
            mrun += d;
            if (j != 0) { const float alpha = fexp2(-d); lrun *= alpha;
#pragma unroll
                for (int vt = 0; vt < 4; ++vt) O[vt] = O[vt] * alpha; }
#pragma unroll
            for (int kt = 0; kt < 2; ++kt)
#pragma unroll
                for (int i = 0; i < 16; ++i) S[kt][i] -= d;
        }
        float ls = 0.f;
#pragma unroll
        for (int kt = 0; kt < 2; ++kt)
#pragma unroll
            for (int i = 0; i < 16; ++i) { const float pv = fexp2(S[kt][i]); S[kt][i] = pv; ls += pv; }
        lrun += ls;
#pragma unroll
        for (int kt = 0; kt < 2; ++kt)
#pragma unroll
            for (int s2 = 0; s2 < 2; ++s2) {
                const bf16x8 pfr = pack8(S[kt], s2);
                const LAS unsigned char* vrow = Vb + (32 * kt + 16 * s2) * VST + troff;
#pragma unroll
                for (int vt = 0; vt < 4; ++vt) { const bf16x8 vf = tr2(vrow + vt * 64, vrow + 8 * VST + vt * 64); O[vt] = MFMA32(vf, pfr, O[vt]); }
            }
        if (more) {
            LAS unsigned char* nb = lds + ((j + 1) & 1) * AT_STAGE;
#pragma unroll
            for (int i = 0; i < 4; ++i) *(LAS u32x4*)(nb + dst[i]) = pf[i];
        }
        __syncthreads();
    }
    lrun += __shfl_xor(lrun, 32);
    const float inv = frcp(lrun);
    LAS float* ex = (LAS float*)lds;
    if (mp == 1) {
        const float sc = inv * lam;
#pragma unroll
        for (int vt = 0; vt < 4; ++vt)
#pragma unroll
            for (int i = 0; i < 16; ++i) ex[(qg * 128 + 32 * vt + crow(i, h)) * 32 + r] = O[vt][i] * sc;
    }
    __syncthreads();
    if (mp == 0) {
        float sq = 0.f;
#pragma unroll
        for (int vt = 0; vt < 4; ++vt)
#pragma unroll
            for (int i = 0; i < 16; ++i) { const float o = O[vt][i] * inv - ex[(qg * 128 + 32 * vt + crow(i, h)) * 32 + r]; O[vt][i] = o; sq += o * o; }
        sq += __shfl_xor(sq, 32);
        const float rn = __builtin_amdgcn_rsqf(sq * (1.0f / 128.0f) + 1e-5f) * 0.8f;
        bf16_t* op = mixed + (rowb + q0 + 32 * qg + r) * DM + hd * 128;
#pragma unroll
        for (int vt = 0; vt < 4; ++vt)
#pragma unroll
            for (int gq = 0; gq < 4; ++gq) { const int v0 = 32 * vt + 8 * gq + 4 * h; const f32x4 wv = *(const f32x4*)(subln + v0);
                u32x2 o; o[0] = pk2(O[vt][4 * gq] * rn * wv[0], O[vt][4 * gq + 1] * rn * wv[1]); o[1] = pk2(O[vt][4 * gq + 2] * rn * wv[2], O[vt][4 * gq + 3] * rn * wv[3]);
                *(u32x2*)(op + v0) = o; }
    }
    __syncthreads();
}

constexpr int SB_K = 0, SB_V = 64 * KST, SB_STAGE = 64 * KST + 64 * VST64;
DI void sb_tile(const LAS unsigned char* base, int kbase, int qidx, const bf16x8 (&qf)[4], f32x16 (&O)[2], float& carry, int r, int h, int troff) {
#pragma unroll
    for (int kt = 1; kt >= 0; --kt) {
        f32x16 S = zero16();
#pragma unroll
        for (int s = 0; s < 4; ++s) { const bf16x8 kf = *(const LAS bf16x8*)(base + SB_K + (32 * kt + r) * KST + (16 * s + 8 * h) * 2); S = MFMA32(kf, qf[s], S); }
        float T[4], sfx[16];
#pragma unroll
        for (int gq = 0; gq < 4; ++gq) {
            float run = 1.0f;
#pragma unroll
            for (int jj = 3; jj >= 0; --jj) {
                const int i = 4 * gq + jj; const bool valid = (kbase + 32 * kt + crow(i, h)) < qidx;
                const float zz = fmaxf(S[i], -60.0f); const float e = fexp2(-LOG2E * zz); const float sg = frcp(1.0f + e);
                const float keep = valid ? e * sg : 1.0f;
                S[i] = valid ? sg : 0.0f; sfx[i] = run; run *= keep;
            }
            T[gq] = run;
        }
        float To[4];
#pragma unroll
        for (int gq = 0; gq < 4; ++gq) To[gq] = __shfl_xor(T[gq], 32);
        float E[4]; float acc_hi = 1.0f;
#pragma unroll
        for (int gq = 3; gq >= 0; --gq) { const float above_same = acc_hi; E[gq] = (h == 0) ? above_same * To[gq] : above_same; acc_hi = acc_hi * T[gq] * To[gq]; }
#pragma unroll
        for (int i = 0; i < 16; ++i) S[i] = S[i] * carry * E[i >> 2] * sfx[i];
        carry *= acc_hi;
#pragma unroll
        for (int s2 = 0; s2 < 2; ++s2) {
            const bf16x8 pfr = pack8(S, s2);
            const LAS unsigned char* vrow = base + SB_V + (32 * kt + 16 * s2) * VST64 + troff;
#pragma unroll
            for (int vt = 0; vt < 2; ++vt) { const bf16x8 vf = tr2(vrow + vt * 64, vrow + 8 * VST64 + vt * 64); O[vt] = MFMA32(vf, pfr, O[vt]); }
        }
    }
}
DI void sb_block(LAS unsigned char* lds, const bf16_t* proj, bf16_t* mixed, int b, int hs, int qb) {
    const int tid = otid(), w = __builtin_amdgcn_readfirstlane(tid >> 6), lane = tid & 63, r = lane & 31, h = lane >> 5;
    const int q0 = qb * 256; const size_t rowb = (size_t)b * SEQ;
    const int qidx = q0 + 32 * w + r;
    bf16x8 qf[4];
    { const bf16_t* qp = proj + (rowb + qidx) * AINW + 1536 + hs * 64 + 8 * h;
#pragma unroll
      for (int s = 0; s < 4; ++s) qf[s] = *(const bf16x8*)(qp + 16 * s); }
    f32x16 O[2]; O[0] = zero16(); O[1] = zero16();
    float carry = 1.0f;
    const int jmax = 4 * qb + 3;
    const int srow = tid >> 3, sc8 = tid & 7;
    const bf16_t* srcK = proj + (rowb + srow) * AINW + 2048 + hs * 64 + sc8 * 8;
    const bf16_t* srcV = proj + (rowb + srow) * AINW + 2560 + hs * 64 + sc8 * 8;
    const int dstK = SB_K + srow * KST + sc8 * 16, dstV = SB_V + srow * VST64 + sc8 * 16;
    constexpr int NPRE = 6;
    {
        u32x4 pk_[NPRE], pv_[NPRE];
#pragma unroll
        for (int s = 0; s < NPRE; ++s) { const int jj = (jmax - s) > 0 ? (jmax - s) : 0; pk_[s] = *(const u32x4*)(srcK + (size_t)jj * 64 * AINW); pv_[s] = *(const u32x4*)(srcV + (size_t)jj * 64 * AINW); }
#pragma unroll
        for (int s = 0; s < NPRE; ++s) { *(LAS u32x4*)(lds + s * SB_STAGE + dstK) = pk_[s]; *(LAS u32x4*)(lds + s * SB_STAGE + dstV) = pv_[s]; }
    }
    __syncthreads();
    const int i16 = lane & 15, tq = i16 >> 2, tp = i16 & 3, g16 = (lane >> 4) & 1;
    const int troff = (4 * h + tq) * VST64 + (16 * g16 + 4 * tp) * 2;
    bool wdone = false;
    int j = (q0 + 32 * w + 31) >> 6;
    for (; j >= 0 && j > jmax - NPRE; --j) {
        sb_tile(lds + (jmax - j) * SB_STAGE, 64 * j, qidx, qf, O, carry, r, h, troff);
        if (__builtin_amdgcn_ballot_w64(carry >= 1e-12f) == 0ull) { wdone = true; break; }
    }
    if (j < 0) wdone = true;
    for (int jj = jmax - NPRE, it = 0; ; --jj, ++it) {
        LAS int* flg = (LAS int*)(lds + NPRE * SB_STAGE) + (it & 1) * 8;
        if (lane == 0) flg[w] = wdone ? 1 : 0;
        __syncthreads();
        int all = 1;
#pragma unroll
        for (int ww = 0; ww < 8; ++ww) all &= flg[ww];
        if (all || jj < 0) break;
        const u32x4 a_ = *(const u32x4*)(srcK + (size_t)jj * 64 * AINW), b_ = *(const u32x4*)(srcV + (size_t)jj * 64 * AINW);
        *(LAS u32x4*)(lds + dstK) = a_; *(LAS u32x4*)(lds + dstV) = b_;
        __syncthreads();
        if (!wdone) { sb_tile(lds, 64 * jj, qidx, qf, O, carry, r, h, troff); if (__builtin_amdgcn_ballot_w64(carry >= 1e-12f) == 0ull || jj == 0) wdone = true; }
    }
    bf16_t* op = mixed + (rowb + qidx) * DM + 512 + hs * 64;
#pragma unroll
    for (int vt = 0; vt < 2; ++vt)
#pragma unroll
        for (int gq = 0; gq < 4; ++gq) { const int v0 = 32 * vt + 8 * gq + 4 * h;
            u32x2 o; o[0] = pk2(O[vt][4 * gq], O[vt][4 * gq + 1]); o[1] = pk2(O[vt][4 * gq + 2], O[vt][4 * gq + 3]); *(u32x2*)(op + v0) = o; }
    __syncthreads();
}
DI void attn_phase(LAS unsigned char* lds, const Params& p) {
    const bf16_t* proj = (const bf16_t*)(p.ws + O_PROJ); bf16_t* mixed = (bf16_t*)(p.ws + O_MIXED);
    const float lam = *(const float*)(p.ws + O_LAM);
    for (int it0 = blockIdx.x; it0 < 256; it0 += gridDim.x) {
        const int it = (it0 & 7) * 32 + (it0 >> 3);
        const int b = it >> 7, hd = (it >> 5) & 3, pr = it & 31;
        diff_tile(lds, proj, mixed, p.in[7], lam, b, hd, 63 - pr);
        diff_tile(lds, proj, mixed, p.in[7], lam, b, hd, pr);
    }
    for (int it0 = blockIdx.x; it0 < 512; it0 += gridDim.x) {
        const int it = (it0 & 7) * 64 + (it0 >> 3);
        const int b = it >> 8, hs = (it >> 5) & 7, qb = it & 31;
        sb_block(lds, proj, mixed, b, hs, qb);
    }
}
constexpr int SXS = 528, SXS2 = 576, SBS = 272, SBS2 = 320;
constexpr int L_SX = 0, L_SB = 128 * SXS2, L_SC = L_SB + 128 * SBS, L_SDT = L_SC + 128 * SBS, L_SAC = L_SDT + 2048, L_SSQ = L_SAC + 2048;
static_assert(L_SSQ + 4096 <= LDS_BYTES, "lds");

DI void ssd_dt_acum(LAS unsigned char* lds, const float* DT, const float* dt_bias, const float* a_log, size_t t0, int g) {
    LAS float* sdt = (LAS float*)(lds + L_SDT); LAS float* sac = (LAS float*)(lds + L_SAC);
    const int tid = otid(), hh = tid >> 7, l = tid & 127, head = 4 * g + hh, w = tid >> 6, lane = tid & 63;
    const float raw = DT[(t0 + l) * 32 + head] + dt_bias[head];
    const float dt = fmaxf(raw, 0.f) + __logf(1.0f + __expf(-fabsf(raw)));
    sdt[hh * 128 + l] = dt; sac[hh * 128 + l] = -dt * __expf(a_log[head]);
    __syncthreads();
    if (w < 4) {
        const float v0 = sac[w * 128 + 2 * lane], v1 = sac[w * 128 + 2 * lane + 1]; float s = v0 + v1;
#pragma unroll
        for (int off = 1; off < 64; off <<= 1) { const float t = __shfl_up(s, off); if (lane >= off) s += t; }
        const float ex = s - (v0 + v1);
        sac[w * 128 + 2 * lane] = ex + v0; sac[w * 128 + 2 * lane + 1] = ex + v0 + v1;
    }
    __syncthreads();
}
template <int NT, class F> DI void conv_strip(const bf16_t* src, int nzero, const float* cw, const float* cb, int ch, F&& emit) {
    f32x4 wlo[4], whi[4];
#pragma unroll
    for (int k = 0; k < 4; ++k) { wlo[k] = *(const f32x4*)(cw + k * XBCW + ch); whi[k] = *(const f32x4*)(cw + k * XBCW + ch + 4); }
    const f32x4 blo = *(const f32x4*)(cb + ch), bhi = *(const f32x4*)(cb + ch + 4);
    u32x4 raw[NT + 3];
#pragma unroll
    for (int i = 0; i < NT + 3; ++i) { const int ii = (i < nzero) ? nzero : i; raw[i] = *(const u32x4*)(src + (ptrdiff_t)(ii - 3) * XBCW); if (i < nzero) raw[i] = (u32x4){0u, 0u, 0u, 0u}; }
#pragma unroll
    for (int t = 0; t < NT; ++t) {
        float o[8];
#pragma unroll
        for (int e = 0; e < 8; ++e) {
            float a = (e < 4) ? blo[e & 3] : bhi[e & 3];
#pragma unroll
            for (int k = 0; k < 4; ++k) { const unsigned d = raw[t + k][e >> 1]; const float xv = (e & 1) ? bfhi(d) : bflo(d); a += ((e < 4) ? wlo[k][e & 3] : whi[k][e & 3]) * xv; }
            o[e] = fsilu(a);
        }
        emit(t, o);
    }
}
DI u32x4 pack8f(const float* o) { u32x4 r; r[0] = pk2(o[0], o[1]); r[1] = pk2(o[2], o[3]); r[2] = pk2(o[4], o[5]); r[3] = pk2(o[6], o[7]); return r; }

template <bool XW, bool WITH_C> DI void ssd_stage(LAS unsigned char* lds, const bf16_t* xbc, const float* cw, const float* cb, size_t t0, int c, int g) {
    const int tid = otid();
    LAS float* sdt = (LAS float*)(lds + L_SDT); LAS float* sac = (LAS float*)(lds + L_SAC);
    {
        const int c8 = tid & 31, tg = tid >> 5, l0 = 8 * tg, ch = 256 * g + 8 * c8, hh = c8 >> 3;
        const int nzero = (c == 0) ? (3 - l0 > 0 ? 3 - l0 : 0) : 0;
        const float alast = sac[hh * 128 + 127];
        conv_strip<8>(xbc + (t0 + l0) * XBCW + ch, nzero, cw, cb, ch, [&](int t, float* o) {
            if (XW) { const float wgt = sdt[hh * 128 + l0 + t] * __expf(alast - sac[hh * 128 + l0 + t]);
#pragma unroll
                for (int e = 0; e < 8; ++e) o[e] *= wgt; }
            *(LAS u32x4*)(lds + L_SX + (l0 + t) * (XW ? SXS2 : SXS) + c8 * 16) = pack8f(o); });
    }
    {
        const int c8 = tid & 15, tg = tid >> 4, l0 = 4 * tg;
        const int nzero = (c == 0) ? (3 - l0 > 0 ? 3 - l0 : 0) : 0;
        const int chb = DIN + 128 * g + 8 * c8;
        conv_strip<4>(xbc + (t0 + l0) * XBCW + chb, nzero, cw, cb, chb, [&](int t, float* o) { *(LAS u32x4*)(lds + L_SB + (l0 + t) * (XW ? SBS2 : SBS) + c8 * 16) = pack8f(o); });
        if (WITH_C) { const int chc = DIN + 1024 + 128 * g + 8 * c8;
            conv_strip<4>(xbc + (t0 + l0) * XBCW + chc, nzero, cw, cb, chc, [&](int t, float* o) { *(LAS u32x4*)(lds + L_SC + (l0 + t) * SBS + c8 * 16) = pack8f(o); }); }
    }
}
DI bf16_t* st_ptr(unsigned char* ws, int b) { return (bf16_t*)(ws + (b ? O_ST1 : O_ST0)); }

DI void ssd_states_phase(LAS unsigned char* lds, const Params& p) {
    const int tid = otid(), w = __builtin_amdgcn_readfirstlane(tid >> 6), lane = tid & 63, r = lane & 31, h = lane >> 5, hh = w >> 1, ph = w & 1;
    const bf16_t* xbc = (const bf16_t*)(p.ws + O_XBC); const float* DT = (const float*)(p.ws + O_DT); float* cdec = (float*)(p.ws + O_CDEC);
    const int i16 = lane & 15, tq = i16 >> 2, tp = i16 & 3, g16 = (lane >> 4) & 1;
    for (int it = blockIdx.x; it < 1024; it += gridDim.x) {
        const int b = it >> 9, c = (it >> 3) & 63, g = it & 7; const size_t t0 = (size_t)b * SEQ + (size_t)c * 128;
        ssd_dt_acum(lds, DT, p.in[13], p.in[14], t0, g);
        ssd_stage<true, false>(lds, xbc, p.in[11], p.in[12], t0, c, g);
        __syncthreads();
        f32x16 acc[4];
#pragma unroll
        for (int i = 0; i < 4; ++i) acc[i] = zero16();
        const LAS unsigned char* xa = lds + L_SX + (8 * h + tq) * SXS2 + (64 * hh + 32 * ph + 16 * g16 + 4 * tp) * 2;
        const LAS unsigned char* ba = lds + L_SB + (8 * h + tq) * SBS2 + (16 * g16 + 4 * tp) * 2;
#pragma unroll
        for (int s = 0; s < 8; ++s) {
            const bf16x8 af = tr2(xa + 16 * s * SXS2, xa + (16 * s + 4) * SXS2);
#pragma unroll
            for (int nt = 0; nt < 4; ++nt) { const bf16x8 bfr = tr2(ba + 16 * s * SBS2 + nt * 64, ba + (16 * s + 4) * SBS2 + nt * 64); acc[nt] = MFMA32(af, bfr, acc[nt]); }
        }
        bf16_t* st = st_ptr(p.ws, b) + ((size_t)(c * 32 + 4 * g + hh) * 64 + 32 * ph) * 128;
#pragma unroll
        for (int nt = 0; nt < 4; ++nt)
#pragma unroll
            for (int i = 0; i < 16; ++i) st[(size_t)crow(i, h) * 128 + 32 * nt + r] = (bf16_t)(pk2(acc[nt][i], 0.f) & 0xffffu);
        if (tid < 4) cdec[(b * 64 + c) * 32 + 4 * g + tid] = __expf(((LAS float*)(lds + L_SAC))[tid * 128 + 127]);
        __syncthreads();
    }
}
DI void ssd_scan_phase(const Params& p, const bool dry) {
    const float* cdec = (const float*)(p.ws + O_CDEC);
    for (int e = blockIdx.x * 512 + threadIdx.x; e < 2 * 32 * 64 * 32; e += gridDim.x * 512) {
        const int b = e >> 16, rem = e & 65535, head = rem >> 11;
        bf16_t* st = st_ptr(p.ws, b) + (size_t)rem * 4;
        float carry[4] = {0.f, 0.f, 0.f, 0.f};
        for (int c0 = 0; c0 < 64; c0 += 8) {
            u32x2 v[8]; float dc[8];
#pragma unroll
            for (int u = 0; u < 8; ++u) { v[u] = *(const u32x2*)(st + (size_t)(c0 + u) * 262144); dc[u] = cdec[(b * 64 + c0 + u) * 32 + head]; }
#pragma unroll
            for (int u = 0; u < 8; ++u) {
                u32x2 o; o[0] = pk2(carry[0], carry[1]); o[1] = pk2(carry[2], carry[3]); if (!dry) *(u32x2*)(st + (size_t)(c0 + u) * 262144) = o;
                carry[0] = carry[0] * dc[u] + bflo(v[u][0]); carry[1] = carry[1] * dc[u] + bfhi(v[u][0]); carry[2] = carry[2] * dc[u] + bflo(v[u][1]); carry[3] = carry[3] * dc[u] + bfhi(v[u][1]);
            }
        }
    }
}
DI void ssd_out_phase(LAS unsigned char* lds, const Params& p, const bool dry) {
    const int tid = otid(), w = __builtin_amdgcn_readfirstlane(tid >> 6), lane = tid & 63, r = lane & 31, h = lane >> 5, hh = w >> 1, ph = w & 1;
    const bf16_t* xbc = (const bf16_t*)(p.ws + O_XBC); const float* DT = (const float*)(p.ws + O_DT); bf16_t* zy = (bf16_t*)p.out;
    LAS float* sdt = (LAS float*)(lds + L_SDT); LAS float* sac = (LAS float*)(lds + L_SAC); LAS float* ssq = (LAS float*)(lds + L_SSQ);
    const int i16 = lane & 15, tq = i16 >> 2, tp = i16 & 3, g16 = (lane >> 4) & 1;
    for (int it = blockIdx.x; it < 1024; it += gridDim.x) {
        const int b = it >> 9, c = (it >> 3) & 63, g = it & 7, head = 4 * g + hh; const size_t t0 = (size_t)b * SEQ + (size_t)c * 128;
        ssd_dt_acum(lds, DT, p.in[13], p.in[14], t0, g);
        ssd_stage<false, true>(lds, xbc, p.in[11], p.in[12], t0, c, g);
        bf16x8 pvf[8];
        { const bf16_t* pp = st_ptr(p.ws, b) + ((size_t)(c * 32 + head) * 64 + 32 * ph + r) * 128 + 8 * h;
#pragma unroll
          for (int s = 0; s < 8; ++s) pvf[s] = *(const bf16x8*)(pp + 16 * s); }
        __syncthreads();
        f32x16 Y[4];
        const LAS unsigned char* xa = lds + L_SX + (4 * h + tq) * SXS + (64 * hh + 32 * ph + 16 * g16 + 4 * tp) * 2;
#pragma unroll
        for (int lt = 0; lt < 4; ++lt) {
            __builtin_amdgcn_sched_barrier(0);
            f32x16 y = zero16();
#pragma unroll
            for (int s = 0; s < 8; ++s) { const bf16x8 cfs = *(const LAS bf16x8*)(lds + L_SC + (32 * lt + r) * SBS + (16 * s + 8 * h) * 2); y = MFMA32(pvf[s], cfs, y); }
            Y[lt] = y * __expf(sac[hh * 128 + 32 * lt + r]);
        }
#pragma unroll
        for (int lt = 0; lt < 4; ++lt) {
            __builtin_amdgcn_sched_barrier(0);
            bf16x8 cf[8];
#pragma unroll
            for (int s = 0; s < 8; ++s) cf[s] = *(const LAS bf16x8*)(lds + L_SC + (32 * lt + r) * SBS + (16 * s + 8 * h) * 2);
            const float al = sac[hh * 128 + 32 * lt + r];
#pragma unroll
            for (int mt = 0; mt < 4; ++mt) {
                if (mt <= lt) {
                    __builtin_amdgcn_sched_barrier(0);
                    f32x16 X = zero16();
#pragma unroll
                    for (int s = 0; s < 8; ++s) { const bf16x8 bfr = *(const LAS bf16x8*)(lds + L_SB + (32 * mt + r) * SBS + (16 * s + 8 * h) * 2); X = MFMA32(bfr, cf[s], X); }
#pragma unroll
                    for (int gq = 0; gq < 4; ++gq) {
                        const f32x4 am = *(const LAS f32x4*)(sac + hh * 128 + 32 * mt + 8 * gq + 4 * h), dm = *(const LAS f32x4*)(sdt + hh * 128 + 32 * mt + 8 * gq + 4 * h);
#pragma unroll
                        for (int jj = 0; jj < 4; ++jj) { const int mrow = 32 * mt + 8 * gq + 4 * h + jj; const bool ok = (32 * lt + r) >= mrow;
                            const float dec = ok ? __expf(fminf(al - am[jj], 0.f)) * dm[jj] : 0.f; X[4 * gq + jj] *= dec; }
                    }
#pragma unroll
                    for (int s2 = 0; s2 < 2; ++s2) { const bf16x8 xs = pack8(X, s2);
                        const LAS unsigned char* xr = xa + (32 * mt + 16 * s2) * SXS; const bf16x8 xf = tr2(xr, xr + 8 * SXS); Y[lt] = MFMA32(xf, xs, Y[lt]); }
                }
            }
        }
        __builtin_amdgcn_sched_barrier(0);
        const float Dh = p.in[15][head];
        float sq[4];
#pragma unroll
        for (int lt = 0; lt < 4; ++lt) {
            const int l = 32 * lt + r; sq[lt] = 0.f;
#pragma unroll
            for (int gq = 0; gq < 4; ++gq) {
                const int chl = 64 * hh + 32 * ph + 8 * gq + 4 * h;
                const u32x2 xv = *(const LAS u32x2*)(lds + L_SX + l * SXS + chl * 2);
                const u32x2 zv = *(const u32x2*)(zy + (t0 + l) * DIN + 256 * g + chl);
                const float xf4[4] = {bflo(xv[0]), bfhi(xv[0]), bflo(xv[1]), bfhi(xv[1])}, zf4[4] = {bflo(zv[0]), bfhi(zv[0]), bflo(zv[1]), bfhi(zv[1])};
#pragma unroll
                for (int jj = 0; jj < 4; ++jj) { const float yv = (Y[lt][4 * gq + jj] + Dh * xf4[jj]) * fsilu(zf4[jj]); Y[lt][4 * gq + jj] = yv; sq[lt] += yv * yv; }
            }
            sq[lt] += __shfl_xor(sq[lt], 32);
            if (h == 0) ssq[w * 128 + l] = sq[lt];
        }
        __syncthreads();
#pragma unroll
        for (int lt = 0; lt < 4; ++lt) {
            const int l = 32 * lt + r; float tot = 0.f;
#pragma unroll
            for (int ww = 0; ww < 8; ++ww) tot += ssq[ww * 128 + l];
            const float rn = __builtin_amdgcn_rsqf(tot * (1.0f / 256.0f) + 1e-5f);
#pragma unroll
            for (int gq = 0; gq < 4; ++gq) {
                const int chl = 64 * hh + 32 * ph + 8 * gq + 4 * h; const f32x4 gw = *(const f32x4*)(p.in[16] + 256 * g + chl);
                u32x2 o; o[0] = pk2(Y[lt][4 * gq] * rn * gw[0], Y[lt][4 * gq + 1] * rn * gw[1]); o[1] = pk2(Y[lt][4 * gq + 2] * rn * gw[2], Y[lt][4 * gq + 3] * rn * gw[3]);
                if (!dry) *(u32x2*)(zy + (t0 + l) * DIN + 256 * g + chl) = o;
            }
        }
        __syncthreads();
    }
}
DI void dt_proj(LAS unsigned char* lds, const Params& p) {
    const int tid = otid(), w = __builtin_amdgcn_readfirstlane(tid >> 6), lane = tid & 63, r = lane & 31, h = lane >> 5, rt = w & 1, kq = w >> 1;
    const bf16_t* hb = (const bf16_t*)(p.ws + O_HB); const bf16_t* wt = (const bf16_t*)(p.ws + W_SIN) + (size_t)6144 * DM;
    const float* ss = (const float*)(p.ws + O_SS) + 2 * MT; float* dt = (float*)(p.ws + O_DT);
    LAS float* part = (LAS float*)lds;
    for (int rb = blockIdx.x; rb < MT / 64; rb += gridDim.x) {
        const bf16_t* ap = hb + (size_t)(rb * 64 + rt * 32 + r) * DM + kq * 256 + 8 * h;
        const bf16_t* bp = wt + (size_t)r * DM + kq * 256 + 8 * h;
        bf16x8 af[16], bfr[16];
#pragma unroll
        for (int s = 0; s < 16; ++s) { af[s] = *(const bf16x8*)(ap + 16 * s); bfr[s] = *(const bf16x8*)(bp + 16 * s); }
        f32x16 acc = zero16();
#pragma unroll
        for (int s = 0; s < 16; ++s) acc = MFMA32(af[s], bfr[s], acc);
#pragma unroll
        for (int i = 0; i < 16; ++i) part[((kq * 2 + rt) * 32 + crow(i, h)) * 32 + r] = acc[i];
        __syncthreads();
#pragma unroll
        for (int q = 0; q < 4; ++q) {
            const int o = tid + 512 * q, row = o >> 5, col = o & 31;
            float v = 0.f;
#pragma unroll
            for (int k = 0; k < 4; ++k) v += part[((k * 2 + (row >> 5)) * 32 + (row & 31)) * 32 + col];
            const int grow = rb * 64 + row;
            dt[(size_t)grow * 32 + col] = v * __builtin_amdgcn_rsqf(ss[grow] * (1.0f / 1024.0f) + 1e-6f);
        }
        __syncthreads();
    }
}
template <class Epi> DI void run_gemm(LAS unsigned char* lds, const bf16_t* A, const bf16_t* Bt, int N, int K, const Epi& E) {
    pg8::Gemm g; g.A = A; g.Bt = Bt; g.M = MT; g.N = N; g.K = K;
    pg8::StaticOrder S; S.init(MT, N, (int)gridDim.x, (int)blockIdx.x);
    pg8::gemm_phase<Epi, pg8::StaticOrder, !Epi::AFTER_DRAIN, true>((PG8_LAS unsigned char*)lds, g, S, E);
}
#if defined(DRY_S3) || defined(DRY_S4)
#define DRYV (p.ws == nullptr)
#else
#define DRYV false
#endif
__global__ void __launch_bounds__(512, 2) fwd_megakernel(Params p) {
    extern __shared__ __attribute__((aligned(16))) unsigned char shm[];
    LAS unsigned char* lds = (LAS unsigned char*)shm;
    cg::grid_group grid = cg::this_grid();
    if (threadIdx.x < 4) ((LAS unsigned*)(lds + LDS_BYTES - 16))[threadIdx.x] = 0u;
    __syncthreads();
    const XcdBarrier xbar = xcd_barrier_post((unsigned*)(p.ws + O_BAR), (volatile LAS unsigned*)(lds + LDS_BYTES - 16));
#define GBAR() xcd_barrier(xbar)
    unsigned char* ws = p.ws;
    bf16_t* hb = (bf16_t*)(ws + O_HB); float* ss = (float*)(ws + O_SS);
    phase0(lds, p);
#ifdef DUP_P0
    GBAR(); phase0(lds, p);
#endif
    if (gridDim.x == 0x7fffffffu) grid.sync();
    GBAR();
    { EpiAttnIn E; E.O = (bf16_t*)(ws + O_PROJ); E.ss = ss; E.tab = (const f32x4*)(ws + O_ROPE); run_gemm(lds, hb, (const bf16_t*)(ws + W_AIN), AINW, DM, E); }
    GBAR();
    attn_phase(lds, p);
#ifdef DUP_ATTN
    GBAR(); attn_phase(lds, p);
#endif
    GBAR();
    { EpiRes<false, false> E; E.xres = nullptr; E.hb = hb;     E.outf = nullptr; E.ssn = ss + MT; run_gemm(lds, (const bf16_t*)(ws + O_MIXED), (const bf16_t*)(ws + W_AOUT), DM, DM, E); }
    GBAR();
    { EpiGU E; E.act = (bf16_t*)(ws + O_ACT); E.ss = ss + MT; run_gemm(lds, hb, (const bf16_t*)(ws + W_GU0), 2 * DFF, DM, E); }
    GBAR();
    { EpiRes<false, false> E; E.xres = nullptr; E.hb = hb; E.outf = nullptr; E.ssn = ss + 2 * MT; run_gemm(lds, (const bf16_t*)(ws + O_ACT), (const bf16_t*)(ws + W_DN0), DM, DFF, E); }
    GBAR();
    { EpiSsdIn E; E.z = (bf16_t*)p.out; E.xbc = (bf16_t*)(ws + O_XBC); E.dt = (float*)(ws + O_DT); E.ss = ss + 2 * MT; dt_proj(lds, p); run_gemm(lds, hb, (const bf16_t*)(ws + W_SIN), 6144, DM, E); }
    GBAR();
    ssd_states_phase(lds, p);
#ifdef DUP_S2
    GBAR(); ssd_states_phase(lds, p);
#endif
    GBAR();
#ifdef DRY_S3
    ssd_scan_phase(p, p.ws != nullptr); GBAR();
#endif
    ssd_scan_phase(p, DRYV);
    GBAR();
#ifdef DRY_S4
    ssd_out_phase(lds, p, p.ws != nullptr); GBAR();
#endif
    ssd_out_phase(lds, p, DRYV);
    GBAR();
    { EpiRes<false, false> E; E.xres = nullptr; E.hb = hb; E.outf = nullptr; E.ssn = ss + 3 * MT; run_gemm(lds, (const bf16_t*)p.out, (const bf16_t*)(ws + W_SOUT), DM, DIN, E); }
    GBAR();
    { EpiGU E; E.act = (bf16_t*)(ws + O_ACT); E.ss = ss + 3 * MT; run_gemm(lds, hb, (const bf16_t*)(ws + W_GU1), 2 * DFF, DM, E); }
    GBAR();
    if (gridDim.x == 256) {
        EpiFinal E; E.hb = hb; E.outf = p.out; E.ssn = ss + 4 * MT; E.cnt = (unsigned*)(ws + O_BAR) + XCD_BAR_WORDS; E.fw = p.in[22];
        run_gemm(lds, (const bf16_t*)(ws + O_ACT), (const bf16_t*)(ws + W_DN1), DM, DFF, E);
    } else {
        { EpiRes<false, true> E; E.xres = nullptr; E.hb = hb; E.outf = p.out; E.ssn = ss + 4 * MT; run_gemm(lds, (const bf16_t*)(ws + O_ACT), (const bf16_t*)(ws + W_DN1), DM, DFF, E); }
        GBAR();
        const float* ss4 = ss + 4 * MT; const f32x4* fw = (const f32x4*)p.in[22]; f32x4* o4 = (f32x4*)p.out;
        for (int i = blockIdx.x * 512 + threadIdx.x; i < MT * (DM / 4); i += gridDim.x * 512) {
            const int row = i >> 8; const float rs = __builtin_amdgcn_rsqf(ss4[row] * (1.0f / 1024.0f) + 1e-6f);
            o4[i] = o4[i] * rs * fw[i & 255];
        }
    }
}

extern "C" void kernel_launch(void* const* d_in, const int* in_sizes, int n_in, void* d_out, int out_size, void* d_ws, size_t ws_size, hipStream_t stream) {
    static int grid_blocks = 0;
    if (!grid_blocks) {
        int dev = 0, cus = 0, per_cu = 0;
        hipGetDevice(&dev);
        hipDeviceGetAttribute(&cus, hipDeviceAttributeMultiprocessorCount, dev);
        if (hipFuncSetAttribute((const void*)fwd_megakernel, hipFuncAttributeMaxDynamicSharedMemorySize, LDS_BYTES) != hipSuccess) fprintf(stderr, "hipFuncSetAttribute failed\n");
        if (hipOccupancyMaxActiveBlocksPerMultiprocessor(&per_cu, (const void*)fwd_megakernel, 512, LDS_BYTES) != hipSuccess || per_cu < 1) { fprintf(stderr, "occupancy query: %d\n", per_cu); per_cu = 1; }
        (void)hipGetLastError();
        grid_blocks = cus * per_cu;
        if (ws_size < 268435456ull || n_in != 23) fprintf(stderr, "unexpected ws_size %zu / n_in %d\n", ws_size, n_in);
    }
    if (hipMemsetAsync((char*)d_ws + O_BAR, 0, 20480, stream) != hipSuccess) fprintf(stderr, "memset failed\n");
    Params p{};
    for (int i = 0; i < 23; ++i) p.in[i] = (const float*)d_in[i];
    p.out = (float*)d_out; p.ws = (unsigned char*)d_ws;
    void* args[] = {&p};
    hipError_t e = hipLaunchCooperativeKernel((const void*)fwd_megakernel, dim3(grid_blocks), dim3(512), args, LDS_BYTES, stream);
    if (e != hipSuccess) fprintf(stderr, "cooperative launch failed: %s (grid %d)\n", hipGetErrorString(e), grid_blocks);
}
#ifdef PHASE_TEST
__global__ void __launch_bounds__(512, 2) t_phase0(Params p) { extern __shared__ __attribute__((aligned(16))) unsigned char shm[]; phase0((LAS unsigned char*)shm, p); }
__global__ void __launch_bounds__(512, 2) t_attn_diff(Params p) { extern __shared__ __attribute__((aligned(16))) unsigned char shm[]; diff_tile((LAS unsigned char*)shm, (const bf16_t*)(p.ws + O_PROJ), (bf16_t*)(p.ws + O_MIXED), p.in[7], 0.3f, blockIdx.x & 1, blockIdx.y, blockIdx.z); }
__global__ void __launch_bounds__(512, 2) t_attn_sb(Params p) { extern __shared__ __attribute__((aligned(16))) unsigned char shm[]; sb_block((LAS unsigned char*)shm, (const bf16_t*)(p.ws + O_PROJ), (bf16_t*)(p.ws + O_MIXED), blockIdx.x & 1, blockIdx.y, blockIdx.z); }
__global__ void __launch_bounds__(512, 2) t_ssd_states(Params p) { extern __shared__ __attribute__((aligned(16))) unsigned char shm[]; ssd_states_phase((LAS unsigned char*)shm, p); }
__global__ void __launch_bounds__(512, 2) t_ssd_scan(Params p) { ssd_scan_phase(p, false); }
__global__ void __launch_bounds__(512, 2) t_ssd_out(Params p) { extern __shared__ __attribute__((aligned(16))) unsigned char shm[]; ssd_out_phase((LAS unsigned char*)shm, p, false); }
__global__ void __launch_bounds__(512, 2) t_gemm_ain(Params p) { extern __shared__ __attribute__((aligned(16))) unsigned char shm[]; EpiAttnIn E; E.O = (bf16_t*)(p.ws + O_PROJ); E.ss = (float*)(p.ws + O_SS); E.tab = (const f32x4*)(p.ws + O_ROPE); run_gemm((LAS unsigned char*)shm, (bf16_t*)(p.ws + O_HB), (const bf16_t*)(p.ws + W_AIN), AINW, DM, E); }
__global__ void __launch_bounds__(512, 2) t_gemm_res(Params p) { extern __shared__ __attribute__((aligned(16))) unsigned char shm[]; EpiRes<false, false> E; E.xres = nullptr; E.hb = (bf16_t*)(p.ws + O_HB); E.outf = nullptr; E.ssn = (float*)(p.ws + O_SS); run_gemm((LAS unsigned char*)shm, (bf16_t*)(p.ws + O_ACT), (const bf16_t*)(p.ws + W_DN0), DM, DFF, E); }
__global__ void __launch_bounds__(512, 2) t_gemm_gu(Params p) { extern __shared__ __attribute__((aligned(16))) unsigned char shm[]; EpiGU E; E.act = (bf16_t*)(p.ws + O_ACT); E.ss = (float*)(p.ws + O_SS); run_gemm((LAS unsigned char*)shm, (bf16_t*)(p.ws + O_HB), (const bf16_t*)(p.ws + W_GU0), 2 * DFF, DM, E); }
__global__ void __launch_bounds__(512, 2) t_gemm_ssdin(Params p) { extern __shared__ __attribute__((aligned(16))) unsigned char shm[]; EpiSsdIn E; E.z = (bf16_t*)p.out; E.xbc = (bf16_t*)(p.ws + O_XBC); E.dt = (float*)(p.ws + O_DT); E.ss = (float*)(p.ws + O_SS); run_gemm((LAS unsigned char*)shm, (bf16_t*)(p.ws + O_HB), (const bf16_t*)(p.ws + W_SIN), SINWP, DM, E); }
#endif
```

```cpp
#include <hip/hip_runtime.h>
#include <hip/hip_cooperative_groups.h>
#include <cstdio>
#include <cstdint>
namespace cg = cooperative_groups;
namespace pg8 {
#define PG8_LAS __attribute__((address_space(3)))
typedef unsigned short bf16_t;
typedef short bf16x8 __attribute__((ext_vector_type(8)));
typedef float f32x4 __attribute__((ext_vector_type(4)));
typedef unsigned u32x4 __attribute__((ext_vector_type(4)));
constexpr int BM = 256, BK = 64, HALF = 128, HTB = HALF * BK * 2  , STAGE_BYTES = 8 * HTB, NXCD = 8, WGM = 8;

__host__ __device__ __forceinline__ int lds_byte(int r, int c) { const int st = (r >> 4) * 2 + (c >> 5), rr = r & 15, cc = c & 31, ob = rr * 64 + cc * 2; return st * 1024 + (ob ^ (((ob >> 9) & 1) << 5)); }
__host__ __device__ __forceinline__ void stage_rc(int b, int& R, int& C) { const int st = b / 1024, sb = b % 1024, swz = sb ^ (((sb >> 9) & 1) << 5); R = (st >> 1) * 16 + swz / 64; C = (st & 1) * 32 + (swz % 64) / 2; }
__host__ __device__ __forceinline__ int perm32(int rho) { const int n = rho >> 4, i = rho & 15; return 8 * (i >> 2) + 4 * n + (i & 3); }

struct Unit { int pm, pn; };
struct Gemm { const bf16_t* A; const bf16_t* Bt; int M, N, K; };

struct StaticOrder {
    int nM, nN, nwg, G, c;
    __host__ __device__ void init(int M, int N, int G_, int c_) { nM = M / BM; nN = N / BM; nwg = nM * nN; G = G_; c = c_; }
    __host__ __device__ bool next(int i, Unit& u) const {
        const long L = (long)i * G + c; if (L >= nwg) return false;
        int wgid = (int)L; { const int q = nwg / NXCD, r = nwg % NXCD, xcd = wgid % NXCD, off = wgid / NXCD; wgid = (xcd < r ? xcd * (q + 1) : r * (q + 1) + (xcd - r) * q) + off; }
        const int nig = WGM * nN, gid = wgid / nig, fm = gid * WGM, gsz = (nM - fm) < WGM ? (nM - fm) : WGM;
        u.pm = fm + ((wgid % nig) % gsz); u.pn = (wgid % nig) / gsz; return true;
    }
    __device__ __forceinline__ void a_ready(const Unit&) const {}
    __device__ __forceinline__ void done(const Unit&) const {}
};

template <class Epi, class Sched, bool ALIGN_EPI = false, bool SP2 = false>
__device__ __forceinline__ void gemm_phase(PG8_LAS unsigned char* lds, const Gemm g, const Sched& S, const Epi& E) {
    int tid_ = threadIdx.x; asm volatile("" : "+v"(tid_)); const int tid = tid_, wid = __builtin_amdgcn_readfirstlane(tid >> 6), lane = tid & 63, wr = wid >> 2, wc = wid & 3, fr = lane & 15, fq = lane >> 4;
    const int K = g.K, nt = K / BK;
    unsigned voffA[2], voffB[2];
#pragma unroll
    for (int i = 0; i < 2; ++i) { int R, C; stage_rc(tid * 16 + i * 8192, R, C); const int Rb = Epi::PERM ? ((R & ~31) + perm32(R & 31)) : R;
        voffA[i] = (unsigned)(R * K + C) * 2u; voffB[i] = (unsigned)(Rb * K + C) * 2u; }
    const size_t kstep = (size_t)(BK * 2);
    const size_t hstep = (size_t)HALF * K * 2;
    const size_t tstep = 2 * hstep;
    const unsigned ldsw = (unsigned)wid * 1024u;
    const int aoff = lds_byte(wr * 64 + fr, fq * 8), boff = lds_byte(wc * 32 + fr, fq * 8);
#define PG8_SA(b, h) (((b) * 2 + (h)) * HTB)
#define PG8_SB(b, h) ((4 + (b) * 2 + (h)) * HTB)
#define PG8_STAGE(bufoff, gbase, voff) do { _Pragma("unroll") for (int _i = 0; _i < 2; ++_i) \
        __builtin_amdgcn_global_load_lds((const unsigned*)((const char*)(gbase) + (voff)[_i]), (PG8_LAS unsigned*)(lds + (bufoff) + ldsw + _i * 8192), 16, 0, 0); } while (0)
#define PG8_LDA(dst, b, h) do { _Pragma("unroll") for (int m = 0; m < 4; ++m) _Pragma("unroll") for (int k = 0; k < 2; ++k) dst[m][k] = *(const PG8_LAS bf16x8*)(lds + PG8_SA(b, h) + aoff + m * 2048 + k * 1024); } while (0)
#define PG8_LDB(dst, b, h) do { _Pragma("unroll") for (int n = 0; n < 2; ++n) _Pragma("unroll") for (int k = 0; k < 2; ++k) dst[n][k] = *(const PG8_LAS bf16x8*)(lds + PG8_SB(b, h) + boff + n * 2048 + k * 1024); } while (0)
#define PG8_MMA(ai, bj, At, Bt) do { __builtin_amdgcn_s_setprio(1); _Pragma("unroll") for (int m = 0; m < 4; ++m) _Pragma("unroll") for (int n = 0; n < 2; ++n) _Pragma("unroll") for (int k = 0; k < 2; ++k) \
        acc[ai][bj][m][n] = __builtin_amdgcn_mfma_f32_16x16x32_bf16(Bt[n][k], At[m][k], acc[ai][bj][m][n], 0, 0, 0); __builtin_amdgcn_s_setprio(0); } while (0)
#define PG8_WAIT_V(n) asm volatile("s_waitcnt vmcnt(" #n ")" ::: "memory")
#define PG8_WAIT_L(n) asm volatile("s_waitcnt lgkmcnt(" #n ")" ::: "memory")
#define PG8_BAR __builtin_amdgcn_s_barrier()
#define PG8_SCHED __builtin_amdgcn_sched_barrier(0)
    Unit cur, nxt; int ui = 0;
    if (!S.next(0, cur)) return;
    f32x4 acc[2][2][4][2];
#pragma unroll
    for (int a = 0; a < 2; ++a)
#pragma unroll
        for (int b = 0; b < 2; ++b)
#pragma unroll
            for (int m = 0; m < 4; ++m)
#pragma unroll
                for (int n = 0; n < 2; ++n) acc[a][b][m][n] = (f32x4){0.f, 0.f, 0.f, 0.f};
    bf16x8 At[4][2], B0[2][2], B1[2][2];
    float epre[8]; E.pre(cur, wr, fr, epre);
    const char* cA = (const char*)g.A + (size_t)cur.pm * tstep; const char* cB = (const char*)g.Bt + (size_t)cur.pn * tstep;
    S.a_ready(cur);
    if constexpr (SP2) {
        PG8_STAGE(PG8_SB(0, 0), cB, voffB); PG8_STAGE(PG8_SB(0, 1), cB + hstep, voffB); PG8_STAGE(PG8_SA(0, 0), cA, voffA); PG8_STAGE(PG8_SA(0, 1), cA + hstep, voffA);
        if (wr == 1) PG8_BAR;
        PG8_WAIT_V(2); PG8_BAR;
        PG8_STAGE(PG8_SB(1, 0), cB + kstep, voffB); PG8_STAGE(PG8_SA(1, 0), cA + kstep, voffA); PG8_STAGE(PG8_SB(1, 1), cB + hstep + kstep, voffB);
        PG8_WAIT_V(6); PG8_BAR;
    } else {
        PG8_STAGE(PG8_SB(0, 0), cB, voffB); PG8_STAGE(PG8_SA(0, 0), cA, voffA); PG8_STAGE(PG8_SB(0, 1), cB + hstep, voffB); PG8_STAGE(PG8_SA(0, 1), cA + hstep, voffA);
        if (wr == 1) PG8_BAR;
        PG8_WAIT_V(4); PG8_BAR;
        PG8_STAGE(PG8_SB(1, 0), cB + kstep, voffB); PG8_STAGE(PG8_SA(1, 0), cA + kstep, voffA); PG8_STAGE(PG8_SB(1, 1), cB + hstep + kstep, voffB);
        PG8_WAIT_V(6); PG8_BAR;
    }
    for (;;) {
        const bool has_next = S.next(ui + 1, nxt);
        const char* nA = has_next ? (const char*)g.A + (size_t)nxt.pm * tstep : cA; const char* nB = has_next ? (const char*)g.Bt + (size_t)nxt.pn * tstep : cB;
        for (int t = 0; t < nt; t += 2) {
            const bool last = (t == nt - 2);
            const char* a1 = cA + (size_t)(t + 1) * kstep;
            const char* a2 = last ? nA : cA + (size_t)(t + 2) * kstep; const char* b2 = last ? nB : cB + (size_t)(t + 2) * kstep;
            const char* a3 = a2 + kstep; const char* b3 = b2 + kstep;
            if (last && has_next) S.a_ready(nxt);
            if constexpr (SP2) {
            PG8_LDB(B0, 0, 0); PG8_LDB(B1, 0, 1); PG8_SCHED; PG8_LDA(At, 0, 0); PG8_STAGE(PG8_SA(1, 1), a1 + hstep, voffA);
            PG8_WAIT_V(8); PG8_WAIT_L(0); PG8_BAR; PG8_MMA(0, 0, At, B0); PG8_MMA(0, 1, At, B1); PG8_BAR; PG8_SCHED;
            PG8_LDA(At, 0, 1); PG8_STAGE(PG8_SB(0, 0), b2, voffB); PG8_STAGE(PG8_SB(0, 1), b2 + hstep, voffB); PG8_STAGE(PG8_SA(0, 0), a2, voffA);
            PG8_WAIT_V(8); PG8_WAIT_L(0); PG8_BAR; PG8_MMA(1, 0, At, B0); PG8_MMA(1, 1, At, B1); PG8_BAR; PG8_SCHED;
            PG8_LDB(B0, 1, 0); PG8_LDB(B1, 1, 1); PG8_SCHED; PG8_LDA(At, 1, 0); PG8_STAGE(PG8_SA(0, 1), a2 + hstep, voffA);
            PG8_WAIT_V(8); PG8_WAIT_L(0); PG8_BAR; PG8_MMA(0, 0, At, B0); PG8_MMA(0, 1, At, B1); PG8_BAR; PG8_SCHED;
            PG8_LDA(At, 1, 1); PG8_STAGE(PG8_SB(1, 0), b3, voffB); PG8_STAGE(PG8_SB(1, 1), b3 + hstep, voffB); PG8_STAGE(PG8_SA(1, 0), a3, voffA);
            PG8_WAIT_V(8); PG8_WAIT_L(0); PG8_BAR; PG8_MMA(1, 0, At, B0); PG8_MMA(1, 1, At, B1); PG8_BAR; PG8_SCHED;
            } else {
            PG8_LDB(B0, 0, 0); PG8_SCHED; PG8_LDA(At, 0, 0); PG8_STAGE(PG8_SA(1, 1), a1 + hstep, voffA);
            PG8_WAIT_L(8); PG8_BAR; PG8_WAIT_L(0); PG8_MMA(0, 0, At, B0); PG8_BAR; PG8_SCHED;
            PG8_LDB(B1, 0, 1); PG8_STAGE(PG8_SB(0, 0), b2, voffB);
            PG8_BAR; PG8_WAIT_L(0); PG8_MMA(0, 1, At, B1); PG8_BAR;
            PG8_LDA(At, 0, 1); PG8_STAGE(PG8_SA(0, 0), a2, voffA);
            PG8_BAR; PG8_WAIT_L(0); PG8_MMA(1, 0, At, B0); PG8_BAR; PG8_SCHED;
            PG8_STAGE(PG8_SB(0, 1), b2 + hstep, voffB);
            PG8_WAIT_V(6); PG8_BAR; PG8_MMA(1, 1, At, B1); PG8_BAR;
            PG8_LDB(B0, 1, 0); PG8_SCHED; PG8_LDA(At, 1, 0); PG8_STAGE(PG8_SA(0, 1), a2 + hstep, voffA);
            PG8_WAIT_L(8); PG8_BAR; PG8_WAIT_L(0); PG8_MMA(0, 0, At, B0); PG8_BAR; PG8_SCHED;
            PG8_LDB(B1, 1, 1); PG8_STAGE(PG8_SB(1, 0), b3, voffB);
            PG8_BAR; PG8_WAIT_L(0); PG8_MMA(0, 1, At, B1); PG8_BAR;
            PG8_LDA(At, 1, 1); PG8_STAGE(PG8_SA(1, 0), a3, voffA);
            PG8_BAR; PG8_WAIT_L(0); PG8_MMA(1, 0, At, B0); PG8_BAR; PG8_SCHED;
            PG8_STAGE(PG8_SB(1, 1), b3 + hstep, voffB);
            PG8_WAIT_V(6); PG8_BAR; PG8_MMA(1, 1, At, B1); PG8_BAR;
            }
        }
        if constexpr (ALIGN_EPI) { if (wr == 0) PG8_BAR; }
        if constexpr (!Epi::AFTER_DRAIN) { E(acc, cur, wr, wc, fr, fq, epre); S.done(cur); }
        if (!has_next) break;
        E.pre(nxt, wr, fr, epre);
#pragma unroll
        for (int a = 0; a < 2; ++a)
#pragma unroll
            for (int b = 0; b < 2; ++b)
#pragma unroll
                for (int m = 0; m < 4; ++m)
#pragma unroll
                    for (int n = 0; n < 2; ++n) acc[a][b][m][n] = (f32x4){0.f, 0.f, 0.f, 0.f};
        cur = nxt; cA = nA; cB = nB; ++ui;
        if constexpr (ALIGN_EPI) { if (wr == 1) PG8_BAR; }
    }
    PG8_WAIT_V(0);
    if constexpr (!ALIGN_EPI) { if (wr == 0) PG8_BAR; }
    PG8_BAR;
    if constexpr (Epi::AFTER_DRAIN) { E.fused(acc, cur, wr, wc, fr, fq, lds, wid, lane); S.done(cur); }
#undef PG8_SA
#undef PG8_SB
#undef PG8_STAGE
#undef PG8_LDA
#undef PG8_LDB
#undef PG8_MMA
#undef PG8_WAIT_V
#undef PG8_WAIT_L
#undef PG8_BAR
#undef PG8_SCHED
}
}
using pg8::bf16_t; using pg8::bf16x8; using pg8::f32x4;
typedef short s16x4 __attribute__((ext_vector_type(4)));
typedef float f32x16 __attribute__((ext_vector_type(16)));
typedef float f32x2 __attribute__((ext_vector_type(2)));
typedef __bf16 bf2_t __attribute__((ext_vector_type(2)));
typedef unsigned u32x2 __attribute__((ext_vector_type(2)));
typedef unsigned u32x4 __attribute__((ext_vector_type(4)));
#define LAS __attribute__((address_space(3)))
#define DI __device__ __forceinline__
#define MFMA32(a, b, c) __builtin_amdgcn_mfma_f32_32x32x16_bf16((a), (b), (c), 0, 0, 0)

DI int otid() { int t = threadIdx.x; asm volatile("" : "+v"(t)); return t; }
DI unsigned pk2(float a, float b) { f32x2 v = {a, b}; bf2_t r = __builtin_convertvector(v, bf2_t); return __builtin_bit_cast(unsigned, r); }
DI float bflo(unsigned u) { return __uint_as_float(u << 16); }
DI float bfhi(unsigned u) { return __uint_as_float(u & 0xffff0000u); }
DI float fexp2(float x) { return __builtin_amdgcn_exp2f(x); }
DI float frcp(float x) { return __builtin_amdgcn_rcpf(x); }
DI float fsilu(float x) { return x * frcp(1.0f + fexp2(-1.44269504089f * x)); }
DI int crow(int i, int h) { return (i & 3) + 8 * (i >> 2) + 4 * h; }
DI s16x4 trr(const LAS unsigned char* p) { return __builtin_amdgcn_ds_read_tr16_b64_v4i16((LAS s16x4*)p); }
DI bf16x8 tr2(const LAS unsigned char* p0, const LAS unsigned char* p1) { s16x4 a = trr(p0), b = trr(p1); return __builtin_shufflevector(a, b, 0, 1, 2, 3, 4, 5, 6, 7); }
DI bf16x8 pack8(const f32x16& x, int s) {
    u32x4 p; p[0] = pk2(x[8 * s], x[8 * s + 1]); p[1] = pk2(x[8 * s + 2], x[8 * s + 3]); p[2] = pk2(x[8 * s + 4], x[8 * s + 5]); p[3] = pk2(x[8 * s + 6], x[8 * s + 7]);
    return __builtin_bit_cast(bf16x8, p);
}
DI f32x16 zero16() { f32x16 z; for (int i = 0; i < 16; ++i) z[i] = 0.f; return z; }

constexpr int MT = 16384, SEQ = 8192, DM = 1024, DFF = 2816, AINW = 3072, SINW = 6176, SINWP = 6400, DIN = 2048, XBCW = 4096;
constexpr float LOG2E = 1.44269504089f;
constexpr int LDS_BYTES = 155648;
constexpr size_t W_AIN = 0, W_AOUT = W_AIN + (size_t)AINW * DM * 2, W_GU0 = W_AOUT + (size_t)DM * DM * 2, W_DN0 = W_GU0 + (size_t)2 * DFF * DM * 2,
                 W_SIN = W_DN0 + (size_t)DM * DFF * 2, W_SOUT = W_SIN + (size_t)SINWP * DM * 2, W_GU1 = W_SOUT + (size_t)DM * DIN * 2, W_DN1 = W_GU1 + (size_t)2 * DFF * DM * 2,
                 O_HB = W_DN1 + (size_t)DM * DFF * 2, O_SS = O_HB + (size_t)MT * DM * 2, O_ROPE = O_SS + (size_t)5 * MT * 4, O_DT = O_ROPE + (size_t)SEQ * 32 * 8,
                 O_CDEC = O_DT + (size_t)MT * 32 * 4, O_LAM = O_CDEC + 16384, O_BAR = O_LAM + 256, O_R = 98566144;
static_assert(O_BAR + 20480 <= O_R, "map");
constexpr size_t O_PROJ = O_R, O_MIXED = O_PROJ + (size_t)MT * AINW * 2, O_ACT = O_R, O_XBC = O_R, O_ST1 = O_XBC + (size_t)MT * XBCW * 2, O_ST0 = 0;
constexpr size_t ST_BATCH = (size_t)64 * 32 * 64 * 128;
static_assert(O_ST1 + ST_BATCH * 2 <= 268435456ull, "ws");
static_assert(ST_BATCH * 2 <= W_SOUT, "st0 overlay");
static_assert(O_MIXED + (size_t)MT * DM * 2 <= 268435456ull, "ws2");

struct Params { const float* in[23]; float* out; unsigned char* ws; };
#include <cstdlib>
#include <vector>

#define XB_TMO      128
#define XB_XCNT(j)  (256  + 64 * (j))
#define XB_XSUB(j)  (1280 + 64 * (j))
#define XB_XGEN(j)  (2304 + 64 * (j))
#define XB_TOP      3328
#define XB_TOPGEN   3392
#define XCD_BAR_WORDS 3456
#define XB_SPIN_CAP (1u << 18)

__device__ __forceinline__ unsigned xb_ld(unsigned* p)              { return __hip_atomic_load(p, __ATOMIC_RELAXED, __HIP_MEMORY_SCOPE_AGENT); }
__device__ __forceinline__ unsigned xb_add(unsigned* p, unsigned v) { return __hip_atomic_fetch_add(p, v, __ATOMIC_RELAXED, __HIP_MEMORY_SCOPE_AGENT); }
__device__ __forceinline__ unsigned xb_xcc_id() { return (unsigned)__builtin_amdgcn_s_getreg((3 << 11) | 20) & 0xFu; }
#define XB_SPIN(cond, bar) do { unsigned _sp = 0; while (cond) { \
    if ((++_sp & 255u) == 0u) { if (xb_ld(&(bar)[XB_TMO])) break; if (_sp > XB_SPIN_CAP) { atomicAdd(&(bar)[XB_TMO], 1u); break; } } } } while (0)

struct XcdBarrier {
    unsigned* bar; unsigned x;
    volatile LAS unsigned* st;
};

__device__ __forceinline__ XcdBarrier xcd_barrier_post(unsigned* bar, volatile LAS unsigned* st) {
    XcdBarrier b; b.bar = bar; b.x = xb_xcc_id(); b.st = st;
    if (threadIdx.x == 0) (void)xb_add(&bar[XB_XCNT(b.x)], 1u);
    return b;
}
__device__ __forceinline__ void xcd_barrier_complete(unsigned* bar, unsigned x, unsigned& nloc, unsigned& nx) {
    const unsigned G = gridDim.x * gridDim.y * gridDim.z;
    unsigned sum, cnt, mine, sp = 0u;
    for (;;) {
        sum = 0u; cnt = 0u; mine = 0u;
#pragma unroll
        for (unsigned j = 0; j < 16; ++j) { const unsigned c = xb_ld(&bar[XB_XCNT(j)]); sum += c; cnt += (c > 0u) ? 1u : 0u; mine = (j == x) ? c : mine; }
        if (sum == G) break;
        __builtin_amdgcn_s_sleep(1);
        if ((++sp & 255u) == 0u) { if (xb_ld(&bar[XB_TMO])) break; if (sp > XB_SPIN_CAP) { atomicAdd(&bar[XB_TMO], 1u); break; } }
    }
    nloc = mine > 0u ? mine : 1u; nx = cnt > 0u ? cnt : 1u;
}

__device__ __forceinline__ void xcd_barrier(const XcdBarrier& b) {
    asm volatile("s_waitcnt vmcnt(0)" ::: "memory");
    __syncthreads();
    if (threadIdx.x == 0) {
        unsigned* bar = b.bar;
        __builtin_amdgcn_s_waitcnt(0);
        unsigned nloc = b.st[0], nx = b.st[1];
        if (nloc == 0u) { xcd_barrier_complete(bar, b.x, nloc, nx); b.st[0] = nloc; b.st[1] = nx; }
        const unsigned old = xb_add(&bar[XB_XSUB(b.x)], 1u);
        const unsigned gen = old / nloc;
        if (old + 1u == (gen + 1u) * nloc) {
            __builtin_amdgcn_fence(__ATOMIC_RELEASE, "agent");
            asm volatile("s_waitcnt vmcnt(0)" ::: "memory");
            const unsigned og = xb_add(&bar[XB_TOP], 1u);
            const unsigned tg = og / nx;
            if (og + 1u != (tg + 1u) * nx) XB_SPIN(xb_ld(&bar[XB_TOP]) < (tg + 1u) * nx, bar);
            __builtin_amdgcn_fence(__ATOMIC_ACQUIRE, "agent");
            asm volatile("s_waitcnt vmcnt(0)" ::: "memory");
        } else {
            XB_SPIN(xb_ld(&bar[XB_TOP]) < (gen + 1u) * nx, bar);
            __builtin_amdgcn_fence(__ATOMIC_ACQUIRE, "agent");
            asm volatile("s_waitcnt vmcnt(0)" ::: "memory");
        }
    }
    __syncthreads();
}
DI void wmap(int mode, int c, int& src, float& scale, int& which) {
    src = c; scale = 1.f; which = 0;
    if (mode == 0) {
        if (c < 1024) { const int base = c & ~63, cc = c & 63, g = cc >> 3, e = cc & 7; src = base + (e < 4 ? 4 * g + e : 32 + 4 * g + (e - 4)); }
        if (c < 512) scale = 0.125f * LOG2E; else if (c >= 1536 && c < 2048) scale = 0.125f;
    } else if (mode == 2) { src = 128 * (c >> 8) + (c & 127); which = (c >> 7) & 1; }
    else if (mode == 3) { if (c >= SINW) src = -1; }
}
struct WJob { int mode, K, ldw, tix; const float* W0; const float* W1; const float* ks; bf16_t* dst; };
DI WJob wjob(const Params& p, int t) {
    unsigned char* ws = p.ws;
    const int cnt[8] = {48 * 4, 16 * 4, 88 * 4, 16 * 11, 100 * 4, 16 * 8, 88 * 4, 16 * 11};
    int j = 0, tt = t;
#pragma unroll
    for (int q = 0; q < 7; ++q) if (j == q && tt >= cnt[q]) { tt -= cnt[q]; j = q + 1; }
    WJob J; J.tix = tt; J.W1 = nullptr; J.ks = nullptr;
    switch (j) {
    case 0: J.mode = 0; J.W0 = p.in[2]; J.ks = p.in[1]; J.dst = (bf16_t*)(ws + W_AIN); J.K = DM; J.ldw = AINW; break;
    case 1: J.mode = 1; J.W0 = p.in[8]; J.dst = (bf16_t*)(ws + W_AOUT); J.K = DM; J.ldw = DM; break;
    case 2: J.mode = 2; J.W0 = p.in[19]; J.W1 = p.in[20]; J.ks = p.in[18]; J.dst = (bf16_t*)(ws + W_GU0); J.K = DM; J.ldw = DFF; break;
    case 3: J.mode = 1; J.W0 = p.in[21]; J.dst = (bf16_t*)(ws + W_DN0); J.K = DFF; J.ldw = DM; break;
    case 4: J.mode = 3; J.W0 = p.in[10]; J.ks = p.in[9]; J.dst = (bf16_t*)(ws + W_SIN); J.K = DM; J.ldw = SINW; break;
    case 5: J.mode = 1; J.W0 = p.in[17]; J.dst = (bf16_t*)(ws + W_SOUT); J.K = DIN; J.ldw = DM; break;
    case 6: J.mode = 2; J.W0 = p.in[19] + (size_t)DM * DFF; J.W1 = p.in[20] + (size_t)DM * DFF; J.ks = p.in[18] + DM; J.dst = (bf16_t*)(ws + W_GU1); J.K = DM; J.ldw = DFF; break;
    default: J.mode = 1; J.W0 = p.in[21] + (size_t)DFF * DM; J.dst = (bf16_t*)(ws + W_DN1); J.K = DFF; J.ldw = DM; break;
    }
    return J;
}
DI void wtile_load(const WJob& J, int tid, float (&v)[32], float& sc, int& srcok) {
    const int nk = J.K >> 8, c0 = (J.tix / nk) * 64, k0 = (J.tix % nk) * 256, cc = tid & 63; int src, which; wmap(J.mode, c0 + cc, src, sc, which);
    const float* W = (which ? J.W1 : J.W0) + (src >= 0 ? src : 0); srcok = (src >= 0);
#pragma unroll
    for (int i = 0; i < 32; ++i) { const int kk = (tid >> 6) + 8 * i; v[i] = __builtin_nontemporal_load(W + (size_t)(k0 + kk) * J.ldw); }
}
DI void wtile_store(LAS float* tile, const WJob& J, int tid, const float (&v)[32], float sc, int srcok) {
    const int nk = J.K >> 8, c0 = (J.tix / nk) * 64, k0 = (J.tix % nk) * 256, cc = tid & 63;
#pragma unroll
    for (int i = 0; i < 32; ++i) { const int kk = (tid >> 6) + 8 * i; float x = srcok ? v[i] * sc : 0.f; if (J.ks) x *= J.ks[k0 + kk]; tile[kk * 65 + cc] = x; }
    __syncthreads();
#pragma unroll
    for (int i = 0; i < 16; ++i) {
        const int idx = tid + 512 * i, c2 = idx >> 7, k2 = (idx & 127) * 2;
        *(unsigned*)(J.dst + (size_t)(c0 + c2) * J.K + k0 + k2) = pk2(tile[k2 * 65 + c2], tile[(k2 + 1) * 65 + c2]);
    }
    __syncthreads();
}
DI void wconv_jobs(LAS unsigned char* lds, const Params& p, int wi, int nb) {
    const int tid = otid(); const int total = 48 * 4 + 16 * 4 + 2 * (88 * 4 + 16 * 11) + 100 * 4 + 16 * 8;
    if (wi >= total) return;
    WJob J = wjob(p, wi); float v[32]; float sc; int ok;
    wtile_load(J, tid, v, sc, ok);
    for (int t = wi; t < total; t += nb) {
        const bool more = (t + nb < total);
        WJob Jn = J; float vn[32]; float scn = 0.f; int okn = 0;
        if (more) { Jn = wjob(p, t + nb); wtile_load(Jn, tid, vn, scn, okn); }
        wtile_store((LAS float*)lds, J, tid, v, sc, ok);
        if (more) { J = Jn; sc = scn; ok = okn;
#pragma unroll
            for (int i = 0; i < 32; ++i) v[i] = vn[i]; }
    }
}
DI void phase0(LAS unsigned char* lds, const Params& p) {
    const int tid = otid(), G = gridDim.x, bx = blockIdx.x;
    unsigned char* ws = p.ws;
    wconv_jobs(lds, p, bx, G);
    {
        const int wave = tid >> 6, lane = tid & 63; bf16_t* hb = (bf16_t*)(ws + O_HB); float* ss = (float*)(ws + O_SS);
        for (int row0 = (bx * 8 + wave) * 2; row0 < MT; row0 += G * 16) {
            f32x4 v[2][4];
#pragma unroll
            for (int q = 0; q < 2; ++q)
#pragma unroll
                for (int i = 0; i < 4; ++i) v[q][i] = __builtin_nontemporal_load((const f32x4*)(p.in[0] + (size_t)(row0 + q) * DM + lane * 4 + 256 * i));
#pragma unroll
            for (int q = 0; q < 2; ++q) {
                float sq = 0.f;
#pragma unroll
                for (int i = 0; i < 4; ++i) { const f32x4 x = v[q][i]; sq += x[0] * x[0] + x[1] * x[1] + x[2] * x[2] + x[3] * x[3];
                    u32x2 o; o[0] = pk2(x[0], x[1]); o[1] = pk2(x[2], x[3]); *(u32x2*)(hb + (size_t)(row0 + q) * DM + lane * 4 + 256 * i) = o; }
#pragma unroll
                for (int o = 32; o >= 1; o >>= 1) sq += __shfl_xor(sq, o);
                if (lane == 0) ss[row0 + q] = sq;
            }
        }
        for (int i = bx * 512 + tid; i < 4 * MT; i += G * 512) ss[MT + i] = 0.f;
        f32x2* tab = (f32x2*)(ws + O_ROPE);
        for (int i = bx * 512 + tid; i < SEQ * 32; i += G * 512) {
            const int pos = i >> 5, f = i & 31; const float inv = fexp2(-(float)f * 0.41524101186092f); const float ang = (float)pos * inv;
            double t = (double)ang * 0.15915494309189535; t -= floor(t); const float tf = (float)t;
            f32x2 cs; cs[0] = __builtin_amdgcn_cosf(tf); cs[1] = __builtin_amdgcn_sinf(tf); tab[i] = cs;
        }
        if (bx == 0 && tid == 0) { float s1 = 0.f, s2 = 0.f; for (int i = 0; i < 64; ++i) { s1 += p.in[3][i] * p.in[4][i]; s2 += p.in[5][i] * p.in[6][i]; }
            *(float*)(ws + O_LAM) = fexp2(s1 * LOG2E) - fexp2(s2 * LOG2E) + 0.2f; }
    }
}

struct EpiAttnIn {
    static constexpr bool PERM = true, AFTER_DRAIN = false;
    bf16_t* O; const float* ss; const f32x4* tab;
    DI void pre(const pg8::Unit& u, int wr, int fr, float (&e)[8]) const {
#pragma unroll
        for (int ai = 0; ai < 2; ++ai)
#pragma unroll
            for (int m = 0; m < 4; ++m) e[ai * 4 + m] = ss[u.pm * 256 + wr * 64 + fr + ai * 128 + m * 16];
    }
    DI void operator()(const f32x4 (&acc)[2][2][4][2], const pg8::Unit& u, int wr, int wc, int fr, int fq, const float (&epre)[8]) const {
        const int row0 = u.pm * 256 + wr * 64 + fr, colt = u.pn * 256, col0 = colt + wc * 32 + 8 * fq;
        const int fb = 4 * (4 * (wc & 1) + fq);
#pragma unroll
        for (int ai = 0; ai < 2; ++ai)
#pragma unroll
            for (int m = 0; m < 4; ++m) {
                const int row = row0 + ai * 128 + m * 16; const float rs = __builtin_amdgcn_rsqf(epre[ai * 4 + m] * (1.0f / 1024.0f) + 1e-6f);
                f32x4 c01 = {1.f, 0.f, 1.f, 0.f}, c23 = {1.f, 0.f, 1.f, 0.f};
                if (colt < 1024) { const int pos = row & (SEQ - 1); c01 = tab[(pos * 32 + fb) >> 1]; c23 = tab[((pos * 32 + fb) >> 1) + 1]; }
#pragma unroll
                for (int bj = 0; bj < 2; ++bj) {
                    f32x4 v0 = acc[ai][bj][m][0] * rs, v1 = acc[ai][bj][m][1] * rs;
                    if (colt < 1024) {
                        const float cs[4] = {c01[0], c01[2], c23[0], c23[2]}, sn[4] = {c01[1], c01[3], c23[1], c23[3]};
#pragma unroll
                        for (int j = 0; j < 4; ++j) { const float t1 = v0[j], t2 = v1[j]; v0[j] = t1 * cs[j] - t2 * sn[j]; v1[j] = t2 * cs[j] + t1 * sn[j]; }
                    }
                    u32x4 o; o[0] = pk2(v0[0], v0[1]); o[1] = pk2(v0[2], v0[3]); o[2] = pk2(v1[0], v1[1]); o[3] = pk2(v1[2], v1[3]);
                    *(u32x4*)(O + (size_t)row * AINW + col0 + bj * 128) = o;
                }
            }
    }
};
template <bool RES_F32, bool OUT_F32> struct EpiRes {
    static constexpr bool PERM = true, AFTER_DRAIN = false;
    const float* xres; bf16_t* hb; float* outf; float* ssn;
    DI void pre(const pg8::Unit&, int, int, float (&)[8]) const {}
    DI void operator()(const f32x4 (&acc)[2][2][4][2], const pg8::Unit& u, int wr, int wc, int fr, int fq, const float (&epre)[8]) const {
        const int row0 = u.pm * 256 + wr * 64 + fr, col0 = u.pn * 256 + wc * 32 + 8 * fq;
#pragma unroll
        for (int ai = 0; ai < 2; ++ai) {
            float sqm[4];
#pragma unroll
            for (int m = 0; m < 4; ++m) {
                const int row = row0 + ai * 128 + m * 16; float sq = 0.f;
#pragma unroll
                for (int bj = 0; bj < 2; ++bj) {
                    const size_t off = (size_t)row * DM + col0 + bj * 128; f32x4 r0, r1;
                    if (RES_F32) { r0 = *(const f32x4*)(xres + off); r1 = *(const f32x4*)(xres + off + 4); }
                    else { const u32x4 t = *(const u32x4*)(hb + off); r0[0] = bflo(t[0]); r0[1] = bfhi(t[0]); r0[2] = bflo(t[1]); r0[3] = bfhi(t[1]); r1[0] = bflo(t[2]); r1[1] = bfhi(t[2]); r1[2] = bflo(t[3]); r1[3] = bfhi(t[3]); }
                    const f32x4 v0 = r0 + acc[ai][bj][m][0], v1 = r1 + acc[ai][bj][m][1];
                    sq += v0[0] * v0[0] + v0[1] * v0[1] + v0[2] * v0[2] + v0[3] * v0[3] + v1[0] * v1[0] + v1[1] * v1[1] + v1[2] * v1[2] + v1[3] * v1[3];
                    if (OUT_F32) { *(f32x4*)(outf + off) = v0; *(f32x4*)(outf + off + 4) = v1; }
                    else { u32x4 o; o[0] = pk2(v0[0], v0[1]); o[1] = pk2(v0[2], v0[3]); o[2] = pk2(v1[0], v1[1]); o[3] = pk2(v1[2], v1[3]); *(u32x4*)(hb + off) = o; }
                }
                sq += __shfl_xor(sq, 16); sq += __shfl_xor(sq, 32);
                sqm[m] = sq;
            }
            const float mine = fq == 0 ? sqm[0] : fq == 1 ? sqm[1] : fq == 2 ? sqm[2] : sqm[3];
            atomicAdd(ssn + row0 + ai * 128 + fq * 16, mine);
        }
    }
};
struct EpiGU {
    static constexpr bool PERM = true, AFTER_DRAIN = false;
    bf16_t* act; const float* ss;
    DI void pre(const pg8::Unit& u, int wr, int fr, float (&e)[8]) const {
#pragma unroll
        for (int ai = 0; ai < 2; ++ai)
#pragma unroll
            for (int m = 0; m < 4; ++m) e[ai * 4 + m] = ss[u.pm * 256 + wr * 64 + fr + ai * 128 + m * 16];
    }
    DI void operator()(const f32x4 (&acc)[2][2][4][2], const pg8::Unit& u, int wr, int wc, int fr, int fq, const float (&epre)[8]) const {
        const int row0 = u.pm * 256 + wr * 64 + fr;
#pragma unroll
        for (int ai = 0; ai < 2; ++ai)
#pragma unroll
            for (int m = 0; m < 4; ++m) {
                const int row = row0 + ai * 128 + m * 16; const float rs = __builtin_amdgcn_rsqf(epre[ai * 4 + m] * (1.0f / 1024.0f) + 1e-6f);
                u32x4 o;
#pragma unroll
                for (int n = 0; n < 2; ++n) {
                    const f32x4 g = acc[ai][0][m][n] * rs, up = acc[ai][1][m][n] * rs; float a[4];
#pragma unroll
                    for (int j = 0; j < 4; ++j) a[j] = fsilu(g[j]) * up[j];
                    o[2 * n] = pk2(a[0], a[1]); o[2 * n + 1] = pk2(a[2], a[3]);
                }
                *(u32x4*)(act + (size_t)row * DFF + u.pn * 128 + wc * 32 + 8 * fq) = o;
            }
    }
};
struct EpiSsdIn {
    static constexpr bool PERM = true, AFTER_DRAIN = false;
    bf16_t* z; bf16_t* xbc; float* dt; const float* ss;
    DI void pre(const pg8::Unit& u, int wr, int fr, float (&e)[8]) const {
#pragma unroll
        for (int ai = 0; ai < 2; ++ai)
#pragma unroll
            for (int m = 0; m < 4; ++m) e[ai * 4 + m] = ss[u.pm * 256 + wr * 64 + fr + ai * 128 + m * 16];
    }
    DI void operator()(const f32x4 (&acc)[2][2][4][2], const pg8::Unit& u, int wr, int wc, int fr, int fq, const float (&epre)[8]) const {
        const int row0 = u.pm * 256 + wr * 64 + fr, col0 = u.pn * 256 + wc * 32 + 8 * fq;
#pragma unroll
        for (int ai = 0; ai < 2; ++ai)
#pragma unroll
            for (int m = 0; m < 4; ++m) {
                const int row = row0 + ai * 128 + m * 16; const float rs = __builtin_amdgcn_rsqf(epre[ai * 4 + m] * (1.0f / 1024.0f) + 1e-6f);
#pragma unroll
                for (int bj = 0; bj < 2; ++bj) {
                    const int c = col0 + bj * 128; const f32x4 v0 = acc[ai][bj][m][0] * rs, v1 = acc[ai][bj][m][1] * rs;
                    if (c < 6144) { u32x4 o; o[0] = pk2(v0[0], v0[1]); o[1] = pk2(v0[2], v0[3]); o[2] = pk2(v1[0], v1[1]); o[3] = pk2(v1[2], v1[3]);
                        if (c < DIN) *(u32x4*)(z + (size_t)row * DIN + c) = o; else *(u32x4*)(xbc + (size_t)row * XBCW + (c - DIN)) = o; }
                }
            }
    }
};

struct EpiFinal {
    static constexpr bool PERM = true, AFTER_DRAIN = true;
    const bf16_t* hb; float* outf; float* ssn; unsigned* cnt; const float* fw;
    DI void operator()(const f32x4 (&)[2][2][4][2], const pg8::Unit&, int, int, int, int, const float (&)[8]) const {}
    DI void pre(const pg8::Unit&, int, int, float (&)[8]) const {}
    DI void fused(f32x4 (&acc)[2][2][4][2], const pg8::Unit& u, int wr, int wc, int fr, int fq, PG8_LAS unsigned char*, int, int) const {
        const int row0 = u.pm * 256 + wr * 64 + fr, col0 = u.pn * 256 + wc * 32 + 8 * fq;
#pragma unroll
        for (int ai = 0; ai < 2; ++ai)
#pragma unroll
            for (int m = 0; m < 4; ++m) {
                const int row = row0 + ai * 128 + m * 16; float sq = 0.f;
#pragma unroll
                for (int bj = 0; bj < 2; ++bj) {
                    const size_t off = (size_t)row * DM + col0 + bj * 128;
                    const u32x4 t = *(const u32x4*)(hb + off);
#pragma unroll
                    for (int n = 0; n < 2; ++n) {
                        f32x4 r; r[0] = bflo(t[2 * n]); r[1] = bfhi(t[2 * n]); r[2] = bflo(t[2 * n + 1]); r[3] = bfhi(t[2 * n + 1]);
                        const f32x4 v = r + acc[ai][bj][m][n]; acc[ai][bj][m][n] = v;
                        sq += v[0] * v[0] + v[1] * v[1] + v[2] * v[2] + v[3] * v[3];
                    }
                }
                sq += __shfl_xor(sq, 16); sq += __shfl_xor(sq, 32);
                if (fq == 0) atomicAdd(ssn + row, sq);
            }
        asm volatile("s_waitcnt vmcnt(0)" ::: "memory");
        __syncthreads();
        unsigned* c = cnt + 16 * u.pm;
        if (threadIdx.x == 0) {
            __builtin_amdgcn_fence(__ATOMIC_RELEASE, "agent"); asm volatile("s_waitcnt vmcnt(0)" ::: "memory");
            __hip_atomic_fetch_add(c, 1u, __ATOMIC_RELAXED, __HIP_MEMORY_SCOPE_AGENT);
            unsigned spins = 0;
            while (__hip_atomic_load(c, __ATOMIC_RELAXED, __HIP_MEMORY_SCOPE_AGENT) < 4u && ++spins < (1u << 22)) { }
            __builtin_amdgcn_fence(__ATOMIC_ACQUIRE, "agent"); asm volatile("s_waitcnt vmcnt(0)" ::: "memory");
        }
        __syncthreads();
#pragma unroll
        for (int ai = 0; ai < 2; ++ai)
#pragma unroll
            for (int m = 0; m < 4; ++m) {
                const int row = row0 + ai * 128 + m * 16;
                const float rs = __builtin_amdgcn_rsqf(__hip_atomic_load(ssn + row, __ATOMIC_RELAXED, __HIP_MEMORY_SCOPE_AGENT) * (1.0f / 1024.0f) + 1e-6f);
#pragma unroll
                for (int bj = 0; bj < 2; ++bj)
#pragma unroll
                    for (int n = 0; n < 2; ++n) {
                        const int col = col0 + bj * 128 + n * 4; const f32x4 w = *(const f32x4*)(fw + col);
                        *(f32x4*)(outf + (size_t)row * DM + col) = acc[ai][bj][m][n] * rs * w;
                    }
            }
    }
};
constexpr int KST = 144, VST = 320, VST64 = 192;
constexpr int AT_K1 = 0, AT_K2 = 64 * KST, AT_V = 2 * 64 * KST, AT_STAGE = AT_V + 64 * VST;

DI void diff_tile(LAS unsigned char* lds, const bf16_t* proj, bf16_t* mixed, const float* subln, float lam, int b, int hd, int qt) {
    const int tid = otid(), w = __builtin_amdgcn_readfirstlane(tid >> 6), lane = tid & 63, qg = w & 3, mp = w >> 2, r = lane & 31, h = lane >> 5;
    const int q0 = qt * 128; const size_t rowb = (size_t)b * SEQ;
    bf16x8 qf[4];
    { const bf16_t* qp = proj + (rowb + q0 + 32 * qg + r) * AINW + hd * 128 + mp * 64 + 8 * h;
#pragma unroll
      for (int s = 0; s < 4; ++s) qf[s] = *(const bf16x8*)(qp + 16 * s); }
    f32x16 O[4];
#pragma unroll
    for (int i = 0; i < 4; ++i) O[i] = zero16();
    float mrun = 0.f, lrun = 0.f;
    const int nsteps = 2 * (qt + 1);
    const bf16_t* src[4]; int dst[4];
#pragma unroll
    for (int i = 0; i < 2; ++i) { const int cid = tid + 512 * i, row = cid >> 4, c16 = cid & 15;
        src[i] = proj + (rowb + row) * AINW + 512 + hd * 128 + c16 * 8; dst[i] = (c16 < 8 ? AT_K1 : AT_K2) + row * KST + (c16 & 7) * 16;
        src[2 + i] = proj + (rowb + row) * AINW + 1024 + hd * 128 + c16 * 8; dst[2 + i] = AT_V + row * VST + c16 * 16; }
    u32x4 pf[4];
#pragma unroll
    for (int i = 0; i < 4; ++i) pf[i] = *(const u32x4*)(src[i]);
#pragma unroll
    for (int i = 0; i < 4; ++i) *(LAS u32x4*)(lds + dst[i]) = pf[i];
    __syncthreads();
    const int i16 = lane & 15, tq = i16 >> 2, tp = i16 & 3, g16 = (lane >> 4) & 1;
    const int troff = (4 * h + tq) * VST + (16 * g16 + 4 * tp) * 2;
    for (int j = 0; j < nsteps; ++j) {
        const bool more = (j + 1 < nsteps);
        if (more) {
#pragma unroll
            for (int i = 0; i < 4; ++i) pf[i] = *(const u32x4*)(src[i] + (size_t)(j + 1) * 64 * AINW);
        }
        const LAS unsigned char* base = lds + (j & 1) * AT_STAGE;
        const LAS unsigned char* Kb = base + (mp ? AT_K2 : AT_K1);
        const LAS unsigned char* Vb = base + AT_V;
        f32x16 S[2];
        const float negm = -mrun;
#pragma unroll
        for (int kt = 0; kt < 2; ++kt) {
#pragma unroll
            for (int i = 0; i < 16; ++i) S[kt][i] = negm;
#pragma unroll
            for (int s = 0; s < 4; ++s) { const bf16x8 kf = *(const LAS bf16x8*)(Kb + (32 * kt + r) * KST + (16 * s + 8 * h) * 2); S[kt] = MFMA32(kf, qf[s], S[kt]); } }
        const int qidx = q0 + 32 * qg + r, kbase = 64 * j;
        if (kbase + 63 > q0 + 32 * qg) {
#pragma unroll
            for (int kt = 0; kt < 2; ++kt)
#pragma unroll
                for (int i = 0; i < 16; ++i) if (kbase + 32 * kt + crow(i, h) > qidx) S[kt][i] = -1e30f;
        }
        float mx = S[0][0];
#pragma unroll
        for (int kt = 0; kt < 2; ++kt)
#pragma unroll
            for (int i = 0; i < 16; ++i) mx = fmaxf(mx, S[kt][i]);
        mx = fmaxf(mx, __shfl_xor(mx, 32));
        if (j == 0 || __builtin_amdgcn_ballot_w64(mx > 8.0f) != 0ull) {
            const float d = (j == 0) ? mx : fmaxf(mx, 0.f);
            mrun += d;
            if (j != 0) { const float alpha = fexp2(-d); lrun *= alpha;
#pragma unroll
                for (int vt = 0; vt < 4; ++vt) O[vt] = O[vt] * alpha; }
#pragma unroll
            for (int kt = 0; kt < 2; ++kt)
#pragma unroll
                for (int i = 0; i < 16; ++i) S[kt][i] -= d;
        }
        float ls = 0.f;
#pragma unroll
        for (int kt = 0; kt < 2; ++kt)
#pragma unroll
            for (int i = 0; i < 16; ++i) { const float pv = fexp2(S[kt][i]); S[kt][i] = pv; ls += pv; }
        lrun += ls;
#pragma unroll
        for (int kt = 0; kt < 2; ++kt)
#pragma unroll
            for (int s2 = 0; s2 < 2; ++s2) {
                const bf16x8 pfr = pack8(S[kt], s2);
                const LAS unsigned char* vrow = Vb + (32 * kt + 16 * s2) * VST + troff;
#pragma unroll
                for (int vt = 0; vt < 4; ++vt) { const bf16x8 vf = tr2(vrow + vt * 64, vrow + 8 * VST + vt * 64); O[vt] = MFMA32(vf, pfr, O[vt]); }
            }
        if (more) {
            LAS unsigned char* nb = lds + ((j + 1) & 1) * AT_STAGE;
#pragma unroll
            for (int i = 0; i < 4; ++i) *(LAS u32x4*)(nb + dst[i]) = pf[i];
        }
        __syncthreads();
    }
    lrun += __shfl_xor(lrun, 32);
    const float inv = frcp(lrun);
    LAS float* ex = (LAS float*)lds;
    if (mp == 1) {
        const float sc = inv * lam;
#pragma unroll
        for (int vt = 0; vt < 4; ++vt)
#pragma unroll
            for (int i = 0; i < 16; ++i) ex[(qg * 128 + 32 * vt + crow(i, h)) * 32 + r] = O[vt][i] * sc;
    }
    __syncthreads();
    if (mp == 0) {
        float sq = 0.f;
#pragma unroll
        for (int vt = 0; vt < 4; ++vt)
#pragma unroll
            for (int i = 0; i < 16; ++i) { const float o = O[vt][i] * inv - ex[(qg * 128 + 32 * vt + crow(i, h)) * 32 + r]; O[vt][i] = o; sq += o * o; }
        sq += __shfl_xor(sq, 32);
        const float rn = __builtin_amdgcn_rsqf(sq * (1.0f / 128.0f) + 1e-5f) * 0.8f;
        bf16_t* op = mixed + (rowb + q0 + 32 * qg + r) * DM + hd * 128;
#pragma unroll
        for (int vt = 0; vt < 4; ++vt)
#pragma unroll
            for (int gq = 0; gq < 4; ++gq) { const int v0 = 32 * vt + 8 * gq + 4 * h; const f32x4 wv = *(const f32x4*)(subln + v0);
                u32x2 o; o[0] = pk2(O[vt][4 * gq] * rn * wv[0], O[vt][4 * gq + 1] * rn * wv[1]); o[1] = pk2(O[vt][4 * gq + 2] * rn * wv[2], O[vt][4 * gq + 3] * rn * wv[3]);
                *(u32x2*)(op + v0) = o; }
    }
    __syncthreads();
}

constexpr int SB_K = 0, SB_V = 64 * KST, SB_STAGE = 64 * KST + 64 * VST64;
DI void sb_tile(const LAS unsigned char* base, int kbase, int qidx, const bf16x8 (&qf)[4], f32x16 (&O)[2], float& carry, int r, int h, int troff) {
#pragma unroll
    for (int kt = 1; kt >= 0; --kt) {
        f32x16 S = zero16();
#pragma unroll
        for (int s = 0; s < 4; ++s) { const bf16x8 kf = *(const LAS bf16x8*)(base + SB_K + (32 * kt + r) * KST + (16 * s + 8 * h) * 2); S = MFMA32(kf, qf[s], S); }
        float T[4], sfx[16];
#pragma unroll
        for (int gq = 0; gq < 4; ++gq) {
            float run = 1.0f;
#pragma unroll
            for (int jj = 3; jj >= 0; --jj) {
                const int i = 4 * gq + jj; const bool valid = (kbase + 32 * kt + crow(i, h)) < qidx;
                const float zz = fmaxf(S[i], -60.0f); const float e = fexp2(-LOG2E * zz); const float sg = frcp(1.0f + e);
                const float keep = valid ? e * sg : 1.0f;
                S[i] = valid ? sg : 0.0f; sfx[i] = run; run *= keep;
            }
            T[gq] = run;
        }
        float To[4];
#pragma unroll
        for (int gq = 0; gq < 4; ++gq) To[gq] = __shfl_xor(T[gq], 32);
        float E[4]; float acc_hi = 1.0f;
#pragma unroll
        for (int gq = 3; gq >= 0; --gq) { const float above_same = acc_hi; E[gq] = (h == 0) ? above_same * To[gq] : above_same; acc_hi = acc_hi * T[gq] * To[gq]; }
#pragma unroll
        for (int i = 0; i < 16; ++i) S[i] = S[i] * carry * E[i >> 2] * sfx[i];
        carry *= acc_hi;
#pragma unroll
        for (int s2 = 0; s2 < 2; ++s2) {
            const bf16x8 pfr = pack8(S, s2);
            const LAS unsigned char* vrow = base + SB_V + (32 * kt + 16 * s2) * VST64 + troff;
#pragma unroll
            for (int vt = 0; vt < 2; ++vt) { const bf16x8 vf = tr2(vrow + vt * 64, vrow + 8 * VST64 + vt * 64); O[vt] = MFMA32(vf, pfr, O[vt]); }
        }
    }
}
DI void sb_block(LAS unsigned char* lds, const bf16_t* proj, bf16_t* mixed, int b, int hs, int qb) {
    const int tid = otid(), w = __builtin_amdgcn_readfirstlane(tid >> 6), lane = tid & 63, r = lane & 31, h = lane >> 5;
    const int q0 = qb * 256; const size_t rowb = (size_t)b * SEQ;
    const int qidx = q0 + 32 * w + r;
    bf16x8 qf[4];
    { const bf16_t* qp = proj + (rowb + qidx) * AINW + 1536 + hs * 64 + 8 * h;
#pragma unroll
      for (int s = 0; s < 4; ++s) qf[s] = *(const bf16x8*)(qp + 16 * s); }
    f32x16 O[2]; O[0] = zero16(); O[1] = zero16();
    float carry = 1.0f;
    const int jmax = 4 * qb + 3;
    const int srow = tid >> 3, sc8 = tid & 7;
    const bf16_t* srcK = proj + (rowb + srow) * AINW + 2048 + hs * 64 + sc8 * 8;
    const bf16_t* srcV = proj + (rowb + srow) * AINW + 2560 + hs * 64 + sc8 * 8;
    const int dstK = SB_K + srow * KST + sc8 * 16, dstV = SB_V + srow * VST64 + sc8 * 16;
    constexpr int NPRE = 6;
    {
        u32x4 pk_[NPRE], pv_[NPRE];
#pragma unroll
        for (int s = 0; s < NPRE; ++s) { const int jj = (jmax - s) > 0 ? (jmax - s) : 0; pk_[s] = *(const u32x4*)(srcK + (size_t)jj * 64 * AINW); pv_[s] = *(const u32x4*)(srcV + (size_t)jj * 64 * AINW); }
#pragma unroll
        for (int s = 0; s < NPRE; ++s) { *(LAS u32x4*)(lds + s * SB_STAGE + dstK) = pk_[s]; *(LAS u32x4*)(lds + s * SB_STAGE + dstV) = pv_[s]; }
    }
    __syncthreads();
    const int i16 = lane & 15, tq = i16 >> 2, tp = i16 & 3, g16 = (lane >> 4) & 1;
    const int troff = (4 * h + tq) * VST64 + (16 * g16 + 4 * tp) * 2;
    bool wdone = false;
    int j = (q0 + 32 * w + 31) >> 6;
    for (; j >= 0 && j > jmax - NPRE; --j) {
        sb_tile(lds + (jmax - j) * SB_STAGE, 64 * j, qidx, qf, O, carry, r, h, troff);
        if (__builtin_amdgcn_ballot_w64(carry >= 1e-12f) == 0ull) { wdone = true; break; }
    }
    if (j < 0) wdone = true;
    for (int jj = jmax - NPRE, it = 0; ; --jj, ++it) {
        LAS int* flg = (LAS int*)(lds + NPRE * SB_STAGE) + (it & 1) * 8;
        if (lane == 0) flg[w] = wdone ? 1 : 0;
        __syncthreads();
        int all = 1;
#pragma unroll
        for (int ww = 0; ww < 8; ++ww) all &= flg[ww];
        if (all || jj < 0) break;
        const u32x4 a_ = *(const u32x4*)(srcK + (size_t)jj * 64 * AINW), b_ = *(const u32x4*)(srcV + (size_t)jj * 64 * AINW);
        *(LAS u32x4*)(lds + dstK) = a_; *(LAS u32x4*)(lds + dstV) = b_;
        __syncthreads();
        if (!wdone) { sb_tile(lds, 64 * jj, qidx, qf, O, carry, r, h, troff); if (__builtin_amdgcn_ballot_w64(carry >= 1e-12f) == 0ull || jj == 0) wdone = true; }
    }
    bf16_t* op = mixed + (rowb + qidx) * DM + 512 + hs * 64;
#pragma unroll
    for (int vt = 0; vt < 2; ++vt)
#pragma unroll
        for (int gq = 0; gq < 4; ++gq) { const int v0 = 32 * vt + 8 * gq + 4 * h;
            u32x2 o; o[0] = pk2(O[vt][4 * gq], O[vt][4 * gq + 1]); o[1] = pk2(O[vt][4 * gq + 2], O[vt][4 * gq + 3]); *(u32x2*)(op + v0) = o; }
    __syncthreads();
}
DI void attn_phase(LAS unsigned char* lds, const Params& p) {
    const bf16_t* proj = (const bf16_t*)(p.ws + O_PROJ); bf16_t* mixed = (bf16_t*)(p.ws + O_MIXED);
    const float lam = *(const float*)(p.ws + O_LAM);
    for (int it0 = blockIdx.x; it0 < 256; it0 += gridDim.x) {
        const int it = (it0 & 7) * 32 + (it0 >> 3);
        const int b = it >> 7, hd = (it >> 5) & 3, pr = it & 31;
        diff_tile(lds, proj, mixed, p.in[7], lam, b, hd, 63 - pr);
        diff_tile(lds, proj, mixed, p.in[7], lam, b, hd, pr);
    }
    for (int it0 = blockIdx.x; it0 < 512; it0 += gridDim.x) {
        const int it = (it0 & 7) * 64 + (it0 >> 3);
        const int b = it >> 8, hs = (it >> 5) & 7, qb = it & 31;
        sb_block(lds, proj, mixed, b, hs, qb);
    }
}
constexpr int SXS = 528, SXS2 = 576, SBS = 272, SBS2 = 320;
constexpr int L_SX = 0, L_SB = 128 * SXS2, L_SC = L_SB + 128 * SBS, L_SDT = L_SC + 128 * SBS, L_SAC = L_SDT + 2048, L_SSQ = L_SAC + 2048;
static_assert(L_SSQ + 4096 <= LDS_BYTES, "lds");

DI void ssd_dt_acum(LAS unsigned char* lds, const float* DT, const float* dt_bias, const float* a_log, size_t t0, int g) {
    LAS float* sdt = (LAS float*)(lds + L_SDT); LAS float* sac = (LAS float*)(lds + L_SAC);
    const int tid = otid(), hh = tid >> 7, l = tid & 127, head = 4 * g + hh, w = tid >> 6, lane = tid & 63;
    const float raw = DT[(t0 + l) * 32 + head] + dt_bias[head];
    const float dt = fmaxf(raw, 0.f) + __logf(1.0f + __expf(-fabsf(raw)));
    sdt[hh * 128 + l] = dt; sac[hh * 128 + l] = -dt * __expf(a_log[head]);
    __syncthreads();
    if (w < 4) {
        const float v0 = sac[w * 128 + 2 * lane], v1 = sac[w * 128 + 2 * lane + 1]; float s = v0 + v1;
#pragma unroll
        for (int off = 1; off < 64; off <<= 1) { const float t = __shfl_up(s, off); if (lane >= off) s += t; }
        const float ex = s - (v0 + v1);
        sac[w * 128 + 2 * lane] = ex + v0; sac[w * 128 + 2 * lane + 1] = ex + v0 + v1;
    }
    __syncthreads();
}
template <int NT, class F> DI void conv_strip(const bf16_t* src, int nzero, const float* cw, const float* cb, int ch, F&& emit) {
    f32x4 wlo[4], whi[4];
#pragma unroll
    for (int k = 0; k < 4; ++k) { wlo[k] = *(const f32x4*)(cw + k * XBCW + ch); whi[k] = *(const f32x4*)(cw + k * XBCW + ch + 4); }
    const f32x4 blo = *(const f32x4*)(cb + ch), bhi = *(const f32x4*)(cb + ch + 4);
    u32x4 raw[NT + 3];
#pragma unroll
    for (int i = 0; i < NT + 3; ++i) { const int ii = (i < nzero) ? nzero : i; raw[i] = *(const u32x4*)(src + (ptrdiff_t)(ii - 3) * XBCW); if (i < nzero) raw[i] = (u32x4){0u, 0u, 0u, 0u}; }
#pragma unroll
    for (int t = 0; t < NT; ++t) {
        float o[8];
#pragma unroll
        for (int e = 0; e < 8; ++e) {
            float a = (e < 4) ? blo[e & 3] : bhi[e & 3];
#pragma unroll
            for (int k = 0; k < 4; ++k) { const unsigned d = raw[t + k][e >> 1]; const float xv = (e & 1) ? bfhi(d) : bflo(d); a += ((e < 4) ? wlo[k][e & 3] : whi[k][e & 3]) * xv; }
            o[e] = fsilu(a);
        }
        emit(t, o);
    }
}
DI u32x4 pack8f(const float* o) { u32x4 r; r[0] = pk2(o[0], o[1]); r[1] = pk2(o[2], o[3]); r[2] = pk2(o[4], o[5]); r[3] = pk2(o[6], o[7]); return r; }

template <bool XW, bool WITH_C> DI void ssd_stage(LAS unsigned char* lds, const bf16_t* xbc, const float* cw, const float* cb, size_t t0, int c, int g) {
    const int tid = otid();
    LAS float* sdt = (LAS float*)(lds + L_SDT); LAS float* sac = (LAS float*)(lds + L_SAC);
    {
        const int c8 = tid & 31, tg = tid >> 5, l0 = 8 * tg, ch = 256 * g + 8 * c8, hh = c8 >> 3;
        const int nzero = (c == 0) ? (3 - l0 > 0 ? 3 - l0 : 0) : 0;
        const float alast = sac[hh * 128 + 127];
        conv_strip<8>(xbc + (t0 + l0) * XBCW + ch, nzero, cw, cb, ch, [&](int t, float* o) {
            if (XW) { const float wgt = sdt[hh * 128 + l0 + t] * __expf(alast - sac[hh * 128 + l0 + t]);
#pragma unroll
                for (int e = 0; e < 8; ++e) o[e] *= wgt; }
            *(LAS u32x4*)(lds + L_SX + (l0 + t) * (XW ? SXS2 : SXS) + c8 * 16) = pack8f(o); });
    }
    {
        const int c8 = tid & 15, tg = tid >> 4, l0 = 4 * tg;
        const int nzero = (c == 0) ? (3 - l0 > 0 ? 3 - l0 : 0) : 0;
        const int chb = DIN + 128 * g + 8 * c8;
        conv_strip<4>(xbc + (t0 + l0) * XBCW + chb, nzero, cw, cb, chb, [&](int t, float* o) { *(LAS u32x4*)(lds + L_SB + (l0 + t) * (XW ? SBS2 : SBS) + c8 * 16) = pack8f(o); });
        if (WITH_C) { const int chc = DIN + 1024 + 128 * g + 8 * c8;
            conv_strip<4>(xbc + (t0 + l0) * XBCW + chc, nzero, cw, cb, chc, [&](int t, float* o) { *(LAS u32x4*)(lds + L_SC + (l0 + t) * SBS + c8 * 16) = pack8f(o); }); }
    }
}
DI bf16_t* st_ptr(unsigned char* ws, int b) { return (bf16_t*)(ws + (b ? O_ST1 : O_ST0)); }

DI void ssd_states_phase(LAS unsigned char* lds, const Params& p) {
    const int tid = otid(), w = __builtin_amdgcn_readfirstlane(tid >> 6), lane = tid & 63, r = lane & 31, h = lane >> 5, hh = w >> 1, ph = w & 1;
    const bf16_t* xbc = (const bf16_t*)(p.ws + O_XBC); const float* DT = (const float*)(p.ws + O_DT); float* cdec = (float*)(p.ws + O_CDEC);
    const int i16 = lane & 15, tq = i16 >> 2, tp = i16 & 3, g16 = (lane >> 4) & 1;
    for (int it = blockIdx.x; it < 1024; it += gridDim.x) {
        const int b = it >> 9, c = (it >> 3) & 63, g = it & 7; const size_t t0 = (size_t)b * SEQ + (size_t)c * 128;
        ssd_dt_acum(lds, DT, p.in[13], p.in[14], t0, g);
        ssd_stage<true, false>(lds, xbc, p.in[11], p.in[12], t0, c, g);
        __syncthreads();
        f32x16 acc[4];
#pragma unroll
        for (int i = 0; i < 4; ++i) acc[i] = zero16();
        const LAS unsigned char* xa = lds + L_SX + (8 * h + tq) * SXS2 + (64 * hh + 32 * ph + 16 * g16 + 4 * tp) * 2;
        const LAS unsigned char* ba = lds + L_SB + (8 * h + tq) * SBS2 + (16 * g16 + 4 * tp) * 2;
#pragma unroll
        for (int s = 0; s < 8; ++s) {
            const bf16x8 af = tr2(xa + 16 * s * SXS2, xa + (16 * s + 4) * SXS2);
#pragma unroll
            for (int nt = 0; nt < 4; ++nt) { const bf16x8 bfr = tr2(ba + 16 * s * SBS2 + nt * 64, ba + (16 * s + 4) * SBS2 + nt * 64); acc[nt] = MFMA32(af, bfr, acc[nt]); }
        }
        bf16_t* st = st_ptr(p.ws, b) + ((size_t)(c * 32 + 4 * g + hh) * 64 + 32 * ph) * 128;
#pragma unroll
        for (int nt = 0; nt < 4; ++nt)
#pragma unroll
            for (int i = 0; i < 16; ++i) st[(size_t)crow(i, h) * 128 + 32 * nt + r] = (bf16_t)(pk2(acc[nt][i], 0.f) & 0xffffu);
        if (tid < 4) cdec[(b * 64 + c) * 32 + 4 * g + tid] = __expf(((LAS float*)(lds + L_SAC))[tid * 128 + 127]);
        __syncthreads();
    }
}
DI void ssd_scan_phase(const Params& p, const bool dry) {
    const float* cdec = (const float*)(p.ws + O_CDEC);
    for (int e = blockIdx.x * 512 + threadIdx.x; e < 2 * 32 * 64 * 32; e += gridDim.x * 512) {
        const int b = e >> 16, rem = e & 65535, head = rem >> 11;
        bf16_t* st = st_ptr(p.ws, b) + (size_t)rem * 4;
        float carry[4] = {0.f, 0.f, 0.f, 0.f};
        for (int c0 = 0; c0 < 64; c0 += 8) {
            u32x2 v[8]; float dc[8];
#pragma unroll
            for (int u = 0; u < 8; ++u) { v[u] = *(const u32x2*)(st + (size_t)(c0 + u) * 262144); dc[u] = cdec[(b * 64 + c0 + u) * 32 + head]; }
#pragma unroll
            for (int u = 0; u < 8; ++u) {
                u32x2 o; o[0] = pk2(carry[0], carry[1]); o[1] = pk2(carry[2], carry[3]); if (!dry) *(u32x2*)(st + (size_t)(c0 + u) * 262144) = o;
                carry[0] = carry[0] * dc[u] + bflo(v[u][0]); carry[1] = carry[1] * dc[u] + bfhi(v[u][0]); carry[2] = carry[2] * dc[u] + bflo(v[u][1]); carry[3] = carry[3] * dc[u] + bfhi(v[u][1]);
            }
        }
    }
}
DI void ssd_out_phase(LAS unsigned char* lds, const Params& p, const bool dry) {
    const int tid = otid(), w = __builtin_amdgcn_readfirstlane(tid >> 6), lane = tid & 63, r = lane & 31, h = lane >> 5, hh = w >> 1, ph = w & 1;
    const bf16_t* xbc = (const bf16_t*)(p.ws + O_XBC); const float* DT = (const float*)(p.ws + O_DT); bf16_t* zy = (bf16_t*)p.out;
    LAS float* sdt = (LAS float*)(lds + L_SDT); LAS float* sac = (LAS float*)(lds + L_SAC); LAS float* ssq = (LAS float*)(lds + L_SSQ);
    const int i16 = lane & 15, tq = i16 >> 2, tp = i16 & 3, g16 = (lane >> 4) & 1;
    for (int it = blockIdx.x; it < 1024; it += gridDim.x) {
        const int b = it >> 9, c = (it >> 3) & 63, g = it & 7, head = 4 * g + hh; const size_t t0 = (size_t)b * SEQ + (size_t)c * 128;
        ssd_dt_acum(lds, DT, p.in[13], p.in[14], t0, g);
        ssd_stage<false, true>(lds, xbc, p.in[11], p.in[12], t0, c, g);
        bf16x8 pvf[8];
        { const bf16_t* pp = st_ptr(p.ws, b) + ((size_t)(c * 32 + head) * 64 + 32 * ph + r) * 128 + 8 * h;
#pragma unroll
          for (int s = 0; s < 8; ++s) pvf[s] = *(const bf16x8*)(pp + 16 * s); }
        __syncthreads();
        f32x16 Y[4];
        const LAS unsigned char* xa = lds + L_SX + (4 * h + tq) * SXS + (64 * hh + 32 * ph + 16 * g16 + 4 * tp) * 2;
#pragma unroll
        for (int lt = 0; lt < 4; ++lt) {
            __builtin_amdgcn_sched_barrier(0);
            f32x16 y = zero16();
#pragma unroll
            for (int s = 0; s < 8; ++s) { const bf16x8 cfs = *(const LAS bf16x8*)(lds + L_SC + (32 * lt + r) * SBS + (16 * s + 8 * h) * 2); y = MFMA32(pvf[s], cfs, y); }
            Y[lt] = y * __expf(sac[hh * 128 + 32 * lt + r]);
        }
#pragma unroll
        for (int lt = 0; lt < 4; ++lt) {
            __builtin_amdgcn_sched_barrier(0);
            bf16x8 cf[8];
#pragma unroll
            for (int s = 0; s < 8; ++s) cf[s] = *(const LAS bf16x8*)(lds + L_SC + (32 * lt + r) * SBS + (16 * s + 8 * h) * 2);
            const float al = sac[hh * 128 + 32 * lt + r];
#pragma unroll
            for (int mt = 0; mt < 4; ++mt) {
                if (mt <= lt) {
                    __builtin_amdgcn_sched_barrier(0);
                    f32x16 X = zero16();
#pragma unroll
                    for (int s = 0; s < 8; ++s) { const bf16x8 bfr = *(const LAS bf16x8*)(lds + L_SB + (32 * mt + r) * SBS + (16 * s + 8 * h) * 2); X = MFMA32(bfr, cf[s], X); }
#pragma unroll
                    for (int gq = 0; gq < 4; ++gq) {
                        const f32x4 am = *(const LAS f32x4*)(sac + hh * 128 + 32 * mt + 8 * gq + 4 * h), dm = *(const LAS f32x4*)(sdt + hh * 128 + 32 * mt + 8 * gq + 4 * h);
#pragma unroll
                        for (int jj = 0; jj < 4; ++jj) { const int mrow = 32 * mt + 8 * gq + 4 * h + jj; const bool ok = (32 * lt + r) >= mrow;
                            const float dec = ok ? __expf(fminf(al - am[jj], 0.f)) * dm[jj] : 0.f; X[4 * gq + jj] *= dec; }
                    }
#pragma unroll
                    for (int s2 = 0; s2 < 2; ++s2) { const bf16x8 xs = pack8(X, s2);
                        const LAS unsigned char* xr = xa + (32 * mt + 16 * s2) * SXS; const bf16x8 xf = tr2(xr, xr + 8 * SXS); Y[lt] = MFMA32(xf, xs, Y[lt]); }
                }
            }
        }
        __builtin_amdgcn_sched_barrier(0);
        const float Dh = p.in[15][head];
        float sq[4];
#pragma unroll
        for (int lt = 0; lt < 4; ++lt) {
            const int l = 32 * lt + r; sq[lt] = 0.f;
#pragma unroll
            for (int gq = 0; gq < 4; ++gq) {
                const int chl = 64 * hh + 32 * ph + 8 * gq + 4 * h;
                const u32x2 xv = *(const LAS u32x2*)(lds + L_SX + l * SXS + chl * 2);
                const u32x2 zv = *(const u32x2*)(zy + (t0 + l) * DIN + 256 * g + chl);
                const float xf4[4] = {bflo(xv[0]), bfhi(xv[0]), bflo(xv[1]), bfhi(xv[1])}, zf4[4] = {bflo(zv[0]), bfhi(zv[0]), bflo(zv[1]), bfhi(zv[1])};
#pragma unroll
                for (int jj = 0; jj < 4; ++jj) { const float yv = (Y[lt][4 * gq + jj] + Dh * xf4[jj]) * fsilu(zf4[jj]); Y[lt][4 * gq + jj] = yv; sq[lt] += yv * yv; }
            }
            sq[lt] += __shfl_xor(sq[lt], 32);
            if (h == 0) ssq[w * 128 + l] = sq[lt];
        }
        __syncthreads();
#pragma unroll
        for (int lt = 0; lt < 4; ++lt) {
            const int l = 32 * lt + r; float tot = 0.f;
#pragma unroll
            for (int ww = 0; ww < 8; ++ww) tot += ssq[ww * 128 + l];
            const float rn = __builtin_amdgcn_rsqf(tot * (1.0f / 256.0f) + 1e-5f);
#pragma unroll
            for (int gq = 0; gq < 4; ++gq) {
                const int chl = 64 * hh + 32 * ph + 8 * gq + 4 * h; const f32x4 gw = *(const f32x4*)(p.in[16] + 256 * g + chl);
                u32x2 o; o[0] = pk2(Y[lt][4 * gq] * rn * gw[0], Y[lt][4 * gq + 1] * rn * gw[1]); o[1] = pk2(Y[lt][4 * gq + 2] * rn * gw[2], Y[lt][4 * gq + 3] * rn * gw[3]);
                if (!dry) *(u32x2*)(zy + (t0 + l) * DIN + 256 * g + chl) = o;
            }
        }
        __syncthreads();
    }
}
DI void dt_proj(LAS unsigned char* lds, const Params& p) {
    const int tid = otid(), w = __builtin_amdgcn_readfirstlane(tid >> 6), lane = tid & 63, r = lane & 31, h = lane >> 5, rt = w & 1, kq = w >> 1;
    const bf16_t* hb = (const bf16_t*)(p.ws + O_HB); const bf16_t* wt = (const bf16_t*)(p.ws + W_SIN) + (size_t)6144 * DM;
    const float* ss = (const float*)(p.ws + O_SS) + 2 * MT; float* dt = (float*)(p.ws + O_DT);
    LAS float* part = (LAS float*)lds;
    for (int rb = blockIdx.x; rb < MT / 64; rb += gridDim.x) {
        const bf16_t* ap = hb + (size_t)(rb * 64 + rt * 32 + r) * DM + kq * 256 + 8 * h;
        const bf16_t* bp = wt + (size_t)r * DM + kq * 256 + 8 * h;
        bf16x8 af[16], bfr[16];
#pragma unroll
        for (int s = 0; s < 16; ++s) { af[s] = *(const bf16x8*)(ap + 16 * s); bfr[s] = *(const bf16x8*)(bp + 16 * s); }
        f32x16 acc = zero16();
#pragma unroll
        for (int s = 0; s < 16; ++s) acc = MFMA32(af[s], bfr[s], acc);
#pragma unroll
        for (int i = 0; i < 16; ++i) part[((kq * 2 + rt) * 32 + crow(i, h)) * 32 + r] = acc[i];
        __syncthreads();
#pragma unroll
        for (int q = 0; q < 4; ++q) {
            const int o = tid + 512 * q, row = o >> 5, col = o & 31;
            float v = 0.f;
#pragma unroll
            for (int k = 0; k < 4; ++k) v += part[((k * 2 + (row >> 5)) * 32 + (row & 31)) * 32 + col];
            const int grow = rb * 64 + row;
            dt[(size_t)grow * 32 + col] = v * __builtin_amdgcn_rsqf(ss[grow] * (1.0f / 1024.0f) + 1e-6f);
        }
        __syncthreads();
    }
}
template <class Epi> DI void run_gemm(LAS unsigned char* lds, const bf16_t* A, const bf16_t* Bt, int N, int K, const Epi& E) {
    pg8::Gemm g; g.A = A; g.Bt = Bt; g.M = MT; g.N = N; g.K = K;
    pg8::StaticOrder S; S.init(MT, N, (int)gridDim.x, (int)blockIdx.x);
    pg8::gemm_phase<Epi, pg8::StaticOrder, !Epi::AFTER_DRAIN, true>((PG8_LAS unsigned char*)lds, g, S, E);
}
#if defined(DRY_S3) || defined(DRY_S4)
#define DRYV (p.ws == nullptr)
#else
#define DRYV false
#endif
__global__ void __launch_bounds__(512, 2) fwd_megakernel(Params p) {
    extern __shared__ __attribute__((aligned(16))) unsigned char shm[];
    LAS unsigned char* lds = (LAS unsigned char*)shm;
    cg::grid_group grid = cg::this_grid();
    if (threadIdx.x < 4) ((LAS unsigned*)(lds + LDS_BYTES - 16))[threadIdx.x] = 0u;
    __syncthreads();
    const XcdBarrier xbar = xcd_barrier_post((unsigned*)(p.ws + O_BAR), (volatile LAS unsigned*)(lds + LDS_BYTES - 16));
#define GBAR() xcd_barrier(xbar)
    unsigned char* ws = p.ws;
    bf16_t* hb = (bf16_t*)(ws + O_HB); float* ss = (float*)(ws + O_SS);
    phase0(lds, p);
#ifdef DUP_P0
    GBAR(); phase0(lds, p);
#endif
    if (gridDim.x == 0x7fffffffu) grid.sync();
    GBAR();
    { EpiAttnIn E; E.O = (bf16_t*)(ws + O_PROJ); E.ss = ss; E.tab = (const f32x4*)(ws + O_ROPE); run_gemm(lds, hb, (const bf16_t*)(ws + W_AIN), AINW, DM, E); }
    GBAR();
    attn_phase(lds, p);
#ifdef DUP_ATTN
    GBAR(); attn_phase(lds, p);
#endif
    GBAR();
    { EpiRes<false, false> E; E.xres = nullptr; E.hb = hb;     E.outf = nullptr; E.ssn = ss + MT; run_gemm(lds, (const bf16_t*)(ws + O_MIXED), (const bf16_t*)(ws + W_AOUT), DM, DM, E); }
    GBAR();
    { EpiGU E; E.act = (bf16_t*)(ws + O_ACT); E.ss = ss + MT; run_gemm(lds, hb, (const bf16_t*)(ws + W_GU0), 2 * DFF, DM, E); }
    GBAR();
    { EpiRes<false, false> E; E.xres = nullptr; E.hb = hb; E.outf = nullptr; E.ssn = ss + 2 * MT; run_gemm(lds, (const bf16_t*)(ws + O_ACT), (const bf16_t*)(ws + W_DN0), DM, DFF, E); }
    GBAR();
    { EpiSsdIn E; E.z = (bf16_t*)p.out; E.xbc = (bf16_t*)(ws + O_XBC); E.dt = (float*)(ws + O_DT); E.ss = ss + 2 * MT; dt_proj(lds, p); run_gemm(lds, hb, (const bf16_t*)(ws + W_SIN), 6144, DM, E); }
    GBAR();
    ssd_states_phase(lds, p);
#ifdef DUP_S2
    GBAR(); ssd_states_phase(lds, p);
#endif
    GBAR();
#ifdef DRY_S3
    ssd_scan_phase(p, p.ws != nullptr); GBAR();
#endif
    ssd_scan_phase(p, DRYV);
    GBAR();
#ifdef DRY_S4
    ssd_out_phase(lds, p, p.ws != nullptr); GBAR();
#endif
    ssd_out_phase(lds, p, DRYV);
    GBAR();
    { EpiRes<false, false> E; E.xres = nullptr; E.hb = hb; E.outf = nullptr; E.ssn = ss + 3 * MT; run_gemm(lds, (const bf16_t*)p.out, (const bf16_t*)(ws + W_SOUT), DM, DIN, E); }
    GBAR();
    { EpiGU E; E.act = (bf16_t*)(ws + O_ACT); E.ss = ss + 3 * MT; run_gemm(lds, hb, (const bf16_t*)(ws + W_GU1), 2 * DFF, DM, E); }
    GBAR();
    if (gridDim.x == 256) {
        EpiFinal E; E.hb = hb; E.outf = p.out; E.ssn = ss + 4 * MT; E.cnt = (unsigned*)(ws + O_BAR) + XCD_BAR_WORDS; E.fw = p.in[22];
        run_gemm(lds, (const bf16_t*)(ws + O_ACT), (const bf16_t*)(ws + W_DN1), DM, DFF, E);
    } else {
        { EpiRes<false, true> E; E.xres = nullptr; E.hb = hb; E.outf = p.out; E.ssn = ss + 4 * MT; run_gemm(lds, (const bf16_t*)(ws + O_ACT), (const bf16_t*)(ws + W_DN1), DM, DFF, E); }
        GBAR();
        const float* ss4 = ss + 4 * MT; const f32x4* fw = (const f32x4*)p.in[22]; f32x4* o4 = (f32x4*)p.out;
        for (int i = blockIdx.x * 512 + threadIdx.x; i < MT * (DM / 4); i += gridDim.x * 512) {
            const int row = i >> 8; const float rs = __builtin_amdgcn_rsqf(ss4[row] * (1.0f / 1024.0f) + 1e-6f);
            o4[i] = o4[i] * rs * fw[i & 255];
        }
    }
}

extern "C" void kernel_launch(void* const* d_in, const int* in_sizes, int n_in, void* d_out, int out_size, void* d_ws, size_t ws_size, hipStream_t stream) {
    static int grid_blocks = 0;
    if (!grid_blocks) {
        int dev = 0, cus = 0, per_cu = 0;
        hipGetDevice(&dev);
        hipDeviceGetAttribute(&cus, hipDeviceAttributeMultiprocessorCount, dev);
        if (hipFuncSetAttribute((const void*)fwd_megakernel, hipFuncAttributeMaxDynamicSharedMemorySize, LDS_BYTES) != hipSuccess) fprintf(stderr, "hipFuncSetAttribute failed\n");
        if (hipOccupancyMaxActiveBlocksPerMultiprocessor(&per_cu, (const void*)fwd_megakernel, 512, LDS_BYTES) != hipSuccess || per_cu < 1) { fprintf(stderr, "occupancy query: %d\n", per_cu); per_cu = 1; }
        (void)hipGetLastError();
        grid_blocks = cus * per_cu;
        if (ws_size < 268435456ull || n_in != 23) fprintf(stderr, "unexpected ws_size %zu / n_in %d\n", ws_size, n_in);
    }
    if (hipMemsetAsync((char*)d_ws + O_BAR, 0, 20480, stream) != hipSuccess) fprintf(stderr, "memset failed\n");
    Params p{};
    for (int i = 0; i < 23; ++i) p.in[i] = (const float*)d_in[i];
    p.out = (float*)d_out; p.ws = (unsigned char*)d_ws;
    void* args[] = {&p};
    hipError_t e = hipLaunchCooperativeKernel((const void*)fwd_megakernel, dim3(grid_blocks), dim3(512), args, LDS_BYTES, stream);
    if (e != hipSuccess) fprintf(stderr, "cooperative launch failed: %s (grid %d)\n", hipGetErrorString(e), grid_blocks);
}
#ifdef PHASE_TEST
__global__ void __launch_bounds__(512, 2) t_phase0(Params p) { extern __shared__ __attribute__((aligned(16))) unsigned char shm[]; phase0((LAS unsigned char*)shm, p); }
__global__ void __launch_bounds__(512, 2) t_attn_diff(Params p) { extern __shared__ __attribute__((aligned(16))) unsigned char shm[]; diff_tile((LAS unsigned char*)shm, (const bf16_t*)(p.ws + O_PROJ), (bf16_t*)(p.ws + O_MIXED), p.in[7], 0.3f, blockIdx.x & 1, blockIdx.y, blockIdx.z); }
__global__ void __launch_bounds__(512, 2) t_attn_sb(Params p) { extern __shared__ __attribute__((aligned(16))) unsigned char shm[]; sb_block((LAS unsigned char*)shm, (const bf16_t*)(p.ws + O_PROJ), (bf16_t*)(p.ws + O_MIXED), blockIdx.x & 1, blockIdx.y, blockIdx.z); }
__global__ void __launch_bounds__(512, 2) t_ssd_states(Params p) { extern __shared__ __attribute__((aligned(16))) unsigned char shm[]; ssd_states_phase((LAS unsigned char*)shm, p); }
__global__ void __launch_bounds__(512, 2) t_ssd_scan(Params p) { ssd_scan_phase(p, false); }
__global__ void __launch_bounds__(512, 2) t_ssd_out(Params p) { extern __shared__ __attribute__((aligned(16))) unsigned char shm[]; ssd_out_phase((LAS unsigned char*)shm, p, false); }
__global__ void __launch_bounds__(512, 2) t_gemm_ain(Params p) { extern __shared__ __attribute__((aligned(16))) unsigned char shm[]; EpiAttnIn E; E.O = (bf16_t*)(p.ws + O_PROJ); E.ss = (float*)(p.ws + O_SS); E.tab = (const f32x4*)(p.ws + O_ROPE); run_gemm((LAS unsigned char*)shm, (bf16_t*)(p.ws + O_HB), (const bf16_t*)(p.ws + W_AIN), AINW, DM, E); }
__global__ void __launch_bounds__(512, 2) t_gemm_res(Params p) { extern __shared__ __attribute__((aligned(16))) unsigned char shm[]; EpiRes<false, false> E; E.xres = nullptr; E.hb = (bf16_t*)(p.ws + O_HB); E.outf = nullptr; E.ssn = (float*)(p.ws + O_SS); run_gemm((LAS unsigned char*)shm, (bf16_t*)(p.ws + O_ACT), (const bf16_t*)(p.ws + W_DN0), DM, DFF, E); }
__global__ void __launch_bounds__(512, 2) t_gemm_gu(Params p) { extern __shared__ __attribute__((aligned(16))) unsigned char shm[]; EpiGU E; E.act = (bf16_t*)(p.ws + O_ACT); E.ss = (float*)(p.ws + O_SS); run_gemm((LAS unsigned char*)shm, (bf16_t*)(p.ws + O_HB), (const bf16_t*)(p.ws + W_GU0), 2 * DFF, DM, E); }
__global__ void __launch_bounds__(512, 2) t_gemm_ssdin(Params p) { extern __shared__ __attribute__((aligned(16))) unsigned char shm[]; EpiSsdIn E; E.z = (bf16_t*)p.out; E.xbc = (bf16_t*)(p.ws + O_XBC); E.dt = (float*)(p.ws + O_DT); E.ss = (float*)(p.ws + O_SS); run_gemm((LAS unsigned char*)shm, (bf16_t*)(p.ws + O_HB), (const bf16_t*)(p.ws + W_SIN), SINWP, DM, E); }
#endif
```
